# Optimizing an MI355X kernel written in HIP

```python
import math
import jax
import jax.numpy as jnp
from jax import lax
import numpy as np

D_MODEL = 1024
BATCH = 32
SEQ = 2048
DEPTH = 4

CTX_LEN = 256
GRID_W = 64
N_MIXERS = 4
N_A = (DEPTH + 3) // 4
N_B = (DEPTH + 2) // 4
N_C = (DEPTH + 1) // 4
N_D = DEPTH // 4

S5_GROUP = 16
S5_GROUPS = D_MODEL // S5_GROUP
S5_STATE = 64
DT_MIN = 0.001
DT_MAX = 0.1

NA_HEAD_DIM = 64
NA_HEADS = D_MODEL // NA_HEAD_DIM
WIN_R = 8
WIN_C = 16

DA_HEAD_DIM = 64
DA_HEADS = D_MODEL // (2 * DA_HEAD_DIM)
Q_BLOCK = 128
ROPE_BASE = 10000.0

HG_EXPAND = 128
HG_HEADS = D_MODEL // HG_EXPAND
HG_DV = D_MODEL // HG_HEADS
HG_CHUNK = 64

N_EXPERTS = 16
EXPERT_FF = 2 * D_MODEL
CAPACITY_FACTOR = 2

EPS = 1e-6
F32 = jnp.float32

kernel_name = 'hybrid_s5_nat_diffattn_hgrn2_ecmoe_dit'


def rmsnorm(x, g):
    xf = x.astype(F32)
    y = xf * lax.rsqrt(jnp.mean(xf * xf, axis=-1, keepdims=True) + EPS)
    return (y * g.astype(F32)).astype(x.dtype)


def s5_discretise(a_re, a_im, log_dt, b_re, b_im):
    a_re, a_im = a_re.astype(F32), a_im.astype(F32)
    dt = jnp.exp(log_dt.astype(F32))[:, None]
    lr, li = a_re * dt, a_im * dt
    cos_li, sin_li = jnp.cos(li), jnp.sin(li)
    mag = jnp.exp(lr)
    ab_re, ab_im = mag * cos_li, mag * sin_li
    nr = jnp.expm1(lr) * cos_li - 2.0 * jnp.sin(0.5 * li) ** 2
    den = a_re * a_re + a_im * a_im
    fr = (nr * a_re + ab_im * a_im) / den
    fi = (ab_im * a_re - nr * a_im) / den
    b_re, b_im = b_re.astype(F32), b_im.astype(F32)
    bb_re = fr[..., None] * b_re - fi[..., None] * b_im
    bb_im = fr[..., None] * b_im + fi[..., None] * b_re
    return ab_re, ab_im, bb_re, bb_im


def _complex_scan_combine(e1, e2):
    a1r, a1i, b1r, b1i = e1
    a2r, a2i, b2r, b2i = e2
    return (a2r * a1r - a2i * a1i, a2r * a1i + a2i * a1r,
            a2r * b1r - a2i * b1i + b2r, a2r * b1i + a2i * b1r + b2i)


def s5_scan(u, h0, ab_re, ab_im, bb_re, bb_im):
    Bn, n, _ = u.shape
    ug = u.astype(F32).reshape(Bn, n, S5_GROUPS, S5_GROUP)
    bu_re = jnp.einsum('blgh,gph->lbgp', ug, bb_re)
    bu_im = jnp.einsum('blgh,gph->lbgp', ug, bb_im)
    if h0 is not None:
        h0r, h0i = h0
        bu_re = bu_re.at[0].add(ab_re * h0r - ab_im * h0i)
        bu_im = bu_im.at[0].add(ab_re * h0i + ab_im * h0r)
    a_re = jnp.broadcast_to(ab_re, (n, 1) + ab_re.shape)
    a_im = jnp.broadcast_to(ab_im, (n, 1) + ab_im.shape)
    _, _, hr, hi = lax.associative_scan(_complex_scan_combine, (a_re, a_im, bu_re, bu_im), axis=0)
    return hr, hi


def s5_readout(hr, hi, c_re, c_im):
    y = jnp.einsum('gkp,lbgp->blgk', c_re.astype(F32), hr) - jnp.einsum('gkp,lbgp->blgk', c_im.astype(F32), hi)
    return y.reshape(y.shape[0], y.shape[1], -1)


def s5_mixer(hc, hl, a_re, a_im, log_dt, b_re, b_im, c_re, c_im, d, w_glu, with_ctx):
    def direction(k, uc, ul):
        ab_re, ab_im, bb_re, bb_im = s5_discretise(a_re[k], a_im[k], log_dt[k], b_re[k], b_im[k])
        cr, ci = s5_scan(uc, None, ab_re, ab_im, bb_re, bb_im)
        lr, li = s5_scan(ul, (cr[-1], ci[-1]), ab_re, ab_im, bb_re, bb_im)
        yl = s5_readout(lr, li, c_re[k], c_im[k])
        yc = s5_readout(cr, ci, c_re[k], c_im[k]) if with_ctx else None
        return yc, yl

    ycf, ylf = direction(0, hc, hl)
    ycb, ylb = direction(1, hc[:, ::-1], hl[:, ::-1])

    def glu(y, u):
        z = jax.nn.gelu(y + d.astype(F32) * u.astype(F32)).astype(u.dtype)
        za, zb = jnp.split(z @ w_glu, 2, axis=-1)
        return za * jax.nn.sigmoid(zb)

    out_l = glu(ylf + ylb[:, ::-1], hl)
    out_c = glu(ycf + ycb[:, ::-1], hc) if with_ctx else None
    return out_c, out_l


def na_mixer(hc, hl, w_qkv, w_o, rpb, with_ctx):
    H, dh = NA_HEADS, NA_HEAD_DIM
    Bn, L, D = hl.shape
    rows = L // GRID_W
    wr = min(WIN_R, rows)
    scale = dh ** -0.5

    def proj(h):
        n = h.shape[1]
        q, k, v = jnp.split(h @ w_qkv, 3, axis=-1)
        return q.reshape(Bn, n, H, dh), k.reshape(Bn, n, H, dh), v.reshape(Bn, n, H, dh)

    qc, kc, vc = proj(hc)
    ql, kl, vl = proj(hl)
    kg = kl.reshape(Bn, rows, GRID_W, H, dh)
    vg = vl.reshape(Bn, rows, GRID_W, H, dh)
    r_q = jnp.arange(rows)
    r0 = jnp.clip(r_q - wr // 2, 0, rows - wr)
    krows = r0[:, None] + jnp.arange(wr)[None, :]
    cq = jnp.arange(GRID_W)
    c0 = jnp.clip(cq - WIN_C // 2, 0, GRID_W - WIN_C)
    col_in = (cq[None, :] >= c0[:, None]) & (cq[None, :] < c0[:, None] + WIN_C)
    dc_idx = jnp.clip(cq[None, :] - cq[:, None] + WIN_C - 1, 0, 2 * WIN_C - 2)
    n_lat = wr * GRID_W

    def row_block(args):
        q_r, rr, krow = args
        k_r = kg[:, krow].reshape(Bn, n_lat, H, dh)
        v_r = vg[:, krow].reshape(Bn, n_lat, H, dh)
        s_lat = jnp.einsum('bqhd,bkhd->bhqk', q_r, k_r).astype(F32) * scale
        s_lat = s_lat.reshape(Bn, H, GRID_W, wr, GRID_W)
        dr_idx = krow - rr + WIN_R - 1
        bias = rpb[:, dr_idx[None, :, None], dc_idx[:, None, :]].astype(F32)
        s_lat = jnp.where(col_in[:, None, :], s_lat + bias, -jnp.inf).reshape(Bn, H, GRID_W, n_lat)
        s_ctx = jnp.einsum('bqhd,bkhd->bhqk', q_r, kc).astype(F32) * scale
        p = jax.nn.softmax(jnp.concatenate([s_lat, s_ctx], axis=-1), axis=-1).astype(vl.dtype)
        return (jnp.einsum('bhqk,bkhd->bqhd', p[..., :n_lat], v_r)
                + jnp.einsum('bhqk,bkhd->bqhd', p[..., n_lat:], vc))

    q_rows = jnp.moveaxis(ql.reshape(Bn, rows, GRID_W, H, dh), 1, 0)
    ob = lax.map(row_block, (q_rows, r_q, krows))
    out_l = jnp.moveaxis(ob, 0, 1).reshape(Bn, L, D) @ w_o
    out_c = None
    if with_ctx:
        p = jax.nn.softmax(jnp.einsum('bqhd,bkhd->bhqk', qc, kc).astype(F32) * scale, axis=-1).astype(vc.dtype)
        out_c = jnp.einsum('bhqk,bkhd->bqhd', p, vc).reshape(Bn, hc.shape[1], D) @ w_o
    return out_c, out_l


def rope_2d_angles(n, dh):
    t = jnp.arange(n)
    row = (t // GRID_W).astype(F32)
    col = (t % GRID_W).astype(F32)
    quarter = dh // 4
    inv = ROPE_BASE ** (-jnp.arange(quarter, dtype=F32) / quarter)
    return row[:, None] * inv[None, :], col[:, None] * inv[None, :]


def apply_rope_2d(x, ang_r, ang_c):
    def rot(t, a):
        cos = jnp.cos(a)[None, :, None, :].astype(t.dtype)
        sin = jnp.sin(a)[None, :, None, :].astype(t.dtype)
        t1, t2 = jnp.split(t, 2, axis=-1)
        return jnp.concatenate([t1 * cos - t2 * sin, t2 * cos + t1 * sin], axis=-1)
    xr, xcl = jnp.split(x, 2, axis=-1)
    return jnp.concatenate([rot(xr, ang_r), rot(xcl, ang_c)], axis=-1)


def diff_attend(q, k, v, lam_full, lam_init, subln):
    s = jnp.einsum('bqhmd,bkhmd->bhmqk', q, k).astype(F32) * (DA_HEAD_DIM ** -0.5)
    p = jax.nn.softmax(s, axis=-1)
    a = (p[:, :, 0] - lam_full * p[:, :, 1]).astype(v.dtype)
    o = jnp.einsum('bhqk,bkhe->bqhe', a, v)
    return rmsnorm(o, subln) * (1.0 - lam_init)


def diff_attn_mixer(hc, hl, w_qkv, w_o, lam, subln, layer_idx, with_ctx):
    H, dh = DA_HEADS, DA_HEAD_DIM
    Bn, L, D = hl.shape

    def proj(h):
        n = h.shape[1]
        q, k, v = jnp.split(h @ w_qkv, 3, axis=-1)
        return q.reshape(Bn, n, H, 2, dh), k.reshape(Bn, n, H, 2, dh), v.reshape(Bn, n, H, 2 * dh)

    qc, kc, vc = proj(hc)
    ql, kl, vl = proj(hl)
    ang_r, ang_c = rope_2d_angles(L, dh)
    rope = lambda t: apply_rope_2d(t.reshape(Bn, L, 2 * H, dh), ang_r, ang_c).reshape(Bn, L, H, 2, dh)
    ql, kl = rope(ql), rope(kl)
    lam = lam.astype(F32)
    lam_init = 0.8 - 0.6 * math.exp(-0.3 * layer_idx)
    lam_full = jnp.exp(jnp.sum(lam[0] * lam[1])) - jnp.exp(jnp.sum(lam[2] * lam[3])) + lam_init
    k_all = jnp.concatenate([kl, kc], axis=1)
    v_all = jnp.concatenate([vl, vc], axis=1)
    n_blk = L // Q_BLOCK
    q_blocks = jnp.moveaxis(ql.reshape(Bn, n_blk, Q_BLOCK, H, 2, dh), 1, 0)
    ob = lax.map(lambda qb: diff_attend(qb, k_all, v_all, lam_full, lam_init, subln), q_blocks)
    out_l = jnp.moveaxis(ob, 0, 1).reshape(Bn, L, D) @ w_o
    out_c = None
    if with_ctx:
        out_c = diff_attend(qc, kc, vc, lam_full, lam_init, subln).reshape(Bn, hc.shape[1], D) @ w_o
    return out_c, out_l


def hgrn2_chunk_scan(q, k, v, logf, s0, with_out):
    Bn, H, n, _ = k.shape
    nc = n // HG_CHUNK
    to_chunks = lambda t: jnp.moveaxis(t.reshape(Bn, H, nc, HG_CHUNK, t.shape[-1]), 2, 0)
    lower = jnp.tril(jnp.ones((HG_CHUNK, HG_CHUNK), dtype=bool))

    def step(S, xs):
        qc, kc, vc, gc = xs
        G = jnp.cumsum(gc, axis=2)
        G_end = G[:, :, -1:, :]
        S_new = (jnp.exp(G_end)[:, :, 0, :, None] * S
                 + jnp.einsum('bhsd,bhse->bhde', kc * jnp.exp(G_end - G), vc))
        if not with_out:
            return S_new, None
        o_inter = jnp.einsum('bhtd,bhde->bhte', qc * jnp.exp(G), S)
        rel = jnp.where(lower[:, :, None], G[:, :, :, None, :] - G[:, :, None, :, :], -jnp.inf)
        att = jnp.einsum('bhtd,bhsd,bhtsd->bhts', qc, kc, jnp.exp(rel))
        return S_new, o_inter + jnp.einsum('bhts,bhse->bhte', att, vc)

    S_fin, o = lax.scan(step, s0, (to_chunks(q), to_chunks(k), to_chunks(v), to_chunks(logf)))
    if not with_out:
        return S_fin, None
    return S_fin, jnp.moveaxis(o, 0, 2).reshape(Bn, H, n, v.shape[-1])


def hgrn2_mixer(hc, hl, w_in, w_o, gnorm, lb, with_ctx):
    H, dk, dv = HG_HEADS, HG_EXPAND, HG_DV
    Bn, L, D = hl.shape
    lb = lb.astype(F32).reshape(1, H, 1, dk)

    def proj(h):
        n = h.shape[1]
        z = (h @ w_in).astype(F32)
        q, ff, fb, i, g = jnp.split(z, 5, axis=-1)
        heads = lambda t, e: t.reshape(Bn, n, H, e).transpose(0, 2, 1, 3)
        logf_f = jnp.log(lb + (1.0 - lb) * jax.nn.sigmoid(heads(ff, dk)))
        logf_b = jnp.log(lb + (1.0 - lb) * jax.nn.sigmoid(heads(fb, dk)))
        return heads(q, dk), logf_f, logf_b, heads(jax.nn.silu(i), dv), g

    qc, lfc, lbc, vc, gc = proj(hc)
    ql, lfl, lbl, vl, gl = proj(hl)
    flip = lambda t: t[:, :, ::-1]
    s0 = jnp.zeros((Bn, H, dk, dv), F32)
    sc_f, oc_f = hgrn2_chunk_scan(qc, -jnp.expm1(lfc), vc, lfc, s0, with_ctx)
    _, ol_f = hgrn2_chunk_scan(ql, -jnp.expm1(lfl), vl, lfl, sc_f, True)
    sc_b, oc_b = hgrn2_chunk_scan(flip(qc), flip(-jnp.expm1(lbc)), flip(vc), flip(lbc), s0, with_ctx)
    _, ol_b = hgrn2_chunk_scan(flip(ql), flip(-jnp.expm1(lbl)), flip(vl), flip(lbl), sc_b, True)

    def readout(o_f, o_b, g, dtype):
        n = o_f.shape[2]
        o = (o_f + flip(o_b)).transpose(0, 2, 1, 3)
        o = rmsnorm(o, gnorm).reshape(Bn, n, D) * jax.nn.silu(g)
        return o.astype(dtype) @ w_o

    out_l = readout(ol_f, ol_b, gl, hl.dtype)
    out_c = readout(oc_f, oc_b, gc, hc.dtype) if with_ctx else None
    return out_c, out_l


def ec_moe(h, w_router, w_gate, w_up, w_down):
    Bn, n, _ = h.shape
    cap = CAPACITY_FACTOR * n // N_EXPERTS
    aff = jax.nn.softmax(jnp.einsum('bnd,de->ben', h, w_router).astype(F32), axis=1)
    gate, idx = lax.top_k(aff, cap)
    bidx = jnp.arange(Bn)[:, None, None]
    xs = h[bidx, idx]
    hid = jax.nn.silu(jnp.einsum('becd,edf->becf', xs, w_gate)) * jnp.einsum('becd,edf->becf', xs, w_up)
    out = jnp.einsum('becf,efd->becd', hid, w_down) * gate[..., None].astype(h.dtype)
    return jnp.zeros_like(h).at[bidx, idx].add(out)


def setup_inputs(seed: int = 0) -> dict:
    key = jax.random.key(seed)
    ks = list(jax.random.split(key, 40))
    nrm = lambda shape, s: jax.random.normal(ks.pop(), shape, F32) * s
    D, G, P, GS = D_MODEL, S5_GROUPS, S5_STATE, S5_GROUP
    x = nrm((BATCH, SEQ, D), 1.0)
    c = nrm((BATCH, D), 1.0)
    ctx = nrm((BATCH, CTX_LEN, D), 1.0)
    c_ctx = nrm((D,), 1.0)
    w_mod = nrm((DEPTH, D, 6 * D), 0.5 * D ** -0.5)
    b_mod = nrm((DEPTH, 6 * D), 0.02)
    norm1 = 1.0 + nrm((DEPTH, D), 0.01)
    norm2 = 1.0 + nrm((DEPTH, D), 0.01)
    s5_a_re = -0.5 + nrm((N_A, 2, G, P), 0.01)
    s5_a_im = math.pi * jnp.arange(P, dtype=F32) + nrm((N_A, 2, G, P), 0.01)
    s5_log_dt = jax.random.uniform(ks.pop(), (N_A, 2, G), F32, math.log(DT_MIN), math.log(DT_MAX))
    s5_b_re = nrm((N_A, 2, G, P, GS), (2 * GS) ** -0.5)
    s5_b_im = nrm((N_A, 2, G, P, GS), (2 * GS) ** -0.5)
    s5_c_re = nrm((N_A, 2, G, GS, P), (2 * P) ** -0.5)
    s5_c_im = nrm((N_A, 2, G, GS, P), (2 * P) ** -0.5)
    s5_d = nrm((N_A, D), 1.0)
    s5_w_glu = nrm((N_A, D, 2 * D), D ** -0.5)
    na_w_qkv = nrm((N_B, D, 3 * D), D ** -0.5)
    na_w_o = nrm((N_B, D, D), D ** -0.5)
    na_rpb = nrm((N_B, NA_HEADS, 2 * WIN_R - 1, 2 * WIN_C - 1), 0.02)
    da_w_qkv = nrm((N_C, D, 3 * D), D ** -0.5)
    da_w_o = nrm((N_C, D, D), D ** -0.5)
    da_lambda = nrm((N_C, 4, DA_HEAD_DIM), 0.1)
    da_subln = 1.0 + nrm((N_C, 2 * DA_HEAD_DIM), 0.01)
    hg_w_in = nrm((N_D, D, 5 * D), D ** -0.5)
    hg_w_o = nrm((N_D, D, D), D ** -0.5)
    hg_gnorm = 1.0 + nrm((N_D, HG_DV), 0.01)
    hg_lower_bounds = 1.0 + nrm((DEPTH, D), 0.1)
    moe_router = nrm((DEPTH, D, N_EXPERTS), D ** -0.5)
    moe_w_gate = nrm((DEPTH, N_EXPERTS, D, EXPERT_FF), D ** -0.5)
    moe_w_up = nrm((DEPTH, N_EXPERTS, D, EXPERT_FF), D ** -0.5)
    moe_w_down = nrm((DEPTH, N_EXPERTS, EXPERT_FF, D), EXPERT_FF ** -0.5)
    norm_f = 1.0 + nrm((D,), 0.01)
    return {'x': x, 'c': c, 'ctx': ctx, 'c_ctx': c_ctx,
            'w_mod': w_mod, 'b_mod': b_mod, 'norm1': norm1, 'norm2': norm2,
            's5_a_re': s5_a_re, 's5_a_im': s5_a_im, 's5_log_dt': s5_log_dt,
            's5_b_re': s5_b_re, 's5_b_im': s5_b_im, 's5_c_re': s5_c_re, 's5_c_im': s5_c_im,
            's5_d': s5_d, 's5_w_glu': s5_w_glu,
            'na_w_qkv': na_w_qkv, 'na_w_o': na_w_o, 'na_rpb': na_rpb,
            'da_w_qkv': da_w_qkv, 'da_w_o': da_w_o, 'da_lambda': da_lambda, 'da_subln': da_subln,
            'hg_w_in': hg_w_in, 'hg_w_o': hg_w_o, 'hg_gnorm': hg_gnorm, 'hg_lower_bounds': hg_lower_bounds,
            'moe_router': moe_router, 'moe_w_gate': moe_w_gate, 'moe_w_up': moe_w_up, 'moe_w_down': moe_w_down,
            'norm_f': norm_f}


def reference(x, c, ctx, c_ctx, w_mod, b_mod, norm1, norm2,
              s5_a_re, s5_a_im, s5_log_dt, s5_b_re, s5_b_im, s5_c_re, s5_c_im, s5_d, s5_w_glu,
              na_w_qkv, na_w_o, na_rpb,
              da_w_qkv, da_w_o, da_lambda, da_subln,
              hg_w_in, hg_w_o, hg_gnorm, hg_lower_bounds,
              moe_router, moe_w_gate, moe_w_up, moe_w_down, norm_f):
    p_lb = jax.nn.softmax(hg_lower_bounds.astype(F32), axis=0)
    lbs = jnp.cumsum(p_lb, axis=0) - p_lb[0]
    silu_c = jax.nn.silu(c)
    silu_cc = jax.nn.silu(c_ctx)
    h_ctx = ctx
    for i in range(DEPTH):
        m, j = i % N_MIXERS, i // N_MIXERS
        last = i == DEPTH - 1
        mod_l = jnp.split((silu_c @ w_mod[i] + b_mod[i])[:, None, :], 6, axis=-1)
        mod_c = jnp.split((silu_cc @ w_mod[i] + b_mod[i])[None, None, :], 6, axis=-1)
        hl = rmsnorm(x, norm1[i]) * (1.0 + mod_l[1]) + mod_l[0]
        hc = rmsnorm(h_ctx, norm1[i]) * (1.0 + mod_c[1]) + mod_c[0]
        if m == 0:
            yc, yl = s5_mixer(hc, hl, s5_a_re[j], s5_a_im[j], s5_log_dt[j], s5_b_re[j], s5_b_im[j],
                              s5_c_re[j], s5_c_im[j], s5_d[j], s5_w_glu[j], not last)
        elif m == 1:
            yc, yl = na_mixer(hc, hl, na_w_qkv[j], na_w_o[j], na_rpb[j], not last)
        elif m == 2:
            yc, yl = diff_attn_mixer(hc, hl, da_w_qkv[j], da_w_o[j], da_lambda[j], da_subln[j], i, not last)
        else:
            yc, yl = hgrn2_mixer(hc, hl, hg_w_in[j], hg_w_o[j], hg_gnorm[j], lbs[i], not last)
        x = x + mod_l[2] * yl
        x = x + mod_l[5] * ec_moe(rmsnorm(x, norm2[i]) * (1.0 + mod_l[4]) + mod_l[3],
                                  moe_router[i], moe_w_gate[i], moe_w_up[i], moe_w_down[i])
        if not last:
            h_ctx = h_ctx + mod_c[2] * yc
            h_ctx = h_ctx + mod_c[5] * ec_moe(rmsnorm(h_ctx, norm2[i]) * (1.0 + mod_c[4]) + mod_c[3],
                                              moe_router[i], moe_w_gate[i], moe_w_up[i], moe_w_down[i])
    return rmsnorm(x, norm_f)
```

```cpp
#include <hip/hip_runtime.h>
#include <cstdio>
#include <cstdint>

#ifndef MK_SINGLE
#define MK_SINGLE 0
#endif

typedef unsigned short bf16;
typedef float f32x4 __attribute__((ext_vector_type(4)));
typedef unsigned u32x2 __attribute__((ext_vector_type(2)));
typedef unsigned u32x4 __attribute__((ext_vector_type(4)));
#define LAS __attribute__((address_space(3)))

constexpr int NB = 32, SEQ = 2048, NCTX = 256, D = 1024, P = NCTX + SEQ  , R = NB * P  ;
constexpr int NE = 16, FF = 2048, SLOTS = NB * 256 + NB * 32  ;
constexpr float EPS = 1e-6f;
constexpr float LAM_INIT = 0.47071302f;
constexpr int NWAVES = 8, NTHREADS = 512;
constexpr int LDS_BYTES = 147456;
constexpr int LDS_MISC = 147456 - 256;

constexpr size_t MiB = 1u << 20;
constexpr size_t WS_CTL = 0, CTL_ZERO_BYTES = 1 * MiB;
constexpr size_t WS_MOD = 1 * MiB;
constexpr size_t WS_AFF = 5 * MiB;
constexpr size_t WS_SEL = 10 * MiB;
constexpr size_t WS_GATE = 11 * MiB;
constexpr size_t WS_INV = 12 * MiB;
constexpr size_t WS_X = 32 * MiB;
constexpr size_t WS_H = 320 * MiB;
constexpr size_t WS_W = 464 * MiB;
constexpr size_t WS_BIG = 720 * MiB;
constexpr size_t WS_HID = WS_BIG;
constexpr size_t WS_Y = WS_BIG + 576 * MiB;
constexpr size_t WS_XS = WS_BIG + 864 * MiB;
constexpr size_t WS_YF = WS_BIG;
constexpr size_t WS_Z = WS_BIG + 288 * MiB;
constexpr size_t WS_Q = WS_BIG, WS_K = WS_BIG + 144 * MiB, WS_V = WS_BIG + 288 * MiB, WS_VT = WS_BIG + 432 * MiB, WS_O = WS_BIG + 576 * MiB;
constexpr size_t WS_ZIN = WS_BIG;
constexpr size_t WS_OF = WS_BIG + 720 * MiB;
constexpr size_t WS_O2 = WS_BIG + 1008 * MiB;
constexpr size_t WS_NEED = 2048 * MiB;
constexpr int CW_BAR = 4096;

__device__ __forceinline__ unsigned f2bf(float f) { unsigned u = __builtin_bit_cast(unsigned, f); return (u + 0x7fffu + ((u >> 16) & 1u)) >> 16; }
__device__ __forceinline__ float bf2f(unsigned h) { return __builtin_bit_cast(float, h << 16); }
__device__ __forceinline__ unsigned pk2(float lo, float hi) { return f2bf(lo) | (f2bf(hi) << 16); }
__device__ __forceinline__ float bflo(unsigned w) { return __builtin_bit_cast(float, w << 16); }
__device__ __forceinline__ float bfhi(unsigned w) { return __builtin_bit_cast(float, w & 0xffff0000u); }
__device__ __forceinline__ float wave_sum(float v) {
#pragma unroll
    for (int o = 1; o < 64; o <<= 1) v += __shfl_xor(v, o);
    return v;
}
__device__ __forceinline__ float wave_max(float v) {
#pragma unroll
    for (int o = 1; o < 64; o <<= 1) v = fmaxf(v, __shfl_xor(v, o));
    return v;
}
__device__ __forceinline__ float sigmoidf_(float x) { return 1.0f / (1.0f + expf(-x)); }
__device__ __forceinline__ float siluf_(float x) { return x / (1.0f + expf(-x)); }
__device__ __forceinline__ float gelu_tanh(float x) { return 0.5f * x * (1.0f + tanhf(0.7978845608028654f * (x + 0.044715f * x * x * x))); }
#define WAVE_LDS_SYNC() asm volatile("s_waitcnt lgkmcnt(0)" ::: "memory")

#define XB_TMO      128
#define XB_XCNT(j)  (256  + 64 * (j))
#define XB_XSUB(j)  (1280 + 64 * (j))
#define XB_XGEN(j)  (2304 + 64 * (j))
#define XB_TOP      3328
#define XB_TOPGEN   3392
#define XCD_BAR_WORDS 3456
#define XB_SPIN_CAP (1u << 27)
__device__ __forceinline__ unsigned xb_ld(unsigned* p)              { return __hip_atomic_load(p, __ATOMIC_RELAXED, __HIP_MEMORY_SCOPE_AGENT); }
__device__ __forceinline__ unsigned xb_add(unsigned* p, unsigned v) { return __hip_atomic_fetch_add(p, v, __ATOMIC_RELAXED, __HIP_MEMORY_SCOPE_AGENT); }
__device__ __forceinline__ unsigned xb_xcc_id() { return (unsigned)__builtin_amdgcn_s_getreg((3 << 11) | 20) & 0xFu; }
#define XB_SPIN(cond, bar) do { unsigned _sp = 0; while (cond) { __builtin_amdgcn_s_sleep(1); \
    if ((++_sp & 255u) == 0u) { if (xb_ld(&(bar)[XB_TMO])) break; if (_sp > XB_SPIN_CAP) { atomicAdd(&(bar)[XB_TMO], 1u); break; } } } } while (0)
struct XcdBarrier { unsigned* bar; unsigned x; volatile LAS unsigned* st; };
__device__ __forceinline__ XcdBarrier xcd_barrier_post(unsigned* bar, volatile LAS unsigned* st) {
    XcdBarrier b; b.bar = bar; b.x = xb_xcc_id(); b.st = st;
    if (threadIdx.x == 0) (void)xb_add(&bar[XB_XCNT(b.x)], 1u);
    return b;
}
__device__ __forceinline__ void xcd_barrier_complete(unsigned* bar, unsigned x, unsigned& nloc, unsigned& nx) {
    const unsigned G = gridDim.x * gridDim.y * gridDim.z;
    unsigned sum, cnt, mine, sp = 0u;
    for (;;) {
        sum = 0u; cnt = 0u; mine = 0u;
#pragma unroll
        for (unsigned j = 0; j < 16; ++j) { const unsigned c = xb_ld(&bar[XB_XCNT(j)]); sum += c; cnt += (c > 0u) ? 1u : 0u; mine = (j == x) ? c : mine; }
        if (sum == G) break;
        __builtin_amdgcn_s_sleep(1);
        if ((++sp & 255u) == 0u) { if (xb_ld(&bar[XB_TMO])) break; if (sp > XB_SPIN_CAP) { atomicAdd(&bar[XB_TMO], 1u); break; } }
    }
    nloc = mine > 0u ? mine : 1u; nx = cnt > 0u ? cnt : 1u;
}
__device__ __forceinline__ void xcd_barrier(const XcdBarrier& b) {
    asm volatile("s_waitcnt vmcnt(0)" ::: "memory");
    __syncthreads();
    if (threadIdx.x == 0) {
        unsigned* bar = b.bar;
        __builtin_amdgcn_s_waitcnt(0);
        unsigned nloc = b.st[0], nx = b.st[1];
        if (nloc == 0u) { xcd_barrier_complete(bar, b.x, nloc, nx); b.st[0] = nloc; b.st[1] = nx; }
        const unsigned old = xb_add(&bar[XB_XSUB(b.x)], 1u);
        const unsigned gen = old / nloc;
        if (old + 1u == (gen + 1u) * nloc) {
            __builtin_amdgcn_fence(__ATOMIC_RELEASE, "agent");
            asm volatile("s_waitcnt vmcnt(0)" ::: "memory");
            const unsigned og = xb_add(&bar[XB_TOP], 1u);
            const unsigned tg = og / nx;
            if (og + 1u == (tg + 1u) * nx) xb_add(&bar[XB_TOPGEN], 1u);
            else XB_SPIN(xb_ld(&bar[XB_TOPGEN]) == tg, bar);
            __builtin_amdgcn_fence(__ATOMIC_ACQUIRE, "agent");
            xb_add(&bar[XB_XGEN(b.x)], 1u);
            asm volatile("s_waitcnt vmcnt(0)" ::: "memory");
        } else {
            XB_SPIN(xb_ld(&bar[XB_XGEN(b.x)]) == gen, bar);
            __builtin_amdgcn_fence(__ATOMIC_ACQUIRE, "agent");
            asm volatile("s_waitcnt vmcnt(0)" ::: "memory");
        }
    }
    __syncthreads();
}

struct Args { const float* in[33]; float* out; unsigned char* ws; int ph_lo, ph_hi; };
struct Frame {
    unsigned char* lds;
    int tid, lane, wave, bid, nb;
    const float* const* in;
    float* out; unsigned char* ws;
    float* MOD; float* AFF; int* SEL; float* GATE; int* INV; float* X; bf16* H;
};
__device__ __forceinline__ int mod_row(int row) { const int b = row / P, pos = row - b * P; return pos < NCTX ? 32 : b; }

__device__ __forceinline__ void ph_prologue(const Frame& F) {
    {
        const f32x4* xs = (const f32x4*)F.in[0]; const f32x4* cs = (const f32x4*)F.in[2]; f32x4* X4 = (f32x4*)F.X;
        const size_t n4 = (size_t)R * 256;
        for (size_t i = (size_t)F.bid * NTHREADS + F.tid; i < n4; i += (size_t)F.nb * NTHREADS) {
            const int row = (int)(i >> 8), c4 = (int)(i & 255), b = row / P, pos = row - b * P;
            X4[i] = pos < NCTX ? cs[((size_t)(b * NCTX + pos) << 8) + c4] : xs[((size_t)(b * SEQ + pos - NCTX) << 8) + c4];
        }
    }
    if (F.bid * NWAVES < 384) {
        float* S = (float*)F.lds;
        for (int i = F.tid; i < 33 * 1024; i += NTHREADS) { const float v = i < 32 * 1024 ? F.in[1][i] : F.in[3][i - 32 * 1024]; S[i] = siluf_(v); }
        __syncthreads();
        for (int task = F.bid * NWAVES + F.wave; task < 384; task += F.nb * NWAVES) {
            const int l = task / 96, col = (task % 96) * 64 + F.lane;
            const float* W = F.in[4] + (size_t)l * 1024 * 6144 + col;
            float acc[33];
#pragma unroll
            for (int r = 0; r < 33; ++r) acc[r] = 0.f;
            for (int k = 0; k < 1024; ++k) {
                const float w = W[(size_t)k * 6144];
#pragma unroll
                for (int r = 0; r < 33; ++r) acc[r] += S[r * 1024 + k] * w;
            }
            const float bm = F.in[5][l * 6144 + col];
#pragma unroll
            for (int r = 0; r < 33; ++r) F.MOD[((size_t)l * 33 + r) * 6144 + col] = acc[r] + bm;
        }
        __syncthreads();
    }
}

template <int MODE, bool COMBINE>
__device__ __forceinline__ void ph_norm(const Frame& F, int layer, int prev_layer) {
    const float* nw = MODE == 0 ? F.in[6] + layer * D : (MODE == 1 ? F.in[7] + layer * D : F.in[32]);
    const bf16* Y = (const bf16*)(F.ws + WS_Y);
    for (int row = F.bid * NWAVES + F.wave; row < R; row += F.nb * NWAVES) {
        const int b = row / P, pos = row - b * P, mr = pos < NCTX ? 32 : b;
        f32x4* xr = (f32x4*)(F.X + (size_t)row * D) + F.lane;
        f32x4 v[4];
#pragma unroll
        for (int j = 0; j < 4; ++j) v[j] = xr[64 * j];
        if (COMBINE) {
            f32x4 a[4];
#pragma unroll
            for (int j = 0; j < 4; ++j) a[j] = (f32x4){0.f, 0.f, 0.f, 0.f};
            for (int e = 0; e < NE; ++e) {
                const int slot = F.INV[(size_t)row * NE + e];
                if (slot >= 0) {
                    const u32x2* yr = (const u32x2*)(Y + ((size_t)e * SLOTS + slot) * D) + F.lane;
#pragma unroll
                    for (int j = 0; j < 4; ++j) { const u32x2 w = yr[64 * j]; a[j].x += bflo(w.x); a[j].y += bfhi(w.x); a[j].z += bflo(w.y); a[j].w += bfhi(w.y); }
                }
            }
            const f32x4* g5 = (const f32x4*)(F.MOD + ((size_t)prev_layer * 33 + mr) * 6144 + 5 * D) + F.lane;
#pragma unroll
            for (int j = 0; j < 4; ++j) { v[j] = v[j] + g5[64 * j] * a[j]; xr[64 * j] = v[j]; }
        }
        float ss = 0.f;
#pragma unroll
        for (int j = 0; j < 4; ++j) ss += (v[j].x * v[j].x + v[j].y * v[j].y) + (v[j].z * v[j].z + v[j].w * v[j].w);
        const float rinv = rsqrtf(wave_sum(ss) * (1.0f / D) + EPS);
        const f32x4* nw4 = (const f32x4*)nw + F.lane;
        if (MODE == 2) {
            if (pos >= NCTX) {
                f32x4* o = (f32x4*)(F.out + ((size_t)b * SEQ + pos - NCTX) * D) + F.lane;
#pragma unroll
                for (int j = 0; j < 4; ++j) o[64 * j] = v[j] * rinv * nw4[64 * j];
            }
        } else {
            const float* mrow = F.MOD + ((size_t)layer * 33 + mr) * 6144;
            const f32x4* sh = (const f32x4*)(mrow + (MODE == 0 ? 0 : 3) * D) + F.lane;
            const f32x4* sc = (const f32x4*)(mrow + (MODE == 0 ? 1 : 4) * D) + F.lane;
            u32x2* ho = (u32x2*)(F.H + (size_t)row * D) + F.lane;
            f32x4 h[4];
#pragma unroll
            for (int j = 0; j < 4; ++j) { h[j] = v[j] * rinv * nw4[64 * j] * (sc[64 * j] + 1.0f) + sh[64 * j]; u32x2 w; w.x = pk2(h[j].x, h[j].y); w.y = pk2(h[j].z, h[j].w); ho[64 * j] = w; }
            if (MODE == 1) {
                const float* wr = F.in[28] + (size_t)layer * D * NE;
                float lg[NE];
#pragma unroll
                for (int e = 0; e < NE; ++e) lg[e] = 0.f;
#pragma unroll
                for (int j = 0; j < 4; ++j)
#pragma unroll
                    for (int q = 0; q < 4; ++q) {
                        const int c = F.lane * 4 + 256 * j + q; const float hv = h[j][q];
                        const f32x4* w4 = (const f32x4*)(wr + (size_t)c * NE);
#pragma unroll
                        for (int e4 = 0; e4 < 4; ++e4) { const f32x4 w = w4[e4]; lg[e4 * 4 + 0] += hv * w.x; lg[e4 * 4 + 1] += hv * w.y; lg[e4 * 4 + 2] += hv * w.z; lg[e4 * 4 + 3] += hv * w.w; }
                    }
                float mx = -3.0e38f;
#pragma unroll
                for (int e = 0; e < NE; ++e) { lg[e] = wave_sum(lg[e]); mx = fmaxf(mx, lg[e]); }
                float se = 0.f;
#pragma unroll
                for (int e = 0; e < NE; ++e) { lg[e] = expf(lg[e] - mx); se += lg[e]; }
                float mine = 0.f;
#pragma unroll
                for (int e = 0; e < NE; ++e) mine = (F.lane == e) ? lg[e] : mine;
                if (F.lane < NE) F.AFF[((size_t)b * NE + F.lane) * P + pos] = mine / se;
            }
        }
    }
}

__device__ __forceinline__ void ph_topk(const Frame& F) {
    float* vals = (float*)F.lds;
    for (int item = F.bid; item < NB * NE * 2; item += F.nb) {
        const int seg = item & 1, e = (item >> 1) % NE, b = item / (2 * NE);
        const int n = seg ? NCTX : SEQ, pos0 = seg ? 0 : NCTX, cap = n / 8, slot0 = seg ? NB * 256 + b * 32 : b * 256;
        const float* a = F.AFF + ((size_t)b * NE + e) * P + pos0;
        __syncthreads();
        for (int i = F.tid; i < n; i += NTHREADS) vals[i] = a[i];
        __syncthreads();
        for (int i = F.tid; i < n; i += NTHREADS) {
            const float ai = vals[i]; int rank = 0;
            for (int j = 0; j < n; ++j) { const float vj = vals[j]; rank += (vj > ai || (vj == ai && j < i)) ? 1 : 0; }
            const int row = b * P + pos0 + i;
            if (rank < cap) { const int slot = slot0 + rank; F.SEL[e * SLOTS + slot] = row; F.GATE[e * SLOTS + slot] = ai; F.INV[(size_t)row * NE + e] = slot; }
            else F.INV[(size_t)row * NE + e] = -1;
        }
    }
    __syncthreads();
}

template <bool DUAL, class Epi>
__device__ __forceinline__ void sgemm_phase(const Frame& F, const bf16* A, int lda, const int* rowidx, int Mg, int N, int K, int groups, size_t rows_per_group,
                                            const float* B, const float* B2, int ldb, size_t strideB, const Epi& epi) {
    float* As = (float*)F.lds;
    float* Bs = As + 16 * 132;
    float* Bs2 = Bs + 16 * 128;
    const int tid = F.tid, ty = tid >> 5, tx = tid & 31;
    const int tilesM = Mg / 128, tilesN = N / 128, tpg = tilesM * tilesN, total = tpg * groups;
    const int ar = tid >> 2, akq = (tid & 3) * 4, bk = tid >> 5, bn = (tid & 31) * 4;
    for (int tile = F.bid; tile < total; tile += F.nb) {
        const int g = tile / tpg, t = tile - g * tpg, tm = t / tilesN, tn = t - tm * tilesN;
        f32x4 acc[8], acc2[8];
#pragma unroll
        for (int i = 0; i < 8; ++i) { acc[i] = (f32x4){0.f, 0.f, 0.f, 0.f}; acc2[i] = (f32x4){0.f, 0.f, 0.f, 0.f}; }
        size_t arow = (size_t)g * rows_per_group + tm * 128 + ar; if (rowidx) arow = (size_t)rowidx[arow];
        const bf16* ap = A + arow * lda + akq;
        const float* bp = B + (size_t)g * strideB + (size_t)bk * ldb + tn * 128 + bn;
        const float* bp2 = DUAL ? B2 + (size_t)g * strideB + (size_t)bk * ldb + tn * 128 + bn : nullptr;
        for (int kt = 0; kt < K; kt += 16) {
            const u32x2 aw = *(const u32x2*)(ap + kt);
            const f32x4 bw = *(const f32x4*)(bp + (size_t)kt * ldb);
            f32x4 bw2 = (f32x4){0.f, 0.f, 0.f, 0.f}; if (DUAL) bw2 = *(const f32x4*)(bp2 + (size_t)kt * ldb);
            __syncthreads();
            As[(akq + 0) * 132 + ar] = bflo(aw.x); As[(akq + 1) * 132 + ar] = bfhi(aw.x); As[(akq + 2) * 132 + ar] = bflo(aw.y); As[(akq + 3) * 132 + ar] = bfhi(aw.y);
            *(f32x4*)&Bs[bk * 128 + bn] = bw; if (DUAL) *(f32x4*)&Bs2[bk * 128 + bn] = bw2;
            __syncthreads();
#pragma unroll
            for (int k = 0; k < 16; ++k) {
                const f32x4 a0 = *(const f32x4*)&As[k * 132 + ty * 8], a1 = *(const f32x4*)&As[k * 132 + ty * 8 + 4];
                const f32x4 b0 = *(const f32x4*)&Bs[k * 128 + tx * 4];
                acc[0] += a0.x * b0; acc[1] += a0.y * b0; acc[2] += a0.z * b0; acc[3] += a0.w * b0;
                acc[4] += a1.x * b0; acc[5] += a1.y * b0; acc[6] += a1.z * b0; acc[7] += a1.w * b0;
                if (DUAL) {
                    const f32x4 c0 = *(const f32x4*)&Bs2[k * 128 + tx * 4];
                    acc2[0] += a0.x * c0; acc2[1] += a0.y * c0; acc2[2] += a0.z * c0; acc2[3] += a0.w * c0;
                    acc2[4] += a1.x * c0; acc2[5] += a1.y * c0; acc2[6] += a1.z * c0; acc2[7] += a1.w * c0;
                }
            }
        }
#pragma unroll
        for (int i = 0; i < 8; ++i) epi(g, tm * 128 + ty * 8 + i, tn * 128 + tx * 4, acc[i], acc2[i]);
    }
    __syncthreads();
}

__device__ __forceinline__ void ph_s5(const Frame& F) {
    const float *a_re = F.in[8], *a_im = F.in[9], *log_dt = F.in[10], *b_re = F.in[11], *b_im = F.in[12], *c_re = F.in[13], *c_im = F.in[14], *dv = F.in[15];
    float* YF = (float*)(F.ws + WS_YF); bf16* Z = (bf16*)(F.ws + WS_Z);
    const int p = F.lane;
    for (int item = F.bid * NWAVES + F.wave; item < NB * 64; item += F.nb * NWAVES) {
        const int b = item >> 6, g = item & 63;
        for (int dir = 0; dir < 2; ++dir) {
            const int dg = dir * 64 + g;
            float abr, abi, fr, fi;
            {
                const double are = (double)a_re[dg * 64 + p], aim = (double)a_im[dg * 64 + p], dt = exp((double)log_dt[dg]);
                const double lr = are * dt, li = aim * dt, cl = cos(li), sl = sin(li), mag = exp(lr);
                const double Abr = mag * cl, Abi = mag * sl, sh = sin(0.5 * li), nr = expm1(lr) * cl - 2.0 * sh * sh;
                const double den = are * are + aim * aim;
                abr = (float)Abr; abi = (float)Abi; fr = (float)((nr * are + Abi * aim) / den); fi = (float)((Abi * are - nr * aim) / den);
            }
            float bbr[16], bbi[16], cr[16], ci[16];
#pragma unroll
            for (int h = 0; h < 16; ++h) { const float br = b_re[((size_t)dg * 64 + p) * 16 + h], bi = b_im[((size_t)dg * 64 + p) * 16 + h]; bbr[h] = fr * br - fi * bi; bbi[h] = fr * bi + fi * br; }
#pragma unroll
            for (int k = 0; k < 16; ++k) { cr[k] = c_re[((size_t)dg * 16 + k) * 64 + p]; ci[k] = c_im[((size_t)dg * 16 + k) * 64 + p]; }
            float hr = 0.f, hi = 0.f;
            const float dk = dv[g * 16 + (p & 15)];
#pragma unroll 1
            for (int s = 0; s < P; ++s) {
                const int pos = dir == 0 ? s : (s < NCTX ? NCTX - 1 - s : P - 1 - (s - NCTX));
                const size_t row = (size_t)b * P + pos;
                const u32x4* up = (const u32x4*)(F.H + row * D + g * 16);
                const u32x4 w0 = up[0], w1 = up[1];
                float u[16];
                u[0] = bflo(w0.x); u[1] = bfhi(w0.x); u[2] = bflo(w0.y); u[3] = bfhi(w0.y); u[4] = bflo(w0.z); u[5] = bfhi(w0.z); u[6] = bflo(w0.w); u[7] = bfhi(w0.w);
                u[8] = bflo(w1.x); u[9] = bfhi(w1.x); u[10] = bflo(w1.y); u[11] = bfhi(w1.y); u[12] = bflo(w1.z); u[13] = bfhi(w1.z); u[14] = bflo(w1.w); u[15] = bfhi(w1.w);
                float bur = 0.f, bui = 0.f;
#pragma unroll
                for (int h = 0; h < 16; ++h) { bur += bbr[h] * u[h]; bui += bbi[h] * u[h]; }
                const float nhr = abr * hr - abi * hi + bur, nhi = abr * hi + abi * hr + bui; hr = nhr; hi = nhi;
                float yk = 0.f;
#pragma unroll
                for (int k = 0; k < 16; ++k) { const float v = wave_sum(cr[k] * hr - ci[k] * hi); yk = (p == k) ? v : yk; }
                if (p < 16) {
                    const size_t o = row * D + g * 16 + p;
                    if (dir == 0) YF[o] = yk;
                    else { const float ul = bf2f(F.H[o]); Z[o] = (bf16)f2bf(gelu_tanh(YF[o] + yk + dk * ul)); }
                }
            }
        }
    }
}

__device__ __forceinline__ void ph_rope(const Frame& F) {
    bf16* Q = (bf16*)(F.ws + WS_Q); bf16* K = (bf16*)(F.ws + WS_K);
    const size_t n = (size_t)NB * SEQ * 256;
    for (size_t idx = (size_t)F.bid * NTHREADS + F.tid; idx < n; idx += (size_t)F.nb * NTHREADS) {
        const int lr = (int)(idx >> 8), hh = (int)((idx >> 4) & 15), i = (int)(idx & 15);
        const int b = lr / SEQ, t = lr - b * SEQ, rr = t >> 6, cc = t & 63;
        const float inv = powf(10000.0f, -(float)i * (1.0f / 16.0f));
        float sr, cr, sc, ccs; sincosf((float)rr * inv, &sr, &cr); sincosf((float)cc * inv, &sc, &ccs);
        const size_t base = ((size_t)b * P + NCTX + t) * D + hh * 64 + i;
#pragma unroll
        for (int w = 0; w < 2; ++w) {
            bf16* T = w ? K : Q;
            const float x1 = bf2f(T[base]), x2 = bf2f(T[base + 16]), y1 = bf2f(T[base + 32]), y2 = bf2f(T[base + 48]);
            T[base] = (bf16)f2bf(x1 * cr - x2 * sr); T[base + 16] = (bf16)f2bf(x2 * cr + x1 * sr);
            T[base + 32] = (bf16)f2bf(y1 * ccs - y2 * sc); T[base + 48] = (bf16)f2bf(y2 * ccs + y1 * sc);
        }
    }
}

__device__ __forceinline__ void ph_na_attn(const Frame& F) {
    const bf16* Q = (const bf16*)(F.ws + WS_Q); const bf16* K = (const bf16*)(F.ws + WS_K); const bf16* V = (const bf16*)(F.ws + WS_V); bf16* O = (bf16*)(F.ws + WS_O);
    const float* rpb = F.in[19];
    float* qs = (float*)F.lds + F.wave * 256; float* ps = qs + 64;
    const int lane = F.lane;
    for (int item = F.bid * NWAVES + F.wave; item < R * 16; item += F.nb * NWAVES) {
        const int row = item >> 4, h = item & 15, b = row / P, pos = row - b * P;
        const bool lat = pos >= NCTX;
        const int t = pos - NCTX, r = t >> 6, c = t & 63;
        const int r0 = min(max(r - 4, 0), 24), c0 = min(max(c - 8, 0), 48);
        WAVE_LDS_SYNC();
        qs[lane] = 0.125f * bf2f(Q[(size_t)row * D + h * 64 + lane]);
        WAVE_LDS_SYNC();
        float m = -INFINITY, l = 0.f, acc = 0.f;
        const int ntiles = lat ? 6 : 4;
        for (int kt = 0; kt < ntiles; ++kt) {
            const int ct = lat ? kt - 2 : kt;
            int kpos; float bias = 0.f;
            if (ct < 0) { const int krow = r0 + kt * 4 + (lane >> 4), kcol = c0 + (lane & 15); kpos = NCTX + krow * 64 + kcol; bias = rpb[(h * 15 + (krow - r + 7)) * 31 + (kcol - c + 15)]; }
            else kpos = ct * 64 + lane;
            const u32x4* kp = (const u32x4*)(K + ((size_t)b * P + kpos) * D + h * 64);
            float s = 0.f;
#pragma unroll
            for (int q8 = 0; q8 < 8; ++q8) {
                const u32x4 w = kp[q8]; const f32x4 qa = *(const f32x4*)&qs[q8 * 8], qb = *(const f32x4*)&qs[q8 * 8 + 4];
                s += bflo(w.x) * qa.x + bfhi(w.x) * qa.y + bflo(w.y) * qa.z + bfhi(w.y) * qa.w + bflo(w.z) * qb.x + bfhi(w.z) * qb.y + bflo(w.w) * qb.z + bfhi(w.w) * qb.w;
            }
            s += bias;
            const float nm = fmaxf(m, wave_max(s)), al = expf(m - nm), pp = expf(s - nm);
            l = l * al + pp; m = nm; acc *= al;
            WAVE_LDS_SYNC();
            ps[lane] = pp;
            WAVE_LDS_SYNC();
            for (int j = 0; j < 64; ++j) {
                int vpos; if (ct < 0) vpos = NCTX + (r0 + kt * 4 + (j >> 4)) * 64 + c0 + (j & 15); else vpos = ct * 64 + j;
                acc += ps[j] * bf2f(V[((size_t)b * P + vpos) * D + h * 64 + lane]);
            }
        }
        const float L = wave_sum(l);
        O[(size_t)row * D + h * 64 + lane] = (bf16)f2bf(acc / L);
    }
}

__device__ __forceinline__ void ph_da_attn(const Frame& F) {
    const bf16* Q = (const bf16*)(F.ws + WS_Q); const bf16* K = (const bf16*)(F.ws + WS_K); const bf16* V = (const bf16*)(F.ws + WS_V); bf16* O = (bf16*)(F.ws + WS_O);
    float* qs = (float*)F.lds + F.wave * 256; float* ps = qs + 128;
    const int lane = F.lane;
    const float* lam = F.in[22];
    const float lam_full = expf(wave_sum(lam[lane] * lam[64 + lane])) - expf(wave_sum(lam[128 + lane] * lam[192 + lane])) + LAM_INIT;
    const float sub0 = F.in[23][lane] * (1.0f - LAM_INIT), sub1 = F.in[23][64 + lane] * (1.0f - LAM_INIT);
    for (int item = F.bid * NWAVES + F.wave; item < R * 8; item += F.nb * NWAVES) {
        const int row = item >> 3, h = item & 7, b = row / P, pos = row - b * P;
        const int nkeys = pos >= NCTX ? P : NCTX;
        WAVE_LDS_SYNC();
        qs[lane] = 0.125f * bf2f(Q[(size_t)row * D + h * 128 + lane]); qs[64 + lane] = 0.125f * bf2f(Q[(size_t)row * D + h * 128 + 64 + lane]);
        WAVE_LDS_SYNC();
        float m0 = -INFINITY, m1 = -INFINITY, l0 = 0.f, l1 = 0.f, a0a = 0.f, a0b = 0.f, a1a = 0.f, a1b = 0.f;
        for (int kt = 0; kt < nkeys; kt += 64) {
            const u32x4* kp = (const u32x4*)(K + ((size_t)b * P + kt + lane) * D + h * 128);
            float s0 = 0.f, s1 = 0.f;
#pragma unroll
            for (int q8 = 0; q8 < 8; ++q8) {
                const u32x4 w = kp[q8]; const f32x4 qa = *(const f32x4*)&qs[q8 * 8], qb = *(const f32x4*)&qs[q8 * 8 + 4];
                s0 += bflo(w.x) * qa.x + bfhi(w.x) * qa.y + bflo(w.y) * qa.z + bfhi(w.y) * qa.w + bflo(w.z) * qb.x + bfhi(w.z) * qb.y + bflo(w.w) * qb.z + bfhi(w.w) * qb.w;
            }
#pragma unroll
            for (int q8 = 0; q8 < 8; ++q8) {
                const u32x4 w = kp[8 + q8]; const f32x4 qa = *(const f32x4*)&qs[64 + q8 * 8], qb = *(const f32x4*)&qs[64 + q8 * 8 + 4];
                s1 += bflo(w.x) * qa.x + bfhi(w.x) * qa.y + bflo(w.y) * qa.z + bfhi(w.y) * qa.w + bflo(w.z) * qb.x + bfhi(w.z) * qb.y + bflo(w.w) * qb.z + bfhi(w.w) * qb.w;
            }
            const float nm0 = fmaxf(m0, wave_max(s0)), nm1 = fmaxf(m1, wave_max(s1));
            const float al0 = expf(m0 - nm0), al1 = expf(m1 - nm1), p0 = expf(s0 - nm0), p1 = expf(s1 - nm1);
            l0 = l0 * al0 + p0; l1 = l1 * al1 + p1; m0 = nm0; m1 = nm1;
            a0a *= al0; a0b *= al0; a1a *= al1; a1b *= al1;
            WAVE_LDS_SYNC();
            ps[lane] = p0; ps[64 + lane] = p1;
            WAVE_LDS_SYNC();
            const bf16* vp = V + ((size_t)b * P + kt) * D + h * 128 + lane;
            for (int j = 0; j < 64; ++j) {
                const float va = bf2f(vp[(size_t)j * D]), vb = bf2f(vp[(size_t)j * D + 64]), q0 = ps[j], q1 = ps[64 + j];
                a0a += q0 * va; a0b += q0 * vb; a1a += q1 * va; a1b += q1 * vb;
            }
        }
        const float L0 = wave_sum(l0), L1 = wave_sum(l1);
        const float oa = a0a / L0 - lam_full * (a1a / L1), ob = a0b / L0 - lam_full * (a1b / L1);
        const float rinv = rsqrtf(wave_sum(oa * oa + ob * ob) * (1.0f / 128.0f) + EPS);
        O[(size_t)row * D + h * 128 + lane] = (bf16)f2bf(oa * rinv * sub0);
        O[(size_t)row * D + h * 128 + 64 + lane] = (bf16)f2bf(ob * rinv * sub1);
    }
}

__device__ __forceinline__ void ph_hgrn_scan(const Frame& F) {
    const bf16* ZIN = (const bf16*)(F.ws + WS_ZIN); float* OF = (float*)(F.ws + WS_OF);
    const float* lbin = F.in[27];
    if (F.wave < 4) {
        float* qs = (float*)F.lds + F.wave * 4096; float* fs = qs + 2048;
        const int lane = F.lane, dh = lane >> 5;
        for (int item = F.bid; item < NB * 8; item += F.nb) {
            const int b = item >> 3, h = item & 7, e = F.wave * 32 + (lane & 31);
            float lbv[2];
#pragma unroll
            for (int q = 0; q < 2; ++q) {
                const int c = h * 128 + q * 64 + lane;
                const float x0 = lbin[c], x1 = lbin[D + c], x2 = lbin[2 * D + c], x3 = lbin[3 * D + c];
                const float mx = fmaxf(fmaxf(x0, x1), fmaxf(x2, x3));
                const float e0 = expf(x0 - mx), e1 = expf(x1 - mx), e2 = expf(x2 - mx), e3 = expf(x3 - mx);
                lbv[q] = (e1 + e2 + e3) / (e0 + e1 + e2 + e3);
            }
            for (int dir = 0; dir < 2; ++dir) {
                float S[64];
#pragma unroll
                for (int d = 0; d < 64; ++d) S[d] = 0.f;
#pragma unroll 1
                for (int s0 = 0; s0 < P; s0 += 16) {
                    WAVE_LDS_SYNC();
#pragma unroll 1
                    for (int tt = 0; tt < 16; ++tt) {
                        const int s = s0 + tt, pos = dir == 0 ? s : (s < NCTX ? NCTX - 1 - s : P - 1 - (s - NCTX));
                        const bf16* zr = ZIN + ((size_t)b * P + pos) * 5120 + h * 128;
#pragma unroll
                        for (int q = 0; q < 2; ++q) {
                            qs[tt * 128 + q * 64 + lane] = bf2f(zr[q * 64 + lane]);
                            fs[tt * 128 + q * 64 + lane] = lbv[q] + (1.0f - lbv[q]) * sigmoidf_(bf2f(zr[(1 + dir) * D + q * 64 + lane]));
                        }
                    }
                    WAVE_LDS_SYNC();
#pragma unroll 1
                    for (int tt = 0; tt < 16; ++tt) {
                        const int s = s0 + tt, pos = dir == 0 ? s : (s < NCTX ? NCTX - 1 - s : P - 1 - (s - NCTX));
                        const size_t row = (size_t)b * P + pos;
                        const float v = siluf_(bf2f(ZIN[row * 5120 + 3 * D + h * 128 + e]));
                        float o = 0.f;
#pragma unroll
                        for (int d4 = 0; d4 < 16; ++d4) {
                            const f32x4 f = *(const f32x4*)&fs[tt * 128 + dh * 64 + d4 * 4], q = *(const f32x4*)&qs[tt * 128 + dh * 64 + d4 * 4];
                            S[d4 * 4 + 0] = f.x * S[d4 * 4 + 0] + (1.0f - f.x) * v; o += q.x * S[d4 * 4 + 0];
                            S[d4 * 4 + 1] = f.y * S[d4 * 4 + 1] + (1.0f - f.y) * v; o += q.y * S[d4 * 4 + 1];
                            S[d4 * 4 + 2] = f.z * S[d4 * 4 + 2] + (1.0f - f.z) * v; o += q.z * S[d4 * 4 + 2];
                            S[d4 * 4 + 3] = f.w * S[d4 * 4 + 3] + (1.0f - f.w) * v; o += q.w * S[d4 * 4 + 3];
                        }
                        o += __shfl_xor(o, 32);
                        if (dh == 0) { float* op = OF + row * D + h * 128 + e; if (dir == 0) *op = o; else *op += o; }
                    }
                }
            }
        }
    }
}
__device__ __forceinline__ void ph_hgrn_post(const Frame& F) {
    const bf16* ZIN = (const bf16*)(F.ws + WS_ZIN); const float* OF = (const float*)(F.ws + WS_OF); bf16* O2 = (bf16*)(F.ws + WS_O2);
    const float g0 = F.in[26][F.lane], g1 = F.in[26][64 + F.lane];
    for (int item = F.bid * NWAVES + F.wave; item < R * 8; item += F.nb * NWAVES) {
        const int row = item >> 3, h = item & 7;
        const size_t o = (size_t)row * D + h * 128 + F.lane;
        const float oa = OF[o], ob = OF[o + 64];
        const float rinv = rsqrtf(wave_sum(oa * oa + ob * ob) * (1.0f / 128.0f) + EPS);
        const float ga = bf2f(ZIN[(size_t)row * 5120 + 4 * D + h * 128 + F.lane]), gb = bf2f(ZIN[(size_t)row * 5120 + 4 * D + h * 128 + 64 + F.lane]);
        O2[o] = (bf16)f2bf(oa * rinv * g0 * siluf_(ga)); O2[o + 64] = (bf16)f2bf(ob * rinv * g1 * siluf_(gb));
    }
}

struct EpiResid {
    float* X; const float* MODL;
    __device__ __forceinline__ void operator()(int, int row, int col, f32x4 v, f32x4) const {
        const f32x4 g = *(const f32x4*)(MODL + (size_t)mod_row(row) * 6144 + 2 * D + col);
        f32x4* x = (f32x4*)(X + (size_t)row * D + col); *x = *x + g * v;
    }
};
struct EpiGlu {
    float* X; const float* MODL;
    __device__ __forceinline__ void operator()(int, int row, int col, f32x4 a, f32x4 z) const {
        f32x4 v; v.x = a.x * sigmoidf_(z.x); v.y = a.y * sigmoidf_(z.y); v.z = a.z * sigmoidf_(z.z); v.w = a.w * sigmoidf_(z.w);
        const f32x4 g = *(const f32x4*)(MODL + (size_t)mod_row(row) * 6144 + 2 * D + col);
        f32x4* x = (f32x4*)(X + (size_t)row * D + col); *x = *x + g * v;
    }
};
struct EpiQkv {
    bf16 *Q, *K, *V, *VT;
    __device__ __forceinline__ void operator()(int, int row, int col, f32x4 v, f32x4) const {
        u32x2 w; w.x = pk2(v.x, v.y); w.y = pk2(v.z, v.w);
        if (col < D) *(u32x2*)(Q + (size_t)row * D + col) = w;
        else if (col < 2 * D) *(u32x2*)(K + (size_t)row * D + col - D) = w;
        else { const int c = col - 2 * D; *(u32x2*)(V + (size_t)row * D + c) = w;
            const int b = row / P, pos = row - b * P; bf16* t = VT + ((size_t)b * D + c) * P + pos;
            t[0] = (bf16)f2bf(v.x); t[P] = (bf16)f2bf(v.y); t[2 * P] = (bf16)f2bf(v.z); t[3 * P] = (bf16)f2bf(v.w); }
    }
};
struct EpiBf {
    bf16* O; int ld;
    __device__ __forceinline__ void operator()(int, int row, int col, f32x4 v, f32x4) const { u32x2 w; w.x = pk2(v.x, v.y); w.y = pk2(v.z, v.w); *(u32x2*)(O + (size_t)row * ld + col) = w; }
};
struct EpiSwiglu {
    bf16* HID;
    __device__ __forceinline__ void operator()(int g, int row, int col, f32x4 a, f32x4 u) const {
        u32x2 w; w.x = pk2(siluf_(a.x) * u.x, siluf_(a.y) * u.y); w.y = pk2(siluf_(a.z) * u.z, siluf_(a.w) * u.w);
        *(u32x2*)(HID + ((size_t)g * SLOTS + row) * FF + col) = w;
    }
};
struct EpiDown {
    bf16* Y; const float* GATE;
    __device__ __forceinline__ void operator()(int g, int row, int col, f32x4 v, f32x4) const {
        const float s = GATE[g * SLOTS + row]; u32x2 w; w.x = pk2(v.x * s, v.y * s); w.y = pk2(v.z * s, v.w * s);
        *(u32x2*)(Y + ((size_t)g * SLOTS + row) * D + col) = w;
    }
};

constexpr int NPH = 35;
__global__ void __launch_bounds__(NTHREADS, 2) fwd(Args args) {
    extern __shared__ __attribute__((aligned(16))) unsigned char lds[];
    Frame F;
    F.lds = lds; F.tid = threadIdx.x; F.lane = F.tid & 63; F.wave = __builtin_amdgcn_readfirstlane(F.tid >> 6); F.bid = blockIdx.x; F.nb = gridDim.x;
    F.in = args.in; F.out = args.out; F.ws = args.ws;
    F.MOD = (float*)(args.ws + WS_MOD); F.AFF = (float*)(args.ws + WS_AFF); F.SEL = (int*)(args.ws + WS_SEL); F.GATE = (float*)(args.ws + WS_GATE); F.INV = (int*)(args.ws + WS_INV);
    F.X = (float*)(args.ws + WS_X); F.H = (bf16*)(args.ws + WS_H);
    const int lo = args.ph_lo, hi = args.ph_hi;
#if MK_SINGLE
    volatile LAS unsigned* misc = (volatile LAS unsigned*)((LAS unsigned char*)lds + LDS_MISC);
    if (F.tid < 64) misc[F.tid] = 0u;
    __syncthreads();
    XcdBarrier bar = xcd_barrier_post((unsigned*)(args.ws + WS_CTL) + CW_BAR, misc);
#define SEAM(k) do { if ((k) + 1 < hi) xcd_barrier(bar); } while (0)
#else
#define SEAM(k) do { } while (0)
#endif
#define IN(k) (lo <= (k) && (k) < hi)
    bf16* HID = (bf16*)(F.ws + WS_HID); bf16* Y = (bf16*)(F.ws + WS_Y);
    bf16 *Qb = (bf16*)(F.ws + WS_Q), *Kb = (bf16*)(F.ws + WS_K), *Vb = (bf16*)(F.ws + WS_V), *VTb = (bf16*)(F.ws + WS_VT), *Ob = (bf16*)(F.ws + WS_O);

#define MOE_PHASES(k0, L) \
    if (IN((k0))) { ph_norm<1, false>(F, (L), 0); SEAM((k0)); } \
    if (IN((k0) + 1)) { ph_topk(F); SEAM((k0) + 1); } \
    if (IN((k0) + 2)) { sgemm_phase<true>(F, F.H, D, F.SEL, SLOTS, FF, D, NE, SLOTS, F.in[29] + (size_t)(L) * NE * D * FF, F.in[30] + (size_t)(L) * NE * D * FF, FF, (size_t)D * FF, EpiSwiglu{HID}); SEAM((k0) + 2); } \
    if (IN((k0) + 3)) { sgemm_phase<false>(F, HID, FF, nullptr, SLOTS, D, FF, NE, SLOTS, F.in[31] + (size_t)(L) * NE * FF * D, nullptr, D, (size_t)FF * D, EpiDown{Y, F.GATE}); SEAM((k0) + 3); }

    if (IN(0)) { ph_prologue(F); SEAM(0); }
    if (IN(1)) { ph_norm<0, false>(F, 0, 0); SEAM(1); }
    if (IN(2)) { ph_s5(F); SEAM(2); }
    if (IN(3)) { sgemm_phase<true>(F, (const bf16*)(F.ws + WS_Z), D, nullptr, R, D, D, 1, 0, F.in[16], F.in[16] + D, 2 * D, 0, EpiGlu{F.X, F.MOD + (size_t)0 * 33 * 6144}); SEAM(3); }
    MOE_PHASES(4, 0)
    if (IN(8)) { ph_norm<0, true>(F, 1, 0); SEAM(8); }
    if (IN(9)) { sgemm_phase<false>(F, F.H, D, nullptr, R, 3 * D, D, 1, 0, F.in[17], nullptr, 3 * D, 0, EpiQkv{Qb, Kb, Vb, VTb}); SEAM(9); }
    if (IN(10)) { ph_na_attn(F); SEAM(10); }
    if (IN(11)) { sgemm_phase<false>(F, Ob, D, nullptr, R, D, D, 1, 0, F.in[18], nullptr, D, 0, EpiResid{F.X, F.MOD + (size_t)1 * 33 * 6144}); SEAM(11); }
    MOE_PHASES(12, 1)
    if (IN(16)) { ph_norm<0, true>(F, 2, 1); SEAM(16); }
    if (IN(17)) { sgemm_phase<false>(F, F.H, D, nullptr, R, 3 * D, D, 1, 0, F.in[20], nullptr, 3 * D, 0, EpiQkv{Qb, Kb, Vb, VTb}); SEAM(17); }
    if (IN(18)) { ph_rope(F); SEAM(18); }
    if (IN(19)) { ph_da_attn(F); SEAM(19); }
    if (IN(20)) { sgemm_phase<false>(F, Ob, D, nullptr, R, D, D, 1, 0, F.in[21], nullptr, D, 0, EpiResid{F.X, F.MOD + (size_t)2 * 33 * 6144}); SEAM(20); }
    MOE_PHASES(21, 2)
    if (IN(25)) { ph_norm<0, true>(F, 3, 2); SEAM(25); }
    if (IN(26)) { sgemm_phase<false>(F, F.H, D, nullptr, R, 5 * D, D, 1, 0, F.in[24], nullptr, 5 * D, 0, EpiBf{(bf16*)(F.ws + WS_ZIN), 5 * D}); SEAM(26); }
    if (IN(27)) { ph_hgrn_scan(F); SEAM(27); }
    if (IN(28)) { ph_hgrn_post(F); SEAM(28); }
    if (IN(29)) { sgemm_phase<false>(F, (const bf16*)(F.ws + WS_O2), D, nullptr, R, D, D, 1, 0, F.in[25], nullptr, D, 0, EpiResid{F.X, F.MOD + (size_t)3 * 33 * 6144}); SEAM(29); }
    MOE_PHASES(30, 3)
    if (IN(34)) { ph_norm<2, true>(F, 0, 3); }
}

extern "C" void kernel_launch(void* const* d_in, const int* in_sizes, int n_in, void* d_out, int out_size, void* d_ws, size_t ws_size, hipStream_t stream) {
    static int grid = 0;
    if (grid == 0) {
        if (n_in != 33 || ws_size < WS_NEED) { fprintf(stderr, "kernel_launch: n_in %d ws %zu (need %zu)\n", n_in, ws_size, (size_t)WS_NEED); grid = -1; return; }
        int dev = 0, cus = 0;
        if (hipGetDevice(&dev) != hipSuccess || hipDeviceGetAttribute(&cus, hipDeviceAttributeMultiprocessorCount, dev) != hipSuccess) { grid = -1; return; }
        if (hipFuncSetAttribute((const void*)fwd, hipFuncAttributeMaxDynamicSharedMemorySize, LDS_BYTES) != hipSuccess) { fprintf(stderr, "kernel_launch: hipFuncSetAttribute failed\n"); grid = -1; return; }
        int per_cu = 0;
        if (hipOccupancyMaxActiveBlocksPerMultiprocessor(&per_cu, (const void*)fwd, NTHREADS, LDS_BYTES) != hipSuccess || per_cu < 1) fprintf(stderr, "kernel_launch: occupancy query says %d\n", per_cu);
        (void)hipGetLastError();
        grid = cus;
    }
    if (grid < 0) return;
    (void)hipMemsetAsync((char*)d_ws + WS_CTL, 0, CTL_ZERO_BYTES, stream);
    Args a{};
    for (int i = 0; i < 33; ++i) a.in[i] = (const float*)d_in[i];
    a.out = (float*)d_out; a.ws = (unsigned char*)d_ws;
#if MK_SINGLE
    a.ph_lo = 0; a.ph_hi = NPH;
    hipLaunchKernelGGL(fwd, dim3(grid), dim3(NTHREADS), LDS_BYTES, stream, a);
#else
    for (int k = 0; k < NPH; ++k) { a.ph_lo = k; a.ph_hi = k + 1; hipLaunchKernelGGL(fwd, dim3(grid), dim3(NTHREADS), LDS_BYTES, stream, a); }
#endif
}
```

```cpp
#include <hip/hip_runtime.h>
#include <cstdio>
#include <cstdint>

#ifndef MK_SINGLE
#define MK_SINGLE 1
#endif

typedef unsigned short bf16;
typedef float f32x4 __attribute__((ext_vector_type(4)));
typedef float f32x2 __attribute__((ext_vector_type(2)));
typedef unsigned u32x2 __attribute__((ext_vector_type(2)));
typedef unsigned u32x4 __attribute__((ext_vector_type(4)));
#define LAS __attribute__((address_space(3)))

constexpr int NB = 32, SEQ = 2048, NCTX = 256, D = 1024, P = NCTX + SEQ  , R = NB * P  ;
constexpr int NE = 16, FF = 2048, SLOTS = NB * 256 + NB * 32  ;
constexpr float EPS = 1e-6f;
constexpr float LOG2E_ = 1.4426950408889634f;
constexpr float LAM_INIT = 0.47071302f;
constexpr int NWAVES = 8, NTHREADS = 512;
constexpr int LDS_BYTES = 147456;
constexpr int LDS_MISC = 147456 - 256;

constexpr size_t MiB = 1u << 20;
constexpr size_t WS_CTL = 0, CTL_ZERO_BYTES = 1 * MiB;
constexpr size_t WS_MOD = 1 * MiB;
constexpr size_t WS_AFF = 5 * MiB;
constexpr size_t WS_SEL = 10 * MiB;
constexpr size_t WS_GATE = 11 * MiB;
constexpr size_t WS_INV = 12 * MiB;
constexpr size_t WS_X = 32 * MiB;
constexpr size_t WS_H = 320 * MiB;
constexpr size_t WS_W = 464 * MiB;
constexpr size_t WS_BIG = 720 * MiB;
constexpr size_t WS_HID = WS_BIG;
constexpr size_t WS_Y = WS_BIG + 576 * MiB;
constexpr size_t WS_XS = WS_BIG + 864 * MiB;
constexpr size_t WS_AG = WS_BIG;
constexpr size_t WS_SS = WS_BIG + 216 * MiB;
constexpr size_t WS_Z = WS_BIG + 360 * MiB;
constexpr size_t WS_S5W1 = WS_BIG + 504 * MiB;
constexpr size_t WS_S5W2 = WS_BIG + 520 * MiB;
constexpr size_t WS_S5A = WS_BIG + 568 * MiB;
constexpr size_t WS_Q = WS_BIG, WS_K = WS_BIG + 144 * MiB, WS_V = WS_BIG + 288 * MiB, WS_VT = WS_BIG + 432 * MiB, WS_O = WS_BIG + 576 * MiB;
constexpr size_t WS_ZIN = WS_BIG;
constexpr size_t WS_VTG = WS_BIG + 576 * MiB;
constexpr size_t WS_OFF = WS_BIG + 720 * MiB;
constexpr size_t WS_OFB = WS_BIG + 1008 * MiB;
constexpr size_t WS_O2 = WS_H;
constexpr size_t WS_LB = 17 * MiB;
constexpr size_t WS_ROPE = 18 * MiB;
constexpr size_t WS_NEED = 2048 * MiB;
constexpr size_t WO_GLU = WS_W, WO_NAQKV = WS_W + 4 * MiB, WO_NAO = WS_W + 10 * MiB, WO_DAQKV = WS_W + 12 * MiB, WO_DAO = WS_W + 18 * MiB, WO_HGIN = WS_W + 20 * MiB, WO_HGO = WS_W + 30 * MiB;
constexpr size_t WO_GU = WS_W + 32 * MiB  , WO_DN = WS_W + 160 * MiB  ;
constexpr int CW_BAR = 4096;

__device__ __forceinline__ unsigned f2bf(float f) { unsigned u = __builtin_bit_cast(unsigned, f); return (u + 0x7fffu + ((u >> 16) & 1u)) >> 16; }
__device__ __forceinline__ float bf2f(unsigned h) { return __builtin_bit_cast(float, h << 16); }
__device__ __forceinline__ unsigned pk2(float lo, float hi) { return f2bf(lo) | (f2bf(hi) << 16); }
typedef __bf16 bf16x2_t __attribute__((ext_vector_type(2)));
__device__ __forceinline__ unsigned pkbf(float lo, float hi) { const f32x2 v = {lo, hi}; return __builtin_bit_cast(unsigned, __builtin_convertvector(v, bf16x2_t)); }
__device__ __forceinline__ float bflo(unsigned w) { return __builtin_bit_cast(float, w << 16); }
__device__ __forceinline__ float bfhi(unsigned w) { return __builtin_bit_cast(float, w & 0xffff0000u); }
__device__ __forceinline__ float wave_sum(float v) {
#pragma unroll
    for (int o = 1; o < 64; o <<= 1) v += __shfl_xor(v, o);
    return v;
}
__device__ __forceinline__ float wave_max(float v) {
#pragma unroll
    for (int o = 1; o < 64; o <<= 1) v = fmaxf(v, __shfl_xor(v, o));
    return v;
}
__device__ __forceinline__ float sigmoidf_(float x) { return 1.0f / (1.0f + expf(-x)); }
__device__ __forceinline__ float siluf_(float x) { return x / (1.0f + expf(-x)); }
__device__ __forceinline__ float gelu_tanh(float x) { return 0.5f * x * (1.0f + tanhf(0.7978845608028654f * (x + 0.044715f * x * x * x))); }
__device__ __forceinline__ float dpp_xor1(float v) { return __builtin_bit_cast(float, __builtin_amdgcn_update_dpp(0, __builtin_bit_cast(int, v), 0xB1, 0xF, 0xF, true)); }
__device__ __forceinline__ float dpp_xor2(float v) { return __builtin_bit_cast(float, __builtin_amdgcn_update_dpp(0, __builtin_bit_cast(int, v), 0x4E, 0xF, 0xF, true)); }
__device__ __forceinline__ float reduce16(float (&v)[16], int lane) {
    const bool b0 = lane & 1, b1 = lane & 2, b2 = lane & 4, b3 = lane & 8;
    float a[8];
#pragma unroll
    for (int k = 0; k < 8; ++k) { const float snd = b0 ? v[k] : v[8 + k], kep = b0 ? v[8 + k] : v[k]; a[k] = kep + dpp_xor1(snd); }
    float c[4];
#pragma unroll
    for (int k = 0; k < 4; ++k) { const float snd = b1 ? a[k] : a[4 + k], kep = b1 ? a[4 + k] : a[k]; c[k] = kep + dpp_xor2(snd); }
    float d[2];
#pragma unroll
    for (int k = 0; k < 2; ++k) { const float snd = b2 ? c[k] : c[2 + k], kep = b2 ? c[2 + k] : c[k]; d[k] = kep + __shfl_xor(snd, 4); }
    float r = (b3 ? d[1] : d[0]) + __shfl_xor(b3 ? d[0] : d[1], 8);
    r += __shfl_xor(r, 16); r += __shfl_xor(r, 32);
    return r;
}
#define WAVE_LDS_SYNC() asm volatile("s_waitcnt lgkmcnt(0)" ::: "memory")

#define XB_TMO      128
#define XB_XCNT(j)  (256  + 64 * (j))
#define XB_XSUB(j)  (1280 + 64 * (j))
#define XB_XGEN(j)  (2304 + 64 * (j))
#define XB_TOP      3328
#define XB_TOPGEN   3392
#define XCD_BAR_WORDS 3456
#define XB_SPIN_CAP (1u << 27)
__device__ __forceinline__ unsigned xb_ld(unsigned* p)              { return __hip_atomic_load(p, __ATOMIC_RELAXED, __HIP_MEMORY_SCOPE_AGENT); }
__device__ __forceinline__ unsigned xb_add(unsigned* p, unsigned v) { return __hip_atomic_fetch_add(p, v, __ATOMIC_RELAXED, __HIP_MEMORY_SCOPE_AGENT); }
__device__ __forceinline__ unsigned xb_xcc_id() { return (unsigned)__builtin_amdgcn_s_getreg((3 << 11) | 20) & 0xFu; }
#define XB_SPIN(cond, bar) do { unsigned _sp = 0; while (cond) { __builtin_amdgcn_s_sleep(1); \
    if ((++_sp & 255u) == 0u) { if (xb_ld(&(bar)[XB_TMO])) break; if (_sp > XB_SPIN_CAP) { atomicAdd(&(bar)[XB_TMO], 1u); break; } } } } while (0)
struct XcdBarrier { unsigned* bar; unsigned x; volatile LAS unsigned* st; };
__device__ __forceinline__ XcdBarrier xcd_barrier_post(unsigned* bar, volatile LAS unsigned* st, int tid_) {
    XcdBarrier b; b.bar = bar; b.x = xb_xcc_id(); b.st = st;
    if (tid_ == 0) (void)xb_add(&bar[XB_XCNT(b.x)], 1u);
    return b;
}
__device__ __forceinline__ void xcd_barrier_complete(unsigned* bar, unsigned x, unsigned& nloc, unsigned& nx) {
    const unsigned G = gridDim.x * gridDim.y * gridDim.z;
    unsigned sum, cnt, mine, sp = 0u;
    for (;;) {
        sum = 0u; cnt = 0u; mine = 0u;
#pragma unroll
        for (unsigned j = 0; j < 16; ++j) { const unsigned c = xb_ld(&bar[XB_XCNT(j)]); sum += c; cnt += (c > 0u) ? 1u : 0u; mine = (j == x) ? c : mine; }
        if (sum == G) break;
        __builtin_amdgcn_s_sleep(1);
        if ((++sp & 255u) == 0u) { if (xb_ld(&bar[XB_TMO])) break; if (sp > XB_SPIN_CAP) { atomicAdd(&bar[XB_TMO], 1u); break; } }
    }
    nloc = mine > 0u ? mine : 1u; nx = cnt > 0u ? cnt : 1u;
}
__device__ __forceinline__ void xcd_barrier(const XcdBarrier& b, int tid_) {
    asm volatile("s_waitcnt vmcnt(0)" ::: "memory");
    __syncthreads();
    if (tid_ == 0) {
        unsigned* bar = b.bar;
        __builtin_amdgcn_s_waitcnt(0);
        unsigned nloc = b.st[0], nx = b.st[1];
        if (nloc == 0u) { xcd_barrier_complete(bar, b.x, nloc, nx); b.st[0] = nloc; b.st[1] = nx; }
        const unsigned old = xb_add(&bar[XB_XSUB(b.x)], 1u);
        const unsigned gen = old / nloc;
        if (old + 1u == (gen + 1u) * nloc) {
            __builtin_amdgcn_fence(__ATOMIC_RELEASE, "agent");
            asm volatile("s_waitcnt vmcnt(0)" ::: "memory");
            const unsigned og = xb_add(&bar[XB_TOP], 1u);
            const unsigned tg = og / nx;
            if (og + 1u == (tg + 1u) * nx) xb_add(&bar[XB_TOPGEN], 1u);
            else XB_SPIN(xb_ld(&bar[XB_TOPGEN]) == tg, bar);
            __builtin_amdgcn_fence(__ATOMIC_ACQUIRE, "agent");
            xb_add(&bar[XB_XGEN(b.x)], 1u);
            asm volatile("s_waitcnt vmcnt(0)" ::: "memory");
        } else {
            XB_SPIN(xb_ld(&bar[XB_XGEN(b.x)]) == gen, bar);
            __builtin_amdgcn_fence(__ATOMIC_ACQUIRE, "agent");
            asm volatile("s_waitcnt vmcnt(0)" ::: "memory");
        }
    }
    __syncthreads();
}

namespace pg8 {
#define PG8_LAS __attribute__((address_space(3)))
typedef unsigned short bf16_t;
typedef short bf16x8 __attribute__((ext_vector_type(8)));
typedef float f32x4 __attribute__((ext_vector_type(4)));
typedef unsigned u32x4 __attribute__((ext_vector_type(4)));
constexpr int BM = 256, BK = 64, HALF = 128, HTB = HALF * BK * 2  , STAGE_BYTES = 8 * HTB, NXCD = 8, WGM = 8;

__host__ __device__ __forceinline__ int lds_byte(int r, int c) { const int st = (r >> 4) * 2 + (c >> 5), rr = r & 15, cc = c & 31, ob = rr * 64 + cc * 2; return st * 1024 + (ob ^ (((ob >> 9) & 1) << 5)); }
__host__ __device__ __forceinline__ void stage_rc(int b, int& R, int& C) { const int st = b / 1024, sb = b % 1024, swz = sb ^ (((sb >> 9) & 1) << 5); R = (st >> 1) * 16 + swz / 64; C = (st & 1) * 32 + (swz % 64) / 2; }
__host__ __device__ __forceinline__ int perm32(int rho) { const int n = rho >> 4, i = rho & 15; return 8 * (i >> 2) + 4 * n + (i & 3); }

struct Unit { int pm, pn; };
struct Gemm { const bf16_t* A; const bf16_t* Bt; int lda, ldb, K; const int* rowidx; };

struct StaticOrder {
    int nM, nN, nwg, G, c;
    __host__ __device__ void init(int M, int N, int G_, int c_) { nM = M / BM; nN = N / BM; nwg = nM * nN; G = G_; c = c_; }
    __host__ __device__ bool next(int i, Unit& u) const {
        const long L = (long)i * G + c; if (L >= nwg) return false;
        int wgid = (int)L; { const int q = nwg / NXCD, r = nwg % NXCD, xcd = wgid % NXCD, off = wgid / NXCD; wgid = (xcd < r ? xcd * (q + 1) : r * (q + 1) + (xcd - r) * q) + off; }
        const int nig = WGM * nN, gid = wgid / nig, fm = gid * WGM, gsz = (nM - fm) < WGM ? (nM - fm) : WGM;
        u.pm = fm + ((wgid % nig) % gsz); u.pn = (wgid % nig) / gsz; return true;
    }
    __device__ __forceinline__ void a_ready(const Unit&) const {}
    __device__ __forceinline__ void done(const Unit&) const {}
};

__device__ __forceinline__ unsigned cvt_pk_bf16(float lo, float hi) { unsigned r; asm volatile("v_cvt_pk_bf16_f32 %0, %1, %2" : "=v"(r) : "v"(lo), "v"(hi)); return r; }
typedef float f32x2 __attribute__((ext_vector_type(2)));
__device__ __forceinline__ f32x2 gelu_pk(f32x2 v) {
    const f32x2 av = __builtin_elementwise_abs(v), d = av * 0.2316418882f + 1.0f;
    f32x2 t; t.x = __builtin_amdgcn_rcpf(d.x); t.y = __builtin_amdgcn_rcpf(d.y);
    f32x2 q = t * 0.5307027145f + (-0.7265760135f); q = q * t + 0.7107068705f; q = q * t + (-0.142248368f); q = q * t + 0.127414796f; q = q * t;
    const f32x2 s = (v * v) * (-0.72134752044f);
    f32x2 e; e.x = __builtin_amdgcn_exp2f(s.x); e.y = __builtin_amdgcn_exp2f(s.y);
    const f32x2 m = v * (q * e), r = v - m;
    f32x2 o; o.x = v.x < 0.f ? m.x : r.x; o.y = v.y < 0.f ? m.y : r.y; return o;
}

template <int ACT  > struct EpiBf16 {
    static constexpr bool PERM = true, AFTER_DRAIN = false; static_assert(ACT == 0 || ACT == 1, "EpiBf16: ACT is 0 (none) or 1 (gelu_pk)");
    bf16_t* O; int ldc; const float* bias; int split_cols; size_t split_stride; float scale0;
    __device__ __forceinline__ void operator()(const f32x4 (&acc)[2][2][4][2], const Unit& u, int wr, int wc, int fr, int fq) const {
        const int row0 = u.pm * BM + wr * 64 + fr; int colt = u.pn * BM; bf16_t* base = O;
        float sc = 1.f; if (split_cols) { const int t = colt / split_cols; base += (size_t)t * split_stride; colt -= t * split_cols; if (t == 0) sc = scale0; }
        const int col0 = colt + wc * 32 + 8 * fq, bcol0 = u.pn * BM + wc * 32 + 8 * fq;
        f32x4 bv[2][2];
#pragma unroll
        for (int bj = 0; bj < 2; ++bj)
#pragma unroll
            for (int n = 0; n < 2; ++n) bv[bj][n] = bias ? *(const f32x4*)(bias + bcol0 + bj * HALF + 4 * n) : (f32x4){0.f, 0.f, 0.f, 0.f};
#pragma unroll
        for (int ai = 0; ai < 2; ++ai)
#pragma unroll
            for (int m = 0; m < 4; ++m) { bf16_t* rowp = base + (size_t)(row0 + ai * HALF + m * 16) * ldc + col0;
#pragma unroll
                for (int bj = 0; bj < 2; ++bj) { f32x4 v0 = acc[ai][bj][m][0] + bv[bj][0], v1 = acc[ai][bj][m][1] + bv[bj][1];
                    if (ACT == 1) { f32x2 a = gelu_pk((f32x2){v0[0], v0[1]}), b = gelu_pk((f32x2){v0[2], v0[3]}), c = gelu_pk((f32x2){v1[0], v1[1]}), d = gelu_pk((f32x2){v1[2], v1[3]});
                        v0 = (f32x4){a.x, a.y, b.x, b.y}; v1 = (f32x4){c.x, c.y, d.x, d.y}; }
                    v0 = v0 * sc; v1 = v1 * sc; u32x4 w; w.x = cvt_pk_bf16(v0[0], v0[1]); w.y = cvt_pk_bf16(v0[2], v0[3]); w.z = cvt_pk_bf16(v1[0], v1[1]); w.w = cvt_pk_bf16(v1[2], v1[3]);
                    *(u32x4*)(rowp + bj * HALF) = w; } }
    }
};


struct GroupedOrder {
    int nM, nN, groups, gsM, G, c, total;
    __host__ __device__ void init(int nM_, int nN_, int groups_, int gsM_, int G_, int c_) { nM = nM_; nN = nN_; groups = groups_; gsM = gsM_; G = G_; c = c_; total = nM * nN * groups; }
    __host__ __device__ bool next(int i, Unit& u) const {
        const long L = (long)i * G + c; if (L >= total) return false;
        int T = (int)L; { const int q = total / NXCD, r = total % NXCD, xcd = T % NXCD, off = T / NXCD; T = (xcd < r ? xcd * (q + 1) : r * (q + 1) + (xcd - r) * q) + off; }
        const int tpg = nM * nN, g = T / tpg, t = T - g * tpg;
        const int nig = WGM * nN, gid = t / nig, fm = gid * WGM, gsz = (nM - fm) < WGM ? (nM - fm) : WGM;
        u.pm = g * gsM + fm + ((t % nig) % gsz); u.pn = g * nN + (t % nig) / gsz; return true;
    }
    __device__ __forceinline__ void a_ready(const Unit&) const {}
    __device__ __forceinline__ void done(const Unit&) const {}
};
struct LatentOrder {
    GroupedOrder o;
    __host__ __device__ void init(int nN_, int G_, int c_) { o.init(256, nN_, 1, 256, G_, c_); }
    __host__ __device__ bool next(int i, Unit& u) const { if (!o.next(i, u)) return false; u.pm += (u.pm >> 3) + 1; return true; }
    __device__ __forceinline__ void a_ready(const Unit&) const {}
    __device__ __forceinline__ void done(const Unit&) const {}
};
struct HgInOrder {
    LatentOrder lat; int G, c;
    __host__ __device__ void init(int G_, int c_) { lat.init(16, G_, c_); G = G_; c = c_; }
    __host__ __device__ bool next(int i, Unit& u) const {
        const long L = (long)i * G + c;
        if (L < 4096) return lat.next(i, u);
        const int t = (int)L - 4096; if (t >= 256) return false;
        u.pm = (t >> 3) * 9; u.pn = 4 + (t & 7); return true;
    }
    __device__ __forceinline__ void a_ready(const Unit&) const {}
    __device__ __forceinline__ void done(const Unit&) const {}
};
__device__ __forceinline__ float sigm(float x) { return __builtin_amdgcn_rcpf(1.0f + __builtin_amdgcn_exp2f(x * -1.4426950408889634f)); }
constexpr int PP = 2304, DD = 1024;
__device__ __forceinline__ int mrow_of(int row) { const int b = row / PP, pos = row - b * PP; return pos < 256 ? 32 : b; }
struct EpiResidT {
    static constexpr bool PERM = false, AFTER_DRAIN = false;
    bf16_t* X; const float* MODL;
    __device__ __forceinline__ void operator()(const f32x4 (&acc)[2][2][4][2], const Unit& u, int wr, int wc, int fr, int fq) const {
        const int row0 = u.pm * BM + wr * 64 + fr, col0 = u.pn * BM + wc * 32 + 4 * fq;
#pragma unroll
        for (int ai = 0; ai < 2; ++ai)
#pragma unroll
            for (int m = 0; m < 4; ++m) { const int row = row0 + ai * HALF + m * 16; bf16_t* x = X + (size_t)row * DD + col0; const float* g = MODL + (size_t)mrow_of(row) * 6144 + 2 * DD + col0;
                u32x2 xo[2][2];
#pragma unroll
                for (int bj = 0; bj < 2; ++bj)
#pragma unroll
                    for (int n = 0; n < 2; ++n) xo[bj][n] = *(const u32x2*)(x + bj * HALF + n * 16);
#pragma unroll
                for (int bj = 0; bj < 2; ++bj)
#pragma unroll
                    for (int n = 0; n < 2; ++n) { const int o = bj * HALF + n * 16; const f32x4 xv = {bflo(xo[bj][n].x), bfhi(xo[bj][n].x), bflo(xo[bj][n].y), bfhi(xo[bj][n].y)};
                        const f32x4 r = xv + *(const f32x4*)(g + o) * acc[ai][bj][m][n]; u32x2 w; w.x = pkbf(r.x, r.y); w.y = pkbf(r.z, r.w); *(u32x2*)(x + o) = w; } }
    }
};
struct EpiGluT {
    static constexpr bool PERM = true, AFTER_DRAIN = false;
    bf16_t* X; const float* MODL;
    __device__ __forceinline__ void operator()(const f32x4 (&acc)[2][2][4][2], const Unit& u, int wr, int wc, int fr, int fq) const {
        const int row0 = u.pm * BM + wr * 64 + fr, f0 = u.pn * 128 + wc * 32 + 8 * fq;
#pragma unroll
        for (int ai = 0; ai < 2; ++ai)
#pragma unroll
            for (int m = 0; m < 4; ++m) { const int row = row0 + ai * HALF + m * 16; bf16_t* x = X + (size_t)row * DD + f0; const float* g = MODL + (size_t)mrow_of(row) * 6144 + 2 * DD + f0;
                const u32x4 xo = *(const u32x4*)x; u32x4 w;
#pragma unroll
                for (int n = 0; n < 2; ++n) { const f32x4 a = acc[ai][0][m][n], b = acc[ai][1][m][n]; f32x4 v = b * -1.4426950408889634f;
#pragma unroll
                    for (int q = 0; q < 4; ++q) v[q] = __builtin_amdgcn_exp2f(v[q]);
                    v = v + 1.0f;
#pragma unroll
                    for (int q = 0; q < 4; ++q) v[q] = __builtin_amdgcn_rcpf(v[q]);
                    v = v * a;
                    const unsigned x01 = n ? xo.z : xo.x, x23 = n ? xo.w : xo.y; const f32x4 xv = {bflo(x01), bfhi(x01), bflo(x23), bfhi(x23)};
                    const f32x4 r = xv + *(const f32x4*)(g + 4 * n) * v; if (n) { w.z = pkbf(r.x, r.y); w.w = pkbf(r.z, r.w); } else { w.x = pkbf(r.x, r.y); w.y = pkbf(r.z, r.w); } }
                *(u32x4*)x = w; }
    }
};
struct EpiSwigluT {
    static constexpr bool PERM = true, AFTER_DRAIN = false;
    bf16_t* HID; int nNg; int ldh;
    __device__ __forceinline__ void operator()(const f32x4 (&acc)[2][2][4][2], const Unit& u, int wr, int wc, int fr, int fq) const {
        const int row0 = u.pm * BM + wr * 64 + fr, f0 = (u.pn % nNg) * 128 + wc * 32 + 8 * fq;
#pragma unroll
        for (int ai = 0; ai < 2; ++ai)
#pragma unroll
            for (int m = 0; m < 4; ++m) { bf16_t* hp = HID + (size_t)(row0 + ai * HALF + m * 16) * ldh + f0;
                const f32x4 a0 = acc[ai][0][m][0], a1 = acc[ai][0][m][1], b0 = acc[ai][1][m][0], b1 = acc[ai][1][m][1];
                f32x4 e0 = a0 * -1.4426950408889634f, e1 = a1 * -1.4426950408889634f;
#pragma unroll
                for (int q = 0; q < 4; ++q) { e0[q] = __builtin_amdgcn_exp2f(e0[q]); e1[q] = __builtin_amdgcn_exp2f(e1[q]); }
                e0 = e0 + 1.0f; e1 = e1 + 1.0f;
#pragma unroll
                for (int q = 0; q < 4; ++q) { e0[q] = __builtin_amdgcn_rcpf(e0[q]); e1[q] = __builtin_amdgcn_rcpf(e1[q]); }
                const f32x4 o0 = (a0 * b0) * e0, o1 = (a1 * b1) * e1;
                u32x4 w; w.x = cvt_pk_bf16(o0.x, o0.y); w.y = cvt_pk_bf16(o0.z, o0.w); w.z = cvt_pk_bf16(o1.x, o1.y); w.w = cvt_pk_bf16(o1.z, o1.w);
                *(u32x4*)hp = w; }
    }
};
struct EpiDownT {
    static constexpr bool PERM = true, AFTER_DRAIN = false;
    bf16_t* Y; const float* GATE; int nNg;
    __device__ __forceinline__ void operator()(const f32x4 (&acc)[2][2][4][2], const Unit& u, int wr, int wc, int fr, int fq) const {
        const int row0 = u.pm * BM + wr * 64 + fr, col0 = (u.pn % nNg) * BM + wc * 32 + 8 * fq;
#pragma unroll
        for (int ai = 0; ai < 2; ++ai)
#pragma unroll
            for (int m = 0; m < 4; ++m) { const int row = row0 + ai * HALF + m * 16; bf16_t* rowp = Y + (size_t)row * DD + col0;
#pragma unroll
                for (int bj = 0; bj < 2; ++bj) { const f32x4 v0 = acc[ai][bj][m][0], v1 = acc[ai][bj][m][1];
                    u32x4 w; w.x = cvt_pk_bf16(v0[0], v0[1]); w.y = cvt_pk_bf16(v0[2], v0[3]); w.z = cvt_pk_bf16(v1[0], v1[1]); w.w = cvt_pk_bf16(v1[2], v1[3]);
                    *(u32x4*)(rowp + bj * HALF) = w; } }
    }
};
template <bool SILU> struct EpiVtT {
    static constexpr bool PERM = true, AFTER_DRAIN = false;
    bf16_t* VT;
    __device__ __forceinline__ void operator()(const f32x4 (&acc)[2][2][4][2], const Unit& u, int wr, int wc, int fr, int fq) const {
        const int hd0 = u.pm * BM + wr * 64 + fr, tok0 = u.pn * BM + wc * 32 + 8 * fq, b = (u.pn * BM) / PP, pos0 = tok0 - b * PP;
#pragma unroll
        for (int ai = 0; ai < 2; ++ai)
#pragma unroll
            for (int m = 0; m < 4; ++m) { bf16_t* rowp = VT + ((size_t)b * DD + hd0 + ai * HALF + m * 16) * PP + pos0;
#pragma unroll
                for (int bj = 0; bj < 2; ++bj) { f32x4 v0 = acc[ai][bj][m][0], v1 = acc[ai][bj][m][1];
                    if (SILU) {
#pragma unroll
                        for (int q = 0; q < 4; ++q) { v0[q] = v0[q] * sigm(v0[q]); v1[q] = v1[q] * sigm(v1[q]); } }
                    u32x4 w; w.x = cvt_pk_bf16(v0[0], v0[1]); w.y = cvt_pk_bf16(v0[2], v0[3]); w.z = cvt_pk_bf16(v1[0], v1[1]); w.w = cvt_pk_bf16(v1[2], v1[3]);
                    *(u32x4*)(rowp + bj * HALF) = w; } }
    }
};
struct EpiHgIn {
    static constexpr bool PERM = true, AFTER_DRAIN = false;
    bf16_t* O; const float* LB;
    __device__ __forceinline__ void operator()(const f32x4 (&acc)[2][2][4][2], const Unit& u, int wr, int wc, int fr, int fq) const {
        const int row0 = u.pm * BM + wr * 64 + fr, col0 = u.pn * BM + wc * 32 + 8 * fq, type = u.pn >> 2;
#pragma unroll
        for (int ai = 0; ai < 2; ++ai)
#pragma unroll
            for (int m = 0; m < 4; ++m) { bf16_t* rowp = O + (size_t)(row0 + ai * HALF + m * 16) * 4096 + col0;
#pragma unroll
                for (int bj = 0; bj < 2; ++bj) { f32x4 v0 = acc[ai][bj][m][0], v1 = acc[ai][bj][m][1];
                    if (type == 1 || type == 2) { const int c = (col0 + bj * HALF) & 1023; const f32x4 l0 = *(const f32x4*)(LB + c), l1 = *(const f32x4*)(LB + c + 4);
#pragma unroll
                        for (int q = 0; q < 4; ++q) { v0[q] = __log2f(l0[q] + (1.0f - l0[q]) * sigm(v0[q])); v1[q] = __log2f(l1[q] + (1.0f - l1[q]) * sigm(v1[q])); } }
                    else if (type == 3) {
#pragma unroll
                        for (int q = 0; q < 4; ++q) { v0[q] = v0[q] * sigm(v0[q]); v1[q] = v1[q] * sigm(v1[q]); } }
                    u32x4 w; w.x = cvt_pk_bf16(v0[0], v0[1]); w.y = cvt_pk_bf16(v0[2], v0[3]); w.z = cvt_pk_bf16(v1[0], v1[1]); w.w = cvt_pk_bf16(v1[2], v1[3]);
                    *(u32x4*)(rowp + bj * HALF) = w; } }
    }
};


struct EpiF32G {
    static constexpr bool PERM = false, AFTER_DRAIN = false;
    float* C; int ldc; int nNg;
    __device__ __forceinline__ void operator()(const f32x4 (&acc)[2][2][4][2], const Unit& u, int wr, int wc, int fr, int fq) const {
        const int row0 = u.pm * BM + wr * 64 + fr, col0 = (u.pn % nNg) * BM + wc * 32 + 4 * fq;
#pragma unroll
        for (int ai = 0; ai < 2; ++ai)
#pragma unroll
            for (int m = 0; m < 4; ++m) { float* rowp = C + (size_t)(row0 + ai * HALF + m * 16) * ldc + col0;
#pragma unroll
                for (int bj = 0; bj < 2; ++bj)
#pragma unroll
                    for (int n = 0; n < 2; ++n) *(f32x4*)(rowp + bj * HALF + n * 16) = acc[ai][bj][m][n]; }
    }
};
__device__ __forceinline__ float gelu_t(float x) { const float t = 1.5957691216057308f * (x + 0.044715f * x * x * x); return x * sigm(t); }
struct EpiS5Out {
    static constexpr bool PERM = true, AFTER_DRAIN = false;
    const bf16_t* H; bf16_t* Z; const float* dvec;
    __device__ __forceinline__ void operator()(const f32x4 (&acc)[2][2][4][2], const Unit& u, int wr, int wc, int fr, int fq) const {
        const int c0 = (u.pn & 1) * BM + wc * 32 + 8 * fq;
#pragma unroll
        for (int ai = 0; ai < 2; ++ai)
#pragma unroll
            for (int m = 0; m < 4; ++m) {
                const int rg = u.pm * BM + ai * HALF + wr * 64 + m * 16 + fr, g = rg / 2304, rem = rg - g * 2304, b = rem / 72, j = rem - b * 72;
#pragma unroll
                for (int bj = 0; bj < 2; ++bj) {
                    const int mc = c0 + bj * HALF, tau = mc >> 4, k0 = mc & 15;
                    const size_t off = ((size_t)b * PP + 32 * j + tau) * DD + g * 16 + k0;
                    const u32x4 uw = *(const u32x4*)(H + off);
                    const f32x4 d0 = *(const f32x4*)(dvec + g * 16 + k0), d1 = *(const f32x4*)(dvec + g * 16 + k0 + 4);
                    const f32x4 y0 = acc[ai][bj][m][0], y1 = acc[ai][bj][m][1];
                    u32x4 w;
                    w.x = cvt_pk_bf16(gelu_t(y0[0] + d0[0] * __uint_as_float(uw.x << 16)), gelu_t(y0[1] + d0[1] * __uint_as_float(uw.x & 0xffff0000u)));
                    w.y = cvt_pk_bf16(gelu_t(y0[2] + d0[2] * __uint_as_float(uw.y << 16)), gelu_t(y0[3] + d0[3] * __uint_as_float(uw.y & 0xffff0000u)));
                    w.z = cvt_pk_bf16(gelu_t(y1[0] + d1[0] * __uint_as_float(uw.z << 16)), gelu_t(y1[1] + d1[1] * __uint_as_float(uw.z & 0xffff0000u)));
                    w.w = cvt_pk_bf16(gelu_t(y1[2] + d1[2] * __uint_as_float(uw.w << 16)), gelu_t(y1[3] + d1[3] * __uint_as_float(uw.w & 0xffff0000u)));
                    *(u32x4*)(Z + off) = w;
                }
            }
    }
};


struct EpiQKRope {
    static constexpr bool PERM = true, AFTER_DRAIN = false;
    bf16_t* Q; size_t kstride; const float* T;
    __device__ __forceinline__ void operator()(const f32x4 (&acc)[2][2][4][2], const Unit& u, int wr, int wc, int fr, int fq) const {
        const int row0 = u.pm * BM + wr * 64 + fr; int colt = u.pn * BM; bf16_t* base = Q;
        { const int t = colt / DD; base += (size_t)t * kstride; colt -= t * DD; }
        const int col0 = colt + wc * 32 + 8 * fq, half = wc & 1; const bool first = fq < 2;
        const float qs = u.pn * BM < DD ? 0.125f * 1.4426950408889634f : 1.0f;
#pragma unroll
        for (int ai = 0; ai < 2; ++ai)
#pragma unroll
            for (int m = 0; m < 4; ++m) { const int row = row0 + ai * HALF + m * 16, b = row / PP, pos = row - b * PP, tt = pos - 256; const bool lat = pos >= 256;
                const int p = lat ? (half ? (tt & 63) : (tt >> 6)) : 0;
                const f32x4* cs = (const f32x4*)(T + (p * 16 + 8 * (fq & 1)) * 2);
                const f32x4 t0 = cs[0], t1 = cs[1], t2 = cs[2], t3 = cs[3];
                bf16_t* rowp = base + (size_t)row * DD + col0;
#pragma unroll
                for (int bj = 0; bj < 2; ++bj) { f32x4 v0 = acc[ai][bj][m][0] * qs, v1 = acc[ai][bj][m][1] * qs;
                    f32x4 p0, p1;
#pragma unroll
                    for (int q = 0; q < 4; ++q) { p0[q] = __shfl_xor(v0[q], 32); p1[q] = __shfl_xor(v1[q], 32); }
                    if (lat) { const float sg = first ? -1.0f : 1.0f;
                        v0 = (f32x4){v0[0] * t0[0] + sg * p0[0] * t0[1], v0[1] * t0[2] + sg * p0[1] * t0[3], v0[2] * t1[0] + sg * p0[2] * t1[1], v0[3] * t1[2] + sg * p0[3] * t1[3]};
                        v1 = (f32x4){v1[0] * t2[0] + sg * p1[0] * t2[1], v1[1] * t2[2] + sg * p1[1] * t2[3], v1[2] * t3[0] + sg * p1[2] * t3[1], v1[3] * t3[2] + sg * p1[3] * t3[3]}; }
                    u32x4 w; w.x = cvt_pk_bf16(v0[0], v0[1]); w.y = cvt_pk_bf16(v0[2], v0[3]); w.z = cvt_pk_bf16(v1[0], v1[1]); w.w = cvt_pk_bf16(v1[2], v1[3]);
                    *(u32x4*)(rowp + bj * HALF) = w; } }
    }
};

template <class Epi, class Sched, bool ALIGN_EPI = false, bool SP2 = false, bool GATHER = false>
__device__ __forceinline__ void gemm_phase(PG8_LAS unsigned char* lds, const Gemm g, const Sched& S, const Epi& E, const int tid) {
    const int wid = __builtin_amdgcn_readfirstlane(tid >> 6), lane = tid & 63, wr = wid >> 2, wc = wid & 3, fr = lane & 15, fq = lane >> 4;
    const int K = g.K, nt = K / BK;
    unsigned voffA[2], voffB[2];
#pragma unroll
    for (int i = 0; i < 2; ++i) { int R, C; stage_rc(tid * 16 + i * 8192, R, C); const int Rb = Epi::PERM ? ((R & ~31) + perm32(R & 31)) : R;
        voffA[i] = (unsigned)(R * g.lda + C) * 2u; voffB[i] = (unsigned)(Rb * g.ldb + C) * 2u; }
    unsigned vA0[2] = {0u, 0u}, vA1[2] = {0u, 0u}, wA0[2] = {0u, 0u}, wA1[2] = {0u, 0u};
#define PG8_GOFF(u_, o0, o1) do { _Pragma("unroll") for (int i = 0; i < 2; ++i) { int R, C; stage_rc(tid * 16 + i * 8192, R, C); const int r0_ = (u_).pm * BM + R; \
        o0[i] = ((unsigned)g.rowidx[r0_] * (unsigned)g.lda + (unsigned)C) * 2u; o1[i] = ((unsigned)g.rowidx[r0_ + HALF] * (unsigned)g.lda + (unsigned)C) * 2u; } } while (0)
    const size_t kstep = (size_t)(BK * 2);
    const size_t hstepA = (size_t)HALF * g.lda * 2, hstepB = (size_t)HALF * g.ldb * 2;
    const size_t tstepA = 2 * hstepA, tstepB = 2 * hstepB;
    const unsigned ldsw = (unsigned)wid * 1024u;
    const int aoff = lds_byte(wr * 64 + fr, fq * 8), boff = lds_byte(wc * 32 + fr, fq * 8);
#define PG8_SA(b, h) (((b) * 2 + (h)) * HTB)
#define PG8_SB(b, h) ((4 + (b) * 2 + (h)) * HTB)
#define PG8_STAGE(bufoff, gbase, voff) do { _Pragma("unroll") for (int _i = 0; _i < 2; ++_i) \
        __builtin_amdgcn_global_load_lds((const unsigned*)((const char*)(gbase) + (voff)[_i]), (PG8_LAS unsigned*)(lds + (bufoff) + ldsw + _i * 8192), 16, 0, 0); } while (0)
#define PG8_STAGEA(bufoff, kptr, h, oc0, oc1) do { if constexpr (GATHER) { if (h) PG8_STAGE(bufoff, kptr, oc1); else PG8_STAGE(bufoff, kptr, oc0); } else { PG8_STAGE(bufoff, (kptr) + ((h) ? hstepA : 0), voffA); } } while (0)
#define PG8_LDA(dst, b, h) do { _Pragma("unroll") for (int m = 0; m < 4; ++m) _Pragma("unroll") for (int k = 0; k < 2; ++k) dst[m][k] = *(const PG8_LAS bf16x8*)(lds + PG8_SA(b, h) + aoff + m * 2048 + k * 1024); } while (0)
#define PG8_LDB(dst, b, h) do { _Pragma("unroll") for (int n = 0; n < 2; ++n) _Pragma("unroll") for (int k = 0; k < 2; ++k) dst[n][k] = *(const PG8_LAS bf16x8*)(lds + PG8_SB(b, h) + boff + n * 2048 + k * 1024); } while (0)
#define PG8_MMA(ai, bj, At, Bt) do { __builtin_amdgcn_s_setprio(1); _Pragma("unroll") for (int m = 0; m < 4; ++m) _Pragma("unroll") for (int n = 0; n < 2; ++n) _Pragma("unroll") for (int k = 0; k < 2; ++k) \
        acc[ai][bj][m][n] = __builtin_amdgcn_mfma_f32_16x16x32_bf16(Bt[n][k], At[m][k], acc[ai][bj][m][n], 0, 0, 0); __builtin_amdgcn_s_setprio(0); } while (0)
#define PG8_WAIT_V(n) asm volatile("s_waitcnt vmcnt(" #n ")" ::: "memory")
#define PG8_WAIT_L(n) asm volatile("s_waitcnt lgkmcnt(" #n ")" ::: "memory")
#define PG8_BAR __builtin_amdgcn_s_barrier()
#define PG8_SCHED __builtin_amdgcn_sched_barrier(0)
    Unit cur, nxt; int ui = 0;
    if (!S.next(0, cur)) return;
    f32x4 acc[2][2][4][2];
#pragma unroll
    for (int a = 0; a < 2; ++a)
#pragma unroll
        for (int b = 0; b < 2; ++b)
#pragma unroll
            for (int m = 0; m < 4; ++m)
#pragma unroll
                for (int n = 0; n < 2; ++n) acc[a][b][m][n] = (f32x4){0.f, 0.f, 0.f, 0.f};
    bf16x8 At[4][2], B0[2][2], B1[2][2];
    const char* cA = (const char*)g.A + (GATHER ? (size_t)0 : (size_t)cur.pm * tstepA); if constexpr (GATHER) PG8_GOFF(cur, vA0, vA1);
    const char* cB = (const char*)g.Bt + (size_t)cur.pn * tstepB;
    S.a_ready(cur);
    if constexpr (SP2) {
        PG8_STAGE(PG8_SB(0, 0), cB, voffB); PG8_STAGE(PG8_SB(0, 1), cB + hstepB, voffB); PG8_STAGEA(PG8_SA(0, 0), cA, 0, vA0, vA1); PG8_STAGEA(PG8_SA(0, 1), cA, 1, vA0, vA1);
        if (wr == 1) PG8_BAR;
        PG8_WAIT_V(2); PG8_BAR;
        PG8_STAGE(PG8_SB(1, 0), cB + kstep, voffB); PG8_STAGEA(PG8_SA(1, 0), cA + kstep, 0, vA0, vA1); PG8_STAGE(PG8_SB(1, 1), cB + hstepB + kstep, voffB);
        PG8_WAIT_V(6); PG8_BAR;
    } else {
        PG8_STAGE(PG8_SB(0, 0), cB, voffB); PG8_STAGE(PG8_SA(0, 0), cA, voffA); PG8_STAGE(PG8_SB(0, 1), cB + hstepB, voffB); PG8_STAGE(PG8_SA(0, 1), cA + hstepA, voffA);
        if (wr == 1) PG8_BAR;
        PG8_WAIT_V(4); PG8_BAR;
        PG8_STAGE(PG8_SB(1, 0), cB + kstep, voffB); PG8_STAGE(PG8_SA(1, 0), cA + kstep, voffA); PG8_STAGE(PG8_SB(1, 1), cB + hstepB + kstep, voffB);
        PG8_WAIT_V(6); PG8_BAR;
    }
    for (;;) {
        const bool has_next = S.next(ui + 1, nxt);
        const char* nA = (has_next && !GATHER) ? (const char*)g.A + (size_t)nxt.pm * tstepA : cA;
        if constexpr (GATHER) { if (has_next) { if (wid < 4) __builtin_amdgcn_global_load_lds((const unsigned*)(g.rowidx + (size_t)nxt.pm * BM + (tid & 255)), (PG8_LAS unsigned*)(lds + STAGE_BYTES + wid * 256), 4, 0, 0); }
                                else { wA0[0] = vA0[0]; wA0[1] = vA0[1]; wA1[0] = vA1[0]; wA1[1] = vA1[1]; } }
        const char* nB = has_next ? (const char*)g.Bt + (size_t)nxt.pn * tstepB : cB;
        for (int t = 0; t < nt; t += 2) {
            const bool last = (t == nt - 2);
            const char* a1 = cA + (size_t)(t + 1) * kstep;
            const char* a2 = last ? nA : cA + (size_t)(t + 2) * kstep; const char* b2 = last ? nB : cB + (size_t)(t + 2) * kstep;
            const char* a3 = a2 + kstep; const char* b3 = b2 + kstep;
            if (last && has_next) S.a_ready(nxt);
            if constexpr (GATHER) { if (last && has_next) {
#pragma unroll
                for (int i = 0; i < 2; ++i) { int R, C; stage_rc(tid * 16 + i * 8192, R, C);
                    const unsigned i0_ = *(const PG8_LAS unsigned*)(lds + STAGE_BYTES + R * 4), i1_ = *(const PG8_LAS unsigned*)(lds + STAGE_BYTES + (R + HALF) * 4);
                    wA0[i] = (i0_ * (unsigned)g.lda + (unsigned)C) * 2u; wA1[i] = (i1_ * (unsigned)g.lda + (unsigned)C) * 2u; } } }
            const unsigned sA0[2] = {last ? wA0[0] : vA0[0], last ? wA0[1] : vA0[1]}, sA1[2] = {last ? wA1[0] : vA1[0], last ? wA1[1] : vA1[1]};
            if constexpr (SP2) {
            PG8_LDB(B0, 0, 0); PG8_LDB(B1, 0, 1); PG8_SCHED; PG8_LDA(At, 0, 0); PG8_STAGEA(PG8_SA(1, 1), a1, 1, vA0, vA1);
            PG8_WAIT_V(8); PG8_WAIT_L(0); PG8_BAR; PG8_MMA(0, 0, At, B0); PG8_MMA(0, 1, At, B1); PG8_BAR; PG8_SCHED;
            PG8_LDA(At, 0, 1); PG8_STAGE(PG8_SB(0, 0), b2, voffB); PG8_STAGE(PG8_SB(0, 1), b2 + hstepB, voffB); PG8_STAGEA(PG8_SA(0, 0), a2, 0, sA0, sA1);
            PG8_WAIT_V(8); PG8_WAIT_L(0); PG8_BAR; PG8_MMA(1, 0, At, B0); PG8_MMA(1, 1, At, B1); PG8_BAR; PG8_SCHED;
            PG8_LDB(B0, 1, 0); PG8_LDB(B1, 1, 1); PG8_SCHED; PG8_LDA(At, 1, 0); PG8_STAGEA(PG8_SA(0, 1), a2, 1, sA0, sA1);
            PG8_WAIT_V(8); PG8_WAIT_L(0); PG8_BAR; PG8_MMA(0, 0, At, B0); PG8_MMA(0, 1, At, B1); PG8_BAR; PG8_SCHED;
            PG8_LDA(At, 1, 1); PG8_STAGE(PG8_SB(1, 0), b3, voffB); PG8_STAGE(PG8_SB(1, 1), b3 + hstepB, voffB); PG8_STAGEA(PG8_SA(1, 0), a3, 0, sA0, sA1);
            PG8_WAIT_V(8); PG8_WAIT_L(0); PG8_BAR; PG8_MMA(1, 0, At, B0); PG8_MMA(1, 1, At, B1); PG8_BAR; PG8_SCHED;
            } else {
            PG8_LDB(B0, 0, 0); PG8_SCHED; PG8_LDA(At, 0, 0); PG8_STAGE(PG8_SA(1, 1), a1 + hstepA, voffA);
            PG8_WAIT_L(8); PG8_BAR; PG8_WAIT_L(0); PG8_MMA(0, 0, At, B0); PG8_BAR; PG8_SCHED;
            PG8_LDB(B1, 0, 1); PG8_STAGE(PG8_SB(0, 0), b2, voffB);
            PG8_BAR; PG8_WAIT_L(0); PG8_MMA(0, 1, At, B1); PG8_BAR;
            PG8_LDA(At, 0, 1); PG8_STAGE(PG8_SA(0, 0), a2, voffA);
            PG8_BAR; PG8_WAIT_L(0); PG8_MMA(1, 0, At, B0); PG8_BAR; PG8_SCHED;
            PG8_STAGE(PG8_SB(0, 1), b2 + hstepB, voffB);
            PG8_WAIT_V(6); PG8_BAR; PG8_MMA(1, 1, At, B1); PG8_BAR;
            PG8_LDB(B0, 1, 0); PG8_SCHED; PG8_LDA(At, 1, 0); PG8_STAGE(PG8_SA(0, 1), a2 + hstepA, voffA);
            PG8_WAIT_L(8); PG8_BAR; PG8_WAIT_L(0); PG8_MMA(0, 0, At, B0); PG8_BAR; PG8_SCHED;
            PG8_LDB(B1, 1, 1); PG8_STAGE(PG8_SB(1, 0), b3, voffB);
            PG8_BAR; PG8_WAIT_L(0); PG8_MMA(0, 1, At, B1); PG8_BAR;
            PG8_LDA(At, 1, 1); PG8_STAGE(PG8_SA(1, 0), a3, voffA);
            PG8_BAR; PG8_WAIT_L(0); PG8_MMA(1, 0, At, B0); PG8_BAR; PG8_SCHED;
            PG8_STAGE(PG8_SB(1, 1), b3 + hstepB, voffB);
            PG8_WAIT_V(6); PG8_BAR; PG8_MMA(1, 1, At, B1); PG8_BAR;
            }
        }
        if constexpr (ALIGN_EPI) { if (wr == 0) PG8_BAR; }
        if constexpr (!Epi::AFTER_DRAIN) { E(acc, cur, wr, wc, fr, fq); S.done(cur); }
        if (!has_next) break;
#pragma unroll
        for (int a = 0; a < 2; ++a)
#pragma unroll
            for (int b = 0; b < 2; ++b)
#pragma unroll
                for (int m = 0; m < 4; ++m)
#pragma unroll
                    for (int n = 0; n < 2; ++n) acc[a][b][m][n] = (f32x4){0.f, 0.f, 0.f, 0.f};
        cur = nxt; cA = nA; cB = nB; ++ui; vA0[0] = wA0[0]; vA0[1] = wA0[1]; vA1[0] = wA1[0]; vA1[1] = wA1[1];
        if constexpr (ALIGN_EPI) { if (wr == 1) PG8_BAR; }
    }
    PG8_WAIT_V(0);
    if constexpr (!ALIGN_EPI) { if (wr == 0) PG8_BAR; }
    PG8_BAR;
    if constexpr (Epi::AFTER_DRAIN) { E.fused(acc, cur, wr, wc, fr, fq, lds, wid, lane); S.done(cur); }
#undef PG8_SA
#undef PG8_SB
#undef PG8_STAGE
#undef PG8_STAGEA
#undef PG8_GOFF
#undef PG8_LDA
#undef PG8_LDB
#undef PG8_MMA
#undef PG8_WAIT_V
#undef PG8_WAIT_L
#undef PG8_BAR
#undef PG8_SCHED
}
}
#define PG8_SP2 true
#define PG8_ALIGN true

struct Frame;
struct Args { const float* in[33]; float* out; unsigned char* ws; int ph_lo, ph_hi; };
struct Frame {
    unsigned char* lds;
    int tid, lane, wave, bid, nb;
    const float* const* in;
    float* out; unsigned char* ws;
    float* MOD; float* AFF; int* SEL; float* GATE; int* INV; bf16* X; bf16* H;
};
__device__ __forceinline__ void REFRESH_(Frame& F) { int l_; asm volatile("v_mbcnt_lo_u32_b32 %0, -1, 0\n\tv_mbcnt_hi_u32_b32 %0, -1, %0" : "=v"(l_)); F.lane = l_; F.tid = F.wave * 64 + l_; }
__device__ __forceinline__ int mod_row(int row) { const int b = row / P, pos = row - b * P; return pos < NCTX ? 32 : b; }

__device__ __forceinline__ void ph_s5_pre(const Frame& F) {
    const float *a_re = F.in[8], *a_im = F.in[9], *log_dt = F.in[10], *b_re = F.in[11], *b_im = F.in[12], *c_re = F.in[13], *c_im = F.in[14];
    f32x2* Bb = (f32x2*)F.lds;
    f32x2* Cc = Bb + 2048;
    f32x2* Ap = Cc + 2048;
    float* Kt = (float*)(Ap + 2 * 33 * 64);
    bf16* W1 = (bf16*)(F.ws + WS_S5W1); bf16* W2 = (bf16*)(F.ws + WS_S5W2); f32x2* A32 = (f32x2*)(F.ws + WS_S5A);
    const int tid = F.tid;
    for (int g = F.nb - 1 - F.bid; g < 64; g += F.nb) {
        __syncthreads();
        if (tid < 128) {
            const int dir = tid >> 6, p = tid & 63, dg = dir * 64 + g;
            const double are = (double)a_re[dg * 64 + p], aim = (double)a_im[dg * 64 + p], dt = exp((double)log_dt[dg]);
            const double lr = are * dt, li = aim * dt, cl = cos(li), sl = sin(li), mag = exp(lr);
            const double Abi = mag * sl, sh = sin(0.5 * li), nr = expm1(lr) * cl - 2.0 * sh * sh, den = are * are + aim * aim;
            const double fr = (nr * are + Abi * aim) / den, fi = (Abi * are - nr * aim) / den;
            for (int h = 0; h < 16; ++h) { const double br = (double)b_re[((size_t)dg * 64 + p) * 16 + h], bi = (double)b_im[((size_t)dg * 64 + p) * 16 + h];
                Bb[(dir * 64 + p) * 16 + h] = (f32x2){(float)(fr * br - fi * bi), (float)(fr * bi + fi * br)}; }
            const double Abr = mag * cl; double pr = 1.0, pi = 0.0;
            for (int e = 0; e <= 32; ++e) { const f32x2 v = {(float)pr, (float)pi};
                Ap[(dir * 33 + e) * 64 + p] = v; if (e == 32) A32[(g * 2 + dir) * 64 + p] = v;
                const double nr2 = pr * Abr - pi * Abi, ni2 = pr * Abi + pi * Abr; pr = nr2; pi = ni2; }
        }
        for (int i = tid; i < 2048; i += NTHREADS) { const int dir = i >> 10, k = (i >> 6) & 15, p = i & 63; const size_t o = ((size_t)(dir * 64 + g) * 16 + k) * 64 + p; Cc[i] = (f32x2){c_re[o], c_im[o]}; }
        __syncthreads();
        {
            const int dir = tid >> 8, k = (tid >> 4) & 15, h = tid & 15; float acc[32];
#pragma unroll
            for (int lag = 0; lag < 32; ++lag) acc[lag] = 0.f;
#pragma unroll 2
            for (int p = 0; p < 64; ++p) { const f32x2 c = Cc[(dir * 16 + k) * 64 + p], bb = Bb[(dir * 64 + p) * 16 + h], a1 = Ap[(dir * 33 + 1) * 64 + p];
                float zr = c.x * bb.x - c.y * bb.y, zi = c.x * bb.y + c.y * bb.x;
#pragma unroll
                for (int lag = 0; lag < 32; ++lag) { acc[lag] += zr; const float nz = zr * a1.x - zi * a1.y; zi = zr * a1.y + zi * a1.x; zr = nz; } }
#pragma unroll
            for (int lag = 0; lag < 32; ++lag) Kt[((dir * 32 + lag) * 16 + k) * 16 + h] = acc[lag];
        }
        for (int i = tid; i < 16384; i += NTHREADS) {
            const int n = i >> 6, sg = (i >> 1) & 31, h0 = (i & 1) * 8, dir = n >> 7, c = (n >> 6) & 1, p = n & 63, e = dir ? sg : 31 - sg;
            const f32x2 a = Ap[(dir * 33 + e) * 64 + p]; float v[8];
#pragma unroll
            for (int q = 0; q < 8; ++q) { const f32x2 bb = Bb[(dir * 64 + p) * 16 + h0 + q]; v[q] = c ? a.x * bb.y + a.y * bb.x : a.x * bb.x - a.y * bb.y; }
            u32x4 w; w.x = pk2(v[0], v[1]); w.y = pk2(v[2], v[3]); w.z = pk2(v[4], v[5]); w.w = pk2(v[6], v[7]);
            *(u32x4*)(W1 + ((size_t)g * 256 + n) * 512 + sg * 16 + h0) = w;
        }
        for (int i = tid; i < 16384; i += NTHREADS) {
            const int m = i >> 5, n0 = (i & 31) * 8, dir = n0 >> 7, c = (n0 >> 6) & 1, p0 = n0 & 63, tau = m >> 4, k = m & 15, e = dir ? 32 - tau : tau + 1; float v[8];
#pragma unroll
            for (int q = 0; q < 8; ++q) { const f32x2 cc = Cc[(dir * 16 + k) * 64 + p0 + q], a = Ap[(dir * 33 + e) * 64 + p0 + q]; v[q] = c ? -(cc.x * a.y + cc.y * a.x) : cc.x * a.x - cc.y * a.y; }
            u32x4 w; w.x = pk2(v[0], v[1]); w.y = pk2(v[2], v[3]); w.z = pk2(v[4], v[5]); w.w = pk2(v[6], v[7]);
            *(u32x4*)(W2 + ((size_t)g * 512 + m) * 768 + 512 + n0) = w;
        }
        __syncthreads();
        for (int i = tid; i < 32768; i += NTHREADS) {
            const int m = i >> 6, sg = (i >> 1) & 31, h0 = (i & 1) * 8, tau = m >> 4, k = m & 15; float v[8];
#pragma unroll
            for (int q = 0; q < 8; ++q) { float x = 0.f; if (sg <= tau) x += Kt[((tau - sg) * 16 + k) * 16 + h0 + q]; if (sg >= tau) x += Kt[((32 + sg - tau) * 16 + k) * 16 + h0 + q]; v[q] = x; }
            u32x4 w; w.x = pk2(v[0], v[1]); w.y = pk2(v[2], v[3]); w.z = pk2(v[4], v[5]); w.w = pk2(v[6], v[7]);
            *(u32x4*)(W2 + ((size_t)g * 512 + m) * 768 + sg * 16 + h0) = w;
        }
    }
    __syncthreads();
}
__device__ __forceinline__ void ph_s5_scan(const Frame& F) {
    const float* SS = (const float*)(F.ws + WS_SS); bf16* AG = (bf16*)(F.ws + WS_AG); const f32x2* A32 = (const f32x2*)(F.ws + WS_S5A);
    for (int gid = F.bid * NTHREADS + F.tid; gid < 64 * 32 * 128; gid += F.nb * NTHREADS) {
        const int p = gid & 63, dir = (gid >> 6) & 1, b = (gid >> 7) & 31, g = gid >> 12;
        const f32x2 a = A32[(g * 2 + dir) * 64 + p];
        float hr = 0.f, hi = 0.f;
        const size_t row0 = (size_t)g * 2304 + b * 72;
#pragma unroll 4
        for (int idx = 0; idx < 72; ++idx) {
            const int j = dir == 0 ? idx : (idx < 8 ? 7 - idx : 79 - idx);
            const size_t row = row0 + j;
            AG[row * 768 + 512 + dir * 128 + p] = (bf16)f2bf(hr); AG[row * 768 + 512 + dir * 128 + 64 + p] = (bf16)f2bf(hi);
            const float sr = SS[row * 256 + dir * 128 + p], si = SS[row * 256 + dir * 128 + 64 + p];
            const float nr = a.x * hr - a.y * hi + sr, ni = a.x * hi + a.y * hr + si; hr = nr; hi = ni;
        }
    }
}

template <int DUAL>
__device__ __forceinline__ void transpose_item(const float* W, int ldw, int K, int N, bf16* WT, int row_off, LAS float* scr, int item, int lane) {
    const int nblk = N / 64, kb = item / nblk, nb = item - kb * nblk, k0 = 64 * kb, n0 = 64 * nb;
    const int lr = lane >> 4, lc = (lane & 15) * 4;
    f32x4 v[16];
#pragma unroll
    for (int i = 0; i < 16; ++i) v[i] = *(const f32x4*)(W + (size_t)(k0 + lr + 4 * i) * ldw + n0 + lc);
#pragma unroll
    for (int i = 0; i < 16; ++i) { LAS float* d = scr + (lr + 4 * i) * 65 + lc; d[0] = v[i].x; d[1] = v[i].y; d[2] = v[i].z; d[3] = v[i].w; }
    asm volatile("s_waitcnt lgkmcnt(0)" ::: "memory");
    const int c = lane & 7;
#pragma unroll
    for (int j = 0; j < 8; ++j) { const int n = (lane >> 3) + 8 * j; const LAS float* sp = scr + (8 * c) * 65 + n;
        u32x4 o; o.x = pkbf(sp[0 * 65], sp[1 * 65]); o.y = pkbf(sp[2 * 65], sp[3 * 65]); o.z = pkbf(sp[4 * 65], sp[5 * 65]); o.w = pkbf(sp[6 * 65], sp[7 * 65]);
        const int nn = n0 + n, dest = DUAL == -2 ? (nn < 3072 ? nn : (nn < 4096 ? nn + 1024 : nn - 1024)) : (DUAL < 0 ? row_off + nn : row_off + (nn >> 7) * 256 + DUAL * 128 + (nn & 127));
        *(u32x4*)(WT + (size_t)dest * K + k0 + 8 * c) = o; }
    asm volatile("s_waitcnt lgkmcnt(0)" ::: "memory");
}
__device__ __forceinline__ void convert_moe(const Frame& F, int l, int cb = -1, int cnb = 0) {
    if (cb < 0) { cb = F.bid; cnb = F.nb; }
    if (cb >= cnb) return;
    LAS float* scr = (LAS float*)((LAS unsigned char*)F.lds) + F.wave * 4160;
    bf16* WGU = (bf16*)(F.ws + WO_GU); bf16* WDN = (bf16*)(F.ws + WO_DN);
    for (int it = cb * NWAVES + F.wave; it < 24576; it += cnb * NWAVES) {
        const int m = it >> 13, r = it & 8191, e = r >> 9, item = r & 511;
        if (m == 0) transpose_item<0>(F.in[29] + (size_t)(l * NE + e) * D * FF, FF, D, FF, WGU, e * 2 * FF, scr, item, F.lane);
        else if (m == 1) transpose_item<1>(F.in[30] + (size_t)(l * NE + e) * D * FF, FF, D, FF, WGU, e * 2 * FF, scr, item, F.lane);
        else transpose_item<-1>(F.in[31] + (size_t)(l * NE + e) * FF * D, D, FF, D, WDN, e * D, scr, item, F.lane);
    }
}
__device__ __forceinline__ void convert_mixers(const Frame& F, int cb, int cnb) {
    if (cb >= cnb) return;
    LAS float* scr = (LAS float*)((LAS unsigned char*)F.lds) + F.wave * 4160;
    for (int it = cb * NWAVES + F.wave; it < 4096; it += cnb * NWAVES) {
        int r = it;
        if (r < 256) { transpose_item<0>(F.in[16], 2 * D, D, D, (bf16*)(F.ws + WO_GLU), 0, scr, r, F.lane); continue; } r -= 256;
        if (r < 256) { transpose_item<1>(F.in[16] + D, 2 * D, D, D, (bf16*)(F.ws + WO_GLU), 0, scr, r, F.lane); continue; } r -= 256;
        if (r < 768) { transpose_item<-1>(F.in[17], 3 * D, D, 3 * D, (bf16*)(F.ws + WO_NAQKV), 0, scr, r, F.lane); continue; } r -= 768;
        if (r < 256) { transpose_item<-1>(F.in[18], D, D, D, (bf16*)(F.ws + WO_NAO), 0, scr, r, F.lane); continue; } r -= 256;
        if (r < 768) { transpose_item<-1>(F.in[20], 3 * D, D, 3 * D, (bf16*)(F.ws + WO_DAQKV), 0, scr, r, F.lane); continue; } r -= 768;
        if (r < 256) { transpose_item<-1>(F.in[21], D, D, D, (bf16*)(F.ws + WO_DAO), 0, scr, r, F.lane); continue; } r -= 256;
        if (r < 1280) { transpose_item<-2>(F.in[24], 5 * D, D, 5 * D, (bf16*)(F.ws + WO_HGIN), 0, scr, r, F.lane); continue; } r -= 1280;
        transpose_item<-1>(F.in[25], D, D, D, (bf16*)(F.ws + WO_HGO), 0, scr, r, F.lane);
    }
}

__device__ __forceinline__ void ph_prologue(const Frame& F) {
    {
        float* S = (float*)F.lds;
        for (int i = F.tid; i < 33 * 1024; i += NTHREADS) { const float v = i < 32 * 1024 ? F.in[1][i] : F.in[3][i - 32 * 1024]; S[i] = siluf_(v); }
        __syncthreads();
        float acc[2][33];
#pragma unroll
        for (int t = 0; t < 2; ++t)
#pragma unroll
            for (int r = 0; r < 33; ++r) acc[t][r] = 0.f;
#pragma unroll
        for (int t = 0; t < 2; ++t) {
            const int task = F.bid + t * F.nb;
            if (task < 384) {
                const int l = task / 96, col = (task % 96) * 64 + F.lane, kb = F.wave * 128;
                const float* W = F.in[4] + (size_t)l * 1024 * 6144 + col;
#pragma unroll 1
                for (int k = kb; k < kb + 128; k += 8) {
                    float w[8];
#pragma unroll
                    for (int q = 0; q < 8; ++q) w[q] = W[(size_t)(k + q) * 6144];
#pragma unroll
                    for (int r = 0; r < 33; ++r) { const f32x4 s0 = *(const f32x4*)&S[r * 1024 + k], s1 = *(const f32x4*)&S[r * 1024 + k + 4];
                        acc[t][r] += (s0.x * w[0] + s0.y * w[1]) + (s0.z * w[2] + s0.w * w[3]) + (s1.x * w[4] + s1.y * w[5]) + (s1.z * w[6] + s1.w * w[7]); }
                }
            }
        }
        __syncthreads();
#pragma unroll
        for (int t = 0; t < 2; ++t)
#pragma unroll
            for (int r = 0; r < 33; ++r) S[((t * 8 + F.wave) * 33 + r) * 64 + F.lane] = acc[t][r];
        __syncthreads();
        for (int i = F.tid; i < 2 * 33 * 64; i += NTHREADS) {
            const int t = i / (33 * 64), r = (i / 64) % 33, ln = i & 63, task = F.bid + t * F.nb;
            if (task < 384) { const int l = task / 96, col = (task % 96) * 64 + ln; float v = F.in[5][l * 6144 + col];
#pragma unroll
                for (int w = 0; w < 8; ++w) v += S[((t * 8 + w) * 33 + r) * 64 + ln];
                F.MOD[((size_t)l * 33 + r) * 6144 + col] = v; }
        }
        __syncthreads();
    }
    if (F.bid == 48) {
        const float* lbin = F.in[27];
        for (int c = F.tid; c < D; c += NTHREADS) { const float x0 = lbin[c], x1 = lbin[D + c], x2 = lbin[2 * D + c], x3 = lbin[3 * D + c], mx = fmaxf(fmaxf(x0, x1), fmaxf(x2, x3));
            const float e0 = expf(x0 - mx), e1 = expf(x1 - mx), e2 = expf(x2 - mx), e3 = expf(x3 - mx); ((float*)(F.ws + WS_LB))[c] = (e1 + e2 + e3) / (e0 + e1 + e2 + e3); }
    }
    if (F.bid == 49) {
        for (int i = F.tid; i < 64 * 16; i += NTHREADS) { const float inv = powf(10000.0f, -(float)(i & 15) * (1.0f / 16.0f)); float sn, cs; sincosf((float)(i >> 4) * inv, &sn, &cs);
            ((float*)(F.ws + WS_ROPE))[2 * i] = cs; ((float*)(F.ws + WS_ROPE))[2 * i + 1] = sn; }
    }
    { const int ncv = F.nb > 128 ? F.nb - 64 : F.nb;
      convert_mixers(F, F.bid, ncv); convert_moe(F, 0, F.bid, ncv); }
    __syncthreads();
    ph_s5_pre(F);
}

template <bool F32> struct XRawT { typedef f32x4 T; };
template <> struct XRawT<false> { typedef u32x2 T; };
__device__ __forceinline__ f32x4 xcvt(const f32x4& r) { return r; }
__device__ __forceinline__ f32x4 xcvt(const u32x2& r) { return (f32x4){bflo(r.x), bfhi(r.x), bflo(r.y), bfhi(r.y)}; }
template <int MODE, bool COMBINE, bool S5OUT = false, bool SKIPCTX = false, bool FROMIN = false>
__device__ __forceinline__ void ph_norm(const Frame& F, int layer, int prev_layer) {
    static_assert(MODE != 1, "norm2 + router is ph_norm2");
    const float* nw = MODE == 0 ? F.in[6] + layer * D : F.in[32];
    const bf16* Y = (const bf16*)(F.ws + WS_Y);
    constexpr int NI = SKIPCTX ? NB * SEQ : R;
    constexpr int NPF = 4;
    const int per = (NI + F.nb * NWAVES - 1) / (F.nb * NWAVES);
    int it = (F.bid * NWAVES + F.wave) * per; const int itend = min(NI, it + per);
    typedef typename XRawT<FROMIN>::T XR;
    const __amdgpu_buffer_rsrc_t yrs = __builtin_amdgcn_make_buffer_rsrc((void*)Y, 0, (int)((size_t)NE * SLOTS * D * 2), 0x00020000);
    const int l16 = F.lane & 15;
#define NORM_ROWOF(i_) (SKIPCTX ? ((i_) >> 11) * P + NCTX + ((i_) & (SEQ - 1)) : (i_))
#define NORM_XPTR(r_) ((FROMIN ? (const XR*)(((r_) % P) < NCTX ? F.in[2] + ((size_t)((r_) / P) * NCTX + ((r_) % P)) * D : F.in[0] + ((size_t)((r_) / P) * SEQ + ((r_) % P) - NCTX) * D) : (const XR*)(F.X + (size_t)(r_) * D)) + F.lane)
#define NORM_STAGE(i_, INVA_, V_, G_, Yq_, INVB_) do { \
        const int ic_ = min((i_), itend - 1), ic1_ = min((i_) + 1, itend - 1); const int rA_ = NORM_ROWOF(ic_); \
        if (COMBINE) INVB_ = F.INV[(size_t)NORM_ROWOF(ic1_) * NE + l16]; \
        if (COMBINE) G_ = F.GATE[l16 * SLOTS + max(INVA_, 0)]; \
        { const XR* xp_ = NORM_XPTR(rA_); _Pragma("unroll") for (int j = 0; j < 4; ++j) V_[j] = xp_[64 * j]; } \
        if (COMBINE) { unsigned m_ = ((i_) < itend) ? (unsigned)(__ballot(F.lane < NE && INVA_ >= 0) & 0xffffull) : 0u; \
            _Pragma("unroll") for (int q = 0; q < NPF; ++q) { const bool pr_ = m_ != 0u; const int e_ = pr_ ? __builtin_ctz(m_) : 0; m_ &= m_ - 1u; const int s_ = __builtin_amdgcn_readlane(INVA_, e_); \
                const unsigned vo_ = pr_ ? (unsigned)(e_ * SLOTS + s_) * (unsigned)(D * 2) + (unsigned)F.lane * 8u : 0xfffff000u; \
                _Pragma("unroll") for (int j = 0; j < 4; ++j) Yq_[q][j] = __builtin_amdgcn_raw_buffer_load_b64(yrs, vo_ + 512u * j, 0, 0); } } \
    } while (0)
    XR v[4]; u32x2 yc[NPF][4]; float gl = 0.f; int invl = -1, invn = -1;
    if (COMBINE) invl = F.INV[(size_t)NORM_ROWOF(min(it, NI - 1)) * NE + l16];
    NORM_STAGE(it, invl, v, gl, yc, invn);
    const f32x4* nw4 = (const f32x4*)nw + F.lane;
    f32x4 g5[4], nwv[4], shv[4], scv[4]; int mrc = -1;
#pragma unroll
    for (int j = 0; j < 4; ++j) { nwv[j] = nw4[64 * j]; g5[j] = shv[j] = scv[j] = (f32x4){0.f, 0.f, 0.f, 0.f}; }
    while (it < itend) {
        const int row = NORM_ROWOF(it), b = row / P, pos = row - b * P, mr = pos < NCTX ? 32 : b;
        if (mr != mrc) { mrc = mr;
            const float* mrow = F.MOD + ((size_t)layer * 33 + mr) * 6144;
#pragma unroll
            for (int j = 0; j < 4; ++j) {
                if (COMBINE) g5[j] = ((const f32x4*)(F.MOD + ((size_t)prev_layer * 33 + mr) * 6144 + 5 * D) + F.lane)[64 * j];
                if (MODE != 2) { shv[j] = ((const f32x4*)(mrow + (MODE == 0 ? 0 : 3) * D) + F.lane)[64 * j]; scv[j] = ((const f32x4*)(mrow + (MODE == 0 ? 1 : 4) * D) + F.lane)[64 * j]; }
            }
        }
        XR vn[4]; u32x2 yn[NPF][4]; float gln = 0.f; int invnn = -1;
        NORM_STAGE(it + 1, invn, vn, gln, yn, invnn);
        f32x4 a[4];
#pragma unroll
        for (int j = 0; j < 4; ++j) a[j] = (f32x4){0.f, 0.f, 0.f, 0.f};
        if (COMBINE) {
            unsigned m = (unsigned)(__ballot(F.lane < NE && invl >= 0) & 0xffffull);
#pragma unroll
            for (int q = 0; q < NPF; ++q) {
                const bool pr = m != 0u; const int e = pr ? __builtin_ctz(m) : 0; m &= m - 1u;
                const float g = pr ? __uint_as_float(__builtin_amdgcn_readlane(__float_as_uint(gl), e)) : 0.f;
#pragma unroll
                for (int j = 0; j < 4; ++j) { a[j].x += g * bflo(yc[q][j].x); a[j].y += g * bfhi(yc[q][j].x); a[j].z += g * bflo(yc[q][j].y); a[j].w += g * bfhi(yc[q][j].y); }
            }
            while (m) {
                const int e = __builtin_ctz(m); m &= m - 1u;
                const int sl = __builtin_amdgcn_readlane(invl, e); const float g = __uint_as_float(__builtin_amdgcn_readlane(__float_as_uint(gl), e));
                const u32x2* y0 = (const u32x2*)(Y + ((size_t)e * SLOTS + sl) * D) + F.lane;
                u32x2 w0[4];
#pragma unroll
                for (int j = 0; j < 4; ++j) w0[j] = y0[64 * j];
#pragma unroll
                for (int j = 0; j < 4; ++j) { a[j].x += g * bflo(w0[j].x); a[j].y += g * bfhi(w0[j].x); a[j].z += g * bflo(w0[j].y); a[j].w += g * bfhi(w0[j].y); }
            }
        }
        f32x4 vv[4];
#pragma unroll
        for (int j = 0; j < 4; ++j) vv[j] = xcvt(v[j]);
        if (COMBINE) {
#pragma unroll
            for (int j = 0; j < 4; ++j) vv[j] = vv[j] + g5[j] * a[j];
        }
        if ((FROMIN || COMBINE) && MODE != 2) { u32x2* xw = (u32x2*)(F.X + (size_t)row * D) + F.lane;
#pragma unroll
            for (int j = 0; j < 4; ++j) { u32x2 w; w.x = pkbf(vv[j].x, vv[j].y); w.y = pkbf(vv[j].z, vv[j].w); xw[64 * j] = w; } }
        float ss = 0.f;
#pragma unroll
        for (int j = 0; j < 4; ++j) ss += (vv[j].x * vv[j].x + vv[j].y * vv[j].y) + (vv[j].z * vv[j].z + vv[j].w * vv[j].w);
        const float rinv = rsqrtf(wave_sum(ss) * (1.0f / D) + EPS);
        if (MODE == 2) {
            if (pos >= NCTX) {
                f32x4* o = (f32x4*)(F.out + ((size_t)b * SEQ + pos - NCTX) * D) + F.lane;
#pragma unroll
                for (int j = 0; j < 4; ++j) o[64 * j] = vv[j] * rinv * nwv[j];
            }
        } else {
            u32x2* ho = (u32x2*)(F.H + (size_t)row * D) + F.lane;
            f32x4 h[4];
#pragma unroll
            for (int j = 0; j < 4; ++j) { h[j] = vv[j] * rinv * nwv[j] * (scv[j] + 1.0f) + shv[j]; u32x2 w; w.x = pkbf(h[j].x, h[j].y); w.y = pkbf(h[j].z, h[j].w); ho[64 * j] = w;
                if (S5OUT) { const int g = (F.lane >> 2) + 16 * j;
                    *(u32x2*)((bf16*)(F.ws + WS_AG) + ((size_t)g * 2304 + b * 72 + (pos >> 5)) * 768 + (pos & 31) * 16 + (F.lane & 3) * 4) = w; } }
        }
#pragma unroll
        for (int j = 0; j < 4; ++j) { v[j] = vn[j];
#pragma unroll
            for (int q = 0; q < NPF; ++q) yc[q][j] = yn[q][j]; }
        gl = gln; invl = invn; invn = invnn; ++it;
    }
#undef NORM_STAGE
#undef NORM_XPTR
#undef NORM_ROWOF
}

template <bool SKIPCTX>
__device__ __forceinline__ void ph_norm2(const Frame& F, int layer) {
    const float* nw = F.in[7] + layer * D;
    LAS float* wrt = (LAS float*)((LAS unsigned char*)F.lds);
    {
        const float* wr = F.in[28] + (size_t)layer * D * NE;
        for (int i = F.tid; i < D * NE; i += NTHREADS) wrt[(i & 15) * D + (i >> 4)] = wr[i];
        __syncthreads();
    }
    const f32x4* nw4 = (const f32x4*)nw + F.lane;
    const int eid = ((F.lane & 1) << 3) | ((F.lane & 2) << 1) | ((F.lane & 4) >> 1) | ((F.lane & 8) >> 3);
    constexpr int NI = SKIPCTX ? NB * SEQ / 2 : R / 2;
    const int per = (NI + F.nb * NWAVES - 1) / (F.nb * NWAVES), it0 = (F.bid * NWAVES + F.wave) * per, it1 = min(NI, it0 + per);
    f32x4 gv[4], shv[4]; int mrc = -1;
#pragma unroll
    for (int j = 0; j < 4; ++j) gv[j] = shv[j] = (f32x4){0.f, 0.f, 0.f, 0.f};
#define N2_ROWOF(i_) (SKIPCTX ? ((i_) >> 10) * P + NCTX + 2 * ((i_) & (SEQ / 2 - 1)) : 2 * (i_))
    u32x2 w0[4], w1[4];
    { const u32x2* x0 = (const u32x2*)(F.X + (size_t)N2_ROWOF(min(it0, NI - 1)) * D) + F.lane;
#pragma unroll
      for (int j = 0; j < 4; ++j) { w0[j] = x0[64 * j]; w1[j] = x0[256 + 64 * j]; } }
    for (int it = it0; it < it1; ++it) {
        const int row = N2_ROWOF(it), b = row / P, pos = row - b * P, mr = pos < NCTX ? 32 : b;
        f32x4 v0[4], v1[4];
#pragma unroll
        for (int j = 0; j < 4; ++j) { v0[j] = xcvt(w0[j]); v1[j] = xcvt(w1[j]); }
        if (mr != mrc) { mrc = mr;
            const float* mrow = F.MOD + ((size_t)layer * 33 + mr) * 6144;
#pragma unroll
            for (int j = 0; j < 4; ++j) { shv[j] = ((const f32x4*)(mrow + 3 * D) + F.lane)[64 * j]; gv[j] = nw4[64 * j] * (((const f32x4*)(mrow + 4 * D) + F.lane)[64 * j] + 1.0f); }
        }
        u32x2 n0[4], n1[4];
        { const u32x2* xn = (const u32x2*)(F.X + (size_t)N2_ROWOF(min(it + 1, it1 - 1)) * D) + F.lane;
#pragma unroll
          for (int j = 0; j < 4; ++j) { n0[j] = xn[64 * j]; n1[j] = xn[256 + 64 * j]; } }
        float s0 = 0.f, s1 = 0.f;
#pragma unroll
        for (int j = 0; j < 4; ++j) { s0 += (v0[j].x * v0[j].x + v0[j].y * v0[j].y) + (v0[j].z * v0[j].z + v0[j].w * v0[j].w); s1 += (v1[j].x * v1[j].x + v1[j].y * v1[j].y) + (v1[j].z * v1[j].z + v1[j].w * v1[j].w); }
        const float r0 = rsqrtf(wave_sum(s0) * (1.0f / D) + EPS), r1 = rsqrtf(wave_sum(s1) * (1.0f / D) + EPS);
        u32x2* h0 = (u32x2*)(F.H + (size_t)row * D) + F.lane; u32x2* h1 = h0 + 256;
#pragma unroll
        for (int j = 0; j < 4; ++j) { const f32x4 g = gv[j];
            v0[j] = v0[j] * r0 * g + shv[j]; v1[j] = v1[j] * r1 * g + shv[j];
            u32x2 w; w.x = pkbf(v0[j].x, v0[j].y); w.y = pkbf(v0[j].z, v0[j].w); h0[64 * j] = w;
            w.x = pkbf(v1[j].x, v1[j].y); w.y = pkbf(v1[j].z, v1[j].w); h1[64 * j] = w; }
        f32x2 a0[NE], a1[NE];
#pragma unroll
        for (int e = 0; e < NE; ++e) { a0[e] = (f32x2){0.f, 0.f}; a1[e] = (f32x2){0.f, 0.f}; }
#pragma unroll
        for (int j = 0; j < 4; ++j) { asm volatile("" ::: "memory");
            const f32x2 p0 = {v0[j].x, v0[j].y}, q0 = {v0[j].z, v0[j].w}, p1 = {v1[j].x, v1[j].y}, q1 = {v1[j].z, v1[j].w};
#pragma unroll
            for (int e = 0; e < NE; ++e) { const f32x4 w = *(const LAS f32x4*)(wrt + e * D + F.lane * 4 + 256 * j); const f32x2 wl = {w.x, w.y}, wh = {w.z, w.w};
                a0[e] += p0 * wl; a0[e] += q0 * wh; a1[e] += p1 * wl; a1[e] += q1 * wh; } }
        float lg0[NE], lg1[NE];
#pragma unroll
        for (int e = 0; e < NE; ++e) { lg0[e] = a0[e].x + a0[e].y; lg1[e] = a1[e].x + a1[e].y; }
        const float t0 = reduce16(lg0, F.lane), t1 = reduce16(lg1, F.lane);
        float m0 = fmaxf(t0, dpp_xor1(t0)), m1 = fmaxf(t1, dpp_xor1(t1));
        m0 = fmaxf(m0, dpp_xor2(m0)); m1 = fmaxf(m1, dpp_xor2(m1)); m0 = fmaxf(m0, __shfl_xor(m0, 4)); m1 = fmaxf(m1, __shfl_xor(m1, 4)); m0 = fmaxf(m0, __shfl_xor(m0, 8)); m1 = fmaxf(m1, __shfl_xor(m1, 8));
        const float e0 = __builtin_amdgcn_exp2f((t0 - m0) * LOG2E_), e1 = __builtin_amdgcn_exp2f((t1 - m1) * LOG2E_);
        float z0 = e0 + dpp_xor1(e0), z1 = e1 + dpp_xor1(e1);
        z0 += dpp_xor2(z0); z1 += dpp_xor2(z1); z0 += __shfl_xor(z0, 4); z1 += __shfl_xor(z1, 4); z0 += __shfl_xor(z0, 8); z1 += __shfl_xor(z1, 8);
        if (F.lane < NE) { float* ap = F.AFF + ((size_t)b * NE + eid) * P + pos; ap[0] = e0 / z0; ap[1] = e1 / z1; }
#pragma unroll
        for (int j = 0; j < 4; ++j) { w0[j] = n0[j]; w1[j] = n1[j]; }
    }
#undef N2_ROWOF
}

__device__ __forceinline__ void ph_topk(const Frame& F, int nitems) {
    unsigned* hist = (unsigned*)F.lds;
    unsigned* wtot = hist + 256;
    unsigned* bc = wtot + 8;
    int* lsel = (int*)(bc + 8);
    bf16* XS = (bf16*)(F.ws + WS_XS);
    const int tid = F.tid, lane = F.lane, wave = F.wave;
    for (int item = F.bid; item < nitems; item += F.nb) {
        const int seg = item >> 9, b = (item >> 4) & 31, e = item & 15;
        const int n = seg ? NCTX : SEQ, pos0 = seg ? 0 : NCTX, cap = n / 8, slot0 = seg ? NB * 256 + b * 32 : b * 256;
        const float* a = F.AFF + ((size_t)b * NE + e) * P + pos0;
        const bool act = tid * 4 < n;
        f32x4 av = (f32x4){0.f, 0.f, 0.f, 0.f}; if (act) av = *(const f32x4*)(a + tid * 4);
        unsigned u[4]; u[0] = __float_as_uint(av.x); u[1] = __float_as_uint(av.y); u[2] = __float_as_uint(av.z); u[3] = __float_as_uint(av.w);
        unsigned prefix = 0u, mask = 0u, kk = (unsigned)cap;
#pragma unroll 1
        for (int pass = 0; pass < 4; ++pass) {
            const int shift = 24 - 8 * pass;
            __syncthreads();
            if (tid < 256) hist[tid] = 0u;
            __syncthreads();
            if (act) {
#pragma unroll
                for (int q = 0; q < 4; ++q) if ((u[q] & mask) == prefix) atomicAdd(&hist[(u[q] >> shift) & 255u], 1u);
            }
            __syncthreads();
            unsigned hv = 0u, cum = 0u;
            if (tid < 256) { hv = hist[255 - tid]; cum = hv;
#pragma unroll
                for (int o = 1; o < 64; o <<= 1) { const unsigned t = __shfl_up(cum, o); if (lane >= o) cum += t; }
                if (lane == 63) wtot[wave] = cum; }
            __syncthreads();
            if (tid < 256) {
                unsigned off = 0u;
#pragma unroll
                for (int w = 0; w < 4; ++w) if (w < wave) off += wtot[w];
                cum += off;
                if (cum >= kk && cum - hv < kk) { bc[0] = 255u - (unsigned)tid; bc[1] = kk - (cum - hv); }
            }
            __syncthreads();
            prefix |= bc[0] << shift; mask |= 255u << shift; kk = bc[1];
        }
        unsigned cg = 0u, ce = 0u;
        if (act) {
#pragma unroll
            for (int q = 0; q < 4; ++q) { cg += u[q] > prefix ? 1u : 0u; ce += u[q] == prefix ? 1u : 0u; }
        }
        unsigned pk = cg | (ce << 16), inc = pk;
#pragma unroll
        for (int o = 1; o < 64; o <<= 1) { const unsigned t = __shfl_up(inc, o); if (lane >= o) inc += t; }
        __syncthreads();
        if (lane == 63) wtot[wave] = inc;
        __syncthreads();
        unsigned off = 0u;
#pragma unroll
        for (int w = 0; w < 8; ++w) if (w < wave) off += wtot[w];
        unsigned excl = inc - pk + off, gb = excl & 0xffffu, eb = excl >> 16;
        if (act) {
#pragma unroll
            for (int q = 0; q < 4; ++q) {
                const int i = tid * 4 + q, row = b * P + pos0 + i;
                const bool gt = u[q] > prefix, eq = u[q] == prefix, sel = gt || (eq && eb < kk);
                if (sel) { const int slot = slot0 + (int)(gb + (eb < kk ? eb : kk)); F.SEL[e * SLOTS + slot] = row; F.GATE[e * SLOTS + slot] = __uint_as_float(u[q]); F.INV[(size_t)row * NE + e] = slot; }
                else F.INV[(size_t)row * NE + e] = -1;
                gb += gt ? 1u : 0u; eb += eq ? 1u : 0u;
            }
        }
        __syncthreads();
    }
    __syncthreads();
}

typedef short bf16x8 __attribute__((ext_vector_type(8)));
typedef float f32x16 __attribute__((ext_vector_type(16)));
#define MFMA32(a, b, c) __builtin_amdgcn_mfma_f32_32x32x16_bf16((a), (b), (c), 0, 0, 0)
__device__ __forceinline__ int kperm(int m) { return (m & 0x13) | ((m & 8) >> 1) | ((m & 4) << 1); }
__device__ __forceinline__ bf16x8 pack8(const f32x16& x, int s8) {
    u32x4 p; p.x = pkbf(x[s8 + 0], x[s8 + 1]); p.y = pkbf(x[s8 + 2], x[s8 + 3]); p.z = pkbf(x[s8 + 4], x[s8 + 5]); p.w = pkbf(x[s8 + 6], x[s8 + 7]);
    return __builtin_bit_cast(bf16x8, p);
}
constexpr float LOG2E = 1.4426950408889634f;

__device__ __forceinline__ void ph_da_attn(const Frame& F) {
    const bf16* Q = (const bf16*)(F.ws + WS_Q); const bf16* K = (const bf16*)(F.ws + WS_K); const bf16* VT = (const bf16*)(F.ws + WS_VT); bf16* O = (bf16*)(F.ws + WS_O);
    const int tid = F.tid, lane = F.lane, l32 = lane & 31, hh = lane >> 5, map = F.wave & 1, qsub = F.wave >> 1;
    const float* lam = F.in[22];
    const float lam_full = expf(wave_sum(lam[lane] * lam[64 + lane])) - expf(wave_sum(lam[128 + lane] * lam[192 + lane])) + LAM_INIT;
    constexpr int KB = 64 * 144, VB = 128 * 144, BUF = 2 * KB + VB;
    unsigned char* sb = F.lds;
    float* xch = (float*)(F.lds + 2 * BUF) + qsub * 4096;
    const float c = 0.125f * LOG2E;
    const int kr = (tid >> 3) & 63, kc = tid & 7, vd = tid >> 3, vc = tid & 7;
    const int kdst = kr * 144 + kc * 16, vdst = 2 * KB + vd * 144 + vc * 16;
    const int kfrag = map * KB + kperm(l32) * 144 + hh * 16, vfrag = 2 * KB + l32 * 144 + hh * 16;
    const int vb = (F.nb & 7) == 0 ? (F.bid & 7) * (F.nb >> 3) + (F.bid >> 3) : F.bid;
    for (int it = vb; it < 4096 + 512; it += F.nb) {
        int b, h, pos0, nst;
        if (it < 4096) { b = it >> 7; h = (it >> 4) & 7; pos0 = NCTX + (it & 15) * 128 + qsub * 32; nst = P / 64; }
        else { const int j = it - 4096; b = j >> 4; h = (j >> 1) & 7; pos0 = (j & 1) * 128 + qsub * 32; nst = NCTX / 64; }
        const size_t qrow = (size_t)b * P + pos0 + l32;
        bf16x8 qf[4];
#pragma unroll
        for (int ks = 0; ks < 4; ++ks) qf[ks] = *(const bf16x8*)(Q + qrow * D + h * 128 + map * 64 + ks * 16 + hh * 8);
        f32x16 o[4];
#pragma unroll
        for (int dt = 0; dt < 4; ++dt)
#pragma unroll
            for (int j = 0; j < 16; ++j) o[dt][j] = 0.f;
        float m = 0.f, l = 0.f;
        const bf16* kg = K + ((size_t)b * P + kr) * D + h * 128 + kc * 8;
        const bf16* vg = VT + ((size_t)b * D + h * 128 + vd) * P + vc * 8;
        u32x4 ka0, ka1, va0, va1;
        { const u32x4 k0 = *(const u32x4*)kg, k1 = *(const u32x4*)(kg + 64), v0 = *(const u32x4*)vg, v1 = *(const u32x4*)(vg + (size_t)64 * P);
          const bf16* kq = kg + (size_t)64 * D; const bf16* vq = vg + 64;
          ka0 = *(const u32x4*)kq; ka1 = *(const u32x4*)(kq + 64); va0 = *(const u32x4*)vq; va1 = *(const u32x4*)(vq + (size_t)64 * P);
          *(u32x4*)(sb + kdst) = k0; *(u32x4*)(sb + KB + kdst) = k1; *(u32x4*)(sb + vdst) = v0; *(u32x4*)(sb + vdst + 64 * 144) = v1; }
        __syncthreads();
#pragma unroll 1
        for (int st = 0; st < nst; ++st) {
            const unsigned char* cb = sb + (st & 1) * BUF;
            u32x4 kn0 = (u32x4){0u, 0u, 0u, 0u}, kn1 = kn0, vn0 = kn0, vn1 = kn0;
            if (st + 2 < nst) { const bf16* kq = kg + (size_t)(st + 2) * 64 * D; const bf16* vq = vg + (st + 2) * 64;
                kn0 = *(const u32x4*)kq; kn1 = *(const u32x4*)(kq + 64); vn0 = *(const u32x4*)vq; vn1 = *(const u32x4*)(vq + (size_t)64 * P); }
#pragma unroll
            for (int sub = 0; sub < 2; ++sub) {
                f32x16 s;
#pragma unroll
                for (int j = 0; j < 16; ++j) s[j] = -m;
#pragma unroll
                for (int ks = 0; ks < 4; ++ks) s = MFMA32(*(const bf16x8*)(cb + kfrag + sub * 32 * 144 + ks * 32), qf[ks], s);
                float mx = s[0];
#pragma unroll
                for (int j = 1; j < 16; ++j) mx = fmaxf(mx, s[j]);
                mx = fmaxf(mx, __shfl_xor(mx, 32));
                const bool first = st == 0 && sub == 0;
                if (first || __any(mx > 8.0f)) {
                    const float d = first ? mx : fmaxf(mx, 0.f);
                    if (!first) { const float alpha = __builtin_amdgcn_exp2f(-d); l *= alpha;
#pragma unroll
                        for (int dt = 0; dt < 4; ++dt)
#pragma unroll
                            for (int j = 0; j < 16; ++j) o[dt][j] *= alpha; }
                    m += d;
#pragma unroll
                    for (int j = 0; j < 16; ++j) s[j] -= d;
                }
                float ps = 0.f;
#pragma unroll
                for (int j = 0; j < 16; ++j) { s[j] = __builtin_amdgcn_exp2f(s[j]); ps += s[j]; }
                l += ps;
                const bf16x8 p0 = pack8(s, 0), p1 = pack8(s, 8);
#pragma unroll
                for (int dt = 0; dt < 4; ++dt) { o[dt] = MFMA32(*(const bf16x8*)(cb + vfrag + dt * 32 * 144 + sub * 64), p0, o[dt]); o[dt] = MFMA32(*(const bf16x8*)(cb + vfrag + dt * 32 * 144 + sub * 64 + 32), p1, o[dt]); }
            }
            if (st + 1 < nst) { unsigned char* nb = sb + ((st + 1) & 1) * BUF; *(u32x4*)(nb + kdst) = ka0; *(u32x4*)(nb + KB + kdst) = ka1; *(u32x4*)(nb + vdst) = va0; *(u32x4*)(nb + vdst + 64 * 144) = va1; }
            ka0 = kn0; ka1 = kn1; va0 = vn0; va1 = vn1;
            __syncthreads();
        }
        l += __shfl_xor(l, 32);
        const float inv = 1.0f / l;
        if (map == 1) {
#pragma unroll
            for (int dt = 0; dt < 4; ++dt)
#pragma unroll
                for (int j = 0; j < 16; ++j) xch[(dt * 16 + j) * 64 + lane] = o[dt][j] * inv * lam_full;
        }
        __syncthreads();
        if (map == 0) {
            float ss = 0.f;
#pragma unroll
            for (int dt = 0; dt < 4; ++dt)
#pragma unroll
                for (int j = 0; j < 16; ++j) { const float v = o[dt][j] * inv - xch[(dt * 16 + j) * 64 + lane]; o[dt][j] = v; ss += v * v; }
            ss += __shfl_xor(ss, 32);
            const float rinv = rsqrtf(ss * (1.0f / 128.0f) + EPS) * (1.0f - LAM_INIT);
#pragma unroll
            for (int dt = 0; dt < 4; ++dt)
#pragma unroll
                for (int jq = 0; jq < 4; ++jq) {
                    const int d0 = dt * 32 + jq * 8 + hh * 4; const f32x4 sw = *(const f32x4*)(F.in[23] + d0);
                    u32x2 w; w.x = pkbf(o[dt][jq * 4 + 0] * rinv * sw.x, o[dt][jq * 4 + 1] * rinv * sw.y); w.y = pkbf(o[dt][jq * 4 + 2] * rinv * sw.z, o[dt][jq * 4 + 3] * rinv * sw.w);
                    *(u32x2*)(O + qrow * D + h * 128 + d0) = w;
                }
        }
        __syncthreads();
    }
}

__device__ __forceinline__ void ph_na_attn(const Frame& F) {
    const bf16* Q = (const bf16*)(F.ws + WS_Q); const bf16* K = (const bf16*)(F.ws + WS_K); const bf16* VT = (const bf16*)(F.ws + WS_VT); bf16* O = (bf16*)(F.ws + WS_O);
    const int tid = F.tid, lane = F.lane, l32 = lane & 31, hh = lane >> 5;
    constexpr int KB = 64 * 144, VB = 64 * 144, BUF = KB + VB;
    unsigned char* sb = F.lds;
    float* rp = (float*)(F.lds + 2 * BUF) + 64;
    for (int i = tid; i < 16 * 15 * 31 + 128; i += NTHREADS) { const int k = i - 64; rp[k] = (k >= 0 && k < 16 * 15 * 31) ? F.in[19][k] * LOG2E : 0.f; }
    __syncthreads();
    const float c = 0.125f * LOG2E;
    const int pr = tid >> 3, pc = tid & 7;
    const int kdst = pr * 144 + pc * 16, vdst = KB + pr * 144 + pc * 16;
    const int kfrag = kperm(l32) * 144 + hh * 16, vfrag = KB + l32 * 144 + hh * 16;
    const int vb = (F.nb & 7) == 0 ? (F.bid & 7) * (F.nb >> 3) + (F.bid >> 3) : F.bid;
    for (int it = vb; it < 4096 + 512; it += F.nb) {
        int b, h, r = 0, cq = 0, kc0 = 0, rlo = 0, wr0 = 0, wr1 = 0, nt; bool lat; size_t qrow;
        if (it < 4096) { lat = true; b = it >> 7; h = (it >> 3) & 15; const int rg = ((it & 7) + (it >> 8)) & 7  ;
            const int rw = rg * 4 + (F.wave >> 2) * 2, cqt = F.wave & 3; r = rw + (l32 >> 4); cq = cqt * 16 + (l32 & 15); kc0 = min(max(cqt * 16 - 8, 0), 32);
            wr0 = min(max(rw - 4, 0), 24); wr1 = min(max(rw + 1 - 4, 0), 24) + 8;
            qrow = (size_t)b * P + NCTX + r * 64 + cq;
            rlo = min(max(rg * 4 - 4, 0), 24); const int rhi = min(max(rg * 4 + 3 - 4, 0), 24) + 7; nt = 4 + (rhi - rlo + 1); }
        else { lat = false; const int j = it - 4096; b = j >> 4; h = j & 15; qrow = (size_t)b * P + F.wave * 32 + l32; nt = 4; }
        const int r0 = min(max(r - 4, 0), 24), c0 = min(max(cq - 8, 0), 48);
        bf16x8 qf[4];
#pragma unroll
        for (int ks = 0; ks < 4; ++ks) qf[ks] = *(const bf16x8*)(Q + qrow * D + h * 64 + ks * 16 + hh * 8);
        float neg[16];
#pragma unroll
        for (int j = 0; j < 16; ++j) { const int kcol = kc0 + 16 * (j >> 3) + 8 * hh + 4 * ((j >> 2) & 1) + (j & 3); neg[j] = (kcol >= c0 && kcol < c0 + 16) ? 0.f : -1.0e30f; }
        f32x16 o[2];
#pragma unroll
        for (int dt = 0; dt < 2; ++dt)
#pragma unroll
            for (int j = 0; j < 16; ++j) o[dt][j] = 0.f;
        float m = -1.0e30f, l = 0.f;
        const bf16* kg = K + ((size_t)b * P + pr) * D + h * 64 + pc * 8;
        const bf16* vg = VT + ((size_t)b * D + h * 64 + pr) * P + pc * 8;
#define NA_KEY0(st) ((st) < 4 ? (st) * 64 : NCTX + (rlo + (st) - 4) * 64)
        u32x4 ka, va;
        { const int k0 = NA_KEY0(0), k1 = NA_KEY0(1); const u32x4 x0 = *(const u32x4*)(kg + (size_t)k0 * D), y0 = *(const u32x4*)(vg + k0);
          ka = *(const u32x4*)(kg + (size_t)k1 * D); va = *(const u32x4*)(vg + k1);
          *(u32x4*)(sb + kdst) = x0; *(u32x4*)(sb + vdst) = y0; }
        __syncthreads();
#pragma unroll 1
        for (int st = 0; st < nt; ++st) {
            const unsigned char* cbuf = sb + (st & 1) * BUF;
            u32x4 kn = (u32x4){0u, 0u, 0u, 0u}, vn = kn;
            if (st + 2 < nt) { const int k2 = NA_KEY0(st + 2); kn = *(const u32x4*)(kg + (size_t)k2 * D); vn = *(const u32x4*)(vg + k2); }
            const int krow = rlo + st - 4;
            const bool use = st < 4 || (krow >= wr0 && krow < wr1);
            if (use) {
#pragma unroll
                for (int sub = 0; sub < 2; ++sub) if (sub == 0 || st < 4) {
                    const int ko = st < 4 ? sub * 32 : kc0;
                    f32x16 s;
#pragma unroll
                    for (int j = 0; j < 16; ++j) s[j] = 0.f;
#pragma unroll
                    for (int ks = 0; ks < 4; ++ks) s = MFMA32(*(const bf16x8*)(cbuf + kfrag + ko * 144 + ks * 32), qf[ks], s);
                    if (st >= 4) {
                        const float rmask = (krow >= r0 && krow < r0 + 8) ? 0.f : -1.0e30f;
                        const float* rph = rp + (h * 15 + (krow - r + 7)) * 31 - cq + 15 + 8 * hh + kc0;
#pragma unroll
                        for (int j = 0; j < 16; ++j) s[j] = (s[j] * c + rph[16 * (j >> 3) + 4 * ((j >> 2) & 1) + (j & 3)]) + (neg[j] + rmask);
                    } else {
#pragma unroll
                        for (int j = 0; j < 16; ++j) s[j] *= c;
                    }
                    float mx = s[0];
#pragma unroll
                    for (int j = 1; j < 16; ++j) mx = fmaxf(mx, s[j]);
                    mx = fmaxf(mx, __shfl_xor(mx, 32));
                    if (__any(mx > m + 8.0f)) {
                        const float mn = fmaxf(m, mx), alpha = __builtin_amdgcn_exp2f(m - mn); m = mn; l *= alpha;
#pragma unroll
                        for (int dt = 0; dt < 2; ++dt)
#pragma unroll
                            for (int j = 0; j < 16; ++j) o[dt][j] *= alpha;
                    }
                    float ps = 0.f;
#pragma unroll
                    for (int j = 0; j < 16; ++j) { s[j] = __builtin_amdgcn_exp2f(s[j] - m); ps += s[j]; }
                    l += ps;
                    const bf16x8 p0 = pack8(s, 0), p1 = pack8(s, 8);
#pragma unroll
                    for (int dt = 0; dt < 2; ++dt) { o[dt] = MFMA32(*(const bf16x8*)(cbuf + vfrag + dt * 32 * 144 + ko * 2), p0, o[dt]); o[dt] = MFMA32(*(const bf16x8*)(cbuf + vfrag + dt * 32 * 144 + ko * 2 + 32), p1, o[dt]); }
                }
            }
            if (st + 1 < nt) { unsigned char* nb = sb + ((st + 1) & 1) * BUF; *(u32x4*)(nb + kdst) = ka; *(u32x4*)(nb + vdst) = va; }
            ka = kn; va = vn;
            __syncthreads();
        }
#undef NA_KEY0
        l += __shfl_xor(l, 32);
        const float inv = 1.0f / l;
#pragma unroll
        for (int dt = 0; dt < 2; ++dt)
#pragma unroll
            for (int jq = 0; jq < 4; ++jq) {
                const int d0 = dt * 32 + jq * 8 + hh * 4;
                u32x2 w; w.x = pkbf(o[dt][jq * 4 + 0] * inv, o[dt][jq * 4 + 1] * inv); w.y = pkbf(o[dt][jq * 4 + 2] * inv, o[dt][jq * 4 + 3] * inv);
                *(u32x2*)(O + qrow * D + h * 64 + d0) = w;
            }
    }
    __syncthreads();
}

__device__ __forceinline__ f32x4 unpk4(u32x2 w) { return (f32x4){bflo(w.x), bfhi(w.x), bflo(w.y), bfhi(w.y)}; }
__device__ __forceinline__ bf16 bf1(float x) { return (bf16)(pkbf(x, 0.f) & 0xffffu); }
__device__ __forceinline__ f32x4 shx32(f32x4 v) { return (f32x4){__shfl_xor(v.x, 32), __shfl_xor(v.y, 32), __shfl_xor(v.z, 32), __shfl_xor(v.w, 32)}; }
template <int DIR>
__device__ __forceinline__ void hgrn_seq(const Frame& F, int b, int h, int eb) {
    const bf16* ZIN = (const bf16*)(F.ws + WS_ZIN); const bf16* VTG = (const bf16*)(F.ws + WS_VTG); bf16* OUT = (bf16*)(F.ws + (DIR ? WS_OFB : WS_OFF));
    const int lane = F.lane, l32 = lane & 31, hh = lane >> 5, cperm = kperm(l32);
    constexpr int IMG = 32 * 136 * 2, KTB = 128 * 80, DBUF = 2 * IMG + KTB + 512;
    unsigned char* dbase = F.lds + DIR * 2 * DBUF;
    const int tg = lane & 7, prho = 8 * eb + (lane >> 3), pc = kperm(prho);
    f32x16 S[4];
#pragma unroll
    for (int d = 0; d < 4; ++d)
#pragma unroll
        for (int j = 0; j < 16; ++j) S[d][j] = 0.f;
    const bf16* vbase = VTG + ((size_t)b * D + h * 128 + eb * 32 + l32) * P + hh * 8;
    const bf16* zp = ZIN + ((size_t)b * P + 4 * tg) * 4096 + h * 128 + 4 * prho;
#define HG_CHUNK(i_) (DIR == 0 ? (i_) : ((i_) < 8 ? 7 - (i_) : 79 - (i_)))
#define HG_LOAD(i_) do { const int c_ = HG_CHUNK(i_); const bf16* z_ = zp + (size_t)c_ * 32 * 4096; \
        _Pragma("unroll") for (int i = 0; i < 4; ++i) { nlf[i] = *(const u32x2*)(z_ + (size_t)i * 4096 + (1 + DIR) * D); nq[i] = *(const u32x2*)(z_ + (size_t)i * 4096); } \
        nv0 = *(const bf16x8*)(vbase + c_ * 32); nv1 = *(const bf16x8*)(vbase + c_ * 32 + 16); } while (0)
    u32x2 nlf[4], nq[4]; bf16x8 nv0, nv1;
    HG_LOAD(0);
#pragma unroll 1
    for (int idx = 0; idx < 72; ++idx) {
        const int cc = HG_CHUNK(idx);
        const size_t row0 = (size_t)b * P + cc * 32;
        unsigned char* buf = dbase + (idx & 1) * DBUF;
        bf16* Qp = (bf16*)buf; bf16* Kp = (bf16*)(buf + IMG); bf16* KT = (bf16*)(buf + 2 * IMG); float* egl = (float*)(buf + 2 * IMG + KTB);
        u32x2 lfc[4], qc[4];
#pragma unroll
        for (int i = 0; i < 4; ++i) { lfc[i] = nlf[i]; qc[i] = nq[i]; }
        const bf16x8 vf0 = nv0, vf1 = nv1;
        HG_LOAD(min(idx + 1, 71));
        f32x4 l4[4], t = (f32x4){0.f, 0.f, 0.f, 0.f};
#pragma unroll
        for (int i = 0; i < 4; ++i) { l4[i] = unpk4(lfc[i]); t += l4[i]; }
        f32x4 x = t;
#pragma unroll
        for (int k = 1; k < 8; k <<= 1) { const f32x4 y = (f32x4){__shfl_up(x.x, k, 8), __shfl_up(x.y, k, 8), __shfl_up(x.z, k, 8), __shfl_up(x.w, k, 8)}; if (tg >= k) x += y; }
        const f32x4 tot = (f32x4){__shfl(x.x, 7, 8), __shfl(x.y, 7, 8), __shfl(x.z, 7, 8), __shfl(x.w, 7, 8)};
        const f32x4 off = DIR == 0 ? x - t : tot - x;
        f32x4 eg = (f32x4){__builtin_amdgcn_exp2f(off.x), __builtin_amdgcn_exp2f(off.y), __builtin_amdgcn_exp2f(off.z), __builtin_amdgcn_exp2f(off.w)}; float kv[4][4];
#pragma unroll
        for (int ii = 0; ii < 4; ++ii) {
            const int i = DIR ? 3 - ii : ii;
            const f32x4 lf = l4[i], q4 = unpk4(qc[i]);
            const int srow = (4 * tg + i) * 136 + pc;
#pragma unroll
            for (int d = 0; d < 4; ++d) { const float f = __builtin_amdgcn_exp2f(lf[d]); eg[d] *= f; const float kq = (1.0f - f) * __builtin_amdgcn_rcpf(eg[d]);
                Qp[srow + d * 32] = bf1(q4[d] * eg[d]); Kp[srow + d * 32] = bf1(kq); kv[d][i] = kq; }
        }
#pragma unroll
        for (int d = 0; d < 4; ++d) { u32x2 w; w.x = pkbf(kv[d][0], kv[d][1]); w.y = pkbf(kv[d][2], kv[d][3]); *(u32x2*)(KT + (d * 32 + prho) * 40 + 4 * tg) = w; }
        if (tg == 0) *(f32x4*)(egl + 4 * prho) = (f32x4){__builtin_amdgcn_exp2f(tot.x), __builtin_amdgcn_exp2f(tot.y), __builtin_amdgcn_exp2f(tot.z), __builtin_amdgcn_exp2f(tot.w)};
        __syncthreads();
        bf16x8 kf[4][2];
#pragma unroll
        for (int d = 0; d < 4; ++d)
#pragma unroll
            for (int sg = 0; sg < 2; ++sg) kf[d][sg] = *(const bf16x8*)(KT + (d * 32 + l32) * 40 + sg * 16 + 8 * hh);
        if (cc >= NCTX / 32) {
        f32x16 att;
#pragma unroll
        for (int j = 0; j < 16; ++j) att[j] = 0.f;
        const bf16* krow = Kp + cperm * 136 + hh * 8; const bf16* qrow = Qp + l32 * 136 + hh * 8;
#pragma unroll
        for (int ks = 0; ks < 8; ++ks) att = MFMA32(*(const bf16x8*)(krow + ks * 16), *(const bf16x8*)(qrow + ks * 16), att);
#pragma unroll
        for (int j = 0; j < 16; ++j) { const int sa = 16 * (j >> 3) + 8 * hh + 4 * ((j >> 2) & 1) + (j & 3); const bool keep = DIR == 0 ? (sa <= l32) : (sa >= l32); att[j] = keep ? att[j] : 0.f; }
        const bf16x8 p0 = pack8(att, 0), p1 = pack8(att, 8);
        f32x16 o;
#pragma unroll
        for (int j = 0; j < 16; ++j) o[j] = 0.f;
        o = MFMA32(vf0, p0, o); o = MFMA32(vf1, p1, o);
#pragma unroll
        for (int d = 0; d < 4; ++d) { o = MFMA32(pack8(S[d], 0), *(const bf16x8*)(qrow + d * 32), o); o = MFMA32(pack8(S[d], 8), *(const bf16x8*)(qrow + d * 32 + 16), o); }
        bf16* op = OUT + (row0 + l32) * D + h * 128 + eb * 32 + 4 * hh;
#pragma unroll
        for (int jq = 0; jq < 4; ++jq) { u32x2 w; w.x = pkbf(o[4 * jq], o[4 * jq + 1]); w.y = pkbf(o[4 * jq + 2], o[4 * jq + 3]); *(u32x2*)(op + 8 * jq) = w; }
        }
#pragma unroll
        for (int d = 0; d < 4; ++d) { S[d] = MFMA32(kf[d][0], vf0, S[d]); S[d] = MFMA32(kf[d][1], vf1, S[d]); }
#pragma unroll
        for (int j = 0; j < 16; ++j) { const int rho = (j & 3) + 8 * (j >> 2) + 4 * hh; const f32x4 e4 = *(const f32x4*)(egl + 4 * rho);
            S[0][j] *= e4.x; S[1][j] *= e4.y; S[2][j] *= e4.z; S[3][j] *= e4.w; }
    }
#undef HG_LOAD
#undef HG_CHUNK
}
__device__ __forceinline__ void ph_hgrn_scan(const Frame& F) {
    for (int id = F.bid * NWAVES + F.wave; id < NB * 8 * 8; id += F.nb * NWAVES) {
        const int eb = id & 3, dir = (id >> 2) & 1, h = (id >> 3) & 7, b = id >> 6;
        if (dir == 0) hgrn_seq<0>(F, b, h, eb); else hgrn_seq<1>(F, b, h, eb);
    }
}
__device__ __forceinline__ void ph_hgrn_post(const Frame& F) {
    const bf16* ZIN = (const bf16*)(F.ws + WS_ZIN); const bf16* OFF = (const bf16*)(F.ws + WS_OFF); const bf16* OFB = (const bf16*)(F.ws + WS_OFB); bf16* O2 = (bf16*)(F.ws + WS_O2);
    const int lane = F.lane, part = lane & 7;
    f32x4 gn[4];
#pragma unroll
    for (int q = 0; q < 4; ++q) gn[q] = *(const f32x4*)(F.in[26] + part * 16 + q * 4);
    for (int row = F.bid * NWAVES + F.wave; row < R; row += F.nb * NWAVES) {
        if (row % P < NCTX) continue;
        const size_t o = (size_t)row * D + lane * 16;
        const u32x4 a0 = *(const u32x4*)(OFF + o), a1 = *(const u32x4*)(OFF + o + 8), b0 = *(const u32x4*)(OFB + o), b1 = *(const u32x4*)(OFB + o + 8);
        const u32x4 g0 = *(const u32x4*)(ZIN + (size_t)row * 4096 + 3 * D + lane * 16), g1 = *(const u32x4*)(ZIN + (size_t)row * 4096 + 3 * D + lane * 16 + 8);
        float v[16];
        v[0] = bflo(a0.x) + bflo(b0.x); v[1] = bfhi(a0.x) + bfhi(b0.x); v[2] = bflo(a0.y) + bflo(b0.y); v[3] = bfhi(a0.y) + bfhi(b0.y);
        v[4] = bflo(a0.z) + bflo(b0.z); v[5] = bfhi(a0.z) + bfhi(b0.z); v[6] = bflo(a0.w) + bflo(b0.w); v[7] = bfhi(a0.w) + bfhi(b0.w);
        v[8] = bflo(a1.x) + bflo(b1.x); v[9] = bfhi(a1.x) + bfhi(b1.x); v[10] = bflo(a1.y) + bflo(b1.y); v[11] = bfhi(a1.y) + bfhi(b1.y);
        v[12] = bflo(a1.z) + bflo(b1.z); v[13] = bfhi(a1.z) + bfhi(b1.z); v[14] = bflo(a1.w) + bflo(b1.w); v[15] = bfhi(a1.w) + bfhi(b1.w);
        float ss = 0.f;
#pragma unroll
        for (int q = 0; q < 16; ++q) ss += v[q] * v[q];
        ss += dpp_xor1(ss); ss += dpp_xor2(ss); ss += __shfl_xor(ss, 4);
        const float rinv = rsqrtf(ss * (1.0f / 128.0f) + EPS);
        const unsigned gw[8] = {g0.x, g0.y, g0.z, g0.w, g1.x, g1.y, g1.z, g1.w};
        unsigned w[8];
#pragma unroll
        for (int q = 0; q < 8; ++q) w[q] = pkbf(v[2 * q] * rinv * gn[q >> 1][(2 * q) & 3] * bflo(gw[q]), v[2 * q + 1] * rinv * gn[q >> 1][(2 * q + 1) & 3] * bfhi(gw[q]));
        *(u32x4*)(O2 + o) = (u32x4){w[0], w[1], w[2], w[3]}; *(u32x4*)(O2 + o + 8) = (u32x4){w[4], w[5], w[6], w[7]};
    }
}

enum { PH_BASE = __COUNTER__ };
__global__ void __launch_bounds__(NTHREADS, 2) fwd(Args args) {
    extern __shared__ __attribute__((aligned(16))) unsigned char lds[];
    Frame F;
    F.lds = lds; F.wave = __builtin_amdgcn_readfirstlane((int)threadIdx.x >> 6); F.bid = blockIdx.x; F.nb = gridDim.x;
    REFRESH_(F);
    F.in = args.in; F.out = args.out; F.ws = args.ws;
    F.MOD = (float*)(args.ws + WS_MOD); F.AFF = (float*)(args.ws + WS_AFF); F.SEL = (int*)(args.ws + WS_SEL); F.GATE = (float*)(args.ws + WS_GATE); F.INV = (int*)(args.ws + WS_INV);
    F.X = (bf16*)(args.ws + WS_X); F.H = (bf16*)(args.ws + WS_H);
    const int lo = args.ph_lo, hi = args.ph_hi;
#if MK_SINGLE
    volatile LAS unsigned* misc = (volatile LAS unsigned*)((LAS unsigned char*)lds + LDS_MISC);
    if (F.tid < 64) misc[F.tid] = 0u;
    __syncthreads();
    XcdBarrier bar = xcd_barrier_post((unsigned*)(args.ws + WS_CTL) + CW_BAR, misc, F.tid);
#define SEAM(k) do { if ((k) + 1 < hi) xcd_barrier(bar, F.tid); } while (0)
#else
#define SEAM(k) do { } while (0)
#endif
#define PH(...) do { constexpr int k_ = __COUNTER__ - PH_BASE - 1; if (lo <= k_ && k_ < hi) { REFRESH_(F); __VA_ARGS__; SEAM(k_); } } while (0)
    bf16* HID = (bf16*)(F.ws + WS_HID); bf16* Y = (bf16*)(F.ws + WS_Y);
    PG8_LAS unsigned char* ring = (PG8_LAS unsigned char*)lds;
    bf16 *Qb = (bf16*)(F.ws + WS_Q), *VTb = (bf16*)(F.ws + WS_VT), *Ob = (bf16*)(F.ws + WS_O);

#define GEMM_PHASE(EPI, gA, lda_, gB, ldb_, gK, nM_, nN_, groups_, gsM_, ...) do { const pg8::Gemm g_{(const bf16*)(gA), (const bf16*)(gB), (lda_), (ldb_), (gK), nullptr}; pg8::GroupedOrder S_; S_.init((nM_), (nN_), (groups_), (gsM_), F.nb, F.bid); \
        const EPI E_{__VA_ARGS__}; pg8::gemm_phase<EPI, pg8::GroupedOrder, PG8_ALIGN, PG8_SP2>(ring, g_, S_, E_, F.tid); } while (0)
#define GEMM_PHASE_LAT(EPI, gA, lda_, gB, ldb_, gK, nN_, ...) do { const pg8::Gemm g_{(const bf16*)(gA), (const bf16*)(gB), (lda_), (ldb_), (gK), nullptr}; pg8::LatentOrder S_; S_.init((nN_), F.nb, F.bid); \
        const EPI E_{__VA_ARGS__}; pg8::gemm_phase<EPI, pg8::LatentOrder, PG8_ALIGN, PG8_SP2>(ring, g_, S_, E_, F.tid); } while (0)
#define GEMM_PHASE_GATHER(EPI, gA, lda_, gIdx, gB, ldb_, gK, nM_, nN_, groups_, gsM_, ...) do { const pg8::Gemm g_{(const bf16*)(gA), (const bf16*)(gB), (lda_), (ldb_), (gK), (gIdx)}; pg8::GroupedOrder S_; S_.init((nM_), (nN_), (groups_), (gsM_), F.nb, F.bid); \
        const EPI E_{__VA_ARGS__}; pg8::gemm_phase<EPI, pg8::GroupedOrder, PG8_ALIGN, PG8_SP2, true>(ring, g_, S_, E_, F.tid); } while (0)
#define MODL(L) (F.MOD + (size_t)(L) * 33 * 6144)
#define MOE_PHASES(L, NMT, NITEMS, SKIPC) \
    PH(ph_norm2<SKIPC>(F, (L))); \
    PH(ph_topk(F, (NITEMS))); \
    PH(GEMM_PHASE_GATHER(pg8::EpiSwigluT, F.H, D, F.SEL, F.ws + WO_GU, D, D, (NMT), 2 * FF / 256, NE, SLOTS / 256, HID, 2 * FF / 256, FF)); \
    PH(GEMM_PHASE(pg8::EpiDownT, HID, FF, F.ws + WO_DN, FF, FF, (NMT), D / 256, NE, SLOTS / 256, Y, F.GATE, D / 256));
#define OUT_PROJ(Asrc, Wsrc, L) PH(GEMM_PHASE(pg8::EpiResidT, (Asrc), D, (Wsrc), D, D, R / 256, D / 256, 1, R / 256, F.X, MODL(L)));

    PH(ph_prologue(F));
    PH(ph_norm<0, false, true, false, true>(F, 0, 0));
    PH(GEMM_PHASE(pg8::EpiF32G, F.ws + WS_AG, 768, F.ws + WS_S5W1, 512, 512, 2304 / 256, 1, 64, 2304 / 256, (float*)(F.ws + WS_SS), 256, 1));
    PH(ph_s5_scan(F));
    PH(GEMM_PHASE(pg8::EpiS5Out, F.ws + WS_AG, 768, F.ws + WS_S5W2, 768, 768, 2304 / 256, 2, 64, 2304 / 256, F.H, (bf16*)(F.ws + WS_Z), F.in[15]));
    PH(GEMM_PHASE(pg8::EpiGluT, F.ws + WS_Z, D, F.ws + WO_GLU, D, D, R / 256, 2 * D / 256, 1, R / 256, F.X, MODL(0)));
    MOE_PHASES(0, SLOTS / 256, NB * NE * 2, false)
    PH(ph_norm<0, true>(F, 1, 0); convert_moe(F, 1));
    PH(GEMM_PHASE(pg8::EpiBf16<0>, F.H, D, F.ws + WO_NAQKV, D, D, R / 256, 2 * D / 256, 1, R / 256, Qb, D, nullptr, D, (size_t)(WS_K - WS_Q) / 2, 1.0f);
       GEMM_PHASE(pg8::EpiVtT<false>, F.ws + WO_NAQKV + (size_t)2 * D * D * 2, D, F.H, D, D, D / 256, R / 256, 1, D / 256, VTb));
    PH(ph_na_attn(F));
    OUT_PROJ(Ob, F.ws + WO_NAO, 1)
    MOE_PHASES(1, SLOTS / 256, NB * NE * 2, false)
    PH(ph_norm<0, true>(F, 2, 1); convert_moe(F, 2));
    PH(GEMM_PHASE(pg8::EpiQKRope, F.H, D, F.ws + WO_DAQKV, D, D, R / 256, 2 * D / 256, 1, R / 256, Qb, (size_t)(WS_K - WS_Q) / 2, (const float*)(F.ws + WS_ROPE));
       GEMM_PHASE(pg8::EpiVtT<false>, F.ws + WO_DAQKV + (size_t)2 * D * D * 2, D, F.H, D, D, D / 256, R / 256, 1, D / 256, VTb));
    PH(ph_da_attn(F));
    OUT_PROJ(Ob, F.ws + WO_DAO, 2)
    MOE_PHASES(2, SLOTS / 256, NB * NE * 2, false)
    PH(ph_norm<0, true>(F, 3, 2); convert_moe(F, 3));
    PH({ const pg8::Gemm g_{(const bf16*)F.H, (const bf16*)(F.ws + WO_HGIN), D, D, D, nullptr}; pg8::HgInOrder S_; S_.init(F.nb, F.bid);
         const pg8::EpiHgIn E_{(bf16*)(F.ws + WS_ZIN), (const float*)(F.ws + WS_LB)}; pg8::gemm_phase<pg8::EpiHgIn, pg8::HgInOrder, PG8_ALIGN, PG8_SP2>(ring, g_, S_, E_, F.tid); }
       GEMM_PHASE(pg8::EpiVtT<true>, F.ws + WO_HGIN + (size_t)4 * D * D * 2, D, F.H, D, D, D / 256, R / 256, 1, D / 256, (bf16*)(F.ws + WS_VTG)));
    PH(ph_hgrn_scan(F));
    PH(ph_hgrn_post(F));
    PH(GEMM_PHASE_LAT(pg8::EpiResidT, F.ws + WS_O2, D, F.ws + WO_HGO, D, D, D / 256, F.X, MODL(3)));
    MOE_PHASES(3, NB, NB * NE, true)
    PH(ph_norm<2, true, false, true>(F, 0, 3));
}
constexpr int NPH = __COUNTER__ - PH_BASE - 1;

extern "C" void kernel_launch(void* const* d_in, const int* in_sizes, int n_in, void* d_out, int out_size, void* d_ws, size_t ws_size, hipStream_t stream) {
    static int grid = 0;
    if (grid == 0) {
        if (n_in != 33 || ws_size < WS_NEED) { fprintf(stderr, "kernel_launch: n_in %d ws %zu (need %zu)\n", n_in, ws_size, (size_t)WS_NEED); grid = -1; return; }
        int dev = 0, cus = 0;
        if (hipGetDevice(&dev) != hipSuccess || hipDeviceGetAttribute(&cus, hipDeviceAttributeMultiprocessorCount, dev) != hipSuccess) { grid = -1; return; }
        if (hipFuncSetAttribute((const void*)fwd, hipFuncAttributeMaxDynamicSharedMemorySize, LDS_BYTES) != hipSuccess) { fprintf(stderr, "kernel_launch: hipFuncSetAttribute failed\n"); grid = -1; return; }
        int per_cu = 0;
        if (hipOccupancyMaxActiveBlocksPerMultiprocessor(&per_cu, (const void*)fwd, NTHREADS, LDS_BYTES) != hipSuccess || per_cu < 1) fprintf(stderr, "kernel_launch: occupancy query says %d\n", per_cu);
        (void)hipGetLastError();
        grid = cus;
    }
    if (grid < 0) return;
    (void)hipMemsetAsync((char*)d_ws + WS_CTL + (size_t)CW_BAR * 4, 0, (size_t)XCD_BAR_WORDS * 4, stream);
    Args a{};
    for (int i = 0; i < 33; ++i) a.in[i] = (const float*)d_in[i];
    a.out = (float*)d_out; a.ws = (unsigned char*)d_ws;
#if MK_SINGLE
    a.ph_lo = 0; a.ph_hi = NPH;
    hipLaunchKernelGGL(fwd, dim3(grid), dim3(NTHREADS), LDS_BYTES, stream, a);
#else
    for (int k = 0; k < NPH; ++k) { a.ph_lo = k; a.ph_hi = k + 1; hipLaunchKernelGGL(fwd, dim3(grid), dim3(NTHREADS), LDS_BYTES, stream, a); }
#endif
}
```

```cpp
#include <hip/hip_runtime.h>
#include <cstdio>
#include <cstdint>

#ifndef MK_SINGLE
#define MK_SINGLE 1
#endif

typedef unsigned short bf16;
typedef float f32x4 __attribute__((ext_vector_type(4)));
typedef float f32x2 __attribute__((ext_vector_type(2)));
typedef unsigned u32x2 __attribute__((ext_vector_type(2)));
typedef unsigned u32x4 __attribute__((ext_vector_type(4)));
#define LAS __attribute__((address_space(3)))

constexpr int NB = 32, SEQ = 2048, NCTX = 256, D = 1024, P = NCTX + SEQ  , R = NB * P  ;
constexpr int NE = 16, FF = 2048, SLOTS = NB * 256 + NB * 32  ;
constexpr float EPS = 1e-6f;
constexpr float LOG2E_ = 1.4426950408889634f;
constexpr float LAM_INIT = 0.47071302f;
constexpr int NWAVES = 8, NTHREADS = 512;
constexpr int LDS_BYTES = 147456;
constexpr int LDS_MISC = 147456 - 256;

constexpr size_t MiB = 1u << 20;
constexpr size_t WS_CTL = 0, CTL_ZERO_BYTES = 1 * MiB;
constexpr size_t WS_MOD = 1 * MiB;
constexpr size_t WS_AFF = 5 * MiB;
constexpr size_t WS_SEL = 10 * MiB;
constexpr size_t WS_GATE = 11 * MiB;
constexpr size_t WS_INV = 12 * MiB;
constexpr size_t WS_X = 32 * MiB;
constexpr size_t WS_H = 320 * MiB;
constexpr size_t WS_W = 464 * MiB;
constexpr size_t WS_BIG = 720 * MiB;
constexpr size_t WS_HID = WS_BIG;
constexpr size_t WS_Y = WS_BIG + 576 * MiB;
constexpr size_t WS_XS = WS_BIG + 864 * MiB;
constexpr size_t WS_AG = WS_BIG;
constexpr size_t WS_SS = WS_BIG + 216 * MiB;
constexpr size_t WS_Z = WS_BIG + 360 * MiB;
constexpr size_t WS_S5W1 = WS_BIG + 504 * MiB;
constexpr size_t WS_S5W2 = WS_BIG + 520 * MiB;
constexpr size_t WS_S5A = WS_BIG + 568 * MiB;
constexpr size_t WS_Q = WS_BIG, WS_K = WS_BIG + 144 * MiB, WS_V = WS_BIG + 288 * MiB, WS_VT = WS_BIG + 432 * MiB, WS_O = WS_BIG + 576 * MiB;
constexpr size_t WS_ZIN = WS_BIG;
constexpr size_t WS_VTG = WS_BIG + 576 * MiB;
constexpr size_t WS_OFF = WS_BIG + 720 * MiB;
constexpr size_t WS_OFB = WS_BIG + 1008 * MiB;
constexpr size_t WS_O2 = WS_H;
constexpr size_t WS_LB = 17 * MiB;
constexpr size_t WS_ROPE = 18 * MiB;
constexpr size_t WS_NEED = 2048 * MiB;
constexpr size_t WO_GLU = WS_W, WO_NAQKV = WS_W + 4 * MiB, WO_NAO = WS_W + 10 * MiB, WO_DAQKV = WS_W + 12 * MiB, WO_DAO = WS_W + 18 * MiB, WO_HGIN = WS_W + 20 * MiB, WO_HGO = WS_W + 30 * MiB;
constexpr size_t WO_GU = WS_W + 32 * MiB  , WO_DN = WS_W + 160 * MiB  ;
constexpr int CW_BAR = 4096;

__device__ __forceinline__ unsigned f2bf(float f) { unsigned u = __builtin_bit_cast(unsigned, f); return (u + 0x7fffu + ((u >> 16) & 1u)) >> 16; }
__device__ __forceinline__ float bf2f(unsigned h) { return __builtin_bit_cast(float, h << 16); }
__device__ __forceinline__ unsigned pk2(float lo, float hi) { return f2bf(lo) | (f2bf(hi) << 16); }
typedef __bf16 bf16x2_t __attribute__((ext_vector_type(2)));
__device__ __forceinline__ unsigned pkbf(float lo, float hi) { const f32x2 v = {lo, hi}; return __builtin_bit_cast(unsigned, __builtin_convertvector(v, bf16x2_t)); }
__device__ __forceinline__ float bflo(unsigned w) { return __builtin_bit_cast(float, w << 16); }
__device__ __forceinline__ float bfhi(unsigned w) { return __builtin_bit_cast(float, w & 0xffff0000u); }
__device__ __forceinline__ float wave_sum(float v) {
#pragma unroll
    for (int o = 1; o < 64; o <<= 1) v += __shfl_xor(v, o);
    return v;
}
__device__ __forceinline__ float wave_max(float v) {
#pragma unroll
    for (int o = 1; o < 64; o <<= 1) v = fmaxf(v, __shfl_xor(v, o));
    return v;
}
__device__ __forceinline__ float sigmoidf_(float x) { return 1.0f / (1.0f + expf(-x)); }
__device__ __forceinline__ float siluf_(float x) { return x / (1.0f + expf(-x)); }
__device__ __forceinline__ float gelu_tanh(float x) { return 0.5f * x * (1.0f + tanhf(0.7978845608028654f * (x + 0.044715f * x * x * x))); }
__device__ __forceinline__ float dpp_xor1(float v) { return __builtin_bit_cast(float, __builtin_amdgcn_update_dpp(0, __builtin_bit_cast(int, v), 0xB1, 0xF, 0xF, true)); }
__device__ __forceinline__ float dpp_xor2(float v) { return __builtin_bit_cast(float, __builtin_amdgcn_update_dpp(0, __builtin_bit_cast(int, v), 0x4E, 0xF, 0xF, true)); }
__device__ __forceinline__ float reduce16(float (&v)[16], int lane) {
    const bool b0 = lane & 1, b1 = lane & 2, b2 = lane & 4, b3 = lane & 8;
    float a[8];
#pragma unroll
    for (int k = 0; k < 8; ++k) { const float snd = b0 ? v[k] : v[8 + k], kep = b0 ? v[8 + k] : v[k]; a[k] = kep + dpp_xor1(snd); }
    float c[4];
#pragma unroll
    for (int k = 0; k < 4; ++k) { const float snd = b1 ? a[k] : a[4 + k], kep = b1 ? a[4 + k] : a[k]; c[k] = kep + dpp_xor2(snd); }
    float d[2];
#pragma unroll
    for (int k = 0; k < 2; ++k) { const float snd = b2 ? c[k] : c[2 + k], kep = b2 ? c[2 + k] : c[k]; d[k] = kep + __shfl_xor(snd, 4); }
    float r = (b3 ? d[1] : d[0]) + __shfl_xor(b3 ? d[0] : d[1], 8);
    r += __shfl_xor(r, 16); r += __shfl_xor(r, 32);
    return r;
}
#define WAVE_LDS_SYNC() asm volatile("s_waitcnt lgkmcnt(0)" ::: "memory")

#define XB_TMO      128
#define XB_XCNT(j)  (256  + 64 * (j))
#define XB_XSUB(j)  (1280 + 64 * (j))
#define XB_XGEN(j)  (2304 + 64 * (j))
#define XB_TOP      3328
#define XB_TOPGEN   3392
#define XCD_BAR_WORDS 3456
#define XB_SPIN_CAP (1u << 27)
__device__ __forceinline__ unsigned xb_ld(unsigned* p)              { return __hip_atomic_load(p, __ATOMIC_RELAXED, __HIP_MEMORY_SCOPE_AGENT); }
__device__ __forceinline__ unsigned xb_add(unsigned* p, unsigned v) { return __hip_atomic_fetch_add(p, v, __ATOMIC_RELAXED, __HIP_MEMORY_SCOPE_AGENT); }
__device__ __forceinline__ unsigned xb_xcc_id() { return (unsigned)__builtin_amdgcn_s_getreg((3 << 11) | 20) & 0xFu; }
#define XB_SPIN(cond, bar) do { unsigned _sp = 0; while (cond) { __builtin_amdgcn_s_sleep(1); \
    if ((++_sp & 255u) == 0u) { if (xb_ld(&(bar)[XB_TMO])) break; if (_sp > XB_SPIN_CAP) { atomicAdd(&(bar)[XB_TMO], 1u); break; } } } } while (0)
struct XcdBarrier { unsigned* bar; unsigned x; volatile LAS unsigned* st; };
__device__ __forceinline__ XcdBarrier xcd_barrier_post(unsigned* bar, volatile LAS unsigned* st, int tid_) {
    XcdBarrier b; b.bar = bar; b.x = xb_xcc_id(); b.st = st;
    if (tid_ == 0) (void)xb_add(&bar[XB_XCNT(b.x)], 1u);
    return b;
}
__device__ __forceinline__ void xcd_barrier_complete(unsigned* bar, unsigned x, unsigned& nloc, unsigned& nx) {
    const unsigned G = gridDim.x * gridDim.y * gridDim.z;
    unsigned sum, cnt, mine, sp = 0u;
    for (;;) {
        sum = 0u; cnt = 0u; mine = 0u;
#pragma unroll
        for (unsigned j = 0; j < 16; ++j) { const unsigned c = xb_ld(&bar[XB_XCNT(j)]); sum += c; cnt += (c > 0u) ? 1u : 0u; mine = (j == x) ? c : mine; }
        if (sum == G) break;
        __builtin_amdgcn_s_sleep(1);
        if ((++sp & 255u) == 0u) { if (xb_ld(&bar[XB_TMO])) break; if (sp > XB_SPIN_CAP) { atomicAdd(&bar[XB_TMO], 1u); break; } }
    }
    nloc = mine > 0u ? mine : 1u; nx = cnt > 0u ? cnt : 1u;
}
__device__ __forceinline__ void xcd_barrier(const XcdBarrier& b, int tid_) {
    asm volatile("s_waitcnt vmcnt(0)" ::: "memory");
    __syncthreads();
    if (tid_ == 0) {
        unsigned* bar = b.bar;
        __builtin_amdgcn_s_waitcnt(0);
        unsigned nloc = b.st[0], nx = b.st[1];
        if (nloc == 0u) { xcd_barrier_complete(bar, b.x, nloc, nx); b.st[0] = nloc; b.st[1] = nx; }
        const unsigned old = xb_add(&bar[XB_XSUB(b.x)], 1u);
        const unsigned gen = old / nloc;
        if (old + 1u == (gen + 1u) * nloc) {
            __builtin_amdgcn_fence(__ATOMIC_RELEASE, "agent");
            asm volatile("s_waitcnt vmcnt(0)" ::: "memory");
            const unsigned og = xb_add(&bar[XB_TOP], 1u);
            const unsigned tg = og / nx;
            if (og + 1u == (tg + 1u) * nx) xb_add(&bar[XB_TOPGEN], 1u);
            else XB_SPIN(xb_ld(&bar[XB_TOPGEN]) == tg, bar);
            __builtin_amdgcn_fence(__ATOMIC_ACQUIRE, "agent");
            xb_add(&bar[XB_XGEN(b.x)], 1u);
            asm volatile("s_waitcnt vmcnt(0)" ::: "memory");
        } else {
            XB_SPIN(xb_ld(&bar[XB_XGEN(b.x)]) == gen, bar);
            __builtin_amdgcn_fence(__ATOMIC_ACQUIRE, "agent");
            asm volatile("s_waitcnt vmcnt(0)" ::: "memory");
        }
    }
    __syncthreads();
}

namespace pg8 {
#define PG8_LAS __attribute__((address_space(3)))
typedef unsigned short bf16_t;
typedef short bf16x8 __attribute__((ext_vector_type(8)));
typedef float f32x4 __attribute__((ext_vector_type(4)));
typedef unsigned u32x4 __attribute__((ext_vector_type(4)));
constexpr int BM = 256, BK = 64, HALF = 128, HTB = HALF * BK * 2  , STAGE_BYTES = 8 * HTB, NXCD = 8, WGM = 8;

__host__ __device__ __forceinline__ int lds_byte(int r, int c) { const int st = (r >> 4) * 2 + (c >> 5), rr = r & 15, cc = c & 31, ob = rr * 64 + cc * 2; return st * 1024 + (ob ^ (((ob >> 9) & 1) << 5)); }
__host__ __device__ __forceinline__ void stage_rc(int b, int& R, int& C) { const int st = b / 1024, sb = b % 1024, swz = sb ^ (((sb >> 9) & 1) << 5); R = (st >> 1) * 16 + swz / 64; C = (st & 1) * 32 + (swz % 64) / 2; }
__host__ __device__ __forceinline__ int perm32(int rho) { const int n = rho >> 4, i = rho & 15; return 8 * (i >> 2) + 4 * n + (i & 3); }

struct Unit { int pm, pn; };
struct Gemm { const bf16_t* A; const bf16_t* Bt; int lda, ldb, K; const int* rowidx; };

struct StaticOrder {
    int nM, nN, nwg, G, c;
    __host__ __device__ void init(int M, int N, int G_, int c_) { nM = M / BM; nN = N / BM; nwg = nM * nN; G = G_; c = c_; }
    __host__ __device__ bool next(int i, Unit& u) const {
        const long L = (long)i * G + c; if (L >= nwg) return false;
        int wgid = (int)L; { const int q = nwg / NXCD, r = nwg % NXCD, xcd = wgid % NXCD, off = wgid / NXCD; wgid = (xcd < r ? xcd * (q + 1) : r * (q + 1) + (xcd - r) * q) + off; }
        const int nig = WGM * nN, gid = wgid / nig, fm = gid * WGM, gsz = (nM - fm) < WGM ? (nM - fm) : WGM;
        u.pm = fm + ((wgid % nig) % gsz); u.pn = (wgid % nig) / gsz; return true;
    }
    __device__ __forceinline__ void a_ready(const Unit&) const {}
    __device__ __forceinline__ void done(const Unit&) const {}
};

__device__ __forceinline__ unsigned cvt_pk_bf16(float lo, float hi) { unsigned r; asm volatile("v_cvt_pk_bf16_f32 %0, %1, %2" : "=v"(r) : "v"(lo), "v"(hi)); return r; }
typedef float f32x2 __attribute__((ext_vector_type(2)));
__device__ __forceinline__ f32x2 gelu_pk(f32x2 v) {
    const f32x2 av = __builtin_elementwise_abs(v), d = av * 0.2316418882f + 1.0f;
    f32x2 t; t.x = __builtin_amdgcn_rcpf(d.x); t.y = __builtin_amdgcn_rcpf(d.y);
    f32x2 q = t * 0.5307027145f + (-0.7265760135f); q = q * t + 0.7107068705f; q = q * t + (-0.142248368f); q = q * t + 0.127414796f; q = q * t;
    const f32x2 s = (v * v) * (-0.72134752044f);
    f32x2 e; e.x = __builtin_amdgcn_exp2f(s.x); e.y = __builtin_amdgcn_exp2f(s.y);
    const f32x2 m = v * (q * e), r = v - m;
    f32x2 o; o.x = v.x < 0.f ? m.x : r.x; o.y = v.y < 0.f ? m.y : r.y; return o;
}

template <int ACT  > struct EpiBf16 {
    static constexpr bool PERM = true, AFTER_DRAIN = false; static_assert(ACT == 0 || ACT == 1, "EpiBf16: ACT is 0 (none) or 1 (gelu_pk)");
    bf16_t* O; int ldc; const float* bias; int split_cols; size_t split_stride; float scale0;
    __device__ __forceinline__ void operator()(const f32x4 (&acc)[2][2][4][2], const Unit& u, int wr, int wc, int fr, int fq) const {
        const int row0 = u.pm * BM + wr * 64 + fr; int colt = u.pn * BM; bf16_t* base = O;
        float sc = 1.f; if (split_cols) { const int t = colt / split_cols; base += (size_t)t * split_stride; colt -= t * split_cols; if (t == 0) sc = scale0; }
        const int col0 = colt + wc * 32 + 8 * fq, bcol0 = u.pn * BM + wc * 32 + 8 * fq;
        f32x4 bv[2][2];
#pragma unroll
        for (int bj = 0; bj < 2; ++bj)
#pragma unroll
            for (int n = 0; n < 2; ++n) bv[bj][n] = bias ? *(const f32x4*)(bias + bcol0 + bj * HALF + 4 * n) : (f32x4){0.f, 0.f, 0.f, 0.f};
#pragma unroll
        for (int ai = 0; ai < 2; ++ai)
#pragma unroll
            for (int m = 0; m < 4; ++m) { bf16_t* rowp = base + (size_t)(row0 + ai * HALF + m * 16) * ldc + col0;
#pragma unroll
                for (int bj = 0; bj < 2; ++bj) { f32x4 v0 = acc[ai][bj][m][0] + bv[bj][0], v1 = acc[ai][bj][m][1] + bv[bj][1];
                    if (ACT == 1) { f32x2 a = gelu_pk((f32x2){v0[0], v0[1]}), b = gelu_pk((f32x2){v0[2], v0[3]}), c = gelu_pk((f32x2){v1[0], v1[1]}), d = gelu_pk((f32x2){v1[2], v1[3]});
                        v0 = (f32x4){a.x, a.y, b.x, b.y}; v1 = (f32x4){c.x, c.y, d.x, d.y}; }
                    v0 = v0 * sc; v1 = v1 * sc; u32x4 w; w.x = cvt_pk_bf16(v0[0], v0[1]); w.y = cvt_pk_bf16(v0[2], v0[3]); w.z = cvt_pk_bf16(v1[0], v1[1]); w.w = cvt_pk_bf16(v1[2], v1[3]);
                    *(u32x4*)(rowp + bj * HALF) = w; } }
    }
};


struct GroupedOrder {
    int nM, nN, groups, gsM, G, c, total;
    __host__ __device__ void init(int nM_, int nN_, int groups_, int gsM_, int G_, int c_) { nM = nM_; nN = nN_; groups = groups_; gsM = gsM_; G = G_; c = c_; total = nM * nN * groups; }
    __host__ __device__ bool next(int i, Unit& u) const {
        const long L = (long)i * G + c; if (L >= total) return false;
        int T = (int)L; { const int q = total / NXCD, r = total % NXCD, xcd = T % NXCD, off = T / NXCD; T = (xcd < r ? xcd * (q + 1) : r * (q + 1) + (xcd - r) * q) + off; }
        const int tpg = nM * nN, g = T / tpg, t = T - g * tpg;
        const int nig = WGM * nN, gid = t / nig, fm = gid * WGM, gsz = (nM - fm) < WGM ? (nM - fm) : WGM;
        u.pm = g * gsM + fm + ((t % nig) % gsz); u.pn = g * nN + (t % nig) / gsz; return true;
    }
    __device__ __forceinline__ void a_ready(const Unit&) const {}
    __device__ __forceinline__ void done(const Unit&) const {}
};
struct LatentOrder {
    GroupedOrder o;
    __host__ __device__ void init(int nN_, int G_, int c_) { o.init(256, nN_, 1, 256, G_, c_); }
    __host__ __device__ bool next(int i, Unit& u) const { if (!o.next(i, u)) return false; u.pm += (u.pm >> 3) + 1; return true; }
    __device__ __forceinline__ void a_ready(const Unit&) const {}
    __device__ __forceinline__ void done(const Unit&) const {}
};
__device__ __forceinline__ float sigm(float x) { return __builtin_amdgcn_rcpf(1.0f + __builtin_amdgcn_exp2f(x * -1.4426950408889634f)); }
constexpr int PP = 2304, DD = 1024;
__device__ __forceinline__ int mrow_of(int row) { const int b = row / PP, pos = row - b * PP; return pos < 256 ? 32 : b; }
struct EpiResidT {
    static constexpr bool PERM = false, AFTER_DRAIN = false;
    bf16_t* X; const float* MODL;
    __device__ __forceinline__ void operator()(const f32x4 (&acc)[2][2][4][2], const Unit& u, int wr, int wc, int fr, int fq) const {
        const int row0 = u.pm * BM + wr * 64 + fr, col0 = u.pn * BM + wc * 32 + 4 * fq;
#pragma unroll
        for (int ai = 0; ai < 2; ++ai)
#pragma unroll
            for (int m = 0; m < 4; ++m) { const int row = row0 + ai * HALF + m * 16; bf16_t* x = X + (size_t)row * DD + col0; const float* g = MODL + (size_t)mrow_of(row) * 6144 + 2 * DD + col0;
                u32x2 xo[2][2];
#pragma unroll
                for (int bj = 0; bj < 2; ++bj)
#pragma unroll
                    for (int n = 0; n < 2; ++n) xo[bj][n] = *(const u32x2*)(x + bj * HALF + n * 16);
#pragma unroll
                for (int bj = 0; bj < 2; ++bj)
#pragma unroll
                    for (int n = 0; n < 2; ++n) { const int o = bj * HALF + n * 16; const f32x4 xv = {bflo(xo[bj][n].x), bfhi(xo[bj][n].x), bflo(xo[bj][n].y), bfhi(xo[bj][n].y)};
                        const f32x4 r = xv + *(const f32x4*)(g + o) * acc[ai][bj][m][n]; u32x2 w; w.x = pkbf(r.x, r.y); w.y = pkbf(r.z, r.w); *(u32x2*)(x + o) = w; } }
    }
};
struct EpiGluT {
    static constexpr bool PERM = true, AFTER_DRAIN = false;
    bf16_t* X; const float* MODL;
    __device__ __forceinline__ void operator()(const f32x4 (&acc)[2][2][4][2], const Unit& u, int wr, int wc, int fr, int fq) const {
        const int row0 = u.pm * BM + wr * 64 + fr, f0 = u.pn * 128 + wc * 32 + 8 * fq;
#pragma unroll
        for (int ai = 0; ai < 2; ++ai)
#pragma unroll
            for (int m = 0; m < 4; ++m) { const int row = row0 + ai * HALF + m * 16; bf16_t* x = X + (size_t)row * DD + f0; const float* g = MODL + (size_t)mrow_of(row) * 6144 + 2 * DD + f0;
                const u32x4 xo = *(const u32x4*)x; u32x4 w;
#pragma unroll
                for (int n = 0; n < 2; ++n) { const f32x4 a = acc[ai][0][m][n], b = acc[ai][1][m][n]; f32x4 v = b * -1.4426950408889634f;
#pragma unroll
                    for (int q = 0; q < 4; ++q) v[q] = __builtin_amdgcn_exp2f(v[q]);
                    v = v + 1.0f;
#pragma unroll
                    for (int q = 0; q < 4; ++q) v[q] = __builtin_amdgcn_rcpf(v[q]);
                    v = v * a;
                    const unsigned x01 = n ? xo.z : xo.x, x23 = n ? xo.w : xo.y; const f32x4 xv = {bflo(x01), bfhi(x01), bflo(x23), bfhi(x23)};
                    const f32x4 r = xv + *(const f32x4*)(g + 4 * n) * v; if (n) { w.z = pkbf(r.x, r.y); w.w = pkbf(r.z, r.w); } else { w.x = pkbf(r.x, r.y); w.y = pkbf(r.z, r.w); } }
                *(u32x4*)x = w; }
    }
};
struct EpiSwigluT {
    static constexpr bool PERM = true, AFTER_DRAIN = false;
    bf16_t* HID; int nNg; int ldh;
    __device__ __forceinline__ void operator()(const f32x4 (&acc)[2][2][4][2], const Unit& u, int wr, int wc, int fr, int fq) const {
        const int row0 = u.pm * BM + wr * 64 + fr, f0 = (u.pn % nNg) * 128 + wc * 32 + 8 * fq;
#pragma unroll
        for (int ai = 0; ai < 2; ++ai)
#pragma unroll
            for (int m = 0; m < 4; ++m) { bf16_t* hp = HID + (size_t)(row0 + ai * HALF + m * 16) * ldh + f0;
                const f32x4 a0 = acc[ai][0][m][0], a1 = acc[ai][0][m][1], b0 = acc[ai][1][m][0], b1 = acc[ai][1][m][1];
                f32x4 e0 = a0 * -1.4426950408889634f, e1 = a1 * -1.4426950408889634f;
#pragma unroll
                for (int q = 0; q < 4; ++q) { e0[q] = __builtin_amdgcn_exp2f(e0[q]); e1[q] = __builtin_amdgcn_exp2f(e1[q]); }
                e0 = e0 + 1.0f; e1 = e1 + 1.0f;
#pragma unroll
                for (int q = 0; q < 4; ++q) { e0[q] = __builtin_amdgcn_rcpf(e0[q]); e1[q] = __builtin_amdgcn_rcpf(e1[q]); }
                const f32x4 o0 = (a0 * b0) * e0, o1 = (a1 * b1) * e1;
                u32x4 w; w.x = cvt_pk_bf16(o0.x, o0.y); w.y = cvt_pk_bf16(o0.z, o0.w); w.z = cvt_pk_bf16(o1.x, o1.y); w.w = cvt_pk_bf16(o1.z, o1.w);
                *(u32x4*)hp = w; }
    }
};
struct EpiDownT {
    static constexpr bool PERM = true, AFTER_DRAIN = false;
    bf16_t* Y; const float* GATE; int nNg;
    __device__ __forceinline__ void operator()(const f32x4 (&acc)[2][2][4][2], const Unit& u, int wr, int wc, int fr, int fq) const {
        const int row0 = u.pm * BM + wr * 64 + fr, col0 = (u.pn % nNg) * BM + wc * 32 + 8 * fq;
#pragma unroll
        for (int ai = 0; ai < 2; ++ai)
#pragma unroll
            for (int m = 0; m < 4; ++m) { const int row = row0 + ai * HALF + m * 16; bf16_t* rowp = Y + (size_t)row * DD + col0;
#pragma unroll
                for (int bj = 0; bj < 2; ++bj) { const f32x4 v0 = acc[ai][bj][m][0], v1 = acc[ai][bj][m][1];
                    u32x4 w; w.x = cvt_pk_bf16(v0[0], v0[1]); w.y = cvt_pk_bf16(v0[2], v0[3]); w.z = cvt_pk_bf16(v1[0], v1[1]); w.w = cvt_pk_bf16(v1[2], v1[3]);
                    *(u32x4*)(rowp + bj * HALF) = w; } }
    }
};
template <bool SILU> struct EpiVtT {
    static constexpr bool PERM = true, AFTER_DRAIN = false;
    bf16_t* VT;
    __device__ __forceinline__ void operator()(const f32x4 (&acc)[2][2][4][2], const Unit& u, int wr, int wc, int fr, int fq) const {
        const int hd0 = u.pm * BM + wr * 64 + fr, tok0 = u.pn * BM + wc * 32 + 8 * fq, b = (u.pn * BM) / PP, pos0 = tok0 - b * PP;
#pragma unroll
        for (int ai = 0; ai < 2; ++ai)
#pragma unroll
            for (int m = 0; m < 4; ++m) { bf16_t* rowp = VT + ((size_t)b * DD + hd0 + ai * HALF + m * 16) * PP + pos0;
#pragma unroll
                for (int bj = 0; bj < 2; ++bj) { f32x4 v0 = acc[ai][bj][m][0], v1 = acc[ai][bj][m][1];
                    if (SILU) {
#pragma unroll
                        for (int q = 0; q < 4; ++q) { v0[q] = v0[q] * sigm(v0[q]); v1[q] = v1[q] * sigm(v1[q]); } }
                    u32x4 w; w.x = cvt_pk_bf16(v0[0], v0[1]); w.y = cvt_pk_bf16(v0[2], v0[3]); w.z = cvt_pk_bf16(v1[0], v1[1]); w.w = cvt_pk_bf16(v1[2], v1[3]);
                    *(u32x4*)(rowp + bj * HALF) = w; } }
    }
};
struct EpiHgIn {
    static constexpr bool PERM = true, AFTER_DRAIN = false;
    bf16_t* O; const float* LB;
    __device__ __forceinline__ void operator()(const f32x4 (&acc)[2][2][4][2], const Unit& u, int wr, int wc, int fr, int fq) const {
        const int row0 = u.pm * BM + wr * 64 + fr, col0 = u.pn * BM + wc * 32 + 8 * fq, type = u.pn >> 2;
#pragma unroll
        for (int ai = 0; ai < 2; ++ai)
#pragma unroll
            for (int m = 0; m < 4; ++m) { bf16_t* rowp = O + (size_t)(row0 + ai * HALF + m * 16) * 4096 + col0;
#pragma unroll
                for (int bj = 0; bj < 2; ++bj) { f32x4 v0 = acc[ai][bj][m][0], v1 = acc[ai][bj][m][1];
                    if (type == 1 || type == 2) { const int c = (col0 + bj * HALF) & 1023; const f32x4 l0 = *(const f32x4*)(LB + c), l1 = *(const f32x4*)(LB + c + 4);
#pragma unroll
                        for (int q = 0; q < 4; ++q) { v0[q] = __log2f(l0[q] + (1.0f - l0[q]) * sigm(v0[q])); v1[q] = __log2f(l1[q] + (1.0f - l1[q]) * sigm(v1[q])); } }
                    else if (type == 3) {
#pragma unroll
                        for (int q = 0; q < 4; ++q) { v0[q] = v0[q] * sigm(v0[q]); v1[q] = v1[q] * sigm(v1[q]); } }
                    u32x4 w; w.x = cvt_pk_bf16(v0[0], v0[1]); w.y = cvt_pk_bf16(v0[2], v0[3]); w.z = cvt_pk_bf16(v1[0], v1[1]); w.w = cvt_pk_bf16(v1[2], v1[3]);
                    *(u32x4*)(rowp + bj * HALF) = w; } }
    }
};


struct EpiF32G {
    static constexpr bool PERM = false, AFTER_DRAIN = false;
    float* C; int ldc; int nNg;
    __device__ __forceinline__ void operator()(const f32x4 (&acc)[2][2][4][2], const Unit& u, int wr, int wc, int fr, int fq) const {
        const int row0 = u.pm * BM + wr * 64 + fr, col0 = (u.pn % nNg) * BM + wc * 32 + 4 * fq;
#pragma unroll
        for (int ai = 0; ai < 2; ++ai)
#pragma unroll
            for (int m = 0; m < 4; ++m) { float* rowp = C + (size_t)(row0 + ai * HALF + m * 16) * ldc + col0;
#pragma unroll
                for (int bj = 0; bj < 2; ++bj)
#pragma unroll
                    for (int n = 0; n < 2; ++n) *(f32x4*)(rowp + bj * HALF + n * 16) = acc[ai][bj][m][n]; }
    }
};
__device__ __forceinline__ float gelu_t(float x) { const float t = 1.5957691216057308f * (x + 0.044715f * x * x * x); return x * sigm(t); }
struct EpiS5Out {
    static constexpr bool PERM = true, AFTER_DRAIN = false;
    const bf16_t* H; bf16_t* Z; const float* dvec;
    __device__ __forceinline__ void operator()(const f32x4 (&acc)[2][2][4][2], const Unit& u, int wr, int wc, int fr, int fq) const {
        const int c0 = (u.pn & 1) * BM + wc * 32 + 8 * fq;
#pragma unroll
        for (int ai = 0; ai < 2; ++ai)
#pragma unroll
            for (int m = 0; m < 4; ++m) {
                const int rg = u.pm * BM + ai * HALF + wr * 64 + m * 16 + fr, g = rg / 2304, rem = rg - g * 2304, b = rem / 72, j = rem - b * 72;
#pragma unroll
                for (int bj = 0; bj < 2; ++bj) {
                    const int mc = c0 + bj * HALF, tau = mc >> 4, k0 = mc & 15;
                    const size_t off = ((size_t)b * PP + 32 * j + tau) * DD + g * 16 + k0;
                    const u32x4 uw = *(const u32x4*)(H + off);
                    const f32x4 d0 = *(const f32x4*)(dvec + g * 16 + k0), d1 = *(const f32x4*)(dvec + g * 16 + k0 + 4);
                    const f32x4 y0 = acc[ai][bj][m][0], y1 = acc[ai][bj][m][1];
                    u32x4 w;
                    w.x = cvt_pk_bf16(gelu_t(y0[0] + d0[0] * __uint_as_float(uw.x << 16)), gelu_t(y0[1] + d0[1] * __uint_as_float(uw.x & 0xffff0000u)));
                    w.y = cvt_pk_bf16(gelu_t(y0[2] + d0[2] * __uint_as_float(uw.y << 16)), gelu_t(y0[3] + d0[3] * __uint_as_float(uw.y & 0xffff0000u)));
                    w.z = cvt_pk_bf16(gelu_t(y1[0] + d1[0] * __uint_as_float(uw.z << 16)), gelu_t(y1[1] + d1[1] * __uint_as_float(uw.z & 0xffff0000u)));
                    w.w = cvt_pk_bf16(gelu_t(y1[2] + d1[2] * __uint_as_float(uw.w << 16)), gelu_t(y1[3] + d1[3] * __uint_as_float(uw.w & 0xffff0000u)));
                    *(u32x4*)(Z + off) = w;
                }
            }
    }
};


struct EpiQKRope {
    static constexpr bool PERM = true, AFTER_DRAIN = false;
    bf16_t* Q; size_t kstride; const float* T;
    __device__ __forceinline__ void operator()(const f32x4 (&acc)[2][2][4][2], const Unit& u, int wr, int wc, int fr, int fq) const {
        const int row0 = u.pm * BM + wr * 64 + fr; int colt = u.pn * BM; bf16_t* base = Q;
        { const int t = colt / DD; base += (size_t)t * kstride; colt -= t * DD; }
        const int col0 = colt + wc * 32 + 8 * fq, half = wc & 1; const bool first = fq < 2;
        const float qs = u.pn * BM < DD ? 0.125f * 1.4426950408889634f : 1.0f;
#pragma unroll
        for (int ai = 0; ai < 2; ++ai)
#pragma unroll
            for (int m = 0; m < 4; ++m) { const int row = row0 + ai * HALF + m * 16, b = row / PP, pos = row - b * PP, tt = pos - 256; const bool lat = pos >= 256;
                const int p = lat ? (half ? (tt & 63) : (tt >> 6)) : 0;
                const f32x4* cs = (const f32x4*)(T + (p * 16 + 8 * (fq & 1)) * 2);
                const f32x4 t0 = cs[0], t1 = cs[1], t2 = cs[2], t3 = cs[3];
                bf16_t* rowp = base + (size_t)row * DD + col0;
#pragma unroll
                for (int bj = 0; bj < 2; ++bj) { f32x4 v0 = acc[ai][bj][m][0] * qs, v1 = acc[ai][bj][m][1] * qs;
                    f32x4 p0, p1;
#pragma unroll
                    for (int q = 0; q < 4; ++q) { p0[q] = __shfl_xor(v0[q], 32); p1[q] = __shfl_xor(v1[q], 32); }
                    if (lat) { const float sg = first ? -1.0f : 1.0f;
                        v0 = (f32x4){v0[0] * t0[0] + sg * p0[0] * t0[1], v0[1] * t0[2] + sg * p0[1] * t0[3], v0[2] * t1[0] + sg * p0[2] * t1[1], v0[3] * t1[2] + sg * p0[3] * t1[3]};
                        v1 = (f32x4){v1[0] * t2[0] + sg * p1[0] * t2[1], v1[1] * t2[2] + sg * p1[1] * t2[3], v1[2] * t3[0] + sg * p1[2] * t3[1], v1[3] * t3[2] + sg * p1[3] * t3[3]}; }
                    u32x4 w; w.x = cvt_pk_bf16(v0[0], v0[1]); w.y = cvt_pk_bf16(v0[2], v0[3]); w.z = cvt_pk_bf16(v1[0], v1[1]); w.w = cvt_pk_bf16(v1[2], v1[3]);
                    *(u32x4*)(rowp + bj * HALF) = w; } }
    }
};

template <class Epi, class Sched, bool ALIGN_EPI = false, bool SP2 = false, bool GATHER = false>
__device__ __forceinline__ void gemm_phase(PG8_LAS unsigned char* lds, const Gemm g, const Sched& S, const Epi& E, const int tid) {
    const int wid = __builtin_amdgcn_readfirstlane(tid >> 6), lane = tid & 63, wr = wid >> 2, wc = wid & 3, fr = lane & 15, fq = lane >> 4;
    const int K = g.K, nt = K / BK;
    unsigned voffA[2], voffB[2];
#pragma unroll
    for (int i = 0; i < 2; ++i) { int R, C; stage_rc(tid * 16 + i * 8192, R, C); const int Rb = Epi::PERM ? ((R & ~31) + perm32(R & 31)) : R;
        voffA[i] = (unsigned)(R * g.lda + C) * 2u; voffB[i] = (unsigned)(Rb * g.ldb + C) * 2u; }
    unsigned vA0[2] = {0u, 0u}, vA1[2] = {0u, 0u}, wA0[2] = {0u, 0u}, wA1[2] = {0u, 0u};
#define PG8_GOFF(u_, o0, o1) do { _Pragma("unroll") for (int i = 0; i < 2; ++i) { int R, C; stage_rc(tid * 16 + i * 8192, R, C); const int r0_ = (u_).pm * BM + R; \
        o0[i] = ((unsigned)g.rowidx[r0_] * (unsigned)g.lda + (unsigned)C) * 2u; o1[i] = ((unsigned)g.rowidx[r0_ + HALF] * (unsigned)g.lda + (unsigned)C) * 2u; } } while (0)
    const size_t kstep = (size_t)(BK * 2);
    const size_t hstepA = (size_t)HALF * g.lda * 2, hstepB = (size_t)HALF * g.ldb * 2;
    const size_t tstepA = 2 * hstepA, tstepB = 2 * hstepB;
    const unsigned ldsw = (unsigned)wid * 1024u;
    const int aoff = lds_byte(wr * 64 + fr, fq * 8), boff = lds_byte(wc * 32 + fr, fq * 8);
#define PG8_SA(b, h) (((b) * 2 + (h)) * HTB)
#define PG8_SB(b, h) ((4 + (b) * 2 + (h)) * HTB)
#define PG8_STAGE(bufoff, gbase, voff) do { _Pragma("unroll") for (int _i = 0; _i < 2; ++_i) \
        __builtin_amdgcn_global_load_lds((const unsigned*)((const char*)(gbase) + (voff)[_i]), (PG8_LAS unsigned*)(lds + (bufoff) + ldsw + _i * 8192), 16, 0, 0); } while (0)
#define PG8_STAGEA(bufoff, kptr, h, oc0, oc1) do { if constexpr (GATHER) { if (h) PG8_STAGE(bufoff, kptr, oc1); else PG8_STAGE(bufoff, kptr, oc0); } else { PG8_STAGE(bufoff, (kptr) + ((h) ? hstepA : 0), voffA); } } while (0)
#define PG8_LDA(dst, b, h) do { _Pragma("unroll") for (int m = 0; m < 4; ++m) _Pragma("unroll") for (int k = 0; k < 2; ++k) dst[m][k] = *(const PG8_LAS bf16x8*)(lds + PG8_SA(b, h) + aoff + m * 2048 + k * 1024); } while (0)
#define PG8_LDB(dst, b, h) do { _Pragma("unroll") for (int n = 0; n < 2; ++n) _Pragma("unroll") for (int k = 0; k < 2; ++k) dst[n][k] = *(const PG8_LAS bf16x8*)(lds + PG8_SB(b, h) + boff + n * 2048 + k * 1024); } while (0)
#define PG8_MMA(ai, bj, At, Bt) do { __builtin_amdgcn_s_setprio(1); _Pragma("unroll") for (int m = 0; m < 4; ++m) _Pragma("unroll") for (int n = 0; n < 2; ++n) _Pragma("unroll") for (int k = 0; k < 2; ++k) \
        acc[ai][bj][m][n] = __builtin_amdgcn_mfma_f32_16x16x32_bf16(Bt[n][k], At[m][k], acc[ai][bj][m][n], 0, 0, 0); __builtin_amdgcn_s_setprio(0); } while (0)
#define PG8_WAIT_V(n) asm volatile("s_waitcnt vmcnt(" #n ")" ::: "memory")
#define PG8_WAIT_L(n) asm volatile("s_waitcnt lgkmcnt(" #n ")" ::: "memory")
#define PG8_BAR __builtin_amdgcn_s_barrier()
#define PG8_SCHED __builtin_amdgcn_sched_barrier(0)
    Unit cur, nxt; int ui = 0;
    if (!S.next(0, cur)) return;
    f32x4 acc[2][2][4][2];
#pragma unroll
    for (int a = 0; a < 2; ++a)
#pragma unroll
        for (int b = 0; b < 2; ++b)
#pragma unroll
            for (int m = 0; m < 4; ++m)
#pragma unroll
                for (int n = 0; n < 2; ++n) acc[a][b][m][n] = (f32x4){0.f, 0.f, 0.f, 0.f};
    bf16x8 At[4][2], B0[2][2], B1[2][2];
    const char* cA = (const char*)g.A + (GATHER ? (size_t)0 : (size_t)cur.pm * tstepA); if constexpr (GATHER) PG8_GOFF(cur, vA0, vA1);
    const char* cB = (const char*)g.Bt + (size_t)cur.pn * tstepB;
    S.a_ready(cur);
    if constexpr (SP2) {
        PG8_STAGE(PG8_SB(0, 0), cB, voffB); PG8_STAGE(PG8_SB(0, 1), cB + hstepB, voffB); PG8_STAGEA(PG8_SA(0, 0), cA, 0, vA0, vA1); PG8_STAGEA(PG8_SA(0, 1), cA, 1, vA0, vA1);
        if (wr == 1) PG8_BAR;
        PG8_WAIT_V(2); PG8_BAR;
        PG8_STAGE(PG8_SB(1, 0), cB + kstep, voffB); PG8_STAGEA(PG8_SA(1, 0), cA + kstep, 0, vA0, vA1); PG8_STAGE(PG8_SB(1, 1), cB + hstepB + kstep, voffB);
        PG8_WAIT_V(6); PG8_BAR;
    } else {
        PG8_STAGE(PG8_SB(0, 0), cB, voffB); PG8_STAGE(PG8_SA(0, 0), cA, voffA); PG8_STAGE(PG8_SB(0, 1), cB + hstepB, voffB); PG8_STAGE(PG8_SA(0, 1), cA + hstepA, voffA);
        if (wr == 1) PG8_BAR;
        PG8_WAIT_V(4); PG8_BAR;
        PG8_STAGE(PG8_SB(1, 0), cB + kstep, voffB); PG8_STAGE(PG8_SA(1, 0), cA + kstep, voffA); PG8_STAGE(PG8_SB(1, 1), cB + hstepB + kstep, voffB);
        PG8_WAIT_V(6); PG8_BAR;
    }
    for (;;) {
        const bool has_next = S.next(ui + 1, nxt);
        const char* nA = (has_next && !GATHER) ? (const char*)g.A + (size_t)nxt.pm * tstepA : cA;
        if constexpr (GATHER) { if (has_next) { if (wid < 4) __builtin_amdgcn_global_load_lds((const unsigned*)(g.rowidx + (size_t)nxt.pm * BM + (tid & 255)), (PG8_LAS unsigned*)(lds + STAGE_BYTES + wid * 256), 4, 0, 0); }
                                else { wA0[0] = vA0[0]; wA0[1] = vA0[1]; wA1[0] = vA1[0]; wA1[1] = vA1[1]; } }
        const char* nB = has_next ? (const char*)g.Bt + (size_t)nxt.pn * tstepB : cB;
        for (int t = 0; t < nt; t += 2) {
            const bool last = (t == nt - 2);
            const char* a1 = cA + (size_t)(t + 1) * kstep;
            const char* a2 = last ? nA : cA + (size_t)(t + 2) * kstep; const char* b2 = last ? nB : cB + (size_t)(t + 2) * kstep;
            const char* a3 = a2 + kstep; const char* b3 = b2 + kstep;
            if (last && has_next) S.a_ready(nxt);
            if constexpr (GATHER) { if (last && has_next) {
#pragma unroll
                for (int i = 0; i < 2; ++i) { int R, C; stage_rc(tid * 16 + i * 8192, R, C);
                    const unsigned i0_ = *(const PG8_LAS unsigned*)(lds + STAGE_BYTES + R * 4), i1_ = *(const PG8_LAS unsigned*)(lds + STAGE_BYTES + (R + HALF) * 4);
                    wA0[i] = (i0_ * (unsigned)g.lda + (unsigned)C) * 2u; wA1[i] = (i1_ * (unsigned)g.lda + (unsigned)C) * 2u; } } }
            const unsigned sA0[2] = {last ? wA0[0] : vA0[0], last ? wA0[1] : vA0[1]}, sA1[2] = {last ? wA1[0] : vA1[0], last ? wA1[1] : vA1[1]};
            if constexpr (SP2) {
            PG8_LDB(B0, 0, 0); PG8_LDB(B1, 0, 1); PG8_SCHED; PG8_LDA(At, 0, 0); PG8_STAGEA(PG8_SA(1, 1), a1, 1, vA0, vA1);
            PG8_WAIT_V(8); PG8_WAIT_L(0); PG8_BAR; PG8_MMA(0, 0, At, B0); PG8_MMA(0, 1, At, B1); PG8_BAR; PG8_SCHED;
            PG8_LDA(At, 0, 1); PG8_STAGE(PG8_SB(0, 0), b2, voffB); PG8_STAGE(PG8_SB(0, 1), b2 + hstepB, voffB); PG8_STAGEA(PG8_SA(0, 0), a2, 0, sA0, sA1);
            PG8_WAIT_V(8); PG8_WAIT_L(0); PG8_BAR; PG8_MMA(1, 0, At, B0); PG8_MMA(1, 1, At, B1); PG8_BAR; PG8_SCHED;
            PG8_LDB(B0, 1, 0); PG8_LDB(B1, 1, 1); PG8_SCHED; PG8_LDA(At, 1, 0); PG8_STAGEA(PG8_SA(0, 1), a2, 1, sA0, sA1);
            PG8_WAIT_V(8); PG8_WAIT_L(0); PG8_BAR; PG8_MMA(0, 0, At, B0); PG8_MMA(0, 1, At, B1); PG8_BAR; PG8_SCHED;
            PG8_LDA(At, 1, 1); PG8_STAGE(PG8_SB(1, 0), b3, voffB); PG8_STAGE(PG8_SB(1, 1), b3 + hstepB, voffB); PG8_STAGEA(PG8_SA(1, 0), a3, 0, sA0, sA1);
            PG8_WAIT_V(8); PG8_WAIT_L(0); PG8_BAR; PG8_MMA(1, 0, At, B0); PG8_MMA(1, 1, At, B1); PG8_BAR; PG8_SCHED;
            } else {
            PG8_LDB(B0, 0, 0); PG8_SCHED; PG8_LDA(At, 0, 0); PG8_STAGE(PG8_SA(1, 1), a1 + hstepA, voffA);
            PG8_WAIT_L(8); PG8_BAR; PG8_WAIT_L(0); PG8_MMA(0, 0, At, B0); PG8_BAR; PG8_SCHED;
            PG8_LDB(B1, 0, 1); PG8_STAGE(PG8_SB(0, 0), b2, voffB);
            PG8_BAR; PG8_WAIT_L(0); PG8_MMA(0, 1, At, B1); PG8_BAR;
            PG8_LDA(At, 0, 1); PG8_STAGE(PG8_SA(0, 0), a2, voffA);
            PG8_BAR; PG8_WAIT_L(0); PG8_MMA(1, 0, At, B0); PG8_BAR; PG8_SCHED;
            PG8_STAGE(PG8_SB(0, 1), b2 + hstepB, voffB);
            PG8_WAIT_V(6); PG8_BAR; PG8_MMA(1, 1, At, B1); PG8_BAR;
            PG8_LDB(B0, 1, 0); PG8_SCHED; PG8_LDA(At, 1, 0); PG8_STAGE(PG8_SA(0, 1), a2 + hstepA, voffA);
            PG8_WAIT_L(8); PG8_BAR; PG8_WAIT_L(0); PG8_MMA(0, 0, At, B0); PG8_BAR; PG8_SCHED;
            PG8_LDB(B1, 1, 1); PG8_STAGE(PG8_SB(1, 0), b3, voffB);
            PG8_BAR; PG8_WAIT_L(0); PG8_MMA(0, 1, At, B1); PG8_BAR;
            PG8_LDA(At, 1, 1); PG8_STAGE(PG8_SA(1, 0), a3, voffA);
            PG8_BAR; PG8_WAIT_L(0); PG8_MMA(1, 0, At, B0); PG8_BAR; PG8_SCHED;
            PG8_STAGE(PG8_SB(1, 1), b3 + hstepB, voffB);
            PG8_WAIT_V(6); PG8_BAR; PG8_MMA(1, 1, At, B1); PG8_BAR;
            }
        }
        if constexpr (ALIGN_EPI) { if (wr == 0) PG8_BAR; }
        if constexpr (!Epi::AFTER_DRAIN) { E(acc, cur, wr, wc, fr, fq); S.done(cur); }
        if (!has_next) break;
#pragma unroll
        for (int a = 0; a < 2; ++a)
#pragma unroll
            for (int b = 0; b < 2; ++b)
#pragma unroll
                for (int m = 0; m < 4; ++m)
#pragma unroll
                    for (int n = 0; n < 2; ++n) acc[a][b][m][n] = (f32x4){0.f, 0.f, 0.f, 0.f};
        cur = nxt; cA = nA; cB = nB; ++ui; vA0[0] = wA0[0]; vA0[1] = wA0[1]; vA1[0] = wA1[0]; vA1[1] = wA1[1];
        if constexpr (ALIGN_EPI) { if (wr == 1) PG8_BAR; }
    }
    PG8_WAIT_V(0);
    if constexpr (!ALIGN_EPI) { if (wr == 0) PG8_BAR; }
    PG8_BAR;
    if constexpr (Epi::AFTER_DRAIN) { E.fused(acc, cur, wr, wc, fr, fq, lds, wid, lane); S.done(cur); }
#undef PG8_SA
#undef PG8_SB
#undef PG8_STAGE
#undef PG8_STAGEA
#undef PG8_GOFF
#undef PG8_LDA
#undef PG8_LDB
#undef PG8_MMA
#undef PG8_WAIT_V
#undef PG8_WAIT_L
#undef PG8_BAR
#undef PG8_SCHED
}
}
#define PG8_SP2 true
#define PG8_ALIGN true

struct Frame;
struct Args { const float* in[33]; float* out; unsigned char* ws; int ph_lo, ph_hi; };
struct Frame {
    unsigned char* lds;
    int tid, lane, wave, bid, nb;
    const float* const* in;
    float* out; unsigned char* ws;
    float* MOD; float* AFF; int* SEL; float* GATE; int* INV; bf16* X; bf16* H;
};
__device__ __forceinline__ void REFRESH_(Frame& F) { int l_; asm volatile("v_mbcnt_lo_u32_b32 %0, -1, 0\n\tv_mbcnt_hi_u32_b32 %0, -1, %0" : "=v"(l_)); F.lane = l_; F.tid = F.wave * 64 + l_; }
__device__ __forceinline__ int mod_row(int row) { const int b = row / P, pos = row - b * P; return pos < NCTX ? 32 : b; }

__device__ __forceinline__ void ph_s5_pre(const Frame& F) {
    const float *a_re = F.in[8], *a_im = F.in[9], *log_dt = F.in[10], *b_re = F.in[11], *b_im = F.in[12], *c_re = F.in[13], *c_im = F.in[14];
    f32x2* Bb = (f32x2*)F.lds;
    f32x2* Cc = Bb + 2048;
    f32x2* Ap = Cc + 2048;
    float* Kt = (float*)(Ap + 2 * 33 * 64);
    bf16* W1 = (bf16*)(F.ws + WS_S5W1); bf16* W2 = (bf16*)(F.ws + WS_S5W2); f32x2* A32 = (f32x2*)(F.ws + WS_S5A);
    const int tid = F.tid;
    for (int g = F.nb - 1 - F.bid; g < 64; g += F.nb) {
        __syncthreads();
        if (tid < 128) {
            const int dir = tid >> 6, p = tid & 63, dg = dir * 64 + g;
            const double are = (double)a_re[dg * 64 + p], aim = (double)a_im[dg * 64 + p], dt = exp((double)log_dt[dg]);
            const double lr = are * dt, li = aim * dt, cl = cos(li), sl = sin(li), mag = exp(lr);
            const double Abi = mag * sl, sh = sin(0.5 * li), nr = expm1(lr) * cl - 2.0 * sh * sh, den = are * are + aim * aim;
            const double fr = (nr * are + Abi * aim) / den, fi = (Abi * are - nr * aim) / den;
            for (int h = 0; h < 16; ++h) { const double br = (double)b_re[((size_t)dg * 64 + p) * 16 + h], bi = (double)b_im[((size_t)dg * 64 + p) * 16 + h];
                Bb[(dir * 64 + p) * 16 + h] = (f32x2){(float)(fr * br - fi * bi), (float)(fr * bi + fi * br)}; }
            const double Abr = mag * cl; double pr = 1.0, pi = 0.0;
            for (int e = 0; e <= 32; ++e) { const f32x2 v = {(float)pr, (float)pi};
                Ap[(dir * 33 + e) * 64 + p] = v; if (e == 32) A32[(g * 2 + dir) * 64 + p] = v;
                const double nr2 = pr * Abr - pi * Abi, ni2 = pr * Abi + pi * Abr; pr = nr2; pi = ni2; }
        }
        for (int i = tid; i < 2048; i += NTHREADS) { const int dir = i >> 10, k = (i >> 6) & 15, p = i & 63; const size_t o = ((size_t)(dir * 64 + g) * 16 + k) * 64 + p; Cc[i] = (f32x2){c_re[o], c_im[o]}; }
        __syncthreads();
        {
            const int dir = tid >> 8, k = (tid >> 4) & 15, h = tid & 15; float acc[32];
#pragma unroll
            for (int lag = 0; lag < 32; ++lag) acc[lag] = 0.f;
#pragma unroll 2
            for (int p = 0; p < 64; ++p) { const f32x2 c = Cc[(dir * 16 + k) * 64 + p], bb = Bb[(dir * 64 + p) * 16 + h], a1 = Ap[(dir * 33 + 1) * 64 + p];
                float zr = c.x * bb.x - c.y * bb.y, zi = c.x * bb.y + c.y * bb.x;
#pragma unroll
                for (int lag = 0; lag < 32; ++lag) { acc[lag] += zr; const float nz = zr * a1.x - zi * a1.y; zi = zr * a1.y + zi * a1.x; zr = nz; } }
#pragma unroll
            for (int lag = 0; lag < 32; ++lag) Kt[((dir * 32 + lag) * 16 + k) * 16 + h] = acc[lag];
        }
        for (int i = tid; i < 16384; i += NTHREADS) {
            const int n = i >> 6, sg = (i >> 1) & 31, h0 = (i & 1) * 8, dir = n >> 7, c = (n >> 6) & 1, p = n & 63, e = dir ? sg : 31 - sg;
            const f32x2 a = Ap[(dir * 33 + e) * 64 + p]; float v[8];
#pragma unroll
            for (int q = 0; q < 8; ++q) { const f32x2 bb = Bb[(dir * 64 + p) * 16 + h0 + q]; v[q] = c ? a.x * bb.y + a.y * bb.x : a.x * bb.x - a.y * bb.y; }
            u32x4 w; w.x = pk2(v[0], v[1]); w.y = pk2(v[2], v[3]); w.z = pk2(v[4], v[5]); w.w = pk2(v[6], v[7]);
            *(u32x4*)(W1 + ((size_t)g * 256 + n) * 512 + sg * 16 + h0) = w;
        }
        for (int i = tid; i < 16384; i += NTHREADS) {
            const int m = i >> 5, n0 = (i & 31) * 8, dir = n0 >> 7, c = (n0 >> 6) & 1, p0 = n0 & 63, tau = m >> 4, k = m & 15, e = dir ? 32 - tau : tau + 1; float v[8];
#pragma unroll
            for (int q = 0; q < 8; ++q) { const f32x2 cc = Cc[(dir * 16 + k) * 64 + p0 + q], a = Ap[(dir * 33 + e) * 64 + p0 + q]; v[q] = c ? -(cc.x * a.y + cc.y * a.x) : cc.x * a.x - cc.y * a.y; }
            u32x4 w; w.x = pk2(v[0], v[1]); w.y = pk2(v[2], v[3]); w.z = pk2(v[4], v[5]); w.w = pk2(v[6], v[7]);
            *(u32x4*)(W2 + ((size_t)g * 512 + m) * 768 + 512 + n0) = w;
        }
        __syncthreads();
        for (int i = tid; i < 32768; i += NTHREADS) {
            const int m = i >> 6, sg = (i >> 1) & 31, h0 = (i & 1) * 8, tau = m >> 4, k = m & 15; float v[8];
#pragma unroll
            for (int q = 0; q < 8; ++q) { float x = 0.f; if (sg <= tau) x += Kt[((tau - sg) * 16 + k) * 16 + h0 + q]; if (sg >= tau) x += Kt[((32 + sg - tau) * 16 + k) * 16 + h0 + q]; v[q] = x; }
            u32x4 w; w.x = pk2(v[0], v[1]); w.y = pk2(v[2], v[3]); w.z = pk2(v[4], v[5]); w.w = pk2(v[6], v[7]);
            *(u32x4*)(W2 + ((size_t)g * 512 + m) * 768 + sg * 16 + h0) = w;
        }
    }
    __syncthreads();
}
__device__ __forceinline__ void ph_s5_scan(const Frame& F) {
    const float* SS = (const float*)(F.ws + WS_SS); bf16* AG = (bf16*)(F.ws + WS_AG); const f32x2* A32 = (const f32x2*)(F.ws + WS_S5A);
    for (int gid = F.bid * NTHREADS + F.tid; gid < 64 * 32 * 128; gid += F.nb * NTHREADS) {
        const int p = gid & 63, dir = (gid >> 6) & 1, b = (gid >> 7) & 31, g = gid >> 12;
        const f32x2 a = A32[(g * 2 + dir) * 64 + p];
        float hr = 0.f, hi = 0.f;
        const size_t row0 = (size_t)g * 2304 + b * 72;
#pragma unroll 4
        for (int idx = 0; idx < 72; ++idx) {
            const int j = dir == 0 ? idx : (idx < 8 ? 7 - idx : 79 - idx);
            const size_t row = row0 + j;
            AG[row * 768 + 512 + dir * 128 + p] = (bf16)f2bf(hr); AG[row * 768 + 512 + dir * 128 + 64 + p] = (bf16)f2bf(hi);
            const float sr = SS[row * 256 + dir * 128 + p], si = SS[row * 256 + dir * 128 + 64 + p];
            const float nr = a.x * hr - a.y * hi + sr, ni = a.x * hi + a.y * hr + si; hr = nr; hi = ni;
        }
    }
}

template <int DUAL>
__device__ __forceinline__ void transpose_item(const float* W, int ldw, int K, int N, bf16* WT, int row_off, LAS float* scr, int item, int lane) {
    const int nblk = N / 64, kb = item / nblk, nb = item - kb * nblk, k0 = 64 * kb, n0 = 64 * nb;
    const int lr = lane >> 4, lc = (lane & 15) * 4;
    f32x4 v[16];
#pragma unroll
    for (int i = 0; i < 16; ++i) v[i] = *(const f32x4*)(W + (size_t)(k0 + lr + 4 * i) * ldw + n0 + lc);
#pragma unroll
    for (int i = 0; i < 16; ++i) { LAS float* d = scr + (lr + 4 * i) * 65 + lc; d[0] = v[i].x; d[1] = v[i].y; d[2] = v[i].z; d[3] = v[i].w; }
    asm volatile("s_waitcnt lgkmcnt(0)" ::: "memory");
    const int c = lane & 7;
#pragma unroll
    for (int j = 0; j < 8; ++j) { const int n = (lane >> 3) + 8 * j; const LAS float* sp = scr + (8 * c) * 65 + n;
        u32x4 o; o.x = pkbf(sp[0 * 65], sp[1 * 65]); o.y = pkbf(sp[2 * 65], sp[3 * 65]); o.z = pkbf(sp[4 * 65], sp[5 * 65]); o.w = pkbf(sp[6 * 65], sp[7 * 65]);
        const int nn = n0 + n, dest = DUAL == -2 ? (nn < 3072 ? nn : (nn < 4096 ? nn + 1024 : nn - 1024)) : (DUAL < 0 ? row_off + nn : row_off + (nn >> 7) * 256 + DUAL * 128 + (nn & 127));
        *(u32x4*)(WT + (size_t)dest * K + k0 + 8 * c) = o; }
    asm volatile("s_waitcnt lgkmcnt(0)" ::: "memory");
}
__device__ __forceinline__ void convert_moe(const Frame& F, int l, int cb = -1, int cnb = 0) {
    if (cb < 0) { cb = F.bid; cnb = F.nb; }
    if (cb >= cnb) return;
    LAS float* scr = (LAS float*)((LAS unsigned char*)F.lds) + F.wave * 4160;
    bf16* WGU = (bf16*)(F.ws + WO_GU); bf16* WDN = (bf16*)(F.ws + WO_DN);
    for (int it = cb * NWAVES + F.wave; it < 24576; it += cnb * NWAVES) {
        const int m = it >> 13, r = it & 8191, e = r >> 9, item = r & 511;
        if (m == 0) transpose_item<0>(F.in[29] + (size_t)(l * NE + e) * D * FF, FF, D, FF, WGU, e * 2 * FF, scr, item, F.lane);
        else if (m == 1) transpose_item<1>(F.in[30] + (size_t)(l * NE + e) * D * FF, FF, D, FF, WGU, e * 2 * FF, scr, item, F.lane);
        else transpose_item<-1>(F.in[31] + (size_t)(l * NE + e) * FF * D, D, FF, D, WDN, e * D, scr, item, F.lane);
    }
}
__device__ __forceinline__ void convert_mixers(const Frame& F, int cb, int cnb) {
    if (cb >= cnb) return;
    LAS float* scr = (LAS float*)((LAS unsigned char*)F.lds) + F.wave * 4160;
    for (int it = cb * NWAVES + F.wave; it < 4096; it += cnb * NWAVES) {
        int r = it;
        if (r < 256) { transpose_item<0>(F.in[16], 2 * D, D, D, (bf16*)(F.ws + WO_GLU), 0, scr, r, F.lane); continue; } r -= 256;
        if (r < 256) { transpose_item<1>(F.in[16] + D, 2 * D, D, D, (bf16*)(F.ws + WO_GLU), 0, scr, r, F.lane); continue; } r -= 256;
        if (r < 768) { transpose_item<-1>(F.in[17], 3 * D, D, 3 * D, (bf16*)(F.ws + WO_NAQKV), 0, scr, r, F.lane); continue; } r -= 768;
        if (r < 256) { transpose_item<-1>(F.in[18], D, D, D, (bf16*)(F.ws + WO_NAO), 0, scr, r, F.lane); continue; } r -= 256;
        if (r < 768) { transpose_item<-1>(F.in[20], 3 * D, D, 3 * D, (bf16*)(F.ws + WO_DAQKV), 0, scr, r, F.lane); continue; } r -= 768;
        if (r < 256) { transpose_item<-1>(F.in[21], D, D, D, (bf16*)(F.ws + WO_DAO), 0, scr, r, F.lane); continue; } r -= 256;
        if (r < 1280) { transpose_item<-2>(F.in[24], 5 * D, D, 5 * D, (bf16*)(F.ws + WO_HGIN), 0, scr, r, F.lane); continue; } r -= 1280;
        transpose_item<-1>(F.in[25], D, D, D, (bf16*)(F.ws + WO_HGO), 0, scr, r, F.lane);
    }
}

__device__ __forceinline__ void ph_prologue(const Frame& F) {
    {
        float* S = (float*)F.lds;
        for (int i = F.tid; i < 33 * 1024; i += NTHREADS) { const float v = i < 32 * 1024 ? F.in[1][i] : F.in[3][i - 32 * 1024]; S[i] = siluf_(v); }
        __syncthreads();
        float acc[2][33];
#pragma unroll
        for (int t = 0; t < 2; ++t)
#pragma unroll
            for (int r = 0; r < 33; ++r) acc[t][r] = 0.f;
#pragma unroll
        for (int t = 0; t < 2; ++t) {
            const int task = F.bid + t * F.nb;
            if (task < 384) {
                const int l = task / 96, col = (task % 96) * 64 + F.lane, kb = F.wave * 128;
                const float* W = F.in[4] + (size_t)l * 1024 * 6144 + col;
#pragma unroll 1
                for (int k = kb; k < kb + 128; k += 8) {
                    float w[8];
#pragma unroll
                    for (int q = 0; q < 8; ++q) w[q] = W[(size_t)(k + q) * 6144];
#pragma unroll
                    for (int r = 0; r < 33; ++r) { const f32x4 s0 = *(const f32x4*)&S[r * 1024 + k], s1 = *(const f32x4*)&S[r * 1024 + k + 4];
                        acc[t][r] += (s0.x * w[0] + s0.y * w[1]) + (s0.z * w[2] + s0.w * w[3]) + (s1.x * w[4] + s1.y * w[5]) + (s1.z * w[6] + s1.w * w[7]); }
                }
            }
        }
        __syncthreads();
#pragma unroll
        for (int t = 0; t < 2; ++t)
#pragma unroll
            for (int r = 0; r < 33; ++r) S[((t * 8 + F.wave) * 33 + r) * 64 + F.lane] = acc[t][r];
        __syncthreads();
        for (int i = F.tid; i < 2 * 33 * 64; i += NTHREADS) {
            const int t = i / (33 * 64), r = (i / 64) % 33, ln = i & 63, task = F.bid + t * F.nb;
            if (task < 384) { const int l = task / 96, col = (task % 96) * 64 + ln; float v = F.in[5][l * 6144 + col];
#pragma unroll
                for (int w = 0; w < 8; ++w) v += S[((t * 8 + w) * 33 + r) * 64 + ln];
                F.MOD[((size_t)l * 33 + r) * 6144 + col] = v; }
        }
        __syncthreads();
    }
    if (F.bid == 48) {
        const float* lbin = F.in[27];
        for (int c = F.tid; c < D; c += NTHREADS) { const float x0 = lbin[c], x1 = lbin[D + c], x2 = lbin[2 * D + c], x3 = lbin[3 * D + c], mx = fmaxf(fmaxf(x0, x1), fmaxf(x2, x3));
            const float e0 = expf(x0 - mx), e1 = expf(x1 - mx), e2 = expf(x2 - mx), e3 = expf(x3 - mx); ((float*)(F.ws + WS_LB))[c] = (e1 + e2 + e3) / (e0 + e1 + e2 + e3); }
    }
    if (F.bid == 49) {
        for (int i = F.tid; i < 64 * 16; i += NTHREADS) { const float inv = powf(10000.0f, -(float)(i & 15) * (1.0f / 16.0f)); float sn, cs; sincosf((float)(i >> 4) * inv, &sn, &cs);
            ((float*)(F.ws + WS_ROPE))[2 * i] = cs; ((float*)(F.ws + WS_ROPE))[2 * i + 1] = sn; }
    }
    { const int ncv = F.nb > 128 ? F.nb - 64 : F.nb;
      convert_mixers(F, F.bid, ncv); convert_moe(F, 0, F.bid, ncv); }
    __syncthreads();
    ph_s5_pre(F);
}

template <bool F32> struct XRawT { typedef f32x4 T; };
template <> struct XRawT<false> { typedef u32x2 T; };
__device__ __forceinline__ f32x4 xcvt(const f32x4& r) { return r; }
__device__ __forceinline__ f32x4 xcvt(const u32x2& r) { return (f32x4){bflo(r.x), bfhi(r.x), bflo(r.y), bfhi(r.y)}; }
template <int MODE, bool COMBINE, bool S5OUT = false, bool SKIPCTX = false, bool FROMIN = false>
__device__ __forceinline__ void ph_norm(const Frame& F, int layer, int prev_layer) {
    static_assert(MODE != 1, "norm2 + router is ph_norm2");
    const float* nw = MODE == 0 ? F.in[6] + layer * D : F.in[32];
    const bf16* Y = (const bf16*)(F.ws + WS_Y);
    constexpr int NI = SKIPCTX ? NB * SEQ : R;
    constexpr int NPF = 4;
    const int per = (NI + F.nb * NWAVES - 1) / (F.nb * NWAVES);
    int it = (F.bid * NWAVES + F.wave) * per; const int itend = min(NI, it + per);
    typedef typename XRawT<FROMIN>::T XR;
    const __amdgpu_buffer_rsrc_t yrs = __builtin_amdgcn_make_buffer_rsrc((void*)Y, 0, (int)((size_t)NE * SLOTS * D * 2), 0x00020000);
    const int l16 = F.lane & 15;
#define NORM_ROWOF(i_) (SKIPCTX ? ((i_) >> 11) * P + NCTX + ((i_) & (SEQ - 1)) : (i_))
#define NORM_XPTR(r_) ((FROMIN ? (const XR*)(((r_) % P) < NCTX ? F.in[2] + ((size_t)((r_) / P) * NCTX + ((r_) % P)) * D : F.in[0] + ((size_t)((r_) / P) * SEQ + ((r_) % P) - NCTX) * D) : (const XR*)(F.X + (size_t)(r_) * D)) + F.lane)
#define NORM_STAGE(i_, INVA_, V_, G_, Yq_, INVB_) do { \
        const int ic_ = min((i_), itend - 1), ic1_ = min((i_) + 1, itend - 1); const int rA_ = NORM_ROWOF(ic_); \
        if (COMBINE) INVB_ = F.INV[(size_t)NORM_ROWOF(ic1_) * NE + l16]; \
        if (COMBINE) G_ = F.GATE[l16 * SLOTS + max(INVA_, 0)]; \
        { const XR* xp_ = NORM_XPTR(rA_); _Pragma("unroll") for (int j = 0; j < 4; ++j) V_[j] = xp_[64 * j]; } \
        if (COMBINE) { unsigned m_ = ((i_) < itend) ? (unsigned)(__ballot(F.lane < NE && INVA_ >= 0) & 0xffffull) : 0u; \
            _Pragma("unroll") for (int q = 0; q < NPF; ++q) { const bool pr_ = m_ != 0u; const int e_ = pr_ ? __builtin_ctz(m_) : 0; m_ &= m_ - 1u; const int s_ = __builtin_amdgcn_readlane(INVA_, e_); \
                const unsigned vo_ = pr_ ? (unsigned)(e_ * SLOTS + s_) * (unsigned)(D * 2) + (unsigned)F.lane * 8u : 0xfffff000u; \
                _Pragma("unroll") for (int j = 0; j < 4; ++j) Yq_[q][j] = __builtin_amdgcn_raw_buffer_load_b64(yrs, vo_ + 512u * j, 0, 0); } } \
    } while (0)
    XR v[4]; u32x2 yc[NPF][4]; float gl = 0.f; int invl = -1, invn = -1;
    if (COMBINE) invl = F.INV[(size_t)NORM_ROWOF(min(it, NI - 1)) * NE + l16];
    NORM_STAGE(it, invl, v, gl, yc, invn);
    const f32x4* nw4 = (const f32x4*)nw + F.lane;
    f32x4 g5[4], nwv[4], shv[4], scv[4]; int mrc = -1;
#pragma unroll
    for (int j = 0; j < 4; ++j) { nwv[j] = nw4[64 * j]; g5[j] = shv[j] = scv[j] = (f32x4){0.f, 0.f, 0.f, 0.f}; }
    while (it < itend) {
        const int row = NORM_ROWOF(it), b = row / P, pos = row - b * P, mr = pos < NCTX ? 32 : b;
        if (mr != mrc) { mrc = mr;
            const float* mrow = F.MOD + ((size_t)layer * 33 + mr) * 6144;
#pragma unroll
            for (int j = 0; j < 4; ++j) {
                if (COMBINE) g5[j] = ((const f32x4*)(F.MOD + ((size_t)prev_layer * 33 + mr) * 6144 + 5 * D) + F.lane)[64 * j];
                if (MODE != 2) { shv[j] = ((const f32x4*)(mrow + (MODE == 0 ? 0 : 3) * D) + F.lane)[64 * j]; scv[j] = ((const f32x4*)(mrow + (MODE == 0 ? 1 : 4) * D) + F.lane)[64 * j]; }
            }
        }
        XR vn[4]; u32x2 yn[NPF][4]; float gln = 0.f; int invnn = -1;
        NORM_STAGE(it + 1, invn, vn, gln, yn, invnn);
        f32x4 a[4];
#pragma unroll
        for (int j = 0; j < 4; ++j) a[j] = (f32x4){0.f, 0.f, 0.f, 0.f};
        if (COMBINE) {
            unsigned m = (unsigned)(__ballot(F.lane < NE && invl >= 0) & 0xffffull);
#pragma unroll
            for (int q = 0; q < NPF; ++q) {
                const bool pr = m != 0u; const int e = pr ? __builtin_ctz(m) : 0; m &= m - 1u;
                const float g = pr ? __uint_as_float(__builtin_amdgcn_readlane(__float_as_uint(gl), e)) : 0.f;
#pragma unroll
                for (int j = 0; j < 4; ++j) { a[j].x += g * bflo(yc[q][j].x); a[j].y += g * bfhi(yc[q][j].x); a[j].z += g * bflo(yc[q][j].y); a[j].w += g * bfhi(yc[q][j].y); }
            }
            while (m) {
                const int e = __builtin_ctz(m); m &= m - 1u;
                const int sl = __builtin_amdgcn_readlane(invl, e); const float g = __uint_as_float(__builtin_amdgcn_readlane(__float_as_uint(gl), e));
                const u32x2* y0 = (const u32x2*)(Y + ((size_t)e * SLOTS + sl) * D) + F.lane;
                u32x2 w0[4];
#pragma unroll
                for (int j = 0; j < 4; ++j) w0[j] = y0[64 * j];
#pragma unroll
                for (int j = 0; j < 4; ++j) { a[j].x += g * bflo(w0[j].x); a[j].y += g * bfhi(w0[j].x); a[j].z += g * bflo(w0[j].y); a[j].w += g * bfhi(w0[j].y); }
            }
        }
        f32x4 vv[4];
#pragma unroll
        for (int j = 0; j < 4; ++j) vv[j] = xcvt(v[j]);
        if (COMBINE) {
#pragma unroll
            for (int j = 0; j < 4; ++j) vv[j] = vv[j] + g5[j] * a[j];
        }
        if ((FROMIN || COMBINE) && MODE != 2) { u32x2* xw = (u32x2*)(F.X + (size_t)row * D) + F.lane;
#pragma unroll
            for (int j = 0; j < 4; ++j) { u32x2 w; w.x = pkbf(vv[j].x, vv[j].y); w.y = pkbf(vv[j].z, vv[j].w); xw[64 * j] = w; } }
        float ss = 0.f;
#pragma unroll
        for (int j = 0; j < 4; ++j) ss += (vv[j].x * vv[j].x + vv[j].y * vv[j].y) + (vv[j].z * vv[j].z + vv[j].w * vv[j].w);
        const float rinv = rsqrtf(wave_sum(ss) * (1.0f / D) + EPS);
        if (MODE == 2) {
            if (pos >= NCTX) {
                f32x4* o = (f32x4*)(F.out + ((size_t)b * SEQ + pos - NCTX) * D) + F.lane;
#pragma unroll
                for (int j = 0; j < 4; ++j) o[64 * j] = vv[j] * rinv * nwv[j];
            }
        } else {
            u32x2* ho = (u32x2*)(F.H + (size_t)row * D) + F.lane;
            f32x4 h[4];
#pragma unroll
            for (int j = 0; j < 4; ++j) { h[j] = vv[j] * rinv * nwv[j] * (scv[j] + 1.0f) + shv[j]; u32x2 w; w.x = pkbf(h[j].x, h[j].y); w.y = pkbf(h[j].z, h[j].w); ho[64 * j] = w;
                if (S5OUT) { const int g = (F.lane >> 2) + 16 * j;
                    *(u32x2*)((bf16*)(F.ws + WS_AG) + ((size_t)g * 2304 + b * 72 + (pos >> 5)) * 768 + (pos & 31) * 16 + (F.lane & 3) * 4) = w; } }
        }
#pragma unroll
        for (int j = 0; j < 4; ++j) { v[j] = vn[j];
#pragma unroll
            for (int q = 0; q < NPF; ++q) yc[q][j] = yn[q][j]; }
        gl = gln; invl = invn; invn = invnn; ++it;
    }
#undef NORM_STAGE
#undef NORM_XPTR
#undef NORM_ROWOF
}

template <bool SKIPCTX>
__device__ __forceinline__ void ph_norm2(const Frame& F, int layer) {
    const float* nw = F.in[7] + layer * D;
    LAS float* wrt = (LAS float*)((LAS unsigned char*)F.lds);
    {
        const float* wr = F.in[28] + (size_t)layer * D * NE;
        for (int i = F.tid; i < D * NE; i += NTHREADS) wrt[(i & 15) * D + (i >> 4)] = wr[i];
        __syncthreads();
    }
    const f32x4* nw4 = (const f32x4*)nw + F.lane;
    const int eid = ((F.lane & 1) << 3) | ((F.lane & 2) << 1) | ((F.lane & 4) >> 1) | ((F.lane & 8) >> 3);
    constexpr int NI = SKIPCTX ? NB * SEQ / 2 : R / 2;
    const int per = (NI + F.nb * NWAVES - 1) / (F.nb * NWAVES), it0 = (F.bid * NWAVES + F.wave) * per, it1 = min(NI, it0 + per);
    f32x4 gv[4], shv[4]; int mrc = -1;
#pragma unroll
    for (int j = 0; j < 4; ++j) gv[j] = shv[j] = (f32x4){0.f, 0.f, 0.f, 0.f};
#define N2_ROWOF(i_) (SKIPCTX ? ((i_) >> 10) * P + NCTX + 2 * ((i_) & (SEQ / 2 - 1)) : 2 * (i_))
    u32x2 w0[4], w1[4];
    { const u32x2* x0 = (const u32x2*)(F.X + (size_t)N2_ROWOF(min(it0, NI - 1)) * D) + F.lane;
#pragma unroll
      for (int j = 0; j < 4; ++j) { w0[j] = x0[64 * j]; w1[j] = x0[256 + 64 * j]; } }
    for (int it = it0; it < it1; ++it) {
        const int row = N2_ROWOF(it), b = row / P, pos = row - b * P, mr = pos < NCTX ? 32 : b;
        f32x4 v0[4], v1[4];
#pragma unroll
        for (int j = 0; j < 4; ++j) { v0[j] = xcvt(w0[j]); v1[j] = xcvt(w1[j]); }
        if (mr != mrc) { mrc = mr;
            const float* mrow = F.MOD + ((size_t)layer * 33 + mr) * 6144;
#pragma unroll
            for (int j = 0; j < 4; ++j) { shv[j] = ((const f32x4*)(mrow + 3 * D) + F.lane)[64 * j]; gv[j] = nw4[64 * j] * (((const f32x4*)(mrow + 4 * D) + F.lane)[64 * j] + 1.0f); }
        }
        u32x2 n0[4], n1[4];
        { const u32x2* xn = (const u32x2*)(F.X + (size_t)N2_ROWOF(min(it + 1, it1 - 1)) * D) + F.lane;
#pragma unroll
          for (int j = 0; j < 4; ++j) { n0[j] = xn[64 * j]; n1[j] = xn[256 + 64 * j]; } }
        float s0 = 0.f, s1 = 0.f;
#pragma unroll
        for (int j = 0; j < 4; ++j) { s0 += (v0[j].x * v0[j].x + v0[j].y * v0[j].y) + (v0[j].z * v0[j].z + v0[j].w * v0[j].w); s1 += (v1[j].x * v1[j].x + v1[j].y * v1[j].y) + (v1[j].z * v1[j].z + v1[j].w * v1[j].w); }
        const float r0 = rsqrtf(wave_sum(s0) * (1.0f / D) + EPS), r1 = rsqrtf(wave_sum(s1) * (1.0f / D) + EPS);
        u32x2* h0 = (u32x2*)(F.H + (size_t)row * D) + F.lane; u32x2* h1 = h0 + 256;
#pragma unroll
        for (int j = 0; j < 4; ++j) { const f32x4 g = gv[j];
            v0[j] = v0[j] * r0 * g + shv[j]; v1[j] = v1[j] * r1 * g + shv[j];
            u32x2 w; w.x = pkbf(v0[j].x, v0[j].y); w.y = pkbf(v0[j].z, v0[j].w); h0[64 * j] = w;
            w.x = pkbf(v1[j].x, v1[j].y); w.y = pkbf(v1[j].z, v1[j].w); h1[64 * j] = w; }
        f32x2 a0[NE], a1[NE];
#pragma unroll
        for (int e = 0; e < NE; ++e) { a0[e] = (f32x2){0.f, 0.f}; a1[e] = (f32x2){0.f, 0.f}; }
#pragma unroll
        for (int j = 0; j < 4; ++j) { asm volatile("" ::: "memory");
            const f32x2 p0 = {v0[j].x, v0[j].y}, q0 = {v0[j].z, v0[j].w}, p1 = {v1[j].x, v1[j].y}, q1 = {v1[j].z, v1[j].w};
#pragma unroll
            for (int e = 0; e < NE; ++e) { const f32x4 w = *(const LAS f32x4*)(wrt + e * D + F.lane * 4 + 256 * j); const f32x2 wl = {w.x, w.y}, wh = {w.z, w.w};
                a0[e] += p0 * wl; a0[e] += q0 * wh; a1[e] += p1 * wl; a1[e] += q1 * wh; } }
        float lg0[NE], lg1[NE];
#pragma unroll
        for (int e = 0; e < NE; ++e) { lg0[e] = a0[e].x + a0[e].y; lg1[e] = a1[e].x + a1[e].y; }
        const float t0 = reduce16(lg0, F.lane), t1 = reduce16(lg1, F.lane);
        float m0 = fmaxf(t0, dpp_xor1(t0)), m1 = fmaxf(t1, dpp_xor1(t1));
        m0 = fmaxf(m0, dpp_xor2(m0)); m1 = fmaxf(m1, dpp_xor2(m1)); m0 = fmaxf(m0, __shfl_xor(m0, 4)); m1 = fmaxf(m1, __shfl_xor(m1, 4)); m0 = fmaxf(m0, __shfl_xor(m0, 8)); m1 = fmaxf(m1, __shfl_xor(m1, 8));
        const float e0 = __builtin_amdgcn_exp2f((t0 - m0) * LOG2E_), e1 = __builtin_amdgcn_exp2f((t1 - m1) * LOG2E_);
        float z0 = e0 + dpp_xor1(e0), z1 = e1 + dpp_xor1(e1);
        z0 += dpp_xor2(z0); z1 += dpp_xor2(z1); z0 += __shfl_xor(z0, 4); z1 += __shfl_xor(z1, 4); z0 += __shfl_xor(z0, 8); z1 += __shfl_xor(z1, 8);
        if (F.lane < NE) { float* ap = F.AFF + ((size_t)b * NE + eid) * P + pos; ap[0] = e0 / z0; ap[1] = e1 / z1; }
#pragma unroll
        for (int j = 0; j < 4; ++j) { w0[j] = n0[j]; w1[j] = n1[j]; }
    }
#undef N2_ROWOF
}

__device__ __forceinline__ void ph_topk(const Frame& F, int nitems) {
    unsigned* hist = (unsigned*)F.lds;
    unsigned* wtot = hist + 256;
    unsigned* bc = wtot + 8;
    int* lsel = (int*)(bc + 8);
    bf16* XS = (bf16*)(F.ws + WS_XS);
    const int tid = F.tid, lane = F.lane, wave = F.wave;
    for (int item = F.bid; item < nitems; item += F.nb) {
        const int seg = item >> 9, b = (item >> 4) & 31, e = item & 15;
        const int n = seg ? NCTX : SEQ, pos0 = seg ? 0 : NCTX, cap = n / 8, slot0 = seg ? NB * 256 + b * 32 : b * 256;
        const float* a = F.AFF + ((size_t)b * NE + e) * P + pos0;
        const bool act = tid * 4 < n;
        f32x4 av = (f32x4){0.f, 0.f, 0.f, 0.f}; if (act) av = *(const f32x4*)(a + tid * 4);
        unsigned u[4]; u[0] = __float_as_uint(av.x); u[1] = __float_as_uint(av.y); u[2] = __float_as_uint(av.z); u[3] = __float_as_uint(av.w);
        unsigned prefix = 0u, mask = 0u, kk = (unsigned)cap;
#pragma unroll 1
        for (int pass = 0; pass < 4; ++pass) {
            const int shift = 24 - 8 * pass;
            __syncthreads();
            if (tid < 256) hist[tid] = 0u;
            __syncthreads();
            if (act) {
#pragma unroll
                for (int q = 0; q < 4; ++q) if ((u[q] & mask) == prefix) atomicAdd(&hist[(u[q] >> shift) & 255u], 1u);
            }
            __syncthreads();
            unsigned hv = 0u, cum = 0u;
            if (tid < 256) { hv = hist[255 - tid]; cum = hv;
#pragma unroll
                for (int o = 1; o < 64; o <<= 1) { const unsigned t = __shfl_up(cum, o); if (lane >= o) cum += t; }
                if (lane == 63) wtot[wave] = cum; }
            __syncthreads();
            if (tid < 256) {
                unsigned off = 0u;
#pragma unroll
                for (int w = 0; w < 4; ++w) if (w < wave) off += wtot[w];
                cum += off;
                if (cum >= kk && cum - hv < kk) { bc[0] = 255u - (unsigned)tid; bc[1] = kk - (cum - hv); }
            }
            __syncthreads();
            prefix |= bc[0] << shift; mask |= 255u << shift; kk = bc[1];
        }
        unsigned cg = 0u, ce = 0u;
        if (act) {
#pragma unroll
            for (int q = 0; q < 4; ++q) { cg += u[q] > prefix ? 1u : 0u; ce += u[q] == prefix ? 1u : 0u; }
        }
        unsigned pk = cg | (ce << 16), inc = pk;
#pragma unroll
        for (int o = 1; o < 64; o <<= 1) { const unsigned t = __shfl_up(inc, o); if (lane >= o) inc += t; }
        __syncthreads();
        if (lane == 63) wtot[wave] = inc;
        __syncthreads();
        unsigned off = 0u;
#pragma unroll
        for (int w = 0; w < 8; ++w) if (w < wave) off += wtot[w];
        unsigned excl = inc - pk + off, gb = excl & 0xffffu, eb = excl >> 16;
        if (act) {
#pragma unroll
            for (int q = 0; q < 4; ++q) {
                const int i = tid * 4 + q, row = b * P + pos0 + i;
                const bool gt = u[q] > prefix, eq = u[q] == prefix, sel = gt || (eq && eb < kk);
                if (sel) { const int slot = slot0 + (int)(gb + (eb < kk ? eb : kk)); F.SEL[e * SLOTS + slot] = row; F.GATE[e * SLOTS + slot] = __uint_as_float(u[q]); F.INV[(size_t)row * NE + e] = slot; }
                else F.INV[(size_t)row * NE + e] = -1;
                gb += gt ? 1u : 0u; eb += eq ? 1u : 0u;
            }
        }
        __syncthreads();
    }
    __syncthreads();
}

typedef short bf16x8 __attribute__((ext_vector_type(8)));
typedef float f32x16 __attribute__((ext_vector_type(16)));
#define MFMA32(a, b, c) __builtin_amdgcn_mfma_f32_32x32x16_bf16((a), (b), (c), 0, 0, 0)
__device__ __forceinline__ int kperm(int m) { return (m & 0x13) | ((m & 8) >> 1) | ((m & 4) << 1); }
__device__ __forceinline__ bf16x8 pack8(const f32x16& x, int s8) {
    u32x4 p; p.x = pkbf(x[s8 + 0], x[s8 + 1]); p.y = pkbf(x[s8 + 2], x[s8 + 3]); p.z = pkbf(x[s8 + 4], x[s8 + 5]); p.w = pkbf(x[s8 + 6], x[s8 + 7]);
    return __builtin_bit_cast(bf16x8, p);
}
constexpr float LOG2E = 1.4426950408889634f;

__device__ __forceinline__ void ph_da_attn(const Frame& F) {
    const bf16* Q = (const bf16*)(F.ws + WS_Q); const bf16* K = (const bf16*)(F.ws + WS_K); const bf16* VT = (const bf16*)(F.ws + WS_VT); bf16* O = (bf16*)(F.ws + WS_O);
    const int tid = F.tid, lane = F.lane, l32 = lane & 31, hh = lane >> 5, map = F.wave & 1, qsub = F.wave >> 1;
    const float* lam = F.in[22];
    const float lam_full = expf(wave_sum(lam[lane] * lam[64 + lane])) - expf(wave_sum(lam[128 + lane] * lam[192 + lane])) + LAM_INIT;
    constexpr int KB = 64 * 144, VB = 128 * 144, BUF = 2 * KB + VB;
    unsigned char* sb = F.lds;
    float* xch = (float*)(F.lds + 2 * BUF) + qsub * 4096;
    const float c = 0.125f * LOG2E;
    const int kr = (tid >> 3) & 63, kc = tid & 7, vd = tid >> 3, vc = tid & 7;
    const int kdst = kr * 144 + kc * 16, vdst = 2 * KB + vd * 144 + vc * 16;
    const int kfrag = map * KB + kperm(l32) * 144 + hh * 16, vfrag = 2 * KB + l32 * 144 + hh * 16;
    const int vb = (F.nb & 7) == 0 ? (F.bid & 7) * (F.nb >> 3) + (F.bid >> 3) : F.bid;
    for (int it = vb; it < 4096 + 512; it += F.nb) {
        int b, h, pos0, nst;
        if (it < 4096) { b = it >> 7; h = (it >> 4) & 7; pos0 = NCTX + (it & 15) * 128 + qsub * 32; nst = P / 64; }
        else { const int j = it - 4096; b = j >> 4; h = (j >> 1) & 7; pos0 = (j & 1) * 128 + qsub * 32; nst = NCTX / 64; }
        const size_t qrow = (size_t)b * P + pos0 + l32;
        bf16x8 qf[4];
#pragma unroll
        for (int ks = 0; ks < 4; ++ks) qf[ks] = *(const bf16x8*)(Q + qrow * D + h * 128 + map * 64 + ks * 16 + hh * 8);
        f32x16 o[4];
#pragma unroll
        for (int dt = 0; dt < 4; ++dt)
#pragma unroll
            for (int j = 0; j < 16; ++j) o[dt][j] = 0.f;
        float m = 0.f, l = 0.f;
        const bf16* kg = K + ((size_t)b * P + kr) * D + h * 128 + kc * 8;
        const bf16* vg = VT + ((size_t)b * D + h * 128 + vd) * P + vc * 8;
        u32x4 ka0, ka1, va0, va1;
        { const u32x4 k0 = *(const u32x4*)kg, k1 = *(const u32x4*)(kg + 64), v0 = *(const u32x4*)vg, v1 = *(const u32x4*)(vg + (size_t)64 * P);
          const bf16* kq = kg + (size_t)64 * D; const bf16* vq = vg + 64;
          ka0 = *(const u32x4*)kq; ka1 = *(const u32x4*)(kq + 64); va0 = *(const u32x4*)vq; va1 = *(const u32x4*)(vq + (size_t)64 * P);
          *(u32x4*)(sb + kdst) = k0; *(u32x4*)(sb + KB + kdst) = k1; *(u32x4*)(sb + vdst) = v0; *(u32x4*)(sb + vdst + 64 * 144) = v1; }
        __syncthreads();
#pragma unroll 1
        for (int st = 0; st < nst; ++st) {
            const unsigned char* cb = sb + (st & 1) * BUF;
            u32x4 kn0 = (u32x4){0u, 0u, 0u, 0u}, kn1 = kn0, vn0 = kn0, vn1 = kn0;
            if (st + 2 < nst) { const bf16* kq = kg + (size_t)(st + 2) * 64 * D; const bf16* vq = vg + (st + 2) * 64;
                kn0 = *(const u32x4*)kq; kn1 = *(const u32x4*)(kq + 64); vn0 = *(const u32x4*)vq; vn1 = *(const u32x4*)(vq + (size_t)64 * P); }
#pragma unroll
            for (int sub = 0; sub < 2; ++sub) {
                f32x16 s;
#pragma unroll
                for (int j = 0; j < 16; ++j) s[j] = -m;
#pragma unroll
                for (int ks = 0; ks < 4; ++ks) s = MFMA32(*(const bf16x8*)(cb + kfrag + sub * 32 * 144 + ks * 32), qf[ks], s);
                float mx = s[0];
#pragma unroll
                for (int j = 1; j < 16; ++j) mx = fmaxf(mx, s[j]);
                mx = fmaxf(mx, __shfl_xor(mx, 32));
                const bool first = st == 0 && sub == 0;
                if (first || __any(mx > 8.0f)) {
                    const float d = first ? mx : fmaxf(mx, 0.f);
                    if (!first) { const float alpha = __builtin_amdgcn_exp2f(-d); l *= alpha;
#pragma unroll
                        for (int dt = 0; dt < 4; ++dt)
#pragma unroll
                            for (int j = 0; j < 16; ++j) o[dt][j] *= alpha; }
                    m += d;
#pragma unroll
                    for (int j = 0; j < 16; ++j) s[j] -= d;
                }
                float ps = 0.f;
#pragma unroll
                for (int j = 0; j < 16; ++j) { s[j] = __builtin_amdgcn_exp2f(s[j]); ps += s[j]; }
                l += ps;
                const bf16x8 p0 = pack8(s, 0), p1 = pack8(s, 8);
#pragma unroll
                for (int dt = 0; dt < 4; ++dt) { o[dt] = MFMA32(*(const bf16x8*)(cb + vfrag + dt * 32 * 144 + sub * 64), p0, o[dt]); o[dt] = MFMA32(*(const bf16x8*)(cb + vfrag + dt * 32 * 144 + sub * 64 + 32), p1, o[dt]); }
            }
            if (st + 1 < nst) { unsigned char* nb = sb + ((st + 1) & 1) * BUF; *(u32x4*)(nb + kdst) = ka0; *(u32x4*)(nb + KB + kdst) = ka1; *(u32x4*)(nb + vdst) = va0; *(u32x4*)(nb + vdst + 64 * 144) = va1; }
            ka0 = kn0; ka1 = kn1; va0 = vn0; va1 = vn1;
            __syncthreads();
        }
        l += __shfl_xor(l, 32);
        const float inv = 1.0f / l;
        if (map == 1) {
#pragma unroll
            for (int dt = 0; dt < 4; ++dt)
#pragma unroll
                for (int j = 0; j < 16; ++j) xch[(dt * 16 + j) * 64 + lane] = o[dt][j] * inv * lam_full;
        }
        __syncthreads();
        if (map == 0) {
            float ss = 0.f;
#pragma unroll
            for (int dt = 0; dt < 4; ++dt)
#pragma unroll
                for (int j = 0; j < 16; ++j) { const float v = o[dt][j] * inv - xch[(dt * 16 + j) * 64 + lane]; o[dt][j] = v; ss += v * v; }
            ss += __shfl_xor(ss, 32);
            const float rinv = rsqrtf(ss * (1.0f / 128.0f) + EPS) * (1.0f - LAM_INIT);
#pragma unroll
            for (int dt = 0; dt < 4; ++dt)
#pragma unroll
                for (int jq = 0; jq < 4; ++jq) {
                    const int d0 = dt * 32 + jq * 8 + hh * 4; const f32x4 sw = *(const f32x4*)(F.in[23] + d0);
                    u32x2 w; w.x = pkbf(o[dt][jq * 4 + 0] * rinv * sw.x, o[dt][jq * 4 + 1] * rinv * sw.y); w.y = pkbf(o[dt][jq * 4 + 2] * rinv * sw.z, o[dt][jq * 4 + 3] * rinv * sw.w);
                    *(u32x2*)(O + qrow * D + h * 128 + d0) = w;
                }
        }
        __syncthreads();
    }
}

__device__ __forceinline__ void ph_na_attn(const Frame& F) {
    const bf16* Q = (const bf16*)(F.ws + WS_Q); const bf16* K = (const bf16*)(F.ws + WS_K); const bf16* VT = (const bf16*)(F.ws + WS_VT); bf16* O = (bf16*)(F.ws + WS_O);
    const int tid = F.tid, lane = F.lane, l32 = lane & 31, hh = lane >> 5;
    constexpr int KB = 128 * 144, VP = 272, VB = 64 * VP, BUF = KB + VB;
    unsigned char* sb = F.lds;
    float* rp = (float*)(F.lds + 2 * BUF) + 64;
    for (int i = tid; i < 16 * 15 * 31 + 128; i += NTHREADS) { const int k = i - 64; rp[k] = (k >= 0 && k < 16 * 15 * 31) ? F.in[19][k] * LOG2E : 0.f; }
    __syncthreads();
    const float c = 0.125f * LOG2E;
    const int pr = tid >> 3, pc = tid & 7;
    const int kdst = pr * 144 + pc * 16, vdst = KB + pr * VP + pc * 16;
    const int kfrag = kperm(l32) * 144 + hh * 16, vfrag = KB + l32 * VP + hh * 16;
    const int vb = (F.nb & 7) == 0 ? (F.bid & 7) * (F.nb >> 3) + (F.bid >> 3) : F.bid;
    for (int it = vb; it < 4096 + 512; it += F.nb) {
        int b, h, r = 0, cq = 0, kc0 = 0, rlo = 0, rhi = 0, wr0 = 0, wr1 = 0, nt; bool lat; size_t qrow;
        if (it < 4096) { lat = true; b = it >> 7; h = (it >> 3) & 15; const int rg = ((it & 7) + (it >> 8)) & 7  ;
            const int rw = rg * 4 + (F.wave >> 2) * 2, cqt = F.wave & 3; r = rw + (l32 >> 4); cq = cqt * 16 + (l32 & 15); kc0 = min(max(cqt * 16 - 8, 0), 32);
            wr0 = min(max(rw - 4, 0), 24); wr1 = min(max(rw + 1 - 4, 0), 24) + 8;
            qrow = (size_t)b * P + NCTX + r * 64 + cq;
            rlo = min(max(rg * 4 - 4, 0), 24); rhi = min(max(rg * 4 + 3 - 4, 0), 24) + 7; nt = 2 + (rhi - rlo + 2) / 2; }
        else { lat = false; const int j = it - 4096; b = j >> 4; h = j & 15; qrow = (size_t)b * P + F.wave * 32 + l32; nt = 2; }
        const int r0 = min(max(r - 4, 0), 24), c0 = min(max(cq - 8, 0), 48);
        bf16x8 qf[4];
#pragma unroll
        for (int ks = 0; ks < 4; ++ks) qf[ks] = *(const bf16x8*)(Q + qrow * D + h * 64 + ks * 16 + hh * 8);
        float neg[16];
#pragma unroll
        for (int j = 0; j < 16; ++j) { const int kcol = kc0 + 16 * (j >> 3) + 8 * hh + 4 * ((j >> 2) & 1) + (j & 3); neg[j] = (kcol >= c0 && kcol < c0 + 16) ? 0.f : -1.0e30f; }
        f32x16 o[2];
#pragma unroll
        for (int dt = 0; dt < 2; ++dt)
#pragma unroll
            for (int j = 0; j < 16; ++j) o[dt][j] = 0.f;
        float m = -1.0e30f, l = 0.f;
        const bf16* kg = K + ((size_t)b * P + pr) * D + h * 64 + pc * 8;
        const bf16* vg = VT + ((size_t)b * D + h * 64 + pr) * P + pc * 8;
#define NA_KEYA(st) ((st) < 2 ? (st) * 128 : NCTX + (rlo + 2 * ((st) - 2)) * 64)
#define NA_KEYB(st) ((st) < 2 ? (st) * 128 + 64 : NCTX + min(rlo + 2 * ((st) - 2) + 1, 31) * 64)
#define NA_LOAD(dk0, dk1, dv0, dv1, st) do { const int ka_ = NA_KEYA(st), kb_ = NA_KEYB(st); dk0 = *(const u32x4*)(kg + (size_t)ka_ * D); dk1 = *(const u32x4*)(kg + (size_t)kb_ * D); \
        dv0 = *(const u32x4*)(vg + ka_); dv1 = *(const u32x4*)(vg + kb_); } while (0)
#define NA_STORE(buf, sk0, sk1, sv0, sv1) do { *(u32x4*)((buf) + kdst) = sk0; *(u32x4*)((buf) + kdst + 64 * 144) = sk1; *(u32x4*)((buf) + vdst) = sv0; *(u32x4*)((buf) + vdst + 128) = sv1; } while (0)
        u32x4 ka0, ka1, va0, va1;
        { u32x4 x0, x1, y0, y1; NA_LOAD(x0, x1, y0, y1, 0); NA_LOAD(ka0, ka1, va0, va1, 1); NA_STORE(sb, x0, x1, y0, y1); }
        __syncthreads();
#pragma unroll 1
        for (int st = 0; st < nt; ++st) {
            const unsigned char* cbuf = sb + (st & 1) * BUF;
            u32x4 kn0 = (u32x4){0u, 0u, 0u, 0u}, kn1 = kn0, vn0 = kn0, vn1 = kn0;
            if (st + 2 < nt) NA_LOAD(kn0, kn1, vn0, vn1, st + 2);
#define NA_TILE(KO_, WIN_, KROW_) do { const int ko = (KO_); \
                f32x16 s; \
                _Pragma("unroll") for (int j = 0; j < 16; ++j) s[j] = 0.f; \
                _Pragma("unroll") for (int ks = 0; ks < 4; ++ks) s = MFMA32(*(const bf16x8*)(cbuf + kfrag + ko * 144 + ks * 32), qf[ks], s); \
                if (WIN_) { const int krow = (KROW_); \
                    const float rmask = (krow >= r0 && krow < r0 + 8) ? 0.f : -1.0e30f;        \
                    const float* rph = rp + (h * 15 + (krow - r + 7)) * 31 - cq + 15 + 8 * hh + kc0;       \
                    _Pragma("unroll") for (int j = 0; j < 16; ++j) s[j] = (s[j] * c + rph[16 * (j >> 3) + 4 * ((j >> 2) & 1) + (j & 3)]) + (neg[j] + rmask); \
                } else { _Pragma("unroll") for (int j = 0; j < 16; ++j) s[j] *= c; } \
                float mx = s[0]; \
                _Pragma("unroll") for (int j = 1; j < 16; ++j) mx = fmaxf(mx, s[j]); \
                mx = fmaxf(mx, __shfl_xor(mx, 32)); \
                if (__any(mx > m + 8.0f)) { \
                    const float mn = fmaxf(m, mx), alpha = __builtin_amdgcn_exp2f(m - mn); m = mn; l *= alpha; \
                    _Pragma("unroll") for (int dt = 0; dt < 2; ++dt) _Pragma("unroll") for (int j = 0; j < 16; ++j) o[dt][j] *= alpha; \
                } \
                f32x2 ps2 = {0.f, 0.f}; \
                _Pragma("unroll") for (int j = 0; j < 16; j += 2) { f32x2 t = {s[j], s[j + 1]}; t = t - (f32x2){m, m}; t.x = __builtin_amdgcn_exp2f(t.x); t.y = __builtin_amdgcn_exp2f(t.y); s[j] = t.x; s[j + 1] = t.y; ps2 += t; } \
                l += ps2.x + ps2.y; \
                const bf16x8 p0 = pack8(s, 0), p1 = pack8(s, 8); \
                _Pragma("unroll") for (int dt = 0; dt < 2; ++dt) { o[dt] = MFMA32(*(const bf16x8*)(cbuf + vfrag + dt * 32 * VP + ko * 2), p0, o[dt]); o[dt] = MFMA32(*(const bf16x8*)(cbuf + vfrag + dt * 32 * VP + ko * 2 + 32), p1, o[dt]); } \
            } while (0)
            if (st < 2) {
#pragma unroll
                for (int sub = 0; sub < 4; ++sub) NA_TILE(sub * 32, false, 0);
            } else {
#pragma unroll
                for (int half = 0; half < 2; ++half) { const int krw = rlo + 2 * (st - 2) + half;
                    if (krw <= rhi && krw >= wr0 && krw < wr1) NA_TILE(half * 64 + kc0, true, krw); }
            }
#undef NA_TILE
            if (st + 1 < nt) { unsigned char* nb = sb + ((st + 1) & 1) * BUF; NA_STORE(nb, ka0, ka1, va0, va1); }
            ka0 = kn0; ka1 = kn1; va0 = vn0; va1 = vn1;
            __syncthreads();
        }
#undef NA_KEYA
#undef NA_KEYB
#undef NA_LOAD
#undef NA_STORE
        l += __shfl_xor(l, 32);
        const float inv = 1.0f / l;
#pragma unroll
        for (int dt = 0; dt < 2; ++dt)
#pragma unroll
            for (int jq = 0; jq < 4; ++jq) {
                const int d0 = dt * 32 + jq * 8 + hh * 4;
                u32x2 w; w.x = pkbf(o[dt][jq * 4 + 0] * inv, o[dt][jq * 4 + 1] * inv); w.y = pkbf(o[dt][jq * 4 + 2] * inv, o[dt][jq * 4 + 3] * inv);
                *(u32x2*)(O + qrow * D + h * 64 + d0) = w;
            }
    }
    __syncthreads();
}

__device__ __forceinline__ f32x4 unpk4(u32x2 w) { return (f32x4){bflo(w.x), bfhi(w.x), bflo(w.y), bfhi(w.y)}; }
__device__ __forceinline__ bf16 bf1(float x) { return (bf16)(pkbf(x, 0.f) & 0xffffu); }
__device__ __forceinline__ f32x4 shx32(f32x4 v) { return (f32x4){__shfl_xor(v.x, 32), __shfl_xor(v.y, 32), __shfl_xor(v.z, 32), __shfl_xor(v.w, 32)}; }
template <int DIR>
__device__ __forceinline__ void hgrn_seq(const Frame& F, int b, int h, int eb) {
    const bf16* ZIN = (const bf16*)(F.ws + WS_ZIN); const bf16* VTG = (const bf16*)(F.ws + WS_VTG); bf16* OUT = (bf16*)(F.ws + (DIR ? WS_OFB : WS_OFF));
    const int lane = F.lane, l32 = lane & 31, hh = lane >> 5, cperm = kperm(l32);
    constexpr int IMG = 32 * 136 * 2, KTB = 128 * 80, DBUF = 2 * IMG + KTB + 512;
    unsigned char* dbase = F.lds + DIR * 2 * DBUF;
    const int tg = lane & 7, prho = 8 * eb + (lane >> 3), pc = kperm(prho);
    f32x16 S[4];
#pragma unroll
    for (int d = 0; d < 4; ++d)
#pragma unroll
        for (int j = 0; j < 16; ++j) S[d][j] = 0.f;
    const bf16* vbase = VTG + ((size_t)b * D + h * 128 + eb * 32 + l32) * P + hh * 8;
    const bf16* zp = ZIN + ((size_t)b * P + 4 * tg) * 4096 + h * 128 + 4 * prho;
#define HG_CHUNK(i_) (DIR == 0 ? (i_) : ((i_) < 8 ? 7 - (i_) : 79 - (i_)))
#define HG_LOAD(i_) do { const int c_ = HG_CHUNK(i_); const bf16* z_ = zp + (size_t)c_ * 32 * 4096; \
        _Pragma("unroll") for (int i = 0; i < 4; ++i) { nlf[i] = *(const u32x2*)(z_ + (size_t)i * 4096 + (1 + DIR) * D); nq[i] = *(const u32x2*)(z_ + (size_t)i * 4096); } \
        nv0 = *(const bf16x8*)(vbase + c_ * 32); nv1 = *(const bf16x8*)(vbase + c_ * 32 + 16); } while (0)
    u32x2 nlf[4], nq[4]; bf16x8 nv0, nv1;
    HG_LOAD(0);
#pragma unroll 1
    for (int idx = 0; idx < 72; ++idx) {
        const int cc = HG_CHUNK(idx);
        const size_t row0 = (size_t)b * P + cc * 32;
        unsigned char* buf = dbase + (idx & 1) * DBUF;
        bf16* Qp = (bf16*)buf; bf16* Kp = (bf16*)(buf + IMG); bf16* KT = (bf16*)(buf + 2 * IMG); float* egl = (float*)(buf + 2 * IMG + KTB);
        u32x2 lfc[4], qc[4];
#pragma unroll
        for (int i = 0; i < 4; ++i) { lfc[i] = nlf[i]; qc[i] = nq[i]; }
        const bf16x8 vf0 = nv0, vf1 = nv1;
        HG_LOAD(min(idx + 1, 71));
        f32x4 l4[4], t = (f32x4){0.f, 0.f, 0.f, 0.f};
#pragma unroll
        for (int i = 0; i < 4; ++i) { l4[i] = unpk4(lfc[i]); t += l4[i]; }
        f32x4 x = t;
#pragma unroll
        for (int k = 1; k < 8; k <<= 1) { const f32x4 y = (f32x4){__shfl_up(x.x, k, 8), __shfl_up(x.y, k, 8), __shfl_up(x.z, k, 8), __shfl_up(x.w, k, 8)}; if (tg >= k) x += y; }
        const f32x4 tot = (f32x4){__shfl(x.x, 7, 8), __shfl(x.y, 7, 8), __shfl(x.z, 7, 8), __shfl(x.w, 7, 8)};
        const f32x4 off = DIR == 0 ? x - t : tot - x;
        f32x4 eg = (f32x4){__builtin_amdgcn_exp2f(off.x), __builtin_amdgcn_exp2f(off.y), __builtin_amdgcn_exp2f(off.z), __builtin_amdgcn_exp2f(off.w)}; float kv[4][4];
#pragma unroll
        for (int ii = 0; ii < 4; ++ii) {
            const int i = DIR ? 3 - ii : ii;
            const f32x4 lf = l4[i], q4 = unpk4(qc[i]);
            const int srow = (4 * tg + i) * 136 + pc;
#pragma unroll
            for (int d = 0; d < 4; ++d) { const float f = __builtin_amdgcn_exp2f(lf[d]); eg[d] *= f; const float kq = (1.0f - f) * __builtin_amdgcn_rcpf(eg[d]);
                Qp[srow + d * 32] = bf1(q4[d] * eg[d]); Kp[srow + d * 32] = bf1(kq); kv[d][i] = kq; }
        }
#pragma unroll
        for (int d = 0; d < 4; ++d) { u32x2 w; w.x = pkbf(kv[d][0], kv[d][1]); w.y = pkbf(kv[d][2], kv[d][3]); *(u32x2*)(KT + (d * 32 + prho) * 40 + 4 * tg) = w; }
        if (tg == 0) *(f32x4*)(egl + 4 * prho) = (f32x4){__builtin_amdgcn_exp2f(tot.x), __builtin_amdgcn_exp2f(tot.y), __builtin_amdgcn_exp2f(tot.z), __builtin_amdgcn_exp2f(tot.w)};
        __syncthreads();
        bf16x8 kf[4][2];
#pragma unroll
        for (int d = 0; d < 4; ++d)
#pragma unroll
            for (int sg = 0; sg < 2; ++sg) kf[d][sg] = *(const bf16x8*)(KT + (d * 32 + l32) * 40 + sg * 16 + 8 * hh);
        if (cc >= NCTX / 32) {
        f32x16 att;
#pragma unroll
        for (int j = 0; j < 16; ++j) att[j] = 0.f;
        const bf16* krow = Kp + cperm * 136 + hh * 8; const bf16* qrow = Qp + l32 * 136 + hh * 8;
#pragma unroll
        for (int ks = 0; ks < 8; ++ks) att = MFMA32(*(const bf16x8*)(krow + ks * 16), *(const bf16x8*)(qrow + ks * 16), att);
#pragma unroll
        for (int j = 0; j < 16; ++j) { const int sa = 16 * (j >> 3) + 8 * hh + 4 * ((j >> 2) & 1) + (j & 3); const bool keep = DIR == 0 ? (sa <= l32) : (sa >= l32); att[j] = keep ? att[j] : 0.f; }
        const bf16x8 p0 = pack8(att, 0), p1 = pack8(att, 8);
        f32x16 o;
#pragma unroll
        for (int j = 0; j < 16; ++j) o[j] = 0.f;
        o = MFMA32(vf0, p0, o); o = MFMA32(vf1, p1, o);
#pragma unroll
        for (int d = 0; d < 4; ++d) { o = MFMA32(pack8(S[d], 0), *(const bf16x8*)(qrow + d * 32), o); o = MFMA32(pack8(S[d], 8), *(const bf16x8*)(qrow + d * 32 + 16), o); }
        bf16* op = OUT + (row0 + l32) * D + h * 128 + eb * 32 + 4 * hh;
#pragma unroll
        for (int jq = 0; jq < 4; ++jq) { u32x2 w; w.x = pkbf(o[4 * jq], o[4 * jq + 1]); w.y = pkbf(o[4 * jq + 2], o[4 * jq + 3]); *(u32x2*)(op + 8 * jq) = w; }
        }
#pragma unroll
        for (int d = 0; d < 4; ++d) { S[d] = MFMA32(kf[d][0], vf0, S[d]); S[d] = MFMA32(kf[d][1], vf1, S[d]); }
#pragma unroll
        for (int j = 0; j < 16; ++j) { const int rho = (j & 3) + 8 * (j >> 2) + 4 * hh; const f32x4 e4 = *(const f32x4*)(egl + 4 * rho);
            S[0][j] *= e4.x; S[1][j] *= e4.y; S[2][j] *= e4.z; S[3][j] *= e4.w; }
    }
#undef HG_LOAD
#undef HG_CHUNK
}
__device__ __forceinline__ void ph_hgrn_scan(const Frame& F) {
    for (int id = F.bid * NWAVES + F.wave; id < NB * 8 * 8; id += F.nb * NWAVES) {
        const int eb = id & 3, dir = (id >> 2) & 1, h = (id >> 3) & 7, b = id >> 6;
        if (dir == 0) hgrn_seq<0>(F, b, h, eb); else hgrn_seq<1>(F, b, h, eb);
    }
}
__device__ __forceinline__ void ph_hgrn_post(const Frame& F) {
    const bf16* ZIN = (const bf16*)(F.ws + WS_ZIN); const bf16* OFF = (const bf16*)(F.ws + WS_OFF); const bf16* OFB = (const bf16*)(F.ws + WS_OFB); bf16* O2 = (bf16*)(F.ws + WS_O2);
    const int lane = F.lane, part = lane & 7;
    f32x4 gn[4];
#pragma unroll
    for (int q = 0; q < 4; ++q) gn[q] = *(const f32x4*)(F.in[26] + part * 16 + q * 4);
    for (int row = F.bid * NWAVES + F.wave; row < R; row += F.nb * NWAVES) {
        if (row % P < NCTX) continue;
        const size_t o = (size_t)row * D + lane * 16;
        const u32x4 a0 = *(const u32x4*)(OFF + o), a1 = *(const u32x4*)(OFF + o + 8), b0 = *(const u32x4*)(OFB + o), b1 = *(const u32x4*)(OFB + o + 8);
        const u32x4 g0 = *(const u32x4*)(ZIN + (size_t)row * 4096 + 3 * D + lane * 16), g1 = *(const u32x4*)(ZIN + (size_t)row * 4096 + 3 * D + lane * 16 + 8);
        float v[16];
        v[0] = bflo(a0.x) + bflo(b0.x); v[1] = bfhi(a0.x) + bfhi(b0.x); v[2] = bflo(a0.y) + bflo(b0.y); v[3] = bfhi(a0.y) + bfhi(b0.y);
        v[4] = bflo(a0.z) + bflo(b0.z); v[5] = bfhi(a0.z) + bfhi(b0.z); v[6] = bflo(a0.w) + bflo(b0.w); v[7] = bfhi(a0.w) + bfhi(b0.w);
        v[8] = bflo(a1.x) + bflo(b1.x); v[9] = bfhi(a1.x) + bfhi(b1.x); v[10] = bflo(a1.y) + bflo(b1.y); v[11] = bfhi(a1.y) + bfhi(b1.y);
        v[12] = bflo(a1.z) + bflo(b1.z); v[13] = bfhi(a1.z) + bfhi(b1.z); v[14] = bflo(a1.w) + bflo(b1.w); v[15] = bfhi(a1.w) + bfhi(b1.w);
        float ss = 0.f;
#pragma unroll
        for (int q = 0; q < 16; ++q) ss += v[q] * v[q];
        ss += dpp_xor1(ss); ss += dpp_xor2(ss); ss += __shfl_xor(ss, 4);
        const float rinv = rsqrtf(ss * (1.0f / 128.0f) + EPS);
        const unsigned gw[8] = {g0.x, g0.y, g0.z, g0.w, g1.x, g1.y, g1.z, g1.w};
        unsigned w[8];
#pragma unroll
        for (int q = 0; q < 8; ++q) w[q] = pkbf(v[2 * q] * rinv * gn[q >> 1][(2 * q) & 3] * bflo(gw[q]), v[2 * q + 1] * rinv * gn[q >> 1][(2 * q + 1) & 3] * bfhi(gw[q]));
        *(u32x4*)(O2 + o) = (u32x4){w[0], w[1], w[2], w[3]}; *(u32x4*)(O2 + o + 8) = (u32x4){w[4], w[5], w[6], w[7]};
    }
}

enum { PH_BASE = __COUNTER__ };
__global__ void __launch_bounds__(NTHREADS, 2) fwd(Args args) {
    extern __shared__ __attribute__((aligned(16))) unsigned char lds[];
    Frame F;
    F.lds = lds; F.wave = __builtin_amdgcn_readfirstlane((int)threadIdx.x >> 6); F.bid = blockIdx.x; F.nb = gridDim.x;
    REFRESH_(F);
    F.in = args.in; F.out = args.out; F.ws = args.ws;
    F.MOD = (float*)(args.ws + WS_MOD); F.AFF = (float*)(args.ws + WS_AFF); F.SEL = (int*)(args.ws + WS_SEL); F.GATE = (float*)(args.ws + WS_GATE); F.INV = (int*)(args.ws + WS_INV);
    F.X = (bf16*)(args.ws + WS_X); F.H = (bf16*)(args.ws + WS_H);
    const int lo = args.ph_lo, hi = args.ph_hi;
#if MK_SINGLE
    volatile LAS unsigned* misc = (volatile LAS unsigned*)((LAS unsigned char*)lds + LDS_MISC);
    if (F.tid < 64) misc[F.tid] = 0u;
    __syncthreads();
    XcdBarrier bar = xcd_barrier_post((unsigned*)(args.ws + WS_CTL) + CW_BAR, misc, F.tid);
#define SEAM(k) do { if ((k) + 1 < hi) xcd_barrier(bar, F.tid); } while (0)
#else
#define SEAM(k) do { } while (0)
#endif
#define PH(...) do { constexpr int k_ = __COUNTER__ - PH_BASE - 1; if (lo <= k_ && k_ < hi) { REFRESH_(F); __VA_ARGS__; SEAM(k_); } } while (0)
    bf16* HID = (bf16*)(F.ws + WS_HID); bf16* Y = (bf16*)(F.ws + WS_Y);
    PG8_LAS unsigned char* ring = (PG8_LAS unsigned char*)lds;
    bf16 *Qb = (bf16*)(F.ws + WS_Q), *VTb = (bf16*)(F.ws + WS_VT), *Ob = (bf16*)(F.ws + WS_O);

#define GEMM_PHASE(EPI, gA, lda_, gB, ldb_, gK, nM_, nN_, groups_, gsM_, ...) do { const pg8::Gemm g_{(const bf16*)(gA), (const bf16*)(gB), (lda_), (ldb_), (gK), nullptr}; pg8::GroupedOrder S_; S_.init((nM_), (nN_), (groups_), (gsM_), F.nb, F.bid); \
        const EPI E_{__VA_ARGS__}; pg8::gemm_phase<EPI, pg8::GroupedOrder, PG8_ALIGN, PG8_SP2>(ring, g_, S_, E_, F.tid); } while (0)
#define GEMM_PHASE_LAT(EPI, gA, lda_, gB, ldb_, gK, nN_, ...) do { const pg8::Gemm g_{(const bf16*)(gA), (const bf16*)(gB), (lda_), (ldb_), (gK), nullptr}; pg8::LatentOrder S_; S_.init((nN_), F.nb, F.bid); \
        const EPI E_{__VA_ARGS__}; pg8::gemm_phase<EPI, pg8::LatentOrder, PG8_ALIGN, PG8_SP2>(ring, g_, S_, E_, F.tid); } while (0)
#define GEMM_PHASE_GATHER(EPI, gA, lda_, gIdx, gB, ldb_, gK, nM_, nN_, groups_, gsM_, ...) do { const pg8::Gemm g_{(const bf16*)(gA), (const bf16*)(gB), (lda_), (ldb_), (gK), (gIdx)}; pg8::GroupedOrder S_; S_.init((nM_), (nN_), (groups_), (gsM_), F.nb, F.bid); \
        const EPI E_{__VA_ARGS__}; pg8::gemm_phase<EPI, pg8::GroupedOrder, PG8_ALIGN, PG8_SP2, true>(ring, g_, S_, E_, F.tid); } while (0)
#define MODL(L) (F.MOD + (size_t)(L) * 33 * 6144)
#define MOE_PHASES(L, NMT, NITEMS, SKIPC) \
    PH(ph_norm2<SKIPC>(F, (L))); \
    PH(ph_topk(F, (NITEMS))); \
    PH(GEMM_PHASE_GATHER(pg8::EpiSwigluT, F.H, D, F.SEL, F.ws + WO_GU, D, D, (NMT), 2 * FF / 256, NE, SLOTS / 256, HID, 2 * FF / 256, FF)); \
    PH(GEMM_PHASE(pg8::EpiDownT, HID, FF, F.ws + WO_DN, FF, FF, (NMT), D / 256, NE, SLOTS / 256, Y, F.GATE, D / 256));
#define OUT_PROJ(Asrc, Wsrc, L) PH(GEMM_PHASE(pg8::EpiResidT, (Asrc), D, (Wsrc), D, D, R / 256, D / 256, 1, R / 256, F.X, MODL(L)));

    PH(ph_prologue(F));
    PH(ph_norm<0, false, true, false, true>(F, 0, 0));
    PH(GEMM_PHASE(pg8::EpiF32G, F.ws + WS_AG, 768, F.ws + WS_S5W1, 512, 512, 2304 / 256, 1, 64, 2304 / 256, (float*)(F.ws + WS_SS), 256, 1));
    PH(ph_s5_scan(F));
    PH(GEMM_PHASE(pg8::EpiS5Out, F.ws + WS_AG, 768, F.ws + WS_S5W2, 768, 768, 2304 / 256, 2, 64, 2304 / 256, F.H, (bf16*)(F.ws + WS_Z), F.in[15]));
    PH(GEMM_PHASE(pg8::EpiGluT, F.ws + WS_Z, D, F.ws + WO_GLU, D, D, R / 256, 2 * D / 256, 1, R / 256, F.X, MODL(0)));
    MOE_PHASES(0, SLOTS / 256, NB * NE * 2, false)
    PH(ph_norm<0, true>(F, 1, 0); convert_moe(F, 1));
    PH(GEMM_PHASE(pg8::EpiBf16<0>, F.H, D, F.ws + WO_NAQKV, D, D, R / 256, 2 * D / 256, 1, R / 256, Qb, D, nullptr, D, (size_t)(WS_K - WS_Q) / 2, 1.0f);
       GEMM_PHASE(pg8::EpiVtT<false>, F.ws + WO_NAQKV + (size_t)2 * D * D * 2, D, F.H, D, D, D / 256, R / 256, 1, D / 256, VTb));
    PH(ph_na_attn(F));
    OUT_PROJ(Ob, F.ws + WO_NAO, 1)
    MOE_PHASES(1, SLOTS / 256, NB * NE * 2, false)
    PH(ph_norm<0, true>(F, 2, 1); convert_moe(F, 2));
    PH(GEMM_PHASE(pg8::EpiQKRope, F.H, D, F.ws + WO_DAQKV, D, D, R / 256, 2 * D / 256, 1, R / 256, Qb, (size_t)(WS_K - WS_Q) / 2, (const float*)(F.ws + WS_ROPE));
       GEMM_PHASE(pg8::EpiVtT<false>, F.ws + WO_DAQKV + (size_t)2 * D * D * 2, D, F.H, D, D, D / 256, R / 256, 1, D / 256, VTb));
    PH(ph_da_attn(F));
    OUT_PROJ(Ob, F.ws + WO_DAO, 2)
    MOE_PHASES(2, SLOTS / 256, NB * NE * 2, false)
    PH(ph_norm<0, true>(F, 3, 2); convert_moe(F, 3));
    PH(GEMM_PHASE(pg8::EpiHgIn, F.H, D, F.ws + WO_HGIN, D, D, R / 256, 4 * D / 256, 1, R / 256, (bf16*)(F.ws + WS_ZIN), (const float*)(F.ws + WS_LB));
       GEMM_PHASE(pg8::EpiVtT<true>, F.ws + WO_HGIN + (size_t)4 * D * D * 2, D, F.H, D, D, D / 256, R / 256, 1, D / 256, (bf16*)(F.ws + WS_VTG)));
    PH(ph_hgrn_scan(F));
    PH(ph_hgrn_post(F));
    PH(GEMM_PHASE_LAT(pg8::EpiResidT, F.ws + WS_O2, D, F.ws + WO_HGO, D, D, D / 256, F.X, MODL(3)));
    MOE_PHASES(3, NB, NB * NE, true)
    PH(ph_norm<2, true, false, true>(F, 0, 3));
}
constexpr int NPH = __COUNTER__ - PH_BASE - 1;

extern "C" void kernel_launch(void* const* d_in, const int* in_sizes, int n_in, void* d_out, int out_size, void* d_ws, size_t ws_size, hipStream_t stream) {
    static int grid = 0;
    if (grid == 0) {
        if (n_in != 33 || ws_size < WS_NEED) { fprintf(stderr, "kernel_launch: n_in %d ws %zu (need %zu)\n", n_in, ws_size, (size_t)WS_NEED); grid = -1; return; }
        int dev = 0, cus = 0;
        if (hipGetDevice(&dev) != hipSuccess || hipDeviceGetAttribute(&cus, hipDeviceAttributeMultiprocessorCount, dev) != hipSuccess) { grid = -1; return; }
        if (hipFuncSetAttribute((const void*)fwd, hipFuncAttributeMaxDynamicSharedMemorySize, LDS_BYTES) != hipSuccess) { fprintf(stderr, "kernel_launch: hipFuncSetAttribute failed\n"); grid = -1; return; }
        int per_cu = 0;
        if (hipOccupancyMaxActiveBlocksPerMultiprocessor(&per_cu, (const void*)fwd, NTHREADS, LDS_BYTES) != hipSuccess || per_cu < 1) fprintf(stderr, "kernel_launch: occupancy query says %d\n", per_cu);
        (void)hipGetLastError();
        grid = cus;
    }
    if (grid < 0) return;
    (void)hipMemsetAsync((char*)d_ws + WS_CTL + (size_t)CW_BAR * 4, 0, (size_t)XCD_BAR_WORDS * 4, stream);
    Args a{};
    for (int i = 0; i < 33; ++i) a.in[i] = (const float*)d_in[i];
    a.out = (float*)d_out; a.ws = (unsigned char*)d_ws;
#if MK_SINGLE
    a.ph_lo = 0; a.ph_hi = NPH;
    hipLaunchKernelGGL(fwd, dim3(grid), dim3(NTHREADS), LDS_BYTES, stream, a);
#else
    for (int k = 0; k < NPH; ++k) { a.ph_lo = k; a.ph_hi = k + 1; hipLaunchKernelGGL(fwd, dim3(grid), dim3(NTHREADS), LDS_BYTES, stream, a); }
#endif
}
```

```cpp
#include <hip/hip_runtime.h>
#include <cstdio>
#include <cstdint>

#ifndef MK_SINGLE
#define MK_SINGLE 1
#endif

typedef unsigned short bf16;
typedef float f32x4 __attribute__((ext_vector_type(4)));
typedef float f32x2 __attribute__((ext_vector_type(2)));
typedef unsigned u32x2 __attribute__((ext_vector_type(2)));
typedef unsigned u32x4 __attribute__((ext_vector_type(4)));
#define LAS __attribute__((address_space(3)))

constexpr int NB = 32, SEQ = 2048, NCTX = 256, D = 1024, P = NCTX + SEQ  , R = NB * P  ;
constexpr int NE = 16, FF = 2048, SLOTS = NB * 256 + NB * 32  ;
constexpr float EPS = 1e-6f;
constexpr float LOG2E_ = 1.4426950408889634f;
constexpr float LAM_INIT = 0.47071302f;
constexpr int NWAVES = 8, NTHREADS = 512;
constexpr int LDS_BYTES = 147456;
constexpr int LDS_MISC = 147456 - 256;

constexpr size_t MiB = 1u << 20;
constexpr size_t WS_CTL = 0, CTL_ZERO_BYTES = 1 * MiB;
constexpr size_t WS_MOD = 1 * MiB;
constexpr size_t WS_AFF = 5 * MiB;
constexpr size_t WS_SEL = 10 * MiB;
constexpr size_t WS_GATE = 11 * MiB;
constexpr size_t WS_INV = 12 * MiB;
constexpr size_t WS_X = 32 * MiB;
constexpr size_t WS_H = 320 * MiB;
constexpr size_t WS_W = 464 * MiB;
constexpr size_t WS_BIG = 720 * MiB;
constexpr size_t WS_HID = WS_BIG;
constexpr size_t WS_Y = WS_BIG + 576 * MiB;
constexpr size_t WS_XS = WS_BIG + 864 * MiB;
constexpr size_t WS_AG = WS_BIG;
constexpr size_t WS_SS = WS_BIG + 216 * MiB;
constexpr size_t WS_Z = WS_BIG + 360 * MiB;
constexpr size_t WS_S5W1 = WS_BIG + 504 * MiB;
constexpr size_t WS_S5W2 = WS_BIG + 520 * MiB;
constexpr size_t WS_S5A = WS_BIG + 568 * MiB;
constexpr size_t WS_Q = WS_BIG, WS_K = WS_BIG + 144 * MiB, WS_V = WS_BIG + 288 * MiB, WS_VT = WS_BIG + 432 * MiB, WS_O = WS_BIG + 576 * MiB;
constexpr size_t WS_ZIN = WS_BIG;
constexpr size_t WS_VTG = WS_BIG + 576 * MiB;
constexpr size_t WS_OFF = WS_BIG + 720 * MiB;
constexpr size_t WS_OFB = WS_BIG + 1008 * MiB;
constexpr size_t WS_O2 = WS_H;
constexpr size_t WS_LB = 17 * MiB;
constexpr size_t WS_ROPE = 18 * MiB;
constexpr size_t WS_NEED = 2048 * MiB;
constexpr size_t WO_GLU = WS_W, WO_NAQKV = WS_W + 4 * MiB, WO_NAO = WS_W + 10 * MiB, WO_DAQKV = WS_W + 12 * MiB, WO_DAO = WS_W + 18 * MiB, WO_HGIN = WS_W + 20 * MiB, WO_HGO = WS_W + 30 * MiB;
constexpr size_t WO_GU = WS_W + 32 * MiB  , WO_DN = WS_W + 160 * MiB  ;
constexpr int CW_BAR = 4096;

__device__ __forceinline__ unsigned f2bf(float f) { unsigned u = __builtin_bit_cast(unsigned, f); return (u + 0x7fffu + ((u >> 16) & 1u)) >> 16; }
__device__ __forceinline__ float bf2f(unsigned h) { return __builtin_bit_cast(float, h << 16); }
__device__ __forceinline__ unsigned pk2(float lo, float hi) { return f2bf(lo) | (f2bf(hi) << 16); }
typedef __bf16 bf16x2_t __attribute__((ext_vector_type(2)));
__device__ __forceinline__ unsigned pkbf(float lo, float hi) { const f32x2 v = {lo, hi}; return __builtin_bit_cast(unsigned, __builtin_convertvector(v, bf16x2_t)); }
__device__ __forceinline__ float bflo(unsigned w) { return __builtin_bit_cast(float, w << 16); }
__device__ __forceinline__ float bfhi(unsigned w) { return __builtin_bit_cast(float, w & 0xffff0000u); }
__device__ __forceinline__ float wave_sum(float v) {
#pragma unroll
    for (int o = 1; o < 64; o <<= 1) v += __shfl_xor(v, o);
    return v;
}
__device__ __forceinline__ float wave_max(float v) {
#pragma unroll
    for (int o = 1; o < 64; o <<= 1) v = fmaxf(v, __shfl_xor(v, o));
    return v;
}
__device__ __forceinline__ float sigmoidf_(float x) { return 1.0f / (1.0f + expf(-x)); }
__device__ __forceinline__ float siluf_(float x) { return x / (1.0f + expf(-x)); }
__device__ __forceinline__ float gelu_tanh(float x) { return 0.5f * x * (1.0f + tanhf(0.7978845608028654f * (x + 0.044715f * x * x * x))); }
__device__ __forceinline__ float dpp_xor1(float v) { return __builtin_bit_cast(float, __builtin_amdgcn_update_dpp(0, __builtin_bit_cast(int, v), 0xB1, 0xF, 0xF, true)); }
__device__ __forceinline__ float dpp_xor2(float v) { return __builtin_bit_cast(float, __builtin_amdgcn_update_dpp(0, __builtin_bit_cast(int, v), 0x4E, 0xF, 0xF, true)); }
__device__ __forceinline__ float reduce16(float (&v)[16], int lane) {
    const bool b0 = lane & 1, b1 = lane & 2, b2 = lane & 4, b3 = lane & 8;
    float a[8];
#pragma unroll
    for (int k = 0; k < 8; ++k) { const float snd = b0 ? v[k] : v[8 + k], kep = b0 ? v[8 + k] : v[k]; a[k] = kep + dpp_xor1(snd); }
    float c[4];
#pragma unroll
    for (int k = 0; k < 4; ++k) { const float snd = b1 ? a[k] : a[4 + k], kep = b1 ? a[4 + k] : a[k]; c[k] = kep + dpp_xor2(snd); }
    float d[2];
#pragma unroll
    for (int k = 0; k < 2; ++k) { const float snd = b2 ? c[k] : c[2 + k], kep = b2 ? c[2 + k] : c[k]; d[k] = kep + __shfl_xor(snd, 4); }
    float r = (b3 ? d[1] : d[0]) + __shfl_xor(b3 ? d[0] : d[1], 8);
    r += __shfl_xor(r, 16); r += __shfl_xor(r, 32);
    return r;
}
#define WAVE_LDS_SYNC() asm volatile("s_waitcnt lgkmcnt(0)" ::: "memory")

#define XB_TMO      128
#define XB_XCNT(j)  (256  + 64 * (j))
#define XB_XSUB(j)  (1280 + 64 * (j))
#define XB_XGEN(j)  (2304 + 64 * (j))
#define XB_TOP      3328
#define XB_TOPGEN   3392
#define XCD_BAR_WORDS 3456
#define XB_SPIN_CAP (1u << 27)
__device__ __forceinline__ unsigned xb_ld(unsigned* p)              { return __hip_atomic_load(p, __ATOMIC_RELAXED, __HIP_MEMORY_SCOPE_AGENT); }
__device__ __forceinline__ unsigned xb_add(unsigned* p, unsigned v) { return __hip_atomic_fetch_add(p, v, __ATOMIC_RELAXED, __HIP_MEMORY_SCOPE_AGENT); }
__device__ __forceinline__ unsigned xb_xcc_id() { return (unsigned)__builtin_amdgcn_s_getreg((3 << 11) | 20) & 0xFu; }
#define XB_SPIN(cond, bar) do { unsigned _sp = 0; while (cond) { __builtin_amdgcn_s_sleep(1); \
    if ((++_sp & 255u) == 0u) { if (xb_ld(&(bar)[XB_TMO])) break; if (_sp > XB_SPIN_CAP) { atomicAdd(&(bar)[XB_TMO], 1u); break; } } } } while (0)
struct XcdBarrier { unsigned* bar; unsigned x; volatile LAS unsigned* st; };
__device__ __forceinline__ XcdBarrier xcd_barrier_post(unsigned* bar, volatile LAS unsigned* st, int tid_) {
    XcdBarrier b; b.bar = bar; b.x = xb_xcc_id(); b.st = st;
    if (tid_ == 0) (void)xb_add(&bar[XB_XCNT(b.x)], 1u);
    return b;
}
__device__ __forceinline__ void xcd_barrier_complete(unsigned* bar, unsigned x, unsigned& nloc, unsigned& nx) {
    const unsigned G = gridDim.x * gridDim.y * gridDim.z;
    unsigned sum, cnt, mine, sp = 0u;
    for (;;) {
        sum = 0u; cnt = 0u; mine = 0u;
#pragma unroll
        for (unsigned j = 0; j < 16; ++j) { const unsigned c = xb_ld(&bar[XB_XCNT(j)]); sum += c; cnt += (c > 0u) ? 1u : 0u; mine = (j == x) ? c : mine; }
        if (sum == G) break;
        __builtin_amdgcn_s_sleep(1);
        if ((++sp & 255u) == 0u) { if (xb_ld(&bar[XB_TMO])) break; if (sp > XB_SPIN_CAP) { atomicAdd(&bar[XB_TMO], 1u); break; } }
    }
    nloc = mine > 0u ? mine : 1u; nx = cnt > 0u ? cnt : 1u;
}
__device__ __forceinline__ void xcd_barrier(const XcdBarrier& b, int tid_) {
    asm volatile("s_waitcnt vmcnt(0)" ::: "memory");
    __syncthreads();
    if (tid_ == 0) {
        unsigned* bar = b.bar;
        __builtin_amdgcn_s_waitcnt(0);
        unsigned nloc = b.st[0], nx = b.st[1];
        if (nloc == 0u) { xcd_barrier_complete(bar, b.x, nloc, nx); b.st[0] = nloc; b.st[1] = nx; }
        const unsigned old = xb_add(&bar[XB_XSUB(b.x)], 1u);
        const unsigned gen = old / nloc;
        if (old + 1u == (gen + 1u) * nloc) {
            __builtin_amdgcn_fence(__ATOMIC_RELEASE, "agent");
            asm volatile("s_waitcnt vmcnt(0)" ::: "memory");
            const unsigned og = xb_add(&bar[XB_TOP], 1u);
            const unsigned tg = og / nx;
            if (og + 1u == (tg + 1u) * nx) xb_add(&bar[XB_TOPGEN], 1u);
            else XB_SPIN(xb_ld(&bar[XB_TOPGEN]) == tg, bar);
            __builtin_amdgcn_fence(__ATOMIC_ACQUIRE, "agent");
            xb_add(&bar[XB_XGEN(b.x)], 1u);
            asm volatile("s_waitcnt vmcnt(0)" ::: "memory");
        } else {
            XB_SPIN(xb_ld(&bar[XB_XGEN(b.x)]) == gen, bar);
            __builtin_amdgcn_fence(__ATOMIC_ACQUIRE, "agent");
            asm volatile("s_waitcnt vmcnt(0)" ::: "memory");
        }
    }
    __syncthreads();
}

namespace pg8 {
#define PG8_LAS __attribute__((address_space(3)))
typedef unsigned short bf16_t;
typedef short bf16x8 __attribute__((ext_vector_type(8)));
typedef float f32x4 __attribute__((ext_vector_type(4)));
typedef unsigned u32x4 __attribute__((ext_vector_type(4)));
constexpr int BM = 256, BK = 64, HALF = 128, HTB = HALF * BK * 2  , STAGE_BYTES = 8 * HTB, NXCD = 8, WGM = 8;

__host__ __device__ __forceinline__ int lds_byte(int r, int c) { const int st = (r >> 4) * 2 + (c >> 5), rr = r & 15, cc = c & 31, ob = rr * 64 + cc * 2; return st * 1024 + (ob ^ (((ob >> 9) & 1) << 5)); }
__host__ __device__ __forceinline__ void stage_rc(int b, int& R, int& C) { const int st = b / 1024, sb = b % 1024, swz = sb ^ (((sb >> 9) & 1) << 5); R = (st >> 1) * 16 + swz / 64; C = (st & 1) * 32 + (swz % 64) / 2; }
__host__ __device__ __forceinline__ int perm32(int rho) { const int n = rho >> 4, i = rho & 15; return 8 * (i >> 2) + 4 * n + (i & 3); }

struct Unit { int pm, pn; };
struct Gemm { const bf16_t* A; const bf16_t* Bt; int lda, ldb, K; const int* rowidx; };

struct StaticOrder {
    int nM, nN, nwg, G, c;
    __host__ __device__ void init(int M, int N, int G_, int c_) { nM = M / BM; nN = N / BM; nwg = nM * nN; G = G_; c = c_; }
    __host__ __device__ bool next(int i, Unit& u) const {
        const long L = (long)i * G + c; if (L >= nwg) return false;
        int wgid = (int)L; { const int q = nwg / NXCD, r = nwg % NXCD, xcd = wgid % NXCD, off = wgid / NXCD; wgid = (xcd < r ? xcd * (q + 1) : r * (q + 1) + (xcd - r) * q) + off; }
        const int nig = WGM * nN, gid = wgid / nig, fm = gid * WGM, gsz = (nM - fm) < WGM ? (nM - fm) : WGM;
        u.pm = fm + ((wgid % nig) % gsz); u.pn = (wgid % nig) / gsz; return true;
    }
    __device__ __forceinline__ void a_ready(const Unit&) const {}
    __device__ __forceinline__ void done(const Unit&) const {}
};

__device__ __forceinline__ unsigned cvt_pk_bf16(float lo, float hi) { unsigned r; asm volatile("v_cvt_pk_bf16_f32 %0, %1, %2" : "=v"(r) : "v"(lo), "v"(hi)); return r; }
typedef float f32x2 __attribute__((ext_vector_type(2)));
__device__ __forceinline__ f32x2 gelu_pk(f32x2 v) {
    const f32x2 av = __builtin_elementwise_abs(v), d = av * 0.2316418882f + 1.0f;
    f32x2 t; t.x = __builtin_amdgcn_rcpf(d.x); t.y = __builtin_amdgcn_rcpf(d.y);
    f32x2 q = t * 0.5307027145f + (-0.7265760135f); q = q * t + 0.7107068705f; q = q * t + (-0.142248368f); q = q * t + 0.127414796f; q = q * t;
    const f32x2 s = (v * v) * (-0.72134752044f);
    f32x2 e; e.x = __builtin_amdgcn_exp2f(s.x); e.y = __builtin_amdgcn_exp2f(s.y);
    const f32x2 m = v * (q * e), r = v - m;
    f32x2 o; o.x = v.x < 0.f ? m.x : r.x; o.y = v.y < 0.f ? m.y : r.y; return o;
}

template <int ACT  > struct EpiBf16 {
    static constexpr bool PERM = true, AFTER_DRAIN = false; static_assert(ACT == 0 || ACT == 1, "EpiBf16: ACT is 0 (none) or 1 (gelu_pk)");
    bf16_t* O; int ldc; const float* bias; int split_cols; size_t split_stride; float scale0;
    __device__ __forceinline__ void operator()(const f32x4 (&acc)[2][2][4][2], const Unit& u, int wr, int wc, int fr, int fq) const {
        const int row0 = u.pm * BM + wr * 64 + fr; int colt = u.pn * BM; bf16_t* base = O;
        float sc = 1.f; if (split_cols) { const int t = colt / split_cols; base += (size_t)t * split_stride; colt -= t * split_cols; if (t == 0) sc = scale0; }
        const int col0 = colt + wc * 32 + 8 * fq, bcol0 = u.pn * BM + wc * 32 + 8 * fq;
        f32x4 bv[2][2];
#pragma unroll
        for (int bj = 0; bj < 2; ++bj)
#pragma unroll
            for (int n = 0; n < 2; ++n) bv[bj][n] = bias ? *(const f32x4*)(bias + bcol0 + bj * HALF + 4 * n) : (f32x4){0.f, 0.f, 0.f, 0.f};
#pragma unroll
        for (int ai = 0; ai < 2; ++ai)
#pragma unroll
            for (int m = 0; m < 4; ++m) { bf16_t* rowp = base + (size_t)(row0 + ai * HALF + m * 16) * ldc + col0;
#pragma unroll
                for (int bj = 0; bj < 2; ++bj) { f32x4 v0 = acc[ai][bj][m][0] + bv[bj][0], v1 = acc[ai][bj][m][1] + bv[bj][1];
                    if (ACT == 1) { f32x2 a = gelu_pk((f32x2){v0[0], v0[1]}), b = gelu_pk((f32x2){v0[2], v0[3]}), c = gelu_pk((f32x2){v1[0], v1[1]}), d = gelu_pk((f32x2){v1[2], v1[3]});
                        v0 = (f32x4){a.x, a.y, b.x, b.y}; v1 = (f32x4){c.x, c.y, d.x, d.y}; }
                    v0 = v0 * sc; v1 = v1 * sc; u32x4 w; w.x = cvt_pk_bf16(v0[0], v0[1]); w.y = cvt_pk_bf16(v0[2], v0[3]); w.z = cvt_pk_bf16(v1[0], v1[1]); w.w = cvt_pk_bf16(v1[2], v1[3]);
                    *(u32x4*)(rowp + bj * HALF) = w; } }
    }
};


struct GroupedOrder {
    int nM, nN, groups, gsM, G, c, total;
    __host__ __device__ void init(int nM_, int nN_, int groups_, int gsM_, int G_, int c_) { nM = nM_; nN = nN_; groups = groups_; gsM = gsM_; G = G_; c = c_; total = nM * nN * groups; }
    __host__ __device__ bool next(int i, Unit& u) const {
        const long L = (long)i * G + c; if (L >= total) return false;
        int T = (int)L; { const int q = total / NXCD, r = total % NXCD, xcd = T % NXCD, off = T / NXCD; T = (xcd < r ? xcd * (q + 1) : r * (q + 1) + (xcd - r) * q) + off; }
        const int tpg = nM * nN, g = T / tpg, t = T - g * tpg;
        const int nig = WGM * nN, gid = t / nig, fm = gid * WGM, gsz = (nM - fm) < WGM ? (nM - fm) : WGM;
        u.pm = g * gsM + fm + ((t % nig) % gsz); u.pn = g * nN + (t % nig) / gsz; return true;
    }
    __device__ __forceinline__ void a_ready(const Unit&) const {}
    __device__ __forceinline__ void done(const Unit&) const {}
};
struct LatentOrder {
    GroupedOrder o;
    __host__ __device__ void init(int nN_, int G_, int c_) { o.init(256, nN_, 1, 256, G_, c_); }
    __host__ __device__ bool next(int i, Unit& u) const { if (!o.next(i, u)) return false; u.pm += (u.pm >> 3) + 1; return true; }
    __device__ __forceinline__ void a_ready(const Unit&) const {}
    __device__ __forceinline__ void done(const Unit&) const {}
};
__device__ __forceinline__ float sigm(float x) { return __builtin_amdgcn_rcpf(1.0f + __builtin_amdgcn_exp2f(x * -1.4426950408889634f)); }
constexpr int PP = 2304, DD = 1024;
__device__ __forceinline__ int mrow_of(int row) { const int b = row / PP, pos = row - b * PP; return pos < 256 ? 32 : b; }
struct EpiResidT {
    static constexpr bool PERM = false, AFTER_DRAIN = false;
    bf16_t* X; const float* MODL;
    __device__ __forceinline__ void operator()(const f32x4 (&acc)[2][2][4][2], const Unit& u, int wr, int wc, int fr, int fq) const {
        const int row0 = u.pm * BM + wr * 64 + fr, col0 = u.pn * BM + wc * 32 + 4 * fq;
#pragma unroll
        for (int ai = 0; ai < 2; ++ai)
#pragma unroll
            for (int m = 0; m < 4; ++m) { const int row = row0 + ai * HALF + m * 16; bf16_t* x = X + (size_t)row * DD + col0; const float* g = MODL + (size_t)mrow_of(row) * 6144 + 2 * DD + col0;
                u32x2 xo[2][2];
#pragma unroll
                for (int bj = 0; bj < 2; ++bj)
#pragma unroll
                    for (int n = 0; n < 2; ++n) xo[bj][n] = *(const u32x2*)(x + bj * HALF + n * 16);
#pragma unroll
                for (int bj = 0; bj < 2; ++bj)
#pragma unroll
                    for (int n = 0; n < 2; ++n) { const int o = bj * HALF + n * 16; const f32x4 xv = {bflo(xo[bj][n].x), bfhi(xo[bj][n].x), bflo(xo[bj][n].y), bfhi(xo[bj][n].y)};
                        const f32x4 r = xv + *(const f32x4*)(g + o) * acc[ai][bj][m][n]; u32x2 w; w.x = pkbf(r.x, r.y); w.y = pkbf(r.z, r.w); *(u32x2*)(x + o) = w; } }
    }
};
struct EpiGluT {
    static constexpr bool PERM = true, AFTER_DRAIN = false;
    bf16_t* X; const float* MODL;
    __device__ __forceinline__ void operator()(const f32x4 (&acc)[2][2][4][2], const Unit& u, int wr, int wc, int fr, int fq) const {
        const int row0 = u.pm * BM + wr * 64 + fr, f0 = u.pn * 128 + wc * 32 + 8 * fq;
#pragma unroll
        for (int ai = 0; ai < 2; ++ai)
#pragma unroll
            for (int m = 0; m < 4; ++m) { const int row = row0 + ai * HALF + m * 16; bf16_t* x = X + (size_t)row * DD + f0; const float* g = MODL + (size_t)mrow_of(row) * 6144 + 2 * DD + f0;
                const u32x4 xo = *(const u32x4*)x; u32x4 w;
#pragma unroll
                for (int n = 0; n < 2; ++n) { const f32x4 a = acc[ai][0][m][n], b = acc[ai][1][m][n]; f32x4 v = b * -1.4426950408889634f;
#pragma unroll
                    for (int q = 0; q < 4; ++q) v[q] = __builtin_amdgcn_exp2f(v[q]);
                    v = v + 1.0f;
#pragma unroll
                    for (int q = 0; q < 4; ++q) v[q] = __builtin_amdgcn_rcpf(v[q]);
                    v = v * a;
                    const unsigned x01 = n ? xo.z : xo.x, x23 = n ? xo.w : xo.y; const f32x4 xv = {bflo(x01), bfhi(x01), bflo(x23), bfhi(x23)};
                    const f32x4 r = xv + *(const f32x4*)(g + 4 * n) * v; if (n) { w.z = pkbf(r.x, r.y); w.w = pkbf(r.z, r.w); } else { w.x = pkbf(r.x, r.y); w.y = pkbf(r.z, r.w); } }
                *(u32x4*)x = w; }
    }
};
struct EpiSwigluT {
    static constexpr bool PERM = true, AFTER_DRAIN = false;
    bf16_t* HID; int nNg; int ldh;
    __device__ __forceinline__ void operator()(const f32x4 (&acc)[2][2][4][2], const Unit& u, int wr, int wc, int fr, int fq) const {
        const int row0 = u.pm * BM + wr * 64 + fr, f0 = (u.pn % nNg) * 128 + wc * 32 + 8 * fq;
#pragma unroll
        for (int ai = 0; ai < 2; ++ai)
#pragma unroll
            for (int m = 0; m < 4; ++m) { bf16_t* hp = HID + (size_t)(row0 + ai * HALF + m * 16) * ldh + f0;
                const f32x4 a0 = acc[ai][0][m][0], a1 = acc[ai][0][m][1], b0 = acc[ai][1][m][0], b1 = acc[ai][1][m][1];
                f32x4 e0 = a0 * -1.4426950408889634f, e1 = a1 * -1.4426950408889634f;
#pragma unroll
                for (int q = 0; q < 4; ++q) { e0[q] = __builtin_amdgcn_exp2f(e0[q]); e1[q] = __builtin_amdgcn_exp2f(e1[q]); }
                e0 = e0 + 1.0f; e1 = e1 + 1.0f;
#pragma unroll
                for (int q = 0; q < 4; ++q) { e0[q] = __builtin_amdgcn_rcpf(e0[q]); e1[q] = __builtin_amdgcn_rcpf(e1[q]); }
                const f32x4 o0 = (a0 * b0) * e0, o1 = (a1 * b1) * e1;
                u32x4 w; w.x = cvt_pk_bf16(o0.x, o0.y); w.y = cvt_pk_bf16(o0.z, o0.w); w.z = cvt_pk_bf16(o1.x, o1.y); w.w = cvt_pk_bf16(o1.z, o1.w);
                *(u32x4*)hp = w; }
    }
};
struct EpiDownT {
    static constexpr bool PERM = true, AFTER_DRAIN = false;
    bf16_t* Y; const float* GATE; int nNg;
    __device__ __forceinline__ void operator()(const f32x4 (&acc)[2][2][4][2], const Unit& u, int wr, int wc, int fr, int fq) const {
        const int row0 = u.pm * BM + wr * 64 + fr, col0 = (u.pn % nNg) * BM + wc * 32 + 8 * fq;
#pragma unroll
        for (int ai = 0; ai < 2; ++ai)
#pragma unroll
            for (int m = 0; m < 4; ++m) { const int row = row0 + ai * HALF + m * 16; bf16_t* rowp = Y + (size_t)row * DD + col0;
#pragma unroll
                for (int bj = 0; bj < 2; ++bj) { const f32x4 v0 = acc[ai][bj][m][0], v1 = acc[ai][bj][m][1];
                    u32x4 w; w.x = cvt_pk_bf16(v0[0], v0[1]); w.y = cvt_pk_bf16(v0[2], v0[3]); w.z = cvt_pk_bf16(v1[0], v1[1]); w.w = cvt_pk_bf16(v1[2], v1[3]);
                    *(u32x4*)(rowp + bj * HALF) = w; } }
    }
};
template <bool SILU> struct EpiVtT {
    static constexpr bool PERM = true, AFTER_DRAIN = false;
    bf16_t* VT;
    __device__ __forceinline__ void operator()(const f32x4 (&acc)[2][2][4][2], const Unit& u, int wr, int wc, int fr, int fq) const {
        const int hd0 = u.pm * BM + wr * 64 + fr, tok0 = u.pn * BM + wc * 32 + 8 * fq, b = (u.pn * BM) / PP, pos0 = tok0 - b * PP;
#pragma unroll
        for (int ai = 0; ai < 2; ++ai)
#pragma unroll
            for (int m = 0; m < 4; ++m) { bf16_t* rowp = VT + ((size_t)b * DD + hd0 + ai * HALF + m * 16) * PP + pos0;
#pragma unroll
                for (int bj = 0; bj < 2; ++bj) { f32x4 v0 = acc[ai][bj][m][0], v1 = acc[ai][bj][m][1];
                    if (SILU) {
#pragma unroll
                        for (int q = 0; q < 4; ++q) { v0[q] = v0[q] * sigm(v0[q]); v1[q] = v1[q] * sigm(v1[q]); } }
                    u32x4 w; w.x = cvt_pk_bf16(v0[0], v0[1]); w.y = cvt_pk_bf16(v0[2], v0[3]); w.z = cvt_pk_bf16(v1[0], v1[1]); w.w = cvt_pk_bf16(v1[2], v1[3]);
                    *(u32x4*)(rowp + bj * HALF) = w; } }
    }
};
struct EpiHgIn {
    static constexpr bool PERM = true, AFTER_DRAIN = false;
    bf16_t* O; const float* LB;
    __device__ __forceinline__ void operator()(const f32x4 (&acc)[2][2][4][2], const Unit& u, int wr, int wc, int fr, int fq) const {
        const int row0 = u.pm * BM + wr * 64 + fr, col0 = u.pn * BM + wc * 32 + 8 * fq, type = u.pn >> 2;
#pragma unroll
        for (int ai = 0; ai < 2; ++ai)
#pragma unroll
            for (int m = 0; m < 4; ++m) { bf16_t* rowp = O + (size_t)(row0 + ai * HALF + m * 16) * 4096 + col0;
#pragma unroll
                for (int bj = 0; bj < 2; ++bj) { f32x4 v0 = acc[ai][bj][m][0], v1 = acc[ai][bj][m][1];
                    if (type == 1 || type == 2) { const int c = (col0 + bj * HALF) & 1023; const f32x4 l0 = *(const f32x4*)(LB + c), l1 = *(const f32x4*)(LB + c + 4);
#pragma unroll
                        for (int q = 0; q < 4; ++q) { v0[q] = __log2f(l0[q] + (1.0f - l0[q]) * sigm(v0[q])); v1[q] = __log2f(l1[q] + (1.0f - l1[q]) * sigm(v1[q])); } }
                    else if (type == 3) {
#pragma unroll
                        for (int q = 0; q < 4; ++q) { v0[q] = v0[q] * sigm(v0[q]); v1[q] = v1[q] * sigm(v1[q]); } }
                    u32x4 w; w.x = cvt_pk_bf16(v0[0], v0[1]); w.y = cvt_pk_bf16(v0[2], v0[3]); w.z = cvt_pk_bf16(v1[0], v1[1]); w.w = cvt_pk_bf16(v1[2], v1[3]);
                    *(u32x4*)(rowp + bj * HALF) = w; } }
    }
};


struct EpiF32G {
    static constexpr bool PERM = false, AFTER_DRAIN = false;
    float* C; int ldc; int nNg;
    __device__ __forceinline__ void operator()(const f32x4 (&acc)[2][2][4][2], const Unit& u, int wr, int wc, int fr, int fq) const {
        const int row0 = u.pm * BM + wr * 64 + fr, col0 = (u.pn % nNg) * BM + wc * 32 + 4 * fq;
#pragma unroll
        for (int ai = 0; ai < 2; ++ai)
#pragma unroll
            for (int m = 0; m < 4; ++m) { float* rowp = C + (size_t)(row0 + ai * HALF + m * 16) * ldc + col0;
#pragma unroll
                for (int bj = 0; bj < 2; ++bj)
#pragma unroll
                    for (int n = 0; n < 2; ++n) *(f32x4*)(rowp + bj * HALF + n * 16) = acc[ai][bj][m][n]; }
    }
};
__device__ __forceinline__ float gelu_t(float x) { const float t = 1.5957691216057308f * (x + 0.044715f * x * x * x); return x * sigm(t); }
struct EpiS5Out {
    static constexpr bool PERM = true, AFTER_DRAIN = false;
    const bf16_t* H; bf16_t* Z; const float* dvec;
    __device__ __forceinline__ void operator()(const f32x4 (&acc)[2][2][4][2], const Unit& u, int wr, int wc, int fr, int fq) const {
        const int c0 = (u.pn & 1) * BM + wc * 32 + 8 * fq;
#pragma unroll
        for (int ai = 0; ai < 2; ++ai)
#pragma unroll
            for (int m = 0; m < 4; ++m) {
                const int rg = u.pm * BM + ai * HALF + wr * 64 + m * 16 + fr, g = rg / 2304, rem = rg - g * 2304, b = rem / 72, j = rem - b * 72;
#pragma unroll
                for (int bj = 0; bj < 2; ++bj) {
                    const int mc = c0 + bj * HALF, tau = mc >> 4, k0 = mc & 15;
                    const size_t off = ((size_t)b * PP + 32 * j + tau) * DD + g * 16 + k0;
                    const u32x4 uw = *(const u32x4*)(H + off);
                    const f32x4 d0 = *(const f32x4*)(dvec + g * 16 + k0), d1 = *(const f32x4*)(dvec + g * 16 + k0 + 4);
                    const f32x4 y0 = acc[ai][bj][m][0], y1 = acc[ai][bj][m][1];
                    u32x4 w;
                    w.x = cvt_pk_bf16(gelu_t(y0[0] + d0[0] * __uint_as_float(uw.x << 16)), gelu_t(y0[1] + d0[1] * __uint_as_float(uw.x & 0xffff0000u)));
                    w.y = cvt_pk_bf16(gelu_t(y0[2] + d0[2] * __uint_as_float(uw.y << 16)), gelu_t(y0[3] + d0[3] * __uint_as_float(uw.y & 0xffff0000u)));
                    w.z = cvt_pk_bf16(gelu_t(y1[0] + d1[0] * __uint_as_float(uw.z << 16)), gelu_t(y1[1] + d1[1] * __uint_as_float(uw.z & 0xffff0000u)));
                    w.w = cvt_pk_bf16(gelu_t(y1[2] + d1[2] * __uint_as_float(uw.w << 16)), gelu_t(y1[3] + d1[3] * __uint_as_float(uw.w & 0xffff0000u)));
                    *(u32x4*)(Z + off) = w;
                }
            }
    }
};


struct EpiQKRope {
    static constexpr bool PERM = true, AFTER_DRAIN = false;
    bf16_t* Q; size_t kstride; const float* T;
    __device__ __forceinline__ void operator()(const f32x4 (&acc)[2][2][4][2], const Unit& u, int wr, int wc, int fr, int fq) const {
        const int row0 = u.pm * BM + wr * 64 + fr; int colt = u.pn * BM; bf16_t* base = Q;
        { const int t = colt / DD; base += (size_t)t * kstride; colt -= t * DD; }
        const int col0 = colt + wc * 32 + 8 * fq, half = wc & 1; const bool first = fq < 2;
        const float qs = u.pn * BM < DD ? 0.125f * 1.4426950408889634f : 1.0f;
#pragma unroll
        for (int ai = 0; ai < 2; ++ai)
#pragma unroll
            for (int m = 0; m < 4; ++m) { const int row = row0 + ai * HALF + m * 16, b = row / PP, pos = row - b * PP, tt = pos - 256; const bool lat = pos >= 256;
                const int p = lat ? (half ? (tt & 63) : (tt >> 6)) : 0;
                const f32x4* cs = (const f32x4*)(T + (p * 16 + 8 * (fq & 1)) * 2);
                const f32x4 t0 = cs[0], t1 = cs[1], t2 = cs[2], t3 = cs[3];
                bf16_t* rowp = base + (size_t)row * DD + col0;
#pragma unroll
                for (int bj = 0; bj < 2; ++bj) { f32x4 v0 = acc[ai][bj][m][0] * qs, v1 = acc[ai][bj][m][1] * qs;
                    f32x4 p0, p1;
#pragma unroll
                    for (int q = 0; q < 4; ++q) { p0[q] = __shfl_xor(v0[q], 32); p1[q] = __shfl_xor(v1[q], 32); }
                    if (lat) { const float sg = first ? -1.0f : 1.0f;
                        v0 = (f32x4){v0[0] * t0[0] + sg * p0[0] * t0[1], v0[1] * t0[2] + sg * p0[1] * t0[3], v0[2] * t1[0] + sg * p0[2] * t1[1], v0[3] * t1[2] + sg * p0[3] * t1[3]};
                        v1 = (f32x4){v1[0] * t2[0] + sg * p1[0] * t2[1], v1[1] * t2[2] + sg * p1[1] * t2[3], v1[2] * t3[0] + sg * p1[2] * t3[1], v1[3] * t3[2] + sg * p1[3] * t3[3]}; }
                    u32x4 w; w.x = cvt_pk_bf16(v0[0], v0[1]); w.y = cvt_pk_bf16(v0[2], v0[3]); w.z = cvt_pk_bf16(v1[0], v1[1]); w.w = cvt_pk_bf16(v1[2], v1[3]);
                    *(u32x4*)(rowp + bj * HALF) = w; } }
    }
};

template <class Epi, class Sched, bool ALIGN_EPI = false, bool SP2 = false, bool GATHER = false>
__device__ __forceinline__ void gemm_phase(PG8_LAS unsigned char* lds, const Gemm g, const Sched& S, const Epi& E, const int tid) {
    const int wid = __builtin_amdgcn_readfirstlane(tid >> 6), lane = tid & 63, wr = wid >> 2, wc = wid & 3, fr = lane & 15, fq = lane >> 4;
    const int K = g.K, nt = K / BK;
    unsigned voffA[2], voffB[2];
#pragma unroll
    for (int i = 0; i < 2; ++i) { int R, C; stage_rc(tid * 16 + i * 8192, R, C); const int Rb = Epi::PERM ? ((R & ~31) + perm32(R & 31)) : R;
        voffA[i] = (unsigned)(R * g.lda + C) * 2u; voffB[i] = (unsigned)(Rb * g.ldb + C) * 2u; }
    unsigned vA0[2] = {0u, 0u}, vA1[2] = {0u, 0u}, wA0[2] = {0u, 0u}, wA1[2] = {0u, 0u};
#define PG8_GOFF(u_, o0, o1) do { _Pragma("unroll") for (int i = 0; i < 2; ++i) { int R, C; stage_rc(tid * 16 + i * 8192, R, C); const int r0_ = (u_).pm * BM + R; \
        o0[i] = ((unsigned)g.rowidx[r0_] * (unsigned)g.lda + (unsigned)C) * 2u; o1[i] = ((unsigned)g.rowidx[r0_ + HALF] * (unsigned)g.lda + (unsigned)C) * 2u; } } while (0)
    const size_t kstep = (size_t)(BK * 2);
    const size_t hstepA = (size_t)HALF * g.lda * 2, hstepB = (size_t)HALF * g.ldb * 2;
    const size_t tstepA = 2 * hstepA, tstepB = 2 * hstepB;
    const unsigned ldsw = (unsigned)wid * 1024u;
    const int aoff = lds_byte(wr * 64 + fr, fq * 8), boff = lds_byte(wc * 32 + fr, fq * 8);
#define PG8_SA(b, h) (((b) * 2 + (h)) * HTB)
#define PG8_SB(b, h) ((4 + (b) * 2 + (h)) * HTB)
#define PG8_STAGE(bufoff, gbase, voff) do { _Pragma("unroll") for (int _i = 0; _i < 2; ++_i) \
        __builtin_amdgcn_global_load_lds((const unsigned*)((const char*)(gbase) + (voff)[_i]), (PG8_LAS unsigned*)(lds + (bufoff) + ldsw + _i * 8192), 16, 0, 0); } while (0)
#define PG8_STAGEA(bufoff, kptr, h, oc0, oc1) do { if constexpr (GATHER) { if (h) PG8_STAGE(bufoff, kptr, oc1); else PG8_STAGE(bufoff, kptr, oc0); } else { PG8_STAGE(bufoff, (kptr) + ((h) ? hstepA : 0), voffA); } } while (0)
#define PG8_LDA(dst, b, h) do { _Pragma("unroll") for (int m = 0; m < 4; ++m) _Pragma("unroll") for (int k = 0; k < 2; ++k) dst[m][k] = *(const PG8_LAS bf16x8*)(lds + PG8_SA(b, h) + aoff + m * 2048 + k * 1024); } while (0)
#define PG8_LDB(dst, b, h) do { _Pragma("unroll") for (int n = 0; n < 2; ++n) _Pragma("unroll") for (int k = 0; k < 2; ++k) dst[n][k] = *(const PG8_LAS bf16x8*)(lds + PG8_SB(b, h) + boff + n * 2048 + k * 1024); } while (0)
#define PG8_MMA(ai, bj, At, Bt) do { __builtin_amdgcn_s_setprio(1); _Pragma("unroll") for (int m = 0; m < 4; ++m) _Pragma("unroll") for (int n = 0; n < 2; ++n) _Pragma("unroll") for (int k = 0; k < 2; ++k) \
        acc[ai][bj][m][n] = __builtin_amdgcn_mfma_f32_16x16x32_bf16(Bt[n][k], At[m][k], acc[ai][bj][m][n], 0, 0, 0); __builtin_amdgcn_s_setprio(0); } while (0)
#define PG8_WAIT_V(n) asm volatile("s_waitcnt vmcnt(" #n ")" ::: "memory")
#define PG8_WAIT_L(n) asm volatile("s_waitcnt lgkmcnt(" #n ")" ::: "memory")
#define PG8_BAR __builtin_amdgcn_s_barrier()
#define PG8_SCHED __builtin_amdgcn_sched_barrier(0)
    Unit cur, nxt; int ui = 0;
    if (!S.next(0, cur)) return;
    f32x4 acc[2][2][4][2];
#pragma unroll
    for (int a = 0; a < 2; ++a)
#pragma unroll
        for (int b = 0; b < 2; ++b)
#pragma unroll
            for (int m = 0; m < 4; ++m)
#pragma unroll
                for (int n = 0; n < 2; ++n) acc[a][b][m][n] = (f32x4){0.f, 0.f, 0.f, 0.f};
    bf16x8 At[4][2], B0[2][2], B1[2][2];
    const char* cA = (const char*)g.A + (GATHER ? (size_t)0 : (size_t)cur.pm * tstepA); if constexpr (GATHER) PG8_GOFF(cur, vA0, vA1);
    const char* cB = (const char*)g.Bt + (size_t)cur.pn * tstepB;
    S.a_ready(cur);
    if constexpr (SP2) {
        PG8_STAGE(PG8_SB(0, 0), cB, voffB); PG8_STAGE(PG8_SB(0, 1), cB + hstepB, voffB); PG8_STAGEA(PG8_SA(0, 0), cA, 0, vA0, vA1); PG8_STAGEA(PG8_SA(0, 1), cA, 1, vA0, vA1);
        if (wr == 1) PG8_BAR;
        PG8_WAIT_V(2); PG8_BAR;
        PG8_STAGE(PG8_SB(1, 0), cB + kstep, voffB); PG8_STAGEA(PG8_SA(1, 0), cA + kstep, 0, vA0, vA1); PG8_STAGE(PG8_SB(1, 1), cB + hstepB + kstep, voffB);
        PG8_WAIT_V(6); PG8_BAR;
    } else {
        PG8_STAGE(PG8_SB(0, 0), cB, voffB); PG8_STAGE(PG8_SA(0, 0), cA, voffA); PG8_STAGE(PG8_SB(0, 1), cB + hstepB, voffB); PG8_STAGE(PG8_SA(0, 1), cA + hstepA, voffA);
        if (wr == 1) PG8_BAR;
        PG8_WAIT_V(4); PG8_BAR;
        PG8_STAGE(PG8_SB(1, 0), cB + kstep, voffB); PG8_STAGE(PG8_SA(1, 0), cA + kstep, voffA); PG8_STAGE(PG8_SB(1, 1), cB + hstepB + kstep, voffB);
        PG8_WAIT_V(6); PG8_BAR;
    }
    for (;;) {
        const bool has_next = S.next(ui + 1, nxt);
        const char* nA = (has_next && !GATHER) ? (const char*)g.A + (size_t)nxt.pm * tstepA : cA;
        if constexpr (GATHER) { if (has_next) { if (wid < 4) __builtin_amdgcn_global_load_lds((const unsigned*)(g.rowidx + (size_t)nxt.pm * BM + (tid & 255)), (PG8_LAS unsigned*)(lds + STAGE_BYTES + wid * 256), 4, 0, 0); }
                                else { wA0[0] = vA0[0]; wA0[1] = vA0[1]; wA1[0] = vA1[0]; wA1[1] = vA1[1]; } }
        const char* nB = has_next ? (const char*)g.Bt + (size_t)nxt.pn * tstepB : cB;
        for (int t = 0; t < nt; t += 2) {
            const bool last = (t == nt - 2);
            const char* a1 = cA + (size_t)(t + 1) * kstep;
            const char* a2 = last ? nA : cA + (size_t)(t + 2) * kstep; const char* b2 = last ? nB : cB + (size_t)(t + 2) * kstep;
            const char* a3 = a2 + kstep; const char* b3 = b2 + kstep;
            if (last && has_next) S.a_ready(nxt);
            if constexpr (GATHER) { if (last && has_next) {
#pragma unroll
                for (int i = 0; i < 2; ++i) { int R, C; stage_rc(tid * 16 + i * 8192, R, C);
                    const unsigned i0_ = *(const PG8_LAS unsigned*)(lds + STAGE_BYTES + R * 4), i1_ = *(const PG8_LAS unsigned*)(lds + STAGE_BYTES + (R + HALF) * 4);
                    wA0[i] = (i0_ * (unsigned)g.lda + (unsigned)C) * 2u; wA1[i] = (i1_ * (unsigned)g.lda + (unsigned)C) * 2u; } } }
            const unsigned sA0[2] = {last ? wA0[0] : vA0[0], last ? wA0[1] : vA0[1]}, sA1[2] = {last ? wA1[0] : vA1[0], last ? wA1[1] : vA1[1]};
            if constexpr (SP2) {
            PG8_LDB(B0, 0, 0); PG8_LDB(B1, 0, 1); PG8_SCHED; PG8_LDA(At, 0, 0); PG8_STAGEA(PG8_SA(1, 1), a1, 1, vA0, vA1);
            PG8_WAIT_V(8); PG8_WAIT_L(0); PG8_BAR; PG8_MMA(0, 0, At, B0); PG8_MMA(0, 1, At, B1); PG8_BAR; PG8_SCHED;
            PG8_LDA(At, 0, 1); PG8_STAGE(PG8_SB(0, 0), b2, voffB); PG8_STAGE(PG8_SB(0, 1), b2 + hstepB, voffB); PG8_STAGEA(PG8_SA(0, 0), a2, 0, sA0, sA1);
            PG8_WAIT_V(8); PG8_WAIT_L(0); PG8_BAR; PG8_MMA(1, 0, At, B0); PG8_MMA(1, 1, At, B1); PG8_BAR; PG8_SCHED;
            PG8_LDB(B0, 1, 0); PG8_LDB(B1, 1, 1); PG8_SCHED; PG8_LDA(At, 1, 0); PG8_STAGEA(PG8_SA(0, 1), a2, 1, sA0, sA1);
            PG8_WAIT_V(8); PG8_WAIT_L(0); PG8_BAR; PG8_MMA(0, 0, At, B0); PG8_MMA(0, 1, At, B1); PG8_BAR; PG8_SCHED;
            PG8_LDA(At, 1, 1); PG8_STAGE(PG8_SB(1, 0), b3, voffB); PG8_STAGE(PG8_SB(1, 1), b3 + hstepB, voffB); PG8_STAGEA(PG8_SA(1, 0), a3, 0, sA0, sA1);
            PG8_WAIT_V(8); PG8_WAIT_L(0); PG8_BAR; PG8_MMA(1, 0, At, B0); PG8_MMA(1, 1, At, B1); PG8_BAR; PG8_SCHED;
            } else {
            PG8_LDB(B0, 0, 0); PG8_SCHED; PG8_LDA(At, 0, 0); PG8_STAGE(PG8_SA(1, 1), a1 + hstepA, voffA);
            PG8_WAIT_L(8); PG8_BAR; PG8_WAIT_L(0); PG8_MMA(0, 0, At, B0); PG8_BAR; PG8_SCHED;
            PG8_LDB(B1, 0, 1); PG8_STAGE(PG8_SB(0, 0), b2, voffB);
            PG8_BAR; PG8_WAIT_L(0); PG8_MMA(0, 1, At, B1); PG8_BAR;
            PG8_LDA(At, 0, 1); PG8_STAGE(PG8_SA(0, 0), a2, voffA);
            PG8_BAR; PG8_WAIT_L(0); PG8_MMA(1, 0, At, B0); PG8_BAR; PG8_SCHED;
            PG8_STAGE(PG8_SB(0, 1), b2 + hstepB, voffB);
            PG8_WAIT_V(6); PG8_BAR; PG8_MMA(1, 1, At, B1); PG8_BAR;
            PG8_LDB(B0, 1, 0); PG8_SCHED; PG8_LDA(At, 1, 0); PG8_STAGE(PG8_SA(0, 1), a2 + hstepA, voffA);
            PG8_WAIT_L(8); PG8_BAR; PG8_WAIT_L(0); PG8_MMA(0, 0, At, B0); PG8_BAR; PG8_SCHED;
            PG8_LDB(B1, 1, 1); PG8_STAGE(PG8_SB(1, 0), b3, voffB);
            PG8_BAR; PG8_WAIT_L(0); PG8_MMA(0, 1, At, B1); PG8_BAR;
            PG8_LDA(At, 1, 1); PG8_STAGE(PG8_SA(1, 0), a3, voffA);
            PG8_BAR; PG8_WAIT_L(0); PG8_MMA(1, 0, At, B0); PG8_BAR; PG8_SCHED;
            PG8_STAGE(PG8_SB(1, 1), b3 + hstepB, voffB);
            PG8_WAIT_V(6); PG8_BAR; PG8_MMA(1, 1, At, B1); PG8_BAR;
            }
        }
        if constexpr (ALIGN_EPI) { if (wr == 0) PG8_BAR; }
        if constexpr (!Epi::AFTER_DRAIN) { E(acc, cur, wr, wc, fr, fq); S.done(cur); }
        if (!has_next) break;
#pragma unroll
        for (int a = 0; a < 2; ++a)
#pragma unroll
            for (int b = 0; b < 2; ++b)
#pragma unroll
                for (int m = 0; m < 4; ++m)
#pragma unroll
                    for (int n = 0; n < 2; ++n) acc[a][b][m][n] = (f32x4){0.f, 0.f, 0.f, 0.f};
        cur = nxt; cA = nA; cB = nB; ++ui; vA0[0] = wA0[0]; vA0[1] = wA0[1]; vA1[0] = wA1[0]; vA1[1] = wA1[1];
        if constexpr (ALIGN_EPI) { if (wr == 1) PG8_BAR; }
    }
    PG8_WAIT_V(0);
    if constexpr (!ALIGN_EPI) { if (wr == 0) PG8_BAR; }
    PG8_BAR;
    if constexpr (Epi::AFTER_DRAIN) { E.fused(acc, cur, wr, wc, fr, fq, lds, wid, lane); S.done(cur); }
#undef PG8_SA
#undef PG8_SB
#undef PG8_STAGE
#undef PG8_STAGEA
#undef PG8_GOFF
#undef PG8_LDA
#undef PG8_LDB
#undef PG8_MMA
#undef PG8_WAIT_V
#undef PG8_WAIT_L
#undef PG8_BAR
#undef PG8_SCHED
}
}
#define PG8_SP2 true
#define PG8_ALIGN true

struct Frame;
struct Args { const float* in[33]; float* out; unsigned char* ws; int ph_lo, ph_hi; };
struct Frame {
    unsigned char* lds;
    int tid, lane, wave, bid, nb;
    const float* const* in;
    float* out; unsigned char* ws;
    float* MOD; float* AFF; int* SEL; float* GATE; int* INV; bf16* X; bf16* H;
};
__device__ __forceinline__ void REFRESH_(Frame& F) { int l_; asm volatile("v_mbcnt_lo_u32_b32 %0, -1, 0\n\tv_mbcnt_hi_u32_b32 %0, -1, %0" : "=v"(l_)); F.lane = l_; F.tid = F.wave * 64 + l_; }
__device__ __forceinline__ int mod_row(int row) { const int b = row / P, pos = row - b * P; return pos < NCTX ? 32 : b; }

__device__ __forceinline__ void ph_s5_pre(const Frame& F) {
    const float *a_re = F.in[8], *a_im = F.in[9], *log_dt = F.in[10], *b_re = F.in[11], *b_im = F.in[12], *c_re = F.in[13], *c_im = F.in[14];
    f32x2* Bb = (f32x2*)F.lds;
    f32x2* Cc = Bb + 2048;
    f32x2* Ap = Cc + 2048;
    float* Kt = (float*)(Ap + 2 * 33 * 64);
    bf16* W1 = (bf16*)(F.ws + WS_S5W1); bf16* W2 = (bf16*)(F.ws + WS_S5W2); f32x2* A32 = (f32x2*)(F.ws + WS_S5A);
    const int tid = F.tid;
    for (int g = F.nb - 1 - F.bid; g < 64; g += F.nb) {
        __syncthreads();
        if (tid < 128) {
            const int dir = tid >> 6, p = tid & 63, dg = dir * 64 + g;
            const double are = (double)a_re[dg * 64 + p], aim = (double)a_im[dg * 64 + p], dt = exp((double)log_dt[dg]);
            const double lr = are * dt, li = aim * dt, cl = cos(li), sl = sin(li), mag = exp(lr);
            const double Abi = mag * sl, sh = sin(0.5 * li), nr = expm1(lr) * cl - 2.0 * sh * sh, den = are * are + aim * aim;
            const double fr = (nr * are + Abi * aim) / den, fi = (Abi * are - nr * aim) / den;
            for (int h = 0; h < 16; ++h) { const double br = (double)b_re[((size_t)dg * 64 + p) * 16 + h], bi = (double)b_im[((size_t)dg * 64 + p) * 16 + h];
                Bb[(dir * 64 + p) * 16 + h] = (f32x2){(float)(fr * br - fi * bi), (float)(fr * bi + fi * br)}; }
            const double Abr = mag * cl; double pr = 1.0, pi = 0.0;
            for (int e = 0; e <= 32; ++e) { const f32x2 v = {(float)pr, (float)pi};
                Ap[(dir * 33 + e) * 64 + p] = v; if (e == 32) A32[(g * 2 + dir) * 64 + p] = v;
                const double nr2 = pr * Abr - pi * Abi, ni2 = pr * Abi + pi * Abr; pr = nr2; pi = ni2; }
        }
        for (int i = tid; i < 2048; i += NTHREADS) { const int dir = i >> 10, k = (i >> 6) & 15, p = i & 63; const size_t o = ((size_t)(dir * 64 + g) * 16 + k) * 64 + p; Cc[i] = (f32x2){c_re[o], c_im[o]}; }
        __syncthreads();
        {
            const int dir = tid >> 8, k = (tid >> 4) & 15, h = tid & 15; float acc[32];
#pragma unroll
            for (int lag = 0; lag < 32; ++lag) acc[lag] = 0.f;
#pragma unroll 2
            for (int p = 0; p < 64; ++p) { const f32x2 c = Cc[(dir * 16 + k) * 64 + p], bb = Bb[(dir * 64 + p) * 16 + h], a1 = Ap[(dir * 33 + 1) * 64 + p];
                float zr = c.x * bb.x - c.y * bb.y, zi = c.x * bb.y + c.y * bb.x;
#pragma unroll
                for (int lag = 0; lag < 32; ++lag) { acc[lag] += zr; const float nz = zr * a1.x - zi * a1.y; zi = zr * a1.y + zi * a1.x; zr = nz; } }
#pragma unroll
            for (int lag = 0; lag < 32; ++lag) Kt[((dir * 32 + lag) * 16 + k) * 16 + h] = acc[lag];
        }
        for (int i = tid; i < 16384; i += NTHREADS) {
            const int n = i >> 6, sg = (i >> 1) & 31, h0 = (i & 1) * 8, dir = n >> 7, c = (n >> 6) & 1, p = n & 63, e = dir ? sg : 31 - sg;
            const f32x2 a = Ap[(dir * 33 + e) * 64 + p]; float v[8];
#pragma unroll
            for (int q = 0; q < 8; ++q) { const f32x2 bb = Bb[(dir * 64 + p) * 16 + h0 + q]; v[q] = c ? a.x * bb.y + a.y * bb.x : a.x * bb.x - a.y * bb.y; }
            u32x4 w; w.x = pk2(v[0], v[1]); w.y = pk2(v[2], v[3]); w.z = pk2(v[4], v[5]); w.w = pk2(v[6], v[7]);
            *(u32x4*)(W1 + ((size_t)g * 256 + n) * 512 + sg * 16 + h0) = w;
        }
        for (int i = tid; i < 16384; i += NTHREADS) {
            const int m = i >> 5, n0 = (i & 31) * 8, dir = n0 >> 7, c = (n0 >> 6) & 1, p0 = n0 & 63, tau = m >> 4, k = m & 15, e = dir ? 32 - tau : tau + 1; float v[8];
#pragma unroll
            for (int q = 0; q < 8; ++q) { const f32x2 cc = Cc[(dir * 16 + k) * 64 + p0 + q], a = Ap[(dir * 33 + e) * 64 + p0 + q]; v[q] = c ? -(cc.x * a.y + cc.y * a.x) : cc.x * a.x - cc.y * a.y; }
            u32x4 w; w.x = pk2(v[0], v[1]); w.y = pk2(v[2], v[3]); w.z = pk2(v[4], v[5]); w.w = pk2(v[6], v[7]);
            *(u32x4*)(W2 + ((size_t)g * 512 + m) * 768 + 512 + n0) = w;
        }
        __syncthreads();
        for (int i = tid; i < 32768; i += NTHREADS) {
            const int m = i >> 6, sg = (i >> 1) & 31, h0 = (i & 1) * 8, tau = m >> 4, k = m & 15; float v[8];
#pragma unroll
            for (int q = 0; q < 8; ++q) { float x = 0.f; if (sg <= tau) x += Kt[((tau - sg) * 16 + k) * 16 + h0 + q]; if (sg >= tau) x += Kt[((32 + sg - tau) * 16 + k) * 16 + h0 + q]; v[q] = x; }
            u32x4 w; w.x = pk2(v[0], v[1]); w.y = pk2(v[2], v[3]); w.z = pk2(v[4], v[5]); w.w = pk2(v[6], v[7]);
            *(u32x4*)(W2 + ((size_t)g * 512 + m) * 768 + sg * 16 + h0) = w;
        }
    }
    __syncthreads();
}
__device__ __forceinline__ void ph_s5_scan(const Frame& F) {
    const float* SS = (const float*)(F.ws + WS_SS); bf16* AG = (bf16*)(F.ws + WS_AG); const f32x2* A32 = (const f32x2*)(F.ws + WS_S5A);
    for (int gid = F.bid * NTHREADS + F.tid; gid < 64 * 32 * 128; gid += F.nb * NTHREADS) {
        const int p = gid & 63, dir = (gid >> 6) & 1, b = (gid >> 7) & 31, g = gid >> 12;
        const f32x2 a = A32[(g * 2 + dir) * 64 + p];
        float hr = 0.f, hi = 0.f;
        const size_t row0 = (size_t)g * 2304 + b * 72;
#pragma unroll 4
        for (int idx = 0; idx < 72; ++idx) {
            const int j = dir == 0 ? idx : (idx < 8 ? 7 - idx : 79 - idx);
            const size_t row = row0 + j;
            AG[row * 768 + 512 + dir * 128 + p] = (bf16)f2bf(hr); AG[row * 768 + 512 + dir * 128 + 64 + p] = (bf16)f2bf(hi);
            const float sr = SS[row * 256 + dir * 128 + p], si = SS[row * 256 + dir * 128 + 64 + p];
            const float nr = a.x * hr - a.y * hi + sr, ni = a.x * hi + a.y * hr + si; hr = nr; hi = ni;
        }
    }
}

template <int DUAL>
__device__ __forceinline__ void transpose_item(const float* W, int ldw, int K, int N, bf16* WT, int row_off, LAS float* scr, int item, int lane) {
    const int nblk = N / 64, kb = item / nblk, nb = item - kb * nblk, k0 = 64 * kb, n0 = 64 * nb;
    const int lr = lane >> 4, lc = (lane & 15) * 4;
    f32x4 v[16];
#pragma unroll
    for (int i = 0; i < 16; ++i) v[i] = *(const f32x4*)(W + (size_t)(k0 + lr + 4 * i) * ldw + n0 + lc);
#pragma unroll
    for (int i = 0; i < 16; ++i) { LAS float* d = scr + (lr + 4 * i) * 65 + lc; d[0] = v[i].x; d[1] = v[i].y; d[2] = v[i].z; d[3] = v[i].w; }
    asm volatile("s_waitcnt lgkmcnt(0)" ::: "memory");
    const int c = lane & 7;
#pragma unroll
    for (int j = 0; j < 8; ++j) { const int n = (lane >> 3) + 8 * j; const LAS float* sp = scr + (8 * c) * 65 + n;
        u32x4 o; o.x = pkbf(sp[0 * 65], sp[1 * 65]); o.y = pkbf(sp[2 * 65], sp[3 * 65]); o.z = pkbf(sp[4 * 65], sp[5 * 65]); o.w = pkbf(sp[6 * 65], sp[7 * 65]);
        const int nn = n0 + n, dest = DUAL == -2 ? (nn < 3072 ? nn : (nn < 4096 ? nn + 1024 : nn - 1024)) : (DUAL < 0 ? row_off + nn : row_off + (nn >> 7) * 256 + DUAL * 128 + (nn & 127));
        *(u32x4*)(WT + (size_t)dest * K + k0 + 8 * c) = o; }
    asm volatile("s_waitcnt lgkmcnt(0)" ::: "memory");
}
__device__ __forceinline__ void convert_moe(const Frame& F, int l, int cb = -1, int cnb = 0) {
    if (cb < 0) { cb = F.bid; cnb = F.nb; }
    if (cb >= cnb) return;
    LAS float* scr = (LAS float*)((LAS unsigned char*)F.lds) + F.wave * 4160;
    bf16* WGU = (bf16*)(F.ws + WO_GU); bf16* WDN = (bf16*)(F.ws + WO_DN);
    for (int it = cb * NWAVES + F.wave; it < 24576; it += cnb * NWAVES) {
        const int m = it >> 13, r = it & 8191, e = r >> 9, item = r & 511;
        if (m == 0) transpose_item<0>(F.in[29] + (size_t)(l * NE + e) * D * FF, FF, D, FF, WGU, e * 2 * FF, scr, item, F.lane);
        else if (m == 1) transpose_item<1>(F.in[30] + (size_t)(l * NE + e) * D * FF, FF, D, FF, WGU, e * 2 * FF, scr, item, F.lane);
        else transpose_item<-1>(F.in[31] + (size_t)(l * NE + e) * FF * D, D, FF, D, WDN, e * D, scr, item, F.lane);
    }
}
__device__ __forceinline__ void convert_mixers(const Frame& F, int cb, int cnb) {
    if (cb >= cnb) return;
    LAS float* scr = (LAS float*)((LAS unsigned char*)F.lds) + F.wave * 4160;
    for (int it = cb * NWAVES + F.wave; it < 4096; it += cnb * NWAVES) {
        int r = it;
        if (r < 256) { transpose_item<0>(F.in[16], 2 * D, D, D, (bf16*)(F.ws + WO_GLU), 0, scr, r, F.lane); continue; } r -= 256;
        if (r < 256) { transpose_item<1>(F.in[16] + D, 2 * D, D, D, (bf16*)(F.ws + WO_GLU), 0, scr, r, F.lane); continue; } r -= 256;
        if (r < 768) { transpose_item<-1>(F.in[17], 3 * D, D, 3 * D, (bf16*)(F.ws + WO_NAQKV), 0, scr, r, F.lane); continue; } r -= 768;
        if (r < 256) { transpose_item<-1>(F.in[18], D, D, D, (bf16*)(F.ws + WO_NAO), 0, scr, r, F.lane); continue; } r -= 256;
        if (r < 768) { transpose_item<-1>(F.in[20], 3 * D, D, 3 * D, (bf16*)(F.ws + WO_DAQKV), 0, scr, r, F.lane); continue; } r -= 768;
        if (r < 256) { transpose_item<-1>(F.in[21], D, D, D, (bf16*)(F.ws + WO_DAO), 0, scr, r, F.lane); continue; } r -= 256;
        if (r < 1280) { transpose_item<-2>(F.in[24], 5 * D, D, 5 * D, (bf16*)(F.ws + WO_HGIN), 0, scr, r, F.lane); continue; } r -= 1280;
        transpose_item<-1>(F.in[25], D, D, D, (bf16*)(F.ws + WO_HGO), 0, scr, r, F.lane);
    }
}

__device__ __forceinline__ void ph_prologue(const Frame& F) {
    {
        float* S = (float*)F.lds;
        for (int i = F.tid; i < 33 * 1024; i += NTHREADS) { const float v = i < 32 * 1024 ? F.in[1][i] : F.in[3][i - 32 * 1024]; S[i] = siluf_(v); }
        __syncthreads();
        float acc[2][33];
#pragma unroll
        for (int t = 0; t < 2; ++t)
#pragma unroll
            for (int r = 0; r < 33; ++r) acc[t][r] = 0.f;
#pragma unroll
        for (int t = 0; t < 2; ++t) {
            const int task = F.bid + t * F.nb;
            if (task < 384) {
                const int l = task / 96, col = (task % 96) * 64 + F.lane, kb = F.wave * 128;
                const float* W = F.in[4] + (size_t)l * 1024 * 6144 + col;
#pragma unroll 1
                for (int k = kb; k < kb + 128; k += 8) {
                    float w[8];
#pragma unroll
                    for (int q = 0; q < 8; ++q) w[q] = W[(size_t)(k + q) * 6144];
#pragma unroll
                    for (int r = 0; r < 33; ++r) { const f32x4 s0 = *(const f32x4*)&S[r * 1024 + k], s1 = *(const f32x4*)&S[r * 1024 + k + 4];
                        acc[t][r] += (s0.x * w[0] + s0.y * w[1]) + (s0.z * w[2] + s0.w * w[3]) + (s1.x * w[4] + s1.y * w[5]) + (s1.z * w[6] + s1.w * w[7]); }
                }
            }
        }
        __syncthreads();
#pragma unroll
        for (int t = 0; t < 2; ++t)
#pragma unroll
            for (int r = 0; r < 33; ++r) S[((t * 8 + F.wave) * 33 + r) * 64 + F.lane] = acc[t][r];
        __syncthreads();
        for (int i = F.tid; i < 2 * 33 * 64; i += NTHREADS) {
            const int t = i / (33 * 64), r = (i / 64) % 33, ln = i & 63, task = F.bid + t * F.nb;
            if (task < 384) { const int l = task / 96, col = (task % 96) * 64 + ln; float v = F.in[5][l * 6144 + col];
#pragma unroll
                for (int w = 0; w < 8; ++w) v += S[((t * 8 + w) * 33 + r) * 64 + ln];
                F.MOD[((size_t)l * 33 + r) * 6144 + col] = v; }
        }
        __syncthreads();
    }
    if (F.bid == 48) {
        const float* lbin = F.in[27];
        for (int c = F.tid; c < D; c += NTHREADS) { const float x0 = lbin[c], x1 = lbin[D + c], x2 = lbin[2 * D + c], x3 = lbin[3 * D + c], mx = fmaxf(fmaxf(x0, x1), fmaxf(x2, x3));
            const float e0 = expf(x0 - mx), e1 = expf(x1 - mx), e2 = expf(x2 - mx), e3 = expf(x3 - mx); ((float*)(F.ws + WS_LB))[c] = (e1 + e2 + e3) / (e0 + e1 + e2 + e3); }
    }
    if (F.bid == 49) {
        for (int i = F.tid; i < 64 * 16; i += NTHREADS) { const float inv = powf(10000.0f, -(float)(i & 15) * (1.0f / 16.0f)); float sn, cs; sincosf((float)(i >> 4) * inv, &sn, &cs);
            ((float*)(F.ws + WS_ROPE))[2 * i] = cs; ((float*)(F.ws + WS_ROPE))[2 * i + 1] = sn; }
    }
    { const int ncv = F.nb > 128 ? F.nb - 64 : F.nb;
      convert_mixers(F, F.bid, ncv); convert_moe(F, 0, F.bid, ncv); }
    __syncthreads();
    ph_s5_pre(F);
}

template <bool F32> struct XRawT { typedef f32x4 T; };
template <> struct XRawT<false> { typedef u32x2 T; };
__device__ __forceinline__ f32x4 xcvt(const f32x4& r) { return r; }
__device__ __forceinline__ f32x4 xcvt(const u32x2& r) { return (f32x4){bflo(r.x), bfhi(r.x), bflo(r.y), bfhi(r.y)}; }
template <int MODE, bool COMBINE, bool S5OUT = false, bool SKIPCTX = false, bool FROMIN = false>
__device__ __forceinline__ void ph_norm(const Frame& F, int layer, int prev_layer) {
    static_assert(MODE != 1, "norm2 + router is ph_norm2");
    const float* nw = MODE == 0 ? F.in[6] + layer * D : F.in[32];
    const bf16* Y = (const bf16*)(F.ws + WS_Y);
    constexpr int NI = SKIPCTX ? NB * SEQ : R;
    constexpr int NPF = 4;
    const int per = (NI + F.nb * NWAVES - 1) / (F.nb * NWAVES);
    int it = (F.bid * NWAVES + F.wave) * per; const int itend = min(NI, it + per);
    typedef typename XRawT<FROMIN>::T XR;
    const __amdgpu_buffer_rsrc_t yrs = __builtin_amdgcn_make_buffer_rsrc((void*)Y, 0, (int)((size_t)NE * SLOTS * D * 2), 0x00020000);
    const int l16 = F.lane & 15;
#define NORM_ROWOF(i_) (SKIPCTX ? ((i_) >> 11) * P + NCTX + ((i_) & (SEQ - 1)) : (i_))
#define NORM_XPTR(r_) ((FROMIN ? (const XR*)(((r_) % P) < NCTX ? F.in[2] + ((size_t)((r_) / P) * NCTX + ((r_) % P)) * D : F.in[0] + ((size_t)((r_) / P) * SEQ + ((r_) % P) - NCTX) * D) : (const XR*)(F.X + (size_t)(r_) * D)) + F.lane)
#define NORM_STAGE(i_, INVA_, V_, G_, Yq_, INVB_) do { \
        const int ic_ = min((i_), itend - 1), ic1_ = min((i_) + 1, itend - 1); const int rA_ = NORM_ROWOF(ic_); \
        if (COMBINE) INVB_ = F.INV[(size_t)NORM_ROWOF(ic1_) * NE + l16]; \
        if (COMBINE) G_ = F.GATE[l16 * SLOTS + max(INVA_, 0)]; \
        { const XR* xp_ = NORM_XPTR(rA_); _Pragma("unroll") for (int j = 0; j < 4; ++j) V_[j] = xp_[64 * j]; } \
        if (COMBINE) { unsigned m_ = ((i_) < itend) ? (unsigned)(__ballot(F.lane < NE && INVA_ >= 0) & 0xffffull) : 0u; \
            _Pragma("unroll") for (int q = 0; q < NPF; ++q) { const bool pr_ = m_ != 0u; const int e_ = pr_ ? __builtin_ctz(m_) : 0; m_ &= m_ - 1u; const int s_ = __builtin_amdgcn_readlane(INVA_, e_); \
                const unsigned vo_ = pr_ ? (unsigned)(e_ * SLOTS + s_) * (unsigned)(D * 2) + (unsigned)F.lane * 8u : 0xfffff000u; \
                _Pragma("unroll") for (int j = 0; j < 4; ++j) Yq_[q][j] = __builtin_amdgcn_raw_buffer_load_b64(yrs, vo_ + 512u * j, 0, 0); } } \
    } while (0)
    XR v[4]; u32x2 yc[NPF][4]; float gl = 0.f; int invl = -1, invn = -1;
    if (COMBINE) invl = F.INV[(size_t)NORM_ROWOF(min(it, NI - 1)) * NE + l16];
    NORM_STAGE(it, invl, v, gl, yc, invn);
    const f32x4* nw4 = (const f32x4*)nw + F.lane;
    f32x4 g5[4], nwv[4], shv[4], scv[4]; int mrc = -1;
#pragma unroll
    for (int j = 0; j < 4; ++j) { nwv[j] = nw4[64 * j]; g5[j] = shv[j] = scv[j] = (f32x4){0.f, 0.f, 0.f, 0.f}; }
    while (it < itend) {
        const int row = NORM_ROWOF(it), b = row / P, pos = row - b * P, mr = pos < NCTX ? 32 : b;
        if (mr != mrc) { mrc = mr;
            const float* mrow = F.MOD + ((size_t)layer * 33 + mr) * 6144;
#pragma unroll
            for (int j = 0; j < 4; ++j) {
                if (COMBINE) g5[j] = ((const f32x4*)(F.MOD + ((size_t)prev_layer * 33 + mr) * 6144 + 5 * D) + F.lane)[64 * j];
                if (MODE != 2) { shv[j] = ((const f32x4*)(mrow + (MODE == 0 ? 0 : 3) * D) + F.lane)[64 * j]; scv[j] = ((const f32x4*)(mrow + (MODE == 0 ? 1 : 4) * D) + F.lane)[64 * j]; }
            }
        }
        XR vn[4]; u32x2 yn[NPF][4]; float gln = 0.f; int invnn = -1;
        NORM_STAGE(it + 1, invn, vn, gln, yn, invnn);
        f32x4 a[4];
#pragma unroll
        for (int j = 0; j < 4; ++j) a[j] = (f32x4){0.f, 0.f, 0.f, 0.f};
        if (COMBINE) {
            unsigned m = (unsigned)(__ballot(F.lane < NE && invl >= 0) & 0xffffull);
#pragma unroll
            for (int q = 0; q < NPF; ++q) {
                const bool pr = m != 0u; const int e = pr ? __builtin_ctz(m) : 0; m &= m - 1u;
                const float g = pr ? __uint_as_float(__builtin_amdgcn_readlane(__float_as_uint(gl), e)) : 0.f;
#pragma unroll
                for (int j = 0; j < 4; ++j) { a[j].x += g * bflo(yc[q][j].x); a[j].y += g * bfhi(yc[q][j].x); a[j].z += g * bflo(yc[q][j].y); a[j].w += g * bfhi(yc[q][j].y); }
            }
            while (m) {
                const int e = __builtin_ctz(m); m &= m - 1u;
                const int sl = __builtin_amdgcn_readlane(invl, e); const float g = __uint_as_float(__builtin_amdgcn_readlane(__float_as_uint(gl), e));
                const u32x2* y0 = (const u32x2*)(Y + ((size_t)e * SLOTS + sl) * D) + F.lane;
                u32x2 w0[4];
#pragma unroll
                for (int j = 0; j < 4; ++j) w0[j] = y0[64 * j];
#pragma unroll
                for (int j = 0; j < 4; ++j) { a[j].x += g * bflo(w0[j].x); a[j].y += g * bfhi(w0[j].x); a[j].z += g * bflo(w0[j].y); a[j].w += g * bfhi(w0[j].y); }
            }
        }
        f32x4 vv[4];
#pragma unroll
        for (int j = 0; j < 4; ++j) vv[j] = xcvt(v[j]);
        if (COMBINE) {
#pragma unroll
            for (int j = 0; j < 4; ++j) vv[j] = vv[j] + g5[j] * a[j];
        }
        if ((FROMIN || COMBINE) && MODE != 2) { u32x2* xw = (u32x2*)(F.X + (size_t)row * D) + F.lane;
#pragma unroll
            for (int j = 0; j < 4; ++j) { u32x2 w; w.x = pkbf(vv[j].x, vv[j].y); w.y = pkbf(vv[j].z, vv[j].w); xw[64 * j] = w; } }
        float ss = 0.f;
#pragma unroll
        for (int j = 0; j < 4; ++j) ss += (vv[j].x * vv[j].x + vv[j].y * vv[j].y) + (vv[j].z * vv[j].z + vv[j].w * vv[j].w);
        const float rinv = rsqrtf(wave_sum(ss) * (1.0f / D) + EPS);
        if (MODE == 2) {
            if (pos >= NCTX) {
                f32x4* o = (f32x4*)(F.out + ((size_t)b * SEQ + pos - NCTX) * D) + F.lane;
#pragma unroll
                for (int j = 0; j < 4; ++j) o[64 * j] = vv[j] * rinv * nwv[j];
            }
        } else {
            u32x2* ho = (u32x2*)(F.H + (size_t)row * D) + F.lane;
            f32x4 h[4];
#pragma unroll
            for (int j = 0; j < 4; ++j) { h[j] = vv[j] * rinv * nwv[j] * (scv[j] + 1.0f) + shv[j]; u32x2 w; w.x = pkbf(h[j].x, h[j].y); w.y = pkbf(h[j].z, h[j].w); ho[64 * j] = w;
                if (S5OUT) { const int g = (F.lane >> 2) + 16 * j;
                    *(u32x2*)((bf16*)(F.ws + WS_AG) + ((size_t)g * 2304 + b * 72 + (pos >> 5)) * 768 + (pos & 31) * 16 + (F.lane & 3) * 4) = w; } }
        }
#pragma unroll
        for (int j = 0; j < 4; ++j) { v[j] = vn[j];
#pragma unroll
            for (int q = 0; q < NPF; ++q) yc[q][j] = yn[q][j]; }
        gl = gln; invl = invn; invn = invnn; ++it;
    }
#undef NORM_STAGE
#undef NORM_XPTR
#undef NORM_ROWOF
}

template <bool SKIPCTX>
__device__ __forceinline__ void ph_norm2(const Frame& F, int layer) {
    const float* nw = F.in[7] + layer * D;
    LAS float* wrt = (LAS float*)((LAS unsigned char*)F.lds);
    {
        const float* wr = F.in[28] + (size_t)layer * D * NE;
        for (int i = F.tid; i < D * NE; i += NTHREADS) wrt[(i & 15) * D + (i >> 4)] = wr[i];
        __syncthreads();
    }
    const f32x4* nw4 = (const f32x4*)nw + F.lane;
    const int eid = ((F.lane & 1) << 3) | ((F.lane & 2) << 1) | ((F.lane & 4) >> 1) | ((F.lane & 8) >> 3);
    constexpr int NI = SKIPCTX ? NB * SEQ / 2 : R / 2;
    const int per = (NI + F.nb * NWAVES - 1) / (F.nb * NWAVES), it0 = (F.bid * NWAVES + F.wave) * per, it1 = min(NI, it0 + per);
    f32x4 gv[4], shv[4]; int mrc = -1;
#pragma unroll
    for (int j = 0; j < 4; ++j) gv[j] = shv[j] = (f32x4){0.f, 0.f, 0.f, 0.f};
#define N2_ROWOF(i_) (SKIPCTX ? ((i_) >> 10) * P + NCTX + 2 * ((i_) & (SEQ / 2 - 1)) : 2 * (i_))
    u32x2 w0[4], w1[4];
    { const u32x2* x0 = (const u32x2*)(F.X + (size_t)N2_ROWOF(min(it0, NI - 1)) * D) + F.lane;
#pragma unroll
      for (int j = 0; j < 4; ++j) { w0[j] = x0[64 * j]; w1[j] = x0[256 + 64 * j]; } }
    for (int it = it0; it < it1; ++it) {
        const int row = N2_ROWOF(it), b = row / P, pos = row - b * P, mr = pos < NCTX ? 32 : b;
        f32x4 v0[4], v1[4];
#pragma unroll
        for (int j = 0; j < 4; ++j) { v0[j] = xcvt(w0[j]); v1[j] = xcvt(w1[j]); }
        if (mr != mrc) { mrc = mr;
            const float* mrow = F.MOD + ((size_t)layer * 33 + mr) * 6144;
#pragma unroll
            for (int j = 0; j < 4; ++j) { shv[j] = ((const f32x4*)(mrow + 3 * D) + F.lane)[64 * j]; gv[j] = nw4[64 * j] * (((const f32x4*)(mrow + 4 * D) + F.lane)[64 * j] + 1.0f); }
        }
        u32x2 n0[4], n1[4];
        { const u32x2* xn = (const u32x2*)(F.X + (size_t)N2_ROWOF(min(it + 1, it1 - 1)) * D) + F.lane;
#pragma unroll
          for (int j = 0; j < 4; ++j) { n0[j] = xn[64 * j]; n1[j] = xn[256 + 64 * j]; } }
        float s0 = 0.f, s1 = 0.f;
#pragma unroll
        for (int j = 0; j < 4; ++j) { s0 += (v0[j].x * v0[j].x + v0[j].y * v0[j].y) + (v0[j].z * v0[j].z + v0[j].w * v0[j].w); s1 += (v1[j].x * v1[j].x + v1[j].y * v1[j].y) + (v1[j].z * v1[j].z + v1[j].w * v1[j].w); }
        const float r0 = rsqrtf(wave_sum(s0) * (1.0f / D) + EPS), r1 = rsqrtf(wave_sum(s1) * (1.0f / D) + EPS);
        u32x2* h0 = (u32x2*)(F.H + (size_t)row * D) + F.lane; u32x2* h1 = h0 + 256;
#pragma unroll
        for (int j = 0; j < 4; ++j) { const f32x4 g = gv[j];
            v0[j] = v0[j] * r0 * g + shv[j]; v1[j] = v1[j] * r1 * g + shv[j];
            u32x2 w; w.x = pkbf(v0[j].x, v0[j].y); w.y = pkbf(v0[j].z, v0[j].w); h0[64 * j] = w;
            w.x = pkbf(v1[j].x, v1[j].y); w.y = pkbf(v1[j].z, v1[j].w); h1[64 * j] = w; }
        f32x2 a0[NE], a1[NE];
#pragma unroll
        for (int e = 0; e < NE; ++e) { a0[e] = (f32x2){0.f, 0.f}; a1[e] = (f32x2){0.f, 0.f}; }
#pragma unroll
        for (int j = 0; j < 4; ++j) { asm volatile("" ::: "memory");
            const f32x2 p0 = {v0[j].x, v0[j].y}, q0 = {v0[j].z, v0[j].w}, p1 = {v1[j].x, v1[j].y}, q1 = {v1[j].z, v1[j].w};
#pragma unroll
            for (int e = 0; e < NE; ++e) { const f32x4 w = *(const LAS f32x4*)(wrt + e * D + F.lane * 4 + 256 * j); const f32x2 wl = {w.x, w.y}, wh = {w.z, w.w};
                a0[e] += p0 * wl; a0[e] += q0 * wh; a1[e] += p1 * wl; a1[e] += q1 * wh; } }
        float lg0[NE], lg1[NE];
#pragma unroll
        for (int e = 0; e < NE; ++e) { lg0[e] = a0[e].x + a0[e].y; lg1[e] = a1[e].x + a1[e].y; }
        const float t0 = reduce16(lg0, F.lane), t1 = reduce16(lg1, F.lane);
        float m0 = fmaxf(t0, dpp_xor1(t0)), m1 = fmaxf(t1, dpp_xor1(t1));
        m0 = fmaxf(m0, dpp_xor2(m0)); m1 = fmaxf(m1, dpp_xor2(m1)); m0 = fmaxf(m0, __shfl_xor(m0, 4)); m1 = fmaxf(m1, __shfl_xor(m1, 4)); m0 = fmaxf(m0, __shfl_xor(m0, 8)); m1 = fmaxf(m1, __shfl_xor(m1, 8));
        const float e0 = __builtin_amdgcn_exp2f((t0 - m0) * LOG2E_), e1 = __builtin_amdgcn_exp2f((t1 - m1) * LOG2E_);
        float z0 = e0 + dpp_xor1(e0), z1 = e1 + dpp_xor1(e1);
        z0 += dpp_xor2(z0); z1 += dpp_xor2(z1); z0 += __shfl_xor(z0, 4); z1 += __shfl_xor(z1, 4); z0 += __shfl_xor(z0, 8); z1 += __shfl_xor(z1, 8);
        if (F.lane < NE) { float* ap = F.AFF + ((size_t)b * NE + eid) * P + pos; ap[0] = e0 / z0; ap[1] = e1 / z1; }
#pragma unroll
        for (int j = 0; j < 4; ++j) { w0[j] = n0[j]; w1[j] = n1[j]; }
    }
#undef N2_ROWOF
}

__device__ __forceinline__ void ph_topk(const Frame& F, int nitems) {
    const int tid = F.tid, lane = F.lane, half = F.wave >> 2, hw = F.wave & 3, ht = tid & 255;
    unsigned* hist = (unsigned*)F.lds + half * 288;
    unsigned* wtot = hist + 256;
    unsigned* bc = wtot + 8;
    for (int item0 = F.bid; item0 < nitems; item0 += 2 * F.nb) {
        const int item = item0 + half * F.nb; const bool valid = item < nitems;
        const int seg = item >> 9, b = (item >> 4) & 31, e = item & 15;
        const int n = seg ? NCTX : SEQ, pos0 = seg ? 0 : NCTX, cap = n / 8, slot0 = seg ? NB * 256 + b * 32 : b * 256;
        const int per = seg ? 1 : 8;
        const float* a = F.AFF + ((size_t)b * NE + e) * P + pos0;
        unsigned u[8];
#pragma unroll
        for (int q = 0; q < 8; ++q) u[q] = 0u;
        if (valid) {
            if (seg) u[0] = __float_as_uint(a[ht]);
            else { const f32x4 a0 = *(const f32x4*)(a + ht * 8), a1 = *(const f32x4*)(a + ht * 8 + 4);
                u[0] = __float_as_uint(a0.x); u[1] = __float_as_uint(a0.y); u[2] = __float_as_uint(a0.z); u[3] = __float_as_uint(a0.w);
                u[4] = __float_as_uint(a1.x); u[5] = __float_as_uint(a1.y); u[6] = __float_as_uint(a1.z); u[7] = __float_as_uint(a1.w); }
        }
        unsigned prefix = 0u, mask = 0u, kk = (unsigned)cap;
#pragma unroll 1
        for (int pass = 0; pass < 4; ++pass) {
            const int shift = 24 - 8 * pass;
            __syncthreads();
            hist[ht] = 0u;
            __syncthreads();
            if (valid) {
#pragma unroll
                for (int q = 0; q < 8; ++q) if (q < per && (u[q] & mask) == prefix) atomicAdd(&hist[(u[q] >> shift) & 255u], 1u);
            }
            __syncthreads();
            unsigned hv = hist[255 - ht], cum = hv;
#pragma unroll
            for (int o = 1; o < 64; o <<= 1) { const unsigned t = __shfl_up(cum, o); if (lane >= o) cum += t; }
            if (lane == 63) wtot[hw] = cum;
            __syncthreads();
            {
                unsigned off = 0u;
#pragma unroll
                for (int w = 0; w < 4; ++w) if (w < hw) off += wtot[w];
                cum += off;
                if (cum >= kk && cum - hv < kk) { bc[0] = 255u - (unsigned)ht; bc[1] = kk - (cum - hv); }
            }
            __syncthreads();
            prefix |= bc[0] << shift; mask |= 255u << shift; kk = bc[1];
        }
        unsigned cg = 0u, ce = 0u;
        if (valid) {
#pragma unroll
            for (int q = 0; q < 8; ++q) if (q < per) { cg += u[q] > prefix ? 1u : 0u; ce += u[q] == prefix ? 1u : 0u; }
        }
        unsigned pk = cg | (ce << 16), inc = pk;
#pragma unroll
        for (int o = 1; o < 64; o <<= 1) { const unsigned t = __shfl_up(inc, o); if (lane >= o) inc += t; }
        __syncthreads();
        if (lane == 63) wtot[hw] = inc;
        __syncthreads();
        unsigned off = 0u;
#pragma unroll
        for (int w = 0; w < 4; ++w) if (w < hw) off += wtot[w];
        unsigned excl = inc - pk + off, gb = excl & 0xffffu, eb = excl >> 16;
        if (valid) {
#pragma unroll
            for (int q = 0; q < 8; ++q) if (q < per) {
                const int i = ht * per + q, row = b * P + pos0 + i;
                const bool gt = u[q] > prefix, eq = u[q] == prefix, sel = gt || (eq && eb < kk);
                if (sel) { const int slot = slot0 + (int)(gb + (eb < kk ? eb : kk)); F.SEL[e * SLOTS + slot] = row; F.GATE[e * SLOTS + slot] = __uint_as_float(u[q]); F.INV[(size_t)row * NE + e] = slot; }
                else F.INV[(size_t)row * NE + e] = -1;
                gb += gt ? 1u : 0u; eb += eq ? 1u : 0u;
            }
        }
        __syncthreads();
    }
    __syncthreads();
}

typedef short bf16x8 __attribute__((ext_vector_type(8)));
typedef float f32x16 __attribute__((ext_vector_type(16)));
#define MFMA32(a, b, c) __builtin_amdgcn_mfma_f32_32x32x16_bf16((a), (b), (c), 0, 0, 0)
__device__ __forceinline__ int kperm(int m) { return (m & 0x13) | ((m & 8) >> 1) | ((m & 4) << 1); }
__device__ __forceinline__ bf16x8 pack8(const f32x16& x, int s8) {
    u32x4 p; p.x = pkbf(x[s8 + 0], x[s8 + 1]); p.y = pkbf(x[s8 + 2], x[s8 + 3]); p.z = pkbf(x[s8 + 4], x[s8 + 5]); p.w = pkbf(x[s8 + 6], x[s8 + 7]);
    return __builtin_bit_cast(bf16x8, p);
}
constexpr float LOG2E = 1.4426950408889634f;

__device__ __forceinline__ void ph_da_attn(const Frame& F) {
    const bf16* Q = (const bf16*)(F.ws + WS_Q); const bf16* K = (const bf16*)(F.ws + WS_K); const bf16* VT = (const bf16*)(F.ws + WS_VT); bf16* O = (bf16*)(F.ws + WS_O);
    const int tid = F.tid, lane = F.lane, l32 = lane & 31, hh = lane >> 5, map = F.wave & 1, qsub = F.wave >> 1;
    const float* lam = F.in[22];
    const float lam_full = expf(wave_sum(lam[lane] * lam[64 + lane])) - expf(wave_sum(lam[128 + lane] * lam[192 + lane])) + LAM_INIT;
    constexpr int KB = 64 * 144, VB = 128 * 144, BUF = 2 * KB + VB;
    unsigned char* sb = F.lds;
    float* xch = (float*)(F.lds + 2 * BUF) + qsub * 4096;
    const float c = 0.125f * LOG2E;
    const int kr = (tid >> 3) & 63, kc = tid & 7, vd = tid >> 3, vc = tid & 7;
    const int kdst = kr * 144 + kc * 16, vdst = 2 * KB + vd * 144 + vc * 16;
    const int kfrag = map * KB + kperm(l32) * 144 + hh * 16, vfrag = 2 * KB + l32 * 144 + hh * 16;
    const int vb = (F.nb & 7) == 0 ? (F.bid & 7) * (F.nb >> 3) + (F.bid >> 3) : F.bid;
    for (int it = vb; it < 4096 + 512; it += F.nb) {
        int b, h, pos0, nst;
        if (it < 4096) { b = it >> 7; h = (it >> 4) & 7; pos0 = NCTX + (it & 15) * 128 + qsub * 32; nst = P / 64; }
        else { const int j = it - 4096; b = j >> 4; h = (j >> 1) & 7; pos0 = (j & 1) * 128 + qsub * 32; nst = NCTX / 64; }
        const size_t qrow = (size_t)b * P + pos0 + l32;
        bf16x8 qf[4];
#pragma unroll
        for (int ks = 0; ks < 4; ++ks) qf[ks] = *(const bf16x8*)(Q + qrow * D + h * 128 + map * 64 + ks * 16 + hh * 8);
        f32x16 o[4];
#pragma unroll
        for (int dt = 0; dt < 4; ++dt)
#pragma unroll
            for (int j = 0; j < 16; ++j) o[dt][j] = 0.f;
        float m = 0.f, l = 0.f;
        const bf16* kg = K + ((size_t)b * P + kr) * D + h * 128 + kc * 8;
        const bf16* vg = VT + ((size_t)b * D + h * 128 + vd) * P + vc * 8;
        u32x4 ka0, ka1, va0, va1;
        { const u32x4 k0 = *(const u32x4*)kg, k1 = *(const u32x4*)(kg + 64), v0 = *(const u32x4*)vg, v1 = *(const u32x4*)(vg + (size_t)64 * P);
          const bf16* kq = kg + (size_t)64 * D; const bf16* vq = vg + 64;
          ka0 = *(const u32x4*)kq; ka1 = *(const u32x4*)(kq + 64); va0 = *(const u32x4*)vq; va1 = *(const u32x4*)(vq + (size_t)64 * P);
          *(u32x4*)(sb + kdst) = k0; *(u32x4*)(sb + KB + kdst) = k1; *(u32x4*)(sb + vdst) = v0; *(u32x4*)(sb + vdst + 64 * 144) = v1; }
        __syncthreads();
#pragma unroll 1
        for (int st = 0; st < nst; ++st) {
            const unsigned char* cb = sb + (st & 1) * BUF;
            u32x4 kn0 = (u32x4){0u, 0u, 0u, 0u}, kn1 = kn0, vn0 = kn0, vn1 = kn0;
            if (st + 2 < nst) { const bf16* kq = kg + (size_t)(st + 2) * 64 * D; const bf16* vq = vg + (st + 2) * 64;
                kn0 = *(const u32x4*)kq; kn1 = *(const u32x4*)(kq + 64); vn0 = *(const u32x4*)vq; vn1 = *(const u32x4*)(vq + (size_t)64 * P); }
#pragma unroll
            for (int sub = 0; sub < 2; ++sub) {
                f32x16 s;
#pragma unroll
                for (int j = 0; j < 16; ++j) s[j] = -m;
#pragma unroll
                for (int ks = 0; ks < 4; ++ks) s = MFMA32(*(const bf16x8*)(cb + kfrag + sub * 32 * 144 + ks * 32), qf[ks], s);
                float mx = s[0];
#pragma unroll
                for (int j = 1; j < 16; ++j) mx = fmaxf(mx, s[j]);
                mx = fmaxf(mx, __shfl_xor(mx, 32));
                const bool first = st == 0 && sub == 0;
                if (first || __any(mx > 8.0f)) {
                    const float d = first ? mx : fmaxf(mx, 0.f);
                    if (!first) { const float alpha = __builtin_amdgcn_exp2f(-d); l *= alpha;
#pragma unroll
                        for (int dt = 0; dt < 4; ++dt)
#pragma unroll
                            for (int j = 0; j < 16; ++j) o[dt][j] *= alpha; }
                    m += d;
#pragma unroll
                    for (int j = 0; j < 16; ++j) s[j] -= d;
                }
                float ps = 0.f;
#pragma unroll
                for (int j = 0; j < 16; ++j) { s[j] = __builtin_amdgcn_exp2f(s[j]); ps += s[j]; }
                l += ps;
                const bf16x8 p0 = pack8(s, 0), p1 = pack8(s, 8);
#pragma unroll
                for (int dt = 0; dt < 4; ++dt) { o[dt] = MFMA32(*(const bf16x8*)(cb + vfrag + dt * 32 * 144 + sub * 64), p0, o[dt]); o[dt] = MFMA32(*(const bf16x8*)(cb + vfrag + dt * 32 * 144 + sub * 64 + 32), p1, o[dt]); }
            }
            if (st + 1 < nst) { unsigned char* nb = sb + ((st + 1) & 1) * BUF; *(u32x4*)(nb + kdst) = ka0; *(u32x4*)(nb + KB + kdst) = ka1; *(u32x4*)(nb + vdst) = va0; *(u32x4*)(nb + vdst + 64 * 144) = va1; }
            ka0 = kn0; ka1 = kn1; va0 = vn0; va1 = vn1;
            __syncthreads();
        }
        l += __shfl_xor(l, 32);
        const float inv = 1.0f / l;
        if (map == 1) {
#pragma unroll
            for (int dt = 0; dt < 4; ++dt)
#pragma unroll
                for (int j = 0; j < 16; ++j) xch[(dt * 16 + j) * 64 + lane] = o[dt][j] * inv * lam_full;
        }
        __syncthreads();
        if (map == 0) {
            float ss = 0.f;
#pragma unroll
            for (int dt = 0; dt < 4; ++dt)
#pragma unroll
                for (int j = 0; j < 16; ++j) { const float v = o[dt][j] * inv - xch[(dt * 16 + j) * 64 + lane]; o[dt][j] = v; ss += v * v; }
            ss += __shfl_xor(ss, 32);
            const float rinv = rsqrtf(ss * (1.0f / 128.0f) + EPS) * (1.0f - LAM_INIT);
#pragma unroll
            for (int dt = 0; dt < 4; ++dt)
#pragma unroll
                for (int jq = 0; jq < 4; ++jq) {
                    const int d0 = dt * 32 + jq * 8 + hh * 4; const f32x4 sw = *(const f32x4*)(F.in[23] + d0);
                    u32x2 w; w.x = pkbf(o[dt][jq * 4 + 0] * rinv * sw.x, o[dt][jq * 4 + 1] * rinv * sw.y); w.y = pkbf(o[dt][jq * 4 + 2] * rinv * sw.z, o[dt][jq * 4 + 3] * rinv * sw.w);
                    *(u32x2*)(O + qrow * D + h * 128 + d0) = w;
                }
        }
        __syncthreads();
    }
}

__device__ __forceinline__ void ph_na_attn(const Frame& F) {
    const bf16* Q = (const bf16*)(F.ws + WS_Q); const bf16* K = (const bf16*)(F.ws + WS_K); const bf16* VT = (const bf16*)(F.ws + WS_VT); bf16* O = (bf16*)(F.ws + WS_O);
    const int tid = F.tid, lane = F.lane, l32 = lane & 31, hh = lane >> 5;
    constexpr int KB = 128 * 144, VP = 272, VB = 64 * VP, BUF = KB + VB;
    unsigned char* sb = F.lds;
    float* rp = (float*)(F.lds + 2 * BUF) + 64;
    for (int i = tid; i < 16 * 15 * 31 + 128; i += NTHREADS) { const int k = i - 64; rp[k] = (k >= 0 && k < 16 * 15 * 31) ? F.in[19][k] * LOG2E : 0.f; }
    __syncthreads();
    const float c = 0.125f * LOG2E;
    const int pr = tid >> 3, pc = tid & 7;
    const int kdst = pr * 144 + pc * 16, vdst = KB + pr * VP + pc * 16;
    const int kfrag = kperm(l32) * 144 + hh * 16, vfrag = KB + l32 * VP + hh * 16;
    const int vb = (F.nb & 7) == 0 ? (F.bid & 7) * (F.nb >> 3) + (F.bid >> 3) : F.bid;
    for (int it = vb; it < 4096 + 512; it += F.nb) {
        int b, h, r = 0, cq = 0, kc0 = 0, rlo = 0, rhi = 0, wr0 = 0, wr1 = 0, nt; bool lat; size_t qrow;
        if (it < 4096) { lat = true; b = it >> 7; h = (it >> 3) & 15; const int rg = ((it & 7) + (it >> 8)) & 7  ;
            const int rw = rg * 4 + (F.wave >> 2) * 2, cqt = F.wave & 3; r = rw + (l32 >> 4); cq = cqt * 16 + (l32 & 15); kc0 = min(max(cqt * 16 - 8, 0), 32);
            wr0 = min(max(rw - 4, 0), 24); wr1 = min(max(rw + 1 - 4, 0), 24) + 8;
            qrow = (size_t)b * P + NCTX + r * 64 + cq;
            rlo = min(max(rg * 4 - 4, 0), 24); rhi = min(max(rg * 4 + 3 - 4, 0), 24) + 7; nt = 2 + (rhi - rlo + 2) / 2; }
        else { lat = false; const int j = it - 4096; b = j >> 4; h = j & 15; qrow = (size_t)b * P + F.wave * 32 + l32; nt = 2; }
        const int r0 = min(max(r - 4, 0), 24), c0 = min(max(cq - 8, 0), 48);
        bf16x8 qf[4];
#pragma unroll
        for (int ks = 0; ks < 4; ++ks) qf[ks] = *(const bf16x8*)(Q + qrow * D + h * 64 + ks * 16 + hh * 8);
        float neg[16];
#pragma unroll
        for (int j = 0; j < 16; ++j) { const int kcol = kc0 + 16 * (j >> 3) + 8 * hh + 4 * ((j >> 2) & 1) + (j & 3); neg[j] = (kcol >= c0 && kcol < c0 + 16) ? 0.f : -1.0e30f; }
        f32x16 o[2];
#pragma unroll
        for (int dt = 0; dt < 2; ++dt)
#pragma unroll
            for (int j = 0; j < 16; ++j) o[dt][j] = 0.f;
        float m = -1.0e30f, l = 0.f;
        const bf16* kg = K + ((size_t)b * P + pr) * D + h * 64 + pc * 8;
        const bf16* vg = VT + ((size_t)b * D + h * 64 + pr) * P + pc * 8;
#define NA_KEYA(st) ((st) < 2 ? (st) * 128 : NCTX + (rlo + 2 * ((st) - 2)) * 64)
#define NA_KEYB(st) ((st) < 2 ? (st) * 128 + 64 : NCTX + min(rlo + 2 * ((st) - 2) + 1, 31) * 64)
#define NA_LOAD(dk0, dk1, dv0, dv1, st) do { const int ka_ = NA_KEYA(st), kb_ = NA_KEYB(st); dk0 = *(const u32x4*)(kg + (size_t)ka_ * D); dk1 = *(const u32x4*)(kg + (size_t)kb_ * D); \
        dv0 = *(const u32x4*)(vg + ka_); dv1 = *(const u32x4*)(vg + kb_); } while (0)
#define NA_STORE(buf, sk0, sk1, sv0, sv1) do { *(u32x4*)((buf) + kdst) = sk0; *(u32x4*)((buf) + kdst + 64 * 144) = sk1; *(u32x4*)((buf) + vdst) = sv0; *(u32x4*)((buf) + vdst + 128) = sv1; } while (0)
        u32x4 ka0, ka1, va0, va1;
        { u32x4 x0, x1, y0, y1; NA_LOAD(x0, x1, y0, y1, 0); NA_LOAD(ka0, ka1, va0, va1, 1); NA_STORE(sb, x0, x1, y0, y1); }
        __syncthreads();
#pragma unroll 1
        for (int st = 0; st < nt; ++st) {
            const unsigned char* cbuf = sb + (st & 1) * BUF;
            u32x4 kn0 = (u32x4){0u, 0u, 0u, 0u}, kn1 = kn0, vn0 = kn0, vn1 = kn0;
            if (st + 2 < nt) NA_LOAD(kn0, kn1, vn0, vn1, st + 2);
#define NA_TILE(KO_, WIN_, KROW_) do { const int ko = (KO_); \
                f32x16 s; \
                _Pragma("unroll") for (int j = 0; j < 16; ++j) s[j] = 0.f; \
                _Pragma("unroll") for (int ks = 0; ks < 4; ++ks) s = MFMA32(*(const bf16x8*)(cbuf + kfrag + ko * 144 + ks * 32), qf[ks], s); \
                if (WIN_) { const int krow = (KROW_); \
                    const float rmask = (krow >= r0 && krow < r0 + 8) ? 0.f : -1.0e30f;        \
                    const float* rph = rp + (h * 15 + (krow - r + 7)) * 31 - cq + 15 + 8 * hh + kc0;       \
                    _Pragma("unroll") for (int j = 0; j < 16; ++j) s[j] = (s[j] * c + rph[16 * (j >> 3) + 4 * ((j >> 2) & 1) + (j & 3)]) + (neg[j] + rmask); \
                } else { _Pragma("unroll") for (int j = 0; j < 16; ++j) s[j] *= c; } \
                float mx = s[0]; \
                _Pragma("unroll") for (int j = 1; j < 16; ++j) mx = fmaxf(mx, s[j]); \
                mx = fmaxf(mx, __shfl_xor(mx, 32)); \
                if (__any(mx > m + 8.0f)) { \
                    const float mn = fmaxf(m, mx), alpha = __builtin_amdgcn_exp2f(m - mn); m = mn; l *= alpha; \
                    _Pragma("unroll") for (int dt = 0; dt < 2; ++dt) _Pragma("unroll") for (int j = 0; j < 16; ++j) o[dt][j] *= alpha; \
                } \
                f32x2 ps2 = {0.f, 0.f}; \
                _Pragma("unroll") for (int j = 0; j < 16; j += 2) { f32x2 t = {s[j], s[j + 1]}; t = t - (f32x2){m, m}; t.x = __builtin_amdgcn_exp2f(t.x); t.y = __builtin_amdgcn_exp2f(t.y); s[j] = t.x; s[j + 1] = t.y; ps2 += t; } \
                l += ps2.x + ps2.y; \
                const bf16x8 p0 = pack8(s, 0), p1 = pack8(s, 8); \
                _Pragma("unroll") for (int dt = 0; dt < 2; ++dt) { o[dt] = MFMA32(*(const bf16x8*)(cbuf + vfrag + dt * 32 * VP + ko * 2), p0, o[dt]); o[dt] = MFMA32(*(const bf16x8*)(cbuf + vfrag + dt * 32 * VP + ko * 2 + 32), p1, o[dt]); } \
            } while (0)
            if (st < 2) {
#pragma unroll
                for (int sub = 0; sub < 4; ++sub) NA_TILE(sub * 32, false, 0);
            } else {
#pragma unroll
                for (int half = 0; half < 2; ++half) { const int krw = rlo + 2 * (st - 2) + half;
                    if (krw <= rhi && krw >= wr0 && krw < wr1) NA_TILE(half * 64 + kc0, true, krw); }
            }
#undef NA_TILE
            if (st + 1 < nt) { unsigned char* nb = sb + ((st + 1) & 1) * BUF; NA_STORE(nb, ka0, ka1, va0, va1); }
            ka0 = kn0; ka1 = kn1; va0 = vn0; va1 = vn1;
            __syncthreads();
        }
#undef NA_KEYA
#undef NA_KEYB
#undef NA_LOAD
#undef NA_STORE
        l += __shfl_xor(l, 32);
        const float inv = 1.0f / l;
#pragma unroll
        for (int dt = 0; dt < 2; ++dt)
#pragma unroll
            for (int jq = 0; jq < 4; ++jq) {
                const int d0 = dt * 32 + jq * 8 + hh * 4;
                u32x2 w; w.x = pkbf(o[dt][jq * 4 + 0] * inv, o[dt][jq * 4 + 1] * inv); w.y = pkbf(o[dt][jq * 4 + 2] * inv, o[dt][jq * 4 + 3] * inv);
                *(u32x2*)(O + qrow * D + h * 64 + d0) = w;
            }
    }
    __syncthreads();
}

__device__ __forceinline__ f32x4 unpk4(u32x2 w) { return (f32x4){bflo(w.x), bfhi(w.x), bflo(w.y), bfhi(w.y)}; }
__device__ __forceinline__ bf16 bf1(float x) { return (bf16)(pkbf(x, 0.f) & 0xffffu); }
__device__ __forceinline__ f32x4 shx32(f32x4 v) { return (f32x4){__shfl_xor(v.x, 32), __shfl_xor(v.y, 32), __shfl_xor(v.z, 32), __shfl_xor(v.w, 32)}; }
template <int DIR>
__device__ __forceinline__ void hgrn_seq(const Frame& F, int b, int h, int eb) {
    const bf16* ZIN = (const bf16*)(F.ws + WS_ZIN); const bf16* VTG = (const bf16*)(F.ws + WS_VTG); bf16* OUT = (bf16*)(F.ws + (DIR ? WS_OFB : WS_OFF));
    const int lane = F.lane, l32 = lane & 31, hh = lane >> 5, cperm = kperm(l32);
    constexpr int IMG = 32 * 136 * 2, KTB = 128 * 80, DBUF = 2 * IMG + KTB + 512;
    unsigned char* dbase = F.lds + DIR * 2 * DBUF;
    const int tg = lane & 7, prho = 8 * eb + (lane >> 3), pc = kperm(prho);
    f32x16 S[4];
#pragma unroll
    for (int d = 0; d < 4; ++d)
#pragma unroll
        for (int j = 0; j < 16; ++j) S[d][j] = 0.f;
    const bf16* vbase = VTG + ((size_t)b * D + h * 128 + eb * 32 + l32) * P + hh * 8;
    const bf16* zp = ZIN + ((size_t)b * P + 4 * tg) * 4096 + h * 128 + 4 * prho;
#define HG_CHUNK(i_) (DIR == 0 ? (i_) : ((i_) < 8 ? 7 - (i_) : 79 - (i_)))
#define HG_LOAD(i_) do { const int c_ = HG_CHUNK(i_); const bf16* z_ = zp + (size_t)c_ * 32 * 4096; \
        _Pragma("unroll") for (int i = 0; i < 4; ++i) { nlf[i] = *(const u32x2*)(z_ + (size_t)i * 4096 + (1 + DIR) * D); nq[i] = *(const u32x2*)(z_ + (size_t)i * 4096); } \
        nv0 = *(const bf16x8*)(vbase + c_ * 32); nv1 = *(const bf16x8*)(vbase + c_ * 32 + 16); } while (0)
    u32x2 nlf[4], nq[4]; bf16x8 nv0, nv1;
    HG_LOAD(0);
#pragma unroll 1
    for (int idx = 0; idx < 72; ++idx) {
        const int cc = HG_CHUNK(idx);
        const size_t row0 = (size_t)b * P + cc * 32;
        unsigned char* buf = dbase + (idx & 1) * DBUF;
        bf16* Qp = (bf16*)buf; bf16* Kp = (bf16*)(buf + IMG); bf16* KT = (bf16*)(buf + 2 * IMG); float* egl = (float*)(buf + 2 * IMG + KTB);
        u32x2 lfc[4], qc[4];
#pragma unroll
        for (int i = 0; i < 4; ++i) { lfc[i] = nlf[i]; qc[i] = nq[i]; }
        const bf16x8 vf0 = nv0, vf1 = nv1;
        HG_LOAD(min(idx + 1, 71));
        f32x4 l4[4], t = (f32x4){0.f, 0.f, 0.f, 0.f};
#pragma unroll
        for (int i = 0; i < 4; ++i) { l4[i] = unpk4(lfc[i]); t += l4[i]; }
        f32x4 x = t;
#pragma unroll
        for (int k = 1; k < 8; k <<= 1) { const f32x4 y = (f32x4){__shfl_up(x.x, k, 8), __shfl_up(x.y, k, 8), __shfl_up(x.z, k, 8), __shfl_up(x.w, k, 8)}; if (tg >= k) x += y; }
        const f32x4 tot = (f32x4){__shfl(x.x, 7, 8), __shfl(x.y, 7, 8), __shfl(x.z, 7, 8), __shfl(x.w, 7, 8)};
        const f32x4 off = DIR == 0 ? x - t : tot - x;
        f32x4 eg = (f32x4){__builtin_amdgcn_exp2f(off.x), __builtin_amdgcn_exp2f(off.y), __builtin_amdgcn_exp2f(off.z), __builtin_amdgcn_exp2f(off.w)}; float kv[4][4];
#pragma unroll
        for (int ii = 0; ii < 4; ++ii) {
            const int i = DIR ? 3 - ii : ii;
            const f32x4 lf = l4[i], q4 = unpk4(qc[i]);
            const int srow = (4 * tg + i) * 136 + pc;
#pragma unroll
            for (int d = 0; d < 4; ++d) { const float f = __builtin_amdgcn_exp2f(lf[d]); eg[d] *= f; const float kq = (1.0f - f) * __builtin_amdgcn_rcpf(eg[d]);
                Qp[srow + d * 32] = bf1(q4[d] * eg[d]); Kp[srow + d * 32] = bf1(kq); kv[d][i] = kq; }
        }
#pragma unroll
        for (int d = 0; d < 4; ++d) { u32x2 w; w.x = pkbf(kv[d][0], kv[d][1]); w.y = pkbf(kv[d][2], kv[d][3]); *(u32x2*)(KT + (d * 32 + prho) * 40 + 4 * tg) = w; }
        if (tg == 0) *(f32x4*)(egl + 4 * prho) = (f32x4){__builtin_amdgcn_exp2f(tot.x), __builtin_amdgcn_exp2f(tot.y), __builtin_amdgcn_exp2f(tot.z), __builtin_amdgcn_exp2f(tot.w)};
        __syncthreads();
        bf16x8 kf[4][2];
#pragma unroll
        for (int d = 0; d < 4; ++d)
#pragma unroll
            for (int sg = 0; sg < 2; ++sg) kf[d][sg] = *(const bf16x8*)(KT + (d * 32 + l32) * 40 + sg * 16 + 8 * hh);
        if (cc >= NCTX / 32) {
        f32x16 att;
#pragma unroll
        for (int j = 0; j < 16; ++j) att[j] = 0.f;
        const bf16* krow = Kp + cperm * 136 + hh * 8; const bf16* qrow = Qp + l32 * 136 + hh * 8;
#pragma unroll
        for (int ks = 0; ks < 8; ++ks) att = MFMA32(*(const bf16x8*)(krow + ks * 16), *(const bf16x8*)(qrow + ks * 16), att);
#pragma unroll
        for (int j = 0; j < 16; ++j) { const int sa = 16 * (j >> 3) + 8 * hh + 4 * ((j >> 2) & 1) + (j & 3); const bool keep = DIR == 0 ? (sa <= l32) : (sa >= l32); att[j] = keep ? att[j] : 0.f; }
        const bf16x8 p0 = pack8(att, 0), p1 = pack8(att, 8);
        f32x16 o;
#pragma unroll
        for (int j = 0; j < 16; ++j) o[j] = 0.f;
        o = MFMA32(vf0, p0, o); o = MFMA32(vf1, p1, o);
#pragma unroll
        for (int d = 0; d < 4; ++d) { o = MFMA32(pack8(S[d], 0), *(const bf16x8*)(qrow + d * 32), o); o = MFMA32(pack8(S[d], 8), *(const bf16x8*)(qrow + d * 32 + 16), o); }
        bf16* op = OUT + (row0 + l32) * D + h * 128 + eb * 32 + 4 * hh;
#pragma unroll
        for (int jq = 0; jq < 4; ++jq) { u32x2 w; w.x = pkbf(o[4 * jq], o[4 * jq + 1]); w.y = pkbf(o[4 * jq + 2], o[4 * jq + 3]); *(u32x2*)(op + 8 * jq) = w; }
        }
#pragma unroll
        for (int d = 0; d < 4; ++d) { S[d] = MFMA32(kf[d][0], vf0, S[d]); S[d] = MFMA32(kf[d][1], vf1, S[d]); }
#pragma unroll
        for (int j = 0; j < 16; ++j) { const int rho = (j & 3) + 8 * (j >> 2) + 4 * hh; const f32x4 e4 = *(const f32x4*)(egl + 4 * rho);
            S[0][j] *= e4.x; S[1][j] *= e4.y; S[2][j] *= e4.z; S[3][j] *= e4.w; }
    }
#undef HG_LOAD
#undef HG_CHUNK
}
__device__ __forceinline__ void ph_hgrn_scan(const Frame& F) {
    for (int id = F.bid * NWAVES + F.wave; id < NB * 8 * 8; id += F.nb * NWAVES) {
        const int eb = id & 3, dir = (id >> 2) & 1, h = (id >> 3) & 7, b = id >> 6;
        if (dir == 0) hgrn_seq<0>(F, b, h, eb); else hgrn_seq<1>(F, b, h, eb);
    }
}
__device__ __forceinline__ void ph_hgrn_post(const Frame& F) {
    const bf16* ZIN = (const bf16*)(F.ws + WS_ZIN); const bf16* OFF = (const bf16*)(F.ws + WS_OFF); const bf16* OFB = (const bf16*)(F.ws + WS_OFB); bf16* O2 = (bf16*)(F.ws + WS_O2);
    const int lane = F.lane, part = lane & 7;
    f32x4 gn[4];
#pragma unroll
    for (int q = 0; q < 4; ++q) gn[q] = *(const f32x4*)(F.in[26] + part * 16 + q * 4);
    for (int row = F.bid * NWAVES + F.wave; row < R; row += F.nb * NWAVES) {
        if (row % P < NCTX) continue;
        const size_t o = (size_t)row * D + lane * 16;
        const u32x4 a0 = *(const u32x4*)(OFF + o), a1 = *(const u32x4*)(OFF + o + 8), b0 = *(const u32x4*)(OFB + o), b1 = *(const u32x4*)(OFB + o + 8);
        const u32x4 g0 = *(const u32x4*)(ZIN + (size_t)row * 4096 + 3 * D + lane * 16), g1 = *(const u32x4*)(ZIN + (size_t)row * 4096 + 3 * D + lane * 16 + 8);
        float v[16];
        v[0] = bflo(a0.x) + bflo(b0.x); v[1] = bfhi(a0.x) + bfhi(b0.x); v[2] = bflo(a0.y) + bflo(b0.y); v[3] = bfhi(a0.y) + bfhi(b0.y);
        v[4] = bflo(a0.z) + bflo(b0.z); v[5] = bfhi(a0.z) + bfhi(b0.z); v[6] = bflo(a0.w) + bflo(b0.w); v[7] = bfhi(a0.w) + bfhi(b0.w);
        v[8] = bflo(a1.x) + bflo(b1.x); v[9] = bfhi(a1.x) + bfhi(b1.x); v[10] = bflo(a1.y) + bflo(b1.y); v[11] = bfhi(a1.y) + bfhi(b1.y);
        v[12] = bflo(a1.z) + bflo(b1.z); v[13] = bfhi(a1.z) + bfhi(b1.z); v[14] = bflo(a1.w) + bflo(b1.w); v[15] = bfhi(a1.w) + bfhi(b1.w);
        float ss = 0.f;
#pragma unroll
        for (int q = 0; q < 16; ++q) ss += v[q] * v[q];
        ss += dpp_xor1(ss); ss += dpp_xor2(ss); ss += __shfl_xor(ss, 4);
        const float rinv = rsqrtf(ss * (1.0f / 128.0f) + EPS);
        const unsigned gw[8] = {g0.x, g0.y, g0.z, g0.w, g1.x, g1.y, g1.z, g1.w};
        unsigned w[8];
#pragma unroll
        for (int q = 0; q < 8; ++q) w[q] = pkbf(v[2 * q] * rinv * gn[q >> 1][(2 * q) & 3] * bflo(gw[q]), v[2 * q + 1] * rinv * gn[q >> 1][(2 * q + 1) & 3] * bfhi(gw[q]));
        *(u32x4*)(O2 + o) = (u32x4){w[0], w[1], w[2], w[3]}; *(u32x4*)(O2 + o + 8) = (u32x4){w[4], w[5], w[6], w[7]};
    }
}

enum { PH_BASE = __COUNTER__ };
__global__ void __launch_bounds__(NTHREADS, 2) fwd(Args args) {
    extern __shared__ __attribute__((aligned(16))) unsigned char lds[];
    Frame F;
    F.lds = lds; F.wave = __builtin_amdgcn_readfirstlane((int)threadIdx.x >> 6); F.bid = blockIdx.x; F.nb = gridDim.x;
    REFRESH_(F);
    F.in = args.in; F.out = args.out; F.ws = args.ws;
    F.MOD = (float*)(args.ws + WS_MOD); F.AFF = (float*)(args.ws + WS_AFF); F.SEL = (int*)(args.ws + WS_SEL); F.GATE = (float*)(args.ws + WS_GATE); F.INV = (int*)(args.ws + WS_INV);
    F.X = (bf16*)(args.ws + WS_X); F.H = (bf16*)(args.ws + WS_H);
    const int lo = args.ph_lo, hi = args.ph_hi;
#if MK_SINGLE
    volatile LAS unsigned* misc = (volatile LAS unsigned*)((LAS unsigned char*)lds + LDS_MISC);
    if (F.tid < 64) misc[F.tid] = 0u;
    __syncthreads();
    XcdBarrier bar = xcd_barrier_post((unsigned*)(args.ws + WS_CTL) + CW_BAR, misc, F.tid);
#define SEAM(k) do { if ((k) + 1 < hi) xcd_barrier(bar, F.tid); } while (0)
#else
#define SEAM(k) do { } while (0)
#endif
#define PH(...) do { constexpr int k_ = __COUNTER__ - PH_BASE - 1; if (lo <= k_ && k_ < hi) { REFRESH_(F); __VA_ARGS__; SEAM(k_); } } while (0)
    bf16* HID = (bf16*)(F.ws + WS_HID); bf16* Y = (bf16*)(F.ws + WS_Y);
    PG8_LAS unsigned char* ring = (PG8_LAS unsigned char*)lds;
    bf16 *Qb = (bf16*)(F.ws + WS_Q), *VTb = (bf16*)(F.ws + WS_VT), *Ob = (bf16*)(F.ws + WS_O);

#define GEMM_PHASE(EPI, gA, lda_, gB, ldb_, gK, nM_, nN_, groups_, gsM_, ...) do { const pg8::Gemm g_{(const bf16*)(gA), (const bf16*)(gB), (lda_), (ldb_), (gK), nullptr}; pg8::GroupedOrder S_; S_.init((nM_), (nN_), (groups_), (gsM_), F.nb, F.bid); \
        const EPI E_{__VA_ARGS__}; pg8::gemm_phase<EPI, pg8::GroupedOrder, PG8_ALIGN, PG8_SP2>(ring, g_, S_, E_, F.tid); } while (0)
#define GEMM_PHASE_LAT(EPI, gA, lda_, gB, ldb_, gK, nN_, ...) do { const pg8::Gemm g_{(const bf16*)(gA), (const bf16*)(gB), (lda_), (ldb_), (gK), nullptr}; pg8::LatentOrder S_; S_.init((nN_), F.nb, F.bid); \
        const EPI E_{__VA_ARGS__}; pg8::gemm_phase<EPI, pg8::LatentOrder, PG8_ALIGN, PG8_SP2>(ring, g_, S_, E_, F.tid); } while (0)
#define GEMM_PHASE_GATHER(EPI, gA, lda_, gIdx, gB, ldb_, gK, nM_, nN_, groups_, gsM_, ...) do { const pg8::Gemm g_{(const bf16*)(gA), (const bf16*)(gB), (lda_), (ldb_), (gK), (gIdx)}; pg8::GroupedOrder S_; S_.init((nM_), (nN_), (groups_), (gsM_), F.nb, F.bid); \
        const EPI E_{__VA_ARGS__}; pg8::gemm_phase<EPI, pg8::GroupedOrder, PG8_ALIGN, PG8_SP2, true>(ring, g_, S_, E_, F.tid); } while (0)
#define MODL(L) (F.MOD + (size_t)(L) * 33 * 6144)
#define MOE_PHASES(L, NMT, NITEMS, SKIPC) \
    PH(ph_norm2<SKIPC>(F, (L))); \
    PH(ph_topk(F, (NITEMS))); \
    PH(GEMM_PHASE_GATHER(pg8::EpiSwigluT, F.H, D, F.SEL, F.ws + WO_GU, D, D, (NMT), 2 * FF / 256, NE, SLOTS / 256, HID, 2 * FF / 256, FF)); \
    PH(GEMM_PHASE(pg8::EpiDownT, HID, FF, F.ws + WO_DN, FF, FF, (NMT), D / 256, NE, SLOTS / 256, Y, F.GATE, D / 256));
#define OUT_PROJ(Asrc, Wsrc, L) PH(GEMM_PHASE(pg8::EpiResidT, (Asrc), D, (Wsrc), D, D, R / 256, D / 256, 1, R / 256, F.X, MODL(L)));

    PH(ph_prologue(F));
    PH(ph_norm<0, false, true, false, true>(F, 0, 0));
    PH(GEMM_PHASE(pg8::EpiF32G, F.ws + WS_AG, 768, F.ws + WS_S5W1, 512, 512, 2304 / 256, 1, 64, 2304 / 256, (float*)(F.ws + WS_SS), 256, 1));
    PH(ph_s5_scan(F));
    PH(GEMM_PHASE(pg8::EpiS5Out, F.ws + WS_AG, 768, F.ws + WS_S5W2, 768, 768, 2304 / 256, 2, 64, 2304 / 256, F.H, (bf16*)(F.ws + WS_Z), F.in[15]));
    PH(GEMM_PHASE(pg8::EpiGluT, F.ws + WS_Z, D, F.ws + WO_GLU, D, D, R / 256, 2 * D / 256, 1, R / 256, F.X, MODL(0)));
    MOE_PHASES(0, SLOTS / 256, NB * NE * 2, false)
    PH(ph_norm<0, true>(F, 1, 0); convert_moe(F, 1));
    PH(GEMM_PHASE(pg8::EpiBf16<0>, F.H, D, F.ws + WO_NAQKV, D, D, R / 256, 2 * D / 256, 1, R / 256, Qb, D, nullptr, D, (size_t)(WS_K - WS_Q) / 2, 1.0f);
       GEMM_PHASE(pg8::EpiVtT<false>, F.ws + WO_NAQKV + (size_t)2 * D * D * 2, D, F.H, D, D, D / 256, R / 256, 1, D / 256, VTb));
    PH(ph_na_attn(F));
    OUT_PROJ(Ob, F.ws + WO_NAO, 1)
    MOE_PHASES(1, SLOTS / 256, NB * NE * 2, false)
    PH(ph_norm<0, true>(F, 2, 1); convert_moe(F, 2));
    PH(GEMM_PHASE(pg8::EpiQKRope, F.H, D, F.ws + WO_DAQKV, D, D, R / 256, 2 * D / 256, 1, R / 256, Qb, (size_t)(WS_K - WS_Q) / 2, (const float*)(F.ws + WS_ROPE));
       GEMM_PHASE(pg8::EpiVtT<false>, F.ws + WO_DAQKV + (size_t)2 * D * D * 2, D, F.H, D, D, D / 256, R / 256, 1, D / 256, VTb));
    PH(ph_da_attn(F));
    OUT_PROJ(Ob, F.ws + WO_DAO, 2)
    MOE_PHASES(2, SLOTS / 256, NB * NE * 2, false)
    PH(ph_norm<0, true>(F, 3, 2); convert_moe(F, 3));
    PH(GEMM_PHASE(pg8::EpiHgIn, F.H, D, F.ws + WO_HGIN, D, D, R / 256, 4 * D / 256, 1, R / 256, (bf16*)(F.ws + WS_ZIN), (const float*)(F.ws + WS_LB));
       GEMM_PHASE(pg8::EpiVtT<true>, F.ws + WO_HGIN + (size_t)4 * D * D * 2, D, F.H, D, D, D / 256, R / 256, 1, D / 256, (bf16*)(F.ws + WS_VTG)));
    PH(ph_hgrn_scan(F));
    PH(ph_hgrn_post(F));
    PH(GEMM_PHASE_LAT(pg8::EpiResidT, F.ws + WS_O2, D, F.ws + WO_HGO, D, D, D / 256, F.X, MODL(3)));
    MOE_PHASES(3, NB, NB * NE, true)
    PH(ph_norm<2, true, false, true>(F, 0, 3));
}
constexpr int NPH = __COUNTER__ - PH_BASE - 1;

extern "C" void kernel_launch(void* const* d_in, const int* in_sizes, int n_in, void* d_out, int out_size, void* d_ws, size_t ws_size, hipStream_t stream) {
    static int grid = 0;
    if (grid == 0) {
        if (n_in != 33 || ws_size < WS_NEED) { fprintf(stderr, "kernel_launch: n_in %d ws %zu (need %zu)\n", n_in, ws_size, (size_t)WS_NEED); grid = -1; return; }
        int dev = 0, cus = 0;
        if (hipGetDevice(&dev) != hipSuccess || hipDeviceGetAttribute(&cus, hipDeviceAttributeMultiprocessorCount, dev) != hipSuccess) { grid = -1; return; }
        if (hipFuncSetAttribute((const void*)fwd, hipFuncAttributeMaxDynamicSharedMemorySize, LDS_BYTES) != hipSuccess) { fprintf(stderr, "kernel_launch: hipFuncSetAttribute failed\n"); grid = -1; return; }
        int per_cu = 0;
        if (hipOccupancyMaxActiveBlocksPerMultiprocessor(&per_cu, (const void*)fwd, NTHREADS, LDS_BYTES) != hipSuccess || per_cu < 1) fprintf(stderr, "kernel_launch: occupancy query says %d\n", per_cu);
        (void)hipGetLastError();
        grid = cus;
    }
    if (grid < 0) return;
    (void)hipMemsetAsync((char*)d_ws + WS_CTL + (size_t)CW_BAR * 4, 0, (size_t)XCD_BAR_WORDS * 4, stream);
    Args a{};
    for (int i = 0; i < 33; ++i) a.in[i] = (const float*)d_in[i];
    a.out = (float*)d_out; a.ws = (unsigned char*)d_ws;
#if MK_SINGLE
    a.ph_lo = 0; a.ph_hi = NPH;
    hipLaunchKernelGGL(fwd, dim3(grid), dim3(NTHREADS), LDS_BYTES, stream, a);
#else
    for (int k = 0; k < NPH; ++k) { a.ph_lo = k; a.ph_hi = k + 1; hipLaunchKernelGGL(fwd, dim3(grid), dim3(NTHREADS), LDS_BYTES, stream, a); }
#endif
}
```

```cpp
#include <hip/hip_runtime.h>
#include <cstdio>
#include <cstdint>

#ifndef MK_SINGLE
#define MK_SINGLE 1
#endif

typedef unsigned short bf16;
typedef float f32x4 __attribute__((ext_vector_type(4)));
typedef float f32x2 __attribute__((ext_vector_type(2)));
typedef unsigned u32x2 __attribute__((ext_vector_type(2)));
typedef unsigned u32x4 __attribute__((ext_vector_type(4)));
#define LAS __attribute__((address_space(3)))

constexpr int NB = 32, SEQ = 2048, NCTX = 256, D = 1024, P = NCTX + SEQ  , R = NB * P  ;
constexpr int NE = 16, FF = 2048, SLOTS = NB * 256 + NB * 32  ;
constexpr float EPS = 1e-6f;
constexpr float LOG2E_ = 1.4426950408889634f;
constexpr float LAM_INIT = 0.47071302f;
constexpr int NWAVES = 8, NTHREADS = 512;
constexpr int LDS_BYTES = 147456;
constexpr int LDS_MISC = 147456 - 256;

constexpr size_t MiB = 1u << 20;
constexpr size_t WS_CTL = 0, CTL_ZERO_BYTES = 1 * MiB;
constexpr size_t WS_MOD = 1 * MiB;
constexpr size_t WS_AFF = 5 * MiB;
constexpr size_t WS_SEL = 10 * MiB;
constexpr size_t WS_GATE = 11 * MiB;
constexpr size_t WS_INV = 12 * MiB;
constexpr size_t WS_X = 32 * MiB;
constexpr size_t WS_H = 320 * MiB;
constexpr size_t WS_W = 464 * MiB;
constexpr size_t WS_BIG = 720 * MiB;
constexpr size_t WS_HID = WS_BIG;
constexpr size_t WS_Y = WS_BIG + 576 * MiB;
constexpr size_t WS_XS = WS_BIG + 864 * MiB;
constexpr size_t WS_AG = WS_BIG;
constexpr size_t WS_SS = WS_BIG + 216 * MiB;
constexpr size_t WS_Z = WS_BIG + 360 * MiB;
constexpr size_t WS_S5W1 = WS_BIG + 504 * MiB;
constexpr size_t WS_S5W2 = WS_BIG + 520 * MiB;
constexpr size_t WS_S5A = WS_BIG + 568 * MiB;
constexpr size_t WS_Q = WS_BIG, WS_K = WS_BIG + 144 * MiB, WS_V = WS_BIG + 288 * MiB, WS_VT = WS_BIG + 432 * MiB, WS_O = WS_BIG + 576 * MiB;
constexpr size_t WS_ZIN = WS_BIG;
constexpr size_t WS_VTG = WS_BIG + 576 * MiB;
constexpr size_t WS_OFF = WS_BIG + 720 * MiB;
constexpr size_t WS_OFB = WS_BIG + 1008 * MiB;
constexpr size_t WS_O2 = WS_H;
constexpr size_t WS_LB = 17 * MiB;
constexpr size_t WS_ROPE = 18 * MiB;
constexpr size_t WS_NEED = 2048 * MiB;
constexpr size_t WO_GLU = WS_W, WO_NAQKV = WS_W + 4 * MiB, WO_NAO = WS_W + 10 * MiB, WO_DAQKV = WS_W + 12 * MiB, WO_DAO = WS_W + 18 * MiB, WO_HGIN = WS_W + 20 * MiB, WO_HGO = WS_W + 30 * MiB;
constexpr size_t WO_GU = WS_W + 32 * MiB  , WO_DN = WS_W + 160 * MiB  ;
constexpr int CW_BAR = 4096;

__device__ __forceinline__ unsigned f2bf(float f) { unsigned u = __builtin_bit_cast(unsigned, f); return (u + 0x7fffu + ((u >> 16) & 1u)) >> 16; }
__device__ __forceinline__ float bf2f(unsigned h) { return __builtin_bit_cast(float, h << 16); }
__device__ __forceinline__ unsigned pk2(float lo, float hi) { return f2bf(lo) | (f2bf(hi) << 16); }
typedef __bf16 bf16x2_t __attribute__((ext_vector_type(2)));
__device__ __forceinline__ unsigned pkbf(float lo, float hi) { const f32x2 v = {lo, hi}; return __builtin_bit_cast(unsigned, __builtin_convertvector(v, bf16x2_t)); }
__device__ __forceinline__ float bflo(unsigned w) { return __builtin_bit_cast(float, w << 16); }
__device__ __forceinline__ float bfhi(unsigned w) { return __builtin_bit_cast(float, w & 0xffff0000u); }
__device__ __forceinline__ float wave_sum(float v) {
#pragma unroll
    for (int o = 1; o < 64; o <<= 1) v += __shfl_xor(v, o);
    return v;
}
__device__ __forceinline__ float wave_max(float v) {
#pragma unroll
    for (int o = 1; o < 64; o <<= 1) v = fmaxf(v, __shfl_xor(v, o));
    return v;
}
__device__ __forceinline__ float sigmoidf_(float x) { return 1.0f / (1.0f + expf(-x)); }
__device__ __forceinline__ float siluf_(float x) { return x / (1.0f + expf(-x)); }
__device__ __forceinline__ float gelu_tanh(float x) { return 0.5f * x * (1.0f + tanhf(0.7978845608028654f * (x + 0.044715f * x * x * x))); }
__device__ __forceinline__ float dpp_xor1(float v) { return __builtin_bit_cast(float, __builtin_amdgcn_update_dpp(0, __builtin_bit_cast(int, v), 0xB1, 0xF, 0xF, true)); }
__device__ __forceinline__ float dpp_xor2(float v) { return __builtin_bit_cast(float, __builtin_amdgcn_update_dpp(0, __builtin_bit_cast(int, v), 0x4E, 0xF, 0xF, true)); }
__device__ __forceinline__ float reduce16(float (&v)[16], int lane) {
    const bool b0 = lane & 1, b1 = lane & 2, b2 = lane & 4, b3 = lane & 8;
    float a[8];
#pragma unroll
    for (int k = 0; k < 8; ++k) { const float snd = b0 ? v[k] : v[8 + k], kep = b0 ? v[8 + k] : v[k]; a[k] = kep + dpp_xor1(snd); }
    float c[4];
#pragma unroll
    for (int k = 0; k < 4; ++k) { const float snd = b1 ? a[k] : a[4 + k], kep = b1 ? a[4 + k] : a[k]; c[k] = kep + dpp_xor2(snd); }
    float d[2];
#pragma unroll
    for (int k = 0; k < 2; ++k) { const float snd = b2 ? c[k] : c[2 + k], kep = b2 ? c[2 + k] : c[k]; d[k] = kep + __shfl_xor(snd, 4); }
    float r = (b3 ? d[1] : d[0]) + __shfl_xor(b3 ? d[0] : d[1], 8);
    r += __shfl_xor(r, 16); r += __shfl_xor(r, 32);
    return r;
}
#define WAVE_LDS_SYNC() asm volatile("s_waitcnt lgkmcnt(0)" ::: "memory")

#define XB_TMO      128
#define XB_XCNT(j)  (256  + 64 * (j))
#define XB_XSUB(j)  (1280 + 64 * (j))
#define XB_XGEN(j)  (2304 + 64 * (j))
#define XB_TOP      3328
#define XB_TOPGEN   3392
#define XCD_BAR_WORDS 3456
#define XB_SPIN_CAP (1u << 27)
__device__ __forceinline__ unsigned xb_ld(unsigned* p)              { return __hip_atomic_load(p, __ATOMIC_RELAXED, __HIP_MEMORY_SCOPE_AGENT); }
__device__ __forceinline__ unsigned xb_add(unsigned* p, unsigned v) { return __hip_atomic_fetch_add(p, v, __ATOMIC_RELAXED, __HIP_MEMORY_SCOPE_AGENT); }
__device__ __forceinline__ unsigned xb_xcc_id() { return (unsigned)__builtin_amdgcn_s_getreg((3 << 11) | 20) & 0xFu; }
#define XB_SPIN(cond, bar) do { unsigned _sp = 0; while (cond) { __builtin_amdgcn_s_sleep(1); \
    if ((++_sp & 255u) == 0u) { if (xb_ld(&(bar)[XB_TMO])) break; if (_sp > XB_SPIN_CAP) { atomicAdd(&(bar)[XB_TMO], 1u); break; } } } } while (0)
struct XcdBarrier { unsigned* bar; unsigned x; volatile LAS unsigned* st; };
__device__ __forceinline__ XcdBarrier xcd_barrier_post(unsigned* bar, volatile LAS unsigned* st, int tid_) {
    XcdBarrier b; b.bar = bar; b.x = xb_xcc_id(); b.st = st;
    if (tid_ == 0) (void)xb_add(&bar[XB_XCNT(b.x)], 1u);
    return b;
}
__device__ __forceinline__ void xcd_barrier_complete(unsigned* bar, unsigned x, unsigned& nloc, unsigned& nx) {
    const unsigned G = gridDim.x * gridDim.y * gridDim.z;
    unsigned sum, cnt, mine, sp = 0u;
    for (;;) {
        sum = 0u; cnt = 0u; mine = 0u;
#pragma unroll
        for (unsigned j = 0; j < 16; ++j) { const unsigned c = xb_ld(&bar[XB_XCNT(j)]); sum += c; cnt += (c > 0u) ? 1u : 0u; mine = (j == x) ? c : mine; }
        if (sum == G) break;
        __builtin_amdgcn_s_sleep(1);
        if ((++sp & 255u) == 0u) { if (xb_ld(&bar[XB_TMO])) break; if (sp > XB_SPIN_CAP) { atomicAdd(&bar[XB_TMO], 1u); break; } }
    }
    nloc = mine > 0u ? mine : 1u; nx = cnt > 0u ? cnt : 1u;
}
__device__ __forceinline__ void xcd_barrier(const XcdBarrier& b, int tid_) {
    asm volatile("s_waitcnt vmcnt(0)" ::: "memory");
    __syncthreads();
    if (tid_ == 0) {
        unsigned* bar = b.bar;
        __builtin_amdgcn_s_waitcnt(0);
        unsigned nloc = b.st[0], nx = b.st[1];
        if (nloc == 0u) { xcd_barrier_complete(bar, b.x, nloc, nx); b.st[0] = nloc; b.st[1] = nx; }
        const unsigned old = xb_add(&bar[XB_XSUB(b.x)], 1u);
        const unsigned gen = old / nloc;
        if (old + 1u == (gen + 1u) * nloc) {
            __builtin_amdgcn_fence(__ATOMIC_RELEASE, "agent");
            asm volatile("s_waitcnt vmcnt(0)" ::: "memory");
            const unsigned og = xb_add(&bar[XB_TOP], 1u);
            const unsigned tg = og / nx;
            if (og + 1u == (tg + 1u) * nx) xb_add(&bar[XB_TOPGEN], 1u);
            else XB_SPIN(xb_ld(&bar[XB_TOPGEN]) == tg, bar);
            __builtin_amdgcn_fence(__ATOMIC_ACQUIRE, "agent");
            xb_add(&bar[XB_XGEN(b.x)], 1u);
            asm volatile("s_waitcnt vmcnt(0)" ::: "memory");
        } else {
            XB_SPIN(xb_ld(&bar[XB_XGEN(b.x)]) == gen, bar);
            __builtin_amdgcn_fence(__ATOMIC_ACQUIRE, "agent");
            asm volatile("s_waitcnt vmcnt(0)" ::: "memory");
        }
    }
    __syncthreads();
}

namespace pg8 {
#define PG8_LAS __attribute__((address_space(3)))
typedef unsigned short bf16_t;
typedef short bf16x8 __attribute__((ext_vector_type(8)));
typedef float f32x4 __attribute__((ext_vector_type(4)));
typedef unsigned u32x4 __attribute__((ext_vector_type(4)));
constexpr int BM = 256, BK = 64, HALF = 128, HTB = HALF * BK * 2  , STAGE_BYTES = 8 * HTB, NXCD = 8, WGM = 8;

__host__ __device__ __forceinline__ int lds_byte(int r, int c) { const int st = (r >> 4) * 2 + (c >> 5), rr = r & 15, cc = c & 31, ob = rr * 64 + cc * 2; return st * 1024 + (ob ^ (((ob >> 9) & 1) << 5)); }
__host__ __device__ __forceinline__ void stage_rc(int b, int& R, int& C) { const int st = b / 1024, sb = b % 1024, swz = sb ^ (((sb >> 9) & 1) << 5); R = (st >> 1) * 16 + swz / 64; C = (st & 1) * 32 + (swz % 64) / 2; }
__host__ __device__ __forceinline__ int perm32(int rho) { const int n = rho >> 4, i = rho & 15; return 8 * (i >> 2) + 4 * n + (i & 3); }

struct Unit { int pm, pn; };
struct Gemm { const bf16_t* A; const bf16_t* Bt; int lda, ldb, K; const int* rowidx; };

struct StaticOrder {
    int nM, nN, nwg, G, c;
    __host__ __device__ void init(int M, int N, int G_, int c_) { nM = M / BM; nN = N / BM; nwg = nM * nN; G = G_; c = c_; }
    __host__ __device__ bool next(int i, Unit& u) const {
        const long L = (long)i * G + c; if (L >= nwg) return false;
        int wgid = (int)L; { const int q = nwg / NXCD, r = nwg % NXCD, xcd = wgid % NXCD, off = wgid / NXCD; wgid = (xcd < r ? xcd * (q + 1) : r * (q + 1) + (xcd - r) * q) + off; }
        const int nig = WGM * nN, gid = wgid / nig, fm = gid * WGM, gsz = (nM - fm) < WGM ? (nM - fm) : WGM;
        u.pm = fm + ((wgid % nig) % gsz); u.pn = (wgid % nig) / gsz; return true;
    }
    __device__ __forceinline__ void a_ready(const Unit&) const {}
    __device__ __forceinline__ void done(const Unit&) const {}
};

__device__ __forceinline__ unsigned cvt_pk_bf16(float lo, float hi) { unsigned r; asm volatile("v_cvt_pk_bf16_f32 %0, %1, %2" : "=v"(r) : "v"(lo), "v"(hi)); return r; }
typedef float f32x2 __attribute__((ext_vector_type(2)));
__device__ __forceinline__ f32x2 gelu_pk(f32x2 v) {
    const f32x2 av = __builtin_elementwise_abs(v), d = av * 0.2316418882f + 1.0f;
    f32x2 t; t.x = __builtin_amdgcn_rcpf(d.x); t.y = __builtin_amdgcn_rcpf(d.y);
    f32x2 q = t * 0.5307027145f + (-0.7265760135f); q = q * t + 0.7107068705f; q = q * t + (-0.142248368f); q = q * t + 0.127414796f; q = q * t;
    const f32x2 s = (v * v) * (-0.72134752044f);
    f32x2 e; e.x = __builtin_amdgcn_exp2f(s.x); e.y = __builtin_amdgcn_exp2f(s.y);
    const f32x2 m = v * (q * e), r = v - m;
    f32x2 o; o.x = v.x < 0.f ? m.x : r.x; o.y = v.y < 0.f ? m.y : r.y; return o;
}

template <int ACT  > struct EpiBf16 {
    static constexpr bool PERM = true, AFTER_DRAIN = false; static_assert(ACT == 0 || ACT == 1, "EpiBf16: ACT is 0 (none) or 1 (gelu_pk)");
    bf16_t* O; int ldc; const float* bias; int split_cols; size_t split_stride; float scale0;
    __device__ __forceinline__ void operator()(const f32x4 (&acc)[2][2][4][2], const Unit& u, int wr, int wc, int fr, int fq) const {
        const int row0 = u.pm * BM + wr * 64 + fr; int colt = u.pn * BM; bf16_t* base = O;
        float sc = 1.f; if (split_cols) { const int t = colt / split_cols; base += (size_t)t * split_stride; colt -= t * split_cols; if (t == 0) sc = scale0; }
        const int col0 = colt + wc * 32 + 8 * fq, bcol0 = u.pn * BM + wc * 32 + 8 * fq;
        f32x4 bv[2][2];
#pragma unroll
        for (int bj = 0; bj < 2; ++bj)
#pragma unroll
            for (int n = 0; n < 2; ++n) bv[bj][n] = bias ? *(const f32x4*)(bias + bcol0 + bj * HALF + 4 * n) : (f32x4){0.f, 0.f, 0.f, 0.f};
#pragma unroll
        for (int ai = 0; ai < 2; ++ai)
#pragma unroll
            for (int m = 0; m < 4; ++m) { bf16_t* rowp = base + (size_t)(row0 + ai * HALF + m * 16) * ldc + col0;
#pragma unroll
                for (int bj = 0; bj < 2; ++bj) { f32x4 v0 = acc[ai][bj][m][0] + bv[bj][0], v1 = acc[ai][bj][m][1] + bv[bj][1];
                    if (ACT == 1) { f32x2 a = gelu_pk((f32x2){v0[0], v0[1]}), b = gelu_pk((f32x2){v0[2], v0[3]}), c = gelu_pk((f32x2){v1[0], v1[1]}), d = gelu_pk((f32x2){v1[2], v1[3]});
                        v0 = (f32x4){a.x, a.y, b.x, b.y}; v1 = (f32x4){c.x, c.y, d.x, d.y}; }
                    v0 = v0 * sc; v1 = v1 * sc; u32x4 w; w.x = cvt_pk_bf16(v0[0], v0[1]); w.y = cvt_pk_bf16(v0[2], v0[3]); w.z = cvt_pk_bf16(v1[0], v1[1]); w.w = cvt_pk_bf16(v1[2], v1[3]);
                    *(u32x4*)(rowp + bj * HALF) = w; } }
    }
};


struct GroupedOrder {
    int nM, nN, groups, gsM, G, c, total;
    __host__ __device__ void init(int nM_, int nN_, int groups_, int gsM_, int G_, int c_) { nM = nM_; nN = nN_; groups = groups_; gsM = gsM_; G = G_; c = c_; total = nM * nN * groups; }
    __host__ __device__ bool next(int i, Unit& u) const {
        const long L = (long)i * G + c; if (L >= total) return false;
        int T = (int)L; { const int q = total / NXCD, r = total % NXCD, xcd = T % NXCD, off = T / NXCD; T = (xcd < r ? xcd * (q + 1) : r * (q + 1) + (xcd - r) * q) + off; }
        const int tpg = nM * nN, g = T / tpg, t = T - g * tpg;
        const int nig = WGM * nN, gid = t / nig, fm = gid * WGM, gsz = (nM - fm) < WGM ? (nM - fm) : WGM;
        u.pm = g * gsM + fm + ((t % nig) % gsz); u.pn = g * nN + (t % nig) / gsz; return true;
    }
    __device__ __forceinline__ void a_ready(const Unit&) const {}
    __device__ __forceinline__ void done(const Unit&) const {}
};
struct LatentOrder {
    GroupedOrder o;
    __host__ __device__ void init(int nN_, int G_, int c_) { o.init(256, nN_, 1, 256, G_, c_); }
    __host__ __device__ bool next(int i, Unit& u) const { if (!o.next(i, u)) return false; u.pm += (u.pm >> 3) + 1; return true; }
    __device__ __forceinline__ void a_ready(const Unit&) const {}
    __device__ __forceinline__ void done(const Unit&) const {}
};
struct HgInOrder {
    LatentOrder lat; int G, c;
    __host__ __device__ void init(int G_, int c_) { lat.init(16, G_, c_); G = G_; c = c_; }
    __host__ __device__ bool next(int i, Unit& u) const {
        const long L = (long)i * G + c;
        if (L < 4096) return lat.next(i, u);
        const int t = (int)L - 4096; if (t >= 256) return false;
        u.pm = (t >> 3) * 9; u.pn = 4 + (t & 7); return true;
    }
    __device__ __forceinline__ void a_ready(const Unit&) const {}
    __device__ __forceinline__ void done(const Unit&) const {}
};
__device__ __forceinline__ float sigm(float x) { return __builtin_amdgcn_rcpf(1.0f + __builtin_amdgcn_exp2f(x * -1.4426950408889634f)); }
constexpr int PP = 2304, DD = 1024;
__device__ __forceinline__ int mrow_of(int row) { const int b = row / PP, pos = row - b * PP; return pos < 256 ? 32 : b; }
struct EpiResidT {
    static constexpr bool PERM = false, AFTER_DRAIN = false;
    bf16_t* X; const float* MODL;
    __device__ __forceinline__ void operator()(const f32x4 (&acc)[2][2][4][2], const Unit& u, int wr, int wc, int fr, int fq) const {
        const int row0 = u.pm * BM + wr * 64 + fr, col0 = u.pn * BM + wc * 32 + 4 * fq;
#pragma unroll
        for (int ai = 0; ai < 2; ++ai)
#pragma unroll
            for (int m = 0; m < 4; ++m) { const int row = row0 + ai * HALF + m * 16; bf16_t* x = X + (size_t)row * DD + col0; const float* g = MODL + (size_t)mrow_of(row) * 6144 + 2 * DD + col0;
                u32x2 xo[2][2];
#pragma unroll
                for (int bj = 0; bj < 2; ++bj)
#pragma unroll
                    for (int n = 0; n < 2; ++n) xo[bj][n] = *(const u32x2*)(x + bj * HALF + n * 16);
#pragma unroll
                for (int bj = 0; bj < 2; ++bj)
#pragma unroll
                    for (int n = 0; n < 2; ++n) { const int o = bj * HALF + n * 16; const f32x4 xv = {bflo(xo[bj][n].x), bfhi(xo[bj][n].x), bflo(xo[bj][n].y), bfhi(xo[bj][n].y)};
                        const f32x4 r = xv + *(const f32x4*)(g + o) * acc[ai][bj][m][n]; u32x2 w; w.x = pkbf(r.x, r.y); w.y = pkbf(r.z, r.w); *(u32x2*)(x + o) = w; } }
    }
};
struct EpiGluT {
    static constexpr bool PERM = true, AFTER_DRAIN = false;
    bf16_t* X; const float* MODL;
    __device__ __forceinline__ void operator()(const f32x4 (&acc)[2][2][4][2], const Unit& u, int wr, int wc, int fr, int fq) const {
        const int row0 = u.pm * BM + wr * 64 + fr, f0 = u.pn * 128 + wc * 32 + 8 * fq;
#pragma unroll
        for (int ai = 0; ai < 2; ++ai)
#pragma unroll
            for (int m = 0; m < 4; ++m) { const int row = row0 + ai * HALF + m * 16; bf16_t* x = X + (size_t)row * DD + f0; const float* g = MODL + (size_t)mrow_of(row) * 6144 + 2 * DD + f0;
                const u32x4 xo = *(const u32x4*)x; u32x4 w;
#pragma unroll
                for (int n = 0; n < 2; ++n) { const f32x4 a = acc[ai][0][m][n], b = acc[ai][1][m][n]; f32x4 v = b * -1.4426950408889634f;
#pragma unroll
                    for (int q = 0; q < 4; ++q) v[q] = __builtin_amdgcn_exp2f(v[q]);
                    v = v + 1.0f;
#pragma unroll
                    for (int q = 0; q < 4; ++q) v[q] = __builtin_amdgcn_rcpf(v[q]);
                    v = v * a;
                    const unsigned x01 = n ? xo.z : xo.x, x23 = n ? xo.w : xo.y; const f32x4 xv = {bflo(x01), bfhi(x01), bflo(x23), bfhi(x23)};
                    const f32x4 r = xv + *(const f32x4*)(g + 4 * n) * v; if (n) { w.z = pkbf(r.x, r.y); w.w = pkbf(r.z, r.w); } else { w.x = pkbf(r.x, r.y); w.y = pkbf(r.z, r.w); } }
                *(u32x4*)x = w; }
    }
};
struct EpiSwigluT {
    static constexpr bool PERM = true, AFTER_DRAIN = false;
    bf16_t* HID; int nNg; int ldh;
    __device__ __forceinline__ void operator()(const f32x4 (&acc)[2][2][4][2], const Unit& u, int wr, int wc, int fr, int fq) const {
        const int row0 = u.pm * BM + wr * 64 + fr, f0 = (u.pn % nNg) * 128 + wc * 32 + 8 * fq;
#pragma unroll
        for (int ai = 0; ai < 2; ++ai)
#pragma unroll
            for (int m = 0; m < 4; ++m) { bf16_t* hp = HID + (size_t)(row0 + ai * HALF + m * 16) * ldh + f0;
                const f32x4 a0 = acc[ai][0][m][0], a1 = acc[ai][0][m][1], b0 = acc[ai][1][m][0], b1 = acc[ai][1][m][1];
                f32x4 e0 = a0 * -1.4426950408889634f, e1 = a1 * -1.4426950408889634f;
#pragma unroll
                for (int q = 0; q < 4; ++q) { e0[q] = __builtin_amdgcn_exp2f(e0[q]); e1[q] = __builtin_amdgcn_exp2f(e1[q]); }
                e0 = e0 + 1.0f; e1 = e1 + 1.0f;
#pragma unroll
                for (int q = 0; q < 4; ++q) { e0[q] = __builtin_amdgcn_rcpf(e0[q]); e1[q] = __builtin_amdgcn_rcpf(e1[q]); }
                const f32x4 o0 = (a0 * b0) * e0, o1 = (a1 * b1) * e1;
                u32x4 w; w.x = cvt_pk_bf16(o0.x, o0.y); w.y = cvt_pk_bf16(o0.z, o0.w); w.z = cvt_pk_bf16(o1.x, o1.y); w.w = cvt_pk_bf16(o1.z, o1.w);
                *(u32x4*)hp = w; }
    }
};
struct EpiDownT {
    static constexpr bool PERM = true, AFTER_DRAIN = false;
    bf16_t* Y; const float* GATE; int nNg;
    __device__ __forceinline__ void operator()(const f32x4 (&acc)[2][2][4][2], const Unit& u, int wr, int wc, int fr, int fq) const {
        const int row0 = u.pm * BM + wr * 64 + fr, col0 = (u.pn % nNg) * BM + wc * 32 + 8 * fq;
#pragma unroll
        for (int ai = 0; ai < 2; ++ai)
#pragma unroll
            for (int m = 0; m < 4; ++m) { const int row = row0 + ai * HALF + m * 16; bf16_t* rowp = Y + (size_t)row * DD + col0;
#pragma unroll
                for (int bj = 0; bj < 2; ++bj) { const f32x4 v0 = acc[ai][bj][m][0], v1 = acc[ai][bj][m][1];
                    u32x4 w; w.x = cvt_pk_bf16(v0[0], v0[1]); w.y = cvt_pk_bf16(v0[2], v0[3]); w.z = cvt_pk_bf16(v1[0], v1[1]); w.w = cvt_pk_bf16(v1[2], v1[3]);
                    *(u32x4*)(rowp + bj * HALF) = w; } }
    }
};
template <bool SILU> struct EpiVtT {
    static constexpr bool PERM = true, AFTER_DRAIN = false;
    bf16_t* VT;
    __device__ __forceinline__ void operator()(const f32x4 (&acc)[2][2][4][2], const Unit& u, int wr, int wc, int fr, int fq) const {
        const int hd0 = u.pm * BM + wr * 64 + fr, tok0 = u.pn * BM + wc * 32 + 8 * fq, b = (u.pn * BM) / PP, pos0 = tok0 - b * PP;
#pragma unroll
        for (int ai = 0; ai < 2; ++ai)
#pragma unroll
            for (int m = 0; m < 4; ++m) { bf16_t* rowp = VT + ((size_t)b * DD + hd0 + ai * HALF + m * 16) * PP + pos0;
#pragma unroll
                for (int bj = 0; bj < 2; ++bj) { f32x4 v0 = acc[ai][bj][m][0], v1 = acc[ai][bj][m][1];
                    if (SILU) {
#pragma unroll
                        for (int q = 0; q < 4; ++q) { v0[q] = v0[q] * sigm(v0[q]); v1[q] = v1[q] * sigm(v1[q]); } }
                    u32x4 w; w.x = cvt_pk_bf16(v0[0], v0[1]); w.y = cvt_pk_bf16(v0[2], v0[3]); w.z = cvt_pk_bf16(v1[0], v1[1]); w.w = cvt_pk_bf16(v1[2], v1[3]);
                    *(u32x4*)(rowp + bj * HALF) = w; } }
    }
};
struct EpiHgIn {
    static constexpr bool PERM = true, AFTER_DRAIN = false;
    bf16_t* O; const float* LB;
    __device__ __forceinline__ void operator()(const f32x4 (&acc)[2][2][4][2], const Unit& u, int wr, int wc, int fr, int fq) const {
        const int row0 = u.pm * BM + wr * 64 + fr, col0 = u.pn * BM + wc * 32 + 8 * fq, type = u.pn >> 2;
#pragma unroll
        for (int ai = 0; ai < 2; ++ai)
#pragma unroll
            for (int m = 0; m < 4; ++m) { bf16_t* rowp = O + (size_t)(row0 + ai * HALF + m * 16) * 4096 + col0;
#pragma unroll
                for (int bj = 0; bj < 2; ++bj) { f32x4 v0 = acc[ai][bj][m][0], v1 = acc[ai][bj][m][1];
                    if (type == 1 || type == 2) { const int c = (col0 + bj * HALF) & 1023; const f32x4 l0 = *(const f32x4*)(LB + c), l1 = *(const f32x4*)(LB + c + 4);
#pragma unroll
                        for (int q = 0; q < 4; ++q) { v0[q] = __log2f(l0[q] + (1.0f - l0[q]) * sigm(v0[q])); v1[q] = __log2f(l1[q] + (1.0f - l1[q]) * sigm(v1[q])); } }
                    else if (type == 3) {
#pragma unroll
                        for (int q = 0; q < 4; ++q) { v0[q] = v0[q] * sigm(v0[q]); v1[q] = v1[q] * sigm(v1[q]); } }
                    u32x4 w; w.x = cvt_pk_bf16(v0[0], v0[1]); w.y = cvt_pk_bf16(v0[2], v0[3]); w.z = cvt_pk_bf16(v1[0], v1[1]); w.w = cvt_pk_bf16(v1[2], v1[3]);
                    *(u32x4*)(rowp + bj * HALF) = w; } }
    }
};


struct EpiF32G {
    static constexpr bool PERM = false, AFTER_DRAIN = false;
    float* C; int ldc; int nNg;
    __device__ __forceinline__ void operator()(const f32x4 (&acc)[2][2][4][2], const Unit& u, int wr, int wc, int fr, int fq) const {
        const int row0 = u.pm * BM + wr * 64 + fr, col0 = (u.pn % nNg) * BM + wc * 32 + 4 * fq;
#pragma unroll
        for (int ai = 0; ai < 2; ++ai)
#pragma unroll
            for (int m = 0; m < 4; ++m) { float* rowp = C + (size_t)(row0 + ai * HALF + m * 16) * ldc + col0;
#pragma unroll
                for (int bj = 0; bj < 2; ++bj)
#pragma unroll
                    for (int n = 0; n < 2; ++n) *(f32x4*)(rowp + bj * HALF + n * 16) = acc[ai][bj][m][n]; }
    }
};
__device__ __forceinline__ float gelu_t(float x) { const float t = 1.5957691216057308f * (x + 0.044715f * x * x * x); return x * sigm(t); }
struct EpiS5Out {
    static constexpr bool PERM = true, AFTER_DRAIN = false;
    const bf16_t* H; bf16_t* Z; const float* dvec;
    __device__ __forceinline__ void operator()(const f32x4 (&acc)[2][2][4][2], const Unit& u, int wr, int wc, int fr, int fq) const {
        const int c0 = (u.pn & 1) * BM + wc * 32 + 8 * fq;
#pragma unroll
        for (int ai = 0; ai < 2; ++ai)
#pragma unroll
            for (int m = 0; m < 4; ++m) {
                const int rg = u.pm * BM + ai * HALF + wr * 64 + m * 16 + fr, g = rg / 2304, rem = rg - g * 2304, b = rem / 72, j = rem - b * 72;
#pragma unroll
                for (int bj = 0; bj < 2; ++bj) {
                    const int mc = c0 + bj * HALF, tau = mc >> 4, k0 = mc & 15;
                    const size_t off = ((size_t)b * PP + 32 * j + tau) * DD + g * 16 + k0;
                    const u32x4 uw = *(const u32x4*)(H + off);
                    const f32x4 d0 = *(const f32x4*)(dvec + g * 16 + k0), d1 = *(const f32x4*)(dvec + g * 16 + k0 + 4);
                    const f32x4 y0 = acc[ai][bj][m][0], y1 = acc[ai][bj][m][1];
                    u32x4 w;
                    w.x = cvt_pk_bf16(gelu_t(y0[0] + d0[0] * __uint_as_float(uw.x << 16)), gelu_t(y0[1] + d0[1] * __uint_as_float(uw.x & 0xffff0000u)));
                    w.y = cvt_pk_bf16(gelu_t(y0[2] + d0[2] * __uint_as_float(uw.y << 16)), gelu_t(y0[3] + d0[3] * __uint_as_float(uw.y & 0xffff0000u)));
                    w.z = cvt_pk_bf16(gelu_t(y1[0] + d1[0] * __uint_as_float(uw.z << 16)), gelu_t(y1[1] + d1[1] * __uint_as_float(uw.z & 0xffff0000u)));
                    w.w = cvt_pk_bf16(gelu_t(y1[2] + d1[2] * __uint_as_float(uw.w << 16)), gelu_t(y1[3] + d1[3] * __uint_as_float(uw.w & 0xffff0000u)));
                    *(u32x4*)(Z + off) = w;
                }
            }
    }
};


struct EpiQKRope {
    static constexpr bool PERM = true, AFTER_DRAIN = false;
    bf16_t* Q; size_t kstride; const float* T;
    __device__ __forceinline__ void operator()(const f32x4 (&acc)[2][2][4][2], const Unit& u, int wr, int wc, int fr, int fq) const {
        const int row0 = u.pm * BM + wr * 64 + fr; int colt = u.pn * BM; bf16_t* base = Q;
        { const int t = colt / DD; base += (size_t)t * kstride; colt -= t * DD; }
        const int col0 = colt + wc * 32 + 8 * fq, half = wc & 1; const bool first = fq < 2;
        const float qs = u.pn * BM < DD ? 0.125f * 1.4426950408889634f : 1.0f;
#pragma unroll
        for (int ai = 0; ai < 2; ++ai)
#pragma unroll
            for (int m = 0; m < 4; ++m) { const int row = row0 + ai * HALF + m * 16, b = row / PP, pos = row - b * PP, tt = pos - 256; const bool lat = pos >= 256;
                const int p = lat ? (half ? (tt & 63) : (tt >> 6)) : 0;
                const f32x4* cs = (const f32x4*)(T + (p * 16 + 8 * (fq & 1)) * 2);
                const f32x4 t0 = cs[0], t1 = cs[1], t2 = cs[2], t3 = cs[3];
                bf16_t* rowp = base + (size_t)row * DD + col0;
#pragma unroll
                for (int bj = 0; bj < 2; ++bj) { f32x4 v0 = acc[ai][bj][m][0] * qs, v1 = acc[ai][bj][m][1] * qs;
                    f32x4 p0, p1;
#pragma unroll
                    for (int q = 0; q < 4; ++q) { p0[q] = __shfl_xor(v0[q], 32); p1[q] = __shfl_xor(v1[q], 32); }
                    if (lat) { const float sg = first ? -1.0f : 1.0f;
                        v0 = (f32x4){v0[0] * t0[0] + sg * p0[0] * t0[1], v0[1] * t0[2] + sg * p0[1] * t0[3], v0[2] * t1[0] + sg * p0[2] * t1[1], v0[3] * t1[2] + sg * p0[3] * t1[3]};
                        v1 = (f32x4){v1[0] * t2[0] + sg * p1[0] * t2[1], v1[1] * t2[2] + sg * p1[1] * t2[3], v1[2] * t3[0] + sg * p1[2] * t3[1], v1[3] * t3[2] + sg * p1[3] * t3[3]}; }
                    u32x4 w; w.x = cvt_pk_bf16(v0[0], v0[1]); w.y = cvt_pk_bf16(v0[2], v0[3]); w.z = cvt_pk_bf16(v1[0], v1[1]); w.w = cvt_pk_bf16(v1[2], v1[3]);
                    *(u32x4*)(rowp + bj * HALF) = w; } }
    }
};

template <class Epi, class Sched, bool ALIGN_EPI = false, bool SP2 = false, bool GATHER = false>
__device__ __forceinline__ void gemm_phase(PG8_LAS unsigned char* lds, const Gemm g, const Sched& S, const Epi& E, const int tid) {
    const int wid = __builtin_amdgcn_readfirstlane(tid >> 6), lane = tid & 63, wr = wid >> 2, wc = wid & 3, fr = lane & 15, fq = lane >> 4;
    const int K = g.K, nt = K / BK;
    unsigned voffA[2], voffB[2];
#pragma unroll
    for (int i = 0; i < 2; ++i) { int R, C; stage_rc(tid * 16 + i * 8192, R, C); const int Rb = Epi::PERM ? ((R & ~31) + perm32(R & 31)) : R;
        voffA[i] = (unsigned)(R * g.lda + C) * 2u; voffB[i] = (unsigned)(Rb * g.ldb + C) * 2u; }
    unsigned vA0[2] = {0u, 0u}, vA1[2] = {0u, 0u}, wA0[2] = {0u, 0u}, wA1[2] = {0u, 0u};
#define PG8_GOFF(u_, o0, o1) do { _Pragma("unroll") for (int i = 0; i < 2; ++i) { int R, C; stage_rc(tid * 16 + i * 8192, R, C); const int r0_ = (u_).pm * BM + R; \
        o0[i] = ((unsigned)g.rowidx[r0_] * (unsigned)g.lda + (unsigned)C) * 2u; o1[i] = ((unsigned)g.rowidx[r0_ + HALF] * (unsigned)g.lda + (unsigned)C) * 2u; } } while (0)
    const size_t kstep = (size_t)(BK * 2);
    const size_t hstepA = (size_t)HALF * g.lda * 2, hstepB = (size_t)HALF * g.ldb * 2;
    const size_t tstepA = 2 * hstepA, tstepB = 2 * hstepB;
    const unsigned ldsw = (unsigned)wid * 1024u;
    const int aoff = lds_byte(wr * 64 + fr, fq * 8), boff = lds_byte(wc * 32 + fr, fq * 8);
#define PG8_SA(b, h) (((b) * 2 + (h)) * HTB)
#define PG8_SB(b, h) ((4 + (b) * 2 + (h)) * HTB)
#define PG8_STAGE(bufoff, gbase, voff) do { _Pragma("unroll") for (int _i = 0; _i < 2; ++_i) \
        __builtin_amdgcn_global_load_lds((const unsigned*)((const char*)(gbase) + (voff)[_i]), (PG8_LAS unsigned*)(lds + (bufoff) + ldsw + _i * 8192), 16, 0, 0); } while (0)
#define PG8_STAGEA(bufoff, kptr, h, oc0, oc1) do { if constexpr (GATHER) { if (h) PG8_STAGE(bufoff, kptr, oc1); else PG8_STAGE(bufoff, kptr, oc0); } else { PG8_STAGE(bufoff, (kptr) + ((h) ? hstepA : 0), voffA); } } while (0)
#define PG8_LDA(dst, b, h) do { _Pragma("unroll") for (int m = 0; m < 4; ++m) _Pragma("unroll") for (int k = 0; k < 2; ++k) dst[m][k] = *(const PG8_LAS bf16x8*)(lds + PG8_SA(b, h) + aoff + m * 2048 + k * 1024); } while (0)
#define PG8_LDB(dst, b, h) do { _Pragma("unroll") for (int n = 0; n < 2; ++n) _Pragma("unroll") for (int k = 0; k < 2; ++k) dst[n][k] = *(const PG8_LAS bf16x8*)(lds + PG8_SB(b, h) + boff + n * 2048 + k * 1024); } while (0)
#define PG8_MMA(ai, bj, At, Bt) do { __builtin_amdgcn_s_setprio(1); _Pragma("unroll") for (int m = 0; m < 4; ++m) _Pragma("unroll") for (int n = 0; n < 2; ++n) _Pragma("unroll") for (int k = 0; k < 2; ++k) \
        acc[ai][bj][m][n] = __builtin_amdgcn_mfma_f32_16x16x32_bf16(Bt[n][k], At[m][k], acc[ai][bj][m][n], 0, 0, 0); __builtin_amdgcn_s_setprio(0); } while (0)
#define PG8_WAIT_V(n) asm volatile("s_waitcnt vmcnt(" #n ")" ::: "memory")
#define PG8_WAIT_L(n) asm volatile("s_waitcnt lgkmcnt(" #n ")" ::: "memory")
#define PG8_BAR __builtin_amdgcn_s_barrier()
#define PG8_SCHED __builtin_amdgcn_sched_barrier(0)
    Unit cur, nxt; int ui = 0;
    if (!S.next(0, cur)) return;
    f32x4 acc[2][2][4][2];
#pragma unroll
    for (int a = 0; a < 2; ++a)
#pragma unroll
        for (int b = 0; b < 2; ++b)
#pragma unroll
            for (int m = 0; m < 4; ++m)
#pragma unroll
                for (int n = 0; n < 2; ++n) acc[a][b][m][n] = (f32x4){0.f, 0.f, 0.f, 0.f};
    bf16x8 At[4][2], B0[2][2], B1[2][2];
    const char* cA = (const char*)g.A + (GATHER ? (size_t)0 : (size_t)cur.pm * tstepA); if constexpr (GATHER) PG8_GOFF(cur, vA0, vA1);
    const char* cB = (const char*)g.Bt + (size_t)cur.pn * tstepB;
    S.a_ready(cur);
    if constexpr (SP2) {
        PG8_STAGE(PG8_SB(0, 0), cB, voffB); PG8_STAGE(PG8_SB(0, 1), cB + hstepB, voffB); PG8_STAGEA(PG8_SA(0, 0), cA, 0, vA0, vA1); PG8_STAGEA(PG8_SA(0, 1), cA, 1, vA0, vA1);
        if (wr == 1) PG8_BAR;
        PG8_WAIT_V(2); PG8_BAR;
        PG8_STAGE(PG8_SB(1, 0), cB + kstep, voffB); PG8_STAGEA(PG8_SA(1, 0), cA + kstep, 0, vA0, vA1); PG8_STAGE(PG8_SB(1, 1), cB + hstepB + kstep, voffB);
        PG8_WAIT_V(6); PG8_BAR;
    } else {
        PG8_STAGE(PG8_SB(0, 0), cB, voffB); PG8_STAGE(PG8_SA(0, 0), cA, voffA); PG8_STAGE(PG8_SB(0, 1), cB + hstepB, voffB); PG8_STAGE(PG8_SA(0, 1), cA + hstepA, voffA);
        if (wr == 1) PG8_BAR;
        PG8_WAIT_V(4); PG8_BAR;
        PG8_STAGE(PG8_SB(1, 0), cB + kstep, voffB); PG8_STAGE(PG8_SA(1, 0), cA + kstep, voffA); PG8_STAGE(PG8_SB(1, 1), cB + hstepB + kstep, voffB);
        PG8_WAIT_V(6); PG8_BAR;
    }
    for (;;) {
        const bool has_next = S.next(ui + 1, nxt);
        const char* nA = (has_next && !GATHER) ? (const char*)g.A + (size_t)nxt.pm * tstepA : cA;
        if constexpr (GATHER) { if (has_next) { if (wid < 4) __builtin_amdgcn_global_load_lds((const unsigned*)(g.rowidx + (size_t)nxt.pm * BM + (tid & 255)), (PG8_LAS unsigned*)(lds + STAGE_BYTES + wid * 256), 4, 0, 0); }
                                else { wA0[0] = vA0[0]; wA0[1] = vA0[1]; wA1[0] = vA1[0]; wA1[1] = vA1[1]; } }
        const char* nB = has_next ? (const char*)g.Bt + (size_t)nxt.pn * tstepB : cB;
        for (int t = 0; t < nt; t += 2) {
            const bool last = (t == nt - 2);
            const char* a1 = cA + (size_t)(t + 1) * kstep;
            const char* a2 = last ? nA : cA + (size_t)(t + 2) * kstep; const char* b2 = last ? nB : cB + (size_t)(t + 2) * kstep;
            const char* a3 = a2 + kstep; const char* b3 = b2 + kstep;
            if (last && has_next) S.a_ready(nxt);
            if constexpr (GATHER) { if (last && has_next) {
#pragma unroll
                for (int i = 0; i < 2; ++i) { int R, C; stage_rc(tid * 16 + i * 8192, R, C);
                    const unsigned i0_ = *(const PG8_LAS unsigned*)(lds + STAGE_BYTES + R * 4), i1_ = *(const PG8_LAS unsigned*)(lds + STAGE_BYTES + (R + HALF) * 4);
                    wA0[i] = (i0_ * (unsigned)g.lda + (unsigned)C) * 2u; wA1[i] = (i1_ * (unsigned)g.lda + (unsigned)C) * 2u; } } }
            const unsigned sA0[2] = {last ? wA0[0] : vA0[0], last ? wA0[1] : vA0[1]}, sA1[2] = {last ? wA1[0] : vA1[0], last ? wA1[1] : vA1[1]};
            if constexpr (SP2) {
            PG8_LDB(B0, 0, 0); PG8_LDB(B1, 0, 1); PG8_SCHED; PG8_LDA(At, 0, 0); PG8_STAGEA(PG8_SA(1, 1), a1, 1, vA0, vA1);
            PG8_WAIT_V(8); PG8_WAIT_L(0); PG8_BAR; PG8_MMA(0, 0, At, B0); PG8_MMA(0, 1, At, B1); PG8_BAR; PG8_SCHED;
            PG8_LDA(At, 0, 1); PG8_STAGE(PG8_SB(0, 0), b2, voffB); PG8_STAGE(PG8_SB(0, 1), b2 + hstepB, voffB); PG8_STAGEA(PG8_SA(0, 0), a2, 0, sA0, sA1);
            PG8_WAIT_V(8); PG8_WAIT_L(0); PG8_BAR; PG8_MMA(1, 0, At, B0); PG8_MMA(1, 1, At, B1); PG8_BAR; PG8_SCHED;
            PG8_LDB(B0, 1, 0); PG8_LDB(B1, 1, 1); PG8_SCHED; PG8_LDA(At, 1, 0); PG8_STAGEA(PG8_SA(0, 1), a2, 1, sA0, sA1);
            PG8_WAIT_V(8); PG8_WAIT_L(0); PG8_BAR; PG8_MMA(0, 0, At, B0); PG8_MMA(0, 1, At, B1); PG8_BAR; PG8_SCHED;
            PG8_LDA(At, 1, 1); PG8_STAGE(PG8_SB(1, 0), b3, voffB); PG8_STAGE(PG8_SB(1, 1), b3 + hstepB, voffB); PG8_STAGEA(PG8_SA(1, 0), a3, 0, sA0, sA1);
            PG8_WAIT_V(8); PG8_WAIT_L(0); PG8_BAR; PG8_MMA(1, 0, At, B0); PG8_MMA(1, 1, At, B1); PG8_BAR; PG8_SCHED;
            } else {
            PG8_LDB(B0, 0, 0); PG8_SCHED; PG8_LDA(At, 0, 0); PG8_STAGE(PG8_SA(1, 1), a1 + hstepA, voffA);
            PG8_WAIT_L(8); PG8_BAR; PG8_WAIT_L(0); PG8_MMA(0, 0, At, B0); PG8_BAR; PG8_SCHED;
            PG8_LDB(B1, 0, 1); PG8_STAGE(PG8_SB(0, 0), b2, voffB);
            PG8_BAR; PG8_WAIT_L(0); PG8_MMA(0, 1, At, B1); PG8_BAR;
            PG8_LDA(At, 0, 1); PG8_STAGE(PG8_SA(0, 0), a2, voffA);
            PG8_BAR; PG8_WAIT_L(0); PG8_MMA(1, 0, At, B0); PG8_BAR; PG8_SCHED;
            PG8_STAGE(PG8_SB(0, 1), b2 + hstepB, voffB);
            PG8_WAIT_V(6); PG8_BAR; PG8_MMA(1, 1, At, B1); PG8_BAR;
            PG8_LDB(B0, 1, 0); PG8_SCHED; PG8_LDA(At, 1, 0); PG8_STAGE(PG8_SA(0, 1), a2 + hstepA, voffA);
            PG8_WAIT_L(8); PG8_BAR; PG8_WAIT_L(0); PG8_MMA(0, 0, At, B0); PG8_BAR; PG8_SCHED;
            PG8_LDB(B1, 1, 1); PG8_STAGE(PG8_SB(1, 0), b3, voffB);
            PG8_BAR; PG8_WAIT_L(0); PG8_MMA(0, 1, At, B1); PG8_BAR;
            PG8_LDA(At, 1, 1); PG8_STAGE(PG8_SA(1, 0), a3, voffA);
            PG8_BAR; PG8_WAIT_L(0); PG8_MMA(1, 0, At, B0); PG8_BAR; PG8_SCHED;
            PG8_STAGE(PG8_SB(1, 1), b3 + hstepB, voffB);
            PG8_WAIT_V(6); PG8_BAR; PG8_MMA(1, 1, At, B1); PG8_BAR;
            }
        }
        if constexpr (ALIGN_EPI) { if (wr == 0) PG8_BAR; }
        if constexpr (!Epi::AFTER_DRAIN) { E(acc, cur, wr, wc, fr, fq); S.done(cur); }
        if (!has_next) break;
#pragma unroll
        for (int a = 0; a < 2; ++a)
#pragma unroll
            for (int b = 0; b < 2; ++b)
#pragma unroll
                for (int m = 0; m < 4; ++m)
#pragma unroll
                    for (int n = 0; n < 2; ++n) acc[a][b][m][n] = (f32x4){0.f, 0.f, 0.f, 0.f};
        cur = nxt; cA = nA; cB = nB; ++ui; vA0[0] = wA0[0]; vA0[1] = wA0[1]; vA1[0] = wA1[0]; vA1[1] = wA1[1];
        if constexpr (ALIGN_EPI) { if (wr == 1) PG8_BAR; }
    }
    PG8_WAIT_V(0);
    if constexpr (!ALIGN_EPI) { if (wr == 0) PG8_BAR; }
    PG8_BAR;
    if constexpr (Epi::AFTER_DRAIN) { E.fused(acc, cur, wr, wc, fr, fq, lds, wid, lane); S.done(cur); }
#undef PG8_SA
#undef PG8_SB
#undef PG8_STAGE
#undef PG8_STAGEA
#undef PG8_GOFF
#undef PG8_LDA
#undef PG8_LDB
#undef PG8_MMA
#undef PG8_WAIT_V
#undef PG8_WAIT_L
#undef PG8_BAR
#undef PG8_SCHED
}
}
#define PG8_SP2 true
#define PG8_ALIGN true

struct Frame;
struct Args { const float* in[33]; float* out; unsigned char* ws; int ph_lo, ph_hi; };
struct Frame {
    unsigned char* lds;
    int tid, lane, wave, bid, nb;
    const float* const* in;
    float* out; unsigned char* ws;
    float* MOD; float* AFF; int* SEL; float* GATE; int* INV; bf16* X; bf16* H;
};
__device__ __forceinline__ void REFRESH_(Frame& F) { int l_; asm volatile("v_mbcnt_lo_u32_b32 %0, -1, 0\n\tv_mbcnt_hi_u32_b32 %0, -1, %0" : "=v"(l_)); F.lane = l_; F.tid = F.wave * 64 + l_; }
__device__ __forceinline__ int mod_row(int row) { const int b = row / P, pos = row - b * P; return pos < NCTX ? 32 : b; }

__device__ __forceinline__ void ph_s5_pre(const Frame& F) {
    const float *a_re = F.in[8], *a_im = F.in[9], *log_dt = F.in[10], *b_re = F.in[11], *b_im = F.in[12], *c_re = F.in[13], *c_im = F.in[14];
    f32x2* Bb = (f32x2*)F.lds;
    f32x2* Cc = Bb + 2048;
    f32x2* Ap = Cc + 2048;
    float* Kt = (float*)(Ap + 2 * 33 * 64);
    bf16* W1 = (bf16*)(F.ws + WS_S5W1); bf16* W2 = (bf16*)(F.ws + WS_S5W2); f32x2* A32 = (f32x2*)(F.ws + WS_S5A);
    const int tid = F.tid;
    for (int g = F.nb - 1 - F.bid; g < 64; g += F.nb) {
        __syncthreads();
        if (tid < 128) {
            const int dir = tid >> 6, p = tid & 63, dg = dir * 64 + g;
            const double are = (double)a_re[dg * 64 + p], aim = (double)a_im[dg * 64 + p], dt = exp((double)log_dt[dg]);
            const double lr = are * dt, li = aim * dt, cl = cos(li), sl = sin(li), mag = exp(lr);
            const double Abi = mag * sl, sh = sin(0.5 * li), nr = expm1(lr) * cl - 2.0 * sh * sh, den = are * are + aim * aim;
            const double fr = (nr * are + Abi * aim) / den, fi = (Abi * are - nr * aim) / den;
            for (int h = 0; h < 16; ++h) { const double br = (double)b_re[((size_t)dg * 64 + p) * 16 + h], bi = (double)b_im[((size_t)dg * 64 + p) * 16 + h];
                Bb[(dir * 64 + p) * 16 + h] = (f32x2){(float)(fr * br - fi * bi), (float)(fr * bi + fi * br)}; }
            const double Abr = mag * cl; double pr = 1.0, pi = 0.0;
            for (int e = 0; e <= 32; ++e) { const f32x2 v = {(float)pr, (float)pi};
                Ap[(dir * 33 + e) * 64 + p] = v; if (e == 32) A32[(g * 2 + dir) * 64 + p] = v;
                const double nr2 = pr * Abr - pi * Abi, ni2 = pr * Abi + pi * Abr; pr = nr2; pi = ni2; }
        }
        for (int i = tid; i < 2048; i += NTHREADS) { const int dir = i >> 10, k = (i >> 6) & 15, p = i & 63; const size_t o = ((size_t)(dir * 64 + g) * 16 + k) * 64 + p; Cc[i] = (f32x2){c_re[o], c_im[o]}; }
        __syncthreads();
        {
            const int dir = tid >> 8, k = (tid >> 4) & 15, h = tid & 15; float acc[32];
#pragma unroll
            for (int lag = 0; lag < 32; ++lag) acc[lag] = 0.f;
#pragma unroll 2
            for (int p = 0; p < 64; ++p) { const f32x2 c = Cc[(dir * 16 + k) * 64 + p], bb = Bb[(dir * 64 + p) * 16 + h], a1 = Ap[(dir * 33 + 1) * 64 + p];
                float zr = c.x * bb.x - c.y * bb.y, zi = c.x * bb.y + c.y * bb.x;
#pragma unroll
                for (int lag = 0; lag < 32; ++lag) { acc[lag] += zr; const float nz = zr * a1.x - zi * a1.y; zi = zr * a1.y + zi * a1.x; zr = nz; } }
#pragma unroll
            for (int lag = 0; lag < 32; ++lag) Kt[((dir * 32 + lag) * 16 + k) * 16 + h] = acc[lag];
        }
        for (int i = tid; i < 16384; i += NTHREADS) {
            const int n = i >> 6, sg = (i >> 1) & 31, h0 = (i & 1) * 8, dir = n >> 7, c = (n >> 6) & 1, p = n & 63, e = dir ? sg : 31 - sg;
            const f32x2 a = Ap[(dir * 33 + e) * 64 + p]; float v[8];
#pragma unroll
            for (int q = 0; q < 8; ++q) { const f32x2 bb = Bb[(dir * 64 + p) * 16 + h0 + q]; v[q] = c ? a.x * bb.y + a.y * bb.x : a.x * bb.x - a.y * bb.y; }
            u32x4 w; w.x = pk2(v[0], v[1]); w.y = pk2(v[2], v[3]); w.z = pk2(v[4], v[5]); w.w = pk2(v[6], v[7]);
            *(u32x4*)(W1 + ((size_t)g * 256 + n) * 512 + sg * 16 + h0) = w;
        }
        for (int i = tid; i < 16384; i += NTHREADS) {
            const int m = i >> 5, n0 = (i & 31) * 8, dir = n0 >> 7, c = (n0 >> 6) & 1, p0 = n0 & 63, tau = m >> 4, k = m & 15, e = dir ? 32 - tau : tau + 1; float v[8];
#pragma unroll
            for (int q = 0; q < 8; ++q) { const f32x2 cc = Cc[(dir * 16 + k) * 64 + p0 + q], a = Ap[(dir * 33 + e) * 64 + p0 + q]; v[q] = c ? -(cc.x * a.y + cc.y * a.x) : cc.x * a.x - cc.y * a.y; }
            u32x4 w; w.x = pk2(v[0], v[1]); w.y = pk2(v[2], v[3]); w.z = pk2(v[4], v[5]); w.w = pk2(v[6], v[7]);
            *(u32x4*)(W2 + ((size_t)g * 512 + m) * 768 + 512 + n0) = w;
        }
        __syncthreads();
        for (int i = tid; i < 32768; i += NTHREADS) {
            const int m = i >> 6, sg = (i >> 1) & 31, h0 = (i & 1) * 8, tau = m >> 4, k = m & 15; float v[8];
#pragma unroll
            for (int q = 0; q < 8; ++q) { float x = 0.f; if (sg <= tau) x += Kt[((tau - sg) * 16 + k) * 16 + h0 + q]; if (sg >= tau) x += Kt[((32 + sg - tau) * 16 + k) * 16 + h0 + q]; v[q] = x; }
            u32x4 w; w.x = pk2(v[0], v[1]); w.y = pk2(v[2], v[3]); w.z = pk2(v[4], v[5]); w.w = pk2(v[6], v[7]);
            *(u32x4*)(W2 + ((size_t)g * 512 + m) * 768 + sg * 16 + h0) = w;
        }
    }
    __syncthreads();
}
__device__ __forceinline__ void ph_s5_scan(const Frame& F) {
    const float* SS = (const float*)(F.ws + WS_SS); bf16* AG = (bf16*)(F.ws + WS_AG); const f32x2* A32 = (const f32x2*)(F.ws + WS_S5A);
    for (int gid = F.bid * NTHREADS + F.tid; gid < 64 * 32 * 128; gid += F.nb * NTHREADS) {
        const int p = gid & 63, dir = (gid >> 6) & 1, b = (gid >> 7) & 31, g = gid >> 12;
        const f32x2 a = A32[(g * 2 + dir) * 64 + p];
        float hr = 0.f, hi = 0.f;
        const size_t row0 = (size_t)g * 2304 + b * 72;
#pragma unroll 4
        for (int idx = 0; idx < 72; ++idx) {
            const int j = dir == 0 ? idx : (idx < 8 ? 7 - idx : 79 - idx);
            const size_t row = row0 + j;
            AG[row * 768 + 512 + dir * 128 + p] = (bf16)f2bf(hr); AG[row * 768 + 512 + dir * 128 + 64 + p] = (bf16)f2bf(hi);
            const float sr = SS[row * 256 + dir * 128 + p], si = SS[row * 256 + dir * 128 + 64 + p];
            const float nr = a.x * hr - a.y * hi + sr, ni = a.x * hi + a.y * hr + si; hr = nr; hi = ni;
        }
    }
}

template <int DUAL>
__device__ __forceinline__ void transpose_item(const float* W, int ldw, int K, int N, bf16* WT, int row_off, LAS float* scr, int item, int lane) {
    const int nblk = N / 64, kb = item / nblk, nb = item - kb * nblk, k0 = 64 * kb, n0 = 64 * nb;
    const int lr = lane >> 4, lc = (lane & 15) * 4;
    f32x4 v[16];
#pragma unroll
    for (int i = 0; i < 16; ++i) v[i] = *(const f32x4*)(W + (size_t)(k0 + lr + 4 * i) * ldw + n0 + lc);
#pragma unroll
    for (int i = 0; i < 16; ++i) { LAS float* d = scr + (lr + 4 * i) * 65 + lc; d[0] = v[i].x; d[1] = v[i].y; d[2] = v[i].z; d[3] = v[i].w; }
    asm volatile("s_waitcnt lgkmcnt(0)" ::: "memory");
    const int c = lane & 7;
#pragma unroll
    for (int j = 0; j < 8; ++j) { const int n = (lane >> 3) + 8 * j; const LAS float* sp = scr + (8 * c) * 65 + n;
        u32x4 o; o.x = pkbf(sp[0 * 65], sp[1 * 65]); o.y = pkbf(sp[2 * 65], sp[3 * 65]); o.z = pkbf(sp[4 * 65], sp[5 * 65]); o.w = pkbf(sp[6 * 65], sp[7 * 65]);
        const int nn = n0 + n, dest = DUAL == -2 ? (nn < 3072 ? nn : (nn < 4096 ? nn + 1024 : nn - 1024)) : (DUAL < 0 ? row_off + nn : row_off + (nn >> 7) * 256 + DUAL * 128 + (nn & 127));
        *(u32x4*)(WT + (size_t)dest * K + k0 + 8 * c) = o; }
    asm volatile("s_waitcnt lgkmcnt(0)" ::: "memory");
}
__device__ __forceinline__ void convert_moe(const Frame& F, int l, int cb = -1, int cnb = 0) {
    if (cb < 0) { cb = F.bid; cnb = F.nb; }
    if (cb >= cnb) return;
    LAS float* scr = (LAS float*)((LAS unsigned char*)F.lds) + F.wave * 4160;
    bf16* WGU = (bf16*)(F.ws + WO_GU); bf16* WDN = (bf16*)(F.ws + WO_DN);
    for (int it = cb * NWAVES + F.wave; it < 24576; it += cnb * NWAVES) {
        const int m = it >> 13, r = it & 8191, e = r >> 9, item = r & 511;
        if (m == 0) transpose_item<0>(F.in[29] + (size_t)(l * NE + e) * D * FF, FF, D, FF, WGU, e * 2 * FF, scr, item, F.lane);
        else if (m == 1) transpose_item<1>(F.in[30] + (size_t)(l * NE + e) * D * FF, FF, D, FF, WGU, e * 2 * FF, scr, item, F.lane);
        else transpose_item<-1>(F.in[31] + (size_t)(l * NE + e) * FF * D, D, FF, D, WDN, e * D, scr, item, F.lane);
    }
}
__device__ __forceinline__ void convert_mixers(const Frame& F, int cb, int cnb) {
    if (cb >= cnb) return;
    LAS float* scr = (LAS float*)((LAS unsigned char*)F.lds) + F.wave * 4160;
    for (int it = cb * NWAVES + F.wave; it < 4096; it += cnb * NWAVES) {
        int r = it;
        if (r < 256) { transpose_item<0>(F.in[16], 2 * D, D, D, (bf16*)(F.ws + WO_GLU), 0, scr, r, F.lane); continue; } r -= 256;
        if (r < 256) { transpose_item<1>(F.in[16] + D, 2 * D, D, D, (bf16*)(F.ws + WO_GLU), 0, scr, r, F.lane); continue; } r -= 256;
        if (r < 768) { transpose_item<-1>(F.in[17], 3 * D, D, 3 * D, (bf16*)(F.ws + WO_NAQKV), 0, scr, r, F.lane); continue; } r -= 768;
        if (r < 256) { transpose_item<-1>(F.in[18], D, D, D, (bf16*)(F.ws + WO_NAO), 0, scr, r, F.lane); continue; } r -= 256;
        if (r < 768) { transpose_item<-1>(F.in[20], 3 * D, D, 3 * D, (bf16*)(F.ws + WO_DAQKV), 0, scr, r, F.lane); continue; } r -= 768;
        if (r < 256) { transpose_item<-1>(F.in[21], D, D, D, (bf16*)(F.ws + WO_DAO), 0, scr, r, F.lane); continue; } r -= 256;
        if (r < 1280) { transpose_item<-2>(F.in[24], 5 * D, D, 5 * D, (bf16*)(F.ws + WO_HGIN), 0, scr, r, F.lane); continue; } r -= 1280;
        transpose_item<-1>(F.in[25], D, D, D, (bf16*)(F.ws + WO_HGO), 0, scr, r, F.lane);
    }
}

__device__ __forceinline__ void ph_prologue(const Frame& F) {
    {
        float* S = (float*)F.lds;
        for (int i = F.tid; i < 33 * 1024; i += NTHREADS) { const float v = i < 32 * 1024 ? F.in[1][i] : F.in[3][i - 32 * 1024]; S[i] = siluf_(v); }
        __syncthreads();
        float acc[2][33];
#pragma unroll
        for (int t = 0; t < 2; ++t)
#pragma unroll
            for (int r = 0; r < 33; ++r) acc[t][r] = 0.f;
#pragma unroll
        for (int t = 0; t < 2; ++t) {
            const int task = F.bid + t * F.nb;
            if (task < 384) {
                const int l = task / 96, col = (task % 96) * 64 + F.lane, kb = F.wave * 128;
                const float* W = F.in[4] + (size_t)l * 1024 * 6144 + col;
#pragma unroll 1
                for (int k = kb; k < kb + 128; k += 8) {
                    float w[8];
#pragma unroll
                    for (int q = 0; q < 8; ++q) w[q] = W[(size_t)(k + q) * 6144];
#pragma unroll
                    for (int r = 0; r < 33; ++r) { const f32x4 s0 = *(const f32x4*)&S[r * 1024 + k], s1 = *(const f32x4*)&S[r * 1024 + k + 4];
                        acc[t][r] += (s0.x * w[0] + s0.y * w[1]) + (s0.z * w[2] + s0.w * w[3]) + (s1.x * w[4] + s1.y * w[5]) + (s1.z * w[6] + s1.w * w[7]); }
                }
            }
        }
        __syncthreads();
#pragma unroll
        for (int t = 0; t < 2; ++t)
#pragma unroll
            for (int r = 0; r < 33; ++r) S[((t * 8 + F.wave) * 33 + r) * 64 + F.lane] = acc[t][r];
        __syncthreads();
        for (int i = F.tid; i < 2 * 33 * 64; i += NTHREADS) {
            const int t = i / (33 * 64), r = (i / 64) % 33, ln = i & 63, task = F.bid + t * F.nb;
            if (task < 384) { const int l = task / 96, col = (task % 96) * 64 + ln; float v = F.in[5][l * 6144 + col];
#pragma unroll
                for (int w = 0; w < 8; ++w) v += S[((t * 8 + w) * 33 + r) * 64 + ln];
                F.MOD[((size_t)l * 33 + r) * 6144 + col] = v; }
        }
        __syncthreads();
    }
    if (F.bid == 48) {
        const float* lbin = F.in[27];
        for (int c = F.tid; c < D; c += NTHREADS) { const float x0 = lbin[c], x1 = lbin[D + c], x2 = lbin[2 * D + c], x3 = lbin[3 * D + c], mx = fmaxf(fmaxf(x0, x1), fmaxf(x2, x3));
            const float e0 = expf(x0 - mx), e1 = expf(x1 - mx), e2 = expf(x2 - mx), e3 = expf(x3 - mx); ((float*)(F.ws + WS_LB))[c] = (e1 + e2 + e3) / (e0 + e1 + e2 + e3); }
    }
    if (F.bid == 49) {
        for (int i = F.tid; i < 64 * 16; i += NTHREADS) { const float inv = powf(10000.0f, -(float)(i & 15) * (1.0f / 16.0f)); float sn, cs; sincosf((float)(i >> 4) * inv, &sn, &cs);
            ((float*)(F.ws + WS_ROPE))[2 * i] = cs; ((float*)(F.ws + WS_ROPE))[2 * i + 1] = sn; }
    }
    { const int ncv = F.nb > 128 ? F.nb - 64 : F.nb;
      convert_mixers(F, F.bid, ncv); convert_moe(F, 0, F.bid, ncv); }
    __syncthreads();
    ph_s5_pre(F);
}

template <bool F32> struct XRawT { typedef f32x4 T; };
template <> struct XRawT<false> { typedef u32x2 T; };
__device__ __forceinline__ f32x4 xcvt(const f32x4& r) { return r; }
__device__ __forceinline__ f32x4 xcvt(const u32x2& r) { return (f32x4){bflo(r.x), bfhi(r.x), bflo(r.y), bfhi(r.y)}; }
template <int MODE, bool COMBINE, bool S5OUT = false, bool SKIPCTX = false, bool FROMIN = false>
__device__ __forceinline__ void ph_norm(const Frame& F, int layer, int prev_layer) {
    static_assert(MODE != 1, "norm2 + router is ph_norm2");
    const float* nw = MODE == 0 ? F.in[6] + layer * D : F.in[32];
    const bf16* Y = (const bf16*)(F.ws + WS_Y);
    constexpr int NI = SKIPCTX ? NB * SEQ : R;
    constexpr int NPF = 4;
    const int per = (NI + F.nb * NWAVES - 1) / (F.nb * NWAVES);
    int it = (F.bid * NWAVES + F.wave) * per; const int itend = min(NI, it + per);
    typedef typename XRawT<FROMIN>::T XR;
    const __amdgpu_buffer_rsrc_t yrs = __builtin_amdgcn_make_buffer_rsrc((void*)Y, 0, (int)((size_t)NE * SLOTS * D * 2), 0x00020000);
    const int l16 = F.lane & 15;
#define NORM_ROWOF(i_) (SKIPCTX ? ((i_) >> 11) * P + NCTX + ((i_) & (SEQ - 1)) : (i_))
#define NORM_XPTR(r_) ((FROMIN ? (const XR*)(((r_) % P) < NCTX ? F.in[2] + ((size_t)((r_) / P) * NCTX + ((r_) % P)) * D : F.in[0] + ((size_t)((r_) / P) * SEQ + ((r_) % P) - NCTX) * D) : (const XR*)(F.X + (size_t)(r_) * D)) + F.lane)
#define NORM_STAGE(i_, INVA_, V_, G_, Yq_, INVB_) do { \
        const int ic_ = min((i_), itend - 1), ic1_ = min((i_) + 1, itend - 1); const int rA_ = NORM_ROWOF(ic_); \
        if (COMBINE) INVB_ = F.INV[(size_t)NORM_ROWOF(ic1_) * NE + l16]; \
        if (COMBINE) G_ = F.GATE[l16 * SLOTS + max(INVA_, 0)]; \
        { const XR* xp_ = NORM_XPTR(rA_); _Pragma("unroll") for (int j = 0; j < 4; ++j) V_[j] = xp_[64 * j]; } \
        if (COMBINE) { unsigned m_ = ((i_) < itend) ? (unsigned)(__ballot(F.lane < NE && INVA_ >= 0) & 0xffffull) : 0u; \
            _Pragma("unroll") for (int q = 0; q < NPF; ++q) { const bool pr_ = m_ != 0u; const int e_ = pr_ ? __builtin_ctz(m_) : 0; m_ &= m_ - 1u; const int s_ = __builtin_amdgcn_readlane(INVA_, e_); \
                const unsigned vo_ = pr_ ? (unsigned)(e_ * SLOTS + s_) * (unsigned)(D * 2) + (unsigned)F.lane * 8u : 0xfffff000u; \
                _Pragma("unroll") for (int j = 0; j < 4; ++j) Yq_[q][j] = __builtin_amdgcn_raw_buffer_load_b64(yrs, vo_ + 512u * j, 0, 0); } } \
    } while (0)
    XR v[4]; u32x2 yc[NPF][4]; float gl = 0.f; int invl = -1, invn = -1;
    if (COMBINE) invl = F.INV[(size_t)NORM_ROWOF(min(it, NI - 1)) * NE + l16];
    NORM_STAGE(it, invl, v, gl, yc, invn);
    const f32x4* nw4 = (const f32x4*)nw + F.lane;
    f32x4 g5[4], nwv[4], shv[4], scv[4]; int mrc = -1;
#pragma unroll
    for (int j = 0; j < 4; ++j) { nwv[j] = nw4[64 * j]; g5[j] = shv[j] = scv[j] = (f32x4){0.f, 0.f, 0.f, 0.f}; }
    while (it < itend) {
        const int row = NORM_ROWOF(it), b = row / P, pos = row - b * P, mr = pos < NCTX ? 32 : b;
        if (mr != mrc) { mrc = mr;
            const float* mrow = F.MOD + ((size_t)layer * 33 + mr) * 6144;
#pragma unroll
            for (int j = 0; j < 4; ++j) {
                if (COMBINE) g5[j] = ((const f32x4*)(F.MOD + ((size_t)prev_layer * 33 + mr) * 6144 + 5 * D) + F.lane)[64 * j];
                if (MODE != 2) { shv[j] = ((const f32x4*)(mrow + (MODE == 0 ? 0 : 3) * D) + F.lane)[64 * j]; scv[j] = ((const f32x4*)(mrow + (MODE == 0 ? 1 : 4) * D) + F.lane)[64 * j]; }
            }
        }
        XR vn[4]; u32x2 yn[NPF][4]; float gln = 0.f; int invnn = -1;
        NORM_STAGE(it + 1, invn, vn, gln, yn, invnn);
        f32x4 a[4];
#pragma unroll
        for (int j = 0; j < 4; ++j) a[j] = (f32x4){0.f, 0.f, 0.f, 0.f};
        if (COMBINE) {
            unsigned m = (unsigned)(__ballot(F.lane < NE && invl >= 0) & 0xffffull);
#pragma unroll
            for (int q = 0; q < NPF; ++q) {
                const bool pr = m != 0u; const int e = pr ? __builtin_ctz(m) : 0; m &= m - 1u;
                const float g = pr ? __uint_as_float(__builtin_amdgcn_readlane(__float_as_uint(gl), e)) : 0.f;
#pragma unroll
                for (int j = 0; j < 4; ++j) { a[j].x += g * bflo(yc[q][j].x); a[j].y += g * bfhi(yc[q][j].x); a[j].z += g * bflo(yc[q][j].y); a[j].w += g * bfhi(yc[q][j].y); }
            }
            while (m) {
                const int e = __builtin_ctz(m); m &= m - 1u;
                const int sl = __builtin_amdgcn_readlane(invl, e); const float g = __uint_as_float(__builtin_amdgcn_readlane(__float_as_uint(gl), e));
                const u32x2* y0 = (const u32x2*)(Y + ((size_t)e * SLOTS + sl) * D) + F.lane;
                u32x2 w0[4];
#pragma unroll
                for (int j = 0; j < 4; ++j) w0[j] = y0[64 * j];
#pragma unroll
                for (int j = 0; j < 4; ++j) { a[j].x += g * bflo(w0[j].x); a[j].y += g * bfhi(w0[j].x); a[j].z += g * bflo(w0[j].y); a[j].w += g * bfhi(w0[j].y); }
            }
        }
        f32x4 vv[4];
#pragma unroll
        for (int j = 0; j < 4; ++j) vv[j] = xcvt(v[j]);
        if (COMBINE) {
#pragma unroll
            for (int j = 0; j < 4; ++j) vv[j] = vv[j] + g5[j] * a[j];
        }
        if ((FROMIN || COMBINE) && MODE != 2) { u32x2* xw = (u32x2*)(F.X + (size_t)row * D) + F.lane;
#pragma unroll
            for (int j = 0; j < 4; ++j) { u32x2 w; w.x = pkbf(vv[j].x, vv[j].y); w.y = pkbf(vv[j].z, vv[j].w); xw[64 * j] = w; } }
        float ss = 0.f;
#pragma unroll
        for (int j = 0; j < 4; ++j) ss += (vv[j].x * vv[j].x + vv[j].y * vv[j].y) + (vv[j].z * vv[j].z + vv[j].w * vv[j].w);
        const float rinv = rsqrtf(wave_sum(ss) * (1.0f / D) + EPS);
        if (MODE == 2) {
            if (pos >= NCTX) {
                f32x4* o = (f32x4*)(F.out + ((size_t)b * SEQ + pos - NCTX) * D) + F.lane;
#pragma unroll
                for (int j = 0; j < 4; ++j) o[64 * j] = vv[j] * rinv * nwv[j];
            }
        } else {
            u32x2* ho = (u32x2*)(F.H + (size_t)row * D) + F.lane;
            f32x4 h[4];
#pragma unroll
            for (int j = 0; j < 4; ++j) { h[j] = vv[j] * rinv * nwv[j] * (scv[j] + 1.0f) + shv[j]; u32x2 w; w.x = pkbf(h[j].x, h[j].y); w.y = pkbf(h[j].z, h[j].w); ho[64 * j] = w;
                if (S5OUT) { const int g = (F.lane >> 2) + 16 * j;
                    *(u32x2*)((bf16*)(F.ws + WS_AG) + ((size_t)g * 2304 + b * 72 + (pos >> 5)) * 768 + (pos & 31) * 16 + (F.lane & 3) * 4) = w; } }
        }
#pragma unroll
        for (int j = 0; j < 4; ++j) { v[j] = vn[j];
#pragma unroll
            for (int q = 0; q < NPF; ++q) yc[q][j] = yn[q][j]; }
        gl = gln; invl = invn; invn = invnn; ++it;
    }
#undef NORM_STAGE
#undef NORM_XPTR
#undef NORM_ROWOF
}

template <bool SKIPCTX>
__device__ __forceinline__ void ph_norm2(const Frame& F, int layer) {
    const float* nw = F.in[7] + layer * D;
    LAS float* wrt = (LAS float*)((LAS unsigned char*)F.lds);
    {
        const float* wr = F.in[28] + (size_t)layer * D * NE;
        for (int i = F.tid; i < D * NE; i += NTHREADS) wrt[(i & 15) * (D + 4) + (i >> 4)] = wr[i];
        __syncthreads();
    }
    const f32x4* nw4 = (const f32x4*)nw + F.lane;
    const int eid = ((F.lane & 1) << 3) | ((F.lane & 2) << 1) | ((F.lane & 4) >> 1) | ((F.lane & 8) >> 3);
    constexpr int NI = SKIPCTX ? NB * SEQ / 2 : R / 2;
    const int per = (NI + F.nb * NWAVES - 1) / (F.nb * NWAVES), it0 = (F.bid * NWAVES + F.wave) * per, it1 = min(NI, it0 + per);
    f32x4 gv[4], shv[4]; int mrc = -1;
#pragma unroll
    for (int j = 0; j < 4; ++j) gv[j] = shv[j] = (f32x4){0.f, 0.f, 0.f, 0.f};
#define N2_ROWOF(i_) (SKIPCTX ? ((i_) >> 10) * P + NCTX + 2 * ((i_) & (SEQ / 2 - 1)) : 2 * (i_))
    u32x2 w0[4], w1[4];
    { const u32x2* x0 = (const u32x2*)(F.X + (size_t)N2_ROWOF(min(it0, NI - 1)) * D) + F.lane;
#pragma unroll
      for (int j = 0; j < 4; ++j) { w0[j] = x0[64 * j]; w1[j] = x0[256 + 64 * j]; } }
    for (int it = it0; it < it1; ++it) {
        const int row = N2_ROWOF(it), b = row / P, pos = row - b * P, mr = pos < NCTX ? 32 : b;
        f32x4 v0[4], v1[4];
#pragma unroll
        for (int j = 0; j < 4; ++j) { v0[j] = xcvt(w0[j]); v1[j] = xcvt(w1[j]); }
        if (mr != mrc) { mrc = mr;
            const float* mrow = F.MOD + ((size_t)layer * 33 + mr) * 6144;
#pragma unroll
            for (int j = 0; j < 4; ++j) { shv[j] = ((const f32x4*)(mrow + 3 * D) + F.lane)[64 * j]; gv[j] = nw4[64 * j] * (((const f32x4*)(mrow + 4 * D) + F.lane)[64 * j] + 1.0f); }
        }
        u32x2 n0[4], n1[4];
        { const u32x2* xn = (const u32x2*)(F.X + (size_t)N2_ROWOF(min(it + 1, it1 - 1)) * D) + F.lane;
#pragma unroll
          for (int j = 0; j < 4; ++j) { n0[j] = xn[64 * j]; n1[j] = xn[256 + 64 * j]; } }
        float s0 = 0.f, s1 = 0.f;
#pragma unroll
        for (int j = 0; j < 4; ++j) { s0 += (v0[j].x * v0[j].x + v0[j].y * v0[j].y) + (v0[j].z * v0[j].z + v0[j].w * v0[j].w); s1 += (v1[j].x * v1[j].x + v1[j].y * v1[j].y) + (v1[j].z * v1[j].z + v1[j].w * v1[j].w); }
        const float r0 = rsqrtf(wave_sum(s0) * (1.0f / D) + EPS), r1 = rsqrtf(wave_sum(s1) * (1.0f / D) + EPS);
        u32x2* h0 = (u32x2*)(F.H + (size_t)row * D) + F.lane; u32x2* h1 = h0 + 256;
#pragma unroll
        for (int j = 0; j < 4; ++j) { const f32x4 g = gv[j];
            v0[j] = v0[j] * r0 * g + shv[j]; v1[j] = v1[j] * r1 * g + shv[j];
            u32x2 w; w.x = pkbf(v0[j].x, v0[j].y); w.y = pkbf(v0[j].z, v0[j].w); h0[64 * j] = w;
            w.x = pkbf(v1[j].x, v1[j].y); w.y = pkbf(v1[j].z, v1[j].w); h1[64 * j] = w; }
        f32x2 a0[NE], a1[NE];
#pragma unroll
        for (int e = 0; e < NE; ++e) { a0[e] = (f32x2){0.f, 0.f}; a1[e] = (f32x2){0.f, 0.f}; }
#pragma unroll
        for (int j = 0; j < 4; ++j) { asm volatile("" ::: "memory");
            const f32x2 p0 = {v0[j].x, v0[j].y}, q0 = {v0[j].z, v0[j].w}, p1 = {v1[j].x, v1[j].y}, q1 = {v1[j].z, v1[j].w};
#pragma unroll
            for (int e = 0; e < NE; ++e) { const f32x4 w = *(const LAS f32x4*)(wrt + e * (D + 4) + F.lane * 4 + 256 * j); const f32x2 wl = {w.x, w.y}, wh = {w.z, w.w};
                a0[e] += p0 * wl; a0[e] += q0 * wh; a1[e] += p1 * wl; a1[e] += q1 * wh; } }
        float lg0[NE], lg1[NE];
#pragma unroll
        for (int e = 0; e < NE; ++e) { lg0[e] = a0[e].x + a0[e].y; lg1[e] = a1[e].x + a1[e].y; }
        const float t0 = reduce16(lg0, F.lane), t1 = reduce16(lg1, F.lane);
        float m0 = fmaxf(t0, dpp_xor1(t0)), m1 = fmaxf(t1, dpp_xor1(t1));
        m0 = fmaxf(m0, dpp_xor2(m0)); m1 = fmaxf(m1, dpp_xor2(m1)); m0 = fmaxf(m0, __shfl_xor(m0, 4)); m1 = fmaxf(m1, __shfl_xor(m1, 4)); m0 = fmaxf(m0, __shfl_xor(m0, 8)); m1 = fmaxf(m1, __shfl_xor(m1, 8));
        const float e0 = __builtin_amdgcn_exp2f((t0 - m0) * LOG2E_), e1 = __builtin_amdgcn_exp2f((t1 - m1) * LOG2E_);
        float z0 = e0 + dpp_xor1(e0), z1 = e1 + dpp_xor1(e1);
        z0 += dpp_xor2(z0); z1 += dpp_xor2(z1); z0 += __shfl_xor(z0, 4); z1 += __shfl_xor(z1, 4); z0 += __shfl_xor(z0, 8); z1 += __shfl_xor(z1, 8);
        if (F.lane < NE) { float* ap = F.AFF + ((size_t)b * NE + eid) * P + pos; ap[0] = e0 / z0; ap[1] = e1 / z1; }
#pragma unroll
        for (int j = 0; j < 4; ++j) { w0[j] = n0[j]; w1[j] = n1[j]; }
    }
#undef N2_ROWOF
}

__device__ __forceinline__ void ph_topk(const Frame& F, int nitems) {
    const int tid = F.tid, lane = F.lane, half = F.wave >> 2, hw = F.wave & 3, ht = tid & 255;
    unsigned* hist = (unsigned*)F.lds + half * 288;
    unsigned* wtot = hist + 256;
    unsigned* bc = wtot + 8;
    for (int item0 = F.bid; item0 < nitems; item0 += 2 * F.nb) {
        const int item = item0 + half * F.nb; const bool valid = item < nitems;
        const int seg = item >> 9, b = (item >> 4) & 31, e = item & 15;
        const int n = seg ? NCTX : SEQ, pos0 = seg ? 0 : NCTX, cap = n / 8, slot0 = seg ? NB * 256 + b * 32 : b * 256;
        const int per = seg ? 1 : 8;
        const float* a = F.AFF + ((size_t)b * NE + e) * P + pos0;
        unsigned u[8];
#pragma unroll
        for (int q = 0; q < 8; ++q) u[q] = 0u;
        if (valid) {
            if (seg) u[0] = __float_as_uint(a[ht]);
            else { const f32x4 a0 = *(const f32x4*)(a + ht * 8), a1 = *(const f32x4*)(a + ht * 8 + 4);
                u[0] = __float_as_uint(a0.x); u[1] = __float_as_uint(a0.y); u[2] = __float_as_uint(a0.z); u[3] = __float_as_uint(a0.w);
                u[4] = __float_as_uint(a1.x); u[5] = __float_as_uint(a1.y); u[6] = __float_as_uint(a1.z); u[7] = __float_as_uint(a1.w); }
        }
        unsigned prefix = 0u, mask = 0u, kk = (unsigned)cap;
#pragma unroll 1
        for (int pass = 0; pass < 4; ++pass) {
            const int shift = 24 - 8 * pass;
            __syncthreads();
            hist[ht] = 0u;
            __syncthreads();
            if (valid) {
#pragma unroll
                for (int q = 0; q < 8; ++q) if (q < per && (u[q] & mask) == prefix) atomicAdd(&hist[(u[q] >> shift) & 255u], 1u);
            }
            __syncthreads();
            unsigned hv = hist[255 - ht], cum = hv;
#pragma unroll
            for (int o = 1; o < 64; o <<= 1) { const unsigned t = __shfl_up(cum, o); if (lane >= o) cum += t; }
            if (lane == 63) wtot[hw] = cum;
            __syncthreads();
            {
                unsigned off = 0u;
#pragma unroll
                for (int w = 0; w < 4; ++w) if (w < hw) off += wtot[w];
                cum += off;
                if (cum >= kk && cum - hv < kk) { bc[0] = 255u - (unsigned)ht; bc[1] = kk - (cum - hv); }
            }
            __syncthreads();
            prefix |= bc[0] << shift; mask |= 255u << shift; kk = bc[1];
        }
        unsigned cg = 0u, ce = 0u;
        if (valid) {
#pragma unroll
            for (int q = 0; q < 8; ++q) if (q < per) { cg += u[q] > prefix ? 1u : 0u; ce += u[q] == prefix ? 1u : 0u; }
        }
        unsigned pk = cg | (ce << 16), inc = pk;
#pragma unroll
        for (int o = 1; o < 64; o <<= 1) { const unsigned t = __shfl_up(inc, o); if (lane >= o) inc += t; }
        __syncthreads();
        if (lane == 63) wtot[hw] = inc;
        __syncthreads();
        unsigned off = 0u;
#pragma unroll
        for (int w = 0; w < 4; ++w) if (w < hw) off += wtot[w];
        unsigned excl = inc - pk + off, gb = excl & 0xffffu, eb = excl >> 16;
        if (valid) {
#pragma unroll
            for (int q = 0; q < 8; ++q) if (q < per) {
                const int i = ht * per + q, row = b * P + pos0 + i;
                const bool gt = u[q] > prefix, eq = u[q] == prefix, sel = gt || (eq && eb < kk);
                if (sel) { const int slot = slot0 + (int)(gb + (eb < kk ? eb : kk)); F.SEL[e * SLOTS + slot] = row; F.GATE[e * SLOTS + slot] = __uint_as_float(u[q]); F.INV[(size_t)row * NE + e] = slot; }
                else F.INV[(size_t)row * NE + e] = -1;
                gb += gt ? 1u : 0u; eb += eq ? 1u : 0u;
            }
        }
        __syncthreads();
    }
    __syncthreads();
}

typedef short bf16x8 __attribute__((ext_vector_type(8)));
typedef float f32x16 __attribute__((ext_vector_type(16)));
#define MFMA32(a, b, c) __builtin_amdgcn_mfma_f32_32x32x16_bf16((a), (b), (c), 0, 0, 0)
__device__ __forceinline__ int kperm(int m) { return (m & 0x13) | ((m & 8) >> 1) | ((m & 4) << 1); }
__device__ __forceinline__ bf16x8 pack8(const f32x16& x, int s8) {
    u32x4 p; p.x = pkbf(x[s8 + 0], x[s8 + 1]); p.y = pkbf(x[s8 + 2], x[s8 + 3]); p.z = pkbf(x[s8 + 4], x[s8 + 5]); p.w = pkbf(x[s8 + 6], x[s8 + 7]);
    return __builtin_bit_cast(bf16x8, p);
}
constexpr float LOG2E = 1.4426950408889634f;

__device__ __forceinline__ void ph_da_attn(const Frame& F) {
    const bf16* Q = (const bf16*)(F.ws + WS_Q); const bf16* K = (const bf16*)(F.ws + WS_K); const bf16* VT = (const bf16*)(F.ws + WS_VT); bf16* O = (bf16*)(F.ws + WS_O);
    const int tid = F.tid, lane = F.lane, l32 = lane & 31, hh = lane >> 5, map = F.wave & 1, qsub = F.wave >> 1;
    const float* lam = F.in[22];
    const float lam_full = expf(wave_sum(lam[lane] * lam[64 + lane])) - expf(wave_sum(lam[128 + lane] * lam[192 + lane])) + LAM_INIT;
    constexpr int KB = 64 * 144, VB = 128 * 144, BUF = 2 * KB + VB;
    unsigned char* sb = F.lds;
    float* xch = (float*)(F.lds + 2 * BUF) + qsub * 4096;
    const float c = 0.125f * LOG2E;
    const int kr = (tid >> 3) & 63, kc = tid & 7, vd = tid >> 3, vc = tid & 7;
    const int kdst = kr * 144 + kc * 16, vdst = 2 * KB + vd * 144 + vc * 16;
    const int kfrag = map * KB + kperm(l32) * 144 + hh * 16, vfrag = 2 * KB + l32 * 144 + hh * 16;
    const int vb = (F.nb & 7) == 0 ? (F.bid & 7) * (F.nb >> 3) + (F.bid >> 3) : F.bid;
    for (int it = vb; it < 4096 + 512; it += F.nb) {
        int b, h, pos0, nst;
        if (it < 4096) { b = it >> 7; h = (it >> 4) & 7; pos0 = NCTX + (it & 15) * 128 + qsub * 32; nst = P / 64; }
        else { const int j = it - 4096; b = j >> 4; h = (j >> 1) & 7; pos0 = (j & 1) * 128 + qsub * 32; nst = NCTX / 64; }
        const size_t qrow = (size_t)b * P + pos0 + l32;
        bf16x8 qf[4];
#pragma unroll
        for (int ks = 0; ks < 4; ++ks) qf[ks] = *(const bf16x8*)(Q + qrow * D + h * 128 + map * 64 + ks * 16 + hh * 8);
        f32x16 o[4];
#pragma unroll
        for (int dt = 0; dt < 4; ++dt)
#pragma unroll
            for (int j = 0; j < 16; ++j) o[dt][j] = 0.f;
        float m = 0.f, l = 0.f;
        const bf16* kg = K + ((size_t)b * P + kr) * D + h * 128 + kc * 8;
        const bf16* vg = VT + ((size_t)b * D + h * 128 + vd) * P + vc * 8;
        u32x4 ka0, ka1, va0, va1;
        { const u32x4 k0 = *(const u32x4*)kg, k1 = *(const u32x4*)(kg + 64), v0 = *(const u32x4*)vg, v1 = *(const u32x4*)(vg + (size_t)64 * P);
          const bf16* kq = kg + (size_t)64 * D; const bf16* vq = vg + 64;
          ka0 = *(const u32x4*)kq; ka1 = *(const u32x4*)(kq + 64); va0 = *(const u32x4*)vq; va1 = *(const u32x4*)(vq + (size_t)64 * P);
          *(u32x4*)(sb + kdst) = k0; *(u32x4*)(sb + KB + kdst) = k1; *(u32x4*)(sb + vdst) = v0; *(u32x4*)(sb + vdst + 64 * 144) = v1; }
        __syncthreads();
#pragma unroll 1
        for (int st = 0; st < nst; ++st) {
            const unsigned char* cb = sb + (st & 1) * BUF;
            u32x4 kn0 = (u32x4){0u, 0u, 0u, 0u}, kn1 = kn0, vn0 = kn0, vn1 = kn0;
            if (st + 2 < nst) { const bf16* kq = kg + (size_t)(st + 2) * 64 * D; const bf16* vq = vg + (st + 2) * 64;
                kn0 = *(const u32x4*)kq; kn1 = *(const u32x4*)(kq + 64); vn0 = *(const u32x4*)vq; vn1 = *(const u32x4*)(vq + (size_t)64 * P); }
#pragma unroll
            for (int sub = 0; sub < 2; ++sub) {
                f32x16 s;
#pragma unroll
                for (int j = 0; j < 16; ++j) s[j] = -m;
#pragma unroll
                for (int ks = 0; ks < 4; ++ks) s = MFMA32(*(const bf16x8*)(cb + kfrag + sub * 32 * 144 + ks * 32), qf[ks], s);
                float mx = s[0];
#pragma unroll
                for (int j = 1; j < 16; ++j) mx = fmaxf(mx, s[j]);
                mx = fmaxf(mx, __shfl_xor(mx, 32));
                const bool first = st == 0 && sub == 0;
                if (first || __any(mx > 8.0f)) {
                    const float d = first ? mx : fmaxf(mx, 0.f);
                    if (!first) { const float alpha = __builtin_amdgcn_exp2f(-d); l *= alpha;
#pragma unroll
                        for (int dt = 0; dt < 4; ++dt)
#pragma unroll
                            for (int j = 0; j < 16; ++j) o[dt][j] *= alpha; }
                    m += d;
#pragma unroll
                    for (int j = 0; j < 16; ++j) s[j] -= d;
                }
                float ps = 0.f;
#pragma unroll
                for (int j = 0; j < 16; ++j) { s[j] = __builtin_amdgcn_exp2f(s[j]); ps += s[j]; }
                l += ps;
                const bf16x8 p0 = pack8(s, 0), p1 = pack8(s, 8);
#pragma unroll
                for (int dt = 0; dt < 4; ++dt) { o[dt] = MFMA32(*(const bf16x8*)(cb + vfrag + dt * 32 * 144 + sub * 64), p0, o[dt]); o[dt] = MFMA32(*(const bf16x8*)(cb + vfrag + dt * 32 * 144 + sub * 64 + 32), p1, o[dt]); }
            }
            if (st + 1 < nst) { unsigned char* nb = sb + ((st + 1) & 1) * BUF; *(u32x4*)(nb + kdst) = ka0; *(u32x4*)(nb + KB + kdst) = ka1; *(u32x4*)(nb + vdst) = va0; *(u32x4*)(nb + vdst + 64 * 144) = va1; }
            ka0 = kn0; ka1 = kn1; va0 = vn0; va1 = vn1;
            __syncthreads();
        }
        l += __shfl_xor(l, 32);
        const float inv = 1.0f / l;
        if (map == 1) {
#pragma unroll
            for (int dt = 0; dt < 4; ++dt)
#pragma unroll
                for (int j = 0; j < 16; ++j) xch[(dt * 16 + j) * 64 + lane] = o[dt][j] * inv * lam_full;
        }
        __syncthreads();
        if (map == 0) {
            float ss = 0.f;
#pragma unroll
            for (int dt = 0; dt < 4; ++dt)
#pragma unroll
                for (int j = 0; j < 16; ++j) { const float v = o[dt][j] * inv - xch[(dt * 16 + j) * 64 + lane]; o[dt][j] = v; ss += v * v; }
            ss += __shfl_xor(ss, 32);
            const float rinv = rsqrtf(ss * (1.0f / 128.0f) + EPS) * (1.0f - LAM_INIT);
#pragma unroll
            for (int dt = 0; dt < 4; ++dt)
#pragma unroll
                for (int jq = 0; jq < 4; ++jq) {
                    const int d0 = dt * 32 + jq * 8 + hh * 4; const f32x4 sw = *(const f32x4*)(F.in[23] + d0);
                    u32x2 w; w.x = pkbf(o[dt][jq * 4 + 0] * rinv * sw.x, o[dt][jq * 4 + 1] * rinv * sw.y); w.y = pkbf(o[dt][jq * 4 + 2] * rinv * sw.z, o[dt][jq * 4 + 3] * rinv * sw.w);
                    *(u32x2*)(O + qrow * D + h * 128 + d0) = w;
                }
        }
        __syncthreads();
    }
}

__device__ __forceinline__ void ph_na_attn(const Frame& F) {
    const bf16* Q = (const bf16*)(F.ws + WS_Q); const bf16* K = (const bf16*)(F.ws + WS_K); const bf16* VT = (const bf16*)(F.ws + WS_VT); bf16* O = (bf16*)(F.ws + WS_O);
    const int tid = F.tid, lane = F.lane, l32 = lane & 31, hh = lane >> 5;
    constexpr int KB = 128 * 144, VP = 272, VB = 64 * VP, BUF = KB + VB;
    unsigned char* sb = F.lds;
    float* rp = (float*)(F.lds + 2 * BUF) + 64;
    for (int i = tid; i < 16 * 15 * 31 + 128; i += NTHREADS) { const int k = i - 64; rp[k] = (k >= 0 && k < 16 * 15 * 31) ? F.in[19][k] * LOG2E : 0.f; }
    __syncthreads();
    const float c = 0.125f * LOG2E;
    const int pr = tid >> 3, pc = tid & 7;
    const int kdst = pr * 144 + pc * 16, vdst = KB + pr * VP + pc * 16;
    const int kfrag = kperm(l32) * 144 + hh * 16, vfrag = KB + l32 * VP + hh * 16;
    const int vb = (F.nb & 7) == 0 ? (F.bid & 7) * (F.nb >> 3) + (F.bid >> 3) : F.bid;
    for (int it = vb; it < 4096 + 512; it += F.nb) {
        int b, h, r = 0, cq = 0, kc0 = 0, rlo = 0, rhi = 0, wr0 = 0, wr1 = 0, nt; bool lat; size_t qrow;
        if (it < 4096) { lat = true; b = it >> 7; h = (it >> 3) & 15; const int rg = ((it & 7) + (it >> 8)) & 7  ;
            const int rw = rg * 4 + (F.wave >> 2) * 2, cqt = F.wave & 3; r = rw + (l32 >> 4); cq = cqt * 16 + (l32 & 15); kc0 = min(max(cqt * 16 - 8, 0), 32);
            wr0 = min(max(rw - 4, 0), 24); wr1 = min(max(rw + 1 - 4, 0), 24) + 8;
            qrow = (size_t)b * P + NCTX + r * 64 + cq;
            rlo = min(max(rg * 4 - 4, 0), 24); rhi = min(max(rg * 4 + 3 - 4, 0), 24) + 7; nt = 2 + (rhi - rlo + 2) / 2; }
        else { lat = false; const int j = it - 4096; b = j >> 4; h = j & 15; qrow = (size_t)b * P + F.wave * 32 + l32; nt = 2; }
        const int r0 = min(max(r - 4, 0), 24), c0 = min(max(cq - 8, 0), 48);
        bf16x8 qf[4];
#pragma unroll
        for (int ks = 0; ks < 4; ++ks) qf[ks] = *(const bf16x8*)(Q + qrow * D + h * 64 + ks * 16 + hh * 8);
        float neg[16];
#pragma unroll
        for (int j = 0; j < 16; ++j) { const int kcol = kc0 + 16 * (j >> 3) + 8 * hh + 4 * ((j >> 2) & 1) + (j & 3); neg[j] = (kcol >= c0 && kcol < c0 + 16) ? 0.f : -1.0e30f; }
        f32x16 o[2];
#pragma unroll
        for (int dt = 0; dt < 2; ++dt)
#pragma unroll
            for (int j = 0; j < 16; ++j) o[dt][j] = 0.f;
        float m = -1.0e30f, l = 0.f;
        const bf16* kg = K + ((size_t)b * P + pr) * D + h * 64 + pc * 8;
        const bf16* vg = VT + ((size_t)b * D + h * 64 + pr) * P + pc * 8;
#define NA_KEYA(st) ((st) < 2 ? (st) * 128 : NCTX + (rlo + 2 * ((st) - 2)) * 64)
#define NA_KEYB(st) ((st) < 2 ? (st) * 128 + 64 : NCTX + min(rlo + 2 * ((st) - 2) + 1, 31) * 64)
#define NA_LOAD(dk0, dk1, dv0, dv1, st) do { const int ka_ = NA_KEYA(st), kb_ = NA_KEYB(st); dk0 = *(const u32x4*)(kg + (size_t)ka_ * D); dk1 = *(const u32x4*)(kg + (size_t)kb_ * D); \
        dv0 = *(const u32x4*)(vg + ka_); dv1 = *(const u32x4*)(vg + kb_); } while (0)
#define NA_STORE(buf, sk0, sk1, sv0, sv1) do { *(u32x4*)((buf) + kdst) = sk0; *(u32x4*)((buf) + kdst + 64 * 144) = sk1; *(u32x4*)((buf) + vdst) = sv0; *(u32x4*)((buf) + vdst + 128) = sv1; } while (0)
        u32x4 ka0, ka1, va0, va1;
        { u32x4 x0, x1, y0, y1; NA_LOAD(x0, x1, y0, y1, 0); NA_LOAD(ka0, ka1, va0, va1, 1); NA_STORE(sb, x0, x1, y0, y1); }
        __syncthreads();
#pragma unroll 1
        for (int st = 0; st < nt; ++st) {
            const unsigned char* cbuf = sb + (st & 1) * BUF;
            u32x4 kn0 = (u32x4){0u, 0u, 0u, 0u}, kn1 = kn0, vn0 = kn0, vn1 = kn0;
            if (st + 2 < nt) NA_LOAD(kn0, kn1, vn0, vn1, st + 2);
#define NA_TILE(KO_, WIN_, KROW_) do { const int ko = (KO_); \
                f32x16 s; \
                _Pragma("unroll") for (int j = 0; j < 16; ++j) s[j] = 0.f; \
                _Pragma("unroll") for (int ks = 0; ks < 4; ++ks) s = MFMA32(*(const bf16x8*)(cbuf + kfrag + ko * 144 + ks * 32), qf[ks], s); \
                if (WIN_) { const int krow = (KROW_); \
                    const float rmask = (krow >= r0 && krow < r0 + 8) ? 0.f : -1.0e30f;        \
                    const float* rph = rp + (h * 15 + (krow - r + 7)) * 31 - cq + 15 + 8 * hh + kc0;       \
                    _Pragma("unroll") for (int j = 0; j < 16; ++j) s[j] = (s[j] * c + rph[16 * (j >> 3) + 4 * ((j >> 2) & 1) + (j & 3)]) + (neg[j] + rmask); \
                } else { _Pragma("unroll") for (int j = 0; j < 16; ++j) s[j] *= c; } \
                float mx = s[0]; \
                _Pragma("unroll") for (int j = 1; j < 16; ++j) mx = fmaxf(mx, s[j]); \
                mx = fmaxf(mx, __shfl_xor(mx, 32)); \
                if (__any(mx > m + 8.0f)) { \
                    const float mn = fmaxf(m, mx), alpha = __builtin_amdgcn_exp2f(m - mn); m = mn; l *= alpha; \
                    _Pragma("unroll") for (int dt = 0; dt < 2; ++dt) _Pragma("unroll") for (int j = 0; j < 16; ++j) o[dt][j] *= alpha; \
                } \
                f32x2 ps2 = {0.f, 0.f}; \
                _Pragma("unroll") for (int j = 0; j < 16; j += 2) { f32x2 t = {s[j], s[j + 1]}; t = t - (f32x2){m, m}; t.x = __builtin_amdgcn_exp2f(t.x); t.y = __builtin_amdgcn_exp2f(t.y); s[j] = t.x; s[j + 1] = t.y; ps2 += t; } \
                l += ps2.x + ps2.y; \
                const bf16x8 p0 = pack8(s, 0), p1 = pack8(s, 8); \
                _Pragma("unroll") for (int dt = 0; dt < 2; ++dt) { o[dt] = MFMA32(*(const bf16x8*)(cbuf + vfrag + dt * 32 * VP + ko * 2), p0, o[dt]); o[dt] = MFMA32(*(const bf16x8*)(cbuf + vfrag + dt * 32 * VP + ko * 2 + 32), p1, o[dt]); } \
            } while (0)
            if (st < 2) {
#pragma unroll
                for (int sub = 0; sub < 4; ++sub) NA_TILE(sub * 32, false, 0);
            } else {
#pragma unroll
                for (int half = 0; half < 2; ++half) { const int krw = rlo + 2 * (st - 2) + half;
                    if (krw <= rhi && krw >= wr0 && krw < wr1) NA_TILE(half * 64 + kc0, true, krw); }
            }
#undef NA_TILE
            if (st + 1 < nt) { unsigned char* nb = sb + ((st + 1) & 1) * BUF; NA_STORE(nb, ka0, ka1, va0, va1); }
            ka0 = kn0; ka1 = kn1; va0 = vn0; va1 = vn1;
            __syncthreads();
        }
#undef NA_KEYA
#undef NA_KEYB
#undef NA_LOAD
#undef NA_STORE
        l += __shfl_xor(l, 32);
        const float inv = 1.0f / l;
#pragma unroll
        for (int dt = 0; dt < 2; ++dt)
#pragma unroll
            for (int jq = 0; jq < 4; ++jq) {
                const int d0 = dt * 32 + jq * 8 + hh * 4;
                u32x2 w; w.x = pkbf(o[dt][jq * 4 + 0] * inv, o[dt][jq * 4 + 1] * inv); w.y = pkbf(o[dt][jq * 4 + 2] * inv, o[dt][jq * 4 + 3] * inv);
                *(u32x2*)(O + qrow * D + h * 64 + d0) = w;
            }
    }
    __syncthreads();
}

__device__ __forceinline__ f32x4 unpk4(u32x2 w) { return (f32x4){bflo(w.x), bfhi(w.x), bflo(w.y), bfhi(w.y)}; }
__device__ __forceinline__ bf16 bf1(float x) { return (bf16)(pkbf(x, 0.f) & 0xffffu); }
__device__ __forceinline__ f32x4 shx32(f32x4 v) { return (f32x4){__shfl_xor(v.x, 32), __shfl_xor(v.y, 32), __shfl_xor(v.z, 32), __shfl_xor(v.w, 32)}; }
template <int DIR>
__device__ __forceinline__ void hgrn_seq(const Frame& F, int b, int h, int eb) {
    const bf16* ZIN = (const bf16*)(F.ws + WS_ZIN); const bf16* VTG = (const bf16*)(F.ws + WS_VTG); bf16* OUT = (bf16*)(F.ws + (DIR ? WS_OFB : WS_OFF));
    const int lane = F.lane, l32 = lane & 31, hh = lane >> 5, cperm = kperm(l32);
    constexpr int IMG = 32 * 136 * 2, KTB = 128 * 80, DBUF = 2 * IMG + KTB + 512;
    unsigned char* dbase = F.lds + DIR * 2 * DBUF;
    const int tg = lane & 7, prho = 8 * eb + (lane >> 3), pc = kperm(prho);
    f32x16 S[4];
#pragma unroll
    for (int d = 0; d < 4; ++d)
#pragma unroll
        for (int j = 0; j < 16; ++j) S[d][j] = 0.f;
    const bf16* vbase = VTG + ((size_t)b * D + h * 128 + eb * 32 + l32) * P + hh * 8;
    const bf16* zp = ZIN + ((size_t)b * P + 4 * tg) * 4096 + h * 128 + 4 * prho;
#define HG_CHUNK(i_) (DIR == 0 ? (i_) : ((i_) < 8 ? 7 - (i_) : 79 - (i_)))
#define HG_LOAD(i_) do { const int c_ = HG_CHUNK(i_); const bf16* z_ = zp + (size_t)c_ * 32 * 4096; \
        _Pragma("unroll") for (int i = 0; i < 4; ++i) { nlf[i] = *(const u32x2*)(z_ + (size_t)i * 4096 + (1 + DIR) * D); nq[i] = *(const u32x2*)(z_ + (size_t)i * 4096); } \
        nv0 = *(const bf16x8*)(vbase + c_ * 32); nv1 = *(const bf16x8*)(vbase + c_ * 32 + 16); } while (0)
    u32x2 nlf[4], nq[4]; bf16x8 nv0, nv1;
    HG_LOAD(0);
#pragma unroll 1
    for (int idx = 0; idx < 72; ++idx) {
        const int cc = HG_CHUNK(idx);
        const size_t row0 = (size_t)b * P + cc * 32;
        unsigned char* buf = dbase + (idx & 1) * DBUF;
        bf16* Qp = (bf16*)buf; bf16* Kp = (bf16*)(buf + IMG); bf16* KT = (bf16*)(buf + 2 * IMG); float* egl = (float*)(buf + 2 * IMG + KTB);
        u32x2 lfc[4], qc[4];
#pragma unroll
        for (int i = 0; i < 4; ++i) { lfc[i] = nlf[i]; qc[i] = nq[i]; }
        const bf16x8 vf0 = nv0, vf1 = nv1;
        HG_LOAD(min(idx + 1, 71));
        f32x4 l4[4], t = (f32x4){0.f, 0.f, 0.f, 0.f};
#pragma unroll
        for (int i = 0; i < 4; ++i) { l4[i] = unpk4(lfc[i]); t += l4[i]; }
        f32x4 x = t;
#pragma unroll
        for (int k = 1; k < 8; k <<= 1) { const f32x4 y = (f32x4){__shfl_up(x.x, k, 8), __shfl_up(x.y, k, 8), __shfl_up(x.z, k, 8), __shfl_up(x.w, k, 8)}; if (tg >= k) x += y; }
        const f32x4 tot = (f32x4){__shfl(x.x, 7, 8), __shfl(x.y, 7, 8), __shfl(x.z, 7, 8), __shfl(x.w, 7, 8)};
        const f32x4 off = DIR == 0 ? x - t : tot - x;
        f32x4 eg = (f32x4){__builtin_amdgcn_exp2f(off.x), __builtin_amdgcn_exp2f(off.y), __builtin_amdgcn_exp2f(off.z), __builtin_amdgcn_exp2f(off.w)}; float kv[4][4];
#pragma unroll
        for (int ii = 0; ii < 4; ++ii) {
            const int i = DIR ? 3 - ii : ii;
            const f32x4 lf = l4[i], q4 = unpk4(qc[i]);
            const int srow = (4 * tg + i) * 136 + pc;
#pragma unroll
            for (int d = 0; d < 4; ++d) { const float f = __builtin_amdgcn_exp2f(lf[d]); eg[d] *= f; const float kq = (1.0f - f) * __builtin_amdgcn_rcpf(eg[d]);
                Qp[srow + d * 32] = bf1(q4[d] * eg[d]); Kp[srow + d * 32] = bf1(kq); kv[d][i] = kq; }
        }
#pragma unroll
        for (int d = 0; d < 4; ++d) { u32x2 w; w.x = pkbf(kv[d][0], kv[d][1]); w.y = pkbf(kv[d][2], kv[d][3]); *(u32x2*)(KT + (d * 32 + prho) * 40 + 4 * tg) = w; }
        if (tg == 0) *(f32x4*)(egl + 4 * prho) = (f32x4){__builtin_amdgcn_exp2f(tot.x), __builtin_amdgcn_exp2f(tot.y), __builtin_amdgcn_exp2f(tot.z), __builtin_amdgcn_exp2f(tot.w)};
        __syncthreads();
        bf16x8 kf[4][2];
#pragma unroll
        for (int d = 0; d < 4; ++d)
#pragma unroll
            for (int sg = 0; sg < 2; ++sg) kf[d][sg] = *(const bf16x8*)(KT + (d * 32 + l32) * 40 + sg * 16 + 8 * hh);
        if (cc >= NCTX / 32) {
        f32x16 att, o;
#pragma unroll
        for (int j = 0; j < 16; ++j) { att[j] = 0.f; o[j] = 0.f; }
        const bf16* krow = Kp + cperm * 136 + hh * 8; const bf16* qrow = Qp + l32 * 136 + hh * 8;
#pragma unroll
        for (int ks = 0; ks < 8; ++ks) { att = MFMA32(*(const bf16x8*)(krow + ks * 16), *(const bf16x8*)(qrow + ks * 16), att);
            o = MFMA32(pack8(S[ks >> 1], (ks & 1) * 8), *(const bf16x8*)(qrow + (ks >> 1) * 32 + (ks & 1) * 16), o); }
#pragma unroll
        for (int j = 0; j < 16; ++j) { const int sa = 16 * (j >> 3) + 8 * hh + 4 * ((j >> 2) & 1) + (j & 3); const bool keep = DIR == 0 ? (sa <= l32) : (sa >= l32); att[j] = keep ? att[j] : 0.f; }
        const bf16x8 p0 = pack8(att, 0), p1 = pack8(att, 8);
        o = MFMA32(vf0, p0, o); o = MFMA32(vf1, p1, o);
        bf16* op = OUT + (row0 + l32) * D + h * 128 + eb * 32 + 4 * hh;
#pragma unroll
        for (int jq = 0; jq < 4; ++jq) { u32x2 w; w.x = pkbf(o[4 * jq], o[4 * jq + 1]); w.y = pkbf(o[4 * jq + 2], o[4 * jq + 3]); *(u32x2*)(op + 8 * jq) = w; }
        }
#pragma unroll
        for (int d = 0; d < 4; ++d) { S[d] = MFMA32(kf[d][0], vf0, S[d]); S[d] = MFMA32(kf[d][1], vf1, S[d]); }
#pragma unroll
        for (int j = 0; j < 16; ++j) { const int rho = (j & 3) + 8 * (j >> 2) + 4 * hh; const f32x4 e4 = *(const f32x4*)(egl + 4 * rho);
            S[0][j] *= e4.x; S[1][j] *= e4.y; S[2][j] *= e4.z; S[3][j] *= e4.w; }
    }
#undef HG_LOAD
#undef HG_CHUNK
}
__device__ __forceinline__ void ph_hgrn_scan(const Frame& F) {
    for (int id = F.bid * NWAVES + F.wave; id < NB * 8 * 8; id += F.nb * NWAVES) {
        const int eb = id & 3, dir = (id >> 2) & 1, h = (id >> 3) & 7, b = id >> 6;
        if (dir == 0) hgrn_seq<0>(F, b, h, eb); else hgrn_seq<1>(F, b, h, eb);
    }
}
__device__ __forceinline__ void ph_hgrn_post(const Frame& F) {
    const bf16* ZIN = (const bf16*)(F.ws + WS_ZIN); const bf16* OFF = (const bf16*)(F.ws + WS_OFF); const bf16* OFB = (const bf16*)(F.ws + WS_OFB); bf16* O2 = (bf16*)(F.ws + WS_O2);
    const int lane = F.lane, part = lane & 7;
    f32x4 gn[4];
#pragma unroll
    for (int q = 0; q < 4; ++q) gn[q] = *(const f32x4*)(F.in[26] + part * 16 + q * 4);
    for (int row = F.bid * NWAVES + F.wave; row < R; row += F.nb * NWAVES) {
        if (row % P < NCTX) continue;
        const size_t o = (size_t)row * D + lane * 16;
        const u32x4 a0 = *(const u32x4*)(OFF + o), a1 = *(const u32x4*)(OFF + o + 8), b0 = *(const u32x4*)(OFB + o), b1 = *(const u32x4*)(OFB + o + 8);
        const u32x4 g0 = *(const u32x4*)(ZIN + (size_t)row * 4096 + 3 * D + lane * 16), g1 = *(const u32x4*)(ZIN + (size_t)row * 4096 + 3 * D + lane * 16 + 8);
        float v[16];
        v[0] = bflo(a0.x) + bflo(b0.x); v[1] = bfhi(a0.x) + bfhi(b0.x); v[2] = bflo(a0.y) + bflo(b0.y); v[3] = bfhi(a0.y) + bfhi(b0.y);
        v[4] = bflo(a0.z) + bflo(b0.z); v[5] = bfhi(a0.z) + bfhi(b0.z); v[6] = bflo(a0.w) + bflo(b0.w); v[7] = bfhi(a0.w) + bfhi(b0.w);
        v[8] = bflo(a1.x) + bflo(b1.x); v[9] = bfhi(a1.x) + bfhi(b1.x); v[10] = bflo(a1.y) + bflo(b1.y); v[11] = bfhi(a1.y) + bfhi(b1.y);
        v[12] = bflo(a1.z) + bflo(b1.z); v[13] = bfhi(a1.z) + bfhi(b1.z); v[14] = bflo(a1.w) + bflo(b1.w); v[15] = bfhi(a1.w) + bfhi(b1.w);
        float ss = 0.f;
#pragma unroll
        for (int q = 0; q < 16; ++q) ss += v[q] * v[q];
        ss += dpp_xor1(ss); ss += dpp_xor2(ss); ss += __shfl_xor(ss, 4);
        const float rinv = rsqrtf(ss * (1.0f / 128.0f) + EPS);
        const unsigned gw[8] = {g0.x, g0.y, g0.z, g0.w, g1.x, g1.y, g1.z, g1.w};
        unsigned w[8];
#pragma unroll
        for (int q = 0; q < 8; ++q) w[q] = pkbf(v[2 * q] * rinv * gn[q >> 1][(2 * q) & 3] * bflo(gw[q]), v[2 * q + 1] * rinv * gn[q >> 1][(2 * q + 1) & 3] * bfhi(gw[q]));
        *(u32x4*)(O2 + o) = (u32x4){w[0], w[1], w[2], w[3]}; *(u32x4*)(O2 + o + 8) = (u32x4){w[4], w[5], w[6], w[7]};
    }
}

enum { PH_BASE = __COUNTER__ };
__global__ void __launch_bounds__(NTHREADS, 2) fwd(Args args) {
    extern __shared__ __attribute__((aligned(16))) unsigned char lds[];
    Frame F;
    F.lds = lds; F.wave = __builtin_amdgcn_readfirstlane((int)threadIdx.x >> 6); F.bid = blockIdx.x; F.nb = gridDim.x;
    REFRESH_(F);
    F.in = args.in; F.out = args.out; F.ws = args.ws;
    F.MOD = (float*)(args.ws + WS_MOD); F.AFF = (float*)(args.ws + WS_AFF); F.SEL = (int*)(args.ws + WS_SEL); F.GATE = (float*)(args.ws + WS_GATE); F.INV = (int*)(args.ws + WS_INV);
    F.X = (bf16*)(args.ws + WS_X); F.H = (bf16*)(args.ws + WS_H);
    const int lo = args.ph_lo, hi = args.ph_hi;
#if MK_SINGLE
    volatile LAS unsigned* misc = (volatile LAS unsigned*)((LAS unsigned char*)lds + LDS_MISC);
    if (F.tid < 64) misc[F.tid] = 0u;
    __syncthreads();
    XcdBarrier bar = xcd_barrier_post((unsigned*)(args.ws + WS_CTL) + CW_BAR, misc, F.tid);
#define SEAM(k) do { if ((k) + 1 < hi) xcd_barrier(bar, F.tid); } while (0)
#else
#define SEAM(k) do { } while (0)
#endif
#define PH(...) do { constexpr int k_ = __COUNTER__ - PH_BASE - 1; if (lo <= k_ && k_ < hi) { REFRESH_(F); __VA_ARGS__; SEAM(k_); } } while (0)
    bf16* HID = (bf16*)(F.ws + WS_HID); bf16* Y = (bf16*)(F.ws + WS_Y);
    PG8_LAS unsigned char* ring = (PG8_LAS unsigned char*)lds;
    bf16 *Qb = (bf16*)(F.ws + WS_Q), *VTb = (bf16*)(F.ws + WS_VT), *Ob = (bf16*)(F.ws + WS_O);

#define GEMM_PHASE(EPI, gA, lda_, gB, ldb_, gK, nM_, nN_, groups_, gsM_, ...) do { const pg8::Gemm g_{(const bf16*)(gA), (const bf16*)(gB), (lda_), (ldb_), (gK), nullptr}; pg8::GroupedOrder S_; S_.init((nM_), (nN_), (groups_), (gsM_), F.nb, F.bid); \
        const EPI E_{__VA_ARGS__}; pg8::gemm_phase<EPI, pg8::GroupedOrder, PG8_ALIGN, PG8_SP2>(ring, g_, S_, E_, F.tid); } while (0)
#define GEMM_PHASE_LAT(EPI, gA, lda_, gB, ldb_, gK, nN_, ...) do { const pg8::Gemm g_{(const bf16*)(gA), (const bf16*)(gB), (lda_), (ldb_), (gK), nullptr}; pg8::LatentOrder S_; S_.init((nN_), F.nb, F.bid); \
        const EPI E_{__VA_ARGS__}; pg8::gemm_phase<EPI, pg8::LatentOrder, PG8_ALIGN, PG8_SP2>(ring, g_, S_, E_, F.tid); } while (0)
#define GEMM_PHASE_GATHER(EPI, gA, lda_, gIdx, gB, ldb_, gK, nM_, nN_, groups_, gsM_, ...) do { const pg8::Gemm g_{(const bf16*)(gA), (const bf16*)(gB), (lda_), (ldb_), (gK), (gIdx)}; pg8::GroupedOrder S_; S_.init((nM_), (nN_), (groups_), (gsM_), F.nb, F.bid); \
        const EPI E_{__VA_ARGS__}; pg8::gemm_phase<EPI, pg8::GroupedOrder, PG8_ALIGN, PG8_SP2, true>(ring, g_, S_, E_, F.tid); } while (0)
#define MODL(L) (F.MOD + (size_t)(L) * 33 * 6144)
#define MOE_PHASES(L, NMT, NITEMS, SKIPC) \
    PH(ph_norm2<SKIPC>(F, (L))); \
    PH(ph_topk(F, (NITEMS))); \
    PH(GEMM_PHASE_GATHER(pg8::EpiSwigluT, F.H, D, F.SEL, F.ws + WO_GU, D, D, (NMT), 2 * FF / 256, NE, SLOTS / 256, HID, 2 * FF / 256, FF)); \
    PH(GEMM_PHASE(pg8::EpiDownT, HID, FF, F.ws + WO_DN, FF, FF, (NMT), D / 256, NE, SLOTS / 256, Y, F.GATE, D / 256));
#define OUT_PROJ(Asrc, Wsrc, L) PH(GEMM_PHASE(pg8::EpiResidT, (Asrc), D, (Wsrc), D, D, R / 256, D / 256, 1, R / 256, F.X, MODL(L)));

    PH(ph_prologue(F));
    PH(ph_norm<0, false, true, false, true>(F, 0, 0));
    PH(GEMM_PHASE(pg8::EpiF32G, F.ws + WS_AG, 768, F.ws + WS_S5W1, 512, 512, 2304 / 256, 1, 64, 2304 / 256, (float*)(F.ws + WS_SS), 256, 1));
    PH(ph_s5_scan(F));
    PH(GEMM_PHASE(pg8::EpiS5Out, F.ws + WS_AG, 768, F.ws + WS_S5W2, 768, 768, 2304 / 256, 2, 64, 2304 / 256, F.H, (bf16*)(F.ws + WS_Z), F.in[15]));
    PH(GEMM_PHASE(pg8::EpiGluT, F.ws + WS_Z, D, F.ws + WO_GLU, D, D, R / 256, 2 * D / 256, 1, R / 256, F.X, MODL(0)));
    MOE_PHASES(0, SLOTS / 256, NB * NE * 2, false)
    PH(ph_norm<0, true>(F, 1, 0); convert_moe(F, 1));
    PH(GEMM_PHASE(pg8::EpiBf16<0>, F.H, D, F.ws + WO_NAQKV, D, D, R / 256, 2 * D / 256, 1, R / 256, Qb, D, nullptr, D, (size_t)(WS_K - WS_Q) / 2, 1.0f);
       GEMM_PHASE(pg8::EpiVtT<false>, F.ws + WO_NAQKV + (size_t)2 * D * D * 2, D, F.H, D, D, D / 256, R / 256, 1, D / 256, VTb));
    PH(ph_na_attn(F));
    OUT_PROJ(Ob, F.ws + WO_NAO, 1)
    MOE_PHASES(1, SLOTS / 256, NB * NE * 2, false)
    PH(ph_norm<0, true>(F, 2, 1); convert_moe(F, 2));
    PH(GEMM_PHASE(pg8::EpiQKRope, F.H, D, F.ws + WO_DAQKV, D, D, R / 256, 2 * D / 256, 1, R / 256, Qb, (size_t)(WS_K - WS_Q) / 2, (const float*)(F.ws + WS_ROPE));
       GEMM_PHASE(pg8::EpiVtT<false>, F.ws + WO_DAQKV + (size_t)2 * D * D * 2, D, F.H, D, D, D / 256, R / 256, 1, D / 256, VTb));
    PH(ph_da_attn(F));
    OUT_PROJ(Ob, F.ws + WO_DAO, 2)
    MOE_PHASES(2, SLOTS / 256, NB * NE * 2, false)
    PH(ph_norm<0, true>(F, 3, 2); convert_moe(F, 3));
    PH({ const pg8::Gemm g_{(const bf16*)F.H, (const bf16*)(F.ws + WO_HGIN), D, D, D, nullptr}; pg8::HgInOrder S_; S_.init(F.nb, F.bid);
         const pg8::EpiHgIn E_{(bf16*)(F.ws + WS_ZIN), (const float*)(F.ws + WS_LB)}; pg8::gemm_phase<pg8::EpiHgIn, pg8::HgInOrder, PG8_ALIGN, PG8_SP2>(ring, g_, S_, E_, F.tid); }
       GEMM_PHASE(pg8::EpiVtT<true>, F.ws + WO_HGIN + (size_t)4 * D * D * 2, D, F.H, D, D, D / 256, R / 256, 1, D / 256, (bf16*)(F.ws + WS_VTG)));
    PH(ph_hgrn_scan(F));
    PH(ph_hgrn_post(F));
    PH(GEMM_PHASE_LAT(pg8::EpiResidT, F.ws + WS_O2, D, F.ws + WO_HGO, D, D, D / 256, F.X, MODL(3)));
    MOE_PHASES(3, NB, NB * NE, true)
    PH(ph_norm<2, true, false, true>(F, 0, 3));
}
constexpr int NPH = __COUNTER__ - PH_BASE - 1;

extern "C" void kernel_launch(void* const* d_in, const int* in_sizes, int n_in, void* d_out, int out_size, void* d_ws, size_t ws_size, hipStream_t stream) {
    static int grid = 0;
    if (grid == 0) {
        if (n_in != 33 || ws_size < WS_NEED) { fprintf(stderr, "kernel_launch: n_in %d ws %zu (need %zu)\n", n_in, ws_size, (size_t)WS_NEED); grid = -1; return; }
        int dev = 0, cus = 0;
        if (hipGetDevice(&dev) != hipSuccess || hipDeviceGetAttribute(&cus, hipDeviceAttributeMultiprocessorCount, dev) != hipSuccess) { grid = -1; return; }
        if (hipFuncSetAttribute((const void*)fwd, hipFuncAttributeMaxDynamicSharedMemorySize, LDS_BYTES) != hipSuccess) { fprintf(stderr, "kernel_launch: hipFuncSetAttribute failed\n"); grid = -1; return; }
        int per_cu = 0;
        if (hipOccupancyMaxActiveBlocksPerMultiprocessor(&per_cu, (const void*)fwd, NTHREADS, LDS_BYTES) != hipSuccess || per_cu < 1) fprintf(stderr, "kernel_launch: occupancy query says %d\n", per_cu);
        (void)hipGetLastError();
        grid = cus;
    }
    if (grid < 0) return;
    (void)hipMemsetAsync((char*)d_ws + WS_CTL + (size_t)CW_BAR * 4, 0, (size_t)XCD_BAR_WORDS * 4, stream);
    Args a{};
    for (int i = 0; i < 33; ++i) a.in[i] = (const float*)d_in[i];
    a.out = (float*)d_out; a.ws = (unsigned char*)d_ws;
#if MK_SINGLE
    a.ph_lo = 0; a.ph_hi = NPH;
    hipLaunchKernelGGL(fwd, dim3(grid), dim3(NTHREADS), LDS_BYTES, stream, a);
#else
    for (int k = 0; k < NPH; ++k) { a.ph_lo = k; a.ph_hi = k + 1; hipLaunchKernelGGL(fwd, dim3(grid), dim3(NTHREADS), LDS_BYTES, stream, a); }
#endif
}
```

```cpp
#include <hip/hip_runtime.h>
#include <cstdio>
#include <cstdint>

#ifndef MK_SINGLE
#define MK_SINGLE 1
#endif

typedef unsigned short bf16;
typedef float f32x4 __attribute__((ext_vector_type(4)));
typedef float f32x2 __attribute__((ext_vector_type(2)));
typedef unsigned u32x2 __attribute__((ext_vector_type(2)));
typedef unsigned u32x4 __attribute__((ext_vector_type(4)));
#define LAS __attribute__((address_space(3)))

constexpr int NB = 32, SEQ = 2048, NCTX = 256, D = 1024, P = NCTX + SEQ  , R = NB * P  ;
constexpr int NE = 16, FF = 2048, SLOTS = NB * 256 + NB * 32  ;
constexpr float EPS = 1e-6f;
constexpr float LOG2E_ = 1.4426950408889634f;
constexpr float LAM_INIT = 0.47071302f;
constexpr int NWAVES = 8, NTHREADS = 512;
constexpr int LDS_BYTES = 147456;
constexpr int LDS_MISC = 147456 - 256;

constexpr size_t MiB = 1u << 20;
constexpr size_t WS_CTL = 0, CTL_ZERO_BYTES = 1 * MiB;
constexpr size_t WS_MOD = 1 * MiB;
constexpr size_t WS_AFF = 5 * MiB;
constexpr size_t WS_SEL = 10 * MiB;
constexpr size_t WS_GATE = 11 * MiB;
constexpr size_t WS_INV = 12 * MiB;
constexpr size_t WS_X = 32 * MiB;
constexpr size_t WS_H = 320 * MiB;
constexpr size_t WS_W = 464 * MiB;
constexpr size_t WS_BIG = 720 * MiB;
constexpr size_t WS_HID = WS_BIG;
constexpr size_t WS_Y = WS_BIG + 576 * MiB;
constexpr size_t WS_XS = WS_BIG + 864 * MiB;
constexpr size_t WS_AG = WS_BIG;
constexpr size_t WS_SS = WS_BIG + 216 * MiB;
constexpr size_t WS_Z = WS_BIG + 360 * MiB;
constexpr size_t WS_S5W1 = WS_BIG + 504 * MiB;
constexpr size_t WS_S5W2 = WS_BIG + 520 * MiB;
constexpr size_t WS_S5A = WS_BIG + 568 * MiB;
constexpr size_t WS_Q = WS_BIG, WS_K = WS_BIG + 144 * MiB, WS_V = WS_BIG + 288 * MiB, WS_VT = WS_BIG + 432 * MiB, WS_O = WS_BIG + 576 * MiB;
constexpr size_t WS_ZIN = WS_BIG;
constexpr size_t WS_VTG = WS_BIG + 576 * MiB;
constexpr size_t WS_OFF = WS_BIG + 720 * MiB;
constexpr size_t WS_OFB = WS_BIG + 1008 * MiB;
constexpr size_t WS_O2 = WS_H;
constexpr size_t WS_LB = 17 * MiB;
constexpr size_t WS_ROPE = 18 * MiB;
constexpr size_t WS_NEED = 2048 * MiB;
constexpr size_t WO_GLU = WS_W, WO_NAQKV = WS_W + 4 * MiB, WO_NAO = WS_W + 10 * MiB, WO_DAQKV = WS_W + 12 * MiB, WO_DAO = WS_W + 18 * MiB, WO_HGIN = WS_W + 20 * MiB, WO_HGO = WS_W + 30 * MiB;
constexpr size_t WO_GU = WS_W + 32 * MiB  , WO_DN = WS_W + 160 * MiB  ;
constexpr int CW_BAR = 4096;

__device__ __forceinline__ unsigned f2bf(float f) { unsigned u = __builtin_bit_cast(unsigned, f); return (u + 0x7fffu + ((u >> 16) & 1u)) >> 16; }
__device__ __forceinline__ float bf2f(unsigned h) { return __builtin_bit_cast(float, h << 16); }
__device__ __forceinline__ unsigned pk2(float lo, float hi) { return f2bf(lo) | (f2bf(hi) << 16); }
typedef __bf16 bf16x2_t __attribute__((ext_vector_type(2)));
__device__ __forceinline__ unsigned pkbf(float lo, float hi) { const f32x2 v = {lo, hi}; return __builtin_bit_cast(unsigned, __builtin_convertvector(v, bf16x2_t)); }
__device__ __forceinline__ float bflo(unsigned w) { return __builtin_bit_cast(float, w << 16); }
__device__ __forceinline__ float bfhi(unsigned w) { return __builtin_bit_cast(float, w & 0xffff0000u); }
__device__ __forceinline__ float wave_sum(float v) {
#pragma unroll
    for (int o = 1; o < 64; o <<= 1) v += __shfl_xor(v, o);
    return v;
}
__device__ __forceinline__ float wave_max(float v) {
#pragma unroll
    for (int o = 1; o < 64; o <<= 1) v = fmaxf(v, __shfl_xor(v, o));
    return v;
}
__device__ __forceinline__ float sigmoidf_(float x) { return 1.0f / (1.0f + expf(-x)); }
__device__ __forceinline__ float siluf_(float x) { return x / (1.0f + expf(-x)); }
__device__ __forceinline__ float gelu_tanh(float x) { return 0.5f * x * (1.0f + tanhf(0.7978845608028654f * (x + 0.044715f * x * x * x))); }
__device__ __forceinline__ float dpp_xor1(float v) { return __builtin_bit_cast(float, __builtin_amdgcn_update_dpp(0, __builtin_bit_cast(int, v), 0xB1, 0xF, 0xF, true)); }
__device__ __forceinline__ float dpp_xor2(float v) { return __builtin_bit_cast(float, __builtin_amdgcn_update_dpp(0, __builtin_bit_cast(int, v), 0x4E, 0xF, 0xF, true)); }
__device__ __forceinline__ float reduce16(float (&v)[16], int lane) {
    const bool b0 = lane & 1, b1 = lane & 2, b2 = lane & 4, b3 = lane & 8;
    float a[8];
#pragma unroll
    for (int k = 0; k < 8; ++k) { const float snd = b0 ? v[k] : v[8 + k], kep = b0 ? v[8 + k] : v[k]; a[k] = kep + dpp_xor1(snd); }
    float c[4];
#pragma unroll
    for (int k = 0; k < 4; ++k) { const float snd = b1 ? a[k] : a[4 + k], kep = b1 ? a[4 + k] : a[k]; c[k] = kep + dpp_xor2(snd); }
    float d[2];
#pragma unroll
    for (int k = 0; k < 2; ++k) { const float snd = b2 ? c[k] : c[2 + k], kep = b2 ? c[2 + k] : c[k]; d[k] = kep + __shfl_xor(snd, 4); }
    float r = (b3 ? d[1] : d[0]) + __shfl_xor(b3 ? d[0] : d[1], 8);
    r += __shfl_xor(r, 16); r += __shfl_xor(r, 32);
    return r;
}
#define WAVE_LDS_SYNC() asm volatile("s_waitcnt lgkmcnt(0)" ::: "memory")

#define XB_TMO      128
#define XB_XCNT(j)  (256  + 64 * (j))
#define XB_XSUB(j)  (1280 + 64 * (j))
#define XB_XGEN(j)  (2304 + 64 * (j))
#define XB_TOP      3328
#define XB_TOPGEN   3392
#define XCD_BAR_WORDS 3456
#define XB_SPIN_CAP (1u << 27)
__device__ __forceinline__ unsigned xb_ld(unsigned* p)              { return __hip_atomic_load(p, __ATOMIC_RELAXED, __HIP_MEMORY_SCOPE_AGENT); }
__device__ __forceinline__ unsigned xb_add(unsigned* p, unsigned v) { return __hip_atomic_fetch_add(p, v, __ATOMIC_RELAXED, __HIP_MEMORY_SCOPE_AGENT); }
__device__ __forceinline__ unsigned xb_xcc_id() { return (unsigned)__builtin_amdgcn_s_getreg((3 << 11) | 20) & 0xFu; }
#define XB_SPIN(cond, bar) do { unsigned _sp = 0; while (cond) { __builtin_amdgcn_s_sleep(1); \
    if ((++_sp & 255u) == 0u) { if (xb_ld(&(bar)[XB_TMO])) break; if (_sp > XB_SPIN_CAP) { atomicAdd(&(bar)[XB_TMO], 1u); break; } } } } while (0)
struct XcdBarrier { unsigned* bar; unsigned x; volatile LAS unsigned* st; };
__device__ __forceinline__ XcdBarrier xcd_barrier_post(unsigned* bar, volatile LAS unsigned* st, int tid_) {
    XcdBarrier b; b.bar = bar; b.x = xb_xcc_id(); b.st = st;
    if (tid_ == 0) (void)xb_add(&bar[XB_XCNT(b.x)], 1u);
    return b;
}
__device__ __forceinline__ void xcd_barrier_complete(unsigned* bar, unsigned x, unsigned& nloc, unsigned& nx) {
    const unsigned G = gridDim.x * gridDim.y * gridDim.z;
    unsigned sum, cnt, mine, sp = 0u;
    for (;;) {
        sum = 0u; cnt = 0u; mine = 0u;
#pragma unroll
        for (unsigned j = 0; j < 16; ++j) { const unsigned c = xb_ld(&bar[XB_XCNT(j)]); sum += c; cnt += (c > 0u) ? 1u : 0u; mine = (j == x) ? c : mine; }
        if (sum == G) break;
        __builtin_amdgcn_s_sleep(1);
        if ((++sp & 255u) == 0u) { if (xb_ld(&bar[XB_TMO])) break; if (sp > XB_SPIN_CAP) { atomicAdd(&bar[XB_TMO], 1u); break; } }
    }
    nloc = mine > 0u ? mine : 1u; nx = cnt > 0u ? cnt : 1u;
}
__device__ __forceinline__ void xcd_barrier(const XcdBarrier& b, int tid_) {
    asm volatile("s_waitcnt vmcnt(0)" ::: "memory");
    __syncthreads();
    if (tid_ == 0) {
        unsigned* bar = b.bar;
        __builtin_amdgcn_s_waitcnt(0);
        unsigned nloc = b.st[0], nx = b.st[1];
        if (nloc == 0u) { xcd_barrier_complete(bar, b.x, nloc, nx); b.st[0] = nloc; b.st[1] = nx; }
        const unsigned old = xb_add(&bar[XB_XSUB(b.x)], 1u);
        const unsigned gen = old / nloc;
        if (old + 1u == (gen + 1u) * nloc) {
            __builtin_amdgcn_fence(__ATOMIC_RELEASE, "agent");
            asm volatile("s_waitcnt vmcnt(0)" ::: "memory");
            const unsigned og = xb_add(&bar[XB_TOP], 1u);
            const unsigned tg = og / nx;
            if (og + 1u == (tg + 1u) * nx) xb_add(&bar[XB_TOPGEN], 1u);
            else XB_SPIN(xb_ld(&bar[XB_TOPGEN]) == tg, bar);
            __builtin_amdgcn_fence(__ATOMIC_ACQUIRE, "agent");
            xb_add(&bar[XB_XGEN(b.x)], 1u);
            asm volatile("s_waitcnt vmcnt(0)" ::: "memory");
        } else {
            XB_SPIN(xb_ld(&bar[XB_XGEN(b.x)]) == gen, bar);
            __builtin_amdgcn_fence(__ATOMIC_ACQUIRE, "agent");
            asm volatile("s_waitcnt vmcnt(0)" ::: "memory");
        }
    }
    __syncthreads();
}

namespace pg8 {
#define PG8_LAS __attribute__((address_space(3)))
typedef unsigned short bf16_t;
typedef short bf16x8 __attribute__((ext_vector_type(8)));
typedef float f32x4 __attribute__((ext_vector_type(4)));
typedef unsigned u32x4 __attribute__((ext_vector_type(4)));
constexpr int BM = 256, BK = 64, HALF = 128, HTB = HALF * BK * 2  , STAGE_BYTES = 8 * HTB, NXCD = 8, WGM = 8;

__host__ __device__ __forceinline__ int lds_byte(int r, int c) { const int st = (r >> 4) * 2 + (c >> 5), rr = r & 15, cc = c & 31, ob = rr * 64 + cc * 2; return st * 1024 + (ob ^ (((ob >> 9) & 1) << 5)); }
__host__ __device__ __forceinline__ void stage_rc(int b, int& R, int& C) { const int st = b / 1024, sb = b % 1024, swz = sb ^ (((sb >> 9) & 1) << 5); R = (st >> 1) * 16 + swz / 64; C = (st & 1) * 32 + (swz % 64) / 2; }
__host__ __device__ __forceinline__ int perm32(int rho) { const int n = rho >> 4, i = rho & 15; return 8 * (i >> 2) + 4 * n + (i & 3); }

struct Unit { int pm, pn; };
struct Gemm { const bf16_t* A; const bf16_t* Bt; int lda, ldb, K; const int* rowidx; };

struct StaticOrder {
    int nM, nN, nwg, G, c;
    __host__ __device__ void init(int M, int N, int G_, int c_) { nM = M / BM; nN = N / BM; nwg = nM * nN; G = G_; c = c_; }
    __host__ __device__ bool next(int i, Unit& u) const {
        const long L = (long)i * G + c; if (L >= nwg) return false;
        int wgid = (int)L; { const int q = nwg / NXCD, r = nwg % NXCD, xcd = wgid % NXCD, off = wgid / NXCD; wgid = (xcd < r ? xcd * (q + 1) : r * (q + 1) + (xcd - r) * q) + off; }
        const int nig = WGM * nN, gid = wgid / nig, fm = gid * WGM, gsz = (nM - fm) < WGM ? (nM - fm) : WGM;
        u.pm = fm + ((wgid % nig) % gsz); u.pn = (wgid % nig) / gsz; return true;
    }
    __device__ __forceinline__ void a_ready(const Unit&) const {}
    __device__ __forceinline__ void done(const Unit&) const {}
};

__device__ __forceinline__ unsigned cvt_pk_bf16(float lo, float hi) { unsigned r; asm volatile("v_cvt_pk_bf16_f32 %0, %1, %2" : "=v"(r) : "v"(lo), "v"(hi)); return r; }
typedef float f32x2 __attribute__((ext_vector_type(2)));
__device__ __forceinline__ f32x2 gelu_pk(f32x2 v) {
    const f32x2 av = __builtin_elementwise_abs(v), d = av * 0.2316418882f + 1.0f;
    f32x2 t; t.x = __builtin_amdgcn_rcpf(d.x); t.y = __builtin_amdgcn_rcpf(d.y);
    f32x2 q = t * 0.5307027145f + (-0.7265760135f); q = q * t + 0.7107068705f; q = q * t + (-0.142248368f); q = q * t + 0.127414796f; q = q * t;
    const f32x2 s = (v * v) * (-0.72134752044f);
    f32x2 e; e.x = __builtin_amdgcn_exp2f(s.x); e.y = __builtin_amdgcn_exp2f(s.y);
    const f32x2 m = v * (q * e), r = v - m;
    f32x2 o; o.x = v.x < 0.f ? m.x : r.x; o.y = v.y < 0.f ? m.y : r.y; return o;
}

template <int ACT  > struct EpiBf16 {
    static constexpr bool PERM = true, AFTER_DRAIN = false; static_assert(ACT == 0 || ACT == 1, "EpiBf16: ACT is 0 (none) or 1 (gelu_pk)");
    bf16_t* O; int ldc; const float* bias; int split_cols; size_t split_stride; float scale0;
    __device__ __forceinline__ void operator()(const f32x4 (&acc)[2][2][4][2], const Unit& u, int wr, int wc, int fr, int fq) const {
        const int row0 = u.pm * BM + wr * 64 + fr; int colt = u.pn * BM; bf16_t* base = O;
        float sc = 1.f; if (split_cols) { const int t = colt / split_cols; base += (size_t)t * split_stride; colt -= t * split_cols; if (t == 0) sc = scale0; }
        const int col0 = colt + wc * 32 + 8 * fq, bcol0 = u.pn * BM + wc * 32 + 8 * fq;
        f32x4 bv[2][2];
#pragma unroll
        for (int bj = 0; bj < 2; ++bj)
#pragma unroll
            for (int n = 0; n < 2; ++n) bv[bj][n] = bias ? *(const f32x4*)(bias + bcol0 + bj * HALF + 4 * n) : (f32x4){0.f, 0.f, 0.f, 0.f};
#pragma unroll
        for (int ai = 0; ai < 2; ++ai)
#pragma unroll
            for (int m = 0; m < 4; ++m) { bf16_t* rowp = base + (size_t)(row0 + ai * HALF + m * 16) * ldc + col0;
#pragma unroll
                for (int bj = 0; bj < 2; ++bj) { f32x4 v0 = acc[ai][bj][m][0] + bv[bj][0], v1 = acc[ai][bj][m][1] + bv[bj][1];
                    if (ACT == 1) { f32x2 a = gelu_pk((f32x2){v0[0], v0[1]}), b = gelu_pk((f32x2){v0[2], v0[3]}), c = gelu_pk((f32x2){v1[0], v1[1]}), d = gelu_pk((f32x2){v1[2], v1[3]});
                        v0 = (f32x4){a.x, a.y, b.x, b.y}; v1 = (f32x4){c.x, c.y, d.x, d.y}; }
                    v0 = v0 * sc; v1 = v1 * sc; u32x4 w; w.x = cvt_pk_bf16(v0[0], v0[1]); w.y = cvt_pk_bf16(v0[2], v0[3]); w.z = cvt_pk_bf16(v1[0], v1[1]); w.w = cvt_pk_bf16(v1[2], v1[3]);
                    *(u32x4*)(rowp + bj * HALF) = w; } }
    }
};


struct GroupedOrder {
    int nM, nN, groups, gsM, G, c, total;
    __host__ __device__ void init(int nM_, int nN_, int groups_, int gsM_, int G_, int c_) { nM = nM_; nN = nN_; groups = groups_; gsM = gsM_; G = G_; c = c_; total = nM * nN * groups; }
    __host__ __device__ bool next(int i, Unit& u) const {
        const long L = (long)i * G + c; if (L >= total) return false;
        int T = (int)L; { const int q = total / NXCD, r = total % NXCD, xcd = T % NXCD, off = T / NXCD; T = (xcd < r ? xcd * (q + 1) : r * (q + 1) + (xcd - r) * q) + off; }
        const int tpg = nM * nN, g = T / tpg, t = T - g * tpg;
        const int nig = WGM * nN, gid = t / nig, fm = gid * WGM, gsz = (nM - fm) < WGM ? (nM - fm) : WGM;
        u.pm = g * gsM + fm + ((t % nig) % gsz); u.pn = g * nN + (t % nig) / gsz; return true;
    }
    __device__ __forceinline__ void a_ready(const Unit&) const {}
    __device__ __forceinline__ void done(const Unit&) const {}
};
struct LatentOrder {
    GroupedOrder o;
    __host__ __device__ void init(int nN_, int G_, int c_) { o.init(256, nN_, 1, 256, G_, c_); }
    __host__ __device__ bool next(int i, Unit& u) const { if (!o.next(i, u)) return false; u.pm += (u.pm >> 3) + 1; return true; }
    __device__ __forceinline__ void a_ready(const Unit&) const {}
    __device__ __forceinline__ void done(const Unit&) const {}
};
struct HgInOrder {
    LatentOrder lat; int G, c;
    __host__ __device__ void init(int G_, int c_) { lat.init(16, G_, c_); G = G_; c = c_; }
    __host__ __device__ bool next(int i, Unit& u) const {
        const long L = (long)i * G + c;
        if (L < 4096) return lat.next(i, u);
        const int t = (int)L - 4096; if (t >= 256) return false;
        u.pm = (t >> 3) * 9; u.pn = 4 + (t & 7); return true;
    }
    __device__ __forceinline__ void a_ready(const Unit&) const {}
    __device__ __forceinline__ void done(const Unit&) const {}
};
__device__ __forceinline__ float sigm(float x) { return __builtin_amdgcn_rcpf(1.0f + __builtin_amdgcn_exp2f(x * -1.4426950408889634f)); }
constexpr int PP = 2304, DD = 1024;
__device__ __forceinline__ int mrow_of(int row) { const int b = row / PP, pos = row - b * PP; return pos < 256 ? 32 : b; }
struct EpiResidT {
    static constexpr bool PERM = false, AFTER_DRAIN = false;
    bf16_t* X; const float* MODL;
    __device__ __forceinline__ void operator()(const f32x4 (&acc)[2][2][4][2], const Unit& u, int wr, int wc, int fr, int fq) const {
        const int row0 = u.pm * BM + wr * 64 + fr, col0 = u.pn * BM + wc * 32 + 4 * fq;
        const float* g = MODL + (size_t)mrow_of(u.pm * BM) * 6144 + 2 * DD + col0;
        f32x4 gt[2][2];
#pragma unroll
        for (int bj = 0; bj < 2; ++bj)
#pragma unroll
            for (int n = 0; n < 2; ++n) gt[bj][n] = *(const f32x4*)(g + bj * HALF + n * 16);
#pragma unroll
        for (int ai = 0; ai < 2; ++ai)
#pragma unroll
            for (int m = 0; m < 4; ++m) { const int row = row0 + ai * HALF + m * 16; bf16_t* x = X + (size_t)row * DD + col0;
                u32x2 xo[2][2];
#pragma unroll
                for (int bj = 0; bj < 2; ++bj)
#pragma unroll
                    for (int n = 0; n < 2; ++n) xo[bj][n] = *(const u32x2*)(x + bj * HALF + n * 16);
#pragma unroll
                for (int bj = 0; bj < 2; ++bj)
#pragma unroll
                    for (int n = 0; n < 2; ++n) { const int o = bj * HALF + n * 16; const f32x4 xv = {bflo(xo[bj][n].x), bfhi(xo[bj][n].x), bflo(xo[bj][n].y), bfhi(xo[bj][n].y)};
                        const f32x4 r = xv + gt[bj][n] * acc[ai][bj][m][n]; u32x2 w; w.x = pkbf(r.x, r.y); w.y = pkbf(r.z, r.w); *(u32x2*)(x + o) = w; } }
    }
};
struct EpiGluT {
    static constexpr bool PERM = true, AFTER_DRAIN = false;
    bf16_t* X; const float* MODL;
    __device__ __forceinline__ void operator()(const f32x4 (&acc)[2][2][4][2], const Unit& u, int wr, int wc, int fr, int fq) const {
        const int row0 = u.pm * BM + wr * 64 + fr, f0 = u.pn * 128 + wc * 32 + 8 * fq;
        const float* g = MODL + (size_t)mrow_of(u.pm * BM) * 6144 + 2 * DD + f0;
        const f32x4 gt[2] = {*(const f32x4*)g, *(const f32x4*)(g + 4)};
#pragma unroll
        for (int ai = 0; ai < 2; ++ai)
#pragma unroll
            for (int m = 0; m < 4; ++m) { const int row = row0 + ai * HALF + m * 16; bf16_t* x = X + (size_t)row * DD + f0;
                const u32x4 xo = *(const u32x4*)x; u32x4 w;
#pragma unroll
                for (int n = 0; n < 2; ++n) { const f32x4 a = acc[ai][0][m][n], b = acc[ai][1][m][n]; f32x4 v = b * -1.4426950408889634f;
#pragma unroll
                    for (int q = 0; q < 4; ++q) v[q] = __builtin_amdgcn_exp2f(v[q]);
                    v = v + 1.0f;
#pragma unroll
                    for (int q = 0; q < 4; ++q) v[q] = __builtin_amdgcn_rcpf(v[q]);
                    v = v * a;
                    const unsigned x01 = n ? xo.z : xo.x, x23 = n ? xo.w : xo.y; const f32x4 xv = {bflo(x01), bfhi(x01), bflo(x23), bfhi(x23)};
                    const f32x4 r = xv + gt[n] * v; if (n) { w.z = pkbf(r.x, r.y); w.w = pkbf(r.z, r.w); } else { w.x = pkbf(r.x, r.y); w.y = pkbf(r.z, r.w); } }
                *(u32x4*)x = w; }
    }
};
struct EpiSwigluT {
    static constexpr bool PERM = true, AFTER_DRAIN = false;
    bf16_t* HID; int nNg; int ldh;
    __device__ __forceinline__ void operator()(const f32x4 (&acc)[2][2][4][2], const Unit& u, int wr, int wc, int fr, int fq) const {
        const int row0 = u.pm * BM + wr * 64 + fr, f0 = (u.pn % nNg) * 128 + wc * 32 + 8 * fq;
#pragma unroll
        for (int ai = 0; ai < 2; ++ai)
#pragma unroll
            for (int m = 0; m < 4; ++m) { bf16_t* hp = HID + (size_t)(row0 + ai * HALF + m * 16) * ldh + f0;
                const f32x4 a0 = acc[ai][0][m][0], a1 = acc[ai][0][m][1], b0 = acc[ai][1][m][0], b1 = acc[ai][1][m][1];
                f32x4 e0 = a0 * -1.4426950408889634f, e1 = a1 * -1.4426950408889634f;
#pragma unroll
                for (int q = 0; q < 4; ++q) { e0[q] = __builtin_amdgcn_exp2f(e0[q]); e1[q] = __builtin_amdgcn_exp2f(e1[q]); }
                e0 = e0 + 1.0f; e1 = e1 + 1.0f;
#pragma unroll
                for (int q = 0; q < 4; ++q) { e0[q] = __builtin_amdgcn_rcpf(e0[q]); e1[q] = __builtin_amdgcn_rcpf(e1[q]); }
                const f32x4 o0 = (a0 * b0) * e0, o1 = (a1 * b1) * e1;
                u32x4 w; w.x = cvt_pk_bf16(o0.x, o0.y); w.y = cvt_pk_bf16(o0.z, o0.w); w.z = cvt_pk_bf16(o1.x, o1.y); w.w = cvt_pk_bf16(o1.z, o1.w);
                *(u32x4*)hp = w; }
    }
};
struct EpiDownT {
    static constexpr bool PERM = true, AFTER_DRAIN = false;
    bf16_t* Y; const float* GATE; int nNg;
    __device__ __forceinline__ void operator()(const f32x4 (&acc)[2][2][4][2], const Unit& u, int wr, int wc, int fr, int fq) const {
        const int row0 = u.pm * BM + wr * 64 + fr, col0 = (u.pn % nNg) * BM + wc * 32 + 8 * fq;
#pragma unroll
        for (int ai = 0; ai < 2; ++ai)
#pragma unroll
            for (int m = 0; m < 4; ++m) { const int row = row0 + ai * HALF + m * 16; bf16_t* rowp = Y + (size_t)row * DD + col0;
#pragma unroll
                for (int bj = 0; bj < 2; ++bj) { const f32x4 v0 = acc[ai][bj][m][0], v1 = acc[ai][bj][m][1];
                    u32x4 w; w.x = cvt_pk_bf16(v0[0], v0[1]); w.y = cvt_pk_bf16(v0[2], v0[3]); w.z = cvt_pk_bf16(v1[0], v1[1]); w.w = cvt_pk_bf16(v1[2], v1[3]);
                    *(u32x4*)(rowp + bj * HALF) = w; } }
    }
};
template <bool SILU> struct EpiVtT {
    static constexpr bool PERM = true, AFTER_DRAIN = false;
    bf16_t* VT;
    __device__ __forceinline__ void operator()(const f32x4 (&acc)[2][2][4][2], const Unit& u, int wr, int wc, int fr, int fq) const {
        const int hd0 = u.pm * BM + wr * 64 + fr, tok0 = u.pn * BM + wc * 32 + 8 * fq, b = (u.pn * BM) / PP, pos0 = tok0 - b * PP;
#pragma unroll
        for (int ai = 0; ai < 2; ++ai)
#pragma unroll
            for (int m = 0; m < 4; ++m) { bf16_t* rowp = VT + ((size_t)b * DD + hd0 + ai * HALF + m * 16) * PP + pos0;
#pragma unroll
                for (int bj = 0; bj < 2; ++bj) { f32x4 v0 = acc[ai][bj][m][0], v1 = acc[ai][bj][m][1];
                    if (SILU) {
#pragma unroll
                        for (int q = 0; q < 4; ++q) { v0[q] = v0[q] * sigm(v0[q]); v1[q] = v1[q] * sigm(v1[q]); } }
                    u32x4 w; w.x = cvt_pk_bf16(v0[0], v0[1]); w.y = cvt_pk_bf16(v0[2], v0[3]); w.z = cvt_pk_bf16(v1[0], v1[1]); w.w = cvt_pk_bf16(v1[2], v1[3]);
                    *(u32x4*)(rowp + bj * HALF) = w; } }
    }
};
struct EpiHgIn {
    static constexpr bool PERM = true, AFTER_DRAIN = false;
    bf16_t* O; const float* LB;
    __device__ __forceinline__ void operator()(const f32x4 (&acc)[2][2][4][2], const Unit& u, int wr, int wc, int fr, int fq) const {
        const int row0 = u.pm * BM + wr * 64 + fr, col0 = u.pn * BM + wc * 32 + 8 * fq, type = u.pn >> 2;
        f32x4 lb[2][2];
#pragma unroll
        for (int bj = 0; bj < 2; ++bj) { const int c = (col0 + bj * HALF) & 1023; lb[bj][0] = *(const f32x4*)(LB + c); lb[bj][1] = *(const f32x4*)(LB + c + 4); }
#pragma unroll
        for (int ai = 0; ai < 2; ++ai)
#pragma unroll
            for (int m = 0; m < 4; ++m) { bf16_t* rowp = O + (size_t)(row0 + ai * HALF + m * 16) * 4096 + col0;
#pragma unroll
                for (int bj = 0; bj < 2; ++bj) { f32x4 v0 = acc[ai][bj][m][0], v1 = acc[ai][bj][m][1];
                    if (type == 1 || type == 2) { const f32x4 l0 = lb[bj][0], l1 = lb[bj][1];
#pragma unroll
                        for (int q = 0; q < 4; ++q) { v0[q] = __log2f(l0[q] + (1.0f - l0[q]) * sigm(v0[q])); v1[q] = __log2f(l1[q] + (1.0f - l1[q]) * sigm(v1[q])); } }
                    else if (type == 3) {
#pragma unroll
                        for (int q = 0; q < 4; ++q) { v0[q] = v0[q] * sigm(v0[q]); v1[q] = v1[q] * sigm(v1[q]); } }
                    u32x4 w; w.x = cvt_pk_bf16(v0[0], v0[1]); w.y = cvt_pk_bf16(v0[2], v0[3]); w.z = cvt_pk_bf16(v1[0], v1[1]); w.w = cvt_pk_bf16(v1[2], v1[3]);
                    *(u32x4*)(rowp + bj * HALF) = w; } }
    }
};


struct EpiF32G {
    static constexpr bool PERM = false, AFTER_DRAIN = false;
    float* C; int ldc; int nNg;
    __device__ __forceinline__ void operator()(const f32x4 (&acc)[2][2][4][2], const Unit& u, int wr, int wc, int fr, int fq) const {
        const int row0 = u.pm * BM + wr * 64 + fr, col0 = (u.pn % nNg) * BM + wc * 32 + 4 * fq;
#pragma unroll
        for (int ai = 0; ai < 2; ++ai)
#pragma unroll
            for (int m = 0; m < 4; ++m) { float* rowp = C + (size_t)(row0 + ai * HALF + m * 16) * ldc + col0;
#pragma unroll
                for (int bj = 0; bj < 2; ++bj)
#pragma unroll
                    for (int n = 0; n < 2; ++n) *(f32x4*)(rowp + bj * HALF + n * 16) = acc[ai][bj][m][n]; }
    }
};
__device__ __forceinline__ float gelu_t(float x) { const float t = 1.5957691216057308f * (x + 0.044715f * x * x * x); return x * sigm(t); }
struct EpiS5Out {
    static constexpr bool PERM = true, AFTER_DRAIN = false;
    const bf16_t* H; bf16_t* Z; const float* dvec;
    __device__ __forceinline__ void operator()(const f32x4 (&acc)[2][2][4][2], const Unit& u, int wr, int wc, int fr, int fq) const {
        const int c0 = (u.pn & 1) * BM + wc * 32 + 8 * fq;
        const int g = (u.pm * BM) / 2304;
        f32x4 dv[2][2];
#pragma unroll
        for (int bj = 0; bj < 2; ++bj) { const int k0 = (c0 + bj * HALF) & 15; dv[bj][0] = *(const f32x4*)(dvec + g * 16 + k0); dv[bj][1] = *(const f32x4*)(dvec + g * 16 + k0 + 4); }
#pragma unroll
        for (int ai = 0; ai < 2; ++ai)
#pragma unroll
            for (int m = 0; m < 4; ++m) {
                const int rg = u.pm * BM + ai * HALF + wr * 64 + m * 16 + fr, rem = rg - g * 2304, b = rem / 72, j = rem - b * 72;
#pragma unroll
                for (int bj = 0; bj < 2; ++bj) {
                    const int mc = c0 + bj * HALF, tau = mc >> 4, k0 = mc & 15;
                    const size_t off = ((size_t)b * PP + 32 * j + tau) * DD + g * 16 + k0;
                    const u32x4 uw = *(const u32x4*)(H + off);
                    const f32x4 d0 = dv[bj][0], d1 = dv[bj][1];
                    const f32x4 y0 = acc[ai][bj][m][0], y1 = acc[ai][bj][m][1];
                    u32x4 w;
                    w.x = cvt_pk_bf16(gelu_t(y0[0] + d0[0] * __uint_as_float(uw.x << 16)), gelu_t(y0[1] + d0[1] * __uint_as_float(uw.x & 0xffff0000u)));
                    w.y = cvt_pk_bf16(gelu_t(y0[2] + d0[2] * __uint_as_float(uw.y << 16)), gelu_t(y0[3] + d0[3] * __uint_as_float(uw.y & 0xffff0000u)));
                    w.z = cvt_pk_bf16(gelu_t(y1[0] + d1[0] * __uint_as_float(uw.z << 16)), gelu_t(y1[1] + d1[1] * __uint_as_float(uw.z & 0xffff0000u)));
                    w.w = cvt_pk_bf16(gelu_t(y1[2] + d1[2] * __uint_as_float(uw.w << 16)), gelu_t(y1[3] + d1[3] * __uint_as_float(uw.w & 0xffff0000u)));
                    *(u32x4*)(Z + off) = w;
                }
            }
    }
};


struct EpiQKRope {
    static constexpr bool PERM = true, AFTER_DRAIN = false;
    bf16_t* Q; size_t kstride; const float* T;
    __device__ __forceinline__ void operator()(const f32x4 (&acc)[2][2][4][2], const Unit& u, int wr, int wc, int fr, int fq) const {
        const int row0 = u.pm * BM + wr * 64 + fr; int colt = u.pn * BM; bf16_t* base = Q;
        { const int t = colt / DD; base += (size_t)t * kstride; colt -= t * DD; }
        const int col0 = colt + wc * 32 + 8 * fq, half = wc & 1; const bool first = fq < 2;
        const int tb = (u.pm * BM) / PP;
        const float qs = u.pn * BM < DD ? 0.125f * 1.4426950408889634f : 1.0f;
#pragma unroll
        for (int ai = 0; ai < 2; ++ai)
#pragma unroll
            for (int m = 0; m < 4; ++m) { const int row = row0 + ai * HALF + m * 16, pos = row - tb * PP, tt = pos - 256; const bool lat = pos >= 256;
                const int p = lat ? (half ? (tt & 63) : (tt >> 6)) : 0;
                const f32x4* cs = (const f32x4*)(T + (p * 16 + 8 * (fq & 1)) * 2);
                const f32x4 t0 = cs[0], t1 = cs[1], t2 = cs[2], t3 = cs[3];
                bf16_t* rowp = base + (size_t)row * DD + col0;
#pragma unroll
                for (int bj = 0; bj < 2; ++bj) { f32x4 v0 = acc[ai][bj][m][0] * qs, v1 = acc[ai][bj][m][1] * qs;
                    f32x4 p0, p1;
#pragma unroll
                    for (int q = 0; q < 4; ++q) { p0[q] = __shfl_xor(v0[q], 32); p1[q] = __shfl_xor(v1[q], 32); }
                    if (lat) { const float sg = first ? -1.0f : 1.0f;
                        v0 = (f32x4){v0[0] * t0[0] + sg * p0[0] * t0[1], v0[1] * t0[2] + sg * p0[1] * t0[3], v0[2] * t1[0] + sg * p0[2] * t1[1], v0[3] * t1[2] + sg * p0[3] * t1[3]};
                        v1 = (f32x4){v1[0] * t2[0] + sg * p1[0] * t2[1], v1[1] * t2[2] + sg * p1[1] * t2[3], v1[2] * t3[0] + sg * p1[2] * t3[1], v1[3] * t3[2] + sg * p1[3] * t3[3]}; }
                    u32x4 w; w.x = cvt_pk_bf16(v0[0], v0[1]); w.y = cvt_pk_bf16(v0[2], v0[3]); w.z = cvt_pk_bf16(v1[0], v1[1]); w.w = cvt_pk_bf16(v1[2], v1[3]);
                    *(u32x4*)(rowp + bj * HALF) = w; } }
    }
};

template <class Epi, class Sched, bool ALIGN_EPI = false, bool SP2 = false, bool GATHER = false>
__device__ __forceinline__ void gemm_phase(PG8_LAS unsigned char* lds, const Gemm g, const Sched& S, const Epi& E, const int tid) {
    const int wid = __builtin_amdgcn_readfirstlane(tid >> 6), lane = tid & 63, wr = wid >> 2, wc = wid & 3, fr = lane & 15, fq = lane >> 4;
    const int K = g.K, nt = K / BK;
    unsigned voffA[2], voffB[2];
#pragma unroll
    for (int i = 0; i < 2; ++i) { int R, C; stage_rc(tid * 16 + i * 8192, R, C); const int Rb = Epi::PERM ? ((R & ~31) + perm32(R & 31)) : R;
        voffA[i] = (unsigned)(R * g.lda + C) * 2u; voffB[i] = (unsigned)(Rb * g.ldb + C) * 2u; }
    unsigned vA0[2] = {0u, 0u}, vA1[2] = {0u, 0u}, wA0[2] = {0u, 0u}, wA1[2] = {0u, 0u};
#define PG8_GOFF(u_, o0, o1) do { _Pragma("unroll") for (int i = 0; i < 2; ++i) { int R, C; stage_rc(tid * 16 + i * 8192, R, C); const int r0_ = (u_).pm * BM + R; \
        o0[i] = ((unsigned)g.rowidx[r0_] * (unsigned)g.lda + (unsigned)C) * 2u; o1[i] = ((unsigned)g.rowidx[r0_ + HALF] * (unsigned)g.lda + (unsigned)C) * 2u; } } while (0)
    const size_t kstep = (size_t)(BK * 2);
    const size_t hstepA = (size_t)HALF * g.lda * 2, hstepB = (size_t)HALF * g.ldb * 2;
    const size_t tstepA = 2 * hstepA, tstepB = 2 * hstepB;
    const unsigned ldsw = (unsigned)wid * 1024u;
    const int aoff = lds_byte(wr * 64 + fr, fq * 8), boff = lds_byte(wc * 32 + fr, fq * 8);
#define PG8_SA(b, h) (((b) * 2 + (h)) * HTB)
#define PG8_SB(b, h) ((4 + (b) * 2 + (h)) * HTB)
#define PG8_STAGE(bufoff, gbase, voff) do { _Pragma("unroll") for (int _i = 0; _i < 2; ++_i) \
        __builtin_amdgcn_global_load_lds((const unsigned*)((const char*)(gbase) + (voff)[_i]), (PG8_LAS unsigned*)(lds + (bufoff) + ldsw + _i * 8192), 16, 0, 0); } while (0)
#define PG8_STAGEA(bufoff, kptr, h, oc0, oc1) do { if constexpr (GATHER) { if (h) PG8_STAGE(bufoff, kptr, oc1); else PG8_STAGE(bufoff, kptr, oc0); } else { PG8_STAGE(bufoff, (kptr) + ((h) ? hstepA : 0), voffA); } } while (0)
#define PG8_LDA(dst, b, h) do { _Pragma("unroll") for (int m = 0; m < 4; ++m) _Pragma("unroll") for (int k = 0; k < 2; ++k) dst[m][k] = *(const PG8_LAS bf16x8*)(lds + PG8_SA(b, h) + aoff + m * 2048 + k * 1024); } while (0)
#define PG8_LDB(dst, b, h) do { _Pragma("unroll") for (int n = 0; n < 2; ++n) _Pragma("unroll") for (int k = 0; k < 2; ++k) dst[n][k] = *(const PG8_LAS bf16x8*)(lds + PG8_SB(b, h) + boff + n * 2048 + k * 1024); } while (0)
#define PG8_MMA(ai, bj, At, Bt) do { __builtin_amdgcn_s_setprio(1); _Pragma("unroll") for (int m = 0; m < 4; ++m) _Pragma("unroll") for (int n = 0; n < 2; ++n) _Pragma("unroll") for (int k = 0; k < 2; ++k) \
        acc[ai][bj][m][n] = __builtin_amdgcn_mfma_f32_16x16x32_bf16(Bt[n][k], At[m][k], acc[ai][bj][m][n], 0, 0, 0); __builtin_amdgcn_s_setprio(0); } while (0)
#define PG8_WAIT_V(n) asm volatile("s_waitcnt vmcnt(" #n ")" ::: "memory")
#define PG8_WAIT_L(n) asm volatile("s_waitcnt lgkmcnt(" #n ")" ::: "memory")
#define PG8_BAR __builtin_amdgcn_s_barrier()
#define PG8_SCHED __builtin_amdgcn_sched_barrier(0)
    Unit cur, nxt; int ui = 0;
    if (!S.next(0, cur)) return;
    f32x4 acc[2][2][4][2];
#pragma unroll
    for (int a = 0; a < 2; ++a)
#pragma unroll
        for (int b = 0; b < 2; ++b)
#pragma unroll
            for (int m = 0; m < 4; ++m)
#pragma unroll
                for (int n = 0; n < 2; ++n) acc[a][b][m][n] = (f32x4){0.f, 0.f, 0.f, 0.f};
    bf16x8 At[4][2], B0[2][2], B1[2][2];
    const char* cA = (const char*)g.A + (GATHER ? (size_t)0 : (size_t)cur.pm * tstepA); if constexpr (GATHER) PG8_GOFF(cur, vA0, vA1);
    const char* cB = (const char*)g.Bt + (size_t)cur.pn * tstepB;
    S.a_ready(cur);
    if constexpr (SP2) {
        PG8_STAGE(PG8_SB(0, 0), cB, voffB); PG8_STAGE(PG8_SB(0, 1), cB + hstepB, voffB); PG8_STAGEA(PG8_SA(0, 0), cA, 0, vA0, vA1); PG8_STAGEA(PG8_SA(0, 1), cA, 1, vA0, vA1);
        if (wr == 1) PG8_BAR;
        PG8_WAIT_V(2); PG8_BAR;
        PG8_STAGE(PG8_SB(1, 0), cB + kstep, voffB); PG8_STAGEA(PG8_SA(1, 0), cA + kstep, 0, vA0, vA1); PG8_STAGE(PG8_SB(1, 1), cB + hstepB + kstep, voffB);
        PG8_WAIT_V(6); PG8_BAR;
    } else {
        PG8_STAGE(PG8_SB(0, 0), cB, voffB); PG8_STAGE(PG8_SA(0, 0), cA, voffA); PG8_STAGE(PG8_SB(0, 1), cB + hstepB, voffB); PG8_STAGE(PG8_SA(0, 1), cA + hstepA, voffA);
        if (wr == 1) PG8_BAR;
        PG8_WAIT_V(4); PG8_BAR;
        PG8_STAGE(PG8_SB(1, 0), cB + kstep, voffB); PG8_STAGE(PG8_SA(1, 0), cA + kstep, voffA); PG8_STAGE(PG8_SB(1, 1), cB + hstepB + kstep, voffB);
        PG8_WAIT_V(6); PG8_BAR;
    }
    for (;;) {
        const bool has_next = S.next(ui + 1, nxt);
        const char* nA = (has_next && !GATHER) ? (const char*)g.A + (size_t)nxt.pm * tstepA : cA;
        if constexpr (GATHER) { if (has_next) { if (wid < 4) __builtin_amdgcn_global_load_lds((const unsigned*)(g.rowidx + (size_t)nxt.pm * BM + (tid & 255)), (PG8_LAS unsigned*)(lds + STAGE_BYTES + wid * 256), 4, 0, 0); }
                                else { wA0[0] = vA0[0]; wA0[1] = vA0[1]; wA1[0] = vA1[0]; wA1[1] = vA1[1]; } }
        const char* nB = has_next ? (const char*)g.Bt + (size_t)nxt.pn * tstepB : cB;
        for (int t = 0; t < nt; t += 2) {
            const bool last = (t == nt - 2);
            const char* a1 = cA + (size_t)(t + 1) * kstep;
            const char* a2 = last ? nA : cA + (size_t)(t + 2) * kstep; const char* b2 = last ? nB : cB + (size_t)(t + 2) * kstep;
            const char* a3 = a2 + kstep; const char* b3 = b2 + kstep;
            if (last && has_next) S.a_ready(nxt);
            if constexpr (GATHER) { if (last && has_next) {
#pragma unroll
                for (int i = 0; i < 2; ++i) { int R, C; stage_rc(tid * 16 + i * 8192, R, C);
                    const unsigned i0_ = *(const PG8_LAS unsigned*)(lds + STAGE_BYTES + R * 4), i1_ = *(const PG8_LAS unsigned*)(lds + STAGE_BYTES + (R + HALF) * 4);
                    wA0[i] = (i0_ * (unsigned)g.lda + (unsigned)C) * 2u; wA1[i] = (i1_ * (unsigned)g.lda + (unsigned)C) * 2u; } } }
            const unsigned sA0[2] = {last ? wA0[0] : vA0[0], last ? wA0[1] : vA0[1]}, sA1[2] = {last ? wA1[0] : vA1[0], last ? wA1[1] : vA1[1]};
            if constexpr (SP2) {
            PG8_LDB(B0, 0, 0); PG8_LDB(B1, 0, 1); PG8_SCHED; PG8_LDA(At, 0, 0); PG8_STAGEA(PG8_SA(1, 1), a1, 1, vA0, vA1);
            PG8_WAIT_V(8); PG8_WAIT_L(0); PG8_BAR; PG8_MMA(0, 0, At, B0); PG8_MMA(0, 1, At, B1); PG8_BAR; PG8_SCHED;
            PG8_LDA(At, 0, 1); PG8_STAGE(PG8_SB(0, 0), b2, voffB); PG8_STAGE(PG8_SB(0, 1), b2 + hstepB, voffB); PG8_STAGEA(PG8_SA(0, 0), a2, 0, sA0, sA1);
            PG8_WAIT_V(8); PG8_WAIT_L(0); PG8_BAR; PG8_MMA(1, 0, At, B0); PG8_MMA(1, 1, At, B1); PG8_BAR; PG8_SCHED;
            PG8_LDB(B0, 1, 0); PG8_LDB(B1, 1, 1); PG8_SCHED; PG8_LDA(At, 1, 0); PG8_STAGEA(PG8_SA(0, 1), a2, 1, sA0, sA1);
            PG8_WAIT_V(8); PG8_WAIT_L(0); PG8_BAR; PG8_MMA(0, 0, At, B0); PG8_MMA(0, 1, At, B1); PG8_BAR; PG8_SCHED;
            PG8_LDA(At, 1, 1); PG8_STAGE(PG8_SB(1, 0), b3, voffB); PG8_STAGE(PG8_SB(1, 1), b3 + hstepB, voffB); PG8_STAGEA(PG8_SA(1, 0), a3, 0, sA0, sA1);
            PG8_WAIT_V(8); PG8_WAIT_L(0); PG8_BAR; PG8_MMA(1, 0, At, B0); PG8_MMA(1, 1, At, B1); PG8_BAR; PG8_SCHED;
            } else {
            PG8_LDB(B0, 0, 0); PG8_SCHED; PG8_LDA(At, 0, 0); PG8_STAGE(PG8_SA(1, 1), a1 + hstepA, voffA);
            PG8_WAIT_L(8); PG8_BAR; PG8_WAIT_L(0); PG8_MMA(0, 0, At, B0); PG8_BAR; PG8_SCHED;
            PG8_LDB(B1, 0, 1); PG8_STAGE(PG8_SB(0, 0), b2, voffB);
            PG8_BAR; PG8_WAIT_L(0); PG8_MMA(0, 1, At, B1); PG8_BAR;
            PG8_LDA(At, 0, 1); PG8_STAGE(PG8_SA(0, 0), a2, voffA);
            PG8_BAR; PG8_WAIT_L(0); PG8_MMA(1, 0, At, B0); PG8_BAR; PG8_SCHED;
            PG8_STAGE(PG8_SB(0, 1), b2 + hstepB, voffB);
            PG8_WAIT_V(6); PG8_BAR; PG8_MMA(1, 1, At, B1); PG8_BAR;
            PG8_LDB(B0, 1, 0); PG8_SCHED; PG8_LDA(At, 1, 0); PG8_STAGE(PG8_SA(0, 1), a2 + hstepA, voffA);
            PG8_WAIT_L(8); PG8_BAR; PG8_WAIT_L(0); PG8_MMA(0, 0, At, B0); PG8_BAR; PG8_SCHED;
            PG8_LDB(B1, 1, 1); PG8_STAGE(PG8_SB(1, 0), b3, voffB);
            PG8_BAR; PG8_WAIT_L(0); PG8_MMA(0, 1, At, B1); PG8_BAR;
            PG8_LDA(At, 1, 1); PG8_STAGE(PG8_SA(1, 0), a3, voffA);
            PG8_BAR; PG8_WAIT_L(0); PG8_MMA(1, 0, At, B0); PG8_BAR; PG8_SCHED;
            PG8_STAGE(PG8_SB(1, 1), b3 + hstepB, voffB);
            PG8_WAIT_V(6); PG8_BAR; PG8_MMA(1, 1, At, B1); PG8_BAR;
            }
        }
        if constexpr (ALIGN_EPI) { if (wr == 0) PG8_BAR; }
        if constexpr (!Epi::AFTER_DRAIN) { E(acc, cur, wr, wc, fr, fq); S.done(cur); }
        if (!has_next) break;
#pragma unroll
        for (int a = 0; a < 2; ++a)
#pragma unroll
            for (int b = 0; b < 2; ++b)
#pragma unroll
                for (int m = 0; m < 4; ++m)
#pragma unroll
                    for (int n = 0; n < 2; ++n) acc[a][b][m][n] = (f32x4){0.f, 0.f, 0.f, 0.f};
        cur = nxt; cA = nA; cB = nB; ++ui; vA0[0] = wA0[0]; vA0[1] = wA0[1]; vA1[0] = wA1[0]; vA1[1] = wA1[1];
        if constexpr (ALIGN_EPI) { if (wr == 1) PG8_BAR; }
    }
    PG8_WAIT_V(0);
    if constexpr (!ALIGN_EPI) { if (wr == 0) PG8_BAR; }
    PG8_BAR;
    if constexpr (Epi::AFTER_DRAIN) { E.fused(acc, cur, wr, wc, fr, fq, lds, wid, lane); S.done(cur); }
#undef PG8_SA
#undef PG8_SB
#undef PG8_STAGE
#undef PG8_STAGEA
#undef PG8_GOFF
#undef PG8_LDA
#undef PG8_LDB
#undef PG8_MMA
#undef PG8_WAIT_V
#undef PG8_WAIT_L
#undef PG8_BAR
#undef PG8_SCHED
}
}
#define PG8_SP2 true
#define PG8_ALIGN true

struct Frame;
struct Args { const float* in[33]; float* out; unsigned char* ws; int ph_lo, ph_hi; };
struct Frame {
    unsigned char* lds;
    int tid, lane, wave, bid, nb;
    const float* const* in;
    float* out; unsigned char* ws;
    float* MOD; float* AFF; int* SEL; float* GATE; int* INV; bf16* X; bf16* H;
};
__device__ __forceinline__ void REFRESH_(Frame& F) { int l_; asm volatile("v_mbcnt_lo_u32_b32 %0, -1, 0\n\tv_mbcnt_hi_u32_b32 %0, -1, %0" : "=v"(l_)); F.lane = l_; F.tid = F.wave * 64 + l_; }
__device__ __forceinline__ int mod_row(int row) { const int b = row / P, pos = row - b * P; return pos < NCTX ? 32 : b; }

__device__ __forceinline__ void ph_s5_pre(const Frame& F) {
    const float *a_re = F.in[8], *a_im = F.in[9], *log_dt = F.in[10], *b_re = F.in[11], *b_im = F.in[12], *c_re = F.in[13], *c_im = F.in[14];
    f32x2* Bb = (f32x2*)F.lds;
    f32x2* Cc = Bb + 2048;
    f32x2* Ap = Cc + 2048;
    float* Kt = (float*)(Ap + 2 * 33 * 64);
    bf16* W1 = (bf16*)(F.ws + WS_S5W1); bf16* W2 = (bf16*)(F.ws + WS_S5W2); f32x2* A32 = (f32x2*)(F.ws + WS_S5A);
    const int tid = F.tid;
    for (int g = F.nb - 1 - F.bid; g < 64; g += F.nb) {
        __syncthreads();
        if (tid < 128) {
            const int dir = tid >> 6, p = tid & 63, dg = dir * 64 + g;
            const double are = (double)a_re[dg * 64 + p], aim = (double)a_im[dg * 64 + p], dt = exp((double)log_dt[dg]);
            const double lr = are * dt, li = aim * dt, cl = cos(li), sl = sin(li), mag = exp(lr);
            const double Abi = mag * sl, sh = sin(0.5 * li), nr = expm1(lr) * cl - 2.0 * sh * sh, den = are * are + aim * aim;
            const double fr = (nr * are + Abi * aim) / den, fi = (Abi * are - nr * aim) / den;
            for (int h = 0; h < 16; ++h) { const double br = (double)b_re[((size_t)dg * 64 + p) * 16 + h], bi = (double)b_im[((size_t)dg * 64 + p) * 16 + h];
                Bb[(dir * 64 + p) * 16 + h] = (f32x2){(float)(fr * br - fi * bi), (float)(fr * bi + fi * br)}; }
            const double Abr = mag * cl; double pr = 1.0, pi = 0.0;
            for (int e = 0; e <= 32; ++e) { const f32x2 v = {(float)pr, (float)pi};
                Ap[(dir * 33 + e) * 64 + p] = v; if (e == 32) A32[(g * 2 + dir) * 64 + p] = v;
                const double nr2 = pr * Abr - pi * Abi, ni2 = pr * Abi + pi * Abr; pr = nr2; pi = ni2; }
        }
        for (int i = tid; i < 2048; i += NTHREADS) { const int dir = i >> 10, k = (i >> 6) & 15, p = i & 63; const size_t o = ((size_t)(dir * 64 + g) * 16 + k) * 64 + p; Cc[i] = (f32x2){c_re[o], c_im[o]}; }
        __syncthreads();
        {
            const int dir = tid >> 8, k = (tid >> 4) & 15, h = tid & 15; float acc[32];
#pragma unroll
            for (int lag = 0; lag < 32; ++lag) acc[lag] = 0.f;
#pragma unroll 2
            for (int p = 0; p < 64; ++p) { const f32x2 c = Cc[(dir * 16 + k) * 64 + p], bb = Bb[(dir * 64 + p) * 16 + h], a1 = Ap[(dir * 33 + 1) * 64 + p];
                float zr = c.x * bb.x - c.y * bb.y, zi = c.x * bb.y + c.y * bb.x;
#pragma unroll
                for (int lag = 0; lag < 32; ++lag) { acc[lag] += zr; const float nz = zr * a1.x - zi * a1.y; zi = zr * a1.y + zi * a1.x; zr = nz; } }
#pragma unroll
            for (int lag = 0; lag < 32; ++lag) Kt[((dir * 32 + lag) * 16 + k) * 16 + h] = acc[lag];
        }
        for (int i = tid; i < 16384; i += NTHREADS) {
            const int n = i >> 6, sg = (i >> 1) & 31, h0 = (i & 1) * 8, dir = n >> 7, c = (n >> 6) & 1, p = n & 63, e = dir ? sg : 31 - sg;
            const f32x2 a = Ap[(dir * 33 + e) * 64 + p]; float v[8];
#pragma unroll
            for (int q = 0; q < 8; ++q) { const f32x2 bb = Bb[(dir * 64 + p) * 16 + h0 + q]; v[q] = c ? a.x * bb.y + a.y * bb.x : a.x * bb.x - a.y * bb.y; }
            u32x4 w; w.x = pk2(v[0], v[1]); w.y = pk2(v[2], v[3]); w.z = pk2(v[4], v[5]); w.w = pk2(v[6], v[7]);
            *(u32x4*)(W1 + ((size_t)g * 256 + n) * 512 + sg * 16 + h0) = w;
        }
        for (int i = tid; i < 16384; i += NTHREADS) {
            const int m = i >> 5, n0 = (i & 31) * 8, dir = n0 >> 7, c = (n0 >> 6) & 1, p0 = n0 & 63, tau = m >> 4, k = m & 15, e = dir ? 32 - tau : tau + 1; float v[8];
#pragma unroll
            for (int q = 0; q < 8; ++q) { const f32x2 cc = Cc[(dir * 16 + k) * 64 + p0 + q], a = Ap[(dir * 33 + e) * 64 + p0 + q]; v[q] = c ? -(cc.x * a.y + cc.y * a.x) : cc.x * a.x - cc.y * a.y; }
            u32x4 w; w.x = pk2(v[0], v[1]); w.y = pk2(v[2], v[3]); w.z = pk2(v[4], v[5]); w.w = pk2(v[6], v[7]);
            *(u32x4*)(W2 + ((size_t)g * 512 + m) * 768 + 512 + n0) = w;
        }
        __syncthreads();
        for (int i = tid; i < 32768; i += NTHREADS) {
            const int m = i >> 6, sg = (i >> 1) & 31, h0 = (i & 1) * 8, tau = m >> 4, k = m & 15; float v[8];
#pragma unroll
            for (int q = 0; q < 8; ++q) { float x = 0.f; if (sg <= tau) x += Kt[((tau - sg) * 16 + k) * 16 + h0 + q]; if (sg >= tau) x += Kt[((32 + sg - tau) * 16 + k) * 16 + h0 + q]; v[q] = x; }
            u32x4 w; w.x = pk2(v[0], v[1]); w.y = pk2(v[2], v[3]); w.z = pk2(v[4], v[5]); w.w = pk2(v[6], v[7]);
            *(u32x4*)(W2 + ((size_t)g * 512 + m) * 768 + sg * 16 + h0) = w;
        }
    }
    __syncthreads();
}
__device__ __forceinline__ void ph_s5_scan(const Frame& F) {
    const float* SS = (const float*)(F.ws + WS_SS); bf16* AG = (bf16*)(F.ws + WS_AG); const f32x2* A32 = (const f32x2*)(F.ws + WS_S5A);
    for (int gid = F.bid * NTHREADS + F.tid; gid < 64 * 32 * 128; gid += F.nb * NTHREADS) {
        const int p = gid & 63, dir = (gid >> 6) & 1, b = (gid >> 7) & 31, g = gid >> 12;
        const f32x2 a = A32[(g * 2 + dir) * 64 + p];
        float hr = 0.f, hi = 0.f;
        const size_t row0 = (size_t)g * 2304 + b * 72;
#pragma unroll 4
        for (int idx = 0; idx < 72; ++idx) {
            const int j = dir == 0 ? idx : (idx < 8 ? 7 - idx : 79 - idx);
            const size_t row = row0 + j;
            AG[row * 768 + 512 + dir * 128 + p] = (bf16)f2bf(hr); AG[row * 768 + 512 + dir * 128 + 64 + p] = (bf16)f2bf(hi);
            const float sr = SS[row * 256 + dir * 128 + p], si = SS[row * 256 + dir * 128 + 64 + p];
            const float nr = a.x * hr - a.y * hi + sr, ni = a.x * hi + a.y * hr + si; hr = nr; hi = ni;
        }
    }
}

template <int DUAL>
__device__ __forceinline__ void transpose_item(const float* W, int ldw, int K, int N, bf16* WT, int row_off, LAS float* scr, int item, int lane) {
    const int nblk = N / 64, kb = item / nblk, nb = item - kb * nblk, k0 = 64 * kb, n0 = 64 * nb;
    const int lr = lane >> 4, lc = (lane & 15) * 4;
    f32x4 v[16];
#pragma unroll
    for (int i = 0; i < 16; ++i) v[i] = *(const f32x4*)(W + (size_t)(k0 + lr + 4 * i) * ldw + n0 + lc);
#pragma unroll
    for (int i = 0; i < 16; ++i) { LAS float* d = scr + (lr + 4 * i) * 65 + lc; d[0] = v[i].x; d[1] = v[i].y; d[2] = v[i].z; d[3] = v[i].w; }
    asm volatile("s_waitcnt lgkmcnt(0)" ::: "memory");
    const int c = lane & 7;
#pragma unroll
    for (int j = 0; j < 8; ++j) { const int n = (lane >> 3) + 8 * j; const LAS float* sp = scr + (8 * c) * 65 + n;
        u32x4 o; o.x = pkbf(sp[0 * 65], sp[1 * 65]); o.y = pkbf(sp[2 * 65], sp[3 * 65]); o.z = pkbf(sp[4 * 65], sp[5 * 65]); o.w = pkbf(sp[6 * 65], sp[7 * 65]);
        const int nn = n0 + n, dest = DUAL == -2 ? (nn < 3072 ? nn : (nn < 4096 ? nn + 1024 : nn - 1024)) : (DUAL < 0 ? row_off + nn : row_off + (nn >> 7) * 256 + DUAL * 128 + (nn & 127));
        *(u32x4*)(WT + (size_t)dest * K + k0 + 8 * c) = o; }
    asm volatile("s_waitcnt lgkmcnt(0)" ::: "memory");
}
__device__ __forceinline__ void convert_moe(const Frame& F, int l, int cb = -1, int cnb = 0) {
    if (cb < 0) { cb = F.bid; cnb = F.nb; }
    if (cb >= cnb) return;
    LAS float* scr = (LAS float*)((LAS unsigned char*)F.lds) + F.wave * 4160;
    bf16* WGU = (bf16*)(F.ws + WO_GU); bf16* WDN = (bf16*)(F.ws + WO_DN);
    for (int it = cb * NWAVES + F.wave; it < 24576; it += cnb * NWAVES) {
        const int m = it >> 13, r = it & 8191, e = r >> 9, item = r & 511;
        if (m == 0) transpose_item<0>(F.in[29] + (size_t)(l * NE + e) * D * FF, FF, D, FF, WGU, e * 2 * FF, scr, item, F.lane);
        else if (m == 1) transpose_item<1>(F.in[30] + (size_t)(l * NE + e) * D * FF, FF, D, FF, WGU, e * 2 * FF, scr, item, F.lane);
        else transpose_item<-1>(F.in[31] + (size_t)(l * NE + e) * FF * D, D, FF, D, WDN, e * D, scr, item, F.lane);
    }
}
__device__ __forceinline__ void convert_mixers(const Frame& F, int cb, int cnb) {
    if (cb >= cnb) return;
    LAS float* scr = (LAS float*)((LAS unsigned char*)F.lds) + F.wave * 4160;
    for (int it = cb * NWAVES + F.wave; it < 4096; it += cnb * NWAVES) {
        int r = it;
        if (r < 256) { transpose_item<0>(F.in[16], 2 * D, D, D, (bf16*)(F.ws + WO_GLU), 0, scr, r, F.lane); continue; } r -= 256;
        if (r < 256) { transpose_item<1>(F.in[16] + D, 2 * D, D, D, (bf16*)(F.ws + WO_GLU), 0, scr, r, F.lane); continue; } r -= 256;
        if (r < 768) { transpose_item<-1>(F.in[17], 3 * D, D, 3 * D, (bf16*)(F.ws + WO_NAQKV), 0, scr, r, F.lane); continue; } r -= 768;
        if (r < 256) { transpose_item<-1>(F.in[18], D, D, D, (bf16*)(F.ws + WO_NAO), 0, scr, r, F.lane); continue; } r -= 256;
        if (r < 768) { transpose_item<-1>(F.in[20], 3 * D, D, 3 * D, (bf16*)(F.ws + WO_DAQKV), 0, scr, r, F.lane); continue; } r -= 768;
        if (r < 256) { transpose_item<-1>(F.in[21], D, D, D, (bf16*)(F.ws + WO_DAO), 0, scr, r, F.lane); continue; } r -= 256;
        if (r < 1280) { transpose_item<-2>(F.in[24], 5 * D, D, 5 * D, (bf16*)(F.ws + WO_HGIN), 0, scr, r, F.lane); continue; } r -= 1280;
        transpose_item<-1>(F.in[25], D, D, D, (bf16*)(F.ws + WO_HGO), 0, scr, r, F.lane);
    }
}

__device__ __forceinline__ void ph_prologue(const Frame& F) {
    {
        float* S = (float*)F.lds;
        for (int i = F.tid; i < 33 * 1024; i += NTHREADS) { const float v = i < 32 * 1024 ? F.in[1][i] : F.in[3][i - 32 * 1024]; S[i] = siluf_(v); }
        __syncthreads();
        float acc[2][33];
#pragma unroll
        for (int t = 0; t < 2; ++t)
#pragma unroll
            for (int r = 0; r < 33; ++r) acc[t][r] = 0.f;
#pragma unroll
        for (int t = 0; t < 2; ++t) {
            const int task = F.bid + t * F.nb;
            if (task < 384) {
                const int l = task / 96, col = (task % 96) * 64 + F.lane, kb = F.wave * 128;
                const float* W = F.in[4] + (size_t)l * 1024 * 6144 + col;
#pragma unroll 1
                for (int k = kb; k < kb + 128; k += 8) {
                    float w[8];
#pragma unroll
                    for (int q = 0; q < 8; ++q) w[q] = W[(size_t)(k + q) * 6144];
#pragma unroll
                    for (int r = 0; r < 33; ++r) { const f32x4 s0 = *(const f32x4*)&S[r * 1024 + k], s1 = *(const f32x4*)&S[r * 1024 + k + 4];
                        acc[t][r] += (s0.x * w[0] + s0.y * w[1]) + (s0.z * w[2] + s0.w * w[3]) + (s1.x * w[4] + s1.y * w[5]) + (s1.z * w[6] + s1.w * w[7]); }
                }
            }
        }
        __syncthreads();
#pragma unroll
        for (int t = 0; t < 2; ++t)
#pragma unroll
            for (int r = 0; r < 33; ++r) S[((t * 8 + F.wave) * 33 + r) * 64 + F.lane] = acc[t][r];
        __syncthreads();
        for (int i = F.tid; i < 2 * 33 * 64; i += NTHREADS) {
            const int t = i / (33 * 64), r = (i / 64) % 33, ln = i & 63, task = F.bid + t * F.nb;
            if (task < 384) { const int l = task / 96, col = (task % 96) * 64 + ln; float v = F.in[5][l * 6144 + col];
#pragma unroll
                for (int w = 0; w < 8; ++w) v += S[((t * 8 + w) * 33 + r) * 64 + ln];
                F.MOD[((size_t)l * 33 + r) * 6144 + col] = v; }
        }
        __syncthreads();
    }
    if (F.bid == 48) {
        const float* lbin = F.in[27];
        for (int c = F.tid; c < D; c += NTHREADS) { const float x0 = lbin[c], x1 = lbin[D + c], x2 = lbin[2 * D + c], x3 = lbin[3 * D + c], mx = fmaxf(fmaxf(x0, x1), fmaxf(x2, x3));
            const float e0 = expf(x0 - mx), e1 = expf(x1 - mx), e2 = expf(x2 - mx), e3 = expf(x3 - mx); ((float*)(F.ws + WS_LB))[c] = (e1 + e2 + e3) / (e0 + e1 + e2 + e3); }
    }
    if (F.bid == 49) {
        for (int i = F.tid; i < 64 * 16; i += NTHREADS) { const float inv = powf(10000.0f, -(float)(i & 15) * (1.0f / 16.0f)); float sn, cs; sincosf((float)(i >> 4) * inv, &sn, &cs);
            ((float*)(F.ws + WS_ROPE))[2 * i] = cs; ((float*)(F.ws + WS_ROPE))[2 * i + 1] = sn; }
    }
    { const int ncv = F.nb > 128 ? F.nb - 64 : F.nb;
      convert_mixers(F, F.bid, ncv); convert_moe(F, 0, F.bid, ncv); }
    __syncthreads();
    ph_s5_pre(F);
}

template <bool F32> struct XRawT { typedef f32x4 T; };
template <> struct XRawT<false> { typedef u32x2 T; };
__device__ __forceinline__ f32x4 xcvt(const f32x4& r) { return r; }
__device__ __forceinline__ f32x4 xcvt(const u32x2& r) { return (f32x4){bflo(r.x), bfhi(r.x), bflo(r.y), bfhi(r.y)}; }
template <int MODE, bool COMBINE, bool S5OUT = false, bool SKIPCTX = false, bool FROMIN = false>
__device__ __forceinline__ void ph_norm(const Frame& F, int layer, int prev_layer) {
    static_assert(MODE != 1, "norm2 + router is ph_norm2");
    const float* nw = MODE == 0 ? F.in[6] + layer * D : F.in[32];
    const bf16* Y = (const bf16*)(F.ws + WS_Y);
    constexpr int NI = SKIPCTX ? NB * SEQ : R;
    constexpr int NPF = 4;
    const int per = (NI + F.nb * NWAVES - 1) / (F.nb * NWAVES);
    int it = (F.bid * NWAVES + F.wave) * per; const int itend = min(NI, it + per);
    typedef typename XRawT<FROMIN>::T XR;
    const __amdgpu_buffer_rsrc_t yrs = __builtin_amdgcn_make_buffer_rsrc((void*)Y, 0, (int)((size_t)NE * SLOTS * D * 2), 0x00020000);
    const int l16 = F.lane & 15;
#define NORM_ROWOF(i_) (SKIPCTX ? ((i_) >> 11) * P + NCTX + ((i_) & (SEQ - 1)) : (i_))
#define NORM_XPTR(r_) ((FROMIN ? (const XR*)(((r_) % P) < NCTX ? F.in[2] + ((size_t)((r_) / P) * NCTX + ((r_) % P)) * D : F.in[0] + ((size_t)((r_) / P) * SEQ + ((r_) % P) - NCTX) * D) : (const XR*)(F.X + (size_t)(r_) * D)) + F.lane)
#define NORM_STAGE(i_, INVA_, V_, G_, Yq_, INVB_) do { \
        const int ic_ = min((i_), itend - 1), ic1_ = min((i_) + 1, itend - 1); const int rA_ = NORM_ROWOF(ic_); \
        if (COMBINE) INVB_ = F.INV[(size_t)NORM_ROWOF(ic1_) * NE + l16]; \
        if (COMBINE) G_ = F.GATE[l16 * SLOTS + max(INVA_, 0)]; \
        { const XR* xp_ = NORM_XPTR(rA_); _Pragma("unroll") for (int j = 0; j < 4; ++j) V_[j] = xp_[64 * j]; } \
        if (COMBINE) { unsigned m_ = ((i_) < itend) ? (unsigned)(__ballot(F.lane < NE && INVA_ >= 0) & 0xffffull) : 0u; \
            _Pragma("unroll") for (int q = 0; q < NPF; ++q) { const bool pr_ = m_ != 0u; const int e_ = pr_ ? __builtin_ctz(m_) : 0; m_ &= m_ - 1u; const int s_ = __builtin_amdgcn_readlane(INVA_, e_); \
                const unsigned vo_ = pr_ ? (unsigned)(e_ * SLOTS + s_) * (unsigned)(D * 2) + (unsigned)F.lane * 8u : 0xfffff000u; \
                _Pragma("unroll") for (int j = 0; j < 4; ++j) Yq_[q][j] = __builtin_amdgcn_raw_buffer_load_b64(yrs, vo_ + 512u * j, 0, 0); } } \
    } while (0)
    XR v[4]; u32x2 yc[NPF][4]; float gl = 0.f; int invl = -1, invn = -1;
    if (COMBINE) invl = F.INV[(size_t)NORM_ROWOF(min(it, NI - 1)) * NE + l16];
    NORM_STAGE(it, invl, v, gl, yc, invn);
    const f32x4* nw4 = (const f32x4*)nw + F.lane;
    f32x4 g5[4], nwv[4], shv[4], scv[4]; int mrc = -1;
#pragma unroll
    for (int j = 0; j < 4; ++j) { nwv[j] = nw4[64 * j]; g5[j] = shv[j] = scv[j] = (f32x4){0.f, 0.f, 0.f, 0.f}; }
    while (it < itend) {
        const int row = NORM_ROWOF(it), b = row / P, pos = row - b * P, mr = pos < NCTX ? 32 : b;
        if (mr != mrc) { mrc = mr;
            const float* mrow = F.MOD + ((size_t)layer * 33 + mr) * 6144;
#pragma unroll
            for (int j = 0; j < 4; ++j) {
                if (COMBINE) g5[j] = ((const f32x4*)(F.MOD + ((size_t)prev_layer * 33 + mr) * 6144 + 5 * D) + F.lane)[64 * j];
                if (MODE != 2) { shv[j] = ((const f32x4*)(mrow + (MODE == 0 ? 0 : 3) * D) + F.lane)[64 * j]; scv[j] = ((const f32x4*)(mrow + (MODE == 0 ? 1 : 4) * D) + F.lane)[64 * j]; }
            }
        }
        XR vn[4]; u32x2 yn[NPF][4]; float gln = 0.f; int invnn = -1;
        NORM_STAGE(it + 1, invn, vn, gln, yn, invnn);
        f32x4 a[4];
#pragma unroll
        for (int j = 0; j < 4; ++j) a[j] = (f32x4){0.f, 0.f, 0.f, 0.f};
        if (COMBINE) {
            unsigned m = (unsigned)(__ballot(F.lane < NE && invl >= 0) & 0xffffull);
#pragma unroll
            for (int q = 0; q < NPF; ++q) {
                const bool pr = m != 0u; const int e = pr ? __builtin_ctz(m) : 0; m &= m - 1u;
                const float g = pr ? __uint_as_float(__builtin_amdgcn_readlane(__float_as_uint(gl), e)) : 0.f;
#pragma unroll
                for (int j = 0; j < 4; ++j) { a[j].x += g * bflo(yc[q][j].x); a[j].y += g * bfhi(yc[q][j].x); a[j].z += g * bflo(yc[q][j].y); a[j].w += g * bfhi(yc[q][j].y); }
            }
            while (m) {
                const int e = __builtin_ctz(m); m &= m - 1u;
                const int sl = __builtin_amdgcn_readlane(invl, e); const float g = __uint_as_float(__builtin_amdgcn_readlane(__float_as_uint(gl), e));
                const u32x2* y0 = (const u32x2*)(Y + ((size_t)e * SLOTS + sl) * D) + F.lane;
                u32x2 w0[4];
#pragma unroll
                for (int j = 0; j < 4; ++j) w0[j] = y0[64 * j];
#pragma unroll
                for (int j = 0; j < 4; ++j) { a[j].x += g * bflo(w0[j].x); a[j].y += g * bfhi(w0[j].x); a[j].z += g * bflo(w0[j].y); a[j].w += g * bfhi(w0[j].y); }
            }
        }
        f32x4 vv[4];
#pragma unroll
        for (int j = 0; j < 4; ++j) vv[j] = xcvt(v[j]);
        if (COMBINE) {
#pragma unroll
            for (int j = 0; j < 4; ++j) vv[j] = vv[j] + g5[j] * a[j];
        }
        if ((FROMIN || COMBINE) && MODE != 2) { u32x2* xw = (u32x2*)(F.X + (size_t)row * D) + F.lane;
#pragma unroll
            for (int j = 0; j < 4; ++j) { u32x2 w; w.x = pkbf(vv[j].x, vv[j].y); w.y = pkbf(vv[j].z, vv[j].w); xw[64 * j] = w; } }
        float ss = 0.f;
#pragma unroll
        for (int j = 0; j < 4; ++j) ss += (vv[j].x * vv[j].x + vv[j].y * vv[j].y) + (vv[j].z * vv[j].z + vv[j].w * vv[j].w);
        const float rinv = rsqrtf(wave_sum(ss) * (1.0f / D) + EPS);
        if (MODE == 2) {
            if (pos >= NCTX) {
                f32x4* o = (f32x4*)(F.out + ((size_t)b * SEQ + pos - NCTX) * D) + F.lane;
#pragma unroll
                for (int j = 0; j < 4; ++j) o[64 * j] = vv[j] * rinv * nwv[j];
            }
        } else {
            u32x2* ho = (u32x2*)(F.H + (size_t)row * D) + F.lane;
            f32x4 h[4];
#pragma unroll
            for (int j = 0; j < 4; ++j) { h[j] = vv[j] * rinv * nwv[j] * (scv[j] + 1.0f) + shv[j]; u32x2 w; w.x = pkbf(h[j].x, h[j].y); w.y = pkbf(h[j].z, h[j].w); ho[64 * j] = w;
                if (S5OUT) { const int g = (F.lane >> 2) + 16 * j;
                    *(u32x2*)((bf16*)(F.ws + WS_AG) + ((size_t)g * 2304 + b * 72 + (pos >> 5)) * 768 + (pos & 31) * 16 + (F.lane & 3) * 4) = w; } }
        }
#pragma unroll
        for (int j = 0; j < 4; ++j) { v[j] = vn[j];
#pragma unroll
            for (int q = 0; q < NPF; ++q) yc[q][j] = yn[q][j]; }
        gl = gln; invl = invn; invn = invnn; ++it;
    }
#undef NORM_STAGE
#undef NORM_XPTR
#undef NORM_ROWOF
}

template <bool SKIPCTX>
__device__ __forceinline__ void ph_norm2(const Frame& F, int layer) {
    const float* nw = F.in[7] + layer * D;
    LAS float* wrt = (LAS float*)((LAS unsigned char*)F.lds);
    {
        const float* wr = F.in[28] + (size_t)layer * D * NE;
        for (int i = F.tid; i < D * NE; i += NTHREADS) wrt[(i & 15) * (D + 4) + (i >> 4)] = wr[i];
        __syncthreads();
    }
    const f32x4* nw4 = (const f32x4*)nw + F.lane;
    const int eid = ((F.lane & 1) << 3) | ((F.lane & 2) << 1) | ((F.lane & 4) >> 1) | ((F.lane & 8) >> 3);
    constexpr int NI = SKIPCTX ? NB * SEQ / 2 : R / 2;
    const int per = (NI + F.nb * NWAVES - 1) / (F.nb * NWAVES), it0 = (F.bid * NWAVES + F.wave) * per, it1 = min(NI, it0 + per);
    f32x4 gv[4], shv[4]; int mrc = -1;
#pragma unroll
    for (int j = 0; j < 4; ++j) gv[j] = shv[j] = (f32x4){0.f, 0.f, 0.f, 0.f};
#define N2_ROWOF(i_) (SKIPCTX ? ((i_) >> 10) * P + NCTX + 2 * ((i_) & (SEQ / 2 - 1)) : 2 * (i_))
    u32x2 w0[4], w1[4];
    { const u32x2* x0 = (const u32x2*)(F.X + (size_t)N2_ROWOF(min(it0, NI - 1)) * D) + F.lane;
#pragma unroll
      for (int j = 0; j < 4; ++j) { w0[j] = x0[64 * j]; w1[j] = x0[256 + 64 * j]; } }
    for (int it = it0; it < it1; ++it) {
        const int row = N2_ROWOF(it), b = row / P, pos = row - b * P, mr = pos < NCTX ? 32 : b;
        f32x4 v0[4], v1[4];
#pragma unroll
        for (int j = 0; j < 4; ++j) { v0[j] = xcvt(w0[j]); v1[j] = xcvt(w1[j]); }
        if (mr != mrc) { mrc = mr;
            const float* mrow = F.MOD + ((size_t)layer * 33 + mr) * 6144;
#pragma unroll
            for (int j = 0; j < 4; ++j) { shv[j] = ((const f32x4*)(mrow + 3 * D) + F.lane)[64 * j]; gv[j] = nw4[64 * j] * (((const f32x4*)(mrow + 4 * D) + F.lane)[64 * j] + 1.0f); }
        }
        u32x2 n0[4], n1[4];
        { const u32x2* xn = (const u32x2*)(F.X + (size_t)N2_ROWOF(min(it + 1, it1 - 1)) * D) + F.lane;
#pragma unroll
          for (int j = 0; j < 4; ++j) { n0[j] = xn[64 * j]; n1[j] = xn[256 + 64 * j]; } }
        float s0 = 0.f, s1 = 0.f;
#pragma unroll
        for (int j = 0; j < 4; ++j) { s0 += (v0[j].x * v0[j].x + v0[j].y * v0[j].y) + (v0[j].z * v0[j].z + v0[j].w * v0[j].w); s1 += (v1[j].x * v1[j].x + v1[j].y * v1[j].y) + (v1[j].z * v1[j].z + v1[j].w * v1[j].w); }
        const float r0 = rsqrtf(wave_sum(s0) * (1.0f / D) + EPS), r1 = rsqrtf(wave_sum(s1) * (1.0f / D) + EPS);
        u32x2* h0 = (u32x2*)(F.H + (size_t)row * D) + F.lane; u32x2* h1 = h0 + 256;
#pragma unroll
        for (int j = 0; j < 4; ++j) { const f32x4 g = gv[j];
            v0[j] = v0[j] * r0 * g + shv[j]; v1[j] = v1[j] * r1 * g + shv[j];
            u32x2 w; w.x = pkbf(v0[j].x, v0[j].y); w.y = pkbf(v0[j].z, v0[j].w); h0[64 * j] = w;
            w.x = pkbf(v1[j].x, v1[j].y); w.y = pkbf(v1[j].z, v1[j].w); h1[64 * j] = w; }
        f32x2 a0[NE], a1[NE];
#pragma unroll
        for (int e = 0; e < NE; ++e) { a0[e] = (f32x2){0.f, 0.f}; a1[e] = (f32x2){0.f, 0.f}; }
#pragma unroll
        for (int j = 0; j < 4; ++j) { asm volatile("" ::: "memory");
            const f32x2 p0 = {v0[j].x, v0[j].y}, q0 = {v0[j].z, v0[j].w}, p1 = {v1[j].x, v1[j].y}, q1 = {v1[j].z, v1[j].w};
#pragma unroll
            for (int e = 0; e < NE; ++e) { const f32x4 w = *(const LAS f32x4*)(wrt + e * (D + 4) + F.lane * 4 + 256 * j); const f32x2 wl = {w.x, w.y}, wh = {w.z, w.w};
                a0[e] += p0 * wl; a0[e] += q0 * wh; a1[e] += p1 * wl; a1[e] += q1 * wh; } }
        float lg0[NE], lg1[NE];
#pragma unroll
        for (int e = 0; e < NE; ++e) { lg0[e] = a0[e].x + a0[e].y; lg1[e] = a1[e].x + a1[e].y; }
        const float t0 = reduce16(lg0, F.lane), t1 = reduce16(lg1, F.lane);
        float m0 = fmaxf(t0, dpp_xor1(t0)), m1 = fmaxf(t1, dpp_xor1(t1));
        m0 = fmaxf(m0, dpp_xor2(m0)); m1 = fmaxf(m1, dpp_xor2(m1)); m0 = fmaxf(m0, __shfl_xor(m0, 4)); m1 = fmaxf(m1, __shfl_xor(m1, 4)); m0 = fmaxf(m0, __shfl_xor(m0, 8)); m1 = fmaxf(m1, __shfl_xor(m1, 8));
        const float e0 = __builtin_amdgcn_exp2f((t0 - m0) * LOG2E_), e1 = __builtin_amdgcn_exp2f((t1 - m1) * LOG2E_);
        float z0 = e0 + dpp_xor1(e0), z1 = e1 + dpp_xor1(e1);
        z0 += dpp_xor2(z0); z1 += dpp_xor2(z1); z0 += __shfl_xor(z0, 4); z1 += __shfl_xor(z1, 4); z0 += __shfl_xor(z0, 8); z1 += __shfl_xor(z1, 8);
        if (F.lane < NE) { float* ap = F.AFF + ((size_t)b * NE + eid) * P + pos; ap[0] = e0 / z0; ap[1] = e1 / z1; }
#pragma unroll
        for (int j = 0; j < 4; ++j) { w0[j] = n0[j]; w1[j] = n1[j]; }
    }
#undef N2_ROWOF
}

__device__ __forceinline__ void ph_topk(const Frame& F, int nitems) {
    const int tid = F.tid, lane = F.lane, half = F.wave >> 2, hw = F.wave & 3, ht = tid & 255;
    unsigned* hist = (unsigned*)F.lds + half * 288;
    unsigned* wtot = hist + 256;
    unsigned* bc = wtot + 8;
    for (int item0 = F.bid; item0 < nitems; item0 += 2 * F.nb) {
        const int item = item0 + half * F.nb; const bool valid = item < nitems;
        const int seg = item >> 9, b = (item >> 4) & 31, e = item & 15;
        const int n = seg ? NCTX : SEQ, pos0 = seg ? 0 : NCTX, cap = n / 8, slot0 = seg ? NB * 256 + b * 32 : b * 256;
        const int per = seg ? 1 : 8;
        const float* a = F.AFF + ((size_t)b * NE + e) * P + pos0;
        unsigned u[8];
#pragma unroll
        for (int q = 0; q < 8; ++q) u[q] = 0u;
        if (valid) {
            if (seg) u[0] = __float_as_uint(a[ht]);
            else { const f32x4 a0 = *(const f32x4*)(a + ht * 8), a1 = *(const f32x4*)(a + ht * 8 + 4);
                u[0] = __float_as_uint(a0.x); u[1] = __float_as_uint(a0.y); u[2] = __float_as_uint(a0.z); u[3] = __float_as_uint(a0.w);
                u[4] = __float_as_uint(a1.x); u[5] = __float_as_uint(a1.y); u[6] = __float_as_uint(a1.z); u[7] = __float_as_uint(a1.w); }
        }
        unsigned prefix = 0u, mask = 0u, kk = (unsigned)cap;
#pragma unroll 1
        for (int pass = 0; pass < 4; ++pass) {
            const int shift = 24 - 8 * pass;
            __syncthreads();
            hist[ht] = 0u;
            __syncthreads();
            if (valid) {
#pragma unroll
                for (int q = 0; q < 8; ++q) if (q < per && (u[q] & mask) == prefix) atomicAdd(&hist[(u[q] >> shift) & 255u], 1u);
            }
            __syncthreads();
            unsigned hv = hist[255 - ht], cum = hv;
#pragma unroll
            for (int o = 1; o < 64; o <<= 1) { const unsigned t = __shfl_up(cum, o); if (lane >= o) cum += t; }
            if (lane == 63) wtot[hw] = cum;
            __syncthreads();
            {
                unsigned off = 0u;
#pragma unroll
                for (int w = 0; w < 4; ++w) if (w < hw) off += wtot[w];
                cum += off;
                if (cum >= kk && cum - hv < kk) { bc[0] = 255u - (unsigned)ht; bc[1] = kk - (cum - hv); }
            }
            __syncthreads();
            prefix |= bc[0] << shift; mask |= 255u << shift; kk = bc[1];
        }
        unsigned cg = 0u, ce = 0u;
        if (valid) {
#pragma unroll
            for (int q = 0; q < 8; ++q) if (q < per) { cg += u[q] > prefix ? 1u : 0u; ce += u[q] == prefix ? 1u : 0u; }
        }
        unsigned pk = cg | (ce << 16), inc = pk;
#pragma unroll
        for (int o = 1; o < 64; o <<= 1) { const unsigned t = __shfl_up(inc, o); if (lane >= o) inc += t; }
        __syncthreads();
        if (lane == 63) wtot[hw] = inc;
        __syncthreads();
        unsigned off = 0u;
#pragma unroll
        for (int w = 0; w < 4; ++w) if (w < hw) off += wtot[w];
        unsigned excl = inc - pk + off, gb = excl & 0xffffu, eb = excl >> 16;
        if (valid) {
#pragma unroll
            for (int q = 0; q < 8; ++q) if (q < per) {
                const int i = ht * per + q, row = b * P + pos0 + i;
                const bool gt = u[q] > prefix, eq = u[q] == prefix, sel = gt || (eq && eb < kk);
                if (sel) { const int slot = slot0 + (int)(gb + (eb < kk ? eb : kk)); F.SEL[e * SLOTS + slot] = row; F.GATE[e * SLOTS + slot] = __uint_as_float(u[q]); F.INV[(size_t)row * NE + e] = slot; }
                else F.INV[(size_t)row * NE + e] = -1;
                gb += gt ? 1u : 0u; eb += eq ? 1u : 0u;
            }
        }
        __syncthreads();
    }
    __syncthreads();
}

typedef short bf16x8 __attribute__((ext_vector_type(8)));
typedef float f32x16 __attribute__((ext_vector_type(16)));
#define MFMA32(a, b, c) __builtin_amdgcn_mfma_f32_32x32x16_bf16((a), (b), (c), 0, 0, 0)
__device__ __forceinline__ int kperm(int m) { return (m & 0x13) | ((m & 8) >> 1) | ((m & 4) << 1); }
__device__ __forceinline__ bf16x8 pack8(const f32x16& x, int s8) {
    u32x4 p; p.x = pkbf(x[s8 + 0], x[s8 + 1]); p.y = pkbf(x[s8 + 2], x[s8 + 3]); p.z = pkbf(x[s8 + 4], x[s8 + 5]); p.w = pkbf(x[s8 + 6], x[s8 + 7]);
    return __builtin_bit_cast(bf16x8, p);
}
constexpr float LOG2E = 1.4426950408889634f;

__device__ __forceinline__ void ph_da_attn(const Frame& F) {
    const bf16* Q = (const bf16*)(F.ws + WS_Q); const bf16* K = (const bf16*)(F.ws + WS_K); const bf16* VT = (const bf16*)(F.ws + WS_VT); bf16* O = (bf16*)(F.ws + WS_O);
    const int tid = F.tid, lane = F.lane, l32 = lane & 31, hh = lane >> 5, map = F.wave & 1, qsub = F.wave >> 1;
    const float* lam = F.in[22];
    const float lam_full = expf(wave_sum(lam[lane] * lam[64 + lane])) - expf(wave_sum(lam[128 + lane] * lam[192 + lane])) + LAM_INIT;
    constexpr int KB = 64 * 144, VB = 128 * 144, BUF = 2 * KB + VB;
    unsigned char* sb = F.lds;
    float* xch = (float*)(F.lds + 2 * BUF) + qsub * 4096;
    const float c = 0.125f * LOG2E;
    const int kr = (tid >> 3) & 63, kc = tid & 7, vd = tid >> 3, vc = tid & 7;
    const int kdst = kr * 144 + kc * 16, vdst = 2 * KB + vd * 144 + vc * 16;
    const int kfrag = map * KB + kperm(l32) * 144 + hh * 16, vfrag = 2 * KB + l32 * 144 + hh * 16;
    const int vb = (F.nb & 7) == 0 ? (F.bid & 7) * (F.nb >> 3) + (F.bid >> 3) : F.bid;
    for (int it = vb; it < 4096 + 512; it += F.nb) {
        int b, h, pos0, nst;
        if (it < 4096) { b = it >> 7; h = (it >> 4) & 7; pos0 = NCTX + (it & 15) * 128 + qsub * 32; nst = P / 64; }
        else { const int j = it - 4096; b = j >> 4; h = (j >> 1) & 7; pos0 = (j & 1) * 128 + qsub * 32; nst = NCTX / 64; }
        const size_t qrow = (size_t)b * P + pos0 + l32;
        bf16x8 qf[4];
#pragma unroll
        for (int ks = 0; ks < 4; ++ks) qf[ks] = *(const bf16x8*)(Q + qrow * D + h * 128 + map * 64 + ks * 16 + hh * 8);
        f32x16 o[4];
#pragma unroll
        for (int dt = 0; dt < 4; ++dt)
#pragma unroll
            for (int j = 0; j < 16; ++j) o[dt][j] = 0.f;
        float m = 0.f, l = 0.f;
        const bf16* kg = K + ((size_t)b * P + kr) * D + h * 128 + kc * 8;
        const bf16* vg = VT + ((size_t)b * D + h * 128 + vd) * P + vc * 8;
        u32x4 ka0, ka1, va0, va1;
        { const u32x4 k0 = *(const u32x4*)kg, k1 = *(const u32x4*)(kg + 64), v0 = *(const u32x4*)vg, v1 = *(const u32x4*)(vg + (size_t)64 * P);
          const bf16* kq = kg + (size_t)64 * D; const bf16* vq = vg + 64;
          ka0 = *(const u32x4*)kq; ka1 = *(const u32x4*)(kq + 64); va0 = *(const u32x4*)vq; va1 = *(const u32x4*)(vq + (size_t)64 * P);
          *(u32x4*)(sb + kdst) = k0; *(u32x4*)(sb + KB + kdst) = k1; *(u32x4*)(sb + vdst) = v0; *(u32x4*)(sb + vdst + 64 * 144) = v1; }
        __syncthreads();
#pragma unroll 1
        for (int st = 0; st < nst; ++st) {
            const unsigned char* cb = sb + (st & 1) * BUF;
            u32x4 kn0 = (u32x4){0u, 0u, 0u, 0u}, kn1 = kn0, vn0 = kn0, vn1 = kn0;
            if (st + 2 < nst) { const bf16* kq = kg + (size_t)(st + 2) * 64 * D; const bf16* vq = vg + (st + 2) * 64;
                kn0 = *(const u32x4*)kq; kn1 = *(const u32x4*)(kq + 64); vn0 = *(const u32x4*)vq; vn1 = *(const u32x4*)(vq + (size_t)64 * P); }
#pragma unroll
            for (int sub = 0; sub < 2; ++sub) {
                f32x16 s;
#pragma unroll
                for (int j = 0; j < 16; ++j) s[j] = -m;
#pragma unroll
                for (int ks = 0; ks < 4; ++ks) s = MFMA32(*(const bf16x8*)(cb + kfrag + sub * 32 * 144 + ks * 32), qf[ks], s);
                float mx = s[0];
#pragma unroll
                for (int j = 1; j < 16; ++j) mx = fmaxf(mx, s[j]);
                mx = fmaxf(mx, __shfl_xor(mx, 32));
                const bool first = st == 0 && sub == 0;
                if (first || __any(mx > 8.0f)) {
                    const float d = first ? mx : fmaxf(mx, 0.f);
                    if (!first) { const float alpha = __builtin_amdgcn_exp2f(-d); l *= alpha;
#pragma unroll
                        for (int dt = 0; dt < 4; ++dt)
#pragma unroll
                            for (int j = 0; j < 16; ++j) o[dt][j] *= alpha; }
                    m += d;
#pragma unroll
                    for (int j = 0; j < 16; ++j) s[j] -= d;
                }
                float ps = 0.f;
#pragma unroll
                for (int j = 0; j < 16; ++j) { s[j] = __builtin_amdgcn_exp2f(s[j]); ps += s[j]; }
                l += ps;
                const bf16x8 p0 = pack8(s, 0), p1 = pack8(s, 8);
#pragma unroll
                for (int dt = 0; dt < 4; ++dt) { o[dt] = MFMA32(*(const bf16x8*)(cb + vfrag + dt * 32 * 144 + sub * 64), p0, o[dt]); o[dt] = MFMA32(*(const bf16x8*)(cb + vfrag + dt * 32 * 144 + sub * 64 + 32), p1, o[dt]); }
            }
            if (st + 1 < nst) { unsigned char* nb = sb + ((st + 1) & 1) * BUF; *(u32x4*)(nb + kdst) = ka0; *(u32x4*)(nb + KB + kdst) = ka1; *(u32x4*)(nb + vdst) = va0; *(u32x4*)(nb + vdst + 64 * 144) = va1; }
            ka0 = kn0; ka1 = kn1; va0 = vn0; va1 = vn1;
            __syncthreads();
        }
        l += __shfl_xor(l, 32);
        const float inv = 1.0f / l;
        if (map == 1) {
#pragma unroll
            for (int dt = 0; dt < 4; ++dt)
#pragma unroll
                for (int j = 0; j < 16; ++j) xch[(dt * 16 + j) * 64 + lane] = o[dt][j] * inv * lam_full;
        }
        __syncthreads();
        if (map == 0) {
            float ss = 0.f;
#pragma unroll
            for (int dt = 0; dt < 4; ++dt)
#pragma unroll
                for (int j = 0; j < 16; ++j) { const float v = o[dt][j] * inv - xch[(dt * 16 + j) * 64 + lane]; o[dt][j] = v; ss += v * v; }
            ss += __shfl_xor(ss, 32);
            const float rinv = rsqrtf(ss * (1.0f / 128.0f) + EPS) * (1.0f - LAM_INIT);
#pragma unroll
            for (int dt = 0; dt < 4; ++dt)
#pragma unroll
                for (int jq = 0; jq < 4; ++jq) {
                    const int d0 = dt * 32 + jq * 8 + hh * 4; const f32x4 sw = *(const f32x4*)(F.in[23] + d0);
                    u32x2 w; w.x = pkbf(o[dt][jq * 4 + 0] * rinv * sw.x, o[dt][jq * 4 + 1] * rinv * sw.y); w.y = pkbf(o[dt][jq * 4 + 2] * rinv * sw.z, o[dt][jq * 4 + 3] * rinv * sw.w);
                    *(u32x2*)(O + qrow * D + h * 128 + d0) = w;
                }
        }
        __syncthreads();
    }
}

__device__ __forceinline__ void ph_na_attn(const Frame& F) {
    const bf16* Q = (const bf16*)(F.ws + WS_Q); const bf16* K = (const bf16*)(F.ws + WS_K); const bf16* VT = (const bf16*)(F.ws + WS_VT); bf16* O = (bf16*)(F.ws + WS_O);
    const int tid = F.tid, lane = F.lane, l32 = lane & 31, hh = lane >> 5;
    constexpr int KB = 128 * 144, VP = 272, VB = 64 * VP, BUF = KB + VB;
    unsigned char* sb = F.lds;
    float* rp = (float*)(F.lds + 2 * BUF) + 64;
    for (int i = tid; i < 16 * 15 * 31 + 128; i += NTHREADS) { const int k = i - 64; rp[k] = (k >= 0 && k < 16 * 15 * 31) ? F.in[19][k] * LOG2E : 0.f; }
    __syncthreads();
    const float c = 0.125f * LOG2E;
    const int pr = tid >> 3, pc = tid & 7;
    const int kdst = pr * 144 + pc * 16, vdst = KB + pr * VP + pc * 16;
    const int kfrag = kperm(l32) * 144 + hh * 16, vfrag = KB + l32 * VP + hh * 16;
    const int vb = (F.nb & 7) == 0 ? (F.bid & 7) * (F.nb >> 3) + (F.bid >> 3) : F.bid;
    for (int it = vb; it < 4096 + 512; it += F.nb) {
        int b, h, r = 0, cq = 0, kc0 = 0, rlo = 0, rhi = 0, wr0 = 0, wr1 = 0, nt; bool lat; size_t qrow;
        if (it < 4096) { lat = true; b = it >> 7; h = (it >> 3) & 15; const int rg = ((it & 7) + (it >> 8)) & 7  ;
            const int rw = rg * 4 + (F.wave >> 2) * 2, cqt = F.wave & 3; r = rw + (l32 >> 4); cq = cqt * 16 + (l32 & 15); kc0 = min(max(cqt * 16 - 8, 0), 32);
            wr0 = min(max(rw - 4, 0), 24); wr1 = min(max(rw + 1 - 4, 0), 24) + 8;
            qrow = (size_t)b * P + NCTX + r * 64 + cq;
            rlo = min(max(rg * 4 - 4, 0), 24); rhi = min(max(rg * 4 + 3 - 4, 0), 24) + 7; nt = 2 + (rhi - rlo + 2) / 2; }
        else { lat = false; const int j = it - 4096; b = j >> 4; h = j & 15; qrow = (size_t)b * P + F.wave * 32 + l32; nt = 2; }
        const int r0 = min(max(r - 4, 0), 24), c0 = min(max(cq - 8, 0), 48);
        bf16x8 qf[4];
#pragma unroll
        for (int ks = 0; ks < 4; ++ks) qf[ks] = *(const bf16x8*)(Q + qrow * D + h * 64 + ks * 16 + hh * 8);
        float neg[16];
#pragma unroll
        for (int j = 0; j < 16; ++j) { const int kcol = kc0 + 16 * (j >> 3) + 8 * hh + 4 * ((j >> 2) & 1) + (j & 3); neg[j] = (kcol >= c0 && kcol < c0 + 16) ? 0.f : -1.0e30f; }
        f32x16 o[2];
#pragma unroll
        for (int dt = 0; dt < 2; ++dt)
#pragma unroll
            for (int j = 0; j < 16; ++j) o[dt][j] = 0.f;
        float m = -1.0e30f, l = 0.f;
        const bf16* kg = K + ((size_t)b * P + pr) * D + h * 64 + pc * 8;
        const bf16* vg = VT + ((size_t)b * D + h * 64 + pr) * P + pc * 8;
#define NA_KEYA(st) ((st) < 2 ? (st) * 128 : NCTX + (rlo + 2 * ((st) - 2)) * 64)
#define NA_KEYB(st) ((st) < 2 ? (st) * 128 + 64 : NCTX + min(rlo + 2 * ((st) - 2) + 1, 31) * 64)
#define NA_LOAD(dk0, dk1, dv0, dv1, st) do { const int ka_ = NA_KEYA(st), kb_ = NA_KEYB(st); dk0 = *(const u32x4*)(kg + (size_t)ka_ * D); dk1 = *(const u32x4*)(kg + (size_t)kb_ * D); \
        dv0 = *(const u32x4*)(vg + ka_); dv1 = *(const u32x4*)(vg + kb_); } while (0)
#define NA_STORE(buf, sk0, sk1, sv0, sv1) do { *(u32x4*)((buf) + kdst) = sk0; *(u32x4*)((buf) + kdst + 64 * 144) = sk1; *(u32x4*)((buf) + vdst) = sv0; *(u32x4*)((buf) + vdst + 128) = sv1; } while (0)
        u32x4 ka0, ka1, va0, va1;
        { u32x4 x0, x1, y0, y1; NA_LOAD(x0, x1, y0, y1, 0); NA_LOAD(ka0, ka1, va0, va1, 1); NA_STORE(sb, x0, x1, y0, y1); }
        __syncthreads();
#pragma unroll 1
        for (int st = 0; st < nt; ++st) {
            const unsigned char* cbuf = sb + (st & 1) * BUF;
            u32x4 kn0 = (u32x4){0u, 0u, 0u, 0u}, kn1 = kn0, vn0 = kn0, vn1 = kn0;
            if (st + 2 < nt) NA_LOAD(kn0, kn1, vn0, vn1, st + 2);
#define NA_TILE(KO_, WIN_, KROW_) do { const int ko = (KO_); \
                f32x16 s; \
                _Pragma("unroll") for (int j = 0; j < 16; ++j) s[j] = 0.f; \
                _Pragma("unroll") for (int ks = 0; ks < 4; ++ks) s = MFMA32(*(const bf16x8*)(cbuf + kfrag + ko * 144 + ks * 32), qf[ks], s); \
                if (WIN_) { const int krow = (KROW_); \
                    const float rmask = (krow >= r0 && krow < r0 + 8) ? 0.f : -1.0e30f;        \
                    const float* rph = rp + (h * 15 + (krow - r + 7)) * 31 - cq + 15 + 8 * hh + kc0;       \
                    _Pragma("unroll") for (int j = 0; j < 16; ++j) s[j] = (s[j] * c + rph[16 * (j >> 3) + 4 * ((j >> 2) & 1) + (j & 3)]) + (neg[j] + rmask); \
                } else { _Pragma("unroll") for (int j = 0; j < 16; ++j) s[j] *= c; } \
                float mx = s[0]; \
                _Pragma("unroll") for (int j = 1; j < 16; ++j) mx = fmaxf(mx, s[j]); \
                mx = fmaxf(mx, __shfl_xor(mx, 32)); \
                if (__any(mx > m + 8.0f)) { \
                    const float mn = fmaxf(m, mx), alpha = __builtin_amdgcn_exp2f(m - mn); m = mn; l *= alpha; \
                    _Pragma("unroll") for (int dt = 0; dt < 2; ++dt) _Pragma("unroll") for (int j = 0; j < 16; ++j) o[dt][j] *= alpha; \
                } \
                f32x2 ps2 = {0.f, 0.f}; \
                _Pragma("unroll") for (int j = 0; j < 16; j += 2) { f32x2 t = {s[j], s[j + 1]}; t = t - (f32x2){m, m}; t.x = __builtin_amdgcn_exp2f(t.x); t.y = __builtin_amdgcn_exp2f(t.y); s[j] = t.x; s[j + 1] = t.y; ps2 += t; } \
                l += ps2.x + ps2.y; \
                const bf16x8 p0 = pack8(s, 0), p1 = pack8(s, 8); \
                _Pragma("unroll") for (int dt = 0; dt < 2; ++dt) { o[dt] = MFMA32(*(const bf16x8*)(cbuf + vfrag + dt * 32 * VP + ko * 2), p0, o[dt]); o[dt] = MFMA32(*(const bf16x8*)(cbuf + vfrag + dt * 32 * VP + ko * 2 + 32), p1, o[dt]); } \
            } while (0)
            if (st < 2) {
#pragma unroll
                for (int sub = 0; sub < 4; ++sub) NA_TILE(sub * 32, false, 0);
            } else {
#pragma unroll
                for (int half = 0; half < 2; ++half) { const int krw = rlo + 2 * (st - 2) + half;
                    if (krw <= rhi && krw >= wr0 && krw < wr1) NA_TILE(half * 64 + kc0, true, krw); }
            }
#undef NA_TILE
            if (st + 1 < nt) { unsigned char* nb = sb + ((st + 1) & 1) * BUF; NA_STORE(nb, ka0, ka1, va0, va1); }
            ka0 = kn0; ka1 = kn1; va0 = vn0; va1 = vn1;
            __syncthreads();
        }
#undef NA_KEYA
#undef NA_KEYB
#undef NA_LOAD
#undef NA_STORE
        l += __shfl_xor(l, 32);
        const float inv = 1.0f / l;
#pragma unroll
        for (int dt = 0; dt < 2; ++dt)
#pragma unroll
            for (int jq = 0; jq < 4; ++jq) {
                const int d0 = dt * 32 + jq * 8 + hh * 4;
                u32x2 w; w.x = pkbf(o[dt][jq * 4 + 0] * inv, o[dt][jq * 4 + 1] * inv); w.y = pkbf(o[dt][jq * 4 + 2] * inv, o[dt][jq * 4 + 3] * inv);
                *(u32x2*)(O + qrow * D + h * 64 + d0) = w;
            }
    }
    __syncthreads();
}

__device__ __forceinline__ f32x4 unpk4(u32x2 w) { return (f32x4){bflo(w.x), bfhi(w.x), bflo(w.y), bfhi(w.y)}; }
__device__ __forceinline__ bf16 bf1(float x) { return (bf16)(pkbf(x, 0.f) & 0xffffu); }
__device__ __forceinline__ f32x4 shx32(f32x4 v) { return (f32x4){__shfl_xor(v.x, 32), __shfl_xor(v.y, 32), __shfl_xor(v.z, 32), __shfl_xor(v.w, 32)}; }
template <int DIR>
__device__ __forceinline__ void hgrn_seq(const Frame& F, int b, int h, int eb) {
    const bf16* ZIN = (const bf16*)(F.ws + WS_ZIN); const bf16* VTG = (const bf16*)(F.ws + WS_VTG); bf16* OUT = (bf16*)(F.ws + (DIR ? WS_OFB : WS_OFF));
    const int lane = F.lane, l32 = lane & 31, hh = lane >> 5, cperm = kperm(l32);
    constexpr int IMG = 32 * 136 * 2, KTB = 128 * 80, DBUF = 2 * IMG + KTB + 512;
    unsigned char* dbase = F.lds + DIR * 2 * DBUF;
    const int tg = lane & 7, prho = 8 * eb + (lane >> 3), pc = kperm(prho);
    f32x16 S[4];
#pragma unroll
    for (int d = 0; d < 4; ++d)
#pragma unroll
        for (int j = 0; j < 16; ++j) S[d][j] = 0.f;
    const bf16* vbase = VTG + ((size_t)b * D + h * 128 + eb * 32 + l32) * P + hh * 8;
    const bf16* zp = ZIN + ((size_t)b * P + 4 * tg) * 4096 + h * 128 + 4 * prho;
#define HG_CHUNK(i_) (DIR == 0 ? (i_) : ((i_) < 8 ? 7 - (i_) : 79 - (i_)))
#define HG_LOAD(i_) do { const int c_ = HG_CHUNK(i_); const bf16* z_ = zp + (size_t)c_ * 32 * 4096; \
        _Pragma("unroll") for (int i = 0; i < 4; ++i) { nlf[i] = *(const u32x2*)(z_ + (size_t)i * 4096 + (1 + DIR) * D); nq[i] = *(const u32x2*)(z_ + (size_t)i * 4096); } \
        nv0 = *(const bf16x8*)(vbase + c_ * 32); nv1 = *(const bf16x8*)(vbase + c_ * 32 + 16); } while (0)
    u32x2 nlf[4], nq[4]; bf16x8 nv0, nv1;
    HG_LOAD(0);
#pragma unroll 1
    for (int idx = 0; idx < 72; ++idx) {
        const int cc = HG_CHUNK(idx);
        const size_t row0 = (size_t)b * P + cc * 32;
        unsigned char* buf = dbase + (idx & 1) * DBUF;
        bf16* Qp = (bf16*)buf; bf16* Kp = (bf16*)(buf + IMG); bf16* KT = (bf16*)(buf + 2 * IMG); float* egl = (float*)(buf + 2 * IMG + KTB);
        u32x2 lfc[4], qc[4];
#pragma unroll
        for (int i = 0; i < 4; ++i) { lfc[i] = nlf[i]; qc[i] = nq[i]; }
        const bf16x8 vf0 = nv0, vf1 = nv1;
        HG_LOAD(min(idx + 1, 71));
        f32x4 l4[4], t = (f32x4){0.f, 0.f, 0.f, 0.f};
#pragma unroll
        for (int i = 0; i < 4; ++i) { l4[i] = unpk4(lfc[i]); t += l4[i]; }
        f32x4 x = t;
#pragma unroll
        for (int k = 1; k < 8; k <<= 1) { const f32x4 y = (f32x4){__shfl_up(x.x, k, 8), __shfl_up(x.y, k, 8), __shfl_up(x.z, k, 8), __shfl_up(x.w, k, 8)}; if (tg >= k) x += y; }
        const f32x4 tot = (f32x4){__shfl(x.x, 7, 8), __shfl(x.y, 7, 8), __shfl(x.z, 7, 8), __shfl(x.w, 7, 8)};
        const f32x4 off = DIR == 0 ? x - t : tot - x;
        f32x4 eg = (f32x4){__builtin_amdgcn_exp2f(off.x), __builtin_amdgcn_exp2f(off.y), __builtin_amdgcn_exp2f(off.z), __builtin_amdgcn_exp2f(off.w)}; float kv[4][4];
#pragma unroll
        for (int ii = 0; ii < 4; ++ii) {
            const int i = DIR ? 3 - ii : ii;
            const f32x4 lf = l4[i], q4 = unpk4(qc[i]);
            const int srow = (4 * tg + i) * 136 + pc;
#pragma unroll
            for (int d = 0; d < 4; ++d) { const float f = __builtin_amdgcn_exp2f(lf[d]); eg[d] *= f; const float kq = (1.0f - f) * __builtin_amdgcn_rcpf(eg[d]);
                Qp[srow + d * 32] = bf1(q4[d] * eg[d]); Kp[srow + d * 32] = bf1(kq); kv[d][i] = kq; }
        }
#pragma unroll
        for (int d = 0; d < 4; ++d) { u32x2 w; w.x = pkbf(kv[d][0], kv[d][1]); w.y = pkbf(kv[d][2], kv[d][3]); *(u32x2*)(KT + (d * 32 + prho) * 40 + 4 * tg) = w; }
        if (tg == 0) *(f32x4*)(egl + 4 * prho) = (f32x4){__builtin_amdgcn_exp2f(tot.x), __builtin_amdgcn_exp2f(tot.y), __builtin_amdgcn_exp2f(tot.z), __builtin_amdgcn_exp2f(tot.w)};
        __syncthreads();
        bf16x8 kf[4][2];
#pragma unroll
        for (int d = 0; d < 4; ++d)
#pragma unroll
            for (int sg = 0; sg < 2; ++sg) kf[d][sg] = *(const bf16x8*)(KT + (d * 32 + l32) * 40 + sg * 16 + 8 * hh);
        if (cc >= NCTX / 32) {
        f32x16 att, o;
#pragma unroll
        for (int j = 0; j < 16; ++j) { att[j] = 0.f; o[j] = 0.f; }
        const bf16* krow = Kp + cperm * 136 + hh * 8; const bf16* qrow = Qp + l32 * 136 + hh * 8;
#pragma unroll
        for (int ks = 0; ks < 8; ++ks) { att = MFMA32(*(const bf16x8*)(krow + ks * 16), *(const bf16x8*)(qrow + ks * 16), att);
            o = MFMA32(pack8(S[ks >> 1], (ks & 1) * 8), *(const bf16x8*)(qrow + (ks >> 1) * 32 + (ks & 1) * 16), o); }
#pragma unroll
        for (int j = 0; j < 16; ++j) { const int sa = 16 * (j >> 3) + 8 * hh + 4 * ((j >> 2) & 1) + (j & 3); const bool keep = DIR == 0 ? (sa <= l32) : (sa >= l32); att[j] = keep ? att[j] : 0.f; }
        const bf16x8 p0 = pack8(att, 0), p1 = pack8(att, 8);
        o = MFMA32(vf0, p0, o); o = MFMA32(vf1, p1, o);
        bf16* op = OUT + (row0 + l32) * D + h * 128 + eb * 32 + 4 * hh;
#pragma unroll
        for (int jq = 0; jq < 4; ++jq) { u32x2 w; w.x = pkbf(o[4 * jq], o[4 * jq + 1]); w.y = pkbf(o[4 * jq + 2], o[4 * jq + 3]); *(u32x2*)(op + 8 * jq) = w; }
        }
#pragma unroll
        for (int d = 0; d < 4; ++d) { S[d] = MFMA32(kf[d][0], vf0, S[d]); S[d] = MFMA32(kf[d][1], vf1, S[d]); }
#pragma unroll
        for (int j = 0; j < 16; ++j) { const int rho = (j & 3) + 8 * (j >> 2) + 4 * hh; const f32x4 e4 = *(const f32x4*)(egl + 4 * rho);
            S[0][j] *= e4.x; S[1][j] *= e4.y; S[2][j] *= e4.z; S[3][j] *= e4.w; }
    }
#undef HG_LOAD
#undef HG_CHUNK
}
__device__ __forceinline__ void ph_hgrn_scan(const Frame& F) {
    for (int id = F.bid * NWAVES + F.wave; id < NB * 8 * 8; id += F.nb * NWAVES) {
        const int eb = id & 3, dir = (id >> 2) & 1, h = (id >> 3) & 7, b = id >> 6;
        if (dir == 0) hgrn_seq<0>(F, b, h, eb); else hgrn_seq<1>(F, b, h, eb);
    }
}
__device__ __forceinline__ void ph_hgrn_post(const Frame& F) {
    const bf16* ZIN = (const bf16*)(F.ws + WS_ZIN); const bf16* OFF = (const bf16*)(F.ws + WS_OFF); const bf16* OFB = (const bf16*)(F.ws + WS_OFB); bf16* O2 = (bf16*)(F.ws + WS_O2);
    const int lane = F.lane, part = lane & 7;
    f32x4 gn[4];
#pragma unroll
    for (int q = 0; q < 4; ++q) gn[q] = *(const f32x4*)(F.in[26] + part * 16 + q * 4);
    for (int row = F.bid * NWAVES + F.wave; row < R; row += F.nb * NWAVES) {
        if (row % P < NCTX) continue;
        const size_t o = (size_t)row * D + lane * 16;
        const u32x4 a0 = *(const u32x4*)(OFF + o), a1 = *(const u32x4*)(OFF + o + 8), b0 = *(const u32x4*)(OFB + o), b1 = *(const u32x4*)(OFB + o + 8);
        const u32x4 g0 = *(const u32x4*)(ZIN + (size_t)row * 4096 + 3 * D + lane * 16), g1 = *(const u32x4*)(ZIN + (size_t)row * 4096 + 3 * D + lane * 16 + 8);
        float v[16];
        v[0] = bflo(a0.x) + bflo(b0.x); v[1] = bfhi(a0.x) + bfhi(b0.x); v[2] = bflo(a0.y) + bflo(b0.y); v[3] = bfhi(a0.y) + bfhi(b0.y);
        v[4] = bflo(a0.z) + bflo(b0.z); v[5] = bfhi(a0.z) + bfhi(b0.z); v[6] = bflo(a0.w) + bflo(b0.w); v[7] = bfhi(a0.w) + bfhi(b0.w);
        v[8] = bflo(a1.x) + bflo(b1.x); v[9] = bfhi(a1.x) + bfhi(b1.x); v[10] = bflo(a1.y) + bflo(b1.y); v[11] = bfhi(a1.y) + bfhi(b1.y);
        v[12] = bflo(a1.z) + bflo(b1.z); v[13] = bfhi(a1.z) + bfhi(b1.z); v[14] = bflo(a1.w) + bflo(b1.w); v[15] = bfhi(a1.w) + bfhi(b1.w);
        float ss = 0.f;
#pragma unroll
        for (int q = 0; q < 16; ++q) ss += v[q] * v[q];
        ss += dpp_xor1(ss); ss += dpp_xor2(ss); ss += __shfl_xor(ss, 4);
        const float rinv = rsqrtf(ss * (1.0f / 128.0f) + EPS);
        const unsigned gw[8] = {g0.x, g0.y, g0.z, g0.w, g1.x, g1.y, g1.z, g1.w};
        unsigned w[8];
#pragma unroll
        for (int q = 0; q < 8; ++q) w[q] = pkbf(v[2 * q] * rinv * gn[q >> 1][(2 * q) & 3] * bflo(gw[q]), v[2 * q + 1] * rinv * gn[q >> 1][(2 * q + 1) & 3] * bfhi(gw[q]));
        *(u32x4*)(O2 + o) = (u32x4){w[0], w[1], w[2], w[3]}; *(u32x4*)(O2 + o + 8) = (u32x4){w[4], w[5], w[6], w[7]};
    }
}

enum { PH_BASE = __COUNTER__ };
__global__ void __launch_bounds__(NTHREADS, 2) fwd(Args args) {
    extern __shared__ __attribute__((aligned(16))) unsigned char lds[];
    Frame F;
    F.lds = lds; F.wave = __builtin_amdgcn_readfirstlane((int)threadIdx.x >> 6); F.bid = blockIdx.x; F.nb = gridDim.x;
    REFRESH_(F);
    F.in = args.in; F.out = args.out; F.ws = args.ws;
    F.MOD = (float*)(args.ws + WS_MOD); F.AFF = (float*)(args.ws + WS_AFF); F.SEL = (int*)(args.ws + WS_SEL); F.GATE = (float*)(args.ws + WS_GATE); F.INV = (int*)(args.ws + WS_INV);
    F.X = (bf16*)(args.ws + WS_X); F.H = (bf16*)(args.ws + WS_H);
    const int lo = args.ph_lo, hi = args.ph_hi;
#if MK_SINGLE
    volatile LAS unsigned* misc = (volatile LAS unsigned*)((LAS unsigned char*)lds + LDS_MISC);
    if (F.tid < 64) misc[F.tid] = 0u;
    __syncthreads();
    XcdBarrier bar = xcd_barrier_post((unsigned*)(args.ws + WS_CTL) + CW_BAR, misc, F.tid);
#define SEAM(k) do { if ((k) + 1 < hi) xcd_barrier(bar, F.tid); } while (0)
#else
#define SEAM(k) do { } while (0)
#endif
#define PH(...) do { constexpr int k_ = __COUNTER__ - PH_BASE - 1; if (lo <= k_ && k_ < hi) { REFRESH_(F); __VA_ARGS__; SEAM(k_); } } while (0)
    bf16* HID = (bf16*)(F.ws + WS_HID); bf16* Y = (bf16*)(F.ws + WS_Y);
    PG8_LAS unsigned char* ring = (PG8_LAS unsigned char*)lds;
    bf16 *Qb = (bf16*)(F.ws + WS_Q), *VTb = (bf16*)(F.ws + WS_VT), *Ob = (bf16*)(F.ws + WS_O);

#define GEMM_PHASE(EPI, gA, lda_, gB, ldb_, gK, nM_, nN_, groups_, gsM_, ...) do { const pg8::Gemm g_{(const bf16*)(gA), (const bf16*)(gB), (lda_), (ldb_), (gK), nullptr}; pg8::GroupedOrder S_; S_.init((nM_), (nN_), (groups_), (gsM_), F.nb, F.bid); \
        const EPI E_{__VA_ARGS__}; pg8::gemm_phase<EPI, pg8::GroupedOrder, PG8_ALIGN, PG8_SP2>(ring, g_, S_, E_, F.tid); } while (0)
#define GEMM_PHASE_LAT(EPI, gA, lda_, gB, ldb_, gK, nN_, ...) do { const pg8::Gemm g_{(const bf16*)(gA), (const bf16*)(gB), (lda_), (ldb_), (gK), nullptr}; pg8::LatentOrder S_; S_.init((nN_), F.nb, F.bid); \
        const EPI E_{__VA_ARGS__}; pg8::gemm_phase<EPI, pg8::LatentOrder, PG8_ALIGN, PG8_SP2>(ring, g_, S_, E_, F.tid); } while (0)
#define GEMM_PHASE_GATHER(EPI, gA, lda_, gIdx, gB, ldb_, gK, nM_, nN_, groups_, gsM_, ...) do { const pg8::Gemm g_{(const bf16*)(gA), (const bf16*)(gB), (lda_), (ldb_), (gK), (gIdx)}; pg8::GroupedOrder S_; S_.init((nM_), (nN_), (groups_), (gsM_), F.nb, F.bid); \
        const EPI E_{__VA_ARGS__}; pg8::gemm_phase<EPI, pg8::GroupedOrder, PG8_ALIGN, PG8_SP2, true>(ring, g_, S_, E_, F.tid); } while (0)
#define MODL(L) (F.MOD + (size_t)(L) * 33 * 6144)
#define MOE_PHASES(L, NMT, NITEMS, SKIPC) \
    PH(ph_norm2<SKIPC>(F, (L))); \
    PH(ph_topk(F, (NITEMS))); \
    PH(GEMM_PHASE_GATHER(pg8::EpiSwigluT, F.H, D, F.SEL, F.ws + WO_GU, D, D, (NMT), 2 * FF / 256, NE, SLOTS / 256, HID, 2 * FF / 256, FF)); \
    PH(GEMM_PHASE(pg8::EpiDownT, HID, FF, F.ws + WO_DN, FF, FF, (NMT), D / 256, NE, SLOTS / 256, Y, F.GATE, D / 256));
#define OUT_PROJ(Asrc, Wsrc, L) PH(GEMM_PHASE(pg8::EpiResidT, (Asrc), D, (Wsrc), D, D, R / 256, D / 256, 1, R / 256, F.X, MODL(L)));

    PH(ph_prologue(F));
    PH(ph_norm<0, false, true, false, true>(F, 0, 0));
    PH(GEMM_PHASE(pg8::EpiF32G, F.ws + WS_AG, 768, F.ws + WS_S5W1, 512, 512, 2304 / 256, 1, 64, 2304 / 256, (float*)(F.ws + WS_SS), 256, 1));
    PH(ph_s5_scan(F));
    PH(GEMM_PHASE(pg8::EpiS5Out, F.ws + WS_AG, 768, F.ws + WS_S5W2, 768, 768, 2304 / 256, 2, 64, 2304 / 256, F.H, (bf16*)(F.ws + WS_Z), F.in[15]));
    PH(GEMM_PHASE(pg8::EpiGluT, F.ws + WS_Z, D, F.ws + WO_GLU, D, D, R / 256, 2 * D / 256, 1, R / 256, F.X, MODL(0)));
    MOE_PHASES(0, SLOTS / 256, NB * NE * 2, false)
    PH(ph_norm<0, true>(F, 1, 0); convert_moe(F, 1));
    PH(GEMM_PHASE(pg8::EpiBf16<0>, F.H, D, F.ws + WO_NAQKV, D, D, R / 256, 2 * D / 256, 1, R / 256, Qb, D, nullptr, D, (size_t)(WS_K - WS_Q) / 2, 1.0f);
       GEMM_PHASE(pg8::EpiVtT<false>, F.ws + WO_NAQKV + (size_t)2 * D * D * 2, D, F.H, D, D, D / 256, R / 256, 1, D / 256, VTb));
    PH(ph_na_attn(F));
    OUT_PROJ(Ob, F.ws + WO_NAO, 1)
    MOE_PHASES(1, SLOTS / 256, NB * NE * 2, false)
    PH(ph_norm<0, true>(F, 2, 1); convert_moe(F, 2));
    PH(GEMM_PHASE(pg8::EpiQKRope, F.H, D, F.ws + WO_DAQKV, D, D, R / 256, 2 * D / 256, 1, R / 256, Qb, (size_t)(WS_K - WS_Q) / 2, (const float*)(F.ws + WS_ROPE));
       GEMM_PHASE(pg8::EpiVtT<false>, F.ws + WO_DAQKV + (size_t)2 * D * D * 2, D, F.H, D, D, D / 256, R / 256, 1, D / 256, VTb));
    PH(ph_da_attn(F));
    OUT_PROJ(Ob, F.ws + WO_DAO, 2)
    MOE_PHASES(2, SLOTS / 256, NB * NE * 2, false)
    PH(ph_norm<0, true>(F, 3, 2); convert_moe(F, 3));
    PH({ const pg8::Gemm g_{(const bf16*)F.H, (const bf16*)(F.ws + WO_HGIN), D, D, D, nullptr}; pg8::HgInOrder S_; S_.init(F.nb, F.bid);
         const pg8::EpiHgIn E_{(bf16*)(F.ws + WS_ZIN), (const float*)(F.ws + WS_LB)}; pg8::gemm_phase<pg8::EpiHgIn, pg8::HgInOrder, PG8_ALIGN, PG8_SP2>(ring, g_, S_, E_, F.tid); }
       GEMM_PHASE(pg8::EpiVtT<true>, F.ws + WO_HGIN + (size_t)4 * D * D * 2, D, F.H, D, D, D / 256, R / 256, 1, D / 256, (bf16*)(F.ws + WS_VTG)));
    PH(ph_hgrn_scan(F));
    PH(ph_hgrn_post(F));
    PH(GEMM_PHASE_LAT(pg8::EpiResidT, F.ws + WS_O2, D, F.ws + WO_HGO, D, D, D / 256, F.X, MODL(3)));
    MOE_PHASES(3, NB, NB * NE, true)
    PH(ph_norm<2, true, false, true>(F, 0, 3));
}
constexpr int NPH = __COUNTER__ - PH_BASE - 1;

extern "C" void kernel_launch(void* const* d_in, const int* in_sizes, int n_in, void* d_out, int out_size, void* d_ws, size_t ws_size, hipStream_t stream) {
    static int grid = 0;
    if (grid == 0) {
        if (n_in != 33 || ws_size < WS_NEED) { fprintf(stderr, "kernel_launch: n_in %d ws %zu (need %zu)\n", n_in, ws_size, (size_t)WS_NEED); grid = -1; return; }
        int dev = 0, cus = 0;
        if (hipGetDevice(&dev) != hipSuccess || hipDeviceGetAttribute(&cus, hipDeviceAttributeMultiprocessorCount, dev) != hipSuccess) { grid = -1; return; }
        if (hipFuncSetAttribute((const void*)fwd, hipFuncAttributeMaxDynamicSharedMemorySize, LDS_BYTES) != hipSuccess) { fprintf(stderr, "kernel_launch: hipFuncSetAttribute failed\n"); grid = -1; return; }
        int per_cu = 0;
        if (hipOccupancyMaxActiveBlocksPerMultiprocessor(&per_cu, (const void*)fwd, NTHREADS, LDS_BYTES) != hipSuccess || per_cu < 1) fprintf(stderr, "kernel_launch: occupancy query says %d\n", per_cu);
        (void)hipGetLastError();
        grid = cus;
    }
    if (grid < 0) return;
    (void)hipMemsetAsync((char*)d_ws + WS_CTL + (size_t)CW_BAR * 4, 0, (size_t)XCD_BAR_WORDS * 4, stream);
    Args a{};
    for (int i = 0; i < 33; ++i) a.in[i] = (const float*)d_in[i];
    a.out = (float*)d_out; a.ws = (unsigned char*)d_ws;
#if MK_SINGLE
    a.ph_lo = 0; a.ph_hi = NPH;
    hipLaunchKernelGGL(fwd, dim3(grid), dim3(NTHREADS), LDS_BYTES, stream, a);
#else
    for (int k = 0; k < NPH; ++k) { a.ph_lo = k; a.ph_hi = k + 1; hipLaunchKernelGGL(fwd, dim3(grid), dim3(NTHREADS), LDS_BYTES, stream, a); }
#endif
}
```

```cpp
#include <hip/hip_runtime.h>
#include <cstdio>
#include <cstdint>

#ifndef MK_SINGLE
#define MK_SINGLE 1
#endif

typedef unsigned short bf16;
typedef float f32x4 __attribute__((ext_vector_type(4)));
typedef float f32x2 __attribute__((ext_vector_type(2)));
typedef unsigned u32x2 __attribute__((ext_vector_type(2)));
typedef unsigned u32x4 __attribute__((ext_vector_type(4)));
#define LAS __attribute__((address_space(3)))

constexpr int NB = 32, SEQ = 2048, NCTX = 256, D = 1024, P = NCTX + SEQ  , R = NB * P  ;
constexpr int NE = 16, FF = 2048, SLOTS = NB * 256 + NB * 32  ;
constexpr float EPS = 1e-6f;
constexpr float LOG2E_ = 1.4426950408889634f;
constexpr float LAM_INIT = 0.47071302f;
constexpr int NWAVES = 8, NTHREADS = 512;
constexpr int LDS_BYTES = 147456;
constexpr int LDS_MISC = 147456 - 256;

constexpr size_t MiB = 1u << 20;
constexpr size_t WS_CTL = 0, CTL_ZERO_BYTES = 1 * MiB;
constexpr size_t WS_MOD = 1 * MiB;
constexpr size_t WS_AFF = 5 * MiB;
constexpr size_t WS_SEL = 10 * MiB;
constexpr size_t WS_GATE = 11 * MiB;
constexpr size_t WS_INV = 12 * MiB;
constexpr size_t WS_X = 32 * MiB;
constexpr size_t WS_H = 320 * MiB;
constexpr size_t WS_W = 464 * MiB;
constexpr size_t WS_BIG = 720 * MiB;
constexpr size_t WS_HID = WS_BIG;
constexpr size_t WS_Y = WS_BIG + 576 * MiB;
constexpr size_t WS_XS = WS_BIG + 864 * MiB;
constexpr size_t WS_AG = WS_BIG;
constexpr size_t WS_SS = WS_BIG + 216 * MiB;
constexpr size_t WS_Z = WS_BIG + 360 * MiB;
constexpr size_t WS_S5W1 = WS_BIG + 504 * MiB;
constexpr size_t WS_S5W2 = WS_BIG + 520 * MiB;
constexpr size_t WS_S5A = WS_BIG + 568 * MiB;
constexpr size_t WS_Q = WS_BIG, WS_K = WS_BIG + 144 * MiB, WS_V = WS_BIG + 288 * MiB, WS_VT = WS_BIG + 432 * MiB, WS_O = WS_BIG + 576 * MiB;
constexpr size_t WS_ZIN = WS_BIG;
constexpr size_t WS_VTG = WS_BIG + 576 * MiB;
constexpr size_t WS_OFF = WS_BIG + 720 * MiB;
constexpr size_t WS_OFB = WS_BIG + 1008 * MiB;
constexpr size_t WS_O2 = WS_H;
constexpr size_t WS_LB = 17 * MiB;
constexpr size_t WS_ROPE = 18 * MiB;
constexpr size_t WS_NEED = 2048 * MiB;
constexpr size_t WO_GLU = WS_W, WO_NAQKV = WS_W + 4 * MiB, WO_NAO = WS_W + 10 * MiB, WO_DAQKV = WS_W + 12 * MiB, WO_DAO = WS_W + 18 * MiB, WO_HGIN = WS_W + 20 * MiB, WO_HGO = WS_W + 30 * MiB;
constexpr size_t WO_GU = WS_W + 32 * MiB  , WO_DN = WS_W + 160 * MiB  ;
constexpr int CW_BAR = 4096;

__device__ __forceinline__ unsigned f2bf(float f) { unsigned u = __builtin_bit_cast(unsigned, f); return (u + 0x7fffu + ((u >> 16) & 1u)) >> 16; }
__device__ __forceinline__ float bf2f(unsigned h) { return __builtin_bit_cast(float, h << 16); }
__device__ __forceinline__ unsigned pk2(float lo, float hi) { return f2bf(lo) | (f2bf(hi) << 16); }
typedef __bf16 bf16x2_t __attribute__((ext_vector_type(2)));
__device__ __forceinline__ unsigned pkbf(float lo, float hi) { const f32x2 v = {lo, hi}; return __builtin_bit_cast(unsigned, __builtin_convertvector(v, bf16x2_t)); }
__device__ __forceinline__ float bflo(unsigned w) { return __builtin_bit_cast(float, w << 16); }
__device__ __forceinline__ float bfhi(unsigned w) { return __builtin_bit_cast(float, w & 0xffff0000u); }
__device__ __forceinline__ float wave_sum(float v) {
#pragma unroll
    for (int o = 1; o < 64; o <<= 1) v += __shfl_xor(v, o);
    return v;
}
__device__ __forceinline__ float wave_max(float v) {
#pragma unroll
    for (int o = 1; o < 64; o <<= 1) v = fmaxf(v, __shfl_xor(v, o));
    return v;
}
__device__ __forceinline__ float sigmoidf_(float x) { return 1.0f / (1.0f + expf(-x)); }
__device__ __forceinline__ float siluf_(float x) { return x / (1.0f + expf(-x)); }
__device__ __forceinline__ float gelu_tanh(float x) { return 0.5f * x * (1.0f + tanhf(0.7978845608028654f * (x + 0.044715f * x * x * x))); }
__device__ __forceinline__ float dpp_xor1(float v) { return __builtin_bit_cast(float, __builtin_amdgcn_update_dpp(0, __builtin_bit_cast(int, v), 0xB1, 0xF, 0xF, true)); }
__device__ __forceinline__ float dpp_xor2(float v) { return __builtin_bit_cast(float, __builtin_amdgcn_update_dpp(0, __builtin_bit_cast(int, v), 0x4E, 0xF, 0xF, true)); }
__device__ __forceinline__ float reduce16(float (&v)[16], int lane) {
    const bool b0 = lane & 1, b1 = lane & 2, b2 = lane & 4, b3 = lane & 8;
    float a[8];
#pragma unroll
    for (int k = 0; k < 8; ++k) { const float snd = b0 ? v[k] : v[8 + k], kep = b0 ? v[8 + k] : v[k]; a[k] = kep + dpp_xor1(snd); }
    float c[4];
#pragma unroll
    for (int k = 0; k < 4; ++k) { const float snd = b1 ? a[k] : a[4 + k], kep = b1 ? a[4 + k] : a[k]; c[k] = kep + dpp_xor2(snd); }
    float d[2];
#pragma unroll
    for (int k = 0; k < 2; ++k) { const float snd = b2 ? c[k] : c[2 + k], kep = b2 ? c[2 + k] : c[k]; d[k] = kep + __shfl_xor(snd, 4); }
    float r = (b3 ? d[1] : d[0]) + __shfl_xor(b3 ? d[0] : d[1], 8);
    r += __shfl_xor(r, 16); r += __shfl_xor(r, 32);
    return r;
}
#define WAVE_LDS_SYNC() asm volatile("s_waitcnt lgkmcnt(0)" ::: "memory")

#define XB_TMO      128
#define XB_XCNT(j)  (256  + 64 * (j))
#define XB_XSUB(j)  (1280 + 64 * (j))
#define XB_XGEN(j)  (2304 + 64 * (j))
#define XB_TOP      3328
#define XB_TOPGEN   3392
#define XCD_BAR_WORDS 3456
#define XB_SPIN_CAP (1u << 27)
__device__ __forceinline__ unsigned xb_ld(unsigned* p)              { return __hip_atomic_load(p, __ATOMIC_RELAXED, __HIP_MEMORY_SCOPE_AGENT); }
__device__ __forceinline__ unsigned xb_add(unsigned* p, unsigned v) { return __hip_atomic_fetch_add(p, v, __ATOMIC_RELAXED, __HIP_MEMORY_SCOPE_AGENT); }
__device__ __forceinline__ unsigned xb_xcc_id() { return (unsigned)__builtin_amdgcn_s_getreg((3 << 11) | 20) & 0xFu; }
#define XB_SPIN(cond, bar) do { unsigned _sp = 0; while (cond) { __builtin_amdgcn_s_sleep(1); \
    if ((++_sp & 255u) == 0u) { if (xb_ld(&(bar)[XB_TMO])) break; if (_sp > XB_SPIN_CAP) { atomicAdd(&(bar)[XB_TMO], 1u); break; } } } } while (0)
struct XcdBarrier { unsigned* bar; unsigned x; volatile LAS unsigned* st; };
__device__ __forceinline__ XcdBarrier xcd_barrier_post(unsigned* bar, volatile LAS unsigned* st, int tid_) {
    XcdBarrier b; b.bar = bar; b.x = xb_xcc_id(); b.st = st;
    if (tid_ == 0) (void)xb_add(&bar[XB_XCNT(b.x)], 1u);
    return b;
}
__device__ __forceinline__ void xcd_barrier_complete(unsigned* bar, unsigned x, unsigned& nloc, unsigned& nx) {
    const unsigned G = gridDim.x * gridDim.y * gridDim.z;
    unsigned sum, cnt, mine, sp = 0u;
    for (;;) {
        sum = 0u; cnt = 0u; mine = 0u;
#pragma unroll
        for (unsigned j = 0; j < 16; ++j) { const unsigned c = xb_ld(&bar[XB_XCNT(j)]); sum += c; cnt += (c > 0u) ? 1u : 0u; mine = (j == x) ? c : mine; }
        if (sum == G) break;
        __builtin_amdgcn_s_sleep(1);
        if ((++sp & 255u) == 0u) { if (xb_ld(&bar[XB_TMO])) break; if (sp > XB_SPIN_CAP) { atomicAdd(&bar[XB_TMO], 1u); break; } }
    }
    nloc = mine > 0u ? mine : 1u; nx = cnt > 0u ? cnt : 1u;
}
__device__ __forceinline__ void xcd_barrier(const XcdBarrier& b, int tid_) {
    asm volatile("s_waitcnt vmcnt(0)" ::: "memory");
    __syncthreads();
    if (tid_ == 0) {
        unsigned* bar = b.bar;
        __builtin_amdgcn_s_waitcnt(0);
        unsigned nloc = b.st[0], nx = b.st[1];
        if (nloc == 0u) { xcd_barrier_complete(bar, b.x, nloc, nx); b.st[0] = nloc; b.st[1] = nx; }
        const unsigned old = xb_add(&bar[XB_XSUB(b.x)], 1u);
        const unsigned gen = old / nloc;
        if (old + 1u == (gen + 1u) * nloc) {
            __builtin_amdgcn_fence(__ATOMIC_RELEASE, "agent");
            asm volatile("s_waitcnt vmcnt(0)" ::: "memory");
            const unsigned og = xb_add(&bar[XB_TOP], 1u);
            const unsigned tg = og / nx;
            if (og + 1u == (tg + 1u) * nx) xb_add(&bar[XB_TOPGEN], 1u);
            else XB_SPIN(xb_ld(&bar[XB_TOPGEN]) == tg, bar);
            __builtin_amdgcn_fence(__ATOMIC_ACQUIRE, "agent");
            xb_add(&bar[XB_XGEN(b.x)], 1u);
            asm volatile("s_waitcnt vmcnt(0)" ::: "memory");
        } else {
            XB_SPIN(xb_ld(&bar[XB_XGEN(b.x)]) == gen, bar);
            __builtin_amdgcn_fence(__ATOMIC_ACQUIRE, "agent");
            asm volatile("s_waitcnt vmcnt(0)" ::: "memory");
        }
    }
    __syncthreads();
}

namespace pg8 {
#define PG8_LAS __attribute__((address_space(3)))
typedef unsigned short bf16_t;
typedef short bf16x8 __attribute__((ext_vector_type(8)));
typedef float f32x4 __attribute__((ext_vector_type(4)));
typedef unsigned u32x4 __attribute__((ext_vector_type(4)));
constexpr int BM = 256, BK = 64, HALF = 128, HTB = HALF * BK * 2  , STAGE_BYTES = 8 * HTB, NXCD = 8, WGM = 8;

__host__ __device__ __forceinline__ int lds_byte(int r, int c) { const int st = (r >> 4) * 2 + (c >> 5), rr = r & 15, cc = c & 31, ob = rr * 64 + cc * 2; return st * 1024 + (ob ^ (((ob >> 9) & 1) << 5)); }
__host__ __device__ __forceinline__ void stage_rc(int b, int& R, int& C) { const int st = b / 1024, sb = b % 1024, swz = sb ^ (((sb >> 9) & 1) << 5); R = (st >> 1) * 16 + swz / 64; C = (st & 1) * 32 + (swz % 64) / 2; }
__host__ __device__ __forceinline__ int perm32(int rho) { const int n = rho >> 4, i = rho & 15; return 8 * (i >> 2) + 4 * n + (i & 3); }

struct Unit { int pm, pn; };
struct Gemm { const bf16_t* A; const bf16_t* Bt; int lda, ldb, K; const int* rowidx; };

struct StaticOrder {
    int nM, nN, nwg, G, c;
    __host__ __device__ void init(int M, int N, int G_, int c_) { nM = M / BM; nN = N / BM; nwg = nM * nN; G = G_; c = c_; }
    __host__ __device__ bool next(int i, Unit& u) const {
        const long L = (long)i * G + c; if (L >= nwg) return false;
        int wgid = (int)L; { const int q = nwg / NXCD, r = nwg % NXCD, xcd = wgid % NXCD, off = wgid / NXCD; wgid = (xcd < r ? xcd * (q + 1) : r * (q + 1) + (xcd - r) * q) + off; }
        const int nig = WGM * nN, gid = wgid / nig, fm = gid * WGM, gsz = (nM - fm) < WGM ? (nM - fm) : WGM;
        u.pm = fm + ((wgid % nig) % gsz); u.pn = (wgid % nig) / gsz; return true;
    }
    __device__ __forceinline__ void a_ready(const Unit&) const {}
    __device__ __forceinline__ void done(const Unit&) const {}
};

__device__ __forceinline__ unsigned cvt_pk_bf16(float lo, float hi) { unsigned r; asm volatile("v_cvt_pk_bf16_f32 %0, %1, %2" : "=v"(r) : "v"(lo), "v"(hi)); return r; }
typedef float f32x2 __attribute__((ext_vector_type(2)));
__device__ __forceinline__ f32x2 gelu_pk(f32x2 v) {
    const f32x2 av = __builtin_elementwise_abs(v), d = av * 0.2316418882f + 1.0f;
    f32x2 t; t.x = __builtin_amdgcn_rcpf(d.x); t.y = __builtin_amdgcn_rcpf(d.y);
    f32x2 q = t * 0.5307027145f + (-0.7265760135f); q = q * t + 0.7107068705f; q = q * t + (-0.142248368f); q = q * t + 0.127414796f; q = q * t;
    const f32x2 s = (v * v) * (-0.72134752044f);
    f32x2 e; e.x = __builtin_amdgcn_exp2f(s.x); e.y = __builtin_amdgcn_exp2f(s.y);
    const f32x2 m = v * (q * e), r = v - m;
    f32x2 o; o.x = v.x < 0.f ? m.x : r.x; o.y = v.y < 0.f ? m.y : r.y; return o;
}

template <int ACT  > struct EpiBf16 {
    static constexpr bool PERM = true, AFTER_DRAIN = false; static_assert(ACT == 0 || ACT == 1, "EpiBf16: ACT is 0 (none) or 1 (gelu_pk)");
    bf16_t* O; int ldc; const float* bias; int split_cols; size_t split_stride; float scale0;
    __device__ __forceinline__ void operator()(const f32x4 (&acc)[2][2][4][2], const Unit& u, int wr, int wc, int fr, int fq) const {
        const int row0 = u.pm * BM + wr * 64 + fr; int colt = u.pn * BM; bf16_t* base = O;
        float sc = 1.f; if (split_cols) { const int t = colt / split_cols; base += (size_t)t * split_stride; colt -= t * split_cols; if (t == 0) sc = scale0; }
        const int col0 = colt + wc * 32 + 8 * fq, bcol0 = u.pn * BM + wc * 32 + 8 * fq;
        f32x4 bv[2][2];
#pragma unroll
        for (int bj = 0; bj < 2; ++bj)
#pragma unroll
            for (int n = 0; n < 2; ++n) bv[bj][n] = bias ? *(const f32x4*)(bias + bcol0 + bj * HALF + 4 * n) : (f32x4){0.f, 0.f, 0.f, 0.f};
#pragma unroll
        for (int ai = 0; ai < 2; ++ai)
#pragma unroll
            for (int m = 0; m < 4; ++m) { bf16_t* rowp = base + (size_t)(row0 + ai * HALF + m * 16) * ldc + col0;
#pragma unroll
                for (int bj = 0; bj < 2; ++bj) { f32x4 v0 = acc[ai][bj][m][0] + bv[bj][0], v1 = acc[ai][bj][m][1] + bv[bj][1];
                    if (ACT == 1) { f32x2 a = gelu_pk((f32x2){v0[0], v0[1]}), b = gelu_pk((f32x2){v0[2], v0[3]}), c = gelu_pk((f32x2){v1[0], v1[1]}), d = gelu_pk((f32x2){v1[2], v1[3]});
                        v0 = (f32x4){a.x, a.y, b.x, b.y}; v1 = (f32x4){c.x, c.y, d.x, d.y}; }
                    v0 = v0 * sc; v1 = v1 * sc; u32x4 w; w.x = cvt_pk_bf16(v0[0], v0[1]); w.y = cvt_pk_bf16(v0[2], v0[3]); w.z = cvt_pk_bf16(v1[0], v1[1]); w.w = cvt_pk_bf16(v1[2], v1[3]);
                    *(u32x4*)(rowp + bj * HALF) = w; } }
    }
};


struct GroupedOrder {
    int nM, nN, groups, gsM, G, c, total;
    __host__ __device__ void init(int nM_, int nN_, int groups_, int gsM_, int G_, int c_) { nM = nM_; nN = nN_; groups = groups_; gsM = gsM_; G = G_; c = c_; total = nM * nN * groups; }
    __host__ __device__ bool next(int i, Unit& u) const {
        const long L = (long)i * G + c; if (L >= total) return false;
        int T = (int)L; { const int q = total / NXCD, r = total % NXCD, xcd = T % NXCD, off = T / NXCD; T = (xcd < r ? xcd * (q + 1) : r * (q + 1) + (xcd - r) * q) + off; }
        const int tpg = nM * nN, g = T / tpg, t = T - g * tpg;
        const int nig = WGM * nN, gid = t / nig, fm = gid * WGM, gsz = (nM - fm) < WGM ? (nM - fm) : WGM;
        u.pm = g * gsM + fm + ((t % nig) % gsz); u.pn = g * nN + (t % nig) / gsz; return true;
    }
    __device__ __forceinline__ void a_ready(const Unit&) const {}
    __device__ __forceinline__ void done(const Unit&) const {}
};
struct LatentOrder {
    GroupedOrder o;
    __host__ __device__ void init(int nN_, int G_, int c_) { o.init(256, nN_, 1, 256, G_, c_); }
    __host__ __device__ bool next(int i, Unit& u) const { if (!o.next(i, u)) return false; u.pm += (u.pm >> 3) + 1; return true; }
    __device__ __forceinline__ void a_ready(const Unit&) const {}
    __device__ __forceinline__ void done(const Unit&) const {}
};
struct HgInOrder {
    LatentOrder lat; int G, c;
    __host__ __device__ void init(int G_, int c_) { lat.init(16, G_, c_); G = G_; c = c_; }
    __host__ __device__ bool next(int i, Unit& u) const {
        const long L = (long)i * G + c;
        if (L < 4096) return lat.next(i, u);
        const int t = (int)L - 4096; if (t >= 256) return false;
        u.pm = (t >> 3) * 9; u.pn = 4 + (t & 7); return true;
    }
    __device__ __forceinline__ void a_ready(const Unit&) const {}
    __device__ __forceinline__ void done(const Unit&) const {}
};
__device__ __forceinline__ float sigm(float x) { return __builtin_amdgcn_rcpf(1.0f + __builtin_amdgcn_exp2f(x * -1.4426950408889634f)); }
constexpr int PP = 2304, DD = 1024;
__device__ __forceinline__ int mrow_of(int row) { const int b = row / PP, pos = row - b * PP; return pos < 256 ? 32 : b; }
struct EpiResidT {
    static constexpr bool PERM = false, AFTER_DRAIN = false;
    bf16_t* X; const float* MODL;
    __device__ __forceinline__ void operator()(const f32x4 (&acc)[2][2][4][2], const Unit& u, int wr, int wc, int fr, int fq) const {
        const int row0 = u.pm * BM + wr * 64 + fr, col0 = u.pn * BM + wc * 32 + 4 * fq;
        const float* g = MODL + (size_t)mrow_of(u.pm * BM) * 6144 + 2 * DD + col0;
        f32x4 gt[2][2];
#pragma unroll
        for (int bj = 0; bj < 2; ++bj)
#pragma unroll
            for (int n = 0; n < 2; ++n) gt[bj][n] = *(const f32x4*)(g + bj * HALF + n * 16);
#pragma unroll
        for (int ai = 0; ai < 2; ++ai)
#pragma unroll
            for (int m = 0; m < 4; ++m) { const int row = row0 + ai * HALF + m * 16; bf16_t* x = X + (size_t)row * DD + col0;
                u32x2 xo[2][2];
#pragma unroll
                for (int bj = 0; bj < 2; ++bj)
#pragma unroll
                    for (int n = 0; n < 2; ++n) xo[bj][n] = *(const u32x2*)(x + bj * HALF + n * 16);
#pragma unroll
                for (int bj = 0; bj < 2; ++bj)
#pragma unroll
                    for (int n = 0; n < 2; ++n) { const int o = bj * HALF + n * 16; const f32x4 xv = {bflo(xo[bj][n].x), bfhi(xo[bj][n].x), bflo(xo[bj][n].y), bfhi(xo[bj][n].y)};
                        const f32x4 r = xv + gt[bj][n] * acc[ai][bj][m][n]; u32x2 w; w.x = pkbf(r.x, r.y); w.y = pkbf(r.z, r.w); *(u32x2*)(x + o) = w; } }
    }
};
struct EpiGluT {
    static constexpr bool PERM = true, AFTER_DRAIN = false;
    bf16_t* X; const float* MODL;
    __device__ __forceinline__ void operator()(const f32x4 (&acc)[2][2][4][2], const Unit& u, int wr, int wc, int fr, int fq) const {
        const int row0 = u.pm * BM + wr * 64 + fr, f0 = u.pn * 128 + wc * 32 + 8 * fq;
        const float* g = MODL + (size_t)mrow_of(u.pm * BM) * 6144 + 2 * DD + f0;
        const f32x4 gt[2] = {*(const f32x4*)g, *(const f32x4*)(g + 4)};
#pragma unroll
        for (int ai = 0; ai < 2; ++ai)
#pragma unroll
            for (int m = 0; m < 4; ++m) { const int row = row0 + ai * HALF + m * 16; bf16_t* x = X + (size_t)row * DD + f0;
                const u32x4 xo = *(const u32x4*)x; u32x4 w;
#pragma unroll
                for (int n = 0; n < 2; ++n) { const f32x4 a = acc[ai][0][m][n], b = acc[ai][1][m][n]; f32x4 v = b * -1.4426950408889634f;
#pragma unroll
                    for (int q = 0; q < 4; ++q) v[q] = __builtin_amdgcn_exp2f(v[q]);
                    v = v + 1.0f;
#pragma unroll
                    for (int q = 0; q < 4; ++q) v[q] = __builtin_amdgcn_rcpf(v[q]);
                    v = v * a;
                    const unsigned x01 = n ? xo.z : xo.x, x23 = n ? xo.w : xo.y; const f32x4 xv = {bflo(x01), bfhi(x01), bflo(x23), bfhi(x23)};
                    const f32x4 r = xv + gt[n] * v; if (n) { w.z = pkbf(r.x, r.y); w.w = pkbf(r.z, r.w); } else { w.x = pkbf(r.x, r.y); w.y = pkbf(r.z, r.w); } }
                *(u32x4*)x = w; }
    }
};
struct EpiSwigluT {
    static constexpr bool PERM = true, AFTER_DRAIN = false;
    bf16_t* HID; int nNg; int ldh;
    __device__ __forceinline__ void operator()(const f32x4 (&acc)[2][2][4][2], const Unit& u, int wr, int wc, int fr, int fq) const {
        const int row0 = u.pm * BM + wr * 64 + fr, f0 = (u.pn % nNg) * 128 + wc * 32 + 8 * fq;
#pragma unroll
        for (int ai = 0; ai < 2; ++ai)
#pragma unroll
            for (int m = 0; m < 4; ++m) { bf16_t* hp = HID + (size_t)(row0 + ai * HALF + m * 16) * ldh + f0;
                const f32x4 a0 = acc[ai][0][m][0], a1 = acc[ai][0][m][1], b0 = acc[ai][1][m][0], b1 = acc[ai][1][m][1];
                f32x4 e0 = a0 * -1.4426950408889634f, e1 = a1 * -1.4426950408889634f;
#pragma unroll
                for (int q = 0; q < 4; ++q) { e0[q] = __builtin_amdgcn_exp2f(e0[q]); e1[q] = __builtin_amdgcn_exp2f(e1[q]); }
                e0 = e0 + 1.0f; e1 = e1 + 1.0f;
#pragma unroll
                for (int q = 0; q < 4; ++q) { e0[q] = __builtin_amdgcn_rcpf(e0[q]); e1[q] = __builtin_amdgcn_rcpf(e1[q]); }
                const f32x4 o0 = (a0 * b0) * e0, o1 = (a1 * b1) * e1;
                u32x4 w; w.x = cvt_pk_bf16(o0.x, o0.y); w.y = cvt_pk_bf16(o0.z, o0.w); w.z = cvt_pk_bf16(o1.x, o1.y); w.w = cvt_pk_bf16(o1.z, o1.w);
                *(u32x4*)hp = w; }
    }
};
struct EpiDownT {
    static constexpr bool PERM = true, AFTER_DRAIN = false;
    bf16_t* Y; const float* GATE; int nNg;
    __device__ __forceinline__ void operator()(const f32x4 (&acc)[2][2][4][2], const Unit& u, int wr, int wc, int fr, int fq) const {
        const int row0 = u.pm * BM + wr * 64 + fr, col0 = (u.pn % nNg) * BM + wc * 32 + 8 * fq;
#pragma unroll
        for (int ai = 0; ai < 2; ++ai)
#pragma unroll
            for (int m = 0; m < 4; ++m) { const int row = row0 + ai * HALF + m * 16; bf16_t* rowp = Y + (size_t)row * DD + col0;
#pragma unroll
                for (int bj = 0; bj < 2; ++bj) { const f32x4 v0 = acc[ai][bj][m][0], v1 = acc[ai][bj][m][1];
                    u32x4 w; w.x = cvt_pk_bf16(v0[0], v0[1]); w.y = cvt_pk_bf16(v0[2], v0[3]); w.z = cvt_pk_bf16(v1[0], v1[1]); w.w = cvt_pk_bf16(v1[2], v1[3]);
                    *(u32x4*)(rowp + bj * HALF) = w; } }
    }
};
template <bool SILU> struct EpiVtT {
    static constexpr bool PERM = true, AFTER_DRAIN = false;
    bf16_t* VT;
    __device__ __forceinline__ void operator()(const f32x4 (&acc)[2][2][4][2], const Unit& u, int wr, int wc, int fr, int fq) const {
        const int hd0 = u.pm * BM + wr * 64 + fr, tok0 = u.pn * BM + wc * 32 + 8 * fq, b = (u.pn * BM) / PP, pos0 = tok0 - b * PP;
#pragma unroll
        for (int ai = 0; ai < 2; ++ai)
#pragma unroll
            for (int m = 0; m < 4; ++m) { bf16_t* rowp = VT + ((size_t)b * DD + hd0 + ai * HALF + m * 16) * PP + pos0;
#pragma unroll
                for (int bj = 0; bj < 2; ++bj) { f32x4 v0 = acc[ai][bj][m][0], v1 = acc[ai][bj][m][1];
                    if (SILU) {
#pragma unroll
                        for (int q = 0; q < 4; ++q) { v0[q] = v0[q] * sigm(v0[q]); v1[q] = v1[q] * sigm(v1[q]); } }
                    u32x4 w; w.x = cvt_pk_bf16(v0[0], v0[1]); w.y = cvt_pk_bf16(v0[2], v0[3]); w.z = cvt_pk_bf16(v1[0], v1[1]); w.w = cvt_pk_bf16(v1[2], v1[3]);
                    *(u32x4*)(rowp + bj * HALF) = w; } }
    }
};
struct EpiHgIn {
    static constexpr bool PERM = true, AFTER_DRAIN = false;
    bf16_t* O; const float* LB;
    __device__ __forceinline__ void operator()(const f32x4 (&acc)[2][2][4][2], const Unit& u, int wr, int wc, int fr, int fq) const {
        const int row0 = u.pm * BM + wr * 64 + fr, col0 = u.pn * BM + wc * 32 + 8 * fq, type = u.pn >> 2;
        f32x4 lb[2][2];
#pragma unroll
        for (int bj = 0; bj < 2; ++bj) { const int c = (col0 + bj * HALF) & 1023; lb[bj][0] = *(const f32x4*)(LB + c); lb[bj][1] = *(const f32x4*)(LB + c + 4); }
#pragma unroll
        for (int ai = 0; ai < 2; ++ai)
#pragma unroll
            for (int m = 0; m < 4; ++m) { bf16_t* rowp = O + (size_t)(row0 + ai * HALF + m * 16) * 4096 + col0;
#pragma unroll
                for (int bj = 0; bj < 2; ++bj) { f32x4 v0 = acc[ai][bj][m][0], v1 = acc[ai][bj][m][1];
                    if (type == 1 || type == 2) { const f32x4 l0 = lb[bj][0], l1 = lb[bj][1];
#pragma unroll
                        for (int q = 0; q < 4; ++q) { v0[q] = __log2f(l0[q] + (1.0f - l0[q]) * sigm(v0[q])); v1[q] = __log2f(l1[q] + (1.0f - l1[q]) * sigm(v1[q])); } }
                    else if (type == 3) {
#pragma unroll
                        for (int q = 0; q < 4; ++q) { v0[q] = v0[q] * sigm(v0[q]); v1[q] = v1[q] * sigm(v1[q]); } }
                    u32x4 w; w.x = cvt_pk_bf16(v0[0], v0[1]); w.y = cvt_pk_bf16(v0[2], v0[3]); w.z = cvt_pk_bf16(v1[0], v1[1]); w.w = cvt_pk_bf16(v1[2], v1[3]);
                    *(u32x4*)(rowp + bj * HALF) = w; } }
    }
};


struct EpiF32G {
    static constexpr bool PERM = false, AFTER_DRAIN = false;
    float* C; int ldc; int nNg;
    __device__ __forceinline__ void operator()(const f32x4 (&acc)[2][2][4][2], const Unit& u, int wr, int wc, int fr, int fq) const {
        const int row0 = u.pm * BM + wr * 64 + fr, col0 = (u.pn % nNg) * BM + wc * 32 + 4 * fq;
#pragma unroll
        for (int ai = 0; ai < 2; ++ai)
#pragma unroll
            for (int m = 0; m < 4; ++m) { float* rowp = C + (size_t)(row0 + ai * HALF + m * 16) * ldc + col0;
#pragma unroll
                for (int bj = 0; bj < 2; ++bj)
#pragma unroll
                    for (int n = 0; n < 2; ++n) *(f32x4*)(rowp + bj * HALF + n * 16) = acc[ai][bj][m][n]; }
    }
};
__device__ __forceinline__ float gelu_t(float x) { const float t = 1.5957691216057308f * (x + 0.044715f * x * x * x); return x * sigm(t); }
struct EpiS5Out {
    static constexpr bool PERM = true, AFTER_DRAIN = false;
    const bf16_t* H; bf16_t* Z; const float* dvec;
    __device__ __forceinline__ void operator()(const f32x4 (&acc)[2][2][4][2], const Unit& u, int wr, int wc, int fr, int fq) const {
        const int c0 = (u.pn & 1) * BM + wc * 32 + 8 * fq;
        const int g = (u.pm * BM) / 2304;
        f32x4 dv[2][2];
#pragma unroll
        for (int bj = 0; bj < 2; ++bj) { const int k0 = (c0 + bj * HALF) & 15; dv[bj][0] = *(const f32x4*)(dvec + g * 16 + k0); dv[bj][1] = *(const f32x4*)(dvec + g * 16 + k0 + 4); }
#pragma unroll
        for (int ai = 0; ai < 2; ++ai)
#pragma unroll
            for (int m = 0; m < 4; ++m) {
                const int rg = u.pm * BM + ai * HALF + wr * 64 + m * 16 + fr, rem = rg - g * 2304, b = rem / 72, j = rem - b * 72;
#pragma unroll
                for (int bj = 0; bj < 2; ++bj) {
                    const int mc = c0 + bj * HALF, tau = mc >> 4, k0 = mc & 15;
                    const size_t off = ((size_t)b * PP + 32 * j + tau) * DD + g * 16 + k0;
                    const u32x4 uw = *(const u32x4*)(H + off);
                    const f32x4 d0 = dv[bj][0], d1 = dv[bj][1];
                    const f32x4 y0 = acc[ai][bj][m][0], y1 = acc[ai][bj][m][1];
                    u32x4 w;
                    w.x = cvt_pk_bf16(gelu_t(y0[0] + d0[0] * __uint_as_float(uw.x << 16)), gelu_t(y0[1] + d0[1] * __uint_as_float(uw.x & 0xffff0000u)));
                    w.y = cvt_pk_bf16(gelu_t(y0[2] + d0[2] * __uint_as_float(uw.y << 16)), gelu_t(y0[3] + d0[3] * __uint_as_float(uw.y & 0xffff0000u)));
                    w.z = cvt_pk_bf16(gelu_t(y1[0] + d1[0] * __uint_as_float(uw.z << 16)), gelu_t(y1[1] + d1[1] * __uint_as_float(uw.z & 0xffff0000u)));
                    w.w = cvt_pk_bf16(gelu_t(y1[2] + d1[2] * __uint_as_float(uw.w << 16)), gelu_t(y1[3] + d1[3] * __uint_as_float(uw.w & 0xffff0000u)));
                    *(u32x4*)(Z + off) = w;
                }
            }
    }
};


struct EpiQKRope {
    static constexpr bool PERM = true, AFTER_DRAIN = false;
    bf16_t* Q; size_t kstride; const PG8_LAS float* T;
    __device__ __forceinline__ void operator()(const f32x4 (&acc)[2][2][4][2], const Unit& u, int wr, int wc, int fr, int fq) const {
        const int row0 = u.pm * BM + wr * 64 + fr; int colt = u.pn * BM; bf16_t* base = Q;
        { const int t = colt / DD; base += (size_t)t * kstride; colt -= t * DD; }
        const int col0 = colt + wc * 32 + 8 * fq, half = wc & 1; const bool first = fq < 2;
        const int tb = (u.pm * BM) / PP;
        const float qs = u.pn * BM < DD ? 0.125f * 1.4426950408889634f : 1.0f;
#pragma unroll
        for (int ai = 0; ai < 2; ++ai)
#pragma unroll
            for (int m = 0; m < 4; ++m) { const int row = row0 + ai * HALF + m * 16, pos = row - tb * PP, tt = pos - 256; const bool lat = pos >= 256;
                const int p = lat ? (half ? (tt & 63) : (tt >> 6)) : 0;
                const PG8_LAS f32x4* cs = (const PG8_LAS f32x4*)(T + (p * 16 + 8 * (fq & 1)) * 2);
                const f32x4 t0 = cs[0], t1 = cs[1], t2 = cs[2], t3 = cs[3];
                bf16_t* rowp = base + (size_t)row * DD + col0;
#pragma unroll
                for (int bj = 0; bj < 2; ++bj) { f32x4 v0 = acc[ai][bj][m][0] * qs, v1 = acc[ai][bj][m][1] * qs;
                    f32x4 p0, p1;
#pragma unroll
                    for (int q = 0; q < 4; ++q) { p0[q] = __shfl_xor(v0[q], 32); p1[q] = __shfl_xor(v1[q], 32); }
                    if (lat) { const float sg = first ? -1.0f : 1.0f;
                        v0 = (f32x4){v0[0] * t0[0] + sg * p0[0] * t0[1], v0[1] * t0[2] + sg * p0[1] * t0[3], v0[2] * t1[0] + sg * p0[2] * t1[1], v0[3] * t1[2] + sg * p0[3] * t1[3]};
                        v1 = (f32x4){v1[0] * t2[0] + sg * p1[0] * t2[1], v1[1] * t2[2] + sg * p1[1] * t2[3], v1[2] * t3[0] + sg * p1[2] * t3[1], v1[3] * t3[2] + sg * p1[3] * t3[3]}; }
                    u32x4 w; w.x = cvt_pk_bf16(v0[0], v0[1]); w.y = cvt_pk_bf16(v0[2], v0[3]); w.z = cvt_pk_bf16(v1[0], v1[1]); w.w = cvt_pk_bf16(v1[2], v1[3]);
                    *(u32x4*)(rowp + bj * HALF) = w; } }
    }
};

template <class Epi, class Sched, bool ALIGN_EPI = false, bool SP2 = false, bool GATHER = false>
__device__ __forceinline__ void gemm_phase(PG8_LAS unsigned char* lds, const Gemm g, const Sched& S, const Epi& E, const int tid) {
    const int wid = __builtin_amdgcn_readfirstlane(tid >> 6), lane = tid & 63, wr = wid >> 2, wc = wid & 3, fr = lane & 15, fq = lane >> 4;
    const int K = g.K, nt = K / BK;
    unsigned voffA[2], voffB[2];
#pragma unroll
    for (int i = 0; i < 2; ++i) { int R, C; stage_rc(tid * 16 + i * 8192, R, C); const int Rb = Epi::PERM ? ((R & ~31) + perm32(R & 31)) : R;
        voffA[i] = (unsigned)(R * g.lda + C) * 2u; voffB[i] = (unsigned)(Rb * g.ldb + C) * 2u; }
    unsigned vA0[2] = {0u, 0u}, vA1[2] = {0u, 0u}, wA0[2] = {0u, 0u}, wA1[2] = {0u, 0u};
#define PG8_GOFF(u_, o0, o1) do { _Pragma("unroll") for (int i = 0; i < 2; ++i) { int R, C; stage_rc(tid * 16 + i * 8192, R, C); const int r0_ = (u_).pm * BM + R; \
        o0[i] = ((unsigned)g.rowidx[r0_] * (unsigned)g.lda + (unsigned)C) * 2u; o1[i] = ((unsigned)g.rowidx[r0_ + HALF] * (unsigned)g.lda + (unsigned)C) * 2u; } } while (0)
    const size_t kstep = (size_t)(BK * 2);
    const size_t hstepA = (size_t)HALF * g.lda * 2, hstepB = (size_t)HALF * g.ldb * 2;
    const size_t tstepA = 2 * hstepA, tstepB = 2 * hstepB;
    const unsigned ldsw = (unsigned)wid * 1024u;
    const int aoff = lds_byte(wr * 64 + fr, fq * 8), boff = lds_byte(wc * 32 + fr, fq * 8);
#define PG8_SA(b, h) (((b) * 2 + (h)) * HTB)
#define PG8_SB(b, h) ((4 + (b) * 2 + (h)) * HTB)
#define PG8_STAGE(bufoff, gbase, voff) do { _Pragma("unroll") for (int _i = 0; _i < 2; ++_i) \
        __builtin_amdgcn_global_load_lds((const unsigned*)((const char*)(gbase) + (voff)[_i]), (PG8_LAS unsigned*)(lds + (bufoff) + ldsw + _i * 8192), 16, 0, 0); } while (0)
#define PG8_STAGEA(bufoff, kptr, h, oc0, oc1) do { if constexpr (GATHER) { if (h) PG8_STAGE(bufoff, kptr, oc1); else PG8_STAGE(bufoff, kptr, oc0); } else { PG8_STAGE(bufoff, (kptr) + ((h) ? hstepA : 0), voffA); } } while (0)
#define PG8_LDA(dst, b, h) do { _Pragma("unroll") for (int m = 0; m < 4; ++m) _Pragma("unroll") for (int k = 0; k < 2; ++k) dst[m][k] = *(const PG8_LAS bf16x8*)(lds + PG8_SA(b, h) + aoff + m * 2048 + k * 1024); } while (0)
#define PG8_LDB(dst, b, h) do { _Pragma("unroll") for (int n = 0; n < 2; ++n) _Pragma("unroll") for (int k = 0; k < 2; ++k) dst[n][k] = *(const PG8_LAS bf16x8*)(lds + PG8_SB(b, h) + boff + n * 2048 + k * 1024); } while (0)
#define PG8_MMA(ai, bj, At, Bt) do { __builtin_amdgcn_s_setprio(1); _Pragma("unroll") for (int m = 0; m < 4; ++m) _Pragma("unroll") for (int n = 0; n < 2; ++n) _Pragma("unroll") for (int k = 0; k < 2; ++k) \
        acc[ai][bj][m][n] = __builtin_amdgcn_mfma_f32_16x16x32_bf16(Bt[n][k], At[m][k], acc[ai][bj][m][n], 0, 0, 0); __builtin_amdgcn_s_setprio(0); } while (0)
#define PG8_WAIT_V(n) asm volatile("s_waitcnt vmcnt(" #n ")" ::: "memory")
#define PG8_WAIT_L(n) asm volatile("s_waitcnt lgkmcnt(" #n ")" ::: "memory")
#define PG8_BAR __builtin_amdgcn_s_barrier()
#define PG8_SCHED __builtin_amdgcn_sched_barrier(0)
    Unit cur, nxt; int ui = 0;
    if (!S.next(0, cur)) return;
    f32x4 acc[2][2][4][2];
#pragma unroll
    for (int a = 0; a < 2; ++a)
#pragma unroll
        for (int b = 0; b < 2; ++b)
#pragma unroll
            for (int m = 0; m < 4; ++m)
#pragma unroll
                for (int n = 0; n < 2; ++n) acc[a][b][m][n] = (f32x4){0.f, 0.f, 0.f, 0.f};
    bf16x8 At[4][2], B0[2][2], B1[2][2];
    const char* cA = (const char*)g.A + (GATHER ? (size_t)0 : (size_t)cur.pm * tstepA); if constexpr (GATHER) PG8_GOFF(cur, vA0, vA1);
    const char* cB = (const char*)g.Bt + (size_t)cur.pn * tstepB;
    S.a_ready(cur);
    if constexpr (SP2) {
        PG8_STAGE(PG8_SB(0, 0), cB, voffB); PG8_STAGE(PG8_SB(0, 1), cB + hstepB, voffB); PG8_STAGEA(PG8_SA(0, 0), cA, 0, vA0, vA1); PG8_STAGEA(PG8_SA(0, 1), cA, 1, vA0, vA1);
        if (wr == 1) PG8_BAR;
        PG8_WAIT_V(2); PG8_BAR;
        PG8_STAGE(PG8_SB(1, 0), cB + kstep, voffB); PG8_STAGEA(PG8_SA(1, 0), cA + kstep, 0, vA0, vA1); PG8_STAGE(PG8_SB(1, 1), cB + hstepB + kstep, voffB);
        PG8_WAIT_V(6); PG8_BAR;
    } else {
        PG8_STAGE(PG8_SB(0, 0), cB, voffB); PG8_STAGE(PG8_SA(0, 0), cA, voffA); PG8_STAGE(PG8_SB(0, 1), cB + hstepB, voffB); PG8_STAGE(PG8_SA(0, 1), cA + hstepA, voffA);
        if (wr == 1) PG8_BAR;
        PG8_WAIT_V(4); PG8_BAR;
        PG8_STAGE(PG8_SB(1, 0), cB + kstep, voffB); PG8_STAGE(PG8_SA(1, 0), cA + kstep, voffA); PG8_STAGE(PG8_SB(1, 1), cB + hstepB + kstep, voffB);
        PG8_WAIT_V(6); PG8_BAR;
    }
    for (;;) {
        const bool has_next = S.next(ui + 1, nxt);
        const char* nA = (has_next && !GATHER) ? (const char*)g.A + (size_t)nxt.pm * tstepA : cA;
        if constexpr (GATHER) { if (has_next) { if (wid < 4) __builtin_amdgcn_global_load_lds((const unsigned*)(g.rowidx + (size_t)nxt.pm * BM + (tid & 255)), (PG8_LAS unsigned*)(lds + STAGE_BYTES + wid * 256), 4, 0, 0); }
                                else { wA0[0] = vA0[0]; wA0[1] = vA0[1]; wA1[0] = vA1[0]; wA1[1] = vA1[1]; } }
        const char* nB = has_next ? (const char*)g.Bt + (size_t)nxt.pn * tstepB : cB;
        for (int t = 0; t < nt; t += 2) {
            const bool last = (t == nt - 2);
            const char* a1 = cA + (size_t)(t + 1) * kstep;
            const char* a2 = last ? nA : cA + (size_t)(t + 2) * kstep; const char* b2 = last ? nB : cB + (size_t)(t + 2) * kstep;
            const char* a3 = a2 + kstep; const char* b3 = b2 + kstep;
            if (last && has_next) S.a_ready(nxt);
            if constexpr (GATHER) { if (last && has_next) {
#pragma unroll
                for (int i = 0; i < 2; ++i) { int R, C; stage_rc(tid * 16 + i * 8192, R, C);
                    const unsigned i0_ = *(const PG8_LAS unsigned*)(lds + STAGE_BYTES + R * 4), i1_ = *(const PG8_LAS unsigned*)(lds + STAGE_BYTES + (R + HALF) * 4);
                    wA0[i] = (i0_ * (unsigned)g.lda + (unsigned)C) * 2u; wA1[i] = (i1_ * (unsigned)g.lda + (unsigned)C) * 2u; } } }
            const unsigned sA0[2] = {last ? wA0[0] : vA0[0], last ? wA0[1] : vA0[1]}, sA1[2] = {last ? wA1[0] : vA1[0], last ? wA1[1] : vA1[1]};
            if constexpr (SP2) {
            PG8_LDB(B0, 0, 0); PG8_LDB(B1, 0, 1); PG8_SCHED; PG8_LDA(At, 0, 0); PG8_STAGEA(PG8_SA(1, 1), a1, 1, vA0, vA1);
            PG8_WAIT_V(8); PG8_WAIT_L(0); PG8_BAR; PG8_MMA(0, 0, At, B0); PG8_MMA(0, 1, At, B1); PG8_BAR; PG8_SCHED;
            PG8_LDA(At, 0, 1); PG8_STAGE(PG8_SB(0, 0), b2, voffB); PG8_STAGE(PG8_SB(0, 1), b2 + hstepB, voffB); PG8_STAGEA(PG8_SA(0, 0), a2, 0, sA0, sA1);
            PG8_WAIT_V(8); PG8_WAIT_L(0); PG8_BAR; PG8_MMA(1, 0, At, B0); PG8_MMA(1, 1, At, B1); PG8_BAR; PG8_SCHED;
            PG8_LDB(B0, 1, 0); PG8_LDB(B1, 1, 1); PG8_SCHED; PG8_LDA(At, 1, 0); PG8_STAGEA(PG8_SA(0, 1), a2, 1, sA0, sA1);
            PG8_WAIT_V(8); PG8_WAIT_L(0); PG8_BAR; PG8_MMA(0, 0, At, B0); PG8_MMA(0, 1, At, B1); PG8_BAR; PG8_SCHED;
            PG8_LDA(At, 1, 1); PG8_STAGE(PG8_SB(1, 0), b3, voffB); PG8_STAGE(PG8_SB(1, 1), b3 + hstepB, voffB); PG8_STAGEA(PG8_SA(1, 0), a3, 0, sA0, sA1);
            PG8_WAIT_V(8); PG8_WAIT_L(0); PG8_BAR; PG8_MMA(1, 0, At, B0); PG8_MMA(1, 1, At, B1); PG8_BAR; PG8_SCHED;
            } else {
            PG8_LDB(B0, 0, 0); PG8_SCHED; PG8_LDA(At, 0, 0); PG8_STAGE(PG8_SA(1, 1), a1 + hstepA, voffA);
            PG8_WAIT_L(8); PG8_BAR; PG8_WAIT_L(0); PG8_MMA(0, 0, At, B0); PG8_BAR; PG8_SCHED;
            PG8_LDB(B1, 0, 1); PG8_STAGE(PG8_SB(0, 0), b2, voffB);
            PG8_BAR; PG8_WAIT_L(0); PG8_MMA(0, 1, At, B1); PG8_BAR;
            PG8_LDA(At, 0, 1); PG8_STAGE(PG8_SA(0, 0), a2, voffA);
            PG8_BAR; PG8_WAIT_L(0); PG8_MMA(1, 0, At, B0); PG8_BAR; PG8_SCHED;
            PG8_STAGE(PG8_SB(0, 1), b2 + hstepB, voffB);
            PG8_WAIT_V(6); PG8_BAR; PG8_MMA(1, 1, At, B1); PG8_BAR;
            PG8_LDB(B0, 1, 0); PG8_SCHED; PG8_LDA(At, 1, 0); PG8_STAGE(PG8_SA(0, 1), a2 + hstepA, voffA);
            PG8_WAIT_L(8); PG8_BAR; PG8_WAIT_L(0); PG8_MMA(0, 0, At, B0); PG8_BAR; PG8_SCHED;
            PG8_LDB(B1, 1, 1); PG8_STAGE(PG8_SB(1, 0), b3, voffB);
            PG8_BAR; PG8_WAIT_L(0); PG8_MMA(0, 1, At, B1); PG8_BAR;
            PG8_LDA(At, 1, 1); PG8_STAGE(PG8_SA(1, 0), a3, voffA);
            PG8_BAR; PG8_WAIT_L(0); PG8_MMA(1, 0, At, B0); PG8_BAR; PG8_SCHED;
            PG8_STAGE(PG8_SB(1, 1), b3 + hstepB, voffB);
            PG8_WAIT_V(6); PG8_BAR; PG8_MMA(1, 1, At, B1); PG8_BAR;
            }
        }
        if constexpr (ALIGN_EPI) { if (wr == 0) PG8_BAR; }
        if constexpr (!Epi::AFTER_DRAIN) { E(acc, cur, wr, wc, fr, fq); S.done(cur); }
        if (!has_next) break;
#pragma unroll
        for (int a = 0; a < 2; ++a)
#pragma unroll
            for (int b = 0; b < 2; ++b)
#pragma unroll
                for (int m = 0; m < 4; ++m)
#pragma unroll
                    for (int n = 0; n < 2; ++n) acc[a][b][m][n] = (f32x4){0.f, 0.f, 0.f, 0.f};
        cur = nxt; cA = nA; cB = nB; ++ui; vA0[0] = wA0[0]; vA0[1] = wA0[1]; vA1[0] = wA1[0]; vA1[1] = wA1[1];
        if constexpr (ALIGN_EPI) { if (wr == 1) PG8_BAR; }
    }
    PG8_WAIT_V(0);
    if constexpr (!ALIGN_EPI) { if (wr == 0) PG8_BAR; }
    PG8_BAR;
    if constexpr (Epi::AFTER_DRAIN) { E.fused(acc, cur, wr, wc, fr, fq, lds, wid, lane); S.done(cur); }
#undef PG8_SA
#undef PG8_SB
#undef PG8_STAGE
#undef PG8_STAGEA
#undef PG8_GOFF
#undef PG8_LDA
#undef PG8_LDB
#undef PG8_MMA
#undef PG8_WAIT_V
#undef PG8_WAIT_L
#undef PG8_BAR
#undef PG8_SCHED
}
}
#define PG8_SP2 true
#define PG8_ALIGN true

struct Frame;
struct Args { const float* in[33]; float* out; unsigned char* ws; int ph_lo, ph_hi; };
struct Frame {
    unsigned char* lds;
    int tid, lane, wave, bid, nb;
    const float* const* in;
    float* out; unsigned char* ws;
    float* MOD; float* AFF; int* SEL; float* GATE; int* INV; bf16* X; bf16* H;
};
__device__ __forceinline__ void REFRESH_(Frame& F) { int l_; asm volatile("v_mbcnt_lo_u32_b32 %0, -1, 0\n\tv_mbcnt_hi_u32_b32 %0, -1, %0" : "=v"(l_)); F.lane = l_; F.tid = F.wave * 64 + l_; }
__device__ __forceinline__ int mod_row(int row) { const int b = row / P, pos = row - b * P; return pos < NCTX ? 32 : b; }

__device__ __forceinline__ void ph_s5_pre(const Frame& F) {
    const float *a_re = F.in[8], *a_im = F.in[9], *log_dt = F.in[10], *b_re = F.in[11], *b_im = F.in[12], *c_re = F.in[13], *c_im = F.in[14];
    f32x2* Bb = (f32x2*)F.lds;
    f32x2* Cc = Bb + 2048;
    f32x2* Ap = Cc + 2048;
    float* Kt = (float*)(Ap + 2 * 33 * 64);
    bf16* W1 = (bf16*)(F.ws + WS_S5W1); bf16* W2 = (bf16*)(F.ws + WS_S5W2); f32x2* A32 = (f32x2*)(F.ws + WS_S5A);
    const int tid = F.tid;
    for (int g = F.nb - 1 - F.bid; g < 64; g += F.nb) {
        __syncthreads();
        if (tid < 128) {
            const int dir = tid >> 6, p = tid & 63, dg = dir * 64 + g;
            const double are = (double)a_re[dg * 64 + p], aim = (double)a_im[dg * 64 + p], dt = exp((double)log_dt[dg]);
            const double lr = are * dt, li = aim * dt, cl = cos(li), sl = sin(li), mag = exp(lr);
            const double Abi = mag * sl, sh = sin(0.5 * li), nr = expm1(lr) * cl - 2.0 * sh * sh, den = are * are + aim * aim;
            const double fr = (nr * are + Abi * aim) / den, fi = (Abi * are - nr * aim) / den;
            for (int h = 0; h < 16; ++h) { const double br = (double)b_re[((size_t)dg * 64 + p) * 16 + h], bi = (double)b_im[((size_t)dg * 64 + p) * 16 + h];
                Bb[(dir * 64 + p) * 16 + h] = (f32x2){(float)(fr * br - fi * bi), (float)(fr * bi + fi * br)}; }
            const double Abr = mag * cl; double pr = 1.0, pi = 0.0;
            for (int e = 0; e <= 32; ++e) { const f32x2 v = {(float)pr, (float)pi};
                Ap[(dir * 33 + e) * 64 + p] = v; if (e == 32) A32[(g * 2 + dir) * 64 + p] = v;
                const double nr2 = pr * Abr - pi * Abi, ni2 = pr * Abi + pi * Abr; pr = nr2; pi = ni2; }
        }
        for (int i = tid; i < 2048; i += NTHREADS) { const int dir = i >> 10, k = (i >> 6) & 15, p = i & 63; const size_t o = ((size_t)(dir * 64 + g) * 16 + k) * 64 + p; Cc[i] = (f32x2){c_re[o], c_im[o]}; }
        __syncthreads();
        {
            const int dir = tid >> 8, k = (tid >> 4) & 15, h = tid & 15; float acc[32];
#pragma unroll
            for (int lag = 0; lag < 32; ++lag) acc[lag] = 0.f;
#pragma unroll 2
            for (int p = 0; p < 64; ++p) { const f32x2 c = Cc[(dir * 16 + k) * 64 + p], bb = Bb[(dir * 64 + p) * 16 + h], a1 = Ap[(dir * 33 + 1) * 64 + p];
                float zr = c.x * bb.x - c.y * bb.y, zi = c.x * bb.y + c.y * bb.x;
#pragma unroll
                for (int lag = 0; lag < 32; ++lag) { acc[lag] += zr; const float nz = zr * a1.x - zi * a1.y; zi = zr * a1.y + zi * a1.x; zr = nz; } }
#pragma unroll
            for (int lag = 0; lag < 32; ++lag) Kt[((dir * 32 + lag) * 16 + k) * 16 + h] = acc[lag];
        }
        for (int i = tid; i < 16384; i += NTHREADS) {
            const int n = i >> 6, sg = (i >> 1) & 31, h0 = (i & 1) * 8, dir = n >> 7, c = (n >> 6) & 1, p = n & 63, e = dir ? sg : 31 - sg;
            const f32x2 a = Ap[(dir * 33 + e) * 64 + p]; float v[8];
#pragma unroll
            for (int q = 0; q < 8; ++q) { const f32x2 bb = Bb[(dir * 64 + p) * 16 + h0 + q]; v[q] = c ? a.x * bb.y + a.y * bb.x : a.x * bb.x - a.y * bb.y; }
            u32x4 w; w.x = pk2(v[0], v[1]); w.y = pk2(v[2], v[3]); w.z = pk2(v[4], v[5]); w.w = pk2(v[6], v[7]);
            *(u32x4*)(W1 + ((size_t)g * 256 + n) * 512 + sg * 16 + h0) = w;
        }
        for (int i = tid; i < 16384; i += NTHREADS) {
            const int m = i >> 5, n0 = (i & 31) * 8, dir = n0 >> 7, c = (n0 >> 6) & 1, p0 = n0 & 63, tau = m >> 4, k = m & 15, e = dir ? 32 - tau : tau + 1; float v[8];
#pragma unroll
            for (int q = 0; q < 8; ++q) { const f32x2 cc = Cc[(dir * 16 + k) * 64 + p0 + q], a = Ap[(dir * 33 + e) * 64 + p0 + q]; v[q] = c ? -(cc.x * a.y + cc.y * a.x) : cc.x * a.x - cc.y * a.y; }
            u32x4 w; w.x = pk2(v[0], v[1]); w.y = pk2(v[2], v[3]); w.z = pk2(v[4], v[5]); w.w = pk2(v[6], v[7]);
            *(u32x4*)(W2 + ((size_t)g * 512 + m) * 768 + 512 + n0) = w;
        }
        __syncthreads();
        for (int i = tid; i < 32768; i += NTHREADS) {
            const int m = i >> 6, sg = (i >> 1) & 31, h0 = (i & 1) * 8, tau = m >> 4, k = m & 15; float v[8];
#pragma unroll
            for (int q = 0; q < 8; ++q) { float x = 0.f; if (sg <= tau) x += Kt[((tau - sg) * 16 + k) * 16 + h0 + q]; if (sg >= tau) x += Kt[((32 + sg - tau) * 16 + k) * 16 + h0 + q]; v[q] = x; }
            u32x4 w; w.x = pk2(v[0], v[1]); w.y = pk2(v[2], v[3]); w.z = pk2(v[4], v[5]); w.w = pk2(v[6], v[7]);
            *(u32x4*)(W2 + ((size_t)g * 512 + m) * 768 + sg * 16 + h0) = w;
        }
    }
    __syncthreads();
}
__device__ __forceinline__ void ph_s5_scan(const Frame& F) {
    const float* SS = (const float*)(F.ws + WS_SS); bf16* AG = (bf16*)(F.ws + WS_AG); const f32x2* A32 = (const f32x2*)(F.ws + WS_S5A);
    for (int gid = F.bid * NTHREADS + F.tid; gid < 64 * 32 * 128; gid += F.nb * NTHREADS) {
        const int p = gid & 63, dir = (gid >> 6) & 1, b = (gid >> 7) & 31, g = gid >> 12;
        const f32x2 a = A32[(g * 2 + dir) * 64 + p];
        float hr = 0.f, hi = 0.f;
        const size_t row0 = (size_t)g * 2304 + b * 72;
#pragma unroll 4
        for (int idx = 0; idx < 72; ++idx) {
            const int j = dir == 0 ? idx : (idx < 8 ? 7 - idx : 79 - idx);
            const size_t row = row0 + j;
            AG[row * 768 + 512 + dir * 128 + p] = (bf16)f2bf(hr); AG[row * 768 + 512 + dir * 128 + 64 + p] = (bf16)f2bf(hi);
            const float sr = SS[row * 256 + dir * 128 + p], si = SS[row * 256 + dir * 128 + 64 + p];
            const float nr = a.x * hr - a.y * hi + sr, ni = a.x * hi + a.y * hr + si; hr = nr; hi = ni;
        }
    }
}

template <int DUAL>
__device__ __forceinline__ void transpose_item(const float* W, int ldw, int K, int N, bf16* WT, int row_off, LAS float* scr, int item, int lane) {
    const int nblk = N / 64, kb = item / nblk, nb = item - kb * nblk, k0 = 64 * kb, n0 = 64 * nb;
    const int lr = lane >> 4, lc = (lane & 15) * 4;
    f32x4 v[16];
#pragma unroll
    for (int i = 0; i < 16; ++i) v[i] = *(const f32x4*)(W + (size_t)(k0 + lr + 4 * i) * ldw + n0 + lc);
#pragma unroll
    for (int i = 0; i < 16; ++i) { LAS float* d = scr + (lr + 4 * i) * 65 + lc; d[0] = v[i].x; d[1] = v[i].y; d[2] = v[i].z; d[3] = v[i].w; }
    asm volatile("s_waitcnt lgkmcnt(0)" ::: "memory");
    const int c = lane & 7;
#pragma unroll
    for (int j = 0; j < 8; ++j) { const int n = (lane >> 3) + 8 * j; const LAS float* sp = scr + (8 * c) * 65 + n;
        u32x4 o; o.x = pkbf(sp[0 * 65], sp[1 * 65]); o.y = pkbf(sp[2 * 65], sp[3 * 65]); o.z = pkbf(sp[4 * 65], sp[5 * 65]); o.w = pkbf(sp[6 * 65], sp[7 * 65]);
        const int nn = n0 + n, dest = DUAL == -2 ? (nn < 3072 ? nn : (nn < 4096 ? nn + 1024 : nn - 1024)) : (DUAL < 0 ? row_off + nn : row_off + (nn >> 7) * 256 + DUAL * 128 + (nn & 127));
        *(u32x4*)(WT + (size_t)dest * K + k0 + 8 * c) = o; }
    asm volatile("s_waitcnt lgkmcnt(0)" ::: "memory");
}
__device__ __forceinline__ void convert_moe(const Frame& F, int l, int cb = -1, int cnb = 0) {
    if (cb < 0) { cb = F.bid; cnb = F.nb; }
    if (cb >= cnb) return;
    LAS float* scr = (LAS float*)((LAS unsigned char*)F.lds) + F.wave * 4160;
    bf16* WGU = (bf16*)(F.ws + WO_GU); bf16* WDN = (bf16*)(F.ws + WO_DN);
    for (int it = cb * NWAVES + F.wave; it < 24576; it += cnb * NWAVES) {
        const int m = it >> 13, r = it & 8191, e = r >> 9, item = r & 511;
        if (m == 0) transpose_item<0>(F.in[29] + (size_t)(l * NE + e) * D * FF, FF, D, FF, WGU, e * 2 * FF, scr, item, F.lane);
        else if (m == 1) transpose_item<1>(F.in[30] + (size_t)(l * NE + e) * D * FF, FF, D, FF, WGU, e * 2 * FF, scr, item, F.lane);
        else transpose_item<-1>(F.in[31] + (size_t)(l * NE + e) * FF * D, D, FF, D, WDN, e * D, scr, item, F.lane);
    }
}
__device__ __forceinline__ void convert_mixers(const Frame& F, int cb, int cnb) {
    if (cb >= cnb) return;
    LAS float* scr = (LAS float*)((LAS unsigned char*)F.lds) + F.wave * 4160;
    for (int it = cb * NWAVES + F.wave; it < 4096; it += cnb * NWAVES) {
        int r = it;
        if (r < 256) { transpose_item<0>(F.in[16], 2 * D, D, D, (bf16*)(F.ws + WO_GLU), 0, scr, r, F.lane); continue; } r -= 256;
        if (r < 256) { transpose_item<1>(F.in[16] + D, 2 * D, D, D, (bf16*)(F.ws + WO_GLU), 0, scr, r, F.lane); continue; } r -= 256;
        if (r < 768) { transpose_item<-1>(F.in[17], 3 * D, D, 3 * D, (bf16*)(F.ws + WO_NAQKV), 0, scr, r, F.lane); continue; } r -= 768;
        if (r < 256) { transpose_item<-1>(F.in[18], D, D, D, (bf16*)(F.ws + WO_NAO), 0, scr, r, F.lane); continue; } r -= 256;
        if (r < 768) { transpose_item<-1>(F.in[20], 3 * D, D, 3 * D, (bf16*)(F.ws + WO_DAQKV), 0, scr, r, F.lane); continue; } r -= 768;
        if (r < 256) { transpose_item<-1>(F.in[21], D, D, D, (bf16*)(F.ws + WO_DAO), 0, scr, r, F.lane); continue; } r -= 256;
        if (r < 1280) { transpose_item<-2>(F.in[24], 5 * D, D, 5 * D, (bf16*)(F.ws + WO_HGIN), 0, scr, r, F.lane); continue; } r -= 1280;
        transpose_item<-1>(F.in[25], D, D, D, (bf16*)(F.ws + WO_HGO), 0, scr, r, F.lane);
    }
}

__device__ __forceinline__ void ph_prologue(const Frame& F) {
    {
        float* S = (float*)F.lds;
        for (int i = F.tid; i < 33 * 1024; i += NTHREADS) { const float v = i < 32 * 1024 ? F.in[1][i] : F.in[3][i - 32 * 1024]; S[i] = siluf_(v); }
        __syncthreads();
        float acc[2][33];
#pragma unroll
        for (int t = 0; t < 2; ++t)
#pragma unroll
            for (int r = 0; r < 33; ++r) acc[t][r] = 0.f;
#pragma unroll
        for (int t = 0; t < 2; ++t) {
            const int task = F.bid + t * F.nb;
            if (task < 384) {
                const int l = task / 96, col = (task % 96) * 64 + F.lane, kb = F.wave * 128;
                const float* W = F.in[4] + (size_t)l * 1024 * 6144 + col;
#pragma unroll 1
                for (int k = kb; k < kb + 128; k += 8) {
                    float w[8];
#pragma unroll
                    for (int q = 0; q < 8; ++q) w[q] = W[(size_t)(k + q) * 6144];
#pragma unroll
                    for (int r = 0; r < 33; ++r) { const f32x4 s0 = *(const f32x4*)&S[r * 1024 + k], s1 = *(const f32x4*)&S[r * 1024 + k + 4];
                        acc[t][r] += (s0.x * w[0] + s0.y * w[1]) + (s0.z * w[2] + s0.w * w[3]) + (s1.x * w[4] + s1.y * w[5]) + (s1.z * w[6] + s1.w * w[7]); }
                }
            }
        }
        __syncthreads();
#pragma unroll
        for (int t = 0; t < 2; ++t)
#pragma unroll
            for (int r = 0; r < 33; ++r) S[((t * 8 + F.wave) * 33 + r) * 64 + F.lane] = acc[t][r];
        __syncthreads();
        for (int i = F.tid; i < 2 * 33 * 64; i += NTHREADS) {
            const int t = i / (33 * 64), r = (i / 64) % 33, ln = i & 63, task = F.bid + t * F.nb;
            if (task < 384) { const int l = task / 96, col = (task % 96) * 64 + ln; float v = F.in[5][l * 6144 + col];
#pragma unroll
                for (int w = 0; w < 8; ++w) v += S[((t * 8 + w) * 33 + r) * 64 + ln];
                F.MOD[((size_t)l * 33 + r) * 6144 + col] = v; }
        }
        __syncthreads();
    }
    if (F.bid == 48) {
        const float* lbin = F.in[27];
        for (int c = F.tid; c < D; c += NTHREADS) { const float x0 = lbin[c], x1 = lbin[D + c], x2 = lbin[2 * D + c], x3 = lbin[3 * D + c], mx = fmaxf(fmaxf(x0, x1), fmaxf(x2, x3));
            const float e0 = expf(x0 - mx), e1 = expf(x1 - mx), e2 = expf(x2 - mx), e3 = expf(x3 - mx); ((float*)(F.ws + WS_LB))[c] = (e1 + e2 + e3) / (e0 + e1 + e2 + e3); }
    }
    if (F.bid == 49) {
        for (int i = F.tid; i < 64 * 16; i += NTHREADS) { const float inv = powf(10000.0f, -(float)(i & 15) * (1.0f / 16.0f)); float sn, cs; sincosf((float)(i >> 4) * inv, &sn, &cs);
            ((float*)(F.ws + WS_ROPE))[2 * i] = cs; ((float*)(F.ws + WS_ROPE))[2 * i + 1] = sn; }
    }
    { const int ncv = F.nb > 128 ? F.nb - 64 : F.nb;
      convert_mixers(F, F.bid, ncv); convert_moe(F, 0, F.bid, ncv); }
    __syncthreads();
    ph_s5_pre(F);
}

template <bool F32> struct XRawT { typedef f32x4 T; };
template <> struct XRawT<false> { typedef u32x2 T; };
__device__ __forceinline__ f32x4 xcvt(const f32x4& r) { return r; }
__device__ __forceinline__ f32x4 xcvt(const u32x2& r) { return (f32x4){bflo(r.x), bfhi(r.x), bflo(r.y), bfhi(r.y)}; }
template <int MODE, bool COMBINE, bool S5OUT = false, bool SKIPCTX = false, bool FROMIN = false>
__device__ __forceinline__ void ph_norm(const Frame& F, int layer, int prev_layer) {
    static_assert(MODE != 1, "norm2 + router is ph_norm2");
    const float* nw = MODE == 0 ? F.in[6] + layer * D : F.in[32];
    const bf16* Y = (const bf16*)(F.ws + WS_Y);
    constexpr int NI = SKIPCTX ? NB * SEQ : R;
    constexpr int NPF = 4;
    const int per = (NI + F.nb * NWAVES - 1) / (F.nb * NWAVES);
    int it = (F.bid * NWAVES + F.wave) * per; const int itend = min(NI, it + per);
    typedef typename XRawT<FROMIN>::T XR;
    const __amdgpu_buffer_rsrc_t yrs = __builtin_amdgcn_make_buffer_rsrc((void*)Y, 0, (int)((size_t)NE * SLOTS * D * 2), 0x00020000);
    const int l16 = F.lane & 15;
#define NORM_ROWOF(i_) (SKIPCTX ? ((i_) >> 11) * P + NCTX + ((i_) & (SEQ - 1)) : (i_))
#define NORM_XPTR(r_) ((FROMIN ? (const XR*)(((r_) % P) < NCTX ? F.in[2] + ((size_t)((r_) / P) * NCTX + ((r_) % P)) * D : F.in[0] + ((size_t)((r_) / P) * SEQ + ((r_) % P) - NCTX) * D) : (const XR*)(F.X + (size_t)(r_) * D)) + F.lane)
#define NORM_STAGE(i_, INVA_, V_, G_, Yq_, INVB_) do { \
        const int ic_ = min((i_), itend - 1), ic1_ = min((i_) + 1, itend - 1); const int rA_ = NORM_ROWOF(ic_); \
        if (COMBINE) INVB_ = F.INV[(size_t)NORM_ROWOF(ic1_) * NE + l16]; \
        if (COMBINE) G_ = F.GATE[l16 * SLOTS + max(INVA_, 0)]; \
        { const XR* xp_ = NORM_XPTR(rA_); _Pragma("unroll") for (int j = 0; j < 4; ++j) V_[j] = xp_[64 * j]; } \
        if (COMBINE) { unsigned m_ = ((i_) < itend) ? (unsigned)(__ballot(F.lane < NE && INVA_ >= 0) & 0xffffull) : 0u; \
            _Pragma("unroll") for (int q = 0; q < NPF; ++q) { const bool pr_ = m_ != 0u; const int e_ = pr_ ? __builtin_ctz(m_) : 0; m_ &= m_ - 1u; const int s_ = __builtin_amdgcn_readlane(INVA_, e_); \
                const unsigned vo_ = pr_ ? (unsigned)(e_ * SLOTS + s_) * (unsigned)(D * 2) + (unsigned)F.lane * 8u : 0xfffff000u; \
                _Pragma("unroll") for (int j = 0; j < 4; ++j) Yq_[q][j] = __builtin_amdgcn_raw_buffer_load_b64(yrs, vo_ + 512u * j, 0, 0); } } \
    } while (0)
    XR v[4]; u32x2 yc[NPF][4]; float gl = 0.f; int invl = -1, invn = -1;
    if (COMBINE) invl = F.INV[(size_t)NORM_ROWOF(min(it, NI - 1)) * NE + l16];
    NORM_STAGE(it, invl, v, gl, yc, invn);
    const f32x4* nw4 = (const f32x4*)nw + F.lane;
    f32x4 g5[4], nwv[4], shv[4], scv[4]; int mrc = -1;
#pragma unroll
    for (int j = 0; j < 4; ++j) { nwv[j] = nw4[64 * j]; g5[j] = shv[j] = scv[j] = (f32x4){0.f, 0.f, 0.f, 0.f}; }
    while (it < itend) {
        const int row = NORM_ROWOF(it), b = row / P, pos = row - b * P, mr = pos < NCTX ? 32 : b;
        if (mr != mrc) { mrc = mr;
            const float* mrow = F.MOD + ((size_t)layer * 33 + mr) * 6144;
#pragma unroll
            for (int j = 0; j < 4; ++j) {
                if (COMBINE) g5[j] = ((const f32x4*)(F.MOD + ((size_t)prev_layer * 33 + mr) * 6144 + 5 * D) + F.lane)[64 * j];
                if (MODE != 2) { shv[j] = ((const f32x4*)(mrow + (MODE == 0 ? 0 : 3) * D) + F.lane)[64 * j]; scv[j] = ((const f32x4*)(mrow + (MODE == 0 ? 1 : 4) * D) + F.lane)[64 * j]; }
            }
        }
        XR vn[4]; u32x2 yn[NPF][4]; float gln = 0.f; int invnn = -1;
        NORM_STAGE(it + 1, invn, vn, gln, yn, invnn);
        f32x4 a[4];
#pragma unroll
        for (int j = 0; j < 4; ++j) a[j] = (f32x4){0.f, 0.f, 0.f, 0.f};
        if (COMBINE) {
            unsigned m = (unsigned)(__ballot(F.lane < NE && invl >= 0) & 0xffffull);
#pragma unroll
            for (int q = 0; q < NPF; ++q) {
                const bool pr = m != 0u; const int e = pr ? __builtin_ctz(m) : 0; m &= m - 1u;
                const float g = pr ? __uint_as_float(__builtin_amdgcn_readlane(__float_as_uint(gl), e)) : 0.f;
#pragma unroll
                for (int j = 0; j < 4; ++j) { a[j].x += g * bflo(yc[q][j].x); a[j].y += g * bfhi(yc[q][j].x); a[j].z += g * bflo(yc[q][j].y); a[j].w += g * bfhi(yc[q][j].y); }
            }
            while (m) {
                const int e = __builtin_ctz(m); m &= m - 1u;
                const int sl = __builtin_amdgcn_readlane(invl, e); const float g = __uint_as_float(__builtin_amdgcn_readlane(__float_as_uint(gl), e));
                const u32x2* y0 = (const u32x2*)(Y + ((size_t)e * SLOTS + sl) * D) + F.lane;
                u32x2 w0[4];
#pragma unroll
                for (int j = 0; j < 4; ++j) w0[j] = y0[64 * j];
#pragma unroll
                for (int j = 0; j < 4; ++j) { a[j].x += g * bflo(w0[j].x); a[j].y += g * bfhi(w0[j].x); a[j].z += g * bflo(w0[j].y); a[j].w += g * bfhi(w0[j].y); }
            }
        }
        f32x4 vv[4];
#pragma unroll
        for (int j = 0; j < 4; ++j) vv[j] = xcvt(v[j]);
        if (COMBINE) {
#pragma unroll
            for (int j = 0; j < 4; ++j) vv[j] = vv[j] + g5[j] * a[j];
        }
        if ((FROMIN || COMBINE) && MODE != 2) { u32x2* xw = (u32x2*)(F.X + (size_t)row * D) + F.lane;
#pragma unroll
            for (int j = 0; j < 4; ++j) { u32x2 w; w.x = pkbf(vv[j].x, vv[j].y); w.y = pkbf(vv[j].z, vv[j].w); xw[64 * j] = w; } }
        float ss = 0.f;
#pragma unroll
        for (int j = 0; j < 4; ++j) ss += (vv[j].x * vv[j].x + vv[j].y * vv[j].y) + (vv[j].z * vv[j].z + vv[j].w * vv[j].w);
        const float rinv = rsqrtf(wave_sum(ss) * (1.0f / D) + EPS);
        if (MODE == 2) {
            if (pos >= NCTX) {
                f32x4* o = (f32x4*)(F.out + ((size_t)b * SEQ + pos - NCTX) * D) + F.lane;
#pragma unroll
                for (int j = 0; j < 4; ++j) o[64 * j] = vv[j] * rinv * nwv[j];
            }
        } else {
            u32x2* ho = (u32x2*)(F.H + (size_t)row * D) + F.lane;
            f32x4 h[4];
#pragma unroll
            for (int j = 0; j < 4; ++j) { h[j] = vv[j] * rinv * nwv[j] * (scv[j] + 1.0f) + shv[j]; u32x2 w; w.x = pkbf(h[j].x, h[j].y); w.y = pkbf(h[j].z, h[j].w); ho[64 * j] = w;
                if (S5OUT) { const int g = (F.lane >> 2) + 16 * j;
                    *(u32x2*)((bf16*)(F.ws + WS_AG) + ((size_t)g * 2304 + b * 72 + (pos >> 5)) * 768 + (pos & 31) * 16 + (F.lane & 3) * 4) = w; } }
        }
#pragma unroll
        for (int j = 0; j < 4; ++j) { v[j] = vn[j];
#pragma unroll
            for (int q = 0; q < NPF; ++q) yc[q][j] = yn[q][j]; }
        gl = gln; invl = invn; invn = invnn; ++it;
    }
#undef NORM_STAGE
#undef NORM_XPTR
#undef NORM_ROWOF
}

template <bool SKIPCTX>
__device__ __forceinline__ void ph_norm2(const Frame& F, int layer) {
    const float* nw = F.in[7] + layer * D;
    LAS float* wrt = (LAS float*)((LAS unsigned char*)F.lds);
    {
        const float* wr = F.in[28] + (size_t)layer * D * NE;
        for (int i = F.tid; i < D * NE; i += NTHREADS) wrt[(i & 15) * (D + 4) + (i >> 4)] = wr[i];
        __syncthreads();
    }
    const f32x4* nw4 = (const f32x4*)nw + F.lane;
    const int eid = ((F.lane & 1) << 3) | ((F.lane & 2) << 1) | ((F.lane & 4) >> 1) | ((F.lane & 8) >> 3);
    constexpr int NI = SKIPCTX ? NB * SEQ / 2 : R / 2;
    const int per = (NI + F.nb * NWAVES - 1) / (F.nb * NWAVES), it0 = (F.bid * NWAVES + F.wave) * per, it1 = min(NI, it0 + per);
    f32x4 gv[4], shv[4]; int mrc = -1;
#pragma unroll
    for (int j = 0; j < 4; ++j) gv[j] = shv[j] = (f32x4){0.f, 0.f, 0.f, 0.f};
#define N2_ROWOF(i_) (SKIPCTX ? ((i_) >> 10) * P + NCTX + 2 * ((i_) & (SEQ / 2 - 1)) : 2 * (i_))
    u32x2 w0[4], w1[4];
    { const u32x2* x0 = (const u32x2*)(F.X + (size_t)N2_ROWOF(min(it0, NI - 1)) * D) + F.lane;
#pragma unroll
      for (int j = 0; j < 4; ++j) { w0[j] = x0[64 * j]; w1[j] = x0[256 + 64 * j]; } }
    for (int it = it0; it < it1; ++it) {
        const int row = N2_ROWOF(it), b = row / P, pos = row - b * P, mr = pos < NCTX ? 32 : b;
        f32x4 v0[4], v1[4];
#pragma unroll
        for (int j = 0; j < 4; ++j) { v0[j] = xcvt(w0[j]); v1[j] = xcvt(w1[j]); }
        if (mr != mrc) { mrc = mr;
            const float* mrow = F.MOD + ((size_t)layer * 33 + mr) * 6144;
#pragma unroll
            for (int j = 0; j < 4; ++j) { shv[j] = ((const f32x4*)(mrow + 3 * D) + F.lane)[64 * j]; gv[j] = nw4[64 * j] * (((const f32x4*)(mrow + 4 * D) + F.lane)[64 * j] + 1.0f); }
        }
        u32x2 n0[4], n1[4];
        { const u32x2* xn = (const u32x2*)(F.X + (size_t)N2_ROWOF(min(it + 1, it1 - 1)) * D) + F.lane;
#pragma unroll
          for (int j = 0; j < 4; ++j) { n0[j] = xn[64 * j]; n1[j] = xn[256 + 64 * j]; } }
        float s0 = 0.f, s1 = 0.f;
#pragma unroll
        for (int j = 0; j < 4; ++j) { s0 += (v0[j].x * v0[j].x + v0[j].y * v0[j].y) + (v0[j].z * v0[j].z + v0[j].w * v0[j].w); s1 += (v1[j].x * v1[j].x + v1[j].y * v1[j].y) + (v1[j].z * v1[j].z + v1[j].w * v1[j].w); }
        const float r0 = rsqrtf(wave_sum(s0) * (1.0f / D) + EPS), r1 = rsqrtf(wave_sum(s1) * (1.0f / D) + EPS);
        u32x2* h0 = (u32x2*)(F.H + (size_t)row * D) + F.lane; u32x2* h1 = h0 + 256;
#pragma unroll
        for (int j = 0; j < 4; ++j) { const f32x4 g = gv[j];
            v0[j] = v0[j] * r0 * g + shv[j]; v1[j] = v1[j] * r1 * g + shv[j];
            u32x2 w; w.x = pkbf(v0[j].x, v0[j].y); w.y = pkbf(v0[j].z, v0[j].w); h0[64 * j] = w;
            w.x = pkbf(v1[j].x, v1[j].y); w.y = pkbf(v1[j].z, v1[j].w); h1[64 * j] = w; }
        f32x2 a0[NE], a1[NE];
#pragma unroll
        for (int e = 0; e < NE; ++e) { a0[e] = (f32x2){0.f, 0.f}; a1[e] = (f32x2){0.f, 0.f}; }
#pragma unroll
        for (int j = 0; j < 4; ++j) { asm volatile("" ::: "memory");
            const f32x2 p0 = {v0[j].x, v0[j].y}, q0 = {v0[j].z, v0[j].w}, p1 = {v1[j].x, v1[j].y}, q1 = {v1[j].z, v1[j].w};
#pragma unroll
            for (int e = 0; e < NE; ++e) { const f32x4 w = *(const LAS f32x4*)(wrt + e * (D + 4) + F.lane * 4 + 256 * j); const f32x2 wl = {w.x, w.y}, wh = {w.z, w.w};
                a0[e] += p0 * wl; a0[e] += q0 * wh; a1[e] += p1 * wl; a1[e] += q1 * wh; } }
        float lg0[NE], lg1[NE];
#pragma unroll
        for (int e = 0; e < NE; ++e) { lg0[e] = a0[e].x + a0[e].y; lg1[e] = a1[e].x + a1[e].y; }
        const float t0 = reduce16(lg0, F.lane), t1 = reduce16(lg1, F.lane);
        float m0 = fmaxf(t0, dpp_xor1(t0)), m1 = fmaxf(t1, dpp_xor1(t1));
        m0 = fmaxf(m0, dpp_xor2(m0)); m1 = fmaxf(m1, dpp_xor2(m1)); m0 = fmaxf(m0, __shfl_xor(m0, 4)); m1 = fmaxf(m1, __shfl_xor(m1, 4)); m0 = fmaxf(m0, __shfl_xor(m0, 8)); m1 = fmaxf(m1, __shfl_xor(m1, 8));
        const float e0 = __builtin_amdgcn_exp2f((t0 - m0) * LOG2E_), e1 = __builtin_amdgcn_exp2f((t1 - m1) * LOG2E_);
        float z0 = e0 + dpp_xor1(e0), z1 = e1 + dpp_xor1(e1);
        z0 += dpp_xor2(z0); z1 += dpp_xor2(z1); z0 += __shfl_xor(z0, 4); z1 += __shfl_xor(z1, 4); z0 += __shfl_xor(z0, 8); z1 += __shfl_xor(z1, 8);
        if (F.lane < NE) { float* ap = F.AFF + ((size_t)b * NE + eid) * P + pos; ap[0] = e0 / z0; ap[1] = e1 / z1; }
#pragma unroll
        for (int j = 0; j < 4; ++j) { w0[j] = n0[j]; w1[j] = n1[j]; }
    }
#undef N2_ROWOF
}

__device__ __forceinline__ void ph_topk(const Frame& F, int nitems) {
    const int tid = F.tid, lane = F.lane, half = F.wave >> 2, hw = F.wave & 3, ht = tid & 255;
    unsigned* hist = (unsigned*)F.lds + half * 288;
    unsigned* wtot = hist + 256;
    unsigned* bc = wtot + 8;
    for (int item0 = F.bid; item0 < nitems; item0 += 2 * F.nb) {
        const int item = item0 + half * F.nb; const bool valid = item < nitems;
        const int seg = item >> 9, b = (item >> 4) & 31, e = item & 15;
        const int n = seg ? NCTX : SEQ, pos0 = seg ? 0 : NCTX, cap = n / 8, slot0 = seg ? NB * 256 + b * 32 : b * 256;
        const int per = seg ? 1 : 8;
        const float* a = F.AFF + ((size_t)b * NE + e) * P + pos0;
        unsigned u[8];
#pragma unroll
        for (int q = 0; q < 8; ++q) u[q] = 0u;
        if (valid) {
            if (seg) u[0] = __float_as_uint(a[ht]);
            else { const f32x4 a0 = *(const f32x4*)(a + ht * 8), a1 = *(const f32x4*)(a + ht * 8 + 4);
                u[0] = __float_as_uint(a0.x); u[1] = __float_as_uint(a0.y); u[2] = __float_as_uint(a0.z); u[3] = __float_as_uint(a0.w);
                u[4] = __float_as_uint(a1.x); u[5] = __float_as_uint(a1.y); u[6] = __float_as_uint(a1.z); u[7] = __float_as_uint(a1.w); }
        }
        unsigned prefix = 0u, mask = 0u, kk = (unsigned)cap;
#pragma unroll 1
        for (int pass = 0; pass < 4; ++pass) {
            const int shift = 24 - 8 * pass;
            __syncthreads();
            hist[ht] = 0u;
            __syncthreads();
            if (valid) {
#pragma unroll
                for (int q = 0; q < 8; ++q) if (q < per && (u[q] & mask) == prefix) atomicAdd(&hist[(u[q] >> shift) & 255u], 1u);
            }
            __syncthreads();
            unsigned hv = hist[255 - ht], cum = hv;
#pragma unroll
            for (int o = 1; o < 64; o <<= 1) { const unsigned t = __shfl_up(cum, o); if (lane >= o) cum += t; }
            if (lane == 63) wtot[hw] = cum;
            __syncthreads();
            {
                unsigned off = 0u;
#pragma unroll
                for (int w = 0; w < 4; ++w) if (w < hw) off += wtot[w];
                cum += off;
                if (cum >= kk && cum - hv < kk) { bc[0] = 255u - (unsigned)ht; bc[1] = kk - (cum - hv); }
            }
            __syncthreads();
            prefix |= bc[0] << shift; mask |= 255u << shift; kk = bc[1];
        }
        unsigned cg = 0u, ce = 0u;
        if (valid) {
#pragma unroll
            for (int q = 0; q < 8; ++q) if (q < per) { cg += u[q] > prefix ? 1u : 0u; ce += u[q] == prefix ? 1u : 0u; }
        }
        unsigned pk = cg | (ce << 16), inc = pk;
#pragma unroll
        for (int o = 1; o < 64; o <<= 1) { const unsigned t = __shfl_up(inc, o); if (lane >= o) inc += t; }
        __syncthreads();
        if (lane == 63) wtot[hw] = inc;
        __syncthreads();
        unsigned off = 0u;
#pragma unroll
        for (int w = 0; w < 4; ++w) if (w < hw) off += wtot[w];
        unsigned excl = inc - pk + off, gb = excl & 0xffffu, eb = excl >> 16;
        if (valid) {
#pragma unroll
            for (int q = 0; q < 8; ++q) if (q < per) {
                const int i = ht * per + q, row = b * P + pos0 + i;
                const bool gt = u[q] > prefix, eq = u[q] == prefix, sel = gt || (eq && eb < kk);
                if (sel) { const int slot = slot0 + (int)(gb + (eb < kk ? eb : kk)); F.SEL[e * SLOTS + slot] = row; F.GATE[e * SLOTS + slot] = __uint_as_float(u[q]); F.INV[(size_t)row * NE + e] = slot; }
                else F.INV[(size_t)row * NE + e] = -1;
                gb += gt ? 1u : 0u; eb += eq ? 1u : 0u;
            }
        }
        __syncthreads();
    }
    __syncthreads();
}

typedef short bf16x8 __attribute__((ext_vector_type(8)));
typedef float f32x16 __attribute__((ext_vector_type(16)));
#define MFMA32(a, b, c) __builtin_amdgcn_mfma_f32_32x32x16_bf16((a), (b), (c), 0, 0, 0)
__device__ __forceinline__ int kperm(int m) { return (m & 0x13) | ((m & 8) >> 1) | ((m & 4) << 1); }
__device__ __forceinline__ bf16x8 pack8(const f32x16& x, int s8) {
    u32x4 p; p.x = pkbf(x[s8 + 0], x[s8 + 1]); p.y = pkbf(x[s8 + 2], x[s8 + 3]); p.z = pkbf(x[s8 + 4], x[s8 + 5]); p.w = pkbf(x[s8 + 6], x[s8 + 7]);
    return __builtin_bit_cast(bf16x8, p);
}
constexpr float LOG2E = 1.4426950408889634f;

__device__ __forceinline__ void ph_da_attn(const Frame& F) {
    const bf16* Q = (const bf16*)(F.ws + WS_Q); const bf16* K = (const bf16*)(F.ws + WS_K); const bf16* VT = (const bf16*)(F.ws + WS_VT); bf16* O = (bf16*)(F.ws + WS_O);
    const int tid = F.tid, lane = F.lane, l32 = lane & 31, hh = lane >> 5, map = F.wave & 1, qsub = F.wave >> 1;
    const float* lam = F.in[22];
    const float lam_full = expf(wave_sum(lam[lane] * lam[64 + lane])) - expf(wave_sum(lam[128 + lane] * lam[192 + lane])) + LAM_INIT;
    constexpr int KB = 64 * 144, VB = 128 * 144, BUF = 2 * KB + VB;
    unsigned char* sb = F.lds;
    float* xch = (float*)(F.lds + 2 * BUF) + qsub * 4096;
    const float c = 0.125f * LOG2E;
    const int kr = (tid >> 3) & 63, kc = tid & 7, vd = tid >> 3, vc = tid & 7;
    const int kdst = kr * 144 + kc * 16, vdst = 2 * KB + vd * 144 + vc * 16;
    const int kfrag = map * KB + kperm(l32) * 144 + hh * 16, vfrag = 2 * KB + l32 * 144 + hh * 16;
    const int vb = (F.nb & 7) == 0 ? (F.bid & 7) * (F.nb >> 3) + (F.bid >> 3) : F.bid;
    for (int it = vb; it < 4096 + 512; it += F.nb) {
        int b, h, pos0, nst;
        if (it < 4096) { b = it >> 7; h = (it >> 4) & 7; pos0 = NCTX + (it & 15) * 128 + qsub * 32; nst = P / 64; }
        else { const int j = it - 4096; b = j >> 4; h = (j >> 1) & 7; pos0 = (j & 1) * 128 + qsub * 32; nst = NCTX / 64; }
        const size_t qrow = (size_t)b * P + pos0 + l32;
        bf16x8 qf[4];
#pragma unroll
        for (int ks = 0; ks < 4; ++ks) qf[ks] = *(const bf16x8*)(Q + qrow * D + h * 128 + map * 64 + ks * 16 + hh * 8);
        f32x16 o[4];
#pragma unroll
        for (int dt = 0; dt < 4; ++dt)
#pragma unroll
            for (int j = 0; j < 16; ++j) o[dt][j] = 0.f;
        float m = 0.f, l = 0.f;
        const bf16* kg = K + ((size_t)b * P + kr) * D + h * 128 + kc * 8;
        const bf16* vg = VT + ((size_t)b * D + h * 128 + vd) * P + vc * 8;
        u32x4 ka0, ka1, va0, va1;
        { const u32x4 k0 = *(const u32x4*)kg, k1 = *(const u32x4*)(kg + 64), v0 = *(const u32x4*)vg, v1 = *(const u32x4*)(vg + (size_t)64 * P);
          const bf16* kq = kg + (size_t)64 * D; const bf16* vq = vg + 64;
          ka0 = *(const u32x4*)kq; ka1 = *(const u32x4*)(kq + 64); va0 = *(const u32x4*)vq; va1 = *(const u32x4*)(vq + (size_t)64 * P);
          *(u32x4*)(sb + kdst) = k0; *(u32x4*)(sb + KB + kdst) = k1; *(u32x4*)(sb + vdst) = v0; *(u32x4*)(sb + vdst + 64 * 144) = v1; }
        __syncthreads();
#pragma unroll 1
        for (int st = 0; st < nst; ++st) {
            const unsigned char* cb = sb + (st & 1) * BUF;
            u32x4 kn0 = (u32x4){0u, 0u, 0u, 0u}, kn1 = kn0, vn0 = kn0, vn1 = kn0;
            if (st + 2 < nst) { const bf16* kq = kg + (size_t)(st + 2) * 64 * D; const bf16* vq = vg + (st + 2) * 64;
                kn0 = *(const u32x4*)kq; kn1 = *(const u32x4*)(kq + 64); vn0 = *(const u32x4*)vq; vn1 = *(const u32x4*)(vq + (size_t)64 * P); }
#pragma unroll
            for (int sub = 0; sub < 2; ++sub) {
                f32x16 s;
#pragma unroll
                for (int j = 0; j < 16; ++j) s[j] = -m;
#pragma unroll
                for (int ks = 0; ks < 4; ++ks) s = MFMA32(*(const bf16x8*)(cb + kfrag + sub * 32 * 144 + ks * 32), qf[ks], s);
                float mx = s[0];
#pragma unroll
                for (int j = 1; j < 16; ++j) mx = fmaxf(mx, s[j]);
                mx = fmaxf(mx, __shfl_xor(mx, 32));
                const bool first = st == 0 && sub == 0;
                if (first || __any(mx > 8.0f)) {
                    const float d = first ? mx : fmaxf(mx, 0.f);
                    if (!first) { const float alpha = __builtin_amdgcn_exp2f(-d); l *= alpha;
#pragma unroll
                        for (int dt = 0; dt < 4; ++dt)
#pragma unroll
                            for (int j = 0; j < 16; ++j) o[dt][j] *= alpha; }
                    m += d;
#pragma unroll
                    for (int j = 0; j < 16; ++j) s[j] -= d;
                }
                float ps = 0.f;
#pragma unroll
                for (int j = 0; j < 16; ++j) { s[j] = __builtin_amdgcn_exp2f(s[j]); ps += s[j]; }
                l += ps;
                const bf16x8 p0 = pack8(s, 0), p1 = pack8(s, 8);
#pragma unroll
                for (int dt = 0; dt < 4; ++dt) { o[dt] = MFMA32(*(const bf16x8*)(cb + vfrag + dt * 32 * 144 + sub * 64), p0, o[dt]); o[dt] = MFMA32(*(const bf16x8*)(cb + vfrag + dt * 32 * 144 + sub * 64 + 32), p1, o[dt]); }
            }
            if (st + 1 < nst) { unsigned char* nb = sb + ((st + 1) & 1) * BUF; *(u32x4*)(nb + kdst) = ka0; *(u32x4*)(nb + KB + kdst) = ka1; *(u32x4*)(nb + vdst) = va0; *(u32x4*)(nb + vdst + 64 * 144) = va1; }
            ka0 = kn0; ka1 = kn1; va0 = vn0; va1 = vn1;
            __syncthreads();
        }
        l += __shfl_xor(l, 32);
        const float inv = 1.0f / l;
        if (map == 1) {
#pragma unroll
            for (int dt = 0; dt < 4; ++dt)
#pragma unroll
                for (int j = 0; j < 16; ++j) xch[(dt * 16 + j) * 64 + lane] = o[dt][j] * inv * lam_full;
        }
        __syncthreads();
        if (map == 0) {
            float ss = 0.f;
#pragma unroll
            for (int dt = 0; dt < 4; ++dt)
#pragma unroll
                for (int j = 0; j < 16; ++j) { const float v = o[dt][j] * inv - xch[(dt * 16 + j) * 64 + lane]; o[dt][j] = v; ss += v * v; }
            ss += __shfl_xor(ss, 32);
            const float rinv = rsqrtf(ss * (1.0f / 128.0f) + EPS) * (1.0f - LAM_INIT);
#pragma unroll
            for (int dt = 0; dt < 4; ++dt)
#pragma unroll
                for (int jq = 0; jq < 4; ++jq) {
                    const int d0 = dt * 32 + jq * 8 + hh * 4; const f32x4 sw = *(const f32x4*)(F.in[23] + d0);
                    u32x2 w; w.x = pkbf(o[dt][jq * 4 + 0] * rinv * sw.x, o[dt][jq * 4 + 1] * rinv * sw.y); w.y = pkbf(o[dt][jq * 4 + 2] * rinv * sw.z, o[dt][jq * 4 + 3] * rinv * sw.w);
                    *(u32x2*)(O + qrow * D + h * 128 + d0) = w;
                }
        }
        __syncthreads();
    }
}

__device__ __forceinline__ void ph_na_attn(const Frame& F) {
    const bf16* Q = (const bf16*)(F.ws + WS_Q); const bf16* K = (const bf16*)(F.ws + WS_K); const bf16* VT = (const bf16*)(F.ws + WS_VT); bf16* O = (bf16*)(F.ws + WS_O);
    const int tid = F.tid, lane = F.lane, l32 = lane & 31, hh = lane >> 5;
    constexpr int KB = 128 * 144, VP = 272, VB = 64 * VP, BUF = KB + VB;
    unsigned char* sb = F.lds;
    float* rp = (float*)(F.lds + 2 * BUF) + 64;
    for (int i = tid; i < 16 * 15 * 31 + 128; i += NTHREADS) { const int k = i - 64; rp[k] = (k >= 0 && k < 16 * 15 * 31) ? F.in[19][k] * LOG2E : 0.f; }
    __syncthreads();
    const float c = 0.125f * LOG2E;
    const int pr = tid >> 3, pc = tid & 7;
    const int kdst = pr * 144 + pc * 16, vdst = KB + pr * VP + pc * 16;
    const int kfrag = kperm(l32) * 144 + hh * 16, vfrag = KB + l32 * VP + hh * 16;
    const int vb = (F.nb & 7) == 0 ? (F.bid & 7) * (F.nb >> 3) + (F.bid >> 3) : F.bid;
    for (int it = vb; it < 4096 + 512; it += F.nb) {
        int b, h, r = 0, cq = 0, kc0 = 0, rlo = 0, rhi = 0, wr0 = 0, wr1 = 0, nt; bool lat; size_t qrow;
        if (it < 4096) { lat = true; b = it >> 7; h = (it >> 3) & 15; const int rg = ((it & 7) + (it >> 8)) & 7  ;
            const int rw = rg * 4 + (F.wave >> 2) * 2, cqt = F.wave & 3; r = rw + (l32 >> 4); cq = cqt * 16 + (l32 & 15); kc0 = min(max(cqt * 16 - 8, 0), 32);
            wr0 = min(max(rw - 4, 0), 24); wr1 = min(max(rw + 1 - 4, 0), 24) + 8;
            qrow = (size_t)b * P + NCTX + r * 64 + cq;
            rlo = min(max(rg * 4 - 4, 0), 24); rhi = min(max(rg * 4 + 3 - 4, 0), 24) + 7; nt = 2 + (rhi - rlo + 2) / 2; }
        else { lat = false; const int j = it - 4096; b = j >> 4; h = j & 15; qrow = (size_t)b * P + F.wave * 32 + l32; nt = 2; }
        const int r0 = min(max(r - 4, 0), 24), c0 = min(max(cq - 8, 0), 48);
        bf16x8 qf[4];
#pragma unroll
        for (int ks = 0; ks < 4; ++ks) qf[ks] = *(const bf16x8*)(Q + qrow * D + h * 64 + ks * 16 + hh * 8);
        float neg[16];
#pragma unroll
        for (int j = 0; j < 16; ++j) { const int kcol = kc0 + 16 * (j >> 3) + 8 * hh + 4 * ((j >> 2) & 1) + (j & 3); neg[j] = (kcol >= c0 && kcol < c0 + 16) ? 0.f : -1.0e30f; }
        f32x16 o[2];
#pragma unroll
        for (int dt = 0; dt < 2; ++dt)
#pragma unroll
            for (int j = 0; j < 16; ++j) o[dt][j] = 0.f;
        float m = -1.0e30f, l = 0.f;
        const bf16* kg = K + ((size_t)b * P + pr) * D + h * 64 + pc * 8;
        const bf16* vg = VT + ((size_t)b * D + h * 64 + pr) * P + pc * 8;
#define NA_KEYA(st) ((st) < 2 ? (st) * 128 : NCTX + (rlo + 2 * ((st) - 2)) * 64)
#define NA_KEYB(st) ((st) < 2 ? (st) * 128 + 64 : NCTX + min(rlo + 2 * ((st) - 2) + 1, 31) * 64)
#define NA_LOAD(dk0, dk1, dv0, dv1, st) do { const int ka_ = NA_KEYA(st), kb_ = NA_KEYB(st); dk0 = *(const u32x4*)(kg + (size_t)ka_ * D); dk1 = *(const u32x4*)(kg + (size_t)kb_ * D); \
        dv0 = *(const u32x4*)(vg + ka_); dv1 = *(const u32x4*)(vg + kb_); } while (0)
#define NA_STORE(buf, sk0, sk1, sv0, sv1) do { *(u32x4*)((buf) + kdst) = sk0; *(u32x4*)((buf) + kdst + 64 * 144) = sk1; *(u32x4*)((buf) + vdst) = sv0; *(u32x4*)((buf) + vdst + 128) = sv1; } while (0)
        u32x4 ka0, ka1, va0, va1;
        { u32x4 x0, x1, y0, y1; NA_LOAD(x0, x1, y0, y1, 0); NA_LOAD(ka0, ka1, va0, va1, 1); NA_STORE(sb, x0, x1, y0, y1); }
        __syncthreads();
#pragma unroll 1
        for (int st = 0; st < nt; ++st) {
            const unsigned char* cbuf = sb + (st & 1) * BUF;
            u32x4 kn0 = (u32x4){0u, 0u, 0u, 0u}, kn1 = kn0, vn0 = kn0, vn1 = kn0;
            if (st + 2 < nt) NA_LOAD(kn0, kn1, vn0, vn1, st + 2);
#define NA_TILE(KO_, WIN_, KROW_) do { const int ko = (KO_); \
                f32x16 s; \
                _Pragma("unroll") for (int j = 0; j < 16; ++j) s[j] = 0.f; \
                _Pragma("unroll") for (int ks = 0; ks < 4; ++ks) s = MFMA32(*(const bf16x8*)(cbuf + kfrag + ko * 144 + ks * 32), qf[ks], s); \
                if (WIN_) { const int krow = (KROW_); \
                    const float rmask = (krow >= r0 && krow < r0 + 8) ? 0.f : -1.0e30f;        \
                    const float* rph = rp + (h * 15 + (krow - r + 7)) * 31 - cq + 15 + 8 * hh + kc0;       \
                    _Pragma("unroll") for (int j = 0; j < 16; ++j) s[j] = (s[j] * c + rph[16 * (j >> 3) + 4 * ((j >> 2) & 1) + (j & 3)]) + (neg[j] + rmask); \
                } else { _Pragma("unroll") for (int j = 0; j < 16; ++j) s[j] *= c; } \
                float mx = s[0]; \
                _Pragma("unroll") for (int j = 1; j < 16; ++j) mx = fmaxf(mx, s[j]); \
                mx = fmaxf(mx, __shfl_xor(mx, 32)); \
                if (__any(mx > m + 8.0f)) { \
                    const float mn = fmaxf(m, mx), alpha = __builtin_amdgcn_exp2f(m - mn); m = mn; l *= alpha; \
                    _Pragma("unroll") for (int dt = 0; dt < 2; ++dt) _Pragma("unroll") for (int j = 0; j < 16; ++j) o[dt][j] *= alpha; \
                } \
                f32x2 ps2 = {0.f, 0.f}; \
                _Pragma("unroll") for (int j = 0; j < 16; j += 2) { f32x2 t = {s[j], s[j + 1]}; t = t - (f32x2){m, m}; t.x = __builtin_amdgcn_exp2f(t.x); t.y = __builtin_amdgcn_exp2f(t.y); s[j] = t.x; s[j + 1] = t.y; ps2 += t; } \
                l += ps2.x + ps2.y; \
                const bf16x8 p0 = pack8(s, 0), p1 = pack8(s, 8); \
                _Pragma("unroll") for (int dt = 0; dt < 2; ++dt) { o[dt] = MFMA32(*(const bf16x8*)(cbuf + vfrag + dt * 32 * VP + ko * 2), p0, o[dt]); o[dt] = MFMA32(*(const bf16x8*)(cbuf + vfrag + dt * 32 * VP + ko * 2 + 32), p1, o[dt]); } \
            } while (0)
            if (st < 2) {
#pragma unroll
                for (int sub = 0; sub < 4; ++sub) NA_TILE(sub * 32, false, 0);
            } else {
#pragma unroll
                for (int half = 0; half < 2; ++half) { const int krw = rlo + 2 * (st - 2) + half;
                    if (krw <= rhi && krw >= wr0 && krw < wr1) NA_TILE(half * 64 + kc0, true, krw); }
            }
#undef NA_TILE
            if (st + 1 < nt) { unsigned char* nb = sb + ((st + 1) & 1) * BUF; NA_STORE(nb, ka0, ka1, va0, va1); }
            ka0 = kn0; ka1 = kn1; va0 = vn0; va1 = vn1;
            __syncthreads();
        }
#undef NA_KEYA
#undef NA_KEYB
#undef NA_LOAD
#undef NA_STORE
        l += __shfl_xor(l, 32);
        const float inv = 1.0f / l;
#pragma unroll
        for (int dt = 0; dt < 2; ++dt)
#pragma unroll
            for (int jq = 0; jq < 4; ++jq) {
                const int d0 = dt * 32 + jq * 8 + hh * 4;
                u32x2 w; w.x = pkbf(o[dt][jq * 4 + 0] * inv, o[dt][jq * 4 + 1] * inv); w.y = pkbf(o[dt][jq * 4 + 2] * inv, o[dt][jq * 4 + 3] * inv);
                *(u32x2*)(O + qrow * D + h * 64 + d0) = w;
            }
    }
    __syncthreads();
}

__device__ __forceinline__ f32x4 unpk4(u32x2 w) { return (f32x4){bflo(w.x), bfhi(w.x), bflo(w.y), bfhi(w.y)}; }
__device__ __forceinline__ bf16 bf1(float x) { return (bf16)(pkbf(x, 0.f) & 0xffffu); }
__device__ __forceinline__ f32x4 shx32(f32x4 v) { return (f32x4){__shfl_xor(v.x, 32), __shfl_xor(v.y, 32), __shfl_xor(v.z, 32), __shfl_xor(v.w, 32)}; }
template <int DIR>
__device__ __forceinline__ void hgrn_seq(const Frame& F, int b, int h, int eb) {
    const bf16* ZIN = (const bf16*)(F.ws + WS_ZIN); const bf16* VTG = (const bf16*)(F.ws + WS_VTG); bf16* OUT = (bf16*)(F.ws + (DIR ? WS_OFB : WS_OFF));
    const int lane = F.lane, l32 = lane & 31, hh = lane >> 5, cperm = kperm(l32);
    constexpr int IMG = 32 * 136 * 2, KTB = 128 * 80, DBUF = 2 * IMG + KTB + 512;
    unsigned char* dbase = F.lds + DIR * 2 * DBUF;
    const int tg = lane & 7, prho = 8 * eb + (lane >> 3), pc = kperm(prho);
    f32x16 S[4];
#pragma unroll
    for (int d = 0; d < 4; ++d)
#pragma unroll
        for (int j = 0; j < 16; ++j) S[d][j] = 0.f;
    const bf16* vbase = VTG + ((size_t)b * D + h * 128 + eb * 32 + l32) * P + hh * 8;
    const bf16* zp = ZIN + ((size_t)b * P + 4 * tg) * 4096 + h * 128 + 4 * prho;
#define HG_CHUNK(i_) (DIR == 0 ? (i_) : ((i_) < 8 ? 7 - (i_) : 79 - (i_)))
#define HG_LOAD(i_) do { const int c_ = HG_CHUNK(i_); const bf16* z_ = zp + (size_t)c_ * 32 * 4096; \
        _Pragma("unroll") for (int i = 0; i < 4; ++i) { nlf[i] = *(const u32x2*)(z_ + (size_t)i * 4096 + (1 + DIR) * D); nq[i] = *(const u32x2*)(z_ + (size_t)i * 4096); } \
        nv0 = *(const bf16x8*)(vbase + c_ * 32); nv1 = *(const bf16x8*)(vbase + c_ * 32 + 16); } while (0)
    u32x2 nlf[4], nq[4]; bf16x8 nv0, nv1;
    HG_LOAD(0);
#pragma unroll 1
    for (int idx = 0; idx < 72; ++idx) {
        const int cc = HG_CHUNK(idx);
        const size_t row0 = (size_t)b * P + cc * 32;
        unsigned char* buf = dbase + (idx & 1) * DBUF;
        bf16* Qp = (bf16*)buf; bf16* Kp = (bf16*)(buf + IMG); bf16* KT = (bf16*)(buf + 2 * IMG); float* egl = (float*)(buf + 2 * IMG + KTB);
        u32x2 lfc[4], qc[4];
#pragma unroll
        for (int i = 0; i < 4; ++i) { lfc[i] = nlf[i]; qc[i] = nq[i]; }
        const bf16x8 vf0 = nv0, vf1 = nv1;
        HG_LOAD(min(idx + 1, 71));
        f32x4 l4[4], t = (f32x4){0.f, 0.f, 0.f, 0.f};
#pragma unroll
        for (int i = 0; i < 4; ++i) { l4[i] = unpk4(lfc[i]); t += l4[i]; }
        f32x4 x = t;
#pragma unroll
        for (int k = 1; k < 8; k <<= 1) { const f32x4 y = (f32x4){__shfl_up(x.x, k, 8), __shfl_up(x.y, k, 8), __shfl_up(x.z, k, 8), __shfl_up(x.w, k, 8)}; if (tg >= k) x += y; }
        const f32x4 tot = (f32x4){__shfl(x.x, 7, 8), __shfl(x.y, 7, 8), __shfl(x.z, 7, 8), __shfl(x.w, 7, 8)};
        const f32x4 off = DIR == 0 ? x - t : tot - x;
        f32x4 eg = (f32x4){__builtin_amdgcn_exp2f(off.x), __builtin_amdgcn_exp2f(off.y), __builtin_amdgcn_exp2f(off.z), __builtin_amdgcn_exp2f(off.w)}; float kv[4][4];
#pragma unroll
        for (int ii = 0; ii < 4; ++ii) {
            const int i = DIR ? 3 - ii : ii;
            const f32x4 lf = l4[i], q4 = unpk4(qc[i]);
            const int srow = (4 * tg + i) * 136 + pc;
#pragma unroll
            for (int d = 0; d < 4; ++d) { const float f = __builtin_amdgcn_exp2f(lf[d]); eg[d] *= f; const float kq = (1.0f - f) * __builtin_amdgcn_rcpf(eg[d]);
                Qp[srow + d * 32] = bf1(q4[d] * eg[d]); Kp[srow + d * 32] = bf1(kq); kv[d][i] = kq; }
        }
#pragma unroll
        for (int d = 0; d < 4; ++d) { u32x2 w; w.x = pkbf(kv[d][0], kv[d][1]); w.y = pkbf(kv[d][2], kv[d][3]); *(u32x2*)(KT + (d * 32 + prho) * 40 + 4 * tg) = w; }
        if (tg == 0) *(f32x4*)(egl + 4 * prho) = (f32x4){__builtin_amdgcn_exp2f(tot.x), __builtin_amdgcn_exp2f(tot.y), __builtin_amdgcn_exp2f(tot.z), __builtin_amdgcn_exp2f(tot.w)};
        __syncthreads();
        bf16x8 kf[4][2];
#pragma unroll
        for (int d = 0; d < 4; ++d)
#pragma unroll
            for (int sg = 0; sg < 2; ++sg) kf[d][sg] = *(const bf16x8*)(KT + (d * 32 + l32) * 40 + sg * 16 + 8 * hh);
        if (cc >= NCTX / 32) {
        f32x16 att, o;
#pragma unroll
        for (int j = 0; j < 16; ++j) { att[j] = 0.f; o[j] = 0.f; }
        const bf16* krow = Kp + cperm * 136 + hh * 8; const bf16* qrow = Qp + l32 * 136 + hh * 8;
#pragma unroll
        for (int ks = 0; ks < 8; ++ks) { att = MFMA32(*(const bf16x8*)(krow + ks * 16), *(const bf16x8*)(qrow + ks * 16), att);
            o = MFMA32(pack8(S[ks >> 1], (ks & 1) * 8), *(const bf16x8*)(qrow + (ks >> 1) * 32 + (ks & 1) * 16), o); }
#pragma unroll
        for (int j = 0; j < 16; ++j) { const int sa = 16 * (j >> 3) + 8 * hh + 4 * ((j >> 2) & 1) + (j & 3); const bool keep = DIR == 0 ? (sa <= l32) : (sa >= l32); att[j] = keep ? att[j] : 0.f; }
        const bf16x8 p0 = pack8(att, 0), p1 = pack8(att, 8);
        o = MFMA32(vf0, p0, o); o = MFMA32(vf1, p1, o);
        bf16* op = OUT + (row0 + l32) * D + h * 128 + eb * 32 + 4 * hh;
#pragma unroll
        for (int jq = 0; jq < 4; ++jq) { u32x2 w; w.x = pkbf(o[4 * jq], o[4 * jq + 1]); w.y = pkbf(o[4 * jq + 2], o[4 * jq + 3]); *(u32x2*)(op + 8 * jq) = w; }
        }
#pragma unroll
        for (int d = 0; d < 4; ++d) { S[d] = MFMA32(kf[d][0], vf0, S[d]); S[d] = MFMA32(kf[d][1], vf1, S[d]); }
#pragma unroll
        for (int j = 0; j < 16; ++j) { const int rho = (j & 3) + 8 * (j >> 2) + 4 * hh; const f32x4 e4 = *(const f32x4*)(egl + 4 * rho);
            S[0][j] *= e4.x; S[1][j] *= e4.y; S[2][j] *= e4.z; S[3][j] *= e4.w; }
    }
#undef HG_LOAD
#undef HG_CHUNK
}
__device__ __forceinline__ void ph_hgrn_scan(const Frame& F) {
    for (int id = F.bid * NWAVES + F.wave; id < NB * 8 * 8; id += F.nb * NWAVES) {
        const int eb = id & 3, dir = (id >> 2) & 1, h = (id >> 3) & 7, b = id >> 6;
        if (dir == 0) hgrn_seq<0>(F, b, h, eb); else hgrn_seq<1>(F, b, h, eb);
    }
}
__device__ __forceinline__ void ph_hgrn_post(const Frame& F) {
    const bf16* ZIN = (const bf16*)(F.ws + WS_ZIN); const bf16* OFF = (const bf16*)(F.ws + WS_OFF); const bf16* OFB = (const bf16*)(F.ws + WS_OFB); bf16* O2 = (bf16*)(F.ws + WS_O2);
    const int lane = F.lane, part = lane & 7;
    f32x4 gn[4];
#pragma unroll
    for (int q = 0; q < 4; ++q) gn[q] = *(const f32x4*)(F.in[26] + part * 16 + q * 4);
    for (int row = F.bid * NWAVES + F.wave; row < R; row += F.nb * NWAVES) {
        if (row % P < NCTX) continue;
        const size_t o = (size_t)row * D + lane * 16;
        const u32x4 a0 = *(const u32x4*)(OFF + o), a1 = *(const u32x4*)(OFF + o + 8), b0 = *(const u32x4*)(OFB + o), b1 = *(const u32x4*)(OFB + o + 8);
        const u32x4 g0 = *(const u32x4*)(ZIN + (size_t)row * 4096 + 3 * D + lane * 16), g1 = *(const u32x4*)(ZIN + (size_t)row * 4096 + 3 * D + lane * 16 + 8);
        float v[16];
        v[0] = bflo(a0.x) + bflo(b0.x); v[1] = bfhi(a0.x) + bfhi(b0.x); v[2] = bflo(a0.y) + bflo(b0.y); v[3] = bfhi(a0.y) + bfhi(b0.y);
        v[4] = bflo(a0.z) + bflo(b0.z); v[5] = bfhi(a0.z) + bfhi(b0.z); v[6] = bflo(a0.w) + bflo(b0.w); v[7] = bfhi(a0.w) + bfhi(b0.w);
        v[8] = bflo(a1.x) + bflo(b1.x); v[9] = bfhi(a1.x) + bfhi(b1.x); v[10] = bflo(a1.y) + bflo(b1.y); v[11] = bfhi(a1.y) + bfhi(b1.y);
        v[12] = bflo(a1.z) + bflo(b1.z); v[13] = bfhi(a1.z) + bfhi(b1.z); v[14] = bflo(a1.w) + bflo(b1.w); v[15] = bfhi(a1.w) + bfhi(b1.w);
        float ss = 0.f;
#pragma unroll
        for (int q = 0; q < 16; ++q) ss += v[q] * v[q];
        ss += dpp_xor1(ss); ss += dpp_xor2(ss); ss += __shfl_xor(ss, 4);
        const float rinv = rsqrtf(ss * (1.0f / 128.0f) + EPS);
        const unsigned gw[8] = {g0.x, g0.y, g0.z, g0.w, g1.x, g1.y, g1.z, g1.w};
        unsigned w[8];
#pragma unroll
        for (int q = 0; q < 8; ++q) w[q] = pkbf(v[2 * q] * rinv * gn[q >> 1][(2 * q) & 3] * bflo(gw[q]), v[2 * q + 1] * rinv * gn[q >> 1][(2 * q + 1) & 3] * bfhi(gw[q]));
        *(u32x4*)(O2 + o) = (u32x4){w[0], w[1], w[2], w[3]}; *(u32x4*)(O2 + o + 8) = (u32x4){w[4], w[5], w[6], w[7]};
    }
}

enum { PH_BASE = __COUNTER__ };
__global__ void __launch_bounds__(NTHREADS, 2) fwd(Args args) {
    extern __shared__ __attribute__((aligned(16))) unsigned char lds[];
    Frame F;
    F.lds = lds; F.wave = __builtin_amdgcn_readfirstlane((int)threadIdx.x >> 6); F.bid = blockIdx.x; F.nb = gridDim.x;
    REFRESH_(F);
    F.in = args.in; F.out = args.out; F.ws = args.ws;
    F.MOD = (float*)(args.ws + WS_MOD); F.AFF = (float*)(args.ws + WS_AFF); F.SEL = (int*)(args.ws + WS_SEL); F.GATE = (float*)(args.ws + WS_GATE); F.INV = (int*)(args.ws + WS_INV);
    F.X = (bf16*)(args.ws + WS_X); F.H = (bf16*)(args.ws + WS_H);
    const int lo = args.ph_lo, hi = args.ph_hi;
#if MK_SINGLE
    volatile LAS unsigned* misc = (volatile LAS unsigned*)((LAS unsigned char*)lds + LDS_MISC);
    if (F.tid < 64) misc[F.tid] = 0u;
    __syncthreads();
    XcdBarrier bar = xcd_barrier_post((unsigned*)(args.ws + WS_CTL) + CW_BAR, misc, F.tid);
#define SEAM(k) do { if ((k) + 1 < hi) xcd_barrier(bar, F.tid); } while (0)
#else
#define SEAM(k) do { } while (0)
#endif
#define PH(...) do { constexpr int k_ = __COUNTER__ - PH_BASE - 1; if (lo <= k_ && k_ < hi) { REFRESH_(F); __VA_ARGS__; SEAM(k_); } } while (0)
    bf16* HID = (bf16*)(F.ws + WS_HID); bf16* Y = (bf16*)(F.ws + WS_Y);
    PG8_LAS unsigned char* ring = (PG8_LAS unsigned char*)lds;
    bf16 *Qb = (bf16*)(F.ws + WS_Q), *VTb = (bf16*)(F.ws + WS_VT), *Ob = (bf16*)(F.ws + WS_O);

#define GEMM_PHASE(EPI, gA, lda_, gB, ldb_, gK, nM_, nN_, groups_, gsM_, ...) do { const pg8::Gemm g_{(const bf16*)(gA), (const bf16*)(gB), (lda_), (ldb_), (gK), nullptr}; pg8::GroupedOrder S_; S_.init((nM_), (nN_), (groups_), (gsM_), F.nb, F.bid); \
        const EPI E_{__VA_ARGS__}; pg8::gemm_phase<EPI, pg8::GroupedOrder, PG8_ALIGN, PG8_SP2>(ring, g_, S_, E_, F.tid); } while (0)
#define GEMM_PHASE_LAT(EPI, gA, lda_, gB, ldb_, gK, nN_, ...) do { const pg8::Gemm g_{(const bf16*)(gA), (const bf16*)(gB), (lda_), (ldb_), (gK), nullptr}; pg8::LatentOrder S_; S_.init((nN_), F.nb, F.bid); \
        const EPI E_{__VA_ARGS__}; pg8::gemm_phase<EPI, pg8::LatentOrder, PG8_ALIGN, PG8_SP2>(ring, g_, S_, E_, F.tid); } while (0)
#define GEMM_PHASE_GATHER(EPI, gA, lda_, gIdx, gB, ldb_, gK, nM_, nN_, groups_, gsM_, ...) do { const pg8::Gemm g_{(const bf16*)(gA), (const bf16*)(gB), (lda_), (ldb_), (gK), (gIdx)}; pg8::GroupedOrder S_; S_.init((nM_), (nN_), (groups_), (gsM_), F.nb, F.bid); \
        const EPI E_{__VA_ARGS__}; pg8::gemm_phase<EPI, pg8::GroupedOrder, PG8_ALIGN, PG8_SP2, true>(ring, g_, S_, E_, F.tid); } while (0)
#define MODL(L) (F.MOD + (size_t)(L) * 33 * 6144)
#define MOE_PHASES(L, NMT, NITEMS, SKIPC) \
    PH(ph_norm2<SKIPC>(F, (L))); \
    PH(ph_topk(F, (NITEMS))); \
    PH(GEMM_PHASE_GATHER(pg8::EpiSwigluT, F.H, D, F.SEL, F.ws + WO_GU, D, D, (NMT), 2 * FF / 256, NE, SLOTS / 256, HID, 2 * FF / 256, FF)); \
    PH(GEMM_PHASE(pg8::EpiDownT, HID, FF, F.ws + WO_DN, FF, FF, (NMT), D / 256, NE, SLOTS / 256, Y, F.GATE, D / 256));
#define OUT_PROJ(Asrc, Wsrc, L) PH(GEMM_PHASE(pg8::EpiResidT, (Asrc), D, (Wsrc), D, D, R / 256, D / 256, 1, R / 256, F.X, MODL(L)));

    PH(ph_prologue(F));
    PH(ph_norm<0, false, true, false, true>(F, 0, 0));
    PH(GEMM_PHASE(pg8::EpiF32G, F.ws + WS_AG, 768, F.ws + WS_S5W1, 512, 512, 2304 / 256, 1, 64, 2304 / 256, (float*)(F.ws + WS_SS), 256, 1));
    PH(ph_s5_scan(F));
    PH(GEMM_PHASE(pg8::EpiS5Out, F.ws + WS_AG, 768, F.ws + WS_S5W2, 768, 768, 2304 / 256, 2, 64, 2304 / 256, F.H, (bf16*)(F.ws + WS_Z), F.in[15]));
    PH(GEMM_PHASE(pg8::EpiGluT, F.ws + WS_Z, D, F.ws + WO_GLU, D, D, R / 256, 2 * D / 256, 1, R / 256, F.X, MODL(0)));
    MOE_PHASES(0, SLOTS / 256, NB * NE * 2, false)
    PH(ph_norm<0, true>(F, 1, 0); convert_moe(F, 1));
    PH(GEMM_PHASE(pg8::EpiBf16<0>, F.H, D, F.ws + WO_NAQKV, D, D, R / 256, 2 * D / 256, 1, R / 256, Qb, D, nullptr, D, (size_t)(WS_K - WS_Q) / 2, 1.0f);
       GEMM_PHASE(pg8::EpiVtT<false>, F.ws + WO_NAQKV + (size_t)2 * D * D * 2, D, F.H, D, D, D / 256, R / 256, 1, D / 256, VTb));
    PH(ph_na_attn(F));
    OUT_PROJ(Ob, F.ws + WO_NAO, 1)
    MOE_PHASES(1, SLOTS / 256, NB * NE * 2, false)
    PH(ph_norm<0, true>(F, 2, 1); convert_moe(F, 2));
    PH({ LAS float* rt = (LAS float*)((LAS unsigned char*)F.lds + pg8::STAGE_BYTES + 4096);
         for (int i = F.tid; i < 2048; i += NTHREADS) rt[i] = ((const float*)(F.ws + WS_ROPE))[i];
         __syncthreads(); }
       GEMM_PHASE(pg8::EpiQKRope, F.H, D, F.ws + WO_DAQKV, D, D, R / 256, 2 * D / 256, 1, R / 256, Qb, (size_t)(WS_K - WS_Q) / 2, (const PG8_LAS float*)((LAS unsigned char*)F.lds + pg8::STAGE_BYTES + 4096));
       GEMM_PHASE(pg8::EpiVtT<false>, F.ws + WO_DAQKV + (size_t)2 * D * D * 2, D, F.H, D, D, D / 256, R / 256, 1, D / 256, VTb));
    PH(ph_da_attn(F));
    OUT_PROJ(Ob, F.ws + WO_DAO, 2)
    MOE_PHASES(2, SLOTS / 256, NB * NE * 2, false)
    PH(ph_norm<0, true>(F, 3, 2); convert_moe(F, 3));
    PH({ const pg8::Gemm g_{(const bf16*)F.H, (const bf16*)(F.ws + WO_HGIN), D, D, D, nullptr}; pg8::HgInOrder S_; S_.init(F.nb, F.bid);
         const pg8::EpiHgIn E_{(bf16*)(F.ws + WS_ZIN), (const float*)(F.ws + WS_LB)}; pg8::gemm_phase<pg8::EpiHgIn, pg8::HgInOrder, PG8_ALIGN, PG8_SP2>(ring, g_, S_, E_, F.tid); }
       GEMM_PHASE(pg8::EpiVtT<true>, F.ws + WO_HGIN + (size_t)4 * D * D * 2, D, F.H, D, D, D / 256, R / 256, 1, D / 256, (bf16*)(F.ws + WS_VTG)));
    PH(ph_hgrn_scan(F));
    PH(ph_hgrn_post(F));
    PH(GEMM_PHASE_LAT(pg8::EpiResidT, F.ws + WS_O2, D, F.ws + WO_HGO, D, D, D / 256, F.X, MODL(3)));
    MOE_PHASES(3, NB, NB * NE, true)
    PH(ph_norm<2, true, false, true>(F, 0, 3));
}
constexpr int NPH = __COUNTER__ - PH_BASE - 1;

extern "C" void kernel_launch(void* const* d_in, const int* in_sizes, int n_in, void* d_out, int out_size, void* d_ws, size_t ws_size, hipStream_t stream) {
    static int grid = 0;
    if (grid == 0) {
        if (n_in != 33 || ws_size < WS_NEED) { fprintf(stderr, "kernel_launch: n_in %d ws %zu (need %zu)\n", n_in, ws_size, (size_t)WS_NEED); grid = -1; return; }
        int dev = 0, cus = 0;
        if (hipGetDevice(&dev) != hipSuccess || hipDeviceGetAttribute(&cus, hipDeviceAttributeMultiprocessorCount, dev) != hipSuccess) { grid = -1; return; }
        if (hipFuncSetAttribute((const void*)fwd, hipFuncAttributeMaxDynamicSharedMemorySize, LDS_BYTES) != hipSuccess) { fprintf(stderr, "kernel_launch: hipFuncSetAttribute failed\n"); grid = -1; return; }
        int per_cu = 0;
        if (hipOccupancyMaxActiveBlocksPerMultiprocessor(&per_cu, (const void*)fwd, NTHREADS, LDS_BYTES) != hipSuccess || per_cu < 1) fprintf(stderr, "kernel_launch: occupancy query says %d\n", per_cu);
        (void)hipGetLastError();
        grid = cus;
    }
    if (grid < 0) return;
    (void)hipMemsetAsync((char*)d_ws + WS_CTL + (size_t)CW_BAR * 4, 0, (size_t)XCD_BAR_WORDS * 4, stream);
    Args a{};
    for (int i = 0; i < 33; ++i) a.in[i] = (const float*)d_in[i];
    a.out = (float*)d_out; a.ws = (unsigned char*)d_ws;
#if MK_SINGLE
    a.ph_lo = 0; a.ph_hi = NPH;
    hipLaunchKernelGGL(fwd, dim3(grid), dim3(NTHREADS), LDS_BYTES, stream, a);
#else
    for (int k = 0; k < NPH; ++k) { a.ph_lo = k; a.ph_hi = k + 1; hipLaunchKernelGGL(fwd, dim3(grid), dim3(NTHREADS), LDS_BYTES, stream, a); }
#endif
}
```

```cpp
#include <hip/hip_runtime.h>
#include <cstdio>
#include <cstdint>

#ifndef MK_SINGLE
#define MK_SINGLE 1
#endif

typedef unsigned short bf16;
typedef float f32x4 __attribute__((ext_vector_type(4)));
typedef float f32x2 __attribute__((ext_vector_type(2)));
typedef unsigned u32x2 __attribute__((ext_vector_type(2)));
typedef unsigned u32x4 __attribute__((ext_vector_type(4)));
#define LAS __attribute__((address_space(3)))

constexpr int NB = 32, SEQ = 2048, NCTX = 256, D = 1024, P = NCTX + SEQ  , R = NB * P  ;
constexpr int NE = 16, FF = 2048, SLOTS = NB * 256 + NB * 32  ;
constexpr float EPS = 1e-6f;
constexpr float LOG2E_ = 1.4426950408889634f;
constexpr float LAM_INIT = 0.47071302f;
constexpr int NWAVES = 8, NTHREADS = 512;
constexpr int LDS_BYTES = 147456;
constexpr int LDS_MISC = 147456 - 256;

constexpr size_t MiB = 1u << 20;
constexpr size_t WS_CTL = 0, CTL_ZERO_BYTES = 1 * MiB;
constexpr size_t WS_MOD = 1 * MiB;
constexpr size_t WS_AFF = 5 * MiB;
constexpr size_t WS_SEL = 10 * MiB;
constexpr size_t WS_GATE = 11 * MiB;
constexpr size_t WS_INV = 12 * MiB;
constexpr size_t WS_X = 32 * MiB;
constexpr size_t WS_H = 320 * MiB;
constexpr size_t WS_W = 464 * MiB;
constexpr size_t WS_BIG = 720 * MiB;
constexpr size_t WS_HID = WS_BIG;
constexpr size_t WS_Y = WS_BIG + 576 * MiB;
constexpr size_t WS_XS = WS_BIG + 864 * MiB;
constexpr size_t WS_AG = WS_BIG;
constexpr size_t WS_SS = WS_BIG + 216 * MiB;
constexpr size_t WS_Z = WS_BIG + 360 * MiB;
constexpr size_t WS_S5W1 = WS_BIG + 504 * MiB;
constexpr size_t WS_S5W2 = WS_BIG + 520 * MiB;
constexpr size_t WS_S5A = WS_BIG + 568 * MiB;
constexpr size_t WS_Q = WS_BIG, WS_K = WS_BIG + 144 * MiB, WS_V = WS_BIG + 288 * MiB, WS_VT = WS_BIG + 432 * MiB, WS_O = WS_BIG + 576 * MiB;
constexpr size_t WS_ZIN = WS_BIG;
constexpr size_t WS_VTG = WS_BIG + 576 * MiB;
constexpr size_t WS_OFF = WS_BIG + 720 * MiB;
constexpr size_t WS_OFB = WS_BIG + 1008 * MiB;
constexpr size_t WS_O2 = WS_H;
constexpr size_t WS_LB = 17 * MiB;
constexpr size_t WS_ROPE = 18 * MiB;
constexpr size_t WS_NEED = 2048 * MiB;
constexpr size_t WO_GLU = WS_W, WO_NAQKV = WS_W + 4 * MiB, WO_NAO = WS_W + 10 * MiB, WO_DAQKV = WS_W + 12 * MiB, WO_DAO = WS_W + 18 * MiB, WO_HGIN = WS_W + 20 * MiB, WO_HGO = WS_W + 30 * MiB;
constexpr size_t WO_GU = WS_W + 32 * MiB  , WO_DN = WS_W + 160 * MiB  ;
constexpr int CW_BAR = 4096;

__device__ __forceinline__ unsigned f2bf(float f) { unsigned u = __builtin_bit_cast(unsigned, f); return (u + 0x7fffu + ((u >> 16) & 1u)) >> 16; }
__device__ __forceinline__ float bf2f(unsigned h) { return __builtin_bit_cast(float, h << 16); }
__device__ __forceinline__ unsigned pk2(float lo, float hi) { return f2bf(lo) | (f2bf(hi) << 16); }
typedef __bf16 bf16x2_t __attribute__((ext_vector_type(2)));
__device__ __forceinline__ unsigned pkbf(float lo, float hi) { const f32x2 v = {lo, hi}; return __builtin_bit_cast(unsigned, __builtin_convertvector(v, bf16x2_t)); }
__device__ __forceinline__ float bflo(unsigned w) { return __builtin_bit_cast(float, w << 16); }
__device__ __forceinline__ float bfhi(unsigned w) { return __builtin_bit_cast(float, w & 0xffff0000u); }
__device__ __forceinline__ float wave_sum(float v) {
#pragma unroll
    for (int o = 1; o < 64; o <<= 1) v += __shfl_xor(v, o);
    return v;
}
__device__ __forceinline__ float wave_max(float v) {
#pragma unroll
    for (int o = 1; o < 64; o <<= 1) v = fmaxf(v, __shfl_xor(v, o));
    return v;
}
__device__ __forceinline__ float sigmoidf_(float x) { return 1.0f / (1.0f + expf(-x)); }
__device__ __forceinline__ float siluf_(float x) { return x / (1.0f + expf(-x)); }
__device__ __forceinline__ float gelu_tanh(float x) { return 0.5f * x * (1.0f + tanhf(0.7978845608028654f * (x + 0.044715f * x * x * x))); }
__device__ __forceinline__ float dpp_xor1(float v) { return __builtin_bit_cast(float, __builtin_amdgcn_update_dpp(0, __builtin_bit_cast(int, v), 0xB1, 0xF, 0xF, true)); }
__device__ __forceinline__ float dpp_xor2(float v) { return __builtin_bit_cast(float, __builtin_amdgcn_update_dpp(0, __builtin_bit_cast(int, v), 0x4E, 0xF, 0xF, true)); }
__device__ __forceinline__ float reduce16(float (&v)[16], int lane) {
    const bool b0 = lane & 1, b1 = lane & 2, b2 = lane & 4, b3 = lane & 8;
    float a[8];
#pragma unroll
    for (int k = 0; k < 8; ++k) { const float snd = b0 ? v[k] : v[8 + k], kep = b0 ? v[8 + k] : v[k]; a[k] = kep + dpp_xor1(snd); }
    float c[4];
#pragma unroll
    for (int k = 0; k < 4; ++k) { const float snd = b1 ? a[k] : a[4 + k], kep = b1 ? a[4 + k] : a[k]; c[k] = kep + dpp_xor2(snd); }
    float d[2];
#pragma unroll
    for (int k = 0; k < 2; ++k) { const float snd = b2 ? c[k] : c[2 + k], kep = b2 ? c[2 + k] : c[k]; d[k] = kep + __shfl_xor(snd, 4); }
    float r = (b3 ? d[1] : d[0]) + __shfl_xor(b3 ? d[0] : d[1], 8);
    r += __shfl_xor(r, 16); r += __shfl_xor(r, 32);
    return r;
}
#define WAVE_LDS_SYNC() asm volatile("s_waitcnt lgkmcnt(0)" ::: "memory")

#define XB_TMO      128
#define XB_XCNT(j)  (256  + 64 * (j))
#define XB_XSUB(j)  (1280 + 64 * (j))
#define XB_XGEN(j)  (2304 + 64 * (j))
#define XB_TOP      3328
#define XB_TOPGEN   3392
#define XCD_BAR_WORDS 3456
#define XB_SPIN_CAP (1u << 27)
__device__ __forceinline__ unsigned xb_ld(unsigned* p)              { return __hip_atomic_load(p, __ATOMIC_RELAXED, __HIP_MEMORY_SCOPE_AGENT); }
__device__ __forceinline__ unsigned xb_add(unsigned* p, unsigned v) { return __hip_atomic_fetch_add(p, v, __ATOMIC_RELAXED, __HIP_MEMORY_SCOPE_AGENT); }
__device__ __forceinline__ unsigned xb_xcc_id() { return (unsigned)__builtin_amdgcn_s_getreg((3 << 11) | 20) & 0xFu; }
#define XB_SPIN(cond, bar) do { unsigned _sp = 0; while (cond) { __builtin_amdgcn_s_sleep(1); \
    if ((++_sp & 255u) == 0u) { if (xb_ld(&(bar)[XB_TMO])) break; if (_sp > XB_SPIN_CAP) { atomicAdd(&(bar)[XB_TMO], 1u); break; } } } } while (0)
struct XcdBarrier { unsigned* bar; unsigned x; volatile LAS unsigned* st; };
__device__ __forceinline__ XcdBarrier xcd_barrier_post(unsigned* bar, volatile LAS unsigned* st, int tid_) {
    XcdBarrier b; b.bar = bar; b.x = xb_xcc_id(); b.st = st;
    if (tid_ == 0) (void)xb_add(&bar[XB_XCNT(b.x)], 1u);
    return b;
}
__device__ __forceinline__ void xcd_barrier_complete(unsigned* bar, unsigned x, unsigned& nloc, unsigned& nx) {
    const unsigned G = gridDim.x * gridDim.y * gridDim.z;
    unsigned sum, cnt, mine, sp = 0u;
    for (;;) {
        sum = 0u; cnt = 0u; mine = 0u;
#pragma unroll
        for (unsigned j = 0; j < 16; ++j) { const unsigned c = xb_ld(&bar[XB_XCNT(j)]); sum += c; cnt += (c > 0u) ? 1u : 0u; mine = (j == x) ? c : mine; }
        if (sum == G) break;
        __builtin_amdgcn_s_sleep(1);
        if ((++sp & 255u) == 0u) { if (xb_ld(&bar[XB_TMO])) break; if (sp > XB_SPIN_CAP) { atomicAdd(&bar[XB_TMO], 1u); break; } }
    }
    nloc = mine > 0u ? mine : 1u; nx = cnt > 0u ? cnt : 1u;
}
__device__ __forceinline__ void xcd_barrier(const XcdBarrier& b, int tid_) {
    asm volatile("s_waitcnt vmcnt(0)" ::: "memory");
    __syncthreads();
    if (tid_ == 0) {
        unsigned* bar = b.bar;
        __builtin_amdgcn_s_waitcnt(0);
        unsigned nloc = b.st[0], nx = b.st[1];
        if (nloc == 0u) { xcd_barrier_complete(bar, b.x, nloc, nx); b.st[0] = nloc; b.st[1] = nx; }
        const unsigned old = xb_add(&bar[XB_XSUB(b.x)], 1u);
        const unsigned gen = old / nloc;
        if (old + 1u == (gen + 1u) * nloc) {
            __builtin_amdgcn_fence(__ATOMIC_RELEASE, "agent");
            asm volatile("s_waitcnt vmcnt(0)" ::: "memory");
            const unsigned og = xb_add(&bar[XB_TOP], 1u);
            const unsigned tg = og / nx;
            if (og + 1u == (tg + 1u) * nx) xb_add(&bar[XB_TOPGEN], 1u);
            else XB_SPIN(xb_ld(&bar[XB_TOPGEN]) == tg, bar);
            __builtin_amdgcn_fence(__ATOMIC_ACQUIRE, "agent");
            xb_add(&bar[XB_XGEN(b.x)], 1u);
            asm volatile("s_waitcnt vmcnt(0)" ::: "memory");
        } else {
            XB_SPIN(xb_ld(&bar[XB_XGEN(b.x)]) == gen, bar);
            __builtin_amdgcn_fence(__ATOMIC_ACQUIRE, "agent");
            asm volatile("s_waitcnt vmcnt(0)" ::: "memory");
        }
    }
    __syncthreads();
}

namespace pg8 {
#define PG8_LAS __attribute__((address_space(3)))
typedef unsigned short bf16_t;
typedef short bf16x8 __attribute__((ext_vector_type(8)));
typedef float f32x4 __attribute__((ext_vector_type(4)));
typedef unsigned u32x4 __attribute__((ext_vector_type(4)));
constexpr int BM = 256, BK = 64, HALF = 128, HTB = HALF * BK * 2  , STAGE_BYTES = 8 * HTB, NXCD = 8, WGM = 8;

__host__ __device__ __forceinline__ int lds_byte(int r, int c) { const int st = (r >> 4) * 2 + (c >> 5), rr = r & 15, cc = c & 31, ob = rr * 64 + cc * 2; return st * 1024 + (ob ^ (((ob >> 9) & 1) << 5)); }
__host__ __device__ __forceinline__ void stage_rc(int b, int& R, int& C) { const int st = b / 1024, sb = b % 1024, swz = sb ^ (((sb >> 9) & 1) << 5); R = (st >> 1) * 16 + swz / 64; C = (st & 1) * 32 + (swz % 64) / 2; }
__host__ __device__ __forceinline__ int perm32(int rho) { const int n = rho >> 4, i = rho & 15; return 8 * (i >> 2) + 4 * n + (i & 3); }

struct Unit { int pm, pn; };
struct Gemm { const bf16_t* A; const bf16_t* Bt; int lda, ldb, K; const int* rowidx; };

struct StaticOrder {
    int nM, nN, nwg, G, c;
    __host__ __device__ void init(int M, int N, int G_, int c_) { nM = M / BM; nN = N / BM; nwg = nM * nN; G = G_; c = c_; }
    __host__ __device__ bool next(int i, Unit& u) const {
        const long L = (long)i * G + c; if (L >= nwg) return false;
        int wgid = (int)L; { const int q = nwg / NXCD, r = nwg % NXCD, xcd = wgid % NXCD, off = wgid / NXCD; wgid = (xcd < r ? xcd * (q + 1) : r * (q + 1) + (xcd - r) * q) + off; }
        const int nig = WGM * nN, gid = wgid / nig, fm = gid * WGM, gsz = (nM - fm) < WGM ? (nM - fm) : WGM;
        u.pm = fm + ((wgid % nig) % gsz); u.pn = (wgid % nig) / gsz; return true;
    }
    __device__ __forceinline__ void a_ready(const Unit&) const {}
    __device__ __forceinline__ void done(const Unit&) const {}
};

__device__ __forceinline__ unsigned cvt_pk_bf16(float lo, float hi) { unsigned r; asm volatile("v_cvt_pk_bf16_f32 %0, %1, %2" : "=v"(r) : "v"(lo), "v"(hi)); return r; }
typedef float f32x2 __attribute__((ext_vector_type(2)));
__device__ __forceinline__ f32x2 gelu_pk(f32x2 v) {
    const f32x2 av = __builtin_elementwise_abs(v), d = av * 0.2316418882f + 1.0f;
    f32x2 t; t.x = __builtin_amdgcn_rcpf(d.x); t.y = __builtin_amdgcn_rcpf(d.y);
    f32x2 q = t * 0.5307027145f + (-0.7265760135f); q = q * t + 0.7107068705f; q = q * t + (-0.142248368f); q = q * t + 0.127414796f; q = q * t;
    const f32x2 s = (v * v) * (-0.72134752044f);
    f32x2 e; e.x = __builtin_amdgcn_exp2f(s.x); e.y = __builtin_amdgcn_exp2f(s.y);
    const f32x2 m = v * (q * e), r = v - m;
    f32x2 o; o.x = v.x < 0.f ? m.x : r.x; o.y = v.y < 0.f ? m.y : r.y; return o;
}

template <int ACT  > struct EpiBf16 {
    static constexpr bool PERM = true, AFTER_DRAIN = false; static_assert(ACT == 0 || ACT == 1, "EpiBf16: ACT is 0 (none) or 1 (gelu_pk)");
    bf16_t* O; int ldc; const float* bias; int split_cols; size_t split_stride; float scale0;
    __device__ __forceinline__ void operator()(const f32x4 (&acc)[2][2][4][2], const Unit& u, int wr, int wc, int fr, int fq) const {
        const int row0 = u.pm * BM + wr * 64 + fr; int colt = u.pn * BM; bf16_t* base = O;
        float sc = 1.f; if (split_cols) { const int t = colt / split_cols; base += (size_t)t * split_stride; colt -= t * split_cols; if (t == 0) sc = scale0; }
        const int col0 = colt + wc * 32 + 8 * fq, bcol0 = u.pn * BM + wc * 32 + 8 * fq;
        f32x4 bv[2][2];
#pragma unroll
        for (int bj = 0; bj < 2; ++bj)
#pragma unroll
            for (int n = 0; n < 2; ++n) bv[bj][n] = bias ? *(const f32x4*)(bias + bcol0 + bj * HALF + 4 * n) : (f32x4){0.f, 0.f, 0.f, 0.f};
#pragma unroll
        for (int ai = 0; ai < 2; ++ai)
#pragma unroll
            for (int m = 0; m < 4; ++m) { bf16_t* rowp = base + (size_t)(row0 + ai * HALF + m * 16) * ldc + col0;
#pragma unroll
                for (int bj = 0; bj < 2; ++bj) { f32x4 v0 = acc[ai][bj][m][0] + bv[bj][0], v1 = acc[ai][bj][m][1] + bv[bj][1];
                    if (ACT == 1) { f32x2 a = gelu_pk((f32x2){v0[0], v0[1]}), b = gelu_pk((f32x2){v0[2], v0[3]}), c = gelu_pk((f32x2){v1[0], v1[1]}), d = gelu_pk((f32x2){v1[2], v1[3]});
                        v0 = (f32x4){a.x, a.y, b.x, b.y}; v1 = (f32x4){c.x, c.y, d.x, d.y}; }
                    v0 = v0 * sc; v1 = v1 * sc; u32x4 w; w.x = cvt_pk_bf16(v0[0], v0[1]); w.y = cvt_pk_bf16(v0[2], v0[3]); w.z = cvt_pk_bf16(v1[0], v1[1]); w.w = cvt_pk_bf16(v1[2], v1[3]);
                    *(u32x4*)(rowp + bj * HALF) = w; } }
    }
};


struct GroupedOrder {
    int nM, nN, groups, gsM, G, c, total;
    __host__ __device__ void init(int nM_, int nN_, int groups_, int gsM_, int G_, int c_) { nM = nM_; nN = nN_; groups = groups_; gsM = gsM_; G = G_; c = c_; total = nM * nN * groups; }
    __host__ __device__ bool next(int i, Unit& u) const {
        const long L = (long)i * G + c; if (L >= total) return false;
        int T = (int)L; { const int q = total / NXCD, r = total % NXCD, xcd = T % NXCD, off = T / NXCD; T = (xcd < r ? xcd * (q + 1) : r * (q + 1) + (xcd - r) * q) + off; }
        const int tpg = nM * nN, g = T / tpg, t = T - g * tpg;
        const int nig = WGM * nN, gid = t / nig, fm = gid * WGM, gsz = (nM - fm) < WGM ? (nM - fm) : WGM;
        u.pm = g * gsM + fm + ((t % nig) % gsz); u.pn = g * nN + (t % nig) / gsz; return true;
    }
    __device__ __forceinline__ void a_ready(const Unit&) const {}
    __device__ __forceinline__ void done(const Unit&) const {}
};
struct LatentOrder {
    GroupedOrder o;
    __host__ __device__ void init(int nN_, int G_, int c_) { o.init(256, nN_, 1, 256, G_, c_); }
    __host__ __device__ bool next(int i, Unit& u) const { if (!o.next(i, u)) return false; u.pm += (u.pm >> 3) + 1; return true; }
    __device__ __forceinline__ void a_ready(const Unit&) const {}
    __device__ __forceinline__ void done(const Unit&) const {}
};
struct HgInOrder {
    LatentOrder lat; int G, c;
    __host__ __device__ void init(int G_, int c_) { lat.init(16, G_, c_); G = G_; c = c_; }
    __host__ __device__ bool next(int i, Unit& u) const {
        const long L = (long)i * G + c;
        if (L < 4096) return lat.next(i, u);
        const int t = (int)L - 4096; if (t >= 256) return false;
        u.pm = (t >> 3) * 9; u.pn = 4 + (t & 7); return true;
    }
    __device__ __forceinline__ void a_ready(const Unit&) const {}
    __device__ __forceinline__ void done(const Unit&) const {}
};
__device__ __forceinline__ float sigm(float x) { return __builtin_amdgcn_rcpf(1.0f + __builtin_amdgcn_exp2f(x * -1.4426950408889634f)); }
constexpr int PP = 2304, DD = 1024;
__device__ __forceinline__ int mrow_of(int row) { const int b = row / PP, pos = row - b * PP; return pos < 256 ? 32 : b; }
struct EpiResidT {
    static constexpr bool PERM = false, AFTER_DRAIN = false;
    bf16_t* X; const float* MODL;
    __device__ __forceinline__ void operator()(const f32x4 (&acc)[2][2][4][2], const Unit& u, int wr, int wc, int fr, int fq) const {
        const int row0 = u.pm * BM + wr * 64 + fr, col0 = u.pn * BM + wc * 32 + 4 * fq;
        const float* g = MODL + (size_t)mrow_of(u.pm * BM) * 6144 + 2 * DD + col0;
        f32x4 gt[2][2];
#pragma unroll
        for (int bj = 0; bj < 2; ++bj)
#pragma unroll
            for (int n = 0; n < 2; ++n) gt[bj][n] = *(const f32x4*)(g + bj * HALF + n * 16);
#pragma unroll
        for (int ai = 0; ai < 2; ++ai)
#pragma unroll
            for (int m = 0; m < 4; ++m) { const int row = row0 + ai * HALF + m * 16; bf16_t* x = X + (size_t)row * DD + col0;
                u32x2 xo[2][2];
#pragma unroll
                for (int bj = 0; bj < 2; ++bj)
#pragma unroll
                    for (int n = 0; n < 2; ++n) xo[bj][n] = *(const u32x2*)(x + bj * HALF + n * 16);
#pragma unroll
                for (int bj = 0; bj < 2; ++bj)
#pragma unroll
                    for (int n = 0; n < 2; ++n) { const int o = bj * HALF + n * 16; const f32x4 xv = {bflo(xo[bj][n].x), bfhi(xo[bj][n].x), bflo(xo[bj][n].y), bfhi(xo[bj][n].y)};
                        const f32x4 r = xv + gt[bj][n] * acc[ai][bj][m][n]; u32x2 w; w.x = pkbf(r.x, r.y); w.y = pkbf(r.z, r.w); *(u32x2*)(x + o) = w; } }
    }
};
struct EpiGluT {
    static constexpr bool PERM = true, AFTER_DRAIN = false;
    bf16_t* X; const float* MODL;
    __device__ __forceinline__ void operator()(const f32x4 (&acc)[2][2][4][2], const Unit& u, int wr, int wc, int fr, int fq) const {
        const int row0 = u.pm * BM + wr * 64 + fr, f0 = u.pn * 128 + wc * 32 + 8 * fq;
        const float* g = MODL + (size_t)mrow_of(u.pm * BM) * 6144 + 2 * DD + f0;
        const f32x4 gt[2] = {*(const f32x4*)g, *(const f32x4*)(g + 4)};
#pragma unroll
        for (int ai = 0; ai < 2; ++ai)
#pragma unroll
            for (int m = 0; m < 4; ++m) { const int row = row0 + ai * HALF + m * 16; bf16_t* x = X + (size_t)row * DD + f0;
                const u32x4 xo = *(const u32x4*)x; u32x4 w;
#pragma unroll
                for (int n = 0; n < 2; ++n) { const f32x4 a = acc[ai][0][m][n], b = acc[ai][1][m][n]; f32x4 v = b * -1.4426950408889634f;
#pragma unroll
                    for (int q = 0; q < 4; ++q) v[q] = __builtin_amdgcn_exp2f(v[q]);
                    v = v + 1.0f;
#pragma unroll
                    for (int q = 0; q < 4; ++q) v[q] = __builtin_amdgcn_rcpf(v[q]);
                    v = v * a;
                    const unsigned x01 = n ? xo.z : xo.x, x23 = n ? xo.w : xo.y; const f32x4 xv = {bflo(x01), bfhi(x01), bflo(x23), bfhi(x23)};
                    const f32x4 r = xv + gt[n] * v; if (n) { w.z = pkbf(r.x, r.y); w.w = pkbf(r.z, r.w); } else { w.x = pkbf(r.x, r.y); w.y = pkbf(r.z, r.w); } }
                *(u32x4*)x = w; }
    }
};
struct EpiSwigluT {
    static constexpr bool PERM = true, AFTER_DRAIN = false;
    bf16_t* HID; int nNg; int ldh;
    __device__ __forceinline__ void operator()(const f32x4 (&acc)[2][2][4][2], const Unit& u, int wr, int wc, int fr, int fq) const {
        const int row0 = u.pm * BM + wr * 64 + fr, f0 = (u.pn % nNg) * 128 + wc * 32 + 8 * fq;
#pragma unroll
        for (int ai = 0; ai < 2; ++ai)
#pragma unroll
            for (int m = 0; m < 4; ++m) { bf16_t* hp = HID + (size_t)(row0 + ai * HALF + m * 16) * ldh + f0;
                const f32x4 a0 = acc[ai][0][m][0], a1 = acc[ai][0][m][1], b0 = acc[ai][1][m][0], b1 = acc[ai][1][m][1];
                f32x4 e0 = a0 * -1.4426950408889634f, e1 = a1 * -1.4426950408889634f;
#pragma unroll
                for (int q = 0; q < 4; ++q) { e0[q] = __builtin_amdgcn_exp2f(e0[q]); e1[q] = __builtin_amdgcn_exp2f(e1[q]); }
                e0 = e0 + 1.0f; e1 = e1 + 1.0f;
#pragma unroll
                for (int q = 0; q < 4; ++q) { e0[q] = __builtin_amdgcn_rcpf(e0[q]); e1[q] = __builtin_amdgcn_rcpf(e1[q]); }
                const f32x4 o0 = (a0 * b0) * e0, o1 = (a1 * b1) * e1;
                u32x4 w; w.x = cvt_pk_bf16(o0.x, o0.y); w.y = cvt_pk_bf16(o0.z, o0.w); w.z = cvt_pk_bf16(o1.x, o1.y); w.w = cvt_pk_bf16(o1.z, o1.w);
                *(u32x4*)hp = w; }
    }
};
struct EpiDownT {
    static constexpr bool PERM = true, AFTER_DRAIN = false;
    bf16_t* Y; const float* GATE; int nNg;
    __device__ __forceinline__ void operator()(const f32x4 (&acc)[2][2][4][2], const Unit& u, int wr, int wc, int fr, int fq) const {
        const int row0 = u.pm * BM + wr * 64 + fr, col0 = (u.pn % nNg) * BM + wc * 32 + 8 * fq;
#pragma unroll
        for (int ai = 0; ai < 2; ++ai)
#pragma unroll
            for (int m = 0; m < 4; ++m) { const int row = row0 + ai * HALF + m * 16; bf16_t* rowp = Y + (size_t)row * DD + col0;
#pragma unroll
                for (int bj = 0; bj < 2; ++bj) { const f32x4 v0 = acc[ai][bj][m][0], v1 = acc[ai][bj][m][1];
                    u32x4 w; w.x = cvt_pk_bf16(v0[0], v0[1]); w.y = cvt_pk_bf16(v0[2], v0[3]); w.z = cvt_pk_bf16(v1[0], v1[1]); w.w = cvt_pk_bf16(v1[2], v1[3]);
                    *(u32x4*)(rowp + bj * HALF) = w; } }
    }
};
template <bool SILU> struct EpiVtT {
    static constexpr bool PERM = true, AFTER_DRAIN = false;
    bf16_t* VT;
    __device__ __forceinline__ void operator()(const f32x4 (&acc)[2][2][4][2], const Unit& u, int wr, int wc, int fr, int fq) const {
        const int hd0 = u.pm * BM + wr * 64 + fr, tok0 = u.pn * BM + wc * 32 + 8 * fq, b = (u.pn * BM) / PP, pos0 = tok0 - b * PP;
#pragma unroll
        for (int ai = 0; ai < 2; ++ai)
#pragma unroll
            for (int m = 0; m < 4; ++m) { bf16_t* rowp = VT + ((size_t)b * DD + hd0 + ai * HALF + m * 16) * PP + pos0;
#pragma unroll
                for (int bj = 0; bj < 2; ++bj) { f32x4 v0 = acc[ai][bj][m][0], v1 = acc[ai][bj][m][1];
                    if (SILU) {
#pragma unroll
                        for (int q = 0; q < 4; ++q) { v0[q] = v0[q] * sigm(v0[q]); v1[q] = v1[q] * sigm(v1[q]); } }
                    u32x4 w; w.x = cvt_pk_bf16(v0[0], v0[1]); w.y = cvt_pk_bf16(v0[2], v0[3]); w.z = cvt_pk_bf16(v1[0], v1[1]); w.w = cvt_pk_bf16(v1[2], v1[3]);
                    *(u32x4*)(rowp + bj * HALF) = w; } }
    }
};
struct EpiHgIn {
    static constexpr bool PERM = true, AFTER_DRAIN = false;
    bf16_t* O; const float* LB;
    __device__ __forceinline__ void operator()(const f32x4 (&acc)[2][2][4][2], const Unit& u, int wr, int wc, int fr, int fq) const {
        const int row0 = u.pm * BM + wr * 64 + fr, col0 = u.pn * BM + wc * 32 + 8 * fq, type = u.pn >> 2;
        f32x4 lb[2][2];
#pragma unroll
        for (int bj = 0; bj < 2; ++bj) { const int c = (col0 + bj * HALF) & 1023; lb[bj][0] = *(const f32x4*)(LB + c); lb[bj][1] = *(const f32x4*)(LB + c + 4); }
#pragma unroll
        for (int ai = 0; ai < 2; ++ai)
#pragma unroll
            for (int m = 0; m < 4; ++m) { bf16_t* rowp = O + (size_t)(row0 + ai * HALF + m * 16) * 4096 + col0;
#pragma unroll
                for (int bj = 0; bj < 2; ++bj) { f32x4 v0 = acc[ai][bj][m][0], v1 = acc[ai][bj][m][1];
                    if (type == 1 || type == 2) { const f32x4 l0 = lb[bj][0], l1 = lb[bj][1];
#pragma unroll
                        for (int q = 0; q < 4; ++q) { v0[q] = __log2f(l0[q] + (1.0f - l0[q]) * sigm(v0[q])); v1[q] = __log2f(l1[q] + (1.0f - l1[q]) * sigm(v1[q])); } }
                    else if (type == 3) {
#pragma unroll
                        for (int q = 0; q < 4; ++q) { v0[q] = v0[q] * sigm(v0[q]); v1[q] = v1[q] * sigm(v1[q]); } }
                    u32x4 w; w.x = cvt_pk_bf16(v0[0], v0[1]); w.y = cvt_pk_bf16(v0[2], v0[3]); w.z = cvt_pk_bf16(v1[0], v1[1]); w.w = cvt_pk_bf16(v1[2], v1[3]);
                    *(u32x4*)(rowp + bj * HALF) = w; } }
    }
};


struct EpiF32G {
    static constexpr bool PERM = false, AFTER_DRAIN = false;
    float* C; int ldc; int nNg;
    __device__ __forceinline__ void operator()(const f32x4 (&acc)[2][2][4][2], const Unit& u, int wr, int wc, int fr, int fq) const {
        const int row0 = u.pm * BM + wr * 64 + fr, col0 = (u.pn % nNg) * BM + wc * 32 + 4 * fq;
#pragma unroll
        for (int ai = 0; ai < 2; ++ai)
#pragma unroll
            for (int m = 0; m < 4; ++m) { float* rowp = C + (size_t)(row0 + ai * HALF + m * 16) * ldc + col0;
#pragma unroll
                for (int bj = 0; bj < 2; ++bj)
#pragma unroll
                    for (int n = 0; n < 2; ++n) *(f32x4*)(rowp + bj * HALF + n * 16) = acc[ai][bj][m][n]; }
    }
};
__device__ __forceinline__ float gelu_t(float x) { const float t = 1.5957691216057308f * (x + 0.044715f * x * x * x); return x * sigm(t); }
struct EpiS5Out {
    static constexpr bool PERM = true, AFTER_DRAIN = false;
    const bf16_t* H; bf16_t* Z; const float* dvec;
    __device__ __forceinline__ void operator()(const f32x4 (&acc)[2][2][4][2], const Unit& u, int wr, int wc, int fr, int fq) const {
        const int c0 = (u.pn & 1) * BM + wc * 32 + 8 * fq;
        const int g = (u.pm * BM) / 2304;
        f32x4 dv[2][2];
#pragma unroll
        for (int bj = 0; bj < 2; ++bj) { const int k0 = (c0 + bj * HALF) & 15; dv[bj][0] = *(const f32x4*)(dvec + g * 16 + k0); dv[bj][1] = *(const f32x4*)(dvec + g * 16 + k0 + 4); }
#pragma unroll
        for (int ai = 0; ai < 2; ++ai)
#pragma unroll
            for (int m = 0; m < 4; ++m) {
                const int rg = u.pm * BM + ai * HALF + wr * 64 + m * 16 + fr, rem = rg - g * 2304, b = rem / 72, j = rem - b * 72;
#pragma unroll
                for (int bj = 0; bj < 2; ++bj) {
                    const int mc = c0 + bj * HALF, tau = mc >> 4, k0 = mc & 15;
                    const size_t off = ((size_t)b * PP + 32 * j + tau) * DD + g * 16 + k0;
                    const u32x4 uw = *(const u32x4*)(H + off);
                    const f32x4 d0 = dv[bj][0], d1 = dv[bj][1];
                    const f32x4 y0 = acc[ai][bj][m][0], y1 = acc[ai][bj][m][1];
                    u32x4 w;
                    w.x = cvt_pk_bf16(gelu_t(y0[0] + d0[0] * __uint_as_float(uw.x << 16)), gelu_t(y0[1] + d0[1] * __uint_as_float(uw.x & 0xffff0000u)));
                    w.y = cvt_pk_bf16(gelu_t(y0[2] + d0[2] * __uint_as_float(uw.y << 16)), gelu_t(y0[3] + d0[3] * __uint_as_float(uw.y & 0xffff0000u)));
                    w.z = cvt_pk_bf16(gelu_t(y1[0] + d1[0] * __uint_as_float(uw.z << 16)), gelu_t(y1[1] + d1[1] * __uint_as_float(uw.z & 0xffff0000u)));
                    w.w = cvt_pk_bf16(gelu_t(y1[2] + d1[2] * __uint_as_float(uw.w << 16)), gelu_t(y1[3] + d1[3] * __uint_as_float(uw.w & 0xffff0000u)));
                    *(u32x4*)(Z + off) = w;
                }
            }
    }
};


struct EpiQKRope {
    static constexpr bool PERM = true, AFTER_DRAIN = false;
    bf16_t* Q; size_t kstride; const PG8_LAS float* T;
    __device__ __forceinline__ void operator()(const f32x4 (&acc)[2][2][4][2], const Unit& u, int wr, int wc, int fr, int fq) const {
        const int row0 = u.pm * BM + wr * 64 + fr; int colt = u.pn * BM; bf16_t* base = Q;
        { const int t = colt / DD; base += (size_t)t * kstride; colt -= t * DD; }
        const int col0 = colt + wc * 32 + 8 * fq, half = wc & 1; const bool first = fq < 2;
        const int tb = (u.pm * BM) / PP;
        const float qs = u.pn * BM < DD ? 0.125f * 1.4426950408889634f : 1.0f;
#pragma unroll
        for (int ai = 0; ai < 2; ++ai)
#pragma unroll
            for (int m = 0; m < 4; ++m) { const int row = row0 + ai * HALF + m * 16, pos = row - tb * PP, tt = pos - 256; const bool lat = pos >= 256;
                const int p = lat ? (half ? (tt & 63) : (tt >> 6)) : 0;
                const PG8_LAS f32x4* cs = (const PG8_LAS f32x4*)(T + (p * 16 + 8 * (fq & 1)) * 2);
                const f32x4 t0 = cs[0], t1 = cs[1], t2 = cs[2], t3 = cs[3];
                bf16_t* rowp = base + (size_t)row * DD + col0;
#pragma unroll
                for (int bj = 0; bj < 2; ++bj) { f32x4 v0 = acc[ai][bj][m][0] * qs, v1 = acc[ai][bj][m][1] * qs;
                    f32x4 p0, p1;
#pragma unroll
                    for (int q = 0; q < 4; ++q) { p0[q] = __shfl_xor(v0[q], 32); p1[q] = __shfl_xor(v1[q], 32); }
                    if (lat) { const float sg = first ? -1.0f : 1.0f;
                        v0 = (f32x4){v0[0] * t0[0] + sg * p0[0] * t0[1], v0[1] * t0[2] + sg * p0[1] * t0[3], v0[2] * t1[0] + sg * p0[2] * t1[1], v0[3] * t1[2] + sg * p0[3] * t1[3]};
                        v1 = (f32x4){v1[0] * t2[0] + sg * p1[0] * t2[1], v1[1] * t2[2] + sg * p1[1] * t2[3], v1[2] * t3[0] + sg * p1[2] * t3[1], v1[3] * t3[2] + sg * p1[3] * t3[3]}; }
                    u32x4 w; w.x = cvt_pk_bf16(v0[0], v0[1]); w.y = cvt_pk_bf16(v0[2], v0[3]); w.z = cvt_pk_bf16(v1[0], v1[1]); w.w = cvt_pk_bf16(v1[2], v1[3]);
                    *(u32x4*)(rowp + bj * HALF) = w; } }
    }
};

template <class Epi, class Sched, bool ALIGN_EPI = false, bool SP2 = false, bool GATHER = false>
__device__ __forceinline__ void gemm_phase(PG8_LAS unsigned char* lds, const Gemm g, const Sched& S, const Epi& E, const int tid) {
    const int wid = __builtin_amdgcn_readfirstlane(tid >> 6), lane = tid & 63, wr = wid >> 2, wc = wid & 3, fr = lane & 15, fq = lane >> 4;
    const int K = g.K, nt = K / BK;
    unsigned voffA[2], voffB[2];
#pragma unroll
    for (int i = 0; i < 2; ++i) { int R, C; stage_rc(tid * 16 + i * 8192, R, C); const int Rb = Epi::PERM ? ((R & ~31) + perm32(R & 31)) : R;
        voffA[i] = (unsigned)(R * g.lda + C) * 2u; voffB[i] = (unsigned)(Rb * g.ldb + C) * 2u; }
    unsigned vA0[2] = {0u, 0u}, vA1[2] = {0u, 0u}, wA0[2] = {0u, 0u}, wA1[2] = {0u, 0u};
#define PG8_GOFF(u_, o0, o1) do { _Pragma("unroll") for (int i = 0; i < 2; ++i) { int R, C; stage_rc(tid * 16 + i * 8192, R, C); const int r0_ = (u_).pm * BM + R; \
        o0[i] = ((unsigned)g.rowidx[r0_] * (unsigned)g.lda + (unsigned)C) * 2u; o1[i] = ((unsigned)g.rowidx[r0_ + HALF] * (unsigned)g.lda + (unsigned)C) * 2u; } } while (0)
    const size_t kstep = (size_t)(BK * 2);
    const size_t hstepA = (size_t)HALF * g.lda * 2, hstepB = (size_t)HALF * g.ldb * 2;
    const size_t tstepA = 2 * hstepA, tstepB = 2 * hstepB;
    const unsigned ldsw = (unsigned)wid * 1024u;
    const int aoff = lds_byte(wr * 64 + fr, fq * 8), boff = lds_byte(wc * 32 + fr, fq * 8);
#define PG8_SA(b, h) (((b) * 2 + (h)) * HTB)
#define PG8_SB(b, h) ((4 + (b) * 2 + (h)) * HTB)
#define PG8_STAGE(bufoff, gbase, voff) do { _Pragma("unroll") for (int _i = 0; _i < 2; ++_i) \
        __builtin_amdgcn_global_load_lds((const unsigned*)((const char*)(gbase) + (voff)[_i]), (PG8_LAS unsigned*)(lds + (bufoff) + ldsw + _i * 8192), 16, 0, 0); } while (0)
#define PG8_STAGEA(bufoff, kptr, h, oc0, oc1) do { if constexpr (GATHER) { if (h) PG8_STAGE(bufoff, kptr, oc1); else PG8_STAGE(bufoff, kptr, oc0); } else { PG8_STAGE(bufoff, (kptr) + ((h) ? hstepA : 0), voffA); } } while (0)
#define PG8_LDA(dst, b, h) do { _Pragma("unroll") for (int m = 0; m < 4; ++m) _Pragma("unroll") for (int k = 0; k < 2; ++k) dst[m][k] = *(const PG8_LAS bf16x8*)(lds + PG8_SA(b, h) + aoff + m * 2048 + k * 1024); } while (0)
#define PG8_LDB(dst, b, h) do { _Pragma("unroll") for (int n = 0; n < 2; ++n) _Pragma("unroll") for (int k = 0; k < 2; ++k) dst[n][k] = *(const PG8_LAS bf16x8*)(lds + PG8_SB(b, h) + boff + n * 2048 + k * 1024); } while (0)
#define PG8_MMA(ai, bj, At, Bt) do { __builtin_amdgcn_s_setprio(1); _Pragma("unroll") for (int m = 0; m < 4; ++m) _Pragma("unroll") for (int n = 0; n < 2; ++n) _Pragma("unroll") for (int k = 0; k < 2; ++k) \
        acc[ai][bj][m][n] = __builtin_amdgcn_mfma_f32_16x16x32_bf16(Bt[n][k], At[m][k], acc[ai][bj][m][n], 0, 0, 0); __builtin_amdgcn_s_setprio(0); } while (0)
#define PG8_WAIT_V(n) asm volatile("s_waitcnt vmcnt(" #n ")" ::: "memory")
#define PG8_WAIT_L(n) asm volatile("s_waitcnt lgkmcnt(" #n ")" ::: "memory")
#define PG8_BAR __builtin_amdgcn_s_barrier()
#define PG8_SCHED __builtin_amdgcn_sched_barrier(0)
    Unit cur, nxt; int ui = 0;
    if (!S.next(0, cur)) return;
    f32x4 acc[2][2][4][2];
#pragma unroll
    for (int a = 0; a < 2; ++a)
#pragma unroll
        for (int b = 0; b < 2; ++b)
#pragma unroll
            for (int m = 0; m < 4; ++m)
#pragma unroll
                for (int n = 0; n < 2; ++n) acc[a][b][m][n] = (f32x4){0.f, 0.f, 0.f, 0.f};
    bf16x8 At[4][2], B0[2][2], B1[2][2];
    const char* cA = (const char*)g.A + (GATHER ? (size_t)0 : (size_t)cur.pm * tstepA); if constexpr (GATHER) PG8_GOFF(cur, vA0, vA1);
    const char* cB = (const char*)g.Bt + (size_t)cur.pn * tstepB;
    S.a_ready(cur);
    if constexpr (SP2) {
        PG8_STAGE(PG8_SB(0, 0), cB, voffB); PG8_STAGE(PG8_SB(0, 1), cB + hstepB, voffB); PG8_STAGEA(PG8_SA(0, 0), cA, 0, vA0, vA1); PG8_STAGEA(PG8_SA(0, 1), cA, 1, vA0, vA1);
        if (wr == 1) PG8_BAR;
        PG8_WAIT_V(2); PG8_BAR;
        PG8_STAGE(PG8_SB(1, 0), cB + kstep, voffB); PG8_STAGEA(PG8_SA(1, 0), cA + kstep, 0, vA0, vA1); PG8_STAGE(PG8_SB(1, 1), cB + hstepB + kstep, voffB);
        PG8_WAIT_V(6); PG8_BAR;
    } else {
        PG8_STAGE(PG8_SB(0, 0), cB, voffB); PG8_STAGE(PG8_SA(0, 0), cA, voffA); PG8_STAGE(PG8_SB(0, 1), cB + hstepB, voffB); PG8_STAGE(PG8_SA(0, 1), cA + hstepA, voffA);
        if (wr == 1) PG8_BAR;
        PG8_WAIT_V(4); PG8_BAR;
        PG8_STAGE(PG8_SB(1, 0), cB + kstep, voffB); PG8_STAGE(PG8_SA(1, 0), cA + kstep, voffA); PG8_STAGE(PG8_SB(1, 1), cB + hstepB + kstep, voffB);
        PG8_WAIT_V(6); PG8_BAR;
    }
    for (;;) {
        const bool has_next = S.next(ui + 1, nxt);
        const char* nA = (has_next && !GATHER) ? (const char*)g.A + (size_t)nxt.pm * tstepA : cA;
        if constexpr (GATHER) { if (has_next) { if (wid < 4) __builtin_amdgcn_global_load_lds((const unsigned*)(g.rowidx + (size_t)nxt.pm * BM + (tid & 255)), (PG8_LAS unsigned*)(lds + STAGE_BYTES + wid * 256), 4, 0, 0); }
                                else { wA0[0] = vA0[0]; wA0[1] = vA0[1]; wA1[0] = vA1[0]; wA1[1] = vA1[1]; } }
        const char* nB = has_next ? (const char*)g.Bt + (size_t)nxt.pn * tstepB : cB;
        for (int t = 0; t < nt; t += 2) {
            const bool last = (t == nt - 2);
            const char* a1 = cA + (size_t)(t + 1) * kstep;
            const char* a2 = last ? nA : cA + (size_t)(t + 2) * kstep; const char* b2 = last ? nB : cB + (size_t)(t + 2) * kstep;
            const char* a3 = a2 + kstep; const char* b3 = b2 + kstep;
            if (last && has_next) S.a_ready(nxt);
            if constexpr (GATHER) { if (last && has_next) {
#pragma unroll
                for (int i = 0; i < 2; ++i) { int R, C; stage_rc(tid * 16 + i * 8192, R, C);
                    const unsigned i0_ = *(const PG8_LAS unsigned*)(lds + STAGE_BYTES + R * 4), i1_ = *(const PG8_LAS unsigned*)(lds + STAGE_BYTES + (R + HALF) * 4);
                    wA0[i] = (i0_ * (unsigned)g.lda + (unsigned)C) * 2u; wA1[i] = (i1_ * (unsigned)g.lda + (unsigned)C) * 2u; } } }
            const unsigned sA0[2] = {last ? wA0[0] : vA0[0], last ? wA0[1] : vA0[1]}, sA1[2] = {last ? wA1[0] : vA1[0], last ? wA1[1] : vA1[1]};
            if constexpr (SP2) {
            PG8_LDB(B0, 0, 0); PG8_LDB(B1, 0, 1); PG8_SCHED; PG8_LDA(At, 0, 0); PG8_STAGEA(PG8_SA(1, 1), a1, 1, vA0, vA1);
            PG8_WAIT_V(8); PG8_WAIT_L(0); PG8_BAR; PG8_MMA(0, 0, At, B0); PG8_MMA(0, 1, At, B1); PG8_BAR; PG8_SCHED;
            PG8_LDA(At, 0, 1); PG8_STAGE(PG8_SB(0, 0), b2, voffB); PG8_STAGE(PG8_SB(0, 1), b2 + hstepB, voffB); PG8_STAGEA(PG8_SA(0, 0), a2, 0, sA0, sA1);
            PG8_WAIT_V(8); PG8_WAIT_L(0); PG8_BAR; PG8_MMA(1, 0, At, B0); PG8_MMA(1, 1, At, B1); PG8_BAR; PG8_SCHED;
            PG8_LDB(B0, 1, 0); PG8_LDB(B1, 1, 1); PG8_SCHED; PG8_LDA(At, 1, 0); PG8_STAGEA(PG8_SA(0, 1), a2, 1, sA0, sA1);
            PG8_WAIT_V(8); PG8_WAIT_L(0); PG8_BAR; PG8_MMA(0, 0, At, B0); PG8_MMA(0, 1, At, B1); PG8_BAR; PG8_SCHED;
            PG8_LDA(At, 1, 1); PG8_STAGE(PG8_SB(1, 0), b3, voffB); PG8_STAGE(PG8_SB(1, 1), b3 + hstepB, voffB); PG8_STAGEA(PG8_SA(1, 0), a3, 0, sA0, sA1);
            PG8_WAIT_V(8); PG8_WAIT_L(0); PG8_BAR; PG8_MMA(1, 0, At, B0); PG8_MMA(1, 1, At, B1); PG8_BAR; PG8_SCHED;
            } else {
            PG8_LDB(B0, 0, 0); PG8_SCHED; PG8_LDA(At, 0, 0); PG8_STAGE(PG8_SA(1, 1), a1 + hstepA, voffA);
            PG8_WAIT_L(8); PG8_BAR; PG8_WAIT_L(0); PG8_MMA(0, 0, At, B0); PG8_BAR; PG8_SCHED;
            PG8_LDB(B1, 0, 1); PG8_STAGE(PG8_SB(0, 0), b2, voffB);
            PG8_BAR; PG8_WAIT_L(0); PG8_MMA(0, 1, At, B1); PG8_BAR;
            PG8_LDA(At, 0, 1); PG8_STAGE(PG8_SA(0, 0), a2, voffA);
            PG8_BAR; PG8_WAIT_L(0); PG8_MMA(1, 0, At, B0); PG8_BAR; PG8_SCHED;
            PG8_STAGE(PG8_SB(0, 1), b2 + hstepB, voffB);
            PG8_WAIT_V(6); PG8_BAR; PG8_MMA(1, 1, At, B1); PG8_BAR;
            PG8_LDB(B0, 1, 0); PG8_SCHED; PG8_LDA(At, 1, 0); PG8_STAGE(PG8_SA(0, 1), a2 + hstepA, voffA);
            PG8_WAIT_L(8); PG8_BAR; PG8_WAIT_L(0); PG8_MMA(0, 0, At, B0); PG8_BAR; PG8_SCHED;
            PG8_LDB(B1, 1, 1); PG8_STAGE(PG8_SB(1, 0), b3, voffB);
            PG8_BAR; PG8_WAIT_L(0); PG8_MMA(0, 1, At, B1); PG8_BAR;
            PG8_LDA(At, 1, 1); PG8_STAGE(PG8_SA(1, 0), a3, voffA);
            PG8_BAR; PG8_WAIT_L(0); PG8_MMA(1, 0, At, B0); PG8_BAR; PG8_SCHED;
            PG8_STAGE(PG8_SB(1, 1), b3 + hstepB, voffB);
            PG8_WAIT_V(6); PG8_BAR; PG8_MMA(1, 1, At, B1); PG8_BAR;
            }
        }
        if constexpr (ALIGN_EPI) { if (wr == 0) PG8_BAR; }
        if constexpr (!Epi::AFTER_DRAIN) { E(acc, cur, wr, wc, fr, fq); S.done(cur); }
        if (!has_next) break;
#pragma unroll
        for (int a = 0; a < 2; ++a)
#pragma unroll
            for (int b = 0; b < 2; ++b)
#pragma unroll
                for (int m = 0; m < 4; ++m)
#pragma unroll
                    for (int n = 0; n < 2; ++n) { double z0_, z1_; asm volatile("v_mov_b64 %0, 0\n\tv_mov_b64 %1, 0" : "=v"(z0_), "=v"(z1_));
                        typedef double f64x2_ __attribute__((ext_vector_type(2))); acc[a][b][m][n] = __builtin_bit_cast(f32x4, (f64x2_){z0_, z1_}); }
        cur = nxt; cA = nA; cB = nB; ++ui; vA0[0] = wA0[0]; vA0[1] = wA0[1]; vA1[0] = wA1[0]; vA1[1] = wA1[1];
        if constexpr (ALIGN_EPI) { if (wr == 1) PG8_BAR; }
    }
    PG8_WAIT_V(0);
    if constexpr (!ALIGN_EPI) { if (wr == 0) PG8_BAR; }
    PG8_BAR;
    if constexpr (Epi::AFTER_DRAIN) { E.fused(acc, cur, wr, wc, fr, fq, lds, wid, lane); S.done(cur); }
#undef PG8_SA
#undef PG8_SB
#undef PG8_STAGE
#undef PG8_STAGEA
#undef PG8_GOFF
#undef PG8_LDA
#undef PG8_LDB
#undef PG8_MMA
#undef PG8_WAIT_V
#undef PG8_WAIT_L
#undef PG8_BAR
#undef PG8_SCHED
}
}
#define PG8_SP2 true
#define PG8_ALIGN true

struct Frame;
struct Args { const float* in[33]; float* out; unsigned char* ws; int ph_lo, ph_hi; };
struct Frame {
    unsigned char* lds;
    int tid, lane, wave, bid, nb;
    const float* const* in;
    float* out; unsigned char* ws;
    float* MOD; float* AFF; int* SEL; float* GATE; int* INV; bf16* X; bf16* H;
};
__device__ __forceinline__ void REFRESH_(Frame& F) { int l_; asm volatile("v_mbcnt_lo_u32_b32 %0, -1, 0\n\tv_mbcnt_hi_u32_b32 %0, -1, %0" : "=v"(l_)); F.lane = l_; F.tid = F.wave * 64 + l_; }
__device__ __forceinline__ int mod_row(int row) { const int b = row / P, pos = row - b * P; return pos < NCTX ? 32 : b; }

__device__ __forceinline__ void ph_s5_pre(const Frame& F) {
    const float *a_re = F.in[8], *a_im = F.in[9], *log_dt = F.in[10], *b_re = F.in[11], *b_im = F.in[12], *c_re = F.in[13], *c_im = F.in[14];
    f32x2* Bb = (f32x2*)F.lds;
    f32x2* Cc = Bb + 2048;
    f32x2* Ap = Cc + 2048;
    float* Kt = (float*)(Ap + 2 * 33 * 64);
    bf16* W1 = (bf16*)(F.ws + WS_S5W1); bf16* W2 = (bf16*)(F.ws + WS_S5W2); f32x2* A32 = (f32x2*)(F.ws + WS_S5A);
    const int tid = F.tid;
    for (int g = F.nb - 1 - F.bid; g < 64; g += F.nb) {
        __syncthreads();
        if (tid < 128) {
            const int dir = tid >> 6, p = tid & 63, dg = dir * 64 + g;
            const double are = (double)a_re[dg * 64 + p], aim = (double)a_im[dg * 64 + p], dt = exp((double)log_dt[dg]);
            const double lr = are * dt, li = aim * dt, cl = cos(li), sl = sin(li), mag = exp(lr);
            const double Abi = mag * sl, sh = sin(0.5 * li), nr = expm1(lr) * cl - 2.0 * sh * sh, den = are * are + aim * aim;
            const double fr = (nr * are + Abi * aim) / den, fi = (Abi * are - nr * aim) / den;
            for (int h = 0; h < 16; ++h) { const double br = (double)b_re[((size_t)dg * 64 + p) * 16 + h], bi = (double)b_im[((size_t)dg * 64 + p) * 16 + h];
                Bb[(dir * 64 + p) * 16 + h] = (f32x2){(float)(fr * br - fi * bi), (float)(fr * bi + fi * br)}; }
            const double Abr = mag * cl; double pr = 1.0, pi = 0.0;
            for (int e = 0; e <= 32; ++e) { const f32x2 v = {(float)pr, (float)pi};
                Ap[(dir * 33 + e) * 64 + p] = v; if (e == 32) A32[(g * 2 + dir) * 64 + p] = v;
                const double nr2 = pr * Abr - pi * Abi, ni2 = pr * Abi + pi * Abr; pr = nr2; pi = ni2; }
        }
        for (int i = tid; i < 2048; i += NTHREADS) { const int dir = i >> 10, k = (i >> 6) & 15, p = i & 63; const size_t o = ((size_t)(dir * 64 + g) * 16 + k) * 64 + p; Cc[i] = (f32x2){c_re[o], c_im[o]}; }
        __syncthreads();
        {
            const int dir = tid >> 8, k = (tid >> 4) & 15, h = tid & 15; float acc[32];
#pragma unroll
            for (int lag = 0; lag < 32; ++lag) acc[lag] = 0.f;
#pragma unroll 2
            for (int p = 0; p < 64; ++p) { const f32x2 c = Cc[(dir * 16 + k) * 64 + p], bb = Bb[(dir * 64 + p) * 16 + h], a1 = Ap[(dir * 33 + 1) * 64 + p];
                float zr = c.x * bb.x - c.y * bb.y, zi = c.x * bb.y + c.y * bb.x;
#pragma unroll
                for (int lag = 0; lag < 32; ++lag) { acc[lag] += zr; const float nz = zr * a1.x - zi * a1.y; zi = zr * a1.y + zi * a1.x; zr = nz; } }
#pragma unroll
            for (int lag = 0; lag < 32; ++lag) Kt[((dir * 32 + lag) * 16 + k) * 16 + h] = acc[lag];
        }
        for (int i = tid; i < 16384; i += NTHREADS) {
            const int n = i >> 6, sg = (i >> 1) & 31, h0 = (i & 1) * 8, dir = n >> 7, c = (n >> 6) & 1, p = n & 63, e = dir ? sg : 31 - sg;
            const f32x2 a = Ap[(dir * 33 + e) * 64 + p]; float v[8];
#pragma unroll
            for (int q = 0; q < 8; ++q) { const f32x2 bb = Bb[(dir * 64 + p) * 16 + h0 + q]; v[q] = c ? a.x * bb.y + a.y * bb.x : a.x * bb.x - a.y * bb.y; }
            u32x4 w; w.x = pk2(v[0], v[1]); w.y = pk2(v[2], v[3]); w.z = pk2(v[4], v[5]); w.w = pk2(v[6], v[7]);
            *(u32x4*)(W1 + ((size_t)g * 256 + n) * 512 + sg * 16 + h0) = w;
        }
        for (int i = tid; i < 16384; i += NTHREADS) {
            const int m = i >> 5, n0 = (i & 31) * 8, dir = n0 >> 7, c = (n0 >> 6) & 1, p0 = n0 & 63, tau = m >> 4, k = m & 15, e = dir ? 32 - tau : tau + 1; float v[8];
#pragma unroll
            for (int q = 0; q < 8; ++q) { const f32x2 cc = Cc[(dir * 16 + k) * 64 + p0 + q], a = Ap[(dir * 33 + e) * 64 + p0 + q]; v[q] = c ? -(cc.x * a.y + cc.y * a.x) : cc.x * a.x - cc.y * a.y; }
            u32x4 w; w.x = pk2(v[0], v[1]); w.y = pk2(v[2], v[3]); w.z = pk2(v[4], v[5]); w.w = pk2(v[6], v[7]);
            *(u32x4*)(W2 + ((size_t)g * 512 + m) * 768 + 512 + n0) = w;
        }
        __syncthreads();
        for (int i = tid; i < 32768; i += NTHREADS) {
            const int m = i >> 6, sg = (i >> 1) & 31, h0 = (i & 1) * 8, tau = m >> 4, k = m & 15; float v[8];
#pragma unroll
            for (int q = 0; q < 8; ++q) { float x = 0.f; if (sg <= tau) x += Kt[((tau - sg) * 16 + k) * 16 + h0 + q]; if (sg >= tau) x += Kt[((32 + sg - tau) * 16 + k) * 16 + h0 + q]; v[q] = x; }
            u32x4 w; w.x = pk2(v[0], v[1]); w.y = pk2(v[2], v[3]); w.z = pk2(v[4], v[5]); w.w = pk2(v[6], v[7]);
            *(u32x4*)(W2 + ((size_t)g * 512 + m) * 768 + sg * 16 + h0) = w;
        }
    }
    __syncthreads();
}
__device__ __forceinline__ void ph_s5_scan(const Frame& F) {
    const float* SS = (const float*)(F.ws + WS_SS); bf16* AG = (bf16*)(F.ws + WS_AG); const f32x2* A32 = (const f32x2*)(F.ws + WS_S5A);
    for (int gid = F.bid * NTHREADS + F.tid; gid < 64 * 32 * 128; gid += F.nb * NTHREADS) {
        const int p = gid & 63, dir = (gid >> 6) & 1, b = (gid >> 7) & 31, g = gid >> 12;
        const f32x2 a = A32[(g * 2 + dir) * 64 + p];
        float hr = 0.f, hi = 0.f;
        const size_t row0 = (size_t)g * 2304 + b * 72;
#pragma unroll 4
        for (int idx = 0; idx < 72; ++idx) {
            const int j = dir == 0 ? idx : (idx < 8 ? 7 - idx : 79 - idx);
            const size_t row = row0 + j;
            AG[row * 768 + 512 + dir * 128 + p] = (bf16)f2bf(hr); AG[row * 768 + 512 + dir * 128 + 64 + p] = (bf16)f2bf(hi);
            const float sr = SS[row * 256 + dir * 128 + p], si = SS[row * 256 + dir * 128 + 64 + p];
            const float nr = a.x * hr - a.y * hi + sr, ni = a.x * hi + a.y * hr + si; hr = nr; hi = ni;
        }
    }
}

template <int DUAL>
__device__ __forceinline__ void transpose_item(const float* W, int ldw, int K, int N, bf16* WT, int row_off, LAS float* scr, int item, int lane) {
    const int nblk = N / 64, kb = item / nblk, nb = item - kb * nblk, k0 = 64 * kb, n0 = 64 * nb;
    const int lr = lane >> 4, lc = (lane & 15) * 4;
    f32x4 v[16];
#pragma unroll
    for (int i = 0; i < 16; ++i) v[i] = *(const f32x4*)(W + (size_t)(k0 + lr + 4 * i) * ldw + n0 + lc);
#pragma unroll
    for (int i = 0; i < 16; ++i) { LAS float* d = scr + (lr + 4 * i) * 65 + lc; d[0] = v[i].x; d[1] = v[i].y; d[2] = v[i].z; d[3] = v[i].w; }
    asm volatile("s_waitcnt lgkmcnt(0)" ::: "memory");
    const int c = lane & 7;
#pragma unroll
    for (int j = 0; j < 8; ++j) { const int n = (lane >> 3) + 8 * j; const LAS float* sp = scr + (8 * c) * 65 + n;
        u32x4 o; o.x = pkbf(sp[0 * 65], sp[1 * 65]); o.y = pkbf(sp[2 * 65], sp[3 * 65]); o.z = pkbf(sp[4 * 65], sp[5 * 65]); o.w = pkbf(sp[6 * 65], sp[7 * 65]);
        const int nn = n0 + n, dest = DUAL == -2 ? (nn < 3072 ? nn : (nn < 4096 ? nn + 1024 : nn - 1024)) : (DUAL < 0 ? row_off + nn : row_off + (nn >> 7) * 256 + DUAL * 128 + (nn & 127));
        *(u32x4*)(WT + (size_t)dest * K + k0 + 8 * c) = o; }
    asm volatile("s_waitcnt lgkmcnt(0)" ::: "memory");
}
__device__ __forceinline__ void convert_moe(const Frame& F, int l, int cb = -1, int cnb = 0) {
    if (cb < 0) { cb = F.bid; cnb = F.nb; }
    if (cb >= cnb) return;
    LAS float* scr = (LAS float*)((LAS unsigned char*)F.lds) + F.wave * 4160;
    bf16* WGU = (bf16*)(F.ws + WO_GU); bf16* WDN = (bf16*)(F.ws + WO_DN);
    for (int it = cb * NWAVES + F.wave; it < 24576; it += cnb * NWAVES) {
        const int m = it >> 13, r = it & 8191, e = r >> 9, item = r & 511;
        if (m == 0) transpose_item<0>(F.in[29] + (size_t)(l * NE + e) * D * FF, FF, D, FF, WGU, e * 2 * FF, scr, item, F.lane);
        else if (m == 1) transpose_item<1>(F.in[30] + (size_t)(l * NE + e) * D * FF, FF, D, FF, WGU, e * 2 * FF, scr, item, F.lane);
        else transpose_item<-1>(F.in[31] + (size_t)(l * NE + e) * FF * D, D, FF, D, WDN, e * D, scr, item, F.lane);
    }
}
__device__ __forceinline__ void convert_mixers(const Frame& F, int cb, int cnb) {
    if (cb >= cnb) return;
    LAS float* scr = (LAS float*)((LAS unsigned char*)F.lds) + F.wave * 4160;
    for (int it = cb * NWAVES + F.wave; it < 4096; it += cnb * NWAVES) {
        int r = it;
        if (r < 256) { transpose_item<0>(F.in[16], 2 * D, D, D, (bf16*)(F.ws + WO_GLU), 0, scr, r, F.lane); continue; } r -= 256;
        if (r < 256) { transpose_item<1>(F.in[16] + D, 2 * D, D, D, (bf16*)(F.ws + WO_GLU), 0, scr, r, F.lane); continue; } r -= 256;
        if (r < 768) { transpose_item<-1>(F.in[17], 3 * D, D, 3 * D, (bf16*)(F.ws + WO_NAQKV), 0, scr, r, F.lane); continue; } r -= 768;
        if (r < 256) { transpose_item<-1>(F.in[18], D, D, D, (bf16*)(F.ws + WO_NAO), 0, scr, r, F.lane); continue; } r -= 256;
        if (r < 768) { transpose_item<-1>(F.in[20], 3 * D, D, 3 * D, (bf16*)(F.ws + WO_DAQKV), 0, scr, r, F.lane); continue; } r -= 768;
        if (r < 256) { transpose_item<-1>(F.in[21], D, D, D, (bf16*)(F.ws + WO_DAO), 0, scr, r, F.lane); continue; } r -= 256;
        if (r < 1280) { transpose_item<-2>(F.in[24], 5 * D, D, 5 * D, (bf16*)(F.ws + WO_HGIN), 0, scr, r, F.lane); continue; } r -= 1280;
        transpose_item<-1>(F.in[25], D, D, D, (bf16*)(F.ws + WO_HGO), 0, scr, r, F.lane);
    }
}

__device__ __forceinline__ void ph_prologue(const Frame& F) {
    {
        float* S = (float*)F.lds;
        for (int i = F.tid; i < 33 * 1024; i += NTHREADS) { const float v = i < 32 * 1024 ? F.in[1][i] : F.in[3][i - 32 * 1024]; S[i] = siluf_(v); }
        __syncthreads();
        float acc[2][33];
#pragma unroll
        for (int t = 0; t < 2; ++t)
#pragma unroll
            for (int r = 0; r < 33; ++r) acc[t][r] = 0.f;
#pragma unroll
        for (int t = 0; t < 2; ++t) {
            const int task = F.bid + t * F.nb;
            if (task < 384) {
                const int l = task / 96, col = (task % 96) * 64 + F.lane, kb = F.wave * 128;
                const float* W = F.in[4] + (size_t)l * 1024 * 6144 + col;
#pragma unroll 1
                for (int k = kb; k < kb + 128; k += 8) {
                    float w[8];
#pragma unroll
                    for (int q = 0; q < 8; ++q) w[q] = W[(size_t)(k + q) * 6144];
#pragma unroll
                    for (int r = 0; r < 33; ++r) { const f32x4 s0 = *(const f32x4*)&S[r * 1024 + k], s1 = *(const f32x4*)&S[r * 1024 + k + 4];
                        acc[t][r] += (s0.x * w[0] + s0.y * w[1]) + (s0.z * w[2] + s0.w * w[3]) + (s1.x * w[4] + s1.y * w[5]) + (s1.z * w[6] + s1.w * w[7]); }
                }
            }
        }
        __syncthreads();
#pragma unroll
        for (int t = 0; t < 2; ++t)
#pragma unroll
            for (int r = 0; r < 33; ++r) S[((t * 8 + F.wave) * 33 + r) * 64 + F.lane] = acc[t][r];
        __syncthreads();
        for (int i = F.tid; i < 2 * 33 * 64; i += NTHREADS) {
            const int t = i / (33 * 64), r = (i / 64) % 33, ln = i & 63, task = F.bid + t * F.nb;
            if (task < 384) { const int l = task / 96, col = (task % 96) * 64 + ln; float v = F.in[5][l * 6144 + col];
#pragma unroll
                for (int w = 0; w < 8; ++w) v += S[((t * 8 + w) * 33 + r) * 64 + ln];
                F.MOD[((size_t)l * 33 + r) * 6144 + col] = v; }
        }
        __syncthreads();
    }
    if (F.bid == 48) {
        const float* lbin = F.in[27];
        for (int c = F.tid; c < D; c += NTHREADS) { const float x0 = lbin[c], x1 = lbin[D + c], x2 = lbin[2 * D + c], x3 = lbin[3 * D + c], mx = fmaxf(fmaxf(x0, x1), fmaxf(x2, x3));
            const float e0 = expf(x0 - mx), e1 = expf(x1 - mx), e2 = expf(x2 - mx), e3 = expf(x3 - mx); ((float*)(F.ws + WS_LB))[c] = (e1 + e2 + e3) / (e0 + e1 + e2 + e3); }
    }
    if (F.bid == 49) {
        for (int i = F.tid; i < 64 * 16; i += NTHREADS) { const float inv = powf(10000.0f, -(float)(i & 15) * (1.0f / 16.0f)); float sn, cs; sincosf((float)(i >> 4) * inv, &sn, &cs);
            ((float*)(F.ws + WS_ROPE))[2 * i] = cs; ((float*)(F.ws + WS_ROPE))[2 * i + 1] = sn; }
    }
    { const int ncv = F.nb > 128 ? F.nb - 64 : F.nb;
      convert_mixers(F, F.bid, ncv); convert_moe(F, 0, F.bid, ncv); }
    __syncthreads();
    ph_s5_pre(F);
}

template <bool F32> struct XRawT { typedef f32x4 T; };
template <> struct XRawT<false> { typedef u32x2 T; };
__device__ __forceinline__ f32x4 xcvt(const f32x4& r) { return r; }
__device__ __forceinline__ f32x4 xcvt(const u32x2& r) { return (f32x4){bflo(r.x), bfhi(r.x), bflo(r.y), bfhi(r.y)}; }
template <int MODE, bool COMBINE, bool S5OUT = false, bool SKIPCTX = false, bool FROMIN = false>
__device__ __forceinline__ void ph_norm(const Frame& F, int layer, int prev_layer) {
    static_assert(MODE != 1, "norm2 + router is ph_norm2");
    const float* nw = MODE == 0 ? F.in[6] + layer * D : F.in[32];
    const bf16* Y = (const bf16*)(F.ws + WS_Y);
    constexpr int NI = SKIPCTX ? NB * SEQ : R;
    constexpr int NPF = 4;
    const int per = (NI + F.nb * NWAVES - 1) / (F.nb * NWAVES);
    int it = (F.bid * NWAVES + F.wave) * per; const int itend = min(NI, it + per);
    typedef typename XRawT<FROMIN>::T XR;
    const __amdgpu_buffer_rsrc_t yrs = __builtin_amdgcn_make_buffer_rsrc((void*)Y, 0, (int)((size_t)NE * SLOTS * D * 2), 0x00020000);
    const int l16 = F.lane & 15;
#define NORM_ROWOF(i_) (SKIPCTX ? ((i_) >> 11) * P + NCTX + ((i_) & (SEQ - 1)) : (i_))
#define NORM_XPTR(r_) ((FROMIN ? (const XR*)(((r_) % P) < NCTX ? F.in[2] + ((size_t)((r_) / P) * NCTX + ((r_) % P)) * D : F.in[0] + ((size_t)((r_) / P) * SEQ + ((r_) % P) - NCTX) * D) : (const XR*)(F.X + (size_t)(r_) * D)) + F.lane)
#define NORM_STAGE(i_, INVA_, V_, G_, Yq_, INVB_) do { \
        const int ic_ = min((i_), itend - 1), ic1_ = min((i_) + 1, itend - 1); const int rA_ = NORM_ROWOF(ic_); \
        if (COMBINE) INVB_ = F.INV[(size_t)NORM_ROWOF(ic1_) * NE + l16]; \
        if (COMBINE) G_ = F.GATE[l16 * SLOTS + max(INVA_, 0)]; \
        { const XR* xp_ = NORM_XPTR(rA_); _Pragma("unroll") for (int j = 0; j < 4; ++j) V_[j] = xp_[64 * j]; } \
        if (COMBINE) { unsigned m_ = ((i_) < itend) ? (unsigned)(__ballot(F.lane < NE && INVA_ >= 0) & 0xffffull) : 0u; \
            _Pragma("unroll") for (int q = 0; q < NPF; ++q) { const bool pr_ = m_ != 0u; const int e_ = pr_ ? __builtin_ctz(m_) : 0; m_ &= m_ - 1u; const int s_ = __builtin_amdgcn_readlane(INVA_, e_); \
                const unsigned vo_ = pr_ ? (unsigned)(e_ * SLOTS + s_) * (unsigned)(D * 2) + (unsigned)F.lane * 8u : 0xfffff000u; \
                _Pragma("unroll") for (int j = 0; j < 4; ++j) Yq_[q][j] = __builtin_amdgcn_raw_buffer_load_b64(yrs, vo_ + 512u * j, 0, 0); } } \
    } while (0)
    XR v[4]; u32x2 yc[NPF][4]; float gl = 0.f; int invl = -1, invn = -1;
    if (COMBINE) invl = F.INV[(size_t)NORM_ROWOF(min(it, NI - 1)) * NE + l16];
    NORM_STAGE(it, invl, v, gl, yc, invn);
    const f32x4* nw4 = (const f32x4*)nw + F.lane;
    f32x4 g5[4], nwv[4], shv[4], scv[4]; int mrc = -1;
#pragma unroll
    for (int j = 0; j < 4; ++j) { nwv[j] = nw4[64 * j]; g5[j] = shv[j] = scv[j] = (f32x4){0.f, 0.f, 0.f, 0.f}; }
    while (it < itend) {
        const int row = NORM_ROWOF(it), b = row / P, pos = row - b * P, mr = pos < NCTX ? 32 : b;
        if (mr != mrc) { mrc = mr;
            const float* mrow = F.MOD + ((size_t)layer * 33 + mr) * 6144;
#pragma unroll
            for (int j = 0; j < 4; ++j) {
                if (COMBINE) g5[j] = ((const f32x4*)(F.MOD + ((size_t)prev_layer * 33 + mr) * 6144 + 5 * D) + F.lane)[64 * j];
                if (MODE != 2) { shv[j] = ((const f32x4*)(mrow + (MODE == 0 ? 0 : 3) * D) + F.lane)[64 * j]; scv[j] = ((const f32x4*)(mrow + (MODE == 0 ? 1 : 4) * D) + F.lane)[64 * j]; }
            }
        }
        XR vn[4]; u32x2 yn[NPF][4]; float gln = 0.f; int invnn = -1;
        NORM_STAGE(it + 1, invn, vn, gln, yn, invnn);
        f32x4 a[4];
#pragma unroll
        for (int j = 0; j < 4; ++j) a[j] = (f32x4){0.f, 0.f, 0.f, 0.f};
        if (COMBINE) {
            unsigned m = (unsigned)(__ballot(F.lane < NE && invl >= 0) & 0xffffull);
#pragma unroll
            for (int q = 0; q < NPF; ++q) {
                const bool pr = m != 0u; const int e = pr ? __builtin_ctz(m) : 0; m &= m - 1u;
                const float g = pr ? __uint_as_float(__builtin_amdgcn_readlane(__float_as_uint(gl), e)) : 0.f;
#pragma unroll
                for (int j = 0; j < 4; ++j) { a[j].x += g * bflo(yc[q][j].x); a[j].y += g * bfhi(yc[q][j].x); a[j].z += g * bflo(yc[q][j].y); a[j].w += g * bfhi(yc[q][j].y); }
            }
            while (m) {
                const int e = __builtin_ctz(m); m &= m - 1u;
                const int sl = __builtin_amdgcn_readlane(invl, e); const float g = __uint_as_float(__builtin_amdgcn_readlane(__float_as_uint(gl), e));
                const u32x2* y0 = (const u32x2*)(Y + ((size_t)e * SLOTS + sl) * D) + F.lane;
                u32x2 w0[4];
#pragma unroll
                for (int j = 0; j < 4; ++j) w0[j] = y0[64 * j];
#pragma unroll
                for (int j = 0; j < 4; ++j) { a[j].x += g * bflo(w0[j].x); a[j].y += g * bfhi(w0[j].x); a[j].z += g * bflo(w0[j].y); a[j].w += g * bfhi(w0[j].y); }
            }
        }
        f32x4 vv[4];
#pragma unroll
        for (int j = 0; j < 4; ++j) vv[j] = xcvt(v[j]);
        if (COMBINE) {
#pragma unroll
            for (int j = 0; j < 4; ++j) vv[j] = vv[j] + g5[j] * a[j];
        }
        if ((FROMIN || COMBINE) && MODE != 2) { u32x2* xw = (u32x2*)(F.X + (size_t)row * D) + F.lane;
#pragma unroll
            for (int j = 0; j < 4; ++j) { u32x2 w; w.x = pkbf(vv[j].x, vv[j].y); w.y = pkbf(vv[j].z, vv[j].w); xw[64 * j] = w; } }
        float ss = 0.f;
#pragma unroll
        for (int j = 0; j < 4; ++j) ss += (vv[j].x * vv[j].x + vv[j].y * vv[j].y) + (vv[j].z * vv[j].z + vv[j].w * vv[j].w);
        const float rinv = rsqrtf(wave_sum(ss) * (1.0f / D) + EPS);
        if (MODE == 2) {
            if (pos >= NCTX) {
                f32x4* o = (f32x4*)(F.out + ((size_t)b * SEQ + pos - NCTX) * D) + F.lane;
#pragma unroll
                for (int j = 0; j < 4; ++j) o[64 * j] = vv[j] * rinv * nwv[j];
            }
        } else {
            u32x2* ho = (u32x2*)(F.H + (size_t)row * D) + F.lane;
            f32x4 h[4];
#pragma unroll
            for (int j = 0; j < 4; ++j) { h[j] = vv[j] * rinv * nwv[j] * (scv[j] + 1.0f) + shv[j]; u32x2 w; w.x = pkbf(h[j].x, h[j].y); w.y = pkbf(h[j].z, h[j].w); ho[64 * j] = w;
                if (S5OUT) { const int g = (F.lane >> 2) + 16 * j;
                    *(u32x2*)((bf16*)(F.ws + WS_AG) + ((size_t)g * 2304 + b * 72 + (pos >> 5)) * 768 + (pos & 31) * 16 + (F.lane & 3) * 4) = w; } }
        }
#pragma unroll
        for (int j = 0; j < 4; ++j) { v[j] = vn[j];
#pragma unroll
            for (int q = 0; q < NPF; ++q) yc[q][j] = yn[q][j]; }
        gl = gln; invl = invn; invn = invnn; ++it;
    }
#undef NORM_STAGE
#undef NORM_XPTR
#undef NORM_ROWOF
}

template <bool SKIPCTX>
__device__ __forceinline__ void ph_norm2(const Frame& F, int layer) {
    const float* nw = F.in[7] + layer * D;
    LAS float* wrt = (LAS float*)((LAS unsigned char*)F.lds);
    {
        const float* wr = F.in[28] + (size_t)layer * D * NE;
        for (int i = F.tid; i < D * NE; i += NTHREADS) wrt[(i & 15) * (D + 4) + (i >> 4)] = wr[i];
        __syncthreads();
    }
    const f32x4* nw4 = (const f32x4*)nw + F.lane;
    const int eid = ((F.lane & 1) << 3) | ((F.lane & 2) << 1) | ((F.lane & 4) >> 1) | ((F.lane & 8) >> 3);
    constexpr int NI = SKIPCTX ? NB * SEQ / 2 : R / 2;
    const int per = (NI + F.nb * NWAVES - 1) / (F.nb * NWAVES), it0 = (F.bid * NWAVES + F.wave) * per, it1 = min(NI, it0 + per);
    f32x4 gv[4], shv[4]; int mrc = -1;
#pragma unroll
    for (int j = 0; j < 4; ++j) gv[j] = shv[j] = (f32x4){0.f, 0.f, 0.f, 0.f};
#define N2_ROWOF(i_) (SKIPCTX ? ((i_) >> 10) * P + NCTX + 2 * ((i_) & (SEQ / 2 - 1)) : 2 * (i_))
    u32x2 w0[4], w1[4];
    { const u32x2* x0 = (const u32x2*)(F.X + (size_t)N2_ROWOF(min(it0, NI - 1)) * D) + F.lane;
#pragma unroll
      for (int j = 0; j < 4; ++j) { w0[j] = x0[64 * j]; w1[j] = x0[256 + 64 * j]; } }
    for (int it = it0; it < it1; ++it) {
        const int row = N2_ROWOF(it), b = row / P, pos = row - b * P, mr = pos < NCTX ? 32 : b;
        f32x4 v0[4], v1[4];
#pragma unroll
        for (int j = 0; j < 4; ++j) { v0[j] = xcvt(w0[j]); v1[j] = xcvt(w1[j]); }
        if (mr != mrc) { mrc = mr;
            const float* mrow = F.MOD + ((size_t)layer * 33 + mr) * 6144;
#pragma unroll
            for (int j = 0; j < 4; ++j) { shv[j] = ((const f32x4*)(mrow + 3 * D) + F.lane)[64 * j]; gv[j] = nw4[64 * j] * (((const f32x4*)(mrow + 4 * D) + F.lane)[64 * j] + 1.0f); }
        }
        u32x2 n0[4], n1[4];
        { const u32x2* xn = (const u32x2*)(F.X + (size_t)N2_ROWOF(min(it + 1, it1 - 1)) * D) + F.lane;
#pragma unroll
          for (int j = 0; j < 4; ++j) { n0[j] = xn[64 * j]; n1[j] = xn[256 + 64 * j]; } }
        float s0 = 0.f, s1 = 0.f;
#pragma unroll
        for (int j = 0; j < 4; ++j) { s0 += (v0[j].x * v0[j].x + v0[j].y * v0[j].y) + (v0[j].z * v0[j].z + v0[j].w * v0[j].w); s1 += (v1[j].x * v1[j].x + v1[j].y * v1[j].y) + (v1[j].z * v1[j].z + v1[j].w * v1[j].w); }
        const float r0 = rsqrtf(wave_sum(s0) * (1.0f / D) + EPS), r1 = rsqrtf(wave_sum(s1) * (1.0f / D) + EPS);
        u32x2* h0 = (u32x2*)(F.H + (size_t)row * D) + F.lane; u32x2* h1 = h0 + 256;
#pragma unroll
        for (int j = 0; j < 4; ++j) { const f32x4 g = gv[j];
            v0[j] = v0[j] * r0 * g + shv[j]; v1[j] = v1[j] * r1 * g + shv[j];
            u32x2 w; w.x = pkbf(v0[j].x, v0[j].y); w.y = pkbf(v0[j].z, v0[j].w); h0[64 * j] = w;
            w.x = pkbf(v1[j].x, v1[j].y); w.y = pkbf(v1[j].z, v1[j].w); h1[64 * j] = w; }
        f32x2 a0[NE], a1[NE];
#pragma unroll
        for (int e = 0; e < NE; ++e) { a0[e] = (f32x2){0.f, 0.f}; a1[e] = (f32x2){0.f, 0.f}; }
#pragma unroll
        for (int j = 0; j < 4; ++j) { asm volatile("" ::: "memory");
            const f32x2 p0 = {v0[j].x, v0[j].y}, q0 = {v0[j].z, v0[j].w}, p1 = {v1[j].x, v1[j].y}, q1 = {v1[j].z, v1[j].w};
#pragma unroll
            for (int e = 0; e < NE; ++e) { const f32x4 w = *(const LAS f32x4*)(wrt + e * (D + 4) + F.lane * 4 + 256 * j); const f32x2 wl = {w.x, w.y}, wh = {w.z, w.w};
                a0[e] += p0 * wl; a0[e] += q0 * wh; a1[e] += p1 * wl; a1[e] += q1 * wh; } }
        float lg0[NE], lg1[NE];
#pragma unroll
        for (int e = 0; e < NE; ++e) { lg0[e] = a0[e].x + a0[e].y; lg1[e] = a1[e].x + a1[e].y; }
        const float t0 = reduce16(lg0, F.lane), t1 = reduce16(lg1, F.lane);
        float m0 = fmaxf(t0, dpp_xor1(t0)), m1 = fmaxf(t1, dpp_xor1(t1));
        m0 = fmaxf(m0, dpp_xor2(m0)); m1 = fmaxf(m1, dpp_xor2(m1)); m0 = fmaxf(m0, __shfl_xor(m0, 4)); m1 = fmaxf(m1, __shfl_xor(m1, 4)); m0 = fmaxf(m0, __shfl_xor(m0, 8)); m1 = fmaxf(m1, __shfl_xor(m1, 8));
        const float e0 = __builtin_amdgcn_exp2f((t0 - m0) * LOG2E_), e1 = __builtin_amdgcn_exp2f((t1 - m1) * LOG2E_);
        float z0 = e0 + dpp_xor1(e0), z1 = e1 + dpp_xor1(e1);
        z0 += dpp_xor2(z0); z1 += dpp_xor2(z1); z0 += __shfl_xor(z0, 4); z1 += __shfl_xor(z1, 4); z0 += __shfl_xor(z0, 8); z1 += __shfl_xor(z1, 8);
        if (F.lane < NE) { float* ap = F.AFF + ((size_t)b * NE + eid) * P + pos; ap[0] = e0 / z0; ap[1] = e1 / z1; }
#pragma unroll
        for (int j = 0; j < 4; ++j) { w0[j] = n0[j]; w1[j] = n1[j]; }
    }
#undef N2_ROWOF
}

__device__ __forceinline__ void ph_topk(const Frame& F, int nitems) {
    const int tid = F.tid, lane = F.lane, half = F.wave >> 2, hw = F.wave & 3, ht = tid & 255;
    unsigned* hist = (unsigned*)F.lds + half * 288;
    unsigned* wtot = hist + 256;
    unsigned* bc = wtot + 8;
    for (int item0 = F.bid; item0 < nitems; item0 += 2 * F.nb) {
        const int item = item0 + half * F.nb; const bool valid = item < nitems;
        const int seg = item >> 9, b = (item >> 4) & 31, e = item & 15;
        const int n = seg ? NCTX : SEQ, pos0 = seg ? 0 : NCTX, cap = n / 8, slot0 = seg ? NB * 256 + b * 32 : b * 256;
        const int per = seg ? 1 : 8;
        const float* a = F.AFF + ((size_t)b * NE + e) * P + pos0;
        unsigned u[8];
#pragma unroll
        for (int q = 0; q < 8; ++q) u[q] = 0u;
        if (valid) {
            if (seg) u[0] = __float_as_uint(a[ht]);
            else { const f32x4 a0 = *(const f32x4*)(a + ht * 8), a1 = *(const f32x4*)(a + ht * 8 + 4);
                u[0] = __float_as_uint(a0.x); u[1] = __float_as_uint(a0.y); u[2] = __float_as_uint(a0.z); u[3] = __float_as_uint(a0.w);
                u[4] = __float_as_uint(a1.x); u[5] = __float_as_uint(a1.y); u[6] = __float_as_uint(a1.z); u[7] = __float_as_uint(a1.w); }
        }
        unsigned prefix = 0u, mask = 0u, kk = (unsigned)cap;
#pragma unroll 1
        for (int pass = 0; pass < 4; ++pass) {
            const int shift = 24 - 8 * pass;
            __syncthreads();
            hist[ht] = 0u;
            __syncthreads();
            if (valid) {
#pragma unroll
                for (int q = 0; q < 8; ++q) if (q < per && (u[q] & mask) == prefix) atomicAdd(&hist[(u[q] >> shift) & 255u], 1u);
            }
            __syncthreads();
            unsigned hv = hist[255 - ht], cum = hv;
#pragma unroll
            for (int o = 1; o < 64; o <<= 1) { const unsigned t = __shfl_up(cum, o); if (lane >= o) cum += t; }
            if (lane == 63) wtot[hw] = cum;
            __syncthreads();
            {
                unsigned off = 0u;
#pragma unroll
                for (int w = 0; w < 4; ++w) if (w < hw) off += wtot[w];
                cum += off;
                if (cum >= kk && cum - hv < kk) { bc[0] = 255u - (unsigned)ht; bc[1] = kk - (cum - hv); }
            }
            __syncthreads();
            prefix |= bc[0] << shift; mask |= 255u << shift; kk = bc[1];
        }
        unsigned cg = 0u, ce = 0u;
        if (valid) {
#pragma unroll
            for (int q = 0; q < 8; ++q) if (q < per) { cg += u[q] > prefix ? 1u : 0u; ce += u[q] == prefix ? 1u : 0u; }
        }
        unsigned pk = cg | (ce << 16), inc = pk;
#pragma unroll
        for (int o = 1; o < 64; o <<= 1) { const unsigned t = __shfl_up(inc, o); if (lane >= o) inc += t; }
        __syncthreads();
        if (lane == 63) wtot[hw] = inc;
        __syncthreads();
        unsigned off = 0u;
#pragma unroll
        for (int w = 0; w < 4; ++w) if (w < hw) off += wtot[w];
        unsigned excl = inc - pk + off, gb = excl & 0xffffu, eb = excl >> 16;
        if (valid) {
#pragma unroll
            for (int q = 0; q < 8; ++q) if (q < per) {
                const int i = ht * per + q, row = b * P + pos0 + i;
                const bool gt = u[q] > prefix, eq = u[q] == prefix, sel = gt || (eq && eb < kk);
                if (sel) { const int slot = slot0 + (int)(gb + (eb < kk ? eb : kk)); F.SEL[e * SLOTS + slot] = row; F.GATE[e * SLOTS + slot] = __uint_as_float(u[q]); F.INV[(size_t)row * NE + e] = slot; }
                else F.INV[(size_t)row * NE + e] = -1;
                gb += gt ? 1u : 0u; eb += eq ? 1u : 0u;
            }
        }
        __syncthreads();
    }
    __syncthreads();
}

typedef short bf16x8 __attribute__((ext_vector_type(8)));
typedef float f32x16 __attribute__((ext_vector_type(16)));
#define MFMA32(a, b, c) __builtin_amdgcn_mfma_f32_32x32x16_bf16((a), (b), (c), 0, 0, 0)
__device__ __forceinline__ int kperm(int m) { return (m & 0x13) | ((m & 8) >> 1) | ((m & 4) << 1); }
__device__ __forceinline__ bf16x8 pack8(const f32x16& x, int s8) {
    u32x4 p; p.x = pkbf(x[s8 + 0], x[s8 + 1]); p.y = pkbf(x[s8 + 2], x[s8 + 3]); p.z = pkbf(x[s8 + 4], x[s8 + 5]); p.w = pkbf(x[s8 + 6], x[s8 + 7]);
    return __builtin_bit_cast(bf16x8, p);
}
constexpr float LOG2E = 1.4426950408889634f;

__device__ __forceinline__ void ph_da_attn(const Frame& F) {
    const bf16* Q = (const bf16*)(F.ws + WS_Q); const bf16* K = (const bf16*)(F.ws + WS_K); const bf16* VT = (const bf16*)(F.ws + WS_VT); bf16* O = (bf16*)(F.ws + WS_O);
    const int tid = F.tid, lane = F.lane, l32 = lane & 31, hh = lane >> 5, map = F.wave & 1, qsub = F.wave >> 1;
    const float* lam = F.in[22];
    const float lam_full = expf(wave_sum(lam[lane] * lam[64 + lane])) - expf(wave_sum(lam[128 + lane] * lam[192 + lane])) + LAM_INIT;
    constexpr int KB = 64 * 144, VB = 128 * 144, BUF = 2 * KB + VB;
    unsigned char* sb = F.lds;
    float* xch = (float*)(F.lds + 2 * BUF) + qsub * 4096;
    const float c = 0.125f * LOG2E;
    const int kr = (tid >> 3) & 63, kc = tid & 7, vd = tid >> 3, vc = tid & 7;
    const int kdst = kr * 144 + kc * 16, vdst = 2 * KB + vd * 144 + vc * 16;
    const int kfrag = map * KB + kperm(l32) * 144 + hh * 16, vfrag = 2 * KB + l32 * 144 + hh * 16;
    const int vb = (F.nb & 7) == 0 ? (F.bid & 7) * (F.nb >> 3) + (F.bid >> 3) : F.bid;
    for (int it = vb; it < 4096 + 512; it += F.nb) {
        int b, h, pos0, nst;
        if (it < 4096) { b = it >> 7; h = (it >> 4) & 7; pos0 = NCTX + (it & 15) * 128 + qsub * 32; nst = P / 64; }
        else { const int j = it - 4096; b = j >> 4; h = (j >> 1) & 7; pos0 = (j & 1) * 128 + qsub * 32; nst = NCTX / 64; }
        const size_t qrow = (size_t)b * P + pos0 + l32;
        bf16x8 qf[4];
#pragma unroll
        for (int ks = 0; ks < 4; ++ks) qf[ks] = *(const bf16x8*)(Q + qrow * D + h * 128 + map * 64 + ks * 16 + hh * 8);
        f32x16 o[4];
#pragma unroll
        for (int dt = 0; dt < 4; ++dt)
#pragma unroll
            for (int j = 0; j < 16; ++j) o[dt][j] = 0.f;
        float m = 0.f, l = 0.f;
        const bf16* kg = K + ((size_t)b * P + kr) * D + h * 128 + kc * 8;
        const bf16* vg = VT + ((size_t)b * D + h * 128 + vd) * P + vc * 8;
        u32x4 ka0, ka1, va0, va1;
        { const u32x4 k0 = *(const u32x4*)kg, k1 = *(const u32x4*)(kg + 64), v0 = *(const u32x4*)vg, v1 = *(const u32x4*)(vg + (size_t)64 * P);
          const bf16* kq = kg + (size_t)64 * D; const bf16* vq = vg + 64;
          ka0 = *(const u32x4*)kq; ka1 = *(const u32x4*)(kq + 64); va0 = *(const u32x4*)vq; va1 = *(const u32x4*)(vq + (size_t)64 * P);
          *(u32x4*)(sb + kdst) = k0; *(u32x4*)(sb + KB + kdst) = k1; *(u32x4*)(sb + vdst) = v0; *(u32x4*)(sb + vdst + 64 * 144) = v1; }
        __syncthreads();
#pragma unroll 1
        for (int st = 0; st < nst; ++st) {
            const unsigned char* cb = sb + (st & 1) * BUF;
            u32x4 kn0 = (u32x4){0u, 0u, 0u, 0u}, kn1 = kn0, vn0 = kn0, vn1 = kn0;
            if (st + 2 < nst) { const bf16* kq = kg + (size_t)(st + 2) * 64 * D; const bf16* vq = vg + (st + 2) * 64;
                kn0 = *(const u32x4*)kq; kn1 = *(const u32x4*)(kq + 64); vn0 = *(const u32x4*)vq; vn1 = *(const u32x4*)(vq + (size_t)64 * P); }
#pragma unroll
            for (int sub = 0; sub < 2; ++sub) {
                f32x16 s;
#pragma unroll
                for (int j = 0; j < 16; ++j) s[j] = -m;
#pragma unroll
                for (int ks = 0; ks < 4; ++ks) s = MFMA32(*(const bf16x8*)(cb + kfrag + sub * 32 * 144 + ks * 32), qf[ks], s);
                float mx = s[0];
#pragma unroll
                for (int j = 1; j < 16; ++j) mx = fmaxf(mx, s[j]);
                mx = fmaxf(mx, __shfl_xor(mx, 32));
                const bool first = st == 0 && sub == 0;
                if (first || __any(mx > 8.0f)) {
                    const float d = first ? mx : fmaxf(mx, 0.f);
                    if (!first) { const float alpha = __builtin_amdgcn_exp2f(-d); l *= alpha;
#pragma unroll
                        for (int dt = 0; dt < 4; ++dt)
#pragma unroll
                            for (int j = 0; j < 16; ++j) o[dt][j] *= alpha; }
                    m += d;
#pragma unroll
                    for (int j = 0; j < 16; ++j) s[j] -= d;
                }
                float ps = 0.f;
#pragma unroll
                for (int j = 0; j < 16; ++j) { s[j] = __builtin_amdgcn_exp2f(s[j]); ps += s[j]; }
                l += ps;
                const bf16x8 p0 = pack8(s, 0), p1 = pack8(s, 8);
#pragma unroll
                for (int dt = 0; dt < 4; ++dt) { o[dt] = MFMA32(*(const bf16x8*)(cb + vfrag + dt * 32 * 144 + sub * 64), p0, o[dt]); o[dt] = MFMA32(*(const bf16x8*)(cb + vfrag + dt * 32 * 144 + sub * 64 + 32), p1, o[dt]); }
            }
            if (st + 1 < nst) { unsigned char* nb = sb + ((st + 1) & 1) * BUF; *(u32x4*)(nb + kdst) = ka0; *(u32x4*)(nb + KB + kdst) = ka1; *(u32x4*)(nb + vdst) = va0; *(u32x4*)(nb + vdst + 64 * 144) = va1; }
            ka0 = kn0; ka1 = kn1; va0 = vn0; va1 = vn1;
            __syncthreads();
        }
        l += __shfl_xor(l, 32);
        const float inv = 1.0f / l;
        if (map == 1) {
#pragma unroll
            for (int dt = 0; dt < 4; ++dt)
#pragma unroll
                for (int j = 0; j < 16; ++j) xch[(dt * 16 + j) * 64 + lane] = o[dt][j] * inv * lam_full;
        }
        __syncthreads();
        if (map == 0) {
            float ss = 0.f;
#pragma unroll
            for (int dt = 0; dt < 4; ++dt)
#pragma unroll
                for (int j = 0; j < 16; ++j) { const float v = o[dt][j] * inv - xch[(dt * 16 + j) * 64 + lane]; o[dt][j] = v; ss += v * v; }
            ss += __shfl_xor(ss, 32);
            const float rinv = rsqrtf(ss * (1.0f / 128.0f) + EPS) * (1.0f - LAM_INIT);
#pragma unroll
            for (int dt = 0; dt < 4; ++dt)
#pragma unroll
                for (int jq = 0; jq < 4; ++jq) {
                    const int d0 = dt * 32 + jq * 8 + hh * 4; const f32x4 sw = *(const f32x4*)(F.in[23] + d0);
                    u32x2 w; w.x = pkbf(o[dt][jq * 4 + 0] * rinv * sw.x, o[dt][jq * 4 + 1] * rinv * sw.y); w.y = pkbf(o[dt][jq * 4 + 2] * rinv * sw.z, o[dt][jq * 4 + 3] * rinv * sw.w);
                    *(u32x2*)(O + qrow * D + h * 128 + d0) = w;
                }
        }
        __syncthreads();
    }
}

__device__ __forceinline__ void ph_na_attn(const Frame& F) {
    const bf16* Q = (const bf16*)(F.ws + WS_Q); const bf16* K = (const bf16*)(F.ws + WS_K); const bf16* VT = (const bf16*)(F.ws + WS_VT); bf16* O = (bf16*)(F.ws + WS_O);
    const int tid = F.tid, lane = F.lane, l32 = lane & 31, hh = lane >> 5;
    constexpr int KB = 128 * 144, VP = 272, VB = 64 * VP, BUF = KB + VB;
    unsigned char* sb = F.lds;
    float* rp = (float*)(F.lds + 2 * BUF) + 64;
    for (int i = tid; i < 16 * 15 * 31 + 128; i += NTHREADS) { const int k = i - 64; rp[k] = (k >= 0 && k < 16 * 15 * 31) ? F.in[19][k] * LOG2E : 0.f; }
    __syncthreads();
    const float c = 0.125f * LOG2E;
    const int pr = tid >> 3, pc = tid & 7;
    const int kdst = pr * 144 + pc * 16, vdst = KB + pr * VP + pc * 16;
    const int kfrag = kperm(l32) * 144 + hh * 16, vfrag = KB + l32 * VP + hh * 16;
    const int vb = (F.nb & 7) == 0 ? (F.bid & 7) * (F.nb >> 3) + (F.bid >> 3) : F.bid;
    for (int it = vb; it < 4096 + 512; it += F.nb) {
        int b, h, r = 0, cq = 0, kc0 = 0, rlo = 0, rhi = 0, wr0 = 0, wr1 = 0, nt; bool lat; size_t qrow;
        if (it < 4096) { lat = true; b = it >> 7; h = (it >> 3) & 15; const int rg = ((it & 7) + (it >> 8)) & 7  ;
            const int rw = rg * 4 + (F.wave >> 2) * 2, cqt = F.wave & 3; r = rw + (l32 >> 4); cq = cqt * 16 + (l32 & 15); kc0 = min(max(cqt * 16 - 8, 0), 32);
            wr0 = min(max(rw - 4, 0), 24); wr1 = min(max(rw + 1 - 4, 0), 24) + 8;
            qrow = (size_t)b * P + NCTX + r * 64 + cq;
            rlo = min(max(rg * 4 - 4, 0), 24); rhi = min(max(rg * 4 + 3 - 4, 0), 24) + 7; nt = 2 + (rhi - rlo + 2) / 2; }
        else { lat = false; const int j = it - 4096; b = j >> 4; h = j & 15; qrow = (size_t)b * P + F.wave * 32 + l32; nt = 2; }
        const int r0 = min(max(r - 4, 0), 24), c0 = min(max(cq - 8, 0), 48);
        bf16x8 qf[4];
#pragma unroll
        for (int ks = 0; ks < 4; ++ks) qf[ks] = *(const bf16x8*)(Q + qrow * D + h * 64 + ks * 16 + hh * 8);
        float neg[16];
#pragma unroll
        for (int j = 0; j < 16; ++j) { const int kcol = kc0 + 16 * (j >> 3) + 8 * hh + 4 * ((j >> 2) & 1) + (j & 3); neg[j] = (kcol >= c0 && kcol < c0 + 16) ? 0.f : -1.0e30f; }
        f32x16 o[2];
#pragma unroll
        for (int dt = 0; dt < 2; ++dt)
#pragma unroll
            for (int j = 0; j < 16; ++j) o[dt][j] = 0.f;
        float m = -1.0e30f, l = 0.f;
        const bf16* kg = K + ((size_t)b * P + pr) * D + h * 64 + pc * 8;
        const bf16* vg = VT + ((size_t)b * D + h * 64 + pr) * P + pc * 8;
#define NA_KEYA(st) ((st) < 2 ? (st) * 128 : NCTX + (rlo + 2 * ((st) - 2)) * 64)
#define NA_KEYB(st) ((st) < 2 ? (st) * 128 + 64 : NCTX + min(rlo + 2 * ((st) - 2) + 1, 31) * 64)
#define NA_LOAD(dk0, dk1, dv0, dv1, st) do { const int ka_ = NA_KEYA(st), kb_ = NA_KEYB(st); dk0 = *(const u32x4*)(kg + (size_t)ka_ * D); dk1 = *(const u32x4*)(kg + (size_t)kb_ * D); \
        dv0 = *(const u32x4*)(vg + ka_); dv1 = *(const u32x4*)(vg + kb_); } while (0)
#define NA_STORE(buf, sk0, sk1, sv0, sv1) do { *(u32x4*)((buf) + kdst) = sk0; *(u32x4*)((buf) + kdst + 64 * 144) = sk1; *(u32x4*)((buf) + vdst) = sv0; *(u32x4*)((buf) + vdst + 128) = sv1; } while (0)
        u32x4 ka0, ka1, va0, va1;
        { u32x4 x0, x1, y0, y1; NA_LOAD(x0, x1, y0, y1, 0); NA_LOAD(ka0, ka1, va0, va1, 1); NA_STORE(sb, x0, x1, y0, y1); }
        __syncthreads();
#pragma unroll 1
        for (int st = 0; st < nt; ++st) {
            const unsigned char* cbuf = sb + (st & 1) * BUF;
            u32x4 kn0 = (u32x4){0u, 0u, 0u, 0u}, kn1 = kn0, vn0 = kn0, vn1 = kn0;
            if (st + 2 < nt) NA_LOAD(kn0, kn1, vn0, vn1, st + 2);
#define NA_TILE(KO_, WIN_, KROW_) do { const int ko = (KO_); \
                f32x16 s; \
                _Pragma("unroll") for (int j = 0; j < 16; ++j) s[j] = 0.f; \
                _Pragma("unroll") for (int ks = 0; ks < 4; ++ks) s = MFMA32(*(const bf16x8*)(cbuf + kfrag + ko * 144 + ks * 32), qf[ks], s); \
                if (WIN_) { const int krow = (KROW_); \
                    const float rmask = (krow >= r0 && krow < r0 + 8) ? 0.f : -1.0e30f;        \
                    const float* rph = rp + (h * 15 + (krow - r + 7)) * 31 - cq + 15 + 8 * hh + kc0;       \
                    _Pragma("unroll") for (int j = 0; j < 16; ++j) s[j] = (s[j] * c + rph[16 * (j >> 3) + 4 * ((j >> 2) & 1) + (j & 3)]) + (neg[j] + rmask); \
                } else { _Pragma("unroll") for (int j = 0; j < 16; ++j) s[j] *= c; } \
                float mx = s[0]; \
                _Pragma("unroll") for (int j = 1; j < 16; ++j) mx = fmaxf(mx, s[j]); \
                mx = fmaxf(mx, __shfl_xor(mx, 32)); \
                if (__any(mx > m + 8.0f)) { \
                    const float mn = fmaxf(m, mx), alpha = __builtin_amdgcn_exp2f(m - mn); m = mn; l *= alpha; \
                    _Pragma("unroll") for (int dt = 0; dt < 2; ++dt) _Pragma("unroll") for (int j = 0; j < 16; ++j) o[dt][j] *= alpha; \
                } \
                f32x2 ps2 = {0.f, 0.f}; \
                _Pragma("unroll") for (int j = 0; j < 16; j += 2) { f32x2 t = {s[j], s[j + 1]}; t = t - (f32x2){m, m}; t.x = __builtin_amdgcn_exp2f(t.x); t.y = __builtin_amdgcn_exp2f(t.y); s[j] = t.x; s[j + 1] = t.y; ps2 += t; } \
                l += ps2.x + ps2.y; \
                const bf16x8 p0 = pack8(s, 0), p1 = pack8(s, 8); \
                _Pragma("unroll") for (int dt = 0; dt < 2; ++dt) { o[dt] = MFMA32(*(const bf16x8*)(cbuf + vfrag + dt * 32 * VP + ko * 2), p0, o[dt]); o[dt] = MFMA32(*(const bf16x8*)(cbuf + vfrag + dt * 32 * VP + ko * 2 + 32), p1, o[dt]); } \
            } while (0)
            if (st < 2) {
#pragma unroll
                for (int sub = 0; sub < 4; ++sub) NA_TILE(sub * 32, false, 0);
            } else {
#pragma unroll
                for (int half = 0; half < 2; ++half) { const int krw = rlo + 2 * (st - 2) + half;
                    if (krw <= rhi && krw >= wr0 && krw < wr1) NA_TILE(half * 64 + kc0, true, krw); }
            }
#undef NA_TILE
            if (st + 1 < nt) { unsigned char* nb = sb + ((st + 1) & 1) * BUF; NA_STORE(nb, ka0, ka1, va0, va1); }
            ka0 = kn0; ka1 = kn1; va0 = vn0; va1 = vn1;
            __syncthreads();
        }
#undef NA_KEYA
#undef NA_KEYB
#undef NA_LOAD
#undef NA_STORE
        l += __shfl_xor(l, 32);
        const float inv = 1.0f / l;
#pragma unroll
        for (int dt = 0; dt < 2; ++dt)
#pragma unroll
            for (int jq = 0; jq < 4; ++jq) {
                const int d0 = dt * 32 + jq * 8 + hh * 4;
                u32x2 w; w.x = pkbf(o[dt][jq * 4 + 0] * inv, o[dt][jq * 4 + 1] * inv); w.y = pkbf(o[dt][jq * 4 + 2] * inv, o[dt][jq * 4 + 3] * inv);
                *(u32x2*)(O + qrow * D + h * 64 + d0) = w;
            }
    }
    __syncthreads();
}

__device__ __forceinline__ f32x4 unpk4(u32x2 w) { return (f32x4){bflo(w.x), bfhi(w.x), bflo(w.y), bfhi(w.y)}; }
__device__ __forceinline__ bf16 bf1(float x) { return (bf16)(pkbf(x, 0.f) & 0xffffu); }
__device__ __forceinline__ f32x4 shx32(f32x4 v) { return (f32x4){__shfl_xor(v.x, 32), __shfl_xor(v.y, 32), __shfl_xor(v.z, 32), __shfl_xor(v.w, 32)}; }
template <int DIR>
__device__ __forceinline__ void hgrn_seq(const Frame& F, int b, int h, int eb) {
    const bf16* ZIN = (const bf16*)(F.ws + WS_ZIN); const bf16* VTG = (const bf16*)(F.ws + WS_VTG); bf16* OUT = (bf16*)(F.ws + (DIR ? WS_OFB : WS_OFF));
    const int lane = F.lane, l32 = lane & 31, hh = lane >> 5, cperm = kperm(l32);
    constexpr int IMG = 32 * 136 * 2, KTB = 128 * 80, DBUF = 2 * IMG + KTB + 512;
    unsigned char* dbase = F.lds + DIR * 2 * DBUF;
    const int tg = lane & 7, prho = 8 * eb + (lane >> 3), pc = kperm(prho);
    f32x16 S[4];
#pragma unroll
    for (int d = 0; d < 4; ++d)
#pragma unroll
        for (int j = 0; j < 16; ++j) S[d][j] = 0.f;
    const bf16* vbase = VTG + ((size_t)b * D + h * 128 + eb * 32 + l32) * P + hh * 8;
    const bf16* zp = ZIN + ((size_t)b * P + 4 * tg) * 4096 + h * 128 + 4 * prho;
#define HG_CHUNK(i_) (DIR == 0 ? (i_) : ((i_) < 8 ? 7 - (i_) : 79 - (i_)))
#define HG_LOAD(i_) do { const int c_ = HG_CHUNK(i_); const bf16* z_ = zp + (size_t)c_ * 32 * 4096; \
        _Pragma("unroll") for (int i = 0; i < 4; ++i) { nlf[i] = *(const u32x2*)(z_ + (size_t)i * 4096 + (1 + DIR) * D); nq[i] = *(const u32x2*)(z_ + (size_t)i * 4096); } \
        nv0 = *(const bf16x8*)(vbase + c_ * 32); nv1 = *(const bf16x8*)(vbase + c_ * 32 + 16); } while (0)
    u32x2 nlf[4], nq[4]; bf16x8 nv0, nv1;
    HG_LOAD(0);
#pragma unroll 1
    for (int idx = 0; idx < 72; ++idx) {
        const int cc = HG_CHUNK(idx);
        const size_t row0 = (size_t)b * P + cc * 32;
        unsigned char* buf = dbase + (idx & 1) * DBUF;
        bf16* Qp = (bf16*)buf; bf16* Kp = (bf16*)(buf + IMG); bf16* KT = (bf16*)(buf + 2 * IMG); float* egl = (float*)(buf + 2 * IMG + KTB);
        u32x2 lfc[4], qc[4];
#pragma unroll
        for (int i = 0; i < 4; ++i) { lfc[i] = nlf[i]; qc[i] = nq[i]; }
        const bf16x8 vf0 = nv0, vf1 = nv1;
        HG_LOAD(min(idx + 1, 71));
        f32x4 l4[4], t = (f32x4){0.f, 0.f, 0.f, 0.f};
#pragma unroll
        for (int i = 0; i < 4; ++i) { l4[i] = unpk4(lfc[i]); t += l4[i]; }
        f32x4 x = t;
#pragma unroll
        for (int k = 1; k < 8; k <<= 1) { const f32x4 y = (f32x4){__shfl_up(x.x, k, 8), __shfl_up(x.y, k, 8), __shfl_up(x.z, k, 8), __shfl_up(x.w, k, 8)}; if (tg >= k) x += y; }
        const f32x4 tot = (f32x4){__shfl(x.x, 7, 8), __shfl(x.y, 7, 8), __shfl(x.z, 7, 8), __shfl(x.w, 7, 8)};
        const f32x4 off = DIR == 0 ? x - t : tot - x;
        f32x4 eg = (f32x4){__builtin_amdgcn_exp2f(off.x), __builtin_amdgcn_exp2f(off.y), __builtin_amdgcn_exp2f(off.z), __builtin_amdgcn_exp2f(off.w)}; float kv[4][4];
#pragma unroll
        for (int ii = 0; ii < 4; ++ii) {
            const int i = DIR ? 3 - ii : ii;
            const f32x4 lf = l4[i], q4 = unpk4(qc[i]);
            const int srow = (4 * tg + i) * 136 + pc;
#pragma unroll
            for (int d = 0; d < 4; ++d) { const float f = __builtin_amdgcn_exp2f(lf[d]); eg[d] *= f; const float kq = (1.0f - f) * __builtin_amdgcn_rcpf(eg[d]);
                Qp[srow + d * 32] = bf1(q4[d] * eg[d]); Kp[srow + d * 32] = bf1(kq); kv[d][i] = kq; }
        }
#pragma unroll
        for (int d = 0; d < 4; ++d) { u32x2 w; w.x = pkbf(kv[d][0], kv[d][1]); w.y = pkbf(kv[d][2], kv[d][3]); *(u32x2*)(KT + (d * 32 + prho) * 40 + 4 * tg) = w; }
        if (tg == 0) *(f32x4*)(egl + 4 * prho) = (f32x4){__builtin_amdgcn_exp2f(tot.x), __builtin_amdgcn_exp2f(tot.y), __builtin_amdgcn_exp2f(tot.z), __builtin_amdgcn_exp2f(tot.w)};
        __syncthreads();
        bf16x8 kf[4][2];
#pragma unroll
        for (int d = 0; d < 4; ++d)
#pragma unroll
            for (int sg = 0; sg < 2; ++sg) kf[d][sg] = *(const bf16x8*)(KT + (d * 32 + l32) * 40 + sg * 16 + 8 * hh);
        if (cc >= NCTX / 32) {
        f32x16 att, o;
#pragma unroll
        for (int j = 0; j < 16; ++j) { att[j] = 0.f; o[j] = 0.f; }
        const bf16* krow = Kp + cperm * 136 + hh * 8; const bf16* qrow = Qp + l32 * 136 + hh * 8;
#pragma unroll
        for (int ks = 0; ks < 8; ++ks) { att = MFMA32(*(const bf16x8*)(krow + ks * 16), *(const bf16x8*)(qrow + ks * 16), att);
            o = MFMA32(pack8(S[ks >> 1], (ks & 1) * 8), *(const bf16x8*)(qrow + (ks >> 1) * 32 + (ks & 1) * 16), o); }
#pragma unroll
        for (int j = 0; j < 16; ++j) { const int sa = 16 * (j >> 3) + 8 * hh + 4 * ((j >> 2) & 1) + (j & 3); const bool keep = DIR == 0 ? (sa <= l32) : (sa >= l32); att[j] = keep ? att[j] : 0.f; }
        const bf16x8 p0 = pack8(att, 0), p1 = pack8(att, 8);
        o = MFMA32(vf0, p0, o); o = MFMA32(vf1, p1, o);
        bf16* op = OUT + (row0 + l32) * D + h * 128 + eb * 32 + 4 * hh;
#pragma unroll
        for (int jq = 0; jq < 4; ++jq) { u32x2 w; w.x = pkbf(o[4 * jq], o[4 * jq + 1]); w.y = pkbf(o[4 * jq + 2], o[4 * jq + 3]); *(u32x2*)(op + 8 * jq) = w; }
        }
#pragma unroll
        for (int d = 0; d < 4; ++d) { S[d] = MFMA32(kf[d][0], vf0, S[d]); S[d] = MFMA32(kf[d][1], vf1, S[d]); }
#pragma unroll
        for (int j = 0; j < 16; ++j) { const int rho = (j & 3) + 8 * (j >> 2) + 4 * hh; const f32x4 e4 = *(const f32x4*)(egl + 4 * rho);
            S[0][j] *= e4.x; S[1][j] *= e4.y; S[2][j] *= e4.z; S[3][j] *= e4.w; }
    }
#undef HG_LOAD
#undef HG_CHUNK
}
__device__ __forceinline__ void ph_hgrn_scan(const Frame& F) {
    for (int id = F.bid * NWAVES + F.wave; id < NB * 8 * 8; id += F.nb * NWAVES) {
        const int eb = id & 3, dir = (id >> 2) & 1, h = (id >> 3) & 7, b = id >> 6;
        if (dir == 0) hgrn_seq<0>(F, b, h, eb); else hgrn_seq<1>(F, b, h, eb);
    }
}
__device__ __forceinline__ void ph_hgrn_post(const Frame& F) {
    const bf16* ZIN = (const bf16*)(F.ws + WS_ZIN); const bf16* OFF = (const bf16*)(F.ws + WS_OFF); const bf16* OFB = (const bf16*)(F.ws + WS_OFB); bf16* O2 = (bf16*)(F.ws + WS_O2);
    const int lane = F.lane, part = lane & 7;
    f32x4 gn[4];
#pragma unroll
    for (int q = 0; q < 4; ++q) gn[q] = *(const f32x4*)(F.in[26] + part * 16 + q * 4);
    for (int row = F.bid * NWAVES + F.wave; row < R; row += F.nb * NWAVES) {
        if (row % P < NCTX) continue;
        const size_t o = (size_t)row * D + lane * 16;
        const u32x4 a0 = *(const u32x4*)(OFF + o), a1 = *(const u32x4*)(OFF + o + 8), b0 = *(const u32x4*)(OFB + o), b1 = *(const u32x4*)(OFB + o + 8);
        const u32x4 g0 = *(const u32x4*)(ZIN + (size_t)row * 4096 + 3 * D + lane * 16), g1 = *(const u32x4*)(ZIN + (size_t)row * 4096 + 3 * D + lane * 16 + 8);
        float v[16];
        v[0] = bflo(a0.x) + bflo(b0.x); v[1] = bfhi(a0.x) + bfhi(b0.x); v[2] = bflo(a0.y) + bflo(b0.y); v[3] = bfhi(a0.y) + bfhi(b0.y);
        v[4] = bflo(a0.z) + bflo(b0.z); v[5] = bfhi(a0.z) + bfhi(b0.z); v[6] = bflo(a0.w) + bflo(b0.w); v[7] = bfhi(a0.w) + bfhi(b0.w);
        v[8] = bflo(a1.x) + bflo(b1.x); v[9] = bfhi(a1.x) + bfhi(b1.x); v[10] = bflo(a1.y) + bflo(b1.y); v[11] = bfhi(a1.y) + bfhi(b1.y);
        v[12] = bflo(a1.z) + bflo(b1.z); v[13] = bfhi(a1.z) + bfhi(b1.z); v[14] = bflo(a1.w) + bflo(b1.w); v[15] = bfhi(a1.w) + bfhi(b1.w);
        float ss = 0.f;
#pragma unroll
        for (int q = 0; q < 16; ++q) ss += v[q] * v[q];
        ss += dpp_xor1(ss); ss += dpp_xor2(ss); ss += __shfl_xor(ss, 4);
        const float rinv = rsqrtf(ss * (1.0f / 128.0f) + EPS);
        const unsigned gw[8] = {g0.x, g0.y, g0.z, g0.w, g1.x, g1.y, g1.z, g1.w};
        unsigned w[8];
#pragma unroll
        for (int q = 0; q < 8; ++q) w[q] = pkbf(v[2 * q] * rinv * gn[q >> 1][(2 * q) & 3] * bflo(gw[q]), v[2 * q + 1] * rinv * gn[q >> 1][(2 * q + 1) & 3] * bfhi(gw[q]));
        *(u32x4*)(O2 + o) = (u32x4){w[0], w[1], w[2], w[3]}; *(u32x4*)(O2 + o + 8) = (u32x4){w[4], w[5], w[6], w[7]};
    }
}

enum { PH_BASE = __COUNTER__ };
__global__ void __launch_bounds__(NTHREADS, 2) fwd(Args args) {
    extern __shared__ __attribute__((aligned(16))) unsigned char lds[];
    Frame F;
    F.lds = lds; F.wave = __builtin_amdgcn_readfirstlane((int)threadIdx.x >> 6); F.bid = blockIdx.x; F.nb = gridDim.x;
    REFRESH_(F);
    F.in = args.in; F.out = args.out; F.ws = args.ws;
    F.MOD = (float*)(args.ws + WS_MOD); F.AFF = (float*)(args.ws + WS_AFF); F.SEL = (int*)(args.ws + WS_SEL); F.GATE = (float*)(args.ws + WS_GATE); F.INV = (int*)(args.ws + WS_INV);
    F.X = (bf16*)(args.ws + WS_X); F.H = (bf16*)(args.ws + WS_H);
    const int lo = args.ph_lo, hi = args.ph_hi;
#if MK_SINGLE
    volatile LAS unsigned* misc = (volatile LAS unsigned*)((LAS unsigned char*)lds + LDS_MISC);
    if (F.tid < 64) misc[F.tid] = 0u;
    __syncthreads();
    XcdBarrier bar = xcd_barrier_post((unsigned*)(args.ws + WS_CTL) + CW_BAR, misc, F.tid);
#define SEAM(k) do { if ((k) + 1 < hi) xcd_barrier(bar, F.tid); } while (0)
#else
#define SEAM(k) do { } while (0)
#endif
#define PH(...) do { constexpr int k_ = __COUNTER__ - PH_BASE - 1; if (lo <= k_ && k_ < hi) { REFRESH_(F); __VA_ARGS__; SEAM(k_); } } while (0)
    bf16* HID = (bf16*)(F.ws + WS_HID); bf16* Y = (bf16*)(F.ws + WS_Y);
    PG8_LAS unsigned char* ring = (PG8_LAS unsigned char*)lds;
    bf16 *Qb = (bf16*)(F.ws + WS_Q), *VTb = (bf16*)(F.ws + WS_VT), *Ob = (bf16*)(F.ws + WS_O);

#define GEMM_PHASE(EPI, gA, lda_, gB, ldb_, gK, nM_, nN_, groups_, gsM_, ...) do { const pg8::Gemm g_{(const bf16*)(gA), (const bf16*)(gB), (lda_), (ldb_), (gK), nullptr}; pg8::GroupedOrder S_; S_.init((nM_), (nN_), (groups_), (gsM_), F.nb, F.bid); \
        const EPI E_{__VA_ARGS__}; pg8::gemm_phase<EPI, pg8::GroupedOrder, PG8_ALIGN, PG8_SP2>(ring, g_, S_, E_, F.tid); } while (0)
#define GEMM_PHASE_LAT(EPI, gA, lda_, gB, ldb_, gK, nN_, ...) do { const pg8::Gemm g_{(const bf16*)(gA), (const bf16*)(gB), (lda_), (ldb_), (gK), nullptr}; pg8::LatentOrder S_; S_.init((nN_), F.nb, F.bid); \
        const EPI E_{__VA_ARGS__}; pg8::gemm_phase<EPI, pg8::LatentOrder, PG8_ALIGN, PG8_SP2>(ring, g_, S_, E_, F.tid); } while (0)
#define GEMM_PHASE_GATHER(EPI, gA, lda_, gIdx, gB, ldb_, gK, nM_, nN_, groups_, gsM_, ...) do { const pg8::Gemm g_{(const bf16*)(gA), (const bf16*)(gB), (lda_), (ldb_), (gK), (gIdx)}; pg8::GroupedOrder S_; S_.init((nM_), (nN_), (groups_), (gsM_), F.nb, F.bid); \
        const EPI E_{__VA_ARGS__}; pg8::gemm_phase<EPI, pg8::GroupedOrder, PG8_ALIGN, PG8_SP2, true>(ring, g_, S_, E_, F.tid); } while (0)
#define MODL(L) (F.MOD + (size_t)(L) * 33 * 6144)
#define MOE_PHASES(L, NMT, NITEMS, SKIPC) \
    PH(ph_norm2<SKIPC>(F, (L))); \
    PH(ph_topk(F, (NITEMS))); \
    PH(GEMM_PHASE_GATHER(pg8::EpiSwigluT, F.H, D, F.SEL, F.ws + WO_GU, D, D, (NMT), 2 * FF / 256, NE, SLOTS / 256, HID, 2 * FF / 256, FF)); \
    PH(GEMM_PHASE(pg8::EpiDownT, HID, FF, F.ws + WO_DN, FF, FF, (NMT), D / 256, NE, SLOTS / 256, Y, F.GATE, D / 256));
#define OUT_PROJ(Asrc, Wsrc, L) PH(GEMM_PHASE(pg8::EpiResidT, (Asrc), D, (Wsrc), D, D, R / 256, D / 256, 1, R / 256, F.X, MODL(L)));

    PH(ph_prologue(F));
    PH(ph_norm<0, false, true, false, true>(F, 0, 0));
    PH(GEMM_PHASE(pg8::EpiF32G, F.ws + WS_AG, 768, F.ws + WS_S5W1, 512, 512, 2304 / 256, 1, 64, 2304 / 256, (float*)(F.ws + WS_SS), 256, 1));
    PH(ph_s5_scan(F));
    PH(GEMM_PHASE(pg8::EpiS5Out, F.ws + WS_AG, 768, F.ws + WS_S5W2, 768, 768, 2304 / 256, 2, 64, 2304 / 256, F.H, (bf16*)(F.ws + WS_Z), F.in[15]));
    PH(GEMM_PHASE(pg8::EpiGluT, F.ws + WS_Z, D, F.ws + WO_GLU, D, D, R / 256, 2 * D / 256, 1, R / 256, F.X, MODL(0)));
    MOE_PHASES(0, SLOTS / 256, NB * NE * 2, false)
    PH(ph_norm<0, true>(F, 1, 0); convert_moe(F, 1));
    PH(GEMM_PHASE(pg8::EpiBf16<0>, F.H, D, F.ws + WO_NAQKV, D, D, R / 256, 2 * D / 256, 1, R / 256, Qb, D, nullptr, D, (size_t)(WS_K - WS_Q) / 2, 1.0f);
       GEMM_PHASE(pg8::EpiVtT<false>, F.ws + WO_NAQKV + (size_t)2 * D * D * 2, D, F.H, D, D, D / 256, R / 256, 1, D / 256, VTb));
    PH(ph_na_attn(F));
    OUT_PROJ(Ob, F.ws + WO_NAO, 1)
    MOE_PHASES(1, SLOTS / 256, NB * NE * 2, false)
    PH(ph_norm<0, true>(F, 2, 1); convert_moe(F, 2));
    PH({ LAS float* rt = (LAS float*)((LAS unsigned char*)F.lds + pg8::STAGE_BYTES + 4096);
         for (int i = F.tid; i < 2048; i += NTHREADS) rt[i] = ((const float*)(F.ws + WS_ROPE))[i];
         __syncthreads(); }
       GEMM_PHASE(pg8::EpiQKRope, F.H, D, F.ws + WO_DAQKV, D, D, R / 256, 2 * D / 256, 1, R / 256, Qb, (size_t)(WS_K - WS_Q) / 2, (const PG8_LAS float*)((LAS unsigned char*)F.lds + pg8::STAGE_BYTES + 4096));
       GEMM_PHASE(pg8::EpiVtT<false>, F.ws + WO_DAQKV + (size_t)2 * D * D * 2, D, F.H, D, D, D / 256, R / 256, 1, D / 256, VTb));
    PH(ph_da_attn(F));
    OUT_PROJ(Ob, F.ws + WO_DAO, 2)
    MOE_PHASES(2, SLOTS / 256, NB * NE * 2, false)
    PH(ph_norm<0, true>(F, 3, 2); convert_moe(F, 3));
    PH({ const pg8::Gemm g_{(const bf16*)F.H, (const bf16*)(F.ws + WO_HGIN), D, D, D, nullptr}; pg8::HgInOrder S_; S_.init(F.nb, F.bid);
         const pg8::EpiHgIn E_{(bf16*)(F.ws + WS_ZIN), (const float*)(F.ws + WS_LB)}; pg8::gemm_phase<pg8::EpiHgIn, pg8::HgInOrder, PG8_ALIGN, PG8_SP2>(ring, g_, S_, E_, F.tid); }
       GEMM_PHASE(pg8::EpiVtT<true>, F.ws + WO_HGIN + (size_t)4 * D * D * 2, D, F.H, D, D, D / 256, R / 256, 1, D / 256, (bf16*)(F.ws + WS_VTG)));
    PH(ph_hgrn_scan(F));
    PH(ph_hgrn_post(F));
    PH(GEMM_PHASE_LAT(pg8::EpiResidT, F.ws + WS_O2, D, F.ws + WO_HGO, D, D, D / 256, F.X, MODL(3)));
    MOE_PHASES(3, NB, NB * NE, true)
    PH(ph_norm<2, true, false, true>(F, 0, 3));
}
constexpr int NPH = __COUNTER__ - PH_BASE - 1;

extern "C" void kernel_launch(void* const* d_in, const int* in_sizes, int n_in, void* d_out, int out_size, void* d_ws, size_t ws_size, hipStream_t stream) {
    static int grid = 0;
    if (grid == 0) {
        if (n_in != 33 || ws_size < WS_NEED) { fprintf(stderr, "kernel_launch: n_in %d ws %zu (need %zu)\n", n_in, ws_size, (size_t)WS_NEED); grid = -1; return; }
        int dev = 0, cus = 0;
        if (hipGetDevice(&dev) != hipSuccess || hipDeviceGetAttribute(&cus, hipDeviceAttributeMultiprocessorCount, dev) != hipSuccess) { grid = -1; return; }
        if (hipFuncSetAttribute((const void*)fwd, hipFuncAttributeMaxDynamicSharedMemorySize, LDS_BYTES) != hipSuccess) { fprintf(stderr, "kernel_launch: hipFuncSetAttribute failed\n"); grid = -1; return; }
        int per_cu = 0;
        if (hipOccupancyMaxActiveBlocksPerMultiprocessor(&per_cu, (const void*)fwd, NTHREADS, LDS_BYTES) != hipSuccess || per_cu < 1) fprintf(stderr, "kernel_launch: occupancy query says %d\n", per_cu);
        (void)hipGetLastError();
        grid = cus;
    }
    if (grid < 0) return;
    (void)hipMemsetAsync((char*)d_ws + WS_CTL + (size_t)CW_BAR * 4, 0, (size_t)XCD_BAR_WORDS * 4, stream);
    Args a{};
    for (int i = 0; i < 33; ++i) a.in[i] = (const float*)d_in[i];
    a.out = (float*)d_out; a.ws = (unsigned char*)d_ws;
#if MK_SINGLE
    a.ph_lo = 0; a.ph_hi = NPH;
    hipLaunchKernelGGL(fwd, dim3(grid), dim3(NTHREADS), LDS_BYTES, stream, a);
#else
    for (int k = 0; k < NPH; ++k) { a.ph_lo = k; a.ph_hi = k + 1; hipLaunchKernelGGL(fwd, dim3(grid), dim3(NTHREADS), LDS_BYTES, stream, a); }
#endif
}
```

```cpp
#include <hip/hip_runtime.h>
#include <cstdio>
#include <cstdint>

#ifndef MK_SINGLE
#define MK_SINGLE 1
#endif

typedef unsigned short bf16;
typedef float f32x4 __attribute__((ext_vector_type(4)));
typedef float f32x2 __attribute__((ext_vector_type(2)));
typedef unsigned u32x2 __attribute__((ext_vector_type(2)));
typedef unsigned u32x4 __attribute__((ext_vector_type(4)));
#define LAS __attribute__((address_space(3)))

constexpr int NB = 32, SEQ = 2048, NCTX = 256, D = 1024, P = NCTX + SEQ  , R = NB * P  ;
constexpr int NE = 16, FF = 2048, SLOTS = NB * 256 + NB * 32  ;
constexpr float EPS = 1e-6f;
constexpr float LOG2E_ = 1.4426950408889634f;
constexpr float LAM_INIT = 0.47071302f;
constexpr int NWAVES = 8, NTHREADS = 512;
constexpr int LDS_BYTES = 147456;
constexpr int LDS_MISC = 147456 - 256;

constexpr size_t MiB = 1u << 20;
constexpr size_t WS_CTL = 0, CTL_ZERO_BYTES = 1 * MiB;
constexpr size_t WS_MOD = 1 * MiB;
constexpr size_t WS_AFF = 5 * MiB;
constexpr size_t WS_SEL = 10 * MiB;
constexpr size_t WS_GATE = 11 * MiB;
constexpr size_t WS_INV = 12 * MiB;
constexpr size_t WS_X = 32 * MiB;
constexpr size_t WS_H = 320 * MiB;
constexpr size_t WS_W = 464 * MiB;
constexpr size_t WS_BIG = 720 * MiB;
constexpr size_t WS_HID = WS_BIG;
constexpr size_t WS_Y = WS_BIG + 576 * MiB;
constexpr size_t WS_XS = WS_BIG + 864 * MiB;
constexpr size_t WS_AG = WS_BIG;
constexpr size_t WS_SS = WS_BIG + 216 * MiB;
constexpr size_t WS_Z = WS_BIG + 360 * MiB;
constexpr size_t WS_S5W1 = WS_BIG + 504 * MiB;
constexpr size_t WS_S5W2 = WS_BIG + 520 * MiB;
constexpr size_t WS_S5A = WS_BIG + 568 * MiB;
constexpr size_t WS_Q = WS_BIG, WS_K = WS_BIG + 144 * MiB, WS_V = WS_BIG + 288 * MiB, WS_VT = WS_BIG + 432 * MiB, WS_O = WS_BIG + 576 * MiB;
constexpr size_t WS_ZIN = WS_BIG;
constexpr size_t WS_VTG = WS_BIG + 576 * MiB;
constexpr size_t WS_OFF = WS_BIG + 720 * MiB;
constexpr size_t WS_OFB = WS_BIG + 1008 * MiB;
constexpr size_t WS_O2 = WS_H;
constexpr size_t WS_LB = 17 * MiB;
constexpr size_t WS_ROPE = 18 * MiB;
constexpr size_t WS_NEED = 2048 * MiB;
constexpr size_t WO_GLU = WS_W, WO_NAQKV = WS_W + 4 * MiB, WO_NAO = WS_W + 10 * MiB, WO_DAQKV = WS_W + 12 * MiB, WO_DAO = WS_W + 18 * MiB, WO_HGIN = WS_W + 20 * MiB, WO_HGO = WS_W + 30 * MiB;
constexpr size_t WO_GU = WS_W + 32 * MiB  , WO_DN = WS_W + 160 * MiB  ;
constexpr int CW_BAR = 4096;

__device__ __forceinline__ unsigned f2bf(float f) { unsigned u = __builtin_bit_cast(unsigned, f); return (u + 0x7fffu + ((u >> 16) & 1u)) >> 16; }
__device__ __forceinline__ float bf2f(unsigned h) { return __builtin_bit_cast(float, h << 16); }
__device__ __forceinline__ unsigned pk2(float lo, float hi) { return f2bf(lo) | (f2bf(hi) << 16); }
typedef __bf16 bf16x2_t __attribute__((ext_vector_type(2)));
__device__ __forceinline__ unsigned pkbf(float lo, float hi) { const f32x2 v = {lo, hi}; return __builtin_bit_cast(unsigned, __builtin_convertvector(v, bf16x2_t)); }
__device__ __forceinline__ float bflo(unsigned w) { return __builtin_bit_cast(float, w << 16); }
__device__ __forceinline__ float bfhi(unsigned w) { return __builtin_bit_cast(float, w & 0xffff0000u); }
__device__ __forceinline__ float wave_sum(float v) {
#pragma unroll
    for (int o = 1; o < 64; o <<= 1) v += __shfl_xor(v, o);
    return v;
}
__device__ __forceinline__ float wave_max(float v) {
#pragma unroll
    for (int o = 1; o < 64; o <<= 1) v = fmaxf(v, __shfl_xor(v, o));
    return v;
}
__device__ __forceinline__ float sigmoidf_(float x) { return 1.0f / (1.0f + expf(-x)); }
__device__ __forceinline__ float siluf_(float x) { return x / (1.0f + expf(-x)); }
__device__ __forceinline__ float gelu_tanh(float x) { return 0.5f * x * (1.0f + tanhf(0.7978845608028654f * (x + 0.044715f * x * x * x))); }
__device__ __forceinline__ float dpp_xor1(float v) { return __builtin_bit_cast(float, __builtin_amdgcn_update_dpp(0, __builtin_bit_cast(int, v), 0xB1, 0xF, 0xF, true)); }
__device__ __forceinline__ float dpp_xor2(float v) { return __builtin_bit_cast(float, __builtin_amdgcn_update_dpp(0, __builtin_bit_cast(int, v), 0x4E, 0xF, 0xF, true)); }
__device__ __forceinline__ float reduce16(float (&v)[16], int lane) {
    const bool b0 = lane & 1, b1 = lane & 2, b2 = lane & 4, b3 = lane & 8;
    float a[8];
#pragma unroll
    for (int k = 0; k < 8; ++k) { const float snd = b0 ? v[k] : v[8 + k], kep = b0 ? v[8 + k] : v[k]; a[k] = kep + dpp_xor1(snd); }
    float c[4];
#pragma unroll
    for (int k = 0; k < 4; ++k) { const float snd = b1 ? a[k] : a[4 + k], kep = b1 ? a[4 + k] : a[k]; c[k] = kep + dpp_xor2(snd); }
    float d[2];
#pragma unroll
    for (int k = 0; k < 2; ++k) { const float snd = b2 ? c[k] : c[2 + k], kep = b2 ? c[2 + k] : c[k]; d[k] = kep + __shfl_xor(snd, 4); }
    float r = (b3 ? d[1] : d[0]) + __shfl_xor(b3 ? d[0] : d[1], 8);
    r += __shfl_xor(r, 16); r += __shfl_xor(r, 32);
    return r;
}
#define WAVE_LDS_SYNC() asm volatile("s_waitcnt lgkmcnt(0)" ::: "memory")

#define XB_TMO      128
#define XB_XCNT(j)  (256  + 64 * (j))
#define XB_XSUB(j)  (1280 + 64 * (j))
#define XB_XGEN(j)  (2304 + 64 * (j))
#define XB_TOP      3328
#define XB_TOPGEN   3392
#define XCD_BAR_WORDS 3456
#define XB_SPIN_CAP (1u << 27)
__device__ __forceinline__ unsigned xb_ld(unsigned* p)              { return __hip_atomic_load(p, __ATOMIC_RELAXED, __HIP_MEMORY_SCOPE_AGENT); }
__device__ __forceinline__ unsigned xb_add(unsigned* p, unsigned v) { return __hip_atomic_fetch_add(p, v, __ATOMIC_RELAXED, __HIP_MEMORY_SCOPE_AGENT); }
__device__ __forceinline__ unsigned xb_xcc_id() { return (unsigned)__builtin_amdgcn_s_getreg((3 << 11) | 20) & 0xFu; }
#define XB_SPIN(cond, bar) do { unsigned _sp = 0; while (cond) { __builtin_amdgcn_s_sleep(1); \
    if ((++_sp & 255u) == 0u) { if (xb_ld(&(bar)[XB_TMO])) break; if (_sp > XB_SPIN_CAP) { atomicAdd(&(bar)[XB_TMO], 1u); break; } } } } while (0)
struct XcdBarrier { unsigned* bar; unsigned x; volatile LAS unsigned* st; };
__device__ __forceinline__ XcdBarrier xcd_barrier_post(unsigned* bar, volatile LAS unsigned* st, int tid_) {
    XcdBarrier b; b.bar = bar; b.x = xb_xcc_id(); b.st = st;
    if (tid_ == 0) (void)xb_add(&bar[XB_XCNT(b.x)], 1u);
    return b;
}
__device__ __forceinline__ void xcd_barrier_complete(unsigned* bar, unsigned x, unsigned& nloc, unsigned& nx) {
    const unsigned G = gridDim.x * gridDim.y * gridDim.z;
    unsigned sum, cnt, mine, sp = 0u;
    for (;;) {
        sum = 0u; cnt = 0u; mine = 0u;
#pragma unroll
        for (unsigned j = 0; j < 16; ++j) { const unsigned c = xb_ld(&bar[XB_XCNT(j)]); sum += c; cnt += (c > 0u) ? 1u : 0u; mine = (j == x) ? c : mine; }
        if (sum == G) break;
        __builtin_amdgcn_s_sleep(1);
        if ((++sp & 255u) == 0u) { if (xb_ld(&bar[XB_TMO])) break; if (sp > XB_SPIN_CAP) { atomicAdd(&bar[XB_TMO], 1u); break; } }
    }
    nloc = mine > 0u ? mine : 1u; nx = cnt > 0u ? cnt : 1u;
}
__device__ __forceinline__ void xcd_barrier(const XcdBarrier& b, int tid_) {
    asm volatile("s_waitcnt vmcnt(0)" ::: "memory");
    __syncthreads();
    if (tid_ == 0) {
        unsigned* bar = b.bar;
        __builtin_amdgcn_s_waitcnt(0);
        unsigned nloc = b.st[0], nx = b.st[1];
        if (nloc == 0u) { xcd_barrier_complete(bar, b.x, nloc, nx); b.st[0] = nloc; b.st[1] = nx; }
        const unsigned old = xb_add(&bar[XB_XSUB(b.x)], 1u);
        const unsigned gen = old / nloc;
        if (old + 1u == (gen + 1u) * nloc) {
            __builtin_amdgcn_fence(__ATOMIC_RELEASE, "agent");
            asm volatile("s_waitcnt vmcnt(0)" ::: "memory");
            const unsigned og = xb_add(&bar[XB_TOP], 1u);
            const unsigned tg = og / nx;
            if (og + 1u == (tg + 1u) * nx) xb_add(&bar[XB_TOPGEN], 1u);
            else XB_SPIN(xb_ld(&bar[XB_TOPGEN]) == tg, bar);
            __builtin_amdgcn_fence(__ATOMIC_ACQUIRE, "agent");
            xb_add(&bar[XB_XGEN(b.x)], 1u);
            asm volatile("s_waitcnt vmcnt(0)" ::: "memory");
        } else {
            XB_SPIN(xb_ld(&bar[XB_XGEN(b.x)]) == gen, bar);
            __builtin_amdgcn_fence(__ATOMIC_ACQUIRE, "agent");
            asm volatile("s_waitcnt vmcnt(0)" ::: "memory");
        }
    }
    __syncthreads();
}

namespace pg8 {
#define PG8_LAS __attribute__((address_space(3)))
typedef unsigned short bf16_t;
typedef short bf16x8 __attribute__((ext_vector_type(8)));
typedef float f32x4 __attribute__((ext_vector_type(4)));
typedef unsigned u32x4 __attribute__((ext_vector_type(4)));
constexpr int BM = 256, BK = 64, HALF = 128, HTB = HALF * BK * 2  , STAGE_BYTES = 8 * HTB, NXCD = 8, WGM = 8;

__host__ __device__ __forceinline__ int lds_byte(int r, int c) { const int st = (r >> 4) * 2 + (c >> 5), rr = r & 15, cc = c & 31, ob = rr * 64 + cc * 2; return st * 1024 + (ob ^ (((ob >> 9) & 1) << 5)); }
__host__ __device__ __forceinline__ void stage_rc(int b, int& R, int& C) { const int st = b / 1024, sb = b % 1024, swz = sb ^ (((sb >> 9) & 1) << 5); R = (st >> 1) * 16 + swz / 64; C = (st & 1) * 32 + (swz % 64) / 2; }
__host__ __device__ __forceinline__ int perm32(int rho) { const int n = rho >> 4, i = rho & 15; return 8 * (i >> 2) + 4 * n + (i & 3); }

struct Unit { int pm, pn; };
struct Gemm { const bf16_t* A; const bf16_t* Bt; int lda, ldb, K; const int* rowidx; };

struct StaticOrder {
    int nM, nN, nwg, G, c;
    __host__ __device__ void init(int M, int N, int G_, int c_) { nM = M / BM; nN = N / BM; nwg = nM * nN; G = G_; c = c_; }
    __host__ __device__ bool next(int i, Unit& u) const {
        const long L = (long)i * G + c; if (L >= nwg) return false;
        int wgid = (int)L; { const int q = nwg / NXCD, r = nwg % NXCD, xcd = wgid % NXCD, off = wgid / NXCD; wgid = (xcd < r ? xcd * (q + 1) : r * (q + 1) + (xcd - r) * q) + off; }
        const int nig = WGM * nN, gid = wgid / nig, fm = gid * WGM, gsz = (nM - fm) < WGM ? (nM - fm) : WGM;
        u.pm = fm + ((wgid % nig) % gsz); u.pn = (wgid % nig) / gsz; return true;
    }
    __device__ __forceinline__ void a_ready(const Unit&) const {}
    __device__ __forceinline__ void done(const Unit&) const {}
};

__device__ __forceinline__ unsigned cvt_pk_bf16(float lo, float hi) { unsigned r; asm volatile("v_cvt_pk_bf16_f32 %0, %1, %2" : "=v"(r) : "v"(lo), "v"(hi)); return r; }
typedef float f32x2 __attribute__((ext_vector_type(2)));
__device__ __forceinline__ f32x2 gelu_pk(f32x2 v) {
    const f32x2 av = __builtin_elementwise_abs(v), d = av * 0.2316418882f + 1.0f;
    f32x2 t; t.x = __builtin_amdgcn_rcpf(d.x); t.y = __builtin_amdgcn_rcpf(d.y);
    f32x2 q = t * 0.5307027145f + (-0.7265760135f); q = q * t + 0.7107068705f; q = q * t + (-0.142248368f); q = q * t + 0.127414796f; q = q * t;
    const f32x2 s = (v * v) * (-0.72134752044f);
    f32x2 e; e.x = __builtin_amdgcn_exp2f(s.x); e.y = __builtin_amdgcn_exp2f(s.y);
    const f32x2 m = v * (q * e), r = v - m;
    f32x2 o; o.x = v.x < 0.f ? m.x : r.x; o.y = v.y < 0.f ? m.y : r.y; return o;
}

template <int ACT  > struct EpiBf16 {
    static constexpr bool PERM = true, AFTER_DRAIN = false; static_assert(ACT == 0 || ACT == 1, "EpiBf16: ACT is 0 (none) or 1 (gelu_pk)");
    bf16_t* O; int ldc; const float* bias; int split_cols; size_t split_stride; float scale0;
    __device__ __forceinline__ void operator()(const f32x4 (&acc)[2][2][4][2], const Unit& u, int wr, int wc, int fr, int fq) const {
        const int row0 = u.pm * BM + wr * 64 + fr; int colt = u.pn * BM; bf16_t* base = O;
        float sc = 1.f; if (split_cols) { const int t = colt / split_cols; base += (size_t)t * split_stride; colt -= t * split_cols; if (t == 0) sc = scale0; }
        const int col0 = colt + wc * 32 + 8 * fq, bcol0 = u.pn * BM + wc * 32 + 8 * fq;
        f32x4 bv[2][2];
#pragma unroll
        for (int bj = 0; bj < 2; ++bj)
#pragma unroll
            for (int n = 0; n < 2; ++n) bv[bj][n] = bias ? *(const f32x4*)(bias + bcol0 + bj * HALF + 4 * n) : (f32x4){0.f, 0.f, 0.f, 0.f};
#pragma unroll
        for (int ai = 0; ai < 2; ++ai)
#pragma unroll
            for (int m = 0; m < 4; ++m) { bf16_t* rowp = base + (size_t)(row0 + ai * HALF + m * 16) * ldc + col0;
#pragma unroll
                for (int bj = 0; bj < 2; ++bj) { f32x4 v0 = acc[ai][bj][m][0] + bv[bj][0], v1 = acc[ai][bj][m][1] + bv[bj][1];
                    if (ACT == 1) { f32x2 a = gelu_pk((f32x2){v0[0], v0[1]}), b = gelu_pk((f32x2){v0[2], v0[3]}), c = gelu_pk((f32x2){v1[0], v1[1]}), d = gelu_pk((f32x2){v1[2], v1[3]});
                        v0 = (f32x4){a.x, a.y, b.x, b.y}; v1 = (f32x4){c.x, c.y, d.x, d.y}; }
                    v0 = v0 * sc; v1 = v1 * sc; u32x4 w; w.x = cvt_pk_bf16(v0[0], v0[1]); w.y = cvt_pk_bf16(v0[2], v0[3]); w.z = cvt_pk_bf16(v1[0], v1[1]); w.w = cvt_pk_bf16(v1[2], v1[3]);
                    *(u32x4*)(rowp + bj * HALF) = w; } }
    }
};


struct GroupedOrder {
    int nM, nN, groups, gsM, G, c, total;
    __host__ __device__ void init(int nM_, int nN_, int groups_, int gsM_, int G_, int c_) { nM = nM_; nN = nN_; groups = groups_; gsM = gsM_; G = G_; c = c_; total = nM * nN * groups; }
    __host__ __device__ bool next(int i, Unit& u) const {
        const long L = (long)i * G + c; if (L >= total) return false;
        int T = (int)L; { const int q = total / NXCD, r = total % NXCD, xcd = T % NXCD, off = T / NXCD; T = (xcd < r ? xcd * (q + 1) : r * (q + 1) + (xcd - r) * q) + off; }
        const int tpg = nM * nN, g = T / tpg, t = T - g * tpg;
        const int nig = WGM * nN, gid = t / nig, fm = gid * WGM, gsz = (nM - fm) < WGM ? (nM - fm) : WGM;
        u.pm = g * gsM + fm + ((t % nig) % gsz); u.pn = g * nN + (t % nig) / gsz; return true;
    }
    __device__ __forceinline__ void a_ready(const Unit&) const {}
    __device__ __forceinline__ void done(const Unit&) const {}
};
struct LatentOrder {
    GroupedOrder o;
    __host__ __device__ void init(int nN_, int G_, int c_) { o.init(256, nN_, 1, 256, G_, c_); }
    __host__ __device__ bool next(int i, Unit& u) const { if (!o.next(i, u)) return false; u.pm += (u.pm >> 3) + 1; return true; }
    __device__ __forceinline__ void a_ready(const Unit&) const {}
    __device__ __forceinline__ void done(const Unit&) const {}
};
struct HgInOrder {
    LatentOrder lat; int G, c;
    __host__ __device__ void init(int G_, int c_) { lat.init(16, G_, c_); G = G_; c = c_; }
    __host__ __device__ bool next(int i, Unit& u) const {
        const long L = (long)i * G + c;
        if (L < 4096) return lat.next(i, u);
        const int t = (int)L - 4096; if (t >= 256) return false;
        u.pm = (t >> 3) * 9; u.pn = 4 + (t & 7); return true;
    }
    __device__ __forceinline__ void a_ready(const Unit&) const {}
    __device__ __forceinline__ void done(const Unit&) const {}
};
__device__ __forceinline__ float sigm(float x) { return __builtin_amdgcn_rcpf(1.0f + __builtin_amdgcn_exp2f(x * -1.4426950408889634f)); }
constexpr int PP = 2304, DD = 1024;
__device__ __forceinline__ int mrow_of(int row) { const int b = row / PP, pos = row - b * PP; return pos < 256 ? 32 : b; }
struct EpiResidT {
    static constexpr bool PERM = false, AFTER_DRAIN = false;
    bf16_t* X; const float* MODL;
    __device__ __forceinline__ void operator()(const f32x4 (&acc)[2][2][4][2], const Unit& u, int wr, int wc, int fr, int fq) const {
        const int row0 = u.pm * BM + wr * 64 + fr, col0 = u.pn * BM + wc * 32 + 4 * fq;
        const float* g = MODL + (size_t)mrow_of(u.pm * BM) * 6144 + 2 * DD + col0;
        f32x4 gt[2][2];
#pragma unroll
        for (int bj = 0; bj < 2; ++bj)
#pragma unroll
            for (int n = 0; n < 2; ++n) gt[bj][n] = *(const f32x4*)(g + bj * HALF + n * 16);
#pragma unroll
        for (int ai = 0; ai < 2; ++ai)
#pragma unroll
            for (int m = 0; m < 4; ++m) { const int row = row0 + ai * HALF + m * 16; bf16_t* x = X + (size_t)row * DD + col0;
                u32x2 xo[2][2];
#pragma unroll
                for (int bj = 0; bj < 2; ++bj)
#pragma unroll
                    for (int n = 0; n < 2; ++n) xo[bj][n] = *(const u32x2*)(x + bj * HALF + n * 16);
#pragma unroll
                for (int bj = 0; bj < 2; ++bj)
#pragma unroll
                    for (int n = 0; n < 2; ++n) { const int o = bj * HALF + n * 16; const f32x4 xv = {bflo(xo[bj][n].x), bfhi(xo[bj][n].x), bflo(xo[bj][n].y), bfhi(xo[bj][n].y)};
                        const f32x4 r = xv + gt[bj][n] * acc[ai][bj][m][n]; u32x2 w; w.x = pkbf(r.x, r.y); w.y = pkbf(r.z, r.w); *(u32x2*)(x + o) = w; } }
    }
};
struct EpiGluT {
    static constexpr bool PERM = true, AFTER_DRAIN = false;
    bf16_t* X; const float* MODL;
    __device__ __forceinline__ void operator()(const f32x4 (&acc)[2][2][4][2], const Unit& u, int wr, int wc, int fr, int fq) const {
        const int row0 = u.pm * BM + wr * 64 + fr, f0 = u.pn * 128 + wc * 32 + 8 * fq;
        const float* g = MODL + (size_t)mrow_of(u.pm * BM) * 6144 + 2 * DD + f0;
        const f32x4 gt[2] = {*(const f32x4*)g, *(const f32x4*)(g + 4)};
#pragma unroll
        for (int ai = 0; ai < 2; ++ai)
#pragma unroll
            for (int m = 0; m < 4; ++m) { const int row = row0 + ai * HALF + m * 16; bf16_t* x = X + (size_t)row * DD + f0;
                const u32x4 xo = *(const u32x4*)x; u32x4 w;
#pragma unroll
                for (int n = 0; n < 2; ++n) { const f32x4 a = acc[ai][0][m][n], b = acc[ai][1][m][n]; f32x4 v = b * -1.4426950408889634f;
#pragma unroll
                    for (int q = 0; q < 4; ++q) v[q] = __builtin_amdgcn_exp2f(v[q]);
                    v = v + 1.0f;
#pragma unroll
                    for (int q = 0; q < 4; ++q) v[q] = __builtin_amdgcn_rcpf(v[q]);
                    v = v * a;
                    const unsigned x01 = n ? xo.z : xo.x, x23 = n ? xo.w : xo.y; const f32x4 xv = {bflo(x01), bfhi(x01), bflo(x23), bfhi(x23)};
                    const f32x4 r = xv + gt[n] * v; if (n) { w.z = pkbf(r.x, r.y); w.w = pkbf(r.z, r.w); } else { w.x = pkbf(r.x, r.y); w.y = pkbf(r.z, r.w); } }
                *(u32x4*)x = w; }
    }
};
struct EpiSwigluT {
    static constexpr bool PERM = true, AFTER_DRAIN = false;
    bf16_t* HID; int nNg; int ldh;
    __device__ __forceinline__ void operator()(const f32x4 (&acc)[2][2][4][2], const Unit& u, int wr, int wc, int fr, int fq) const {
        const int row0 = u.pm * BM + wr * 64 + fr, f0 = (u.pn % nNg) * 128 + wc * 32 + 8 * fq;
#pragma unroll
        for (int ai = 0; ai < 2; ++ai)
#pragma unroll
            for (int m = 0; m < 4; ++m) { bf16_t* hp = HID + (size_t)(row0 + ai * HALF + m * 16) * ldh + f0;
                const f32x4 a0 = acc[ai][0][m][0], a1 = acc[ai][0][m][1], b0 = acc[ai][1][m][0], b1 = acc[ai][1][m][1];
                f32x4 e0 = a0 * -1.4426950408889634f, e1 = a1 * -1.4426950408889634f;
#pragma unroll
                for (int q = 0; q < 4; ++q) { e0[q] = __builtin_amdgcn_exp2f(e0[q]); e1[q] = __builtin_amdgcn_exp2f(e1[q]); }
                e0 = e0 + 1.0f; e1 = e1 + 1.0f;
#pragma unroll
                for (int q = 0; q < 4; ++q) { e0[q] = __builtin_amdgcn_rcpf(e0[q]); e1[q] = __builtin_amdgcn_rcpf(e1[q]); }
                const f32x4 o0 = (a0 * b0) * e0, o1 = (a1 * b1) * e1;
                u32x4 w; w.x = cvt_pk_bf16(o0.x, o0.y); w.y = cvt_pk_bf16(o0.z, o0.w); w.z = cvt_pk_bf16(o1.x, o1.y); w.w = cvt_pk_bf16(o1.z, o1.w);
                *(u32x4*)hp = w; }
    }
};
struct EpiDownT {
    static constexpr bool PERM = true, AFTER_DRAIN = false;
    bf16_t* Y; const float* GATE; int nNg;
    __device__ __forceinline__ void operator()(const f32x4 (&acc)[2][2][4][2], const Unit& u, int wr, int wc, int fr, int fq) const {
        const int row0 = u.pm * BM + wr * 64 + fr, col0 = (u.pn % nNg) * BM + wc * 32 + 8 * fq;
#pragma unroll
        for (int ai = 0; ai < 2; ++ai)
#pragma unroll
            for (int m = 0; m < 4; ++m) { const int row = row0 + ai * HALF + m * 16; bf16_t* rowp = Y + (size_t)row * DD + col0;
#pragma unroll
                for (int bj = 0; bj < 2; ++bj) { const f32x4 v0 = acc[ai][bj][m][0], v1 = acc[ai][bj][m][1];
                    u32x4 w; w.x = cvt_pk_bf16(v0[0], v0[1]); w.y = cvt_pk_bf16(v0[2], v0[3]); w.z = cvt_pk_bf16(v1[0], v1[1]); w.w = cvt_pk_bf16(v1[2], v1[3]);
                    *(u32x4*)(rowp + bj * HALF) = w; } }
    }
};
template <bool SILU> struct EpiVtT {
    static constexpr bool PERM = true, AFTER_DRAIN = false;
    bf16_t* VT;
    __device__ __forceinline__ void operator()(const f32x4 (&acc)[2][2][4][2], const Unit& u, int wr, int wc, int fr, int fq) const {
        const int hd0 = u.pm * BM + wr * 64 + fr, tok0 = u.pn * BM + wc * 32 + 8 * fq, b = (u.pn * BM) / PP, pos0 = tok0 - b * PP;
#pragma unroll
        for (int ai = 0; ai < 2; ++ai)
#pragma unroll
            for (int m = 0; m < 4; ++m) { bf16_t* rowp = VT + ((size_t)b * DD + hd0 + ai * HALF + m * 16) * PP + pos0;
#pragma unroll
                for (int bj = 0; bj < 2; ++bj) { f32x4 v0 = acc[ai][bj][m][0], v1 = acc[ai][bj][m][1];
                    if (SILU) {
#pragma unroll
                        for (int q = 0; q < 4; ++q) { v0[q] = v0[q] * sigm(v0[q]); v1[q] = v1[q] * sigm(v1[q]); } }
                    u32x4 w; w.x = cvt_pk_bf16(v0[0], v0[1]); w.y = cvt_pk_bf16(v0[2], v0[3]); w.z = cvt_pk_bf16(v1[0], v1[1]); w.w = cvt_pk_bf16(v1[2], v1[3]);
                    *(u32x4*)(rowp + bj * HALF) = w; } }
    }
};
struct EpiHgIn {
    static constexpr bool PERM = true, AFTER_DRAIN = false;
    bf16_t* O; const float* LB;
    __device__ __forceinline__ void operator()(const f32x4 (&acc)[2][2][4][2], const Unit& u, int wr, int wc, int fr, int fq) const {
        const int row0 = u.pm * BM + wr * 64 + fr, col0 = u.pn * BM + wc * 32 + 8 * fq, type = u.pn >> 2;
        f32x4 lb[2][2];
#pragma unroll
        for (int bj = 0; bj < 2; ++bj) { const int c = (col0 + bj * HALF) & 1023; lb[bj][0] = *(const f32x4*)(LB + c); lb[bj][1] = *(const f32x4*)(LB + c + 4); }
#pragma unroll
        for (int ai = 0; ai < 2; ++ai)
#pragma unroll
            for (int m = 0; m < 4; ++m) { bf16_t* rowp = O + (size_t)(row0 + ai * HALF + m * 16) * 4096 + col0;
#pragma unroll
                for (int bj = 0; bj < 2; ++bj) { f32x4 v0 = acc[ai][bj][m][0], v1 = acc[ai][bj][m][1];
                    if (type == 1 || type == 2) { const f32x4 l0 = lb[bj][0], l1 = lb[bj][1];
#pragma unroll
                        for (int q = 0; q < 4; ++q) { v0[q] = __log2f(l0[q] + (1.0f - l0[q]) * sigm(v0[q])); v1[q] = __log2f(l1[q] + (1.0f - l1[q]) * sigm(v1[q])); } }
                    else if (type == 3) {
#pragma unroll
                        for (int q = 0; q < 4; ++q) { v0[q] = v0[q] * sigm(v0[q]); v1[q] = v1[q] * sigm(v1[q]); } }
                    u32x4 w; w.x = cvt_pk_bf16(v0[0], v0[1]); w.y = cvt_pk_bf16(v0[2], v0[3]); w.z = cvt_pk_bf16(v1[0], v1[1]); w.w = cvt_pk_bf16(v1[2], v1[3]);
                    *(u32x4*)(rowp + bj * HALF) = w; } }
    }
};


struct EpiF32G {
    static constexpr bool PERM = false, AFTER_DRAIN = false;
    float* C; int ldc; int nNg;
    __device__ __forceinline__ void operator()(const f32x4 (&acc)[2][2][4][2], const Unit& u, int wr, int wc, int fr, int fq) const {
        const int row0 = u.pm * BM + wr * 64 + fr, col0 = (u.pn % nNg) * BM + wc * 32 + 4 * fq;
#pragma unroll
        for (int ai = 0; ai < 2; ++ai)
#pragma unroll
            for (int m = 0; m < 4; ++m) { float* rowp = C + (size_t)(row0 + ai * HALF + m * 16) * ldc + col0;
#pragma unroll
                for (int bj = 0; bj < 2; ++bj)
#pragma unroll
                    for (int n = 0; n < 2; ++n) *(f32x4*)(rowp + bj * HALF + n * 16) = acc[ai][bj][m][n]; }
    }
};
__device__ __forceinline__ float gelu_t(float x) { const float t = 1.5957691216057308f * (x + 0.044715f * x * x * x); return x * sigm(t); }
struct EpiS5Out {
    static constexpr bool PERM = true, AFTER_DRAIN = false;
    const bf16_t* H; bf16_t* Z; const float* dvec;
    __device__ __forceinline__ void operator()(const f32x4 (&acc)[2][2][4][2], const Unit& u, int wr, int wc, int fr, int fq) const {
        const int c0 = (u.pn & 1) * BM + wc * 32 + 8 * fq;
        const int g = (u.pm * BM) / 2304;
        f32x4 dv[2][2];
#pragma unroll
        for (int bj = 0; bj < 2; ++bj) { const int k0 = (c0 + bj * HALF) & 15; dv[bj][0] = *(const f32x4*)(dvec + g * 16 + k0); dv[bj][1] = *(const f32x4*)(dvec + g * 16 + k0 + 4); }
#pragma unroll
        for (int ai = 0; ai < 2; ++ai)
#pragma unroll
            for (int m = 0; m < 4; ++m) {
                const int rg = u.pm * BM + ai * HALF + wr * 64 + m * 16 + fr, rem = rg - g * 2304, b = rem / 72, j = rem - b * 72;
#pragma unroll
                for (int bj = 0; bj < 2; ++bj) {
                    const int mc = c0 + bj * HALF, tau = mc >> 4, k0 = mc & 15;
                    const size_t off = ((size_t)b * PP + 32 * j + tau) * DD + g * 16 + k0;
                    const u32x4 uw = *(const u32x4*)(H + off);
                    const f32x4 d0 = dv[bj][0], d1 = dv[bj][1];
                    const f32x4 y0 = acc[ai][bj][m][0], y1 = acc[ai][bj][m][1];
                    u32x4 w;
                    w.x = cvt_pk_bf16(gelu_t(y0[0] + d0[0] * __uint_as_float(uw.x << 16)), gelu_t(y0[1] + d0[1] * __uint_as_float(uw.x & 0xffff0000u)));
                    w.y = cvt_pk_bf16(gelu_t(y0[2] + d0[2] * __uint_as_float(uw.y << 16)), gelu_t(y0[3] + d0[3] * __uint_as_float(uw.y & 0xffff0000u)));
                    w.z = cvt_pk_bf16(gelu_t(y1[0] + d1[0] * __uint_as_float(uw.z << 16)), gelu_t(y1[1] + d1[1] * __uint_as_float(uw.z & 0xffff0000u)));
                    w.w = cvt_pk_bf16(gelu_t(y1[2] + d1[2] * __uint_as_float(uw.w << 16)), gelu_t(y1[3] + d1[3] * __uint_as_float(uw.w & 0xffff0000u)));
                    *(u32x4*)(Z + off) = w;
                }
            }
    }
};


__device__ __forceinline__ void xor32_pair(float x, float y, float& xs, float& ys) {
    const auto r1 = __builtin_amdgcn_permlane32_swap(__float_as_uint(x), __float_as_uint(y), false, false);
    const auto r2 = __builtin_amdgcn_permlane32_swap(r1[1], r1[0], false, false);
    xs = __uint_as_float(r2[0]); ys = __uint_as_float(r2[1]);
}
struct EpiQKRope {
    static constexpr bool PERM = true, AFTER_DRAIN = false;
    bf16_t* Q; size_t kstride; const PG8_LAS float* T;
    __device__ __forceinline__ void operator()(const f32x4 (&acc)[2][2][4][2], const Unit& u, int wr, int wc, int fr, int fq) const {
        const int row0 = u.pm * BM + wr * 64 + fr; int colt = u.pn * BM; bf16_t* base = Q;
        { const int t = colt / DD; base += (size_t)t * kstride; colt -= t * DD; }
        const int col0 = colt + wc * 32 + 8 * fq, half = wc & 1; const bool first = fq < 2;
        const int tb = (u.pm * BM) / PP;
        const float qs = u.pn * BM < DD ? 0.125f * 1.4426950408889634f : 1.0f;
#pragma unroll
        for (int ai = 0; ai < 2; ++ai)
#pragma unroll
            for (int m = 0; m < 4; ++m) { const int row = row0 + ai * HALF + m * 16, pos = row - tb * PP, tt = pos - 256; const bool lat = pos >= 256;
                const int p = lat ? (half ? (tt & 63) : (tt >> 6)) : 0;
                const PG8_LAS f32x4* cs = (const PG8_LAS f32x4*)(T + (p * 16 + 8 * (fq & 1)) * 2);
                const f32x4 t0 = cs[0], t1 = cs[1], t2 = cs[2], t3 = cs[3];
                bf16_t* rowp = base + (size_t)row * DD + col0;
#pragma unroll
                for (int bj = 0; bj < 2; ++bj) { f32x4 v0 = acc[ai][bj][m][0] * qs, v1 = acc[ai][bj][m][1] * qs;
                    f32x4 p0, p1;
#pragma unroll
                    for (int q = 0; q < 4; ++q) { float a_, b_; xor32_pair(v0[q], v1[q], a_, b_); p0[q] = a_; p1[q] = b_; }
                    if (lat) { const float sg = first ? -1.0f : 1.0f;
                        v0 = (f32x4){v0[0] * t0[0] + sg * p0[0] * t0[1], v0[1] * t0[2] + sg * p0[1] * t0[3], v0[2] * t1[0] + sg * p0[2] * t1[1], v0[3] * t1[2] + sg * p0[3] * t1[3]};
                        v1 = (f32x4){v1[0] * t2[0] + sg * p1[0] * t2[1], v1[1] * t2[2] + sg * p1[1] * t2[3], v1[2] * t3[0] + sg * p1[2] * t3[1], v1[3] * t3[2] + sg * p1[3] * t3[3]}; }
                    u32x4 w; w.x = cvt_pk_bf16(v0[0], v0[1]); w.y = cvt_pk_bf16(v0[2], v0[3]); w.z = cvt_pk_bf16(v1[0], v1[1]); w.w = cvt_pk_bf16(v1[2], v1[3]);
                    *(u32x4*)(rowp + bj * HALF) = w; } }
    }
};

template <class Epi, class Sched, bool ALIGN_EPI = false, bool SP2 = false, bool GATHER = false>
__device__ __forceinline__ void gemm_phase(PG8_LAS unsigned char* lds, const Gemm g, const Sched& S, const Epi& E, const int tid) {
    const int wid = __builtin_amdgcn_readfirstlane(tid >> 6), lane = tid & 63, wr = wid >> 2, wc = wid & 3, fr = lane & 15, fq = lane >> 4;
    const int K = g.K, nt = K / BK;
    unsigned voffA[2], voffB[2];
#pragma unroll
    for (int i = 0; i < 2; ++i) { int R, C; stage_rc(tid * 16 + i * 8192, R, C); const int Rb = Epi::PERM ? ((R & ~31) + perm32(R & 31)) : R;
        voffA[i] = (unsigned)(R * g.lda + C) * 2u; voffB[i] = (unsigned)(Rb * g.ldb + C) * 2u; }
    unsigned vA0[2] = {0u, 0u}, vA1[2] = {0u, 0u}, wA0[2] = {0u, 0u}, wA1[2] = {0u, 0u};
#define PG8_GOFF(u_, o0, o1) do { _Pragma("unroll") for (int i = 0; i < 2; ++i) { int R, C; stage_rc(tid * 16 + i * 8192, R, C); const int r0_ = (u_).pm * BM + R; \
        o0[i] = ((unsigned)g.rowidx[r0_] * (unsigned)g.lda + (unsigned)C) * 2u; o1[i] = ((unsigned)g.rowidx[r0_ + HALF] * (unsigned)g.lda + (unsigned)C) * 2u; } } while (0)
    const size_t kstep = (size_t)(BK * 2);
    const size_t hstepA = (size_t)HALF * g.lda * 2, hstepB = (size_t)HALF * g.ldb * 2;
    const size_t tstepA = 2 * hstepA, tstepB = 2 * hstepB;
    const unsigned ldsw = (unsigned)wid * 1024u;
    const int aoff = lds_byte(wr * 64 + fr, fq * 8), boff = lds_byte(wc * 32 + fr, fq * 8);
#define PG8_SA(b, h) (((b) * 2 + (h)) * HTB)
#define PG8_SB(b, h) ((4 + (b) * 2 + (h)) * HTB)
#define PG8_STAGE(bufoff, gbase, voff) do { _Pragma("unroll") for (int _i = 0; _i < 2; ++_i) \
        __builtin_amdgcn_global_load_lds((const unsigned*)((const char*)(gbase) + (voff)[_i]), (PG8_LAS unsigned*)(lds + (bufoff) + ldsw + _i * 8192), 16, 0, 0); } while (0)
#define PG8_STAGEA(bufoff, kptr, h, oc0, oc1) do { if constexpr (GATHER) { if (h) PG8_STAGE(bufoff, kptr, oc1); else PG8_STAGE(bufoff, kptr, oc0); } else { PG8_STAGE(bufoff, (kptr) + ((h) ? hstepA : 0), voffA); } } while (0)
#define PG8_LDA(dst, b, h) do { _Pragma("unroll") for (int m = 0; m < 4; ++m) _Pragma("unroll") for (int k = 0; k < 2; ++k) dst[m][k] = *(const PG8_LAS bf16x8*)(lds + PG8_SA(b, h) + aoff + m * 2048 + k * 1024); } while (0)
#define PG8_LDB(dst, b, h) do { _Pragma("unroll") for (int n = 0; n < 2; ++n) _Pragma("unroll") for (int k = 0; k < 2; ++k) dst[n][k] = *(const PG8_LAS bf16x8*)(lds + PG8_SB(b, h) + boff + n * 2048 + k * 1024); } while (0)
#define PG8_MMA(ai, bj, At, Bt) do { __builtin_amdgcn_s_setprio(1); _Pragma("unroll") for (int m = 0; m < 4; ++m) _Pragma("unroll") for (int n = 0; n < 2; ++n) _Pragma("unroll") for (int k = 0; k < 2; ++k) \
        acc[ai][bj][m][n] = __builtin_amdgcn_mfma_f32_16x16x32_bf16(Bt[n][k], At[m][k], acc[ai][bj][m][n], 0, 0, 0); __builtin_amdgcn_s_setprio(0); } while (0)
#define PG8_WAIT_V(n) asm volatile("s_waitcnt vmcnt(" #n ")" ::: "memory")
#define PG8_WAIT_L(n) asm volatile("s_waitcnt lgkmcnt(" #n ")" ::: "memory")
#define PG8_BAR __builtin_amdgcn_s_barrier()
#define PG8_SCHED __builtin_amdgcn_sched_barrier(0)
    Unit cur, nxt; int ui = 0;
    if (!S.next(0, cur)) return;
    f32x4 acc[2][2][4][2];
#pragma unroll
    for (int a = 0; a < 2; ++a)
#pragma unroll
        for (int b = 0; b < 2; ++b)
#pragma unroll
            for (int m = 0; m < 4; ++m)
#pragma unroll
                for (int n = 0; n < 2; ++n) acc[a][b][m][n] = (f32x4){0.f, 0.f, 0.f, 0.f};
    bf16x8 At[4][2], B0[2][2], B1[2][2];
    const char* cA = (const char*)g.A + (GATHER ? (size_t)0 : (size_t)cur.pm * tstepA); if constexpr (GATHER) PG8_GOFF(cur, vA0, vA1);
    const char* cB = (const char*)g.Bt + (size_t)cur.pn * tstepB;
    S.a_ready(cur);
    if constexpr (SP2) {
        PG8_STAGE(PG8_SB(0, 0), cB, voffB); PG8_STAGE(PG8_SB(0, 1), cB + hstepB, voffB); PG8_STAGEA(PG8_SA(0, 0), cA, 0, vA0, vA1); PG8_STAGEA(PG8_SA(0, 1), cA, 1, vA0, vA1);
        if (wr == 1) PG8_BAR;
        PG8_WAIT_V(2); PG8_BAR;
        PG8_STAGE(PG8_SB(1, 0), cB + kstep, voffB); PG8_STAGEA(PG8_SA(1, 0), cA + kstep, 0, vA0, vA1); PG8_STAGE(PG8_SB(1, 1), cB + hstepB + kstep, voffB);
        PG8_WAIT_V(6); PG8_BAR;
    } else {
        PG8_STAGE(PG8_SB(0, 0), cB, voffB); PG8_STAGE(PG8_SA(0, 0), cA, voffA); PG8_STAGE(PG8_SB(0, 1), cB + hstepB, voffB); PG8_STAGE(PG8_SA(0, 1), cA + hstepA, voffA);
        if (wr == 1) PG8_BAR;
        PG8_WAIT_V(4); PG8_BAR;
        PG8_STAGE(PG8_SB(1, 0), cB + kstep, voffB); PG8_STAGE(PG8_SA(1, 0), cA + kstep, voffA); PG8_STAGE(PG8_SB(1, 1), cB + hstepB + kstep, voffB);
        PG8_WAIT_V(6); PG8_BAR;
    }
    for (;;) {
        const bool has_next = S.next(ui + 1, nxt);
        const char* nA = (has_next && !GATHER) ? (const char*)g.A + (size_t)nxt.pm * tstepA : cA;
        if constexpr (GATHER) { if (has_next) { if (wid < 4) __builtin_amdgcn_global_load_lds((const unsigned*)(g.rowidx + (size_t)nxt.pm * BM + (tid & 255)), (PG8_LAS unsigned*)(lds + STAGE_BYTES + wid * 256), 4, 0, 0); }
                                else { wA0[0] = vA0[0]; wA0[1] = vA0[1]; wA1[0] = vA1[0]; wA1[1] = vA1[1]; } }
        const char* nB = has_next ? (const char*)g.Bt + (size_t)nxt.pn * tstepB : cB;
        for (int t = 0; t < nt; t += 2) {
            const bool last = (t == nt - 2);
            const char* a1 = cA + (size_t)(t + 1) * kstep;
            const char* a2 = last ? nA : cA + (size_t)(t + 2) * kstep; const char* b2 = last ? nB : cB + (size_t)(t + 2) * kstep;
            const char* a3 = a2 + kstep; const char* b3 = b2 + kstep;
            if (last && has_next) S.a_ready(nxt);
            if constexpr (GATHER) { if (last && has_next) {
#pragma unroll
                for (int i = 0; i < 2; ++i) { int R, C; stage_rc(tid * 16 + i * 8192, R, C);
                    const unsigned i0_ = *(const PG8_LAS unsigned*)(lds + STAGE_BYTES + R * 4), i1_ = *(const PG8_LAS unsigned*)(lds + STAGE_BYTES + (R + HALF) * 4);
                    wA0[i] = (i0_ * (unsigned)g.lda + (unsigned)C) * 2u; wA1[i] = (i1_ * (unsigned)g.lda + (unsigned)C) * 2u; } } }
            const unsigned sA0[2] = {last ? wA0[0] : vA0[0], last ? wA0[1] : vA0[1]}, sA1[2] = {last ? wA1[0] : vA1[0], last ? wA1[1] : vA1[1]};
            if constexpr (SP2) {
            PG8_LDB(B0, 0, 0); PG8_LDB(B1, 0, 1); PG8_SCHED; PG8_LDA(At, 0, 0); PG8_STAGEA(PG8_SA(1, 1), a1, 1, vA0, vA1);
            PG8_WAIT_V(8); PG8_WAIT_L(0); PG8_BAR; PG8_MMA(0, 0, At, B0); PG8_MMA(0, 1, At, B1); PG8_BAR; PG8_SCHED;
            PG8_LDA(At, 0, 1); PG8_STAGE(PG8_SB(0, 0), b2, voffB); PG8_STAGE(PG8_SB(0, 1), b2 + hstepB, voffB); PG8_STAGEA(PG8_SA(0, 0), a2, 0, sA0, sA1);
            PG8_WAIT_V(8); PG8_WAIT_L(0); PG8_BAR; PG8_MMA(1, 0, At, B0); PG8_MMA(1, 1, At, B1); PG8_BAR; PG8_SCHED;
            PG8_LDB(B0, 1, 0); PG8_LDB(B1, 1, 1); PG8_SCHED; PG8_LDA(At, 1, 0); PG8_STAGEA(PG8_SA(0, 1), a2, 1, sA0, sA1);
            PG8_WAIT_V(8); PG8_WAIT_L(0); PG8_BAR; PG8_MMA(0, 0, At, B0); PG8_MMA(0, 1, At, B1); PG8_BAR; PG8_SCHED;
            PG8_LDA(At, 1, 1); PG8_STAGE(PG8_SB(1, 0), b3, voffB); PG8_STAGE(PG8_SB(1, 1), b3 + hstepB, voffB); PG8_STAGEA(PG8_SA(1, 0), a3, 0, sA0, sA1);
            PG8_WAIT_V(8); PG8_WAIT_L(0); PG8_BAR; PG8_MMA(1, 0, At, B0); PG8_MMA(1, 1, At, B1); PG8_BAR; PG8_SCHED;
            } else {
            PG8_LDB(B0, 0, 0); PG8_SCHED; PG8_LDA(At, 0, 0); PG8_STAGE(PG8_SA(1, 1), a1 + hstepA, voffA);
            PG8_WAIT_L(8); PG8_BAR; PG8_WAIT_L(0); PG8_MMA(0, 0, At, B0); PG8_BAR; PG8_SCHED;
            PG8_LDB(B1, 0, 1); PG8_STAGE(PG8_SB(0, 0), b2, voffB);
            PG8_BAR; PG8_WAIT_L(0); PG8_MMA(0, 1, At, B1); PG8_BAR;
            PG8_LDA(At, 0, 1); PG8_STAGE(PG8_SA(0, 0), a2, voffA);
            PG8_BAR; PG8_WAIT_L(0); PG8_MMA(1, 0, At, B0); PG8_BAR; PG8_SCHED;
            PG8_STAGE(PG8_SB(0, 1), b2 + hstepB, voffB);
            PG8_WAIT_V(6); PG8_BAR; PG8_MMA(1, 1, At, B1); PG8_BAR;
            PG8_LDB(B0, 1, 0); PG8_SCHED; PG8_LDA(At, 1, 0); PG8_STAGE(PG8_SA(0, 1), a2 + hstepA, voffA);
            PG8_WAIT_L(8); PG8_BAR; PG8_WAIT_L(0); PG8_MMA(0, 0, At, B0); PG8_BAR; PG8_SCHED;
            PG8_LDB(B1, 1, 1); PG8_STAGE(PG8_SB(1, 0), b3, voffB);
            PG8_BAR; PG8_WAIT_L(0); PG8_MMA(0, 1, At, B1); PG8_BAR;
            PG8_LDA(At, 1, 1); PG8_STAGE(PG8_SA(1, 0), a3, voffA);
            PG8_BAR; PG8_WAIT_L(0); PG8_MMA(1, 0, At, B0); PG8_BAR; PG8_SCHED;
            PG8_STAGE(PG8_SB(1, 1), b3 + hstepB, voffB);
            PG8_WAIT_V(6); PG8_BAR; PG8_MMA(1, 1, At, B1); PG8_BAR;
            }
        }
        if constexpr (ALIGN_EPI) { if (wr == 0) PG8_BAR; }
        if constexpr (!Epi::AFTER_DRAIN) { E(acc, cur, wr, wc, fr, fq); S.done(cur); }
        if (!has_next) break;
#pragma unroll
        for (int a = 0; a < 2; ++a)
#pragma unroll
            for (int b = 0; b < 2; ++b)
#pragma unroll
                for (int m = 0; m < 4; ++m)
#pragma unroll
                    for (int n = 0; n < 2; ++n) { double z0_, z1_; asm volatile("v_mov_b64 %0, 0\n\tv_mov_b64 %1, 0" : "=v"(z0_), "=v"(z1_));
                        typedef double f64x2_ __attribute__((ext_vector_type(2))); acc[a][b][m][n] = __builtin_bit_cast(f32x4, (f64x2_){z0_, z1_}); }
        cur = nxt; cA = nA; cB = nB; ++ui; vA0[0] = wA0[0]; vA0[1] = wA0[1]; vA1[0] = wA1[0]; vA1[1] = wA1[1];
        if constexpr (ALIGN_EPI) { if (wr == 1) PG8_BAR; }
    }
    PG8_WAIT_V(0);
    if constexpr (!ALIGN_EPI) { if (wr == 0) PG8_BAR; }
    PG8_BAR;
    if constexpr (Epi::AFTER_DRAIN) { E.fused(acc, cur, wr, wc, fr, fq, lds, wid, lane); S.done(cur); }
#undef PG8_SA
#undef PG8_SB
#undef PG8_STAGE
#undef PG8_STAGEA
#undef PG8_GOFF
#undef PG8_LDA
#undef PG8_LDB
#undef PG8_MMA
#undef PG8_WAIT_V
#undef PG8_WAIT_L
#undef PG8_BAR
#undef PG8_SCHED
}
}
#define PG8_SP2 true
#define PG8_ALIGN true

struct Frame;
struct Args { const float* in[33]; float* out; unsigned char* ws; int ph_lo, ph_hi; };
struct Frame {
    unsigned char* lds;
    int tid, lane, wave, bid, nb;
    const float* const* in;
    float* out; unsigned char* ws;
    float* MOD; float* AFF; int* SEL; float* GATE; int* INV; bf16* X; bf16* H;
};
__device__ __forceinline__ void REFRESH_(Frame& F) { int l_; asm volatile("v_mbcnt_lo_u32_b32 %0, -1, 0\n\tv_mbcnt_hi_u32_b32 %0, -1, %0" : "=v"(l_)); F.lane = l_; F.tid = F.wave * 64 + l_; }
__device__ __forceinline__ int mod_row(int row) { const int b = row / P, pos = row - b * P; return pos < NCTX ? 32 : b; }

__device__ __forceinline__ void ph_s5_pre(const Frame& F) {
    const float *a_re = F.in[8], *a_im = F.in[9], *log_dt = F.in[10], *b_re = F.in[11], *b_im = F.in[12], *c_re = F.in[13], *c_im = F.in[14];
    f32x2* Bb = (f32x2*)F.lds;
    f32x2* Cc = Bb + 2048;
    f32x2* Ap = Cc + 2048;
    float* Kt = (float*)(Ap + 2 * 33 * 64);
    bf16* W1 = (bf16*)(F.ws + WS_S5W1); bf16* W2 = (bf16*)(F.ws + WS_S5W2); f32x2* A32 = (f32x2*)(F.ws + WS_S5A);
    const int tid = F.tid;
    for (int g = F.nb - 1 - F.bid; g < 64; g += F.nb) {
        __syncthreads();
        if (tid < 128) {
            const int dir = tid >> 6, p = tid & 63, dg = dir * 64 + g;
            const double are = (double)a_re[dg * 64 + p], aim = (double)a_im[dg * 64 + p], dt = exp((double)log_dt[dg]);
            const double lr = are * dt, li = aim * dt, cl = cos(li), sl = sin(li), mag = exp(lr);
            const double Abi = mag * sl, sh = sin(0.5 * li), nr = expm1(lr) * cl - 2.0 * sh * sh, den = are * are + aim * aim;
            const double fr = (nr * are + Abi * aim) / den, fi = (Abi * are - nr * aim) / den;
            for (int h = 0; h < 16; ++h) { const double br = (double)b_re[((size_t)dg * 64 + p) * 16 + h], bi = (double)b_im[((size_t)dg * 64 + p) * 16 + h];
                Bb[(dir * 64 + p) * 16 + h] = (f32x2){(float)(fr * br - fi * bi), (float)(fr * bi + fi * br)}; }
            const double Abr = mag * cl; double pr = 1.0, pi = 0.0;
            for (int e = 0; e <= 32; ++e) { const f32x2 v = {(float)pr, (float)pi};
                Ap[(dir * 33 + e) * 64 + p] = v; if (e == 32) A32[(g * 2 + dir) * 64 + p] = v;
                const double nr2 = pr * Abr - pi * Abi, ni2 = pr * Abi + pi * Abr; pr = nr2; pi = ni2; }
        }
        for (int i = tid; i < 2048; i += NTHREADS) { const int dir = i >> 10, k = (i >> 6) & 15, p = i & 63; const size_t o = ((size_t)(dir * 64 + g) * 16 + k) * 64 + p; Cc[i] = (f32x2){c_re[o], c_im[o]}; }
        __syncthreads();
        {
            const int dir = tid >> 8, k = (tid >> 4) & 15, h = tid & 15; float acc[32];
#pragma unroll
            for (int lag = 0; lag < 32; ++lag) acc[lag] = 0.f;
#pragma unroll 2
            for (int p = 0; p < 64; ++p) { const f32x2 c = Cc[(dir * 16 + k) * 64 + p], bb = Bb[(dir * 64 + p) * 16 + h], a1 = Ap[(dir * 33 + 1) * 64 + p];
                float zr = c.x * bb.x - c.y * bb.y, zi = c.x * bb.y + c.y * bb.x;
#pragma unroll
                for (int lag = 0; lag < 32; ++lag) { acc[lag] += zr; const float nz = zr * a1.x - zi * a1.y; zi = zr * a1.y + zi * a1.x; zr = nz; } }
#pragma unroll
            for (int lag = 0; lag < 32; ++lag) Kt[((dir * 32 + lag) * 16 + k) * 16 + h] = acc[lag];
        }
        for (int i = tid; i < 16384; i += NTHREADS) {
            const int n = i >> 6, sg = (i >> 1) & 31, h0 = (i & 1) * 8, dir = n >> 7, c = (n >> 6) & 1, p = n & 63, e = dir ? sg : 31 - sg;
            const f32x2 a = Ap[(dir * 33 + e) * 64 + p]; float v[8];
#pragma unroll
            for (int q = 0; q < 8; ++q) { const f32x2 bb = Bb[(dir * 64 + p) * 16 + h0 + q]; v[q] = c ? a.x * bb.y + a.y * bb.x : a.x * bb.x - a.y * bb.y; }
            u32x4 w; w.x = pk2(v[0], v[1]); w.y = pk2(v[2], v[3]); w.z = pk2(v[4], v[5]); w.w = pk2(v[6], v[7]);
            *(u32x4*)(W1 + ((size_t)g * 256 + n) * 512 + sg * 16 + h0) = w;
        }
        for (int i = tid; i < 16384; i += NTHREADS) {
            const int m = i >> 5, n0 = (i & 31) * 8, dir = n0 >> 7, c = (n0 >> 6) & 1, p0 = n0 & 63, tau = m >> 4, k = m & 15, e = dir ? 32 - tau : tau + 1; float v[8];
#pragma unroll
            for (int q = 0; q < 8; ++q) { const f32x2 cc = Cc[(dir * 16 + k) * 64 + p0 + q], a = Ap[(dir * 33 + e) * 64 + p0 + q]; v[q] = c ? -(cc.x * a.y + cc.y * a.x) : cc.x * a.x - cc.y * a.y; }
            u32x4 w; w.x = pk2(v[0], v[1]); w.y = pk2(v[2], v[3]); w.z = pk2(v[4], v[5]); w.w = pk2(v[6], v[7]);
            *(u32x4*)(W2 + ((size_t)g * 512 + m) * 768 + 512 + n0) = w;
        }
        __syncthreads();
        for (int i = tid; i < 32768; i += NTHREADS) {
            const int m = i >> 6, sg = (i >> 1) & 31, h0 = (i & 1) * 8, tau = m >> 4, k = m & 15; float v[8];
#pragma unroll
            for (int q = 0; q < 8; ++q) { float x = 0.f; if (sg <= tau) x += Kt[((tau - sg) * 16 + k) * 16 + h0 + q]; if (sg >= tau) x += Kt[((32 + sg - tau) * 16 + k) * 16 + h0 + q]; v[q] = x; }
            u32x4 w; w.x = pk2(v[0], v[1]); w.y = pk2(v[2], v[3]); w.z = pk2(v[4], v[5]); w.w = pk2(v[6], v[7]);
            *(u32x4*)(W2 + ((size_t)g * 512 + m) * 768 + sg * 16 + h0) = w;
        }
    }
    __syncthreads();
}
__device__ __forceinline__ void ph_s5_scan(const Frame& F) {
    const float* SS = (const float*)(F.ws + WS_SS); bf16* AG = (bf16*)(F.ws + WS_AG); const f32x2* A32 = (const f32x2*)(F.ws + WS_S5A);
    for (int gid = F.bid * NTHREADS + F.tid; gid < 64 * 32 * 128; gid += F.nb * NTHREADS) {
        const int p = gid & 63, dir = (gid >> 6) & 1, b = (gid >> 7) & 31, g = gid >> 12;
        const f32x2 a = A32[(g * 2 + dir) * 64 + p];
        float hr = 0.f, hi = 0.f;
        const size_t row0 = (size_t)g * 2304 + b * 72;
#pragma unroll 4
        for (int idx = 0; idx < 72; ++idx) {
            const int j = dir == 0 ? idx : (idx < 8 ? 7 - idx : 79 - idx);
            const size_t row = row0 + j;
            AG[row * 768 + 512 + dir * 128 + p] = (bf16)f2bf(hr); AG[row * 768 + 512 + dir * 128 + 64 + p] = (bf16)f2bf(hi);
            const float sr = SS[row * 256 + dir * 128 + p], si = SS[row * 256 + dir * 128 + 64 + p];
            const float nr = a.x * hr - a.y * hi + sr, ni = a.x * hi + a.y * hr + si; hr = nr; hi = ni;
        }
    }
}

template <int DUAL>
__device__ __forceinline__ void transpose_item(const float* W, int ldw, int K, int N, bf16* WT, int row_off, LAS float* scr, int item, int lane) {
    const int nblk = N / 64, kb = item / nblk, nb = item - kb * nblk, k0 = 64 * kb, n0 = 64 * nb;
    const int lr = lane >> 4, lc = (lane & 15) * 4;
    f32x4 v[16];
#pragma unroll
    for (int i = 0; i < 16; ++i) v[i] = *(const f32x4*)(W + (size_t)(k0 + lr + 4 * i) * ldw + n0 + lc);
#pragma unroll
    for (int i = 0; i < 16; ++i) { LAS float* d = scr + (lr + 4 * i) * 65 + lc; d[0] = v[i].x; d[1] = v[i].y; d[2] = v[i].z; d[3] = v[i].w; }
    asm volatile("s_waitcnt lgkmcnt(0)" ::: "memory");
    const int c = lane & 7;
#pragma unroll
    for (int j = 0; j < 8; ++j) { const int n = (lane >> 3) + 8 * j; const LAS float* sp = scr + (8 * c) * 65 + n;
        u32x4 o; o.x = pkbf(sp[0 * 65], sp[1 * 65]); o.y = pkbf(sp[2 * 65], sp[3 * 65]); o.z = pkbf(sp[4 * 65], sp[5 * 65]); o.w = pkbf(sp[6 * 65], sp[7 * 65]);
        const int nn = n0 + n, dest = DUAL == -2 ? (nn < 3072 ? nn : (nn < 4096 ? nn + 1024 : nn - 1024)) : (DUAL < 0 ? row_off + nn : row_off + (nn >> 7) * 256 + DUAL * 128 + (nn & 127));
        *(u32x4*)(WT + (size_t)dest * K + k0 + 8 * c) = o; }
    asm volatile("s_waitcnt lgkmcnt(0)" ::: "memory");
}
__device__ __forceinline__ void convert_moe(const Frame& F, int l, int cb = -1, int cnb = 0) {
    if (cb < 0) { cb = F.bid; cnb = F.nb; }
    if (cb >= cnb) return;
    LAS float* scr = (LAS float*)((LAS unsigned char*)F.lds) + F.wave * 4160;
    bf16* WGU = (bf16*)(F.ws + WO_GU); bf16* WDN = (bf16*)(F.ws + WO_DN);
    for (int it = cb * NWAVES + F.wave; it < 24576; it += cnb * NWAVES) {
        const int m = it >> 13, r = it & 8191, e = r >> 9, item = r & 511;
        if (m == 0) transpose_item<0>(F.in[29] + (size_t)(l * NE + e) * D * FF, FF, D, FF, WGU, e * 2 * FF, scr, item, F.lane);
        else if (m == 1) transpose_item<1>(F.in[30] + (size_t)(l * NE + e) * D * FF, FF, D, FF, WGU, e * 2 * FF, scr, item, F.lane);
        else transpose_item<-1>(F.in[31] + (size_t)(l * NE + e) * FF * D, D, FF, D, WDN, e * D, scr, item, F.lane);
    }
}
__device__ __forceinline__ void convert_mixers(const Frame& F, int cb, int cnb) {
    if (cb >= cnb) return;
    LAS float* scr = (LAS float*)((LAS unsigned char*)F.lds) + F.wave * 4160;
    for (int it = cb * NWAVES + F.wave; it < 4096; it += cnb * NWAVES) {
        int r = it;
        if (r < 256) { transpose_item<0>(F.in[16], 2 * D, D, D, (bf16*)(F.ws + WO_GLU), 0, scr, r, F.lane); continue; } r -= 256;
        if (r < 256) { transpose_item<1>(F.in[16] + D, 2 * D, D, D, (bf16*)(F.ws + WO_GLU), 0, scr, r, F.lane); continue; } r -= 256;
        if (r < 768) { transpose_item<-1>(F.in[17], 3 * D, D, 3 * D, (bf16*)(F.ws + WO_NAQKV), 0, scr, r, F.lane); continue; } r -= 768;
        if (r < 256) { transpose_item<-1>(F.in[18], D, D, D, (bf16*)(F.ws + WO_NAO), 0, scr, r, F.lane); continue; } r -= 256;
        if (r < 768) { transpose_item<-1>(F.in[20], 3 * D, D, 3 * D, (bf16*)(F.ws + WO_DAQKV), 0, scr, r, F.lane); continue; } r -= 768;
        if (r < 256) { transpose_item<-1>(F.in[21], D, D, D, (bf16*)(F.ws + WO_DAO), 0, scr, r, F.lane); continue; } r -= 256;
        if (r < 1280) { transpose_item<-2>(F.in[24], 5 * D, D, 5 * D, (bf16*)(F.ws + WO_HGIN), 0, scr, r, F.lane); continue; } r -= 1280;
        transpose_item<-1>(F.in[25], D, D, D, (bf16*)(F.ws + WO_HGO), 0, scr, r, F.lane);
    }
}

__device__ __forceinline__ void ph_prologue(const Frame& F) {
    {
        float* S = (float*)F.lds;
        for (int i = F.tid; i < 33 * 1024; i += NTHREADS) { const float v = i < 32 * 1024 ? F.in[1][i] : F.in[3][i - 32 * 1024]; S[i] = siluf_(v); }
        __syncthreads();
        float acc[2][33];
#pragma unroll
        for (int t = 0; t < 2; ++t)
#pragma unroll
            for (int r = 0; r < 33; ++r) acc[t][r] = 0.f;
#pragma unroll
        for (int t = 0; t < 2; ++t) {
            const int task = F.bid + t * F.nb;
            if (task < 384) {
                const int l = task / 96, col = (task % 96) * 64 + F.lane, kb = F.wave * 128;
                const float* W = F.in[4] + (size_t)l * 1024 * 6144 + col;
#pragma unroll 1
                for (int k = kb; k < kb + 128; k += 8) {
                    float w[8];
#pragma unroll
                    for (int q = 0; q < 8; ++q) w[q] = W[(size_t)(k + q) * 6144];
#pragma unroll
                    for (int r = 0; r < 33; ++r) { const f32x4 s0 = *(const f32x4*)&S[r * 1024 + k], s1 = *(const f32x4*)&S[r * 1024 + k + 4];
                        acc[t][r] += (s0.x * w[0] + s0.y * w[1]) + (s0.z * w[2] + s0.w * w[3]) + (s1.x * w[4] + s1.y * w[5]) + (s1.z * w[6] + s1.w * w[7]); }
                }
            }
        }
        __syncthreads();
#pragma unroll
        for (int t = 0; t < 2; ++t)
#pragma unroll
            for (int r = 0; r < 33; ++r) S[((t * 8 + F.wave) * 33 + r) * 64 + F.lane] = acc[t][r];
        __syncthreads();
        for (int i = F.tid; i < 2 * 33 * 64; i += NTHREADS) {
            const int t = i / (33 * 64), r = (i / 64) % 33, ln = i & 63, task = F.bid + t * F.nb;
            if (task < 384) { const int l = task / 96, col = (task % 96) * 64 + ln; float v = F.in[5][l * 6144 + col];
#pragma unroll
                for (int w = 0; w < 8; ++w) v += S[((t * 8 + w) * 33 + r) * 64 + ln];
                F.MOD[((size_t)l * 33 + r) * 6144 + col] = v; }
        }
        __syncthreads();
    }
    if (F.bid == 48) {
        const float* lbin = F.in[27];
        for (int c = F.tid; c < D; c += NTHREADS) { const float x0 = lbin[c], x1 = lbin[D + c], x2 = lbin[2 * D + c], x3 = lbin[3 * D + c], mx = fmaxf(fmaxf(x0, x1), fmaxf(x2, x3));
            const float e0 = expf(x0 - mx), e1 = expf(x1 - mx), e2 = expf(x2 - mx), e3 = expf(x3 - mx); ((float*)(F.ws + WS_LB))[c] = (e1 + e2 + e3) / (e0 + e1 + e2 + e3); }
    }
    if (F.bid == 49) {
        for (int i = F.tid; i < 64 * 16; i += NTHREADS) { const float inv = powf(10000.0f, -(float)(i & 15) * (1.0f / 16.0f)); float sn, cs; sincosf((float)(i >> 4) * inv, &sn, &cs);
            ((float*)(F.ws + WS_ROPE))[2 * i] = cs; ((float*)(F.ws + WS_ROPE))[2 * i + 1] = sn; }
    }
    { const int ncv = F.nb > 128 ? F.nb - 64 : F.nb;
      convert_mixers(F, F.bid, ncv); convert_moe(F, 0, F.bid, ncv); }
    __syncthreads();
    ph_s5_pre(F);
}

template <bool F32> struct XRawT { typedef f32x4 T; };
template <> struct XRawT<false> { typedef u32x2 T; };
__device__ __forceinline__ f32x4 xcvt(const f32x4& r) { return r; }
__device__ __forceinline__ f32x4 xcvt(const u32x2& r) { return (f32x4){bflo(r.x), bfhi(r.x), bflo(r.y), bfhi(r.y)}; }
template <int MODE, bool COMBINE, bool S5OUT = false, bool SKIPCTX = false, bool FROMIN = false>
__device__ __forceinline__ void ph_norm(const Frame& F, int layer, int prev_layer) {
    static_assert(MODE != 1, "norm2 + router is ph_norm2");
    const float* nw = MODE == 0 ? F.in[6] + layer * D : F.in[32];
    const bf16* Y = (const bf16*)(F.ws + WS_Y);
    constexpr int NI = SKIPCTX ? NB * SEQ : R;
    constexpr int NPF = 4;
    const int per = (NI + F.nb * NWAVES - 1) / (F.nb * NWAVES);
    int it = (F.bid * NWAVES + F.wave) * per; const int itend = min(NI, it + per);
    typedef typename XRawT<FROMIN>::T XR;
    const __amdgpu_buffer_rsrc_t yrs = __builtin_amdgcn_make_buffer_rsrc((void*)Y, 0, (int)((size_t)NE * SLOTS * D * 2), 0x00020000);
    const int l16 = F.lane & 15;
#define NORM_ROWOF(i_) (SKIPCTX ? ((i_) >> 11) * P + NCTX + ((i_) & (SEQ - 1)) : (i_))
#define NORM_XPTR(r_) ((FROMIN ? (const XR*)(((r_) % P) < NCTX ? F.in[2] + ((size_t)((r_) / P) * NCTX + ((r_) % P)) * D : F.in[0] + ((size_t)((r_) / P) * SEQ + ((r_) % P) - NCTX) * D) : (const XR*)(F.X + (size_t)(r_) * D)) + F.lane)
#define NORM_STAGE(i_, INVA_, V_, G_, Yq_, INVB_) do { \
        const int ic_ = min((i_), itend - 1), ic1_ = min((i_) + 1, itend - 1); const int rA_ = NORM_ROWOF(ic_); \
        if (COMBINE) INVB_ = F.INV[(size_t)NORM_ROWOF(ic1_) * NE + l16]; \
        if (COMBINE) G_ = F.GATE[l16 * SLOTS + max(INVA_, 0)]; \
        { const XR* xp_ = NORM_XPTR(rA_); _Pragma("unroll") for (int j = 0; j < 4; ++j) V_[j] = xp_[64 * j]; } \
        if (COMBINE) { unsigned m_ = ((i_) < itend) ? (unsigned)(__ballot(F.lane < NE && INVA_ >= 0) & 0xffffull) : 0u; \
            _Pragma("unroll") for (int q = 0; q < NPF; ++q) { const bool pr_ = m_ != 0u; const int e_ = pr_ ? __builtin_ctz(m_) : 0; m_ &= m_ - 1u; const int s_ = __builtin_amdgcn_readlane(INVA_, e_); \
                const unsigned vo_ = pr_ ? (unsigned)(e_ * SLOTS + s_) * (unsigned)(D * 2) + (unsigned)F.lane * 8u : 0xfffff000u; \
                _Pragma("unroll") for (int j = 0; j < 4; ++j) Yq_[q][j] = __builtin_amdgcn_raw_buffer_load_b64(yrs, vo_ + 512u * j, 0, 0); } } \
    } while (0)
    XR v[4]; u32x2 yc[NPF][4]; float gl = 0.f; int invl = -1, invn = -1;
    if (COMBINE) invl = F.INV[(size_t)NORM_ROWOF(min(it, NI - 1)) * NE + l16];
    NORM_STAGE(it, invl, v, gl, yc, invn);
    const f32x4* nw4 = (const f32x4*)nw + F.lane;
    f32x4 g5[4], nwv[4], shv[4], scv[4]; int mrc = -1;
#pragma unroll
    for (int j = 0; j < 4; ++j) { nwv[j] = nw4[64 * j]; g5[j] = shv[j] = scv[j] = (f32x4){0.f, 0.f, 0.f, 0.f}; }
    while (it < itend) {
        const int row = NORM_ROWOF(it), b = row / P, pos = row - b * P, mr = pos < NCTX ? 32 : b;
        if (mr != mrc) { mrc = mr;
            const float* mrow = F.MOD + ((size_t)layer * 33 + mr) * 6144;
#pragma unroll
            for (int j = 0; j < 4; ++j) {
                if (COMBINE) g5[j] = ((const f32x4*)(F.MOD + ((size_t)prev_layer * 33 + mr) * 6144 + 5 * D) + F.lane)[64 * j];
                if (MODE != 2) { shv[j] = ((const f32x4*)(mrow + (MODE == 0 ? 0 : 3) * D) + F.lane)[64 * j]; scv[j] = ((const f32x4*)(mrow + (MODE == 0 ? 1 : 4) * D) + F.lane)[64 * j]; }
            }
        }
        XR vn[4]; u32x2 yn[NPF][4]; float gln = 0.f; int invnn = -1;
        NORM_STAGE(it + 1, invn, vn, gln, yn, invnn);
        f32x4 a[4];
#pragma unroll
        for (int j = 0; j < 4; ++j) a[j] = (f32x4){0.f, 0.f, 0.f, 0.f};
        if (COMBINE) {
            unsigned m = (unsigned)(__ballot(F.lane < NE && invl >= 0) & 0xffffull);
#pragma unroll
            for (int q = 0; q < NPF; ++q) {
                const bool pr = m != 0u; const int e = pr ? __builtin_ctz(m) : 0; m &= m - 1u;
                const float g = pr ? __uint_as_float(__builtin_amdgcn_readlane(__float_as_uint(gl), e)) : 0.f;
#pragma unroll
                for (int j = 0; j < 4; ++j) { a[j].x += g * bflo(yc[q][j].x); a[j].y += g * bfhi(yc[q][j].x); a[j].z += g * bflo(yc[q][j].y); a[j].w += g * bfhi(yc[q][j].y); }
            }
            while (m) {
                const int e = __builtin_ctz(m); m &= m - 1u;
                const int sl = __builtin_amdgcn_readlane(invl, e); const float g = __uint_as_float(__builtin_amdgcn_readlane(__float_as_uint(gl), e));
                const u32x2* y0 = (const u32x2*)(Y + ((size_t)e * SLOTS + sl) * D) + F.lane;
                u32x2 w0[4];
#pragma unroll
                for (int j = 0; j < 4; ++j) w0[j] = y0[64 * j];
#pragma unroll
                for (int j = 0; j < 4; ++j) { a[j].x += g * bflo(w0[j].x); a[j].y += g * bfhi(w0[j].x); a[j].z += g * bflo(w0[j].y); a[j].w += g * bfhi(w0[j].y); }
            }
        }
        f32x4 vv[4];
#pragma unroll
        for (int j = 0; j < 4; ++j) vv[j] = xcvt(v[j]);
        if (COMBINE) {
#pragma unroll
            for (int j = 0; j < 4; ++j) vv[j] = vv[j] + g5[j] * a[j];
        }
        if ((FROMIN || COMBINE) && MODE != 2) { u32x2* xw = (u32x2*)(F.X + (size_t)row * D) + F.lane;
#pragma unroll
            for (int j = 0; j < 4; ++j) { u32x2 w; w.x = pkbf(vv[j].x, vv[j].y); w.y = pkbf(vv[j].z, vv[j].w); xw[64 * j] = w; } }
        float ss = 0.f;
#pragma unroll
        for (int j = 0; j < 4; ++j) ss += (vv[j].x * vv[j].x + vv[j].y * vv[j].y) + (vv[j].z * vv[j].z + vv[j].w * vv[j].w);
        const float rinv = rsqrtf(wave_sum(ss) * (1.0f / D) + EPS);
        if (MODE == 2) {
            if (pos >= NCTX) {
                f32x4* o = (f32x4*)(F.out + ((size_t)b * SEQ + pos - NCTX) * D) + F.lane;
#pragma unroll
                for (int j = 0; j < 4; ++j) o[64 * j] = vv[j] * rinv * nwv[j];
            }
        } else {
            u32x2* ho = (u32x2*)(F.H + (size_t)row * D) + F.lane;
            f32x4 h[4];
#pragma unroll
            for (int j = 0; j < 4; ++j) { h[j] = vv[j] * rinv * nwv[j] * (scv[j] + 1.0f) + shv[j]; u32x2 w; w.x = pkbf(h[j].x, h[j].y); w.y = pkbf(h[j].z, h[j].w); ho[64 * j] = w;
                if (S5OUT) { const int g = (F.lane >> 2) + 16 * j;
                    *(u32x2*)((bf16*)(F.ws + WS_AG) + ((size_t)g * 2304 + b * 72 + (pos >> 5)) * 768 + (pos & 31) * 16 + (F.lane & 3) * 4) = w; } }
        }
#pragma unroll
        for (int j = 0; j < 4; ++j) { v[j] = vn[j];
#pragma unroll
            for (int q = 0; q < NPF; ++q) yc[q][j] = yn[q][j]; }
        gl = gln; invl = invn; invn = invnn; ++it;
    }
#undef NORM_STAGE
#undef NORM_XPTR
#undef NORM_ROWOF
}

template <bool SKIPCTX>
__device__ __forceinline__ void ph_norm2(const Frame& F, int layer) {
    const float* nw = F.in[7] + layer * D;
    LAS float* wrt = (LAS float*)((LAS unsigned char*)F.lds);
    {
        const float* wr = F.in[28] + (size_t)layer * D * NE;
        for (int i = F.tid; i < D * NE; i += NTHREADS) wrt[(i & 15) * (D + 4) + (i >> 4)] = wr[i];
        __syncthreads();
    }
    const f32x4* nw4 = (const f32x4*)nw + F.lane;
    const int eid = ((F.lane & 1) << 3) | ((F.lane & 2) << 1) | ((F.lane & 4) >> 1) | ((F.lane & 8) >> 3);
    constexpr int NI = SKIPCTX ? NB * SEQ / 2 : R / 2;
    const int per = (NI + F.nb * NWAVES - 1) / (F.nb * NWAVES), it0 = (F.bid * NWAVES + F.wave) * per, it1 = min(NI, it0 + per);
    f32x4 gv[4], shv[4]; int mrc = -1;
#pragma unroll
    for (int j = 0; j < 4; ++j) gv[j] = shv[j] = (f32x4){0.f, 0.f, 0.f, 0.f};
#define N2_ROWOF(i_) (SKIPCTX ? ((i_) >> 10) * P + NCTX + 2 * ((i_) & (SEQ / 2 - 1)) : 2 * (i_))
    u32x2 w0[4], w1[4];
    { const u32x2* x0 = (const u32x2*)(F.X + (size_t)N2_ROWOF(min(it0, NI - 1)) * D) + F.lane;
#pragma unroll
      for (int j = 0; j < 4; ++j) { w0[j] = x0[64 * j]; w1[j] = x0[256 + 64 * j]; } }
    for (int it = it0; it < it1; ++it) {
        const int row = N2_ROWOF(it), b = row / P, pos = row - b * P, mr = pos < NCTX ? 32 : b;
        f32x4 v0[4], v1[4];
#pragma unroll
        for (int j = 0; j < 4; ++j) { v0[j] = xcvt(w0[j]); v1[j] = xcvt(w1[j]); }
        if (mr != mrc) { mrc = mr;
            const float* mrow = F.MOD + ((size_t)layer * 33 + mr) * 6144;
#pragma unroll
            for (int j = 0; j < 4; ++j) { shv[j] = ((const f32x4*)(mrow + 3 * D) + F.lane)[64 * j]; gv[j] = nw4[64 * j] * (((const f32x4*)(mrow + 4 * D) + F.lane)[64 * j] + 1.0f); }
        }
        u32x2 n0[4], n1[4];
        { const u32x2* xn = (const u32x2*)(F.X + (size_t)N2_ROWOF(min(it + 1, it1 - 1)) * D) + F.lane;
#pragma unroll
          for (int j = 0; j < 4; ++j) { n0[j] = xn[64 * j]; n1[j] = xn[256 + 64 * j]; } }
        float s0 = 0.f, s1 = 0.f;
#pragma unroll
        for (int j = 0; j < 4; ++j) { s0 += (v0[j].x * v0[j].x + v0[j].y * v0[j].y) + (v0[j].z * v0[j].z + v0[j].w * v0[j].w); s1 += (v1[j].x * v1[j].x + v1[j].y * v1[j].y) + (v1[j].z * v1[j].z + v1[j].w * v1[j].w); }
        const float r0 = rsqrtf(wave_sum(s0) * (1.0f / D) + EPS), r1 = rsqrtf(wave_sum(s1) * (1.0f / D) + EPS);
        u32x2* h0 = (u32x2*)(F.H + (size_t)row * D) + F.lane; u32x2* h1 = h0 + 256;
#pragma unroll
        for (int j = 0; j < 4; ++j) { const f32x4 g = gv[j];
            v0[j] = v0[j] * r0 * g + shv[j]; v1[j] = v1[j] * r1 * g + shv[j];
            u32x2 w; w.x = pkbf(v0[j].x, v0[j].y); w.y = pkbf(v0[j].z, v0[j].w); h0[64 * j] = w;
            w.x = pkbf(v1[j].x, v1[j].y); w.y = pkbf(v1[j].z, v1[j].w); h1[64 * j] = w; }
        f32x2 a0[NE], a1[NE];
#pragma unroll
        for (int e = 0; e < NE; ++e) { a0[e] = (f32x2){0.f, 0.f}; a1[e] = (f32x2){0.f, 0.f}; }
#pragma unroll
        for (int j = 0; j < 4; ++j) { asm volatile("" ::: "memory");
            const f32x2 p0 = {v0[j].x, v0[j].y}, q0 = {v0[j].z, v0[j].w}, p1 = {v1[j].x, v1[j].y}, q1 = {v1[j].z, v1[j].w};
#pragma unroll
            for (int e = 0; e < NE; ++e) { const f32x4 w = *(const LAS f32x4*)(wrt + e * (D + 4) + F.lane * 4 + 256 * j); const f32x2 wl = {w.x, w.y}, wh = {w.z, w.w};
                a0[e] += p0 * wl; a0[e] += q0 * wh; a1[e] += p1 * wl; a1[e] += q1 * wh; } }
        float lg0[NE], lg1[NE];
#pragma unroll
        for (int e = 0; e < NE; ++e) { lg0[e] = a0[e].x + a0[e].y; lg1[e] = a1[e].x + a1[e].y; }
        const float t0 = reduce16(lg0, F.lane), t1 = reduce16(lg1, F.lane);
        float m0 = fmaxf(t0, dpp_xor1(t0)), m1 = fmaxf(t1, dpp_xor1(t1));
        m0 = fmaxf(m0, dpp_xor2(m0)); m1 = fmaxf(m1, dpp_xor2(m1)); m0 = fmaxf(m0, __shfl_xor(m0, 4)); m1 = fmaxf(m1, __shfl_xor(m1, 4)); m0 = fmaxf(m0, __shfl_xor(m0, 8)); m1 = fmaxf(m1, __shfl_xor(m1, 8));
        const float e0 = __builtin_amdgcn_exp2f((t0 - m0) * LOG2E_), e1 = __builtin_amdgcn_exp2f((t1 - m1) * LOG2E_);
        float z0 = e0 + dpp_xor1(e0), z1 = e1 + dpp_xor1(e1);
        z0 += dpp_xor2(z0); z1 += dpp_xor2(z1); z0 += __shfl_xor(z0, 4); z1 += __shfl_xor(z1, 4); z0 += __shfl_xor(z0, 8); z1 += __shfl_xor(z1, 8);
        if (F.lane < NE) { float* ap = F.AFF + ((size_t)b * NE + eid) * P + pos; ap[0] = e0 / z0; ap[1] = e1 / z1; }
#pragma unroll
        for (int j = 0; j < 4; ++j) { w0[j] = n0[j]; w1[j] = n1[j]; }
    }
#undef N2_ROWOF
}

__device__ __forceinline__ void ph_topk(const Frame& F, int nitems) {
    const int tid = F.tid, lane = F.lane, half = F.wave >> 2, hw = F.wave & 3, ht = tid & 255;
    unsigned* hist = (unsigned*)F.lds + half * 288;
    unsigned* wtot = hist + 256;
    unsigned* bc = wtot + 8;
    for (int item0 = F.bid; item0 < nitems; item0 += 2 * F.nb) {
        const int item = item0 + half * F.nb; const bool valid = item < nitems;
        const int seg = item >> 9, b = (item >> 4) & 31, e = item & 15;
        const int n = seg ? NCTX : SEQ, pos0 = seg ? 0 : NCTX, cap = n / 8, slot0 = seg ? NB * 256 + b * 32 : b * 256;
        const int per = seg ? 1 : 8;
        const float* a = F.AFF + ((size_t)b * NE + e) * P + pos0;
        unsigned u[8];
#pragma unroll
        for (int q = 0; q < 8; ++q) u[q] = 0u;
        if (valid) {
            if (seg) u[0] = __float_as_uint(a[ht]);
            else { const f32x4 a0 = *(const f32x4*)(a + ht * 8), a1 = *(const f32x4*)(a + ht * 8 + 4);
                u[0] = __float_as_uint(a0.x); u[1] = __float_as_uint(a0.y); u[2] = __float_as_uint(a0.z); u[3] = __float_as_uint(a0.w);
                u[4] = __float_as_uint(a1.x); u[5] = __float_as_uint(a1.y); u[6] = __float_as_uint(a1.z); u[7] = __float_as_uint(a1.w); }
        }
        unsigned prefix = 0u, mask = 0u, kk = (unsigned)cap;
#pragma unroll 1
        for (int pass = 0; pass < 4; ++pass) {
            const int shift = 24 - 8 * pass;
            __syncthreads();
            hist[ht] = 0u;
            __syncthreads();
            if (valid) {
#pragma unroll
                for (int q = 0; q < 8; ++q) if (q < per && (u[q] & mask) == prefix) atomicAdd(&hist[(u[q] >> shift) & 255u], 1u);
            }
            __syncthreads();
            unsigned hv = hist[255 - ht], cum = hv;
#pragma unroll
            for (int o = 1; o < 64; o <<= 1) { const unsigned t = __shfl_up(cum, o); if (lane >= o) cum += t; }
            if (lane == 63) wtot[hw] = cum;
            __syncthreads();
            {
                unsigned off = 0u;
#pragma unroll
                for (int w = 0; w < 4; ++w) if (w < hw) off += wtot[w];
                cum += off;
                if (cum >= kk && cum - hv < kk) { bc[0] = 255u - (unsigned)ht; bc[1] = kk - (cum - hv); }
            }
            __syncthreads();
            prefix |= bc[0] << shift; mask |= 255u << shift; kk = bc[1];
        }
        unsigned cg = 0u, ce = 0u;
        if (valid) {
#pragma unroll
            for (int q = 0; q < 8; ++q) if (q < per) { cg += u[q] > prefix ? 1u : 0u; ce += u[q] == prefix ? 1u : 0u; }
        }
        unsigned pk = cg | (ce << 16), inc = pk;
#pragma unroll
        for (int o = 1; o < 64; o <<= 1) { const unsigned t = __shfl_up(inc, o); if (lane >= o) inc += t; }
        __syncthreads();
        if (lane == 63) wtot[hw] = inc;
        __syncthreads();
        unsigned off = 0u;
#pragma unroll
        for (int w = 0; w < 4; ++w) if (w < hw) off += wtot[w];
        unsigned excl = inc - pk + off, gb = excl & 0xffffu, eb = excl >> 16;
        if (valid) {
#pragma unroll
            for (int q = 0; q < 8; ++q) if (q < per) {
                const int i = ht * per + q, row = b * P + pos0 + i;
                const bool gt = u[q] > prefix, eq = u[q] == prefix, sel = gt || (eq && eb < kk);
                if (sel) { const int slot = slot0 + (int)(gb + (eb < kk ? eb : kk)); F.SEL[e * SLOTS + slot] = row; F.GATE[e * SLOTS + slot] = __uint_as_float(u[q]); F.INV[(size_t)row * NE + e] = slot; }
                else F.INV[(size_t)row * NE + e] = -1;
                gb += gt ? 1u : 0u; eb += eq ? 1u : 0u;
            }
        }
        __syncthreads();
    }
    __syncthreads();
}

typedef short bf16x8 __attribute__((ext_vector_type(8)));
typedef float f32x16 __attribute__((ext_vector_type(16)));
#define MFMA32(a, b, c) __builtin_amdgcn_mfma_f32_32x32x16_bf16((a), (b), (c), 0, 0, 0)
__device__ __forceinline__ int kperm(int m) { return (m & 0x13) | ((m & 8) >> 1) | ((m & 4) << 1); }
__device__ __forceinline__ bf16x8 pack8(const f32x16& x, int s8) {
    u32x4 p; p.x = pkbf(x[s8 + 0], x[s8 + 1]); p.y = pkbf(x[s8 + 2], x[s8 + 3]); p.z = pkbf(x[s8 + 4], x[s8 + 5]); p.w = pkbf(x[s8 + 6], x[s8 + 7]);
    return __builtin_bit_cast(bf16x8, p);
}
constexpr float LOG2E = 1.4426950408889634f;

__device__ __forceinline__ void ph_da_attn(const Frame& F) {
    const bf16* Q = (const bf16*)(F.ws + WS_Q); const bf16* K = (const bf16*)(F.ws + WS_K); const bf16* VT = (const bf16*)(F.ws + WS_VT); bf16* O = (bf16*)(F.ws + WS_O);
    const int tid = F.tid, lane = F.lane, l32 = lane & 31, hh = lane >> 5, map = F.wave & 1, qsub = F.wave >> 1;
    const float* lam = F.in[22];
    const float lam_full = expf(wave_sum(lam[lane] * lam[64 + lane])) - expf(wave_sum(lam[128 + lane] * lam[192 + lane])) + LAM_INIT;
    constexpr int KB = 64 * 144, VB = 128 * 144, BUF = 2 * KB + VB;
    unsigned char* sb = F.lds;
    float* xch = (float*)(F.lds + 2 * BUF) + qsub * 4096;
    const float c = 0.125f * LOG2E;
    const int kr = (tid >> 3) & 63, kc = tid & 7, vd = tid >> 3, vc = tid & 7;
    const int kdst = kr * 144 + kc * 16, vdst = 2 * KB + vd * 144 + vc * 16;
    const int kfrag = map * KB + kperm(l32) * 144 + hh * 16, vfrag = 2 * KB + l32 * 144 + hh * 16;
    const int vb = (F.nb & 7) == 0 ? (F.bid & 7) * (F.nb >> 3) + (F.bid >> 3) : F.bid;
    for (int it = vb; it < 4096 + 512; it += F.nb) {
        int b, h, pos0, nst;
        if (it < 4096) { b = it >> 7; h = (it >> 4) & 7; pos0 = NCTX + (it & 15) * 128 + qsub * 32; nst = P / 64; }
        else { const int j = it - 4096; b = j >> 4; h = (j >> 1) & 7; pos0 = (j & 1) * 128 + qsub * 32; nst = NCTX / 64; }
        const size_t qrow = (size_t)b * P + pos0 + l32;
        bf16x8 qf[4];
#pragma unroll
        for (int ks = 0; ks < 4; ++ks) qf[ks] = *(const bf16x8*)(Q + qrow * D + h * 128 + map * 64 + ks * 16 + hh * 8);
        f32x16 o[4];
#pragma unroll
        for (int dt = 0; dt < 4; ++dt)
#pragma unroll
            for (int j = 0; j < 16; ++j) o[dt][j] = 0.f;
        float m = 0.f, l = 0.f;
        const bf16* kg = K + ((size_t)b * P + kr) * D + h * 128 + kc * 8;
        const bf16* vg = VT + ((size_t)b * D + h * 128 + vd) * P + vc * 8;
        u32x4 ka0, ka1, va0, va1;
        { const u32x4 k0 = *(const u32x4*)kg, k1 = *(const u32x4*)(kg + 64), v0 = *(const u32x4*)vg, v1 = *(const u32x4*)(vg + (size_t)64 * P);
          const bf16* kq = kg + (size_t)64 * D; const bf16* vq = vg + 64;
          ka0 = *(const u32x4*)kq; ka1 = *(const u32x4*)(kq + 64); va0 = *(const u32x4*)vq; va1 = *(const u32x4*)(vq + (size_t)64 * P);
          *(u32x4*)(sb + kdst) = k0; *(u32x4*)(sb + KB + kdst) = k1; *(u32x4*)(sb + vdst) = v0; *(u32x4*)(sb + vdst + 64 * 144) = v1; }
        __syncthreads();
#pragma unroll 1
        for (int st = 0; st < nst; ++st) {
            const unsigned char* cb = sb + (st & 1) * BUF;
            u32x4 kn0 = (u32x4){0u, 0u, 0u, 0u}, kn1 = kn0, vn0 = kn0, vn1 = kn0;
            if (st + 2 < nst) { const bf16* kq = kg + (size_t)(st + 2) * 64 * D; const bf16* vq = vg + (st + 2) * 64;
                kn0 = *(const u32x4*)kq; kn1 = *(const u32x4*)(kq + 64); vn0 = *(const u32x4*)vq; vn1 = *(const u32x4*)(vq + (size_t)64 * P); }
#pragma unroll
            for (int sub = 0; sub < 2; ++sub) {
                f32x16 s;
#pragma unroll
                for (int j = 0; j < 16; ++j) s[j] = -m;
#pragma unroll
                for (int ks = 0; ks < 4; ++ks) s = MFMA32(*(const bf16x8*)(cb + kfrag + sub * 32 * 144 + ks * 32), qf[ks], s);
                float mx = s[0];
#pragma unroll
                for (int j = 1; j < 16; ++j) mx = fmaxf(mx, s[j]);
                mx = fmaxf(mx, __shfl_xor(mx, 32));
                const bool first = st == 0 && sub == 0;
                if (first || __any(mx > 8.0f)) {
                    const float d = first ? mx : fmaxf(mx, 0.f);
                    if (!first) { const float alpha = __builtin_amdgcn_exp2f(-d); l *= alpha;
#pragma unroll
                        for (int dt = 0; dt < 4; ++dt)
#pragma unroll
                            for (int j = 0; j < 16; ++j) o[dt][j] *= alpha; }
                    m += d;
#pragma unroll
                    for (int j = 0; j < 16; ++j) s[j] -= d;
                }
                float ps = 0.f;
#pragma unroll
                for (int j = 0; j < 16; ++j) { s[j] = __builtin_amdgcn_exp2f(s[j]); ps += s[j]; }
                l += ps;
                const bf16x8 p0 = pack8(s, 0), p1 = pack8(s, 8);
#pragma unroll
                for (int dt = 0; dt < 4; ++dt) { o[dt] = MFMA32(*(const bf16x8*)(cb + vfrag + dt * 32 * 144 + sub * 64), p0, o[dt]); o[dt] = MFMA32(*(const bf16x8*)(cb + vfrag + dt * 32 * 144 + sub * 64 + 32), p1, o[dt]); }
            }
            if (st + 1 < nst) { unsigned char* nb = sb + ((st + 1) & 1) * BUF; *(u32x4*)(nb + kdst) = ka0; *(u32x4*)(nb + KB + kdst) = ka1; *(u32x4*)(nb + vdst) = va0; *(u32x4*)(nb + vdst + 64 * 144) = va1; }
            ka0 = kn0; ka1 = kn1; va0 = vn0; va1 = vn1;
            __syncthreads();
        }
        l += __shfl_xor(l, 32);
        const float inv = 1.0f / l;
        if (map == 1) {
#pragma unroll
            for (int dt = 0; dt < 4; ++dt)
#pragma unroll
                for (int j = 0; j < 16; ++j) xch[(dt * 16 + j) * 64 + lane] = o[dt][j] * inv * lam_full;
        }
        __syncthreads();
        if (map == 0) {
            float ss = 0.f;
#pragma unroll
            for (int dt = 0; dt < 4; ++dt)
#pragma unroll
                for (int j = 0; j < 16; ++j) { const float v = o[dt][j] * inv - xch[(dt * 16 + j) * 64 + lane]; o[dt][j] = v; ss += v * v; }
            ss += __shfl_xor(ss, 32);
            const float rinv = rsqrtf(ss * (1.0f / 128.0f) + EPS) * (1.0f - LAM_INIT);
#pragma unroll
            for (int dt = 0; dt < 4; ++dt)
#pragma unroll
                for (int jq = 0; jq < 4; ++jq) {
                    const int d0 = dt * 32 + jq * 8 + hh * 4; const f32x4 sw = *(const f32x4*)(F.in[23] + d0);
                    u32x2 w; w.x = pkbf(o[dt][jq * 4 + 0] * rinv * sw.x, o[dt][jq * 4 + 1] * rinv * sw.y); w.y = pkbf(o[dt][jq * 4 + 2] * rinv * sw.z, o[dt][jq * 4 + 3] * rinv * sw.w);
                    *(u32x2*)(O + qrow * D + h * 128 + d0) = w;
                }
        }
        __syncthreads();
    }
}

__device__ __forceinline__ void ph_na_attn(const Frame& F) {
    const bf16* Q = (const bf16*)(F.ws + WS_Q); const bf16* K = (const bf16*)(F.ws + WS_K); const bf16* VT = (const bf16*)(F.ws + WS_VT); bf16* O = (bf16*)(F.ws + WS_O);
    const int tid = F.tid, lane = F.lane, l32 = lane & 31, hh = lane >> 5;
    constexpr int KB = 128 * 144, VP = 272, VB = 64 * VP, BUF = KB + VB;
    unsigned char* sb = F.lds;
    float* rp = (float*)(F.lds + 2 * BUF) + 64;
    for (int i = tid; i < 16 * 15 * 31 + 128; i += NTHREADS) { const int k = i - 64; rp[k] = (k >= 0 && k < 16 * 15 * 31) ? F.in[19][k] * LOG2E : 0.f; }
    __syncthreads();
    const float c = 0.125f * LOG2E;
    const int pr = tid >> 3, pc = tid & 7;
    const int kdst = pr * 144 + pc * 16, vdst = KB + pr * VP + pc * 16;
    const int kfrag = kperm(l32) * 144 + hh * 16, vfrag = KB + l32 * VP + hh * 16;
    const int vb = (F.nb & 7) == 0 ? (F.bid & 7) * (F.nb >> 3) + (F.bid >> 3) : F.bid;
    for (int it = vb; it < 4096 + 512; it += F.nb) {
        int b, h, r = 0, cq = 0, kc0 = 0, rlo = 0, rhi = 0, wr0 = 0, wr1 = 0, nt; bool lat; size_t qrow;
        if (it < 4096) { lat = true; b = it >> 7; h = (it >> 3) & 15; const int rg = ((it & 7) + (it >> 8)) & 7  ;
            const int rw = rg * 4 + (F.wave >> 2) * 2, cqt = F.wave & 3; r = rw + (l32 >> 4); cq = cqt * 16 + (l32 & 15); kc0 = min(max(cqt * 16 - 8, 0), 32);
            wr0 = min(max(rw - 4, 0), 24); wr1 = min(max(rw + 1 - 4, 0), 24) + 8;
            qrow = (size_t)b * P + NCTX + r * 64 + cq;
            rlo = min(max(rg * 4 - 4, 0), 24); rhi = min(max(rg * 4 + 3 - 4, 0), 24) + 7; nt = 2 + (rhi - rlo + 2) / 2; }
        else { lat = false; const int j = it - 4096; b = j >> 4; h = j & 15; qrow = (size_t)b * P + F.wave * 32 + l32; nt = 2; }
        const int r0 = min(max(r - 4, 0), 24), c0 = min(max(cq - 8, 0), 48);
        bf16x8 qf[4];
#pragma unroll
        for (int ks = 0; ks < 4; ++ks) qf[ks] = *(const bf16x8*)(Q + qrow * D + h * 64 + ks * 16 + hh * 8);
        float neg[16];
#pragma unroll
        for (int j = 0; j < 16; ++j) { const int kcol = kc0 + 16 * (j >> 3) + 8 * hh + 4 * ((j >> 2) & 1) + (j & 3); neg[j] = (kcol >= c0 && kcol < c0 + 16) ? 0.f : -1.0e30f; }
        f32x16 o[2];
#pragma unroll
        for (int dt = 0; dt < 2; ++dt)
#pragma unroll
            for (int j = 0; j < 16; ++j) o[dt][j] = 0.f;
        float m = -1.0e30f, l = 0.f;
        const bf16* kg = K + ((size_t)b * P + pr) * D + h * 64 + pc * 8;
        const bf16* vg = VT + ((size_t)b * D + h * 64 + pr) * P + pc * 8;
#define NA_KEYA(st) ((st) < 2 ? (st) * 128 : NCTX + (rlo + 2 * ((st) - 2)) * 64)
#define NA_KEYB(st) ((st) < 2 ? (st) * 128 + 64 : NCTX + min(rlo + 2 * ((st) - 2) + 1, 31) * 64)
#define NA_LOAD(dk0, dk1, dv0, dv1, st) do { const int ka_ = NA_KEYA(st), kb_ = NA_KEYB(st); dk0 = *(const u32x4*)(kg + (size_t)ka_ * D); dk1 = *(const u32x4*)(kg + (size_t)kb_ * D); \
        dv0 = *(const u32x4*)(vg + ka_); dv1 = *(const u32x4*)(vg + kb_); } while (0)
#define NA_STORE(buf, sk0, sk1, sv0, sv1) do { *(u32x4*)((buf) + kdst) = sk0; *(u32x4*)((buf) + kdst + 64 * 144) = sk1; *(u32x4*)((buf) + vdst) = sv0; *(u32x4*)((buf) + vdst + 128) = sv1; } while (0)
        u32x4 ka0, ka1, va0, va1;
        { u32x4 x0, x1, y0, y1; NA_LOAD(x0, x1, y0, y1, 0); NA_LOAD(ka0, ka1, va0, va1, 1); NA_STORE(sb, x0, x1, y0, y1); }
        __syncthreads();
#pragma unroll 1
        for (int st = 0; st < nt; ++st) {
            const unsigned char* cbuf = sb + (st & 1) * BUF;
            u32x4 kn0 = (u32x4){0u, 0u, 0u, 0u}, kn1 = kn0, vn0 = kn0, vn1 = kn0;
            if (st + 2 < nt) NA_LOAD(kn0, kn1, vn0, vn1, st + 2);
#define NA_TILE(KO_, WIN_, KROW_) do { const int ko = (KO_); \
                f32x16 s; \
                _Pragma("unroll") for (int j = 0; j < 16; ++j) s[j] = 0.f; \
                _Pragma("unroll") for (int ks = 0; ks < 4; ++ks) s = MFMA32(*(const bf16x8*)(cbuf + kfrag + ko * 144 + ks * 32), qf[ks], s); \
                if (WIN_) { const int krow = (KROW_); \
                    const float rmask = (krow >= r0 && krow < r0 + 8) ? 0.f : -1.0e30f;        \
                    const float* rph = rp + (h * 15 + (krow - r + 7)) * 31 - cq + 15 + 8 * hh + kc0;       \
                    _Pragma("unroll") for (int j = 0; j < 16; ++j) s[j] = (s[j] * c + rph[16 * (j >> 3) + 4 * ((j >> 2) & 1) + (j & 3)]) + (neg[j] + rmask); \
                } else { _Pragma("unroll") for (int j = 0; j < 16; ++j) s[j] *= c; } \
                float mx = s[0]; \
                _Pragma("unroll") for (int j = 1; j < 16; ++j) mx = fmaxf(mx, s[j]); \
                mx = fmaxf(mx, __shfl_xor(mx, 32)); \
                if (__any(mx > m + 8.0f)) { \
                    const float mn = fmaxf(m, mx), alpha = __builtin_amdgcn_exp2f(m - mn); m = mn; l *= alpha; \
                    _Pragma("unroll") for (int dt = 0; dt < 2; ++dt) _Pragma("unroll") for (int j = 0; j < 16; ++j) o[dt][j] *= alpha; \
                } \
                f32x2 ps2 = {0.f, 0.f}; \
                _Pragma("unroll") for (int j = 0; j < 16; j += 2) { f32x2 t = {s[j], s[j + 1]}; t = t - (f32x2){m, m}; t.x = __builtin_amdgcn_exp2f(t.x); t.y = __builtin_amdgcn_exp2f(t.y); s[j] = t.x; s[j + 1] = t.y; ps2 += t; } \
                l += ps2.x + ps2.y; \
                const bf16x8 p0 = pack8(s, 0), p1 = pack8(s, 8); \
                _Pragma("unroll") for (int dt = 0; dt < 2; ++dt) { o[dt] = MFMA32(*(const bf16x8*)(cbuf + vfrag + dt * 32 * VP + ko * 2), p0, o[dt]); o[dt] = MFMA32(*(const bf16x8*)(cbuf + vfrag + dt * 32 * VP + ko * 2 + 32), p1, o[dt]); } \
            } while (0)
            if (st < 2) {
#pragma unroll
                for (int sub = 0; sub < 4; ++sub) NA_TILE(sub * 32, false, 0);
            } else {
#pragma unroll
                for (int half = 0; half < 2; ++half) { const int krw = rlo + 2 * (st - 2) + half;
                    if (krw <= rhi && krw >= wr0 && krw < wr1) NA_TILE(half * 64 + kc0, true, krw); }
            }
#undef NA_TILE
            if (st + 1 < nt) { unsigned char* nb = sb + ((st + 1) & 1) * BUF; NA_STORE(nb, ka0, ka1, va0, va1); }
            ka0 = kn0; ka1 = kn1; va0 = vn0; va1 = vn1;
            __syncthreads();
        }
#undef NA_KEYA
#undef NA_KEYB
#undef NA_LOAD
#undef NA_STORE
        l += __shfl_xor(l, 32);
        const float inv = 1.0f / l;
#pragma unroll
        for (int dt = 0; dt < 2; ++dt)
#pragma unroll
            for (int jq = 0; jq < 4; ++jq) {
                const int d0 = dt * 32 + jq * 8 + hh * 4;
                u32x2 w; w.x = pkbf(o[dt][jq * 4 + 0] * inv, o[dt][jq * 4 + 1] * inv); w.y = pkbf(o[dt][jq * 4 + 2] * inv, o[dt][jq * 4 + 3] * inv);
                *(u32x2*)(O + qrow * D + h * 64 + d0) = w;
            }
    }
    __syncthreads();
}

__device__ __forceinline__ f32x4 unpk4(u32x2 w) { return (f32x4){bflo(w.x), bfhi(w.x), bflo(w.y), bfhi(w.y)}; }
__device__ __forceinline__ bf16 bf1(float x) { return (bf16)(pkbf(x, 0.f) & 0xffffu); }
__device__ __forceinline__ f32x4 shx32(f32x4 v) { return (f32x4){__shfl_xor(v.x, 32), __shfl_xor(v.y, 32), __shfl_xor(v.z, 32), __shfl_xor(v.w, 32)}; }
template <int DIR>
__device__ __forceinline__ void hgrn_seq(const Frame& F, int b, int h, int eb) {
    const bf16* ZIN = (const bf16*)(F.ws + WS_ZIN); const bf16* VTG = (const bf16*)(F.ws + WS_VTG); bf16* OUT = (bf16*)(F.ws + (DIR ? WS_OFB : WS_OFF));
    const int lane = F.lane, l32 = lane & 31, hh = lane >> 5, cperm = kperm(l32);
    constexpr int IMG = 32 * 136 * 2, KTB = 128 * 80, DBUF = 2 * IMG + KTB + 512;
    unsigned char* dbase = F.lds + DIR * 2 * DBUF;
    const int tg = lane & 7, prho = 8 * eb + (lane >> 3), pc = kperm(prho);
    f32x16 S[4];
#pragma unroll
    for (int d = 0; d < 4; ++d)
#pragma unroll
        for (int j = 0; j < 16; ++j) S[d][j] = 0.f;
    const bf16* vbase = VTG + ((size_t)b * D + h * 128 + eb * 32 + l32) * P + hh * 8;
    const bf16* zp = ZIN + ((size_t)b * P + 4 * tg) * 4096 + h * 128 + 4 * prho;
#define HG_CHUNK(i_) (DIR == 0 ? (i_) : ((i_) < 8 ? 7 - (i_) : 79 - (i_)))
#define HG_LOAD(i_) do { const int c_ = HG_CHUNK(i_); const bf16* z_ = zp + (size_t)c_ * 32 * 4096; \
        _Pragma("unroll") for (int i = 0; i < 4; ++i) { nlf[i] = *(const u32x2*)(z_ + (size_t)i * 4096 + (1 + DIR) * D); nq[i] = *(const u32x2*)(z_ + (size_t)i * 4096); } \
        nv0 = *(const bf16x8*)(vbase + c_ * 32); nv1 = *(const bf16x8*)(vbase + c_ * 32 + 16); } while (0)
    u32x2 nlf[4], nq[4]; bf16x8 nv0, nv1;
    HG_LOAD(0);
#pragma unroll 1
    for (int idx = 0; idx < 72; ++idx) {
        const int cc = HG_CHUNK(idx);
        const size_t row0 = (size_t)b * P + cc * 32;
        unsigned char* buf = dbase + (idx & 1) * DBUF;
        bf16* Qp = (bf16*)buf; bf16* Kp = (bf16*)(buf + IMG); bf16* KT = (bf16*)(buf + 2 * IMG); float* egl = (float*)(buf + 2 * IMG + KTB);
        u32x2 lfc[4], qc[4];
#pragma unroll
        for (int i = 0; i < 4; ++i) { lfc[i] = nlf[i]; qc[i] = nq[i]; }
        const bf16x8 vf0 = nv0, vf1 = nv1;
        HG_LOAD(min(idx + 1, 71));
        f32x4 l4[4], t = (f32x4){0.f, 0.f, 0.f, 0.f};
#pragma unroll
        for (int i = 0; i < 4; ++i) { l4[i] = unpk4(lfc[i]); t += l4[i]; }
        f32x4 x = t;
#pragma unroll
        for (int k = 1; k < 8; k <<= 1) { const f32x4 y = (f32x4){__shfl_up(x.x, k, 8), __shfl_up(x.y, k, 8), __shfl_up(x.z, k, 8), __shfl_up(x.w, k, 8)}; if (tg >= k) x += y; }
        const f32x4 tot = (f32x4){__shfl(x.x, 7, 8), __shfl(x.y, 7, 8), __shfl(x.z, 7, 8), __shfl(x.w, 7, 8)};
        const f32x4 off = DIR == 0 ? x - t : tot - x;
        f32x4 eg = (f32x4){__builtin_amdgcn_exp2f(off.x), __builtin_amdgcn_exp2f(off.y), __builtin_amdgcn_exp2f(off.z), __builtin_amdgcn_exp2f(off.w)}; float kv[4][4];
#pragma unroll
        for (int ii = 0; ii < 4; ++ii) {
            const int i = DIR ? 3 - ii : ii;
            const f32x4 lf = l4[i], q4 = unpk4(qc[i]);
            const int srow = (4 * tg + i) * 136 + pc;
#pragma unroll
            for (int d = 0; d < 4; ++d) { const float f = __builtin_amdgcn_exp2f(lf[d]); eg[d] *= f; const float kq = (1.0f - f) * __builtin_amdgcn_rcpf(eg[d]);
                Qp[srow + d * 32] = bf1(q4[d] * eg[d]); Kp[srow + d * 32] = bf1(kq); kv[d][i] = kq; }
        }
#pragma unroll
        for (int d = 0; d < 4; ++d) { u32x2 w; w.x = pkbf(kv[d][0], kv[d][1]); w.y = pkbf(kv[d][2], kv[d][3]); *(u32x2*)(KT + (d * 32 + prho) * 40 + 4 * tg) = w; }
        if (tg == 0) *(f32x4*)(egl + 4 * prho) = (f32x4){__builtin_amdgcn_exp2f(tot.x), __builtin_amdgcn_exp2f(tot.y), __builtin_amdgcn_exp2f(tot.z), __builtin_amdgcn_exp2f(tot.w)};
        __syncthreads();
        bf16x8 kf[4][2];
#pragma unroll
        for (int d = 0; d < 4; ++d)
#pragma unroll
            for (int sg = 0; sg < 2; ++sg) kf[d][sg] = *(const bf16x8*)(KT + (d * 32 + l32) * 40 + sg * 16 + 8 * hh);
        if (cc >= NCTX / 32) {
        f32x16 att, o;
#pragma unroll
        for (int j = 0; j < 16; ++j) { att[j] = 0.f; o[j] = 0.f; }
        const bf16* krow = Kp + cperm * 136 + hh * 8; const bf16* qrow = Qp + l32 * 136 + hh * 8;
#pragma unroll
        for (int ks = 0; ks < 8; ++ks) { att = MFMA32(*(const bf16x8*)(krow + ks * 16), *(const bf16x8*)(qrow + ks * 16), att);
            o = MFMA32(pack8(S[ks >> 1], (ks & 1) * 8), *(const bf16x8*)(qrow + (ks >> 1) * 32 + (ks & 1) * 16), o); }
#pragma unroll
        for (int j = 0; j < 16; ++j) { const int sa = 16 * (j >> 3) + 8 * hh + 4 * ((j >> 2) & 1) + (j & 3); const bool keep = DIR == 0 ? (sa <= l32) : (sa >= l32); att[j] = keep ? att[j] : 0.f; }
        const bf16x8 p0 = pack8(att, 0), p1 = pack8(att, 8);
        o = MFMA32(vf0, p0, o); o = MFMA32(vf1, p1, o);
        bf16* op = OUT + (row0 + l32) * D + h * 128 + eb * 32 + 4 * hh;
#pragma unroll
        for (int jq = 0; jq < 4; ++jq) { u32x2 w; w.x = pkbf(o[4 * jq], o[4 * jq + 1]); w.y = pkbf(o[4 * jq + 2], o[4 * jq + 3]); *(u32x2*)(op + 8 * jq) = w; }
        }
#pragma unroll
        for (int d = 0; d < 4; ++d) { S[d] = MFMA32(kf[d][0], vf0, S[d]); S[d] = MFMA32(kf[d][1], vf1, S[d]); }
#pragma unroll
        for (int j = 0; j < 16; ++j) { const int rho = (j & 3) + 8 * (j >> 2) + 4 * hh; const f32x4 e4 = *(const f32x4*)(egl + 4 * rho);
            S[0][j] *= e4.x; S[1][j] *= e4.y; S[2][j] *= e4.z; S[3][j] *= e4.w; }
    }
#undef HG_LOAD
#undef HG_CHUNK
}
__device__ __forceinline__ void ph_hgrn_scan(const Frame& F) {
    for (int id = F.bid * NWAVES + F.wave; id < NB * 8 * 8; id += F.nb * NWAVES) {
        const int eb = id & 3, dir = (id >> 2) & 1, h = (id >> 3) & 7, b = id >> 6;
        if (dir == 0) hgrn_seq<0>(F, b, h, eb); else hgrn_seq<1>(F, b, h, eb);
    }
}
__device__ __forceinline__ void ph_hgrn_post(const Frame& F) {
    const bf16* ZIN = (const bf16*)(F.ws + WS_ZIN); const bf16* OFF = (const bf16*)(F.ws + WS_OFF); const bf16* OFB = (const bf16*)(F.ws + WS_OFB); bf16* O2 = (bf16*)(F.ws + WS_O2);
    const int lane = F.lane, part = lane & 7;
    f32x4 gn[4];
#pragma unroll
    for (int q = 0; q < 4; ++q) gn[q] = *(const f32x4*)(F.in[26] + part * 16 + q * 4);
    for (int row = F.bid * NWAVES + F.wave; row < R; row += F.nb * NWAVES) {
        if (row % P < NCTX) continue;
        const size_t o = (size_t)row * D + lane * 16;
        const u32x4 a0 = *(const u32x4*)(OFF + o), a1 = *(const u32x4*)(OFF + o + 8), b0 = *(const u32x4*)(OFB + o), b1 = *(const u32x4*)(OFB + o + 8);
        const u32x4 g0 = *(const u32x4*)(ZIN + (size_t)row * 4096 + 3 * D + lane * 16), g1 = *(const u32x4*)(ZIN + (size_t)row * 4096 + 3 * D + lane * 16 + 8);
        float v[16];
        v[0] = bflo(a0.x) + bflo(b0.x); v[1] = bfhi(a0.x) + bfhi(b0.x); v[2] = bflo(a0.y) + bflo(b0.y); v[3] = bfhi(a0.y) + bfhi(b0.y);
        v[4] = bflo(a0.z) + bflo(b0.z); v[5] = bfhi(a0.z) + bfhi(b0.z); v[6] = bflo(a0.w) + bflo(b0.w); v[7] = bfhi(a0.w) + bfhi(b0.w);
        v[8] = bflo(a1.x) + bflo(b1.x); v[9] = bfhi(a1.x) + bfhi(b1.x); v[10] = bflo(a1.y) + bflo(b1.y); v[11] = bfhi(a1.y) + bfhi(b1.y);
        v[12] = bflo(a1.z) + bflo(b1.z); v[13] = bfhi(a1.z) + bfhi(b1.z); v[14] = bflo(a1.w) + bflo(b1.w); v[15] = bfhi(a1.w) + bfhi(b1.w);
        float ss = 0.f;
#pragma unroll
        for (int q = 0; q < 16; ++q) ss += v[q] * v[q];
        ss += dpp_xor1(ss); ss += dpp_xor2(ss); ss += __shfl_xor(ss, 4);
        const float rinv = rsqrtf(ss * (1.0f / 128.0f) + EPS);
        const unsigned gw[8] = {g0.x, g0.y, g0.z, g0.w, g1.x, g1.y, g1.z, g1.w};
        unsigned w[8];
#pragma unroll
        for (int q = 0; q < 8; ++q) w[q] = pkbf(v[2 * q] * rinv * gn[q >> 1][(2 * q) & 3] * bflo(gw[q]), v[2 * q + 1] * rinv * gn[q >> 1][(2 * q + 1) & 3] * bfhi(gw[q]));
        *(u32x4*)(O2 + o) = (u32x4){w[0], w[1], w[2], w[3]}; *(u32x4*)(O2 + o + 8) = (u32x4){w[4], w[5], w[6], w[7]};
    }
}

enum { PH_BASE = __COUNTER__ };
__global__ void __launch_bounds__(NTHREADS, 2) fwd(Args args) {
    extern __shared__ __attribute__((aligned(16))) unsigned char lds[];
    Frame F;
    F.lds = lds; F.wave = __builtin_amdgcn_readfirstlane((int)threadIdx.x >> 6); F.bid = blockIdx.x; F.nb = gridDim.x;
    REFRESH_(F);
    F.in = args.in; F.out = args.out; F.ws = args.ws;
    F.MOD = (float*)(args.ws + WS_MOD); F.AFF = (float*)(args.ws + WS_AFF); F.SEL = (int*)(args.ws + WS_SEL); F.GATE = (float*)(args.ws + WS_GATE); F.INV = (int*)(args.ws + WS_INV);
    F.X = (bf16*)(args.ws + WS_X); F.H = (bf16*)(args.ws + WS_H);
    const int lo = args.ph_lo, hi = args.ph_hi;
#if MK_SINGLE
    volatile LAS unsigned* misc = (volatile LAS unsigned*)((LAS unsigned char*)lds + LDS_MISC);
    if (F.tid < 64) misc[F.tid] = 0u;
    __syncthreads();
    XcdBarrier bar = xcd_barrier_post((unsigned*)(args.ws + WS_CTL) + CW_BAR, misc, F.tid);
#define SEAM(k) do { if ((k) + 1 < hi) xcd_barrier(bar, F.tid); } while (0)
#else
#define SEAM(k) do { } while (0)
#endif
#define PH(...) do { constexpr int k_ = __COUNTER__ - PH_BASE - 1; if (lo <= k_ && k_ < hi) { REFRESH_(F); __VA_ARGS__; SEAM(k_); } } while (0)
    bf16* HID = (bf16*)(F.ws + WS_HID); bf16* Y = (bf16*)(F.ws + WS_Y);
    PG8_LAS unsigned char* ring = (PG8_LAS unsigned char*)lds;
    bf16 *Qb = (bf16*)(F.ws + WS_Q), *VTb = (bf16*)(F.ws + WS_VT), *Ob = (bf16*)(F.ws + WS_O);

#define GEMM_PHASE(EPI, gA, lda_, gB, ldb_, gK, nM_, nN_, groups_, gsM_, ...) do { const pg8::Gemm g_{(const bf16*)(gA), (const bf16*)(gB), (lda_), (ldb_), (gK), nullptr}; pg8::GroupedOrder S_; S_.init((nM_), (nN_), (groups_), (gsM_), F.nb, F.bid); \
        const EPI E_{__VA_ARGS__}; pg8::gemm_phase<EPI, pg8::GroupedOrder, PG8_ALIGN, PG8_SP2>(ring, g_, S_, E_, F.tid); } while (0)
#define GEMM_PHASE_LAT(EPI, gA, lda_, gB, ldb_, gK, nN_, ...) do { const pg8::Gemm g_{(const bf16*)(gA), (const bf16*)(gB), (lda_), (ldb_), (gK), nullptr}; pg8::LatentOrder S_; S_.init((nN_), F.nb, F.bid); \
        const EPI E_{__VA_ARGS__}; pg8::gemm_phase<EPI, pg8::LatentOrder, PG8_ALIGN, PG8_SP2>(ring, g_, S_, E_, F.tid); } while (0)
#define GEMM_PHASE_NOALIGN(EPI, gA, lda_, gB, ldb_, gK, nM_, nN_, groups_, gsM_, ...) do { const pg8::Gemm g_{(const bf16*)(gA), (const bf16*)(gB), (lda_), (ldb_), (gK), nullptr}; pg8::GroupedOrder S_; S_.init((nM_), (nN_), (groups_), (gsM_), F.nb, F.bid); \
        const EPI E_{__VA_ARGS__}; pg8::gemm_phase<EPI, pg8::GroupedOrder, false, PG8_SP2>(ring, g_, S_, E_, F.tid); } while (0)
#define GEMM_PHASE_GATHER(EPI, gA, lda_, gIdx, gB, ldb_, gK, nM_, nN_, groups_, gsM_, ...) do { const pg8::Gemm g_{(const bf16*)(gA), (const bf16*)(gB), (lda_), (ldb_), (gK), (gIdx)}; pg8::GroupedOrder S_; S_.init((nM_), (nN_), (groups_), (gsM_), F.nb, F.bid); \
        const EPI E_{__VA_ARGS__}; pg8::gemm_phase<EPI, pg8::GroupedOrder, PG8_ALIGN, PG8_SP2, true>(ring, g_, S_, E_, F.tid); } while (0)
#define MODL(L) (F.MOD + (size_t)(L) * 33 * 6144)
#define MOE_PHASES(L, NMT, NITEMS, SKIPC) \
    PH(ph_norm2<SKIPC>(F, (L))); \
    PH(ph_topk(F, (NITEMS))); \
    PH(GEMM_PHASE_GATHER(pg8::EpiSwigluT, F.H, D, F.SEL, F.ws + WO_GU, D, D, (NMT), 2 * FF / 256, NE, SLOTS / 256, HID, 2 * FF / 256, FF)); \
    PH(GEMM_PHASE(pg8::EpiDownT, HID, FF, F.ws + WO_DN, FF, FF, (NMT), D / 256, NE, SLOTS / 256, Y, F.GATE, D / 256));
#define OUT_PROJ(Asrc, Wsrc, L) PH(GEMM_PHASE_NOALIGN(pg8::EpiResidT, (Asrc), D, (Wsrc), D, D, R / 256, D / 256, 1, R / 256, F.X, MODL(L)));

    PH(ph_prologue(F));
    PH(ph_norm<0, false, true, false, true>(F, 0, 0));
    PH(GEMM_PHASE(pg8::EpiF32G, F.ws + WS_AG, 768, F.ws + WS_S5W1, 512, 512, 2304 / 256, 1, 64, 2304 / 256, (float*)(F.ws + WS_SS), 256, 1));
    PH(ph_s5_scan(F));
    PH(GEMM_PHASE(pg8::EpiS5Out, F.ws + WS_AG, 768, F.ws + WS_S5W2, 768, 768, 2304 / 256, 2, 64, 2304 / 256, F.H, (bf16*)(F.ws + WS_Z), F.in[15]));
    PH(GEMM_PHASE(pg8::EpiGluT, F.ws + WS_Z, D, F.ws + WO_GLU, D, D, R / 256, 2 * D / 256, 1, R / 256, F.X, MODL(0)));
    MOE_PHASES(0, SLOTS / 256, NB * NE * 2, false)
    PH(ph_norm<0, true>(F, 1, 0); convert_moe(F, 1));
    PH(GEMM_PHASE(pg8::EpiBf16<0>, F.H, D, F.ws + WO_NAQKV, D, D, R / 256, 2 * D / 256, 1, R / 256, Qb, D, nullptr, D, (size_t)(WS_K - WS_Q) / 2, 1.0f);
       GEMM_PHASE(pg8::EpiVtT<false>, F.ws + WO_NAQKV + (size_t)2 * D * D * 2, D, F.H, D, D, D / 256, R / 256, 1, D / 256, VTb));
    PH(ph_na_attn(F));
    OUT_PROJ(Ob, F.ws + WO_NAO, 1)
    MOE_PHASES(1, SLOTS / 256, NB * NE * 2, false)
    PH(ph_norm<0, true>(F, 2, 1); convert_moe(F, 2));
    PH({ LAS float* rt = (LAS float*)((LAS unsigned char*)F.lds + pg8::STAGE_BYTES + 4096);
         for (int i = F.tid; i < 2048; i += NTHREADS) rt[i] = ((const float*)(F.ws + WS_ROPE))[i];
         __syncthreads(); }
       GEMM_PHASE(pg8::EpiQKRope, F.H, D, F.ws + WO_DAQKV, D, D, R / 256, 2 * D / 256, 1, R / 256, Qb, (size_t)(WS_K - WS_Q) / 2, (const PG8_LAS float*)((LAS unsigned char*)F.lds + pg8::STAGE_BYTES + 4096));
       GEMM_PHASE(pg8::EpiVtT<false>, F.ws + WO_DAQKV + (size_t)2 * D * D * 2, D, F.H, D, D, D / 256, R / 256, 1, D / 256, VTb));
    PH(ph_da_attn(F));
    OUT_PROJ(Ob, F.ws + WO_DAO, 2)
    MOE_PHASES(2, SLOTS / 256, NB * NE * 2, false)
    PH(ph_norm<0, true>(F, 3, 2); convert_moe(F, 3));
    PH({ const pg8::Gemm g_{(const bf16*)F.H, (const bf16*)(F.ws + WO_HGIN), D, D, D, nullptr}; pg8::HgInOrder S_; S_.init(F.nb, F.bid);
         const pg8::EpiHgIn E_{(bf16*)(F.ws + WS_ZIN), (const float*)(F.ws + WS_LB)}; pg8::gemm_phase<pg8::EpiHgIn, pg8::HgInOrder, PG8_ALIGN, PG8_SP2>(ring, g_, S_, E_, F.tid); }
       GEMM_PHASE(pg8::EpiVtT<true>, F.ws + WO_HGIN + (size_t)4 * D * D * 2, D, F.H, D, D, D / 256, R / 256, 1, D / 256, (bf16*)(F.ws + WS_VTG)));
    PH(ph_hgrn_scan(F));
    PH(ph_hgrn_post(F));
    PH(GEMM_PHASE_LAT(pg8::EpiResidT, F.ws + WS_O2, D, F.ws + WO_HGO, D, D, D / 256, F.X, MODL(3)));
    MOE_PHASES(3, NB, NB * NE, true)
    PH(ph_norm<2, true, false, true>(F, 0, 3));
}
constexpr int NPH = __COUNTER__ - PH_BASE - 1;

extern "C" void kernel_launch(void* const* d_in, const int* in_sizes, int n_in, void* d_out, int out_size, void* d_ws, size_t ws_size, hipStream_t stream) {
    static int grid = 0;
    if (grid == 0) {
        if (n_in != 33 || ws_size < WS_NEED) { fprintf(stderr, "kernel_launch: n_in %d ws %zu (need %zu)\n", n_in, ws_size, (size_t)WS_NEED); grid = -1; return; }
        int dev = 0, cus = 0;
        if (hipGetDevice(&dev) != hipSuccess || hipDeviceGetAttribute(&cus, hipDeviceAttributeMultiprocessorCount, dev) != hipSuccess) { grid = -1; return; }
        if (hipFuncSetAttribute((const void*)fwd, hipFuncAttributeMaxDynamicSharedMemorySize, LDS_BYTES) != hipSuccess) { fprintf(stderr, "kernel_launch: hipFuncSetAttribute failed\n"); grid = -1; return; }
        int per_cu = 0;
        if (hipOccupancyMaxActiveBlocksPerMultiprocessor(&per_cu, (const void*)fwd, NTHREADS, LDS_BYTES) != hipSuccess || per_cu < 1) fprintf(stderr, "kernel_launch: occupancy query says %d\n", per_cu);
        (void)hipGetLastError();
        grid = cus;
    }
    if (grid < 0) return;
    (void)hipMemsetAsync((char*)d_ws + WS_CTL + (size_t)CW_BAR * 4, 0, (size_t)XCD_BAR_WORDS * 4, stream);
    Args a{};
    for (int i = 0; i < 33; ++i) a.in[i] = (const float*)d_in[i];
    a.out = (float*)d_out; a.ws = (unsigned char*)d_ws;
#if MK_SINGLE
    a.ph_lo = 0; a.ph_hi = NPH;
    hipLaunchKernelGGL(fwd, dim3(grid), dim3(NTHREADS), LDS_BYTES, stream, a);
#else
    for (int k = 0; k < NPH; ++k) { a.ph_lo = k; a.ph_hi = k + 1; hipLaunchKernelGGL(fwd, dim3(grid), dim3(NTHREADS), LDS_BYTES, stream, a); }
#endif
}
```

```cpp
#include <hip/hip_runtime.h>
#include <cstdio>
#include <cstdint>

#ifndef MK_SINGLE
#define MK_SINGLE 1
#endif

typedef unsigned short bf16;
typedef float f32x4 __attribute__((ext_vector_type(4)));
typedef float f32x2 __attribute__((ext_vector_type(2)));
typedef unsigned u32x2 __attribute__((ext_vector_type(2)));
typedef unsigned u32x4 __attribute__((ext_vector_type(4)));
#define LAS __attribute__((address_space(3)))

constexpr int NB = 32, SEQ = 2048, NCTX = 256, D = 1024, P = NCTX + SEQ  , R = NB * P  ;
constexpr int NE = 16, FF = 2048, SLOTS = NB * 256 + NB * 32  ;
constexpr float EPS = 1e-6f;
constexpr float LOG2E_ = 1.4426950408889634f;
constexpr float LAM_INIT = 0.47071302f;
constexpr int NWAVES = 8, NTHREADS = 512;
constexpr int LDS_BYTES = 147456;
constexpr int LDS_MISC = 147456 - 256;

constexpr size_t MiB = 1u << 20;
constexpr size_t WS_CTL = 0, CTL_ZERO_BYTES = 1 * MiB;
constexpr size_t WS_MOD = 1 * MiB;
constexpr size_t WS_AFF = 5 * MiB;
constexpr size_t WS_SEL = 10 * MiB;
constexpr size_t WS_GATE = 11 * MiB;
constexpr size_t WS_INV = 12 * MiB;
constexpr size_t WS_X = 32 * MiB;
constexpr size_t WS_H = 320 * MiB;
constexpr size_t WS_W = 464 * MiB;
constexpr size_t WS_BIG = 720 * MiB;
constexpr size_t WS_HID = WS_BIG;
constexpr size_t WS_Y = WS_BIG + 576 * MiB;
constexpr size_t WS_XS = WS_BIG + 864 * MiB;
constexpr size_t WS_AG = WS_BIG;
constexpr size_t WS_SS = WS_BIG + 216 * MiB;
constexpr size_t WS_Z = WS_BIG + 360 * MiB;
constexpr size_t WS_S5W1 = WS_BIG + 504 * MiB;
constexpr size_t WS_S5W2 = WS_BIG + 520 * MiB;
constexpr size_t WS_S5A = WS_BIG + 568 * MiB;
constexpr size_t WS_Q = WS_BIG, WS_K = WS_BIG + 144 * MiB, WS_V = WS_BIG + 288 * MiB, WS_VT = WS_BIG + 432 * MiB, WS_O = WS_BIG + 576 * MiB;
constexpr size_t WS_ZIN = WS_BIG;
constexpr size_t WS_VTG = WS_BIG + 576 * MiB;
constexpr size_t WS_OFF = WS_BIG + 720 * MiB;
constexpr size_t WS_OFB = WS_BIG + 1008 * MiB;
constexpr size_t WS_O2 = WS_H;
constexpr size_t WS_LB = 17 * MiB;
constexpr size_t WS_ROPE = 18 * MiB;
constexpr size_t WS_NEED = 2048 * MiB;
constexpr size_t WO_GLU = WS_W, WO_NAQKV = WS_W + 4 * MiB, WO_NAO = WS_W + 10 * MiB, WO_DAQKV = WS_W + 12 * MiB, WO_DAO = WS_W + 18 * MiB, WO_HGIN = WS_W + 20 * MiB, WO_HGO = WS_W + 30 * MiB;
constexpr size_t WO_GU = WS_W + 32 * MiB  , WO_DN = WS_W + 160 * MiB  ;
constexpr int CW_BAR = 4096;

__device__ __forceinline__ unsigned f2bf(float f) { unsigned u = __builtin_bit_cast(unsigned, f); return (u + 0x7fffu + ((u >> 16) & 1u)) >> 16; }
__device__ __forceinline__ float bf2f(unsigned h) { return __builtin_bit_cast(float, h << 16); }
__device__ __forceinline__ unsigned pk2(float lo, float hi) { return f2bf(lo) | (f2bf(hi) << 16); }
typedef __bf16 bf16x2_t __attribute__((ext_vector_type(2)));
__device__ __forceinline__ unsigned pkbf(float lo, float hi) { const f32x2 v = {lo, hi}; return __builtin_bit_cast(unsigned, __builtin_convertvector(v, bf16x2_t)); }
__device__ __forceinline__ float bflo(unsigned w) { return __builtin_bit_cast(float, w << 16); }
__device__ __forceinline__ float bfhi(unsigned w) { return __builtin_bit_cast(float, w & 0xffff0000u); }
__device__ __forceinline__ float wave_sum(float v) {
#pragma unroll
    for (int o = 1; o < 64; o <<= 1) v += __shfl_xor(v, o);
    return v;
}
__device__ __forceinline__ float wave_max(float v) {
#pragma unroll
    for (int o = 1; o < 64; o <<= 1) v = fmaxf(v, __shfl_xor(v, o));
    return v;
}
__device__ __forceinline__ float sigmoidf_(float x) { return 1.0f / (1.0f + expf(-x)); }
__device__ __forceinline__ float siluf_(float x) { return x / (1.0f + expf(-x)); }
__device__ __forceinline__ float gelu_tanh(float x) { return 0.5f * x * (1.0f + tanhf(0.7978845608028654f * (x + 0.044715f * x * x * x))); }
__device__ __forceinline__ float dpp_xor1(float v) { return __builtin_bit_cast(float, __builtin_amdgcn_update_dpp(0, __builtin_bit_cast(int, v), 0xB1, 0xF, 0xF, true)); }
__device__ __forceinline__ float dpp_xor2(float v) { return __builtin_bit_cast(float, __builtin_amdgcn_update_dpp(0, __builtin_bit_cast(int, v), 0x4E, 0xF, 0xF, true)); }
__device__ __forceinline__ float reduce16(float (&v)[16], int lane) {
    const bool b0 = lane & 1, b1 = lane & 2, b2 = lane & 4, b3 = lane & 8;
    float a[8];
#pragma unroll
    for (int k = 0; k < 8; ++k) { const float snd = b0 ? v[k] : v[8 + k], kep = b0 ? v[8 + k] : v[k]; a[k] = kep + dpp_xor1(snd); }
    float c[4];
#pragma unroll
    for (int k = 0; k < 4; ++k) { const float snd = b1 ? a[k] : a[4 + k], kep = b1 ? a[4 + k] : a[k]; c[k] = kep + dpp_xor2(snd); }
    float d[2];
#pragma unroll
    for (int k = 0; k < 2; ++k) { const float snd = b2 ? c[k] : c[2 + k], kep = b2 ? c[2 + k] : c[k]; d[k] = kep + __shfl_xor(snd, 4); }
    float r = (b3 ? d[1] : d[0]) + __shfl_xor(b3 ? d[0] : d[1], 8);
    r += __shfl_xor(r, 16); r += __shfl_xor(r, 32);
    return r;
}
#define WAVE_LDS_SYNC() asm volatile("s_waitcnt lgkmcnt(0)" ::: "memory")

#define XB_TMO      128
#define XB_XCNT(j)  (256  + 64 * (j))
#define XB_XSUB(j)  (1280 + 64 * (j))
#define XB_XGEN(j)  (2304 + 64 * (j))
#define XB_TOP      3328
#define XB_TOPGEN   3392
#define XCD_BAR_WORDS 3456
#define XB_SPIN_CAP (1u << 27)
__device__ __forceinline__ unsigned xb_ld(unsigned* p)              { return __hip_atomic_load(p, __ATOMIC_RELAXED, __HIP_MEMORY_SCOPE_AGENT); }
__device__ __forceinline__ unsigned xb_add(unsigned* p, unsigned v) { return __hip_atomic_fetch_add(p, v, __ATOMIC_RELAXED, __HIP_MEMORY_SCOPE_AGENT); }
__device__ __forceinline__ unsigned xb_xcc_id() { return (unsigned)__builtin_amdgcn_s_getreg((3 << 11) | 20) & 0xFu; }
#define XB_SPIN(cond, bar) do { unsigned _sp = 0; while (cond) { __builtin_amdgcn_s_sleep(1); \
    if ((++_sp & 255u) == 0u) { if (xb_ld(&(bar)[XB_TMO])) break; if (_sp > XB_SPIN_CAP) { atomicAdd(&(bar)[XB_TMO], 1u); break; } } } } while (0)
struct XcdBarrier { unsigned* bar; unsigned x; volatile LAS unsigned* st; };
__device__ __forceinline__ XcdBarrier xcd_barrier_post(unsigned* bar, volatile LAS unsigned* st, int tid_) {
    XcdBarrier b; b.bar = bar; b.x = xb_xcc_id(); b.st = st;
    if (tid_ == 0) (void)xb_add(&bar[XB_XCNT(b.x)], 1u);
    return b;
}
__device__ __forceinline__ void xcd_barrier_complete(unsigned* bar, unsigned x, unsigned& nloc, unsigned& nx) {
    const unsigned G = gridDim.x * gridDim.y * gridDim.z;
    unsigned sum, cnt, mine, sp = 0u;
    for (;;) {
        sum = 0u; cnt = 0u; mine = 0u;
#pragma unroll
        for (unsigned j = 0; j < 16; ++j) { const unsigned c = xb_ld(&bar[XB_XCNT(j)]); sum += c; cnt += (c > 0u) ? 1u : 0u; mine = (j == x) ? c : mine; }
        if (sum == G) break;
        __builtin_amdgcn_s_sleep(1);
        if ((++sp & 255u) == 0u) { if (xb_ld(&bar[XB_TMO])) break; if (sp > XB_SPIN_CAP) { atomicAdd(&bar[XB_TMO], 1u); break; } }
    }
    nloc = mine > 0u ? mine : 1u; nx = cnt > 0u ? cnt : 1u;
}
__device__ __forceinline__ void xcd_barrier(const XcdBarrier& b, int tid_) {
    asm volatile("s_waitcnt vmcnt(0)" ::: "memory");
    __syncthreads();
    if (tid_ == 0) {
        unsigned* bar = b.bar;
        __builtin_amdgcn_s_waitcnt(0);
        unsigned nloc = b.st[0], nx = b.st[1];
        if (nloc == 0u) { xcd_barrier_complete(bar, b.x, nloc, nx); b.st[0] = nloc; b.st[1] = nx; }
        const unsigned old = xb_add(&bar[XB_XSUB(b.x)], 1u);
        const unsigned gen = old / nloc;
        if (old + 1u == (gen + 1u) * nloc) {
            __builtin_amdgcn_fence(__ATOMIC_RELEASE, "agent");
            asm volatile("s_waitcnt vmcnt(0)" ::: "memory");
            const unsigned og = xb_add(&bar[XB_TOP], 1u);
            const unsigned tg = og / nx;
            if (og + 1u == (tg + 1u) * nx) xb_add(&bar[XB_TOPGEN], 1u);
            else XB_SPIN(xb_ld(&bar[XB_TOPGEN]) == tg, bar);
            __builtin_amdgcn_fence(__ATOMIC_ACQUIRE, "agent");
            xb_add(&bar[XB_XGEN(b.x)], 1u);
            asm volatile("s_waitcnt vmcnt(0)" ::: "memory");
        } else {
            XB_SPIN(xb_ld(&bar[XB_XGEN(b.x)]) == gen, bar);
            __builtin_amdgcn_fence(__ATOMIC_ACQUIRE, "agent");
            asm volatile("s_waitcnt vmcnt(0)" ::: "memory");
        }
    }
    __syncthreads();
}

namespace pg8 {
#define PG8_LAS __attribute__((address_space(3)))
typedef unsigned short bf16_t;
typedef short bf16x8 __attribute__((ext_vector_type(8)));
typedef float f32x4 __attribute__((ext_vector_type(4)));
typedef unsigned u32x4 __attribute__((ext_vector_type(4)));
constexpr int BM = 256, BK = 64, HALF = 128, HTB = HALF * BK * 2  , STAGE_BYTES = 8 * HTB, NXCD = 8, WGM = 8;

__host__ __device__ __forceinline__ int lds_byte(int r, int c) { const int st = (r >> 4) * 2 + (c >> 5), rr = r & 15, cc = c & 31, ob = rr * 64 + cc * 2; return st * 1024 + (ob ^ (((ob >> 9) & 1) << 5)); }
__host__ __device__ __forceinline__ void stage_rc(int b, int& R, int& C) { const int st = b / 1024, sb = b % 1024, swz = sb ^ (((sb >> 9) & 1) << 5); R = (st >> 1) * 16 + swz / 64; C = (st & 1) * 32 + (swz % 64) / 2; }
__host__ __device__ __forceinline__ int perm32(int rho) { const int n = rho >> 4, i = rho & 15; return 8 * (i >> 2) + 4 * n + (i & 3); }

struct Unit { int pm, pn; };
struct Gemm { const bf16_t* A; const bf16_t* Bt; int lda, ldb, K; const int* rowidx; };

struct StaticOrder {
    int nM, nN, nwg, G, c;
    __host__ __device__ void init(int M, int N, int G_, int c_) { nM = M / BM; nN = N / BM; nwg = nM * nN; G = G_; c = c_; }
    __host__ __device__ bool next(int i, Unit& u) const {
        const long L = (long)i * G + c; if (L >= nwg) return false;
        int wgid = (int)L; { const int q = nwg / NXCD, r = nwg % NXCD, xcd = wgid % NXCD, off = wgid / NXCD; wgid = (xcd < r ? xcd * (q + 1) : r * (q + 1) + (xcd - r) * q) + off; }
        const int nig = WGM * nN, gid = wgid / nig, fm = gid * WGM, gsz = (nM - fm) < WGM ? (nM - fm) : WGM;
        u.pm = fm + ((wgid % nig) % gsz); u.pn = (wgid % nig) / gsz; return true;
    }
    __device__ __forceinline__ void a_ready(const Unit&) const {}
    __device__ __forceinline__ void done(const Unit&) const {}
};

__device__ __forceinline__ unsigned cvt_pk_bf16(float lo, float hi) { unsigned r; asm volatile("v_cvt_pk_bf16_f32 %0, %1, %2" : "=v"(r) : "v"(lo), "v"(hi)); return r; }
typedef float f32x2 __attribute__((ext_vector_type(2)));
__device__ __forceinline__ f32x2 gelu_pk(f32x2 v) {
    const f32x2 av = __builtin_elementwise_abs(v), d = av * 0.2316418882f + 1.0f;
    f32x2 t; t.x = __builtin_amdgcn_rcpf(d.x); t.y = __builtin_amdgcn_rcpf(d.y);
    f32x2 q = t * 0.5307027145f + (-0.7265760135f); q = q * t + 0.7107068705f; q = q * t + (-0.142248368f); q = q * t + 0.127414796f; q = q * t;
    const f32x2 s = (v * v) * (-0.72134752044f);
    f32x2 e; e.x = __builtin_amdgcn_exp2f(s.x); e.y = __builtin_amdgcn_exp2f(s.y);
    const f32x2 m = v * (q * e), r = v - m;
    f32x2 o; o.x = v.x < 0.f ? m.x : r.x; o.y = v.y < 0.f ? m.y : r.y; return o;
}

template <int ACT  > struct EpiBf16 {
    static constexpr bool PERM = true, AFTER_DRAIN = false; static_assert(ACT == 0 || ACT == 1, "EpiBf16: ACT is 0 (none) or 1 (gelu_pk)");
    bf16_t* O; int ldc; const float* bias; int split_cols; size_t split_stride; float scale0;
    __device__ __forceinline__ void operator()(const f32x4 (&acc)[2][2][4][2], const Unit& u, int wr, int wc, int fr, int fq) const {
        const int row0 = u.pm * BM + wr * 64 + fr; int colt = u.pn * BM; bf16_t* base = O;
        float sc = 1.f; if (split_cols) { const int t = colt / split_cols; base += (size_t)t * split_stride; colt -= t * split_cols; if (t == 0) sc = scale0; }
        const int col0 = colt + wc * 32 + 8 * fq, bcol0 = u.pn * BM + wc * 32 + 8 * fq;
        f32x4 bv[2][2];
#pragma unroll
        for (int bj = 0; bj < 2; ++bj)
#pragma unroll
            for (int n = 0; n < 2; ++n) bv[bj][n] = bias ? *(const f32x4*)(bias + bcol0 + bj * HALF + 4 * n) : (f32x4){0.f, 0.f, 0.f, 0.f};
#pragma unroll
        for (int ai = 0; ai < 2; ++ai)
#pragma unroll
            for (int m = 0; m < 4; ++m) { bf16_t* rowp = base + (size_t)(row0 + ai * HALF + m * 16) * ldc + col0;
#pragma unroll
                for (int bj = 0; bj < 2; ++bj) { f32x4 v0 = acc[ai][bj][m][0] + bv[bj][0], v1 = acc[ai][bj][m][1] + bv[bj][1];
                    if (ACT == 1) { f32x2 a = gelu_pk((f32x2){v0[0], v0[1]}), b = gelu_pk((f32x2){v0[2], v0[3]}), c = gelu_pk((f32x2){v1[0], v1[1]}), d = gelu_pk((f32x2){v1[2], v1[3]});
                        v0 = (f32x4){a.x, a.y, b.x, b.y}; v1 = (f32x4){c.x, c.y, d.x, d.y}; }
                    v0 = v0 * sc; v1 = v1 * sc; u32x4 w; w.x = cvt_pk_bf16(v0[0], v0[1]); w.y = cvt_pk_bf16(v0[2], v0[3]); w.z = cvt_pk_bf16(v1[0], v1[1]); w.w = cvt_pk_bf16(v1[2], v1[3]);
                    *(u32x4*)(rowp + bj * HALF) = w; } }
    }
};


struct GroupedOrder {
    int nM, nN, groups, gsM, G, c, total;
    __host__ __device__ void init(int nM_, int nN_, int groups_, int gsM_, int G_, int c_) { nM = nM_; nN = nN_; groups = groups_; gsM = gsM_; G = G_; c = c_; total = nM * nN * groups; }
    __host__ __device__ bool next(int i, Unit& u) const {
        const long L = (long)i * G + c; if (L >= total) return false;
        int T = (int)L; { const int q = total / NXCD, r = total % NXCD, xcd = T % NXCD, off = T / NXCD; T = (xcd < r ? xcd * (q + 1) : r * (q + 1) + (xcd - r) * q) + off; }
        const int tpg = nM * nN, g = T / tpg, t = T - g * tpg;
        const int nig = WGM * nN, gid = t / nig, fm = gid * WGM, gsz = (nM - fm) < WGM ? (nM - fm) : WGM;
        u.pm = g * gsM + fm + ((t % nig) % gsz); u.pn = g * nN + (t % nig) / gsz; return true;
    }
    __device__ __forceinline__ void a_ready(const Unit&) const {}
    __device__ __forceinline__ void done(const Unit&) const {}
};
struct LatentOrder {
    GroupedOrder o;
    __host__ __device__ void init(int nN_, int G_, int c_) { o.init(256, nN_, 1, 256, G_, c_); }
    __host__ __device__ bool next(int i, Unit& u) const { if (!o.next(i, u)) return false; u.pm += (u.pm >> 3) + 1; return true; }
    __device__ __forceinline__ void a_ready(const Unit&) const {}
    __device__ __forceinline__ void done(const Unit&) const {}
};
struct HgInOrder {
    LatentOrder lat; int G, c;
    __host__ __device__ void init(int G_, int c_) { lat.init(16, G_, c_); G = G_; c = c_; }
    __host__ __device__ bool next(int i, Unit& u) const {
        const long L = (long)i * G + c;
        if (L < 4096) return lat.next(i, u);
        const int t = (int)L - 4096; if (t >= 256) return false;
        u.pm = (t >> 3) * 9; u.pn = 4 + (t & 7); return true;
    }
    __device__ __forceinline__ void a_ready(const Unit&) const {}
    __device__ __forceinline__ void done(const Unit&) const {}
};
__device__ __forceinline__ float sigm(float x) { return __builtin_amdgcn_rcpf(1.0f + __builtin_amdgcn_exp2f(x * -1.4426950408889634f)); }
constexpr int PP = 2304, DD = 1024;
__device__ __forceinline__ int mrow_of(int row) { const int b = row / PP, pos = row - b * PP; return pos < 256 ? 32 : b; }
struct EpiResidT {
    static constexpr bool PERM = false, AFTER_DRAIN = false;
    bf16_t* X; const float* MODL;
    __device__ __forceinline__ void operator()(const f32x4 (&acc)[2][2][4][2], const Unit& u, int wr, int wc, int fr, int fq) const {
        const int row0 = u.pm * BM + wr * 64 + fr, col0 = u.pn * BM + wc * 32 + 4 * fq;
        const float* g = MODL + (size_t)mrow_of(u.pm * BM) * 6144 + 2 * DD + col0;
        f32x4 gt[2][2];
#pragma unroll
        for (int bj = 0; bj < 2; ++bj)
#pragma unroll
            for (int n = 0; n < 2; ++n) gt[bj][n] = *(const f32x4*)(g + bj * HALF + n * 16);
#pragma unroll
        for (int ai = 0; ai < 2; ++ai)
#pragma unroll
            for (int m = 0; m < 4; ++m) { const int row = row0 + ai * HALF + m * 16; bf16_t* x = X + (size_t)row * DD + col0;
                u32x2 xo[2][2];
#pragma unroll
                for (int bj = 0; bj < 2; ++bj)
#pragma unroll
                    for (int n = 0; n < 2; ++n) xo[bj][n] = *(const u32x2*)(x + bj * HALF + n * 16);
#pragma unroll
                for (int bj = 0; bj < 2; ++bj)
#pragma unroll
                    for (int n = 0; n < 2; ++n) { const int o = bj * HALF + n * 16; const f32x4 xv = {bflo(xo[bj][n].x), bfhi(xo[bj][n].x), bflo(xo[bj][n].y), bfhi(xo[bj][n].y)};
                        const f32x4 r = xv + gt[bj][n] * acc[ai][bj][m][n]; u32x2 w; w.x = pkbf(r.x, r.y); w.y = pkbf(r.z, r.w); *(u32x2*)(x + o) = w; } }
    }
};
struct EpiGluT {
    static constexpr bool PERM = true, AFTER_DRAIN = false;
    bf16_t* X; const float* MODL;
    __device__ __forceinline__ void operator()(const f32x4 (&acc)[2][2][4][2], const Unit& u, int wr, int wc, int fr, int fq) const {
        const int row0 = u.pm * BM + wr * 64 + fr, f0 = u.pn * 128 + wc * 32 + 8 * fq;
        const float* g = MODL + (size_t)mrow_of(u.pm * BM) * 6144 + 2 * DD + f0;
        const f32x4 gt[2] = {*(const f32x4*)g, *(const f32x4*)(g + 4)};
#pragma unroll
        for (int ai = 0; ai < 2; ++ai)
#pragma unroll
            for (int m = 0; m < 4; ++m) { const int row = row0 + ai * HALF + m * 16; bf16_t* x = X + (size_t)row * DD + f0;
                const u32x4 xo = *(const u32x4*)x; u32x4 w;
#pragma unroll
                for (int n = 0; n < 2; ++n) { const f32x4 a = acc[ai][0][m][n], b = acc[ai][1][m][n]; f32x4 v = b * -1.4426950408889634f;
#pragma unroll
                    for (int q = 0; q < 4; ++q) v[q] = __builtin_amdgcn_exp2f(v[q]);
                    v = v + 1.0f;
#pragma unroll
                    for (int q = 0; q < 4; ++q) v[q] = __builtin_amdgcn_rcpf(v[q]);
                    v = v * a;
                    const unsigned x01 = n ? xo.z : xo.x, x23 = n ? xo.w : xo.y; const f32x4 xv = {bflo(x01), bfhi(x01), bflo(x23), bfhi(x23)};
                    const f32x4 r = xv + gt[n] * v; if (n) { w.z = pkbf(r.x, r.y); w.w = pkbf(r.z, r.w); } else { w.x = pkbf(r.x, r.y); w.y = pkbf(r.z, r.w); } }
                *(u32x4*)x = w; }
    }
};
struct EpiSwigluT {
    static constexpr bool PERM = true, AFTER_DRAIN = false;
    bf16_t* HID; int nNg; int ldh;
    __device__ __forceinline__ void operator()(const f32x4 (&acc)[2][2][4][2], const Unit& u, int wr, int wc, int fr, int fq) const {
        const int row0 = u.pm * BM + wr * 64 + fr, f0 = (u.pn % nNg) * 128 + wc * 32 + 8 * fq;
#pragma unroll
        for (int ai = 0; ai < 2; ++ai)
#pragma unroll
            for (int m = 0; m < 4; ++m) { bf16_t* hp = HID + (size_t)(row0 + ai * HALF + m * 16) * ldh + f0;
                const f32x4 a0 = acc[ai][0][m][0], a1 = acc[ai][0][m][1], b0 = acc[ai][1][m][0], b1 = acc[ai][1][m][1];
                f32x4 e0 = a0 * -1.4426950408889634f, e1 = a1 * -1.4426950408889634f;
#pragma unroll
                for (int q = 0; q < 4; ++q) { e0[q] = __builtin_amdgcn_exp2f(e0[q]); e1[q] = __builtin_amdgcn_exp2f(e1[q]); }
                e0 = e0 + 1.0f; e1 = e1 + 1.0f;
#pragma unroll
                for (int q = 0; q < 4; ++q) { e0[q] = __builtin_amdgcn_rcpf(e0[q]); e1[q] = __builtin_amdgcn_rcpf(e1[q]); }
                const f32x4 o0 = (a0 * b0) * e0, o1 = (a1 * b1) * e1;
                u32x4 w; w.x = cvt_pk_bf16(o0.x, o0.y); w.y = cvt_pk_bf16(o0.z, o0.w); w.z = cvt_pk_bf16(o1.x, o1.y); w.w = cvt_pk_bf16(o1.z, o1.w);
                *(u32x4*)hp = w; }
    }
};
struct EpiDownT {
    static constexpr bool PERM = true, AFTER_DRAIN = false;
    bf16_t* Y; const float* GATE; int nNg;
    __device__ __forceinline__ void operator()(const f32x4 (&acc)[2][2][4][2], const Unit& u, int wr, int wc, int fr, int fq) const {
        const int row0 = u.pm * BM + wr * 64 + fr, col0 = (u.pn % nNg) * BM + wc * 32 + 8 * fq;
#pragma unroll
        for (int ai = 0; ai < 2; ++ai)
#pragma unroll
            for (int m = 0; m < 4; ++m) { const int row = row0 + ai * HALF + m * 16; bf16_t* rowp = Y + (size_t)row * DD + col0;
#pragma unroll
                for (int bj = 0; bj < 2; ++bj) { const f32x4 v0 = acc[ai][bj][m][0], v1 = acc[ai][bj][m][1];
                    u32x4 w; w.x = cvt_pk_bf16(v0[0], v0[1]); w.y = cvt_pk_bf16(v0[2], v0[3]); w.z = cvt_pk_bf16(v1[0], v1[1]); w.w = cvt_pk_bf16(v1[2], v1[3]);
                    *(u32x4*)(rowp + bj * HALF) = w; } }
    }
};
template <bool SILU> struct EpiVtT {
    static constexpr bool PERM = true, AFTER_DRAIN = false;
    bf16_t* VT;
    __device__ __forceinline__ void operator()(const f32x4 (&acc)[2][2][4][2], const Unit& u, int wr, int wc, int fr, int fq) const {
        const int hd0 = u.pm * BM + wr * 64 + fr, tok0 = u.pn * BM + wc * 32 + 8 * fq, b = (u.pn * BM) / PP, pos0 = tok0 - b * PP;
#pragma unroll
        for (int ai = 0; ai < 2; ++ai)
#pragma unroll
            for (int m = 0; m < 4; ++m) { bf16_t* rowp = VT + ((size_t)b * DD + hd0 + ai * HALF + m * 16) * PP + pos0;
#pragma unroll
                for (int bj = 0; bj < 2; ++bj) { f32x4 v0 = acc[ai][bj][m][0], v1 = acc[ai][bj][m][1];
                    if (SILU) {
#pragma unroll
                        for (int q = 0; q < 4; ++q) { v0[q] = v0[q] * sigm(v0[q]); v1[q] = v1[q] * sigm(v1[q]); } }
                    u32x4 w; w.x = cvt_pk_bf16(v0[0], v0[1]); w.y = cvt_pk_bf16(v0[2], v0[3]); w.z = cvt_pk_bf16(v1[0], v1[1]); w.w = cvt_pk_bf16(v1[2], v1[3]);
                    *(u32x4*)(rowp + bj * HALF) = w; } }
    }
};
struct EpiHgIn {
    static constexpr bool PERM = true, AFTER_DRAIN = false;
    bf16_t* O; const float* LB;
    __device__ __forceinline__ void operator()(const f32x4 (&acc)[2][2][4][2], const Unit& u, int wr, int wc, int fr, int fq) const {
        const int row0 = u.pm * BM + wr * 64 + fr, col0 = u.pn * BM + wc * 32 + 8 * fq, type = u.pn >> 2;
        f32x4 lb[2][2];
#pragma unroll
        for (int bj = 0; bj < 2; ++bj) { const int c = (col0 + bj * HALF) & 1023; lb[bj][0] = *(const f32x4*)(LB + c); lb[bj][1] = *(const f32x4*)(LB + c + 4); }
#pragma unroll
        for (int ai = 0; ai < 2; ++ai)
#pragma unroll
            for (int m = 0; m < 4; ++m) { bf16_t* rowp = O + (size_t)(row0 + ai * HALF + m * 16) * 4096 + col0;
#pragma unroll
                for (int bj = 0; bj < 2; ++bj) { f32x4 v0 = acc[ai][bj][m][0], v1 = acc[ai][bj][m][1];
                    if (type == 1 || type == 2) { const f32x4 l0 = lb[bj][0], l1 = lb[bj][1];
#pragma unroll
                        for (int q = 0; q < 4; ++q) { v0[q] = __log2f(l0[q] + (1.0f - l0[q]) * sigm(v0[q])); v1[q] = __log2f(l1[q] + (1.0f - l1[q]) * sigm(v1[q])); } }
                    else if (type == 3) {
#pragma unroll
                        for (int q = 0; q < 4; ++q) { v0[q] = v0[q] * sigm(v0[q]); v1[q] = v1[q] * sigm(v1[q]); } }
                    u32x4 w; w.x = cvt_pk_bf16(v0[0], v0[1]); w.y = cvt_pk_bf16(v0[2], v0[3]); w.z = cvt_pk_bf16(v1[0], v1[1]); w.w = cvt_pk_bf16(v1[2], v1[3]);
                    *(u32x4*)(rowp + bj * HALF) = w; } }
    }
};


struct EpiF32G {
    static constexpr bool PERM = false, AFTER_DRAIN = false;
    float* C; int ldc; int nNg;
    __device__ __forceinline__ void operator()(const f32x4 (&acc)[2][2][4][2], const Unit& u, int wr, int wc, int fr, int fq) const {
        const int row0 = u.pm * BM + wr * 64 + fr, col0 = (u.pn % nNg) * BM + wc * 32 + 4 * fq;
#pragma unroll
        for (int ai = 0; ai < 2; ++ai)
#pragma unroll
            for (int m = 0; m < 4; ++m) { float* rowp = C + (size_t)(row0 + ai * HALF + m * 16) * ldc + col0;
#pragma unroll
                for (int bj = 0; bj < 2; ++bj)
#pragma unroll
                    for (int n = 0; n < 2; ++n) *(f32x4*)(rowp + bj * HALF + n * 16) = acc[ai][bj][m][n]; }
    }
};
__device__ __forceinline__ float gelu_t(float x) { const float t = 1.5957691216057308f * (x + 0.044715f * x * x * x); return x * sigm(t); }
struct EpiS5Out {
    static constexpr bool PERM = true, AFTER_DRAIN = false;
    const bf16_t* H; bf16_t* Z; const float* dvec;
    __device__ __forceinline__ void operator()(const f32x4 (&acc)[2][2][4][2], const Unit& u, int wr, int wc, int fr, int fq) const {
        const int c0 = (u.pn & 1) * BM + wc * 32 + 8 * fq;
        const int g = (u.pm * BM) / 2304;
        f32x4 dv[2][2];
#pragma unroll
        for (int bj = 0; bj < 2; ++bj) { const int k0 = (c0 + bj * HALF) & 15; dv[bj][0] = *(const f32x4*)(dvec + g * 16 + k0); dv[bj][1] = *(const f32x4*)(dvec + g * 16 + k0 + 4); }
#pragma unroll
        for (int ai = 0; ai < 2; ++ai)
#pragma unroll
            for (int m = 0; m < 4; ++m) {
                const int rg = u.pm * BM + ai * HALF + wr * 64 + m * 16 + fr, rem = rg - g * 2304, b = rem / 72, j = rem - b * 72;
#pragma unroll
                for (int bj = 0; bj < 2; ++bj) {
                    const int mc = c0 + bj * HALF, tau = mc >> 4, k0 = mc & 15;
                    const size_t off = ((size_t)b * PP + 32 * j + tau) * DD + g * 16 + k0;
                    const u32x4 uw = *(const u32x4*)(H + off);
                    const f32x4 d0 = dv[bj][0], d1 = dv[bj][1];
                    const f32x4 y0 = acc[ai][bj][m][0], y1 = acc[ai][bj][m][1];
                    u32x4 w;
                    w.x = cvt_pk_bf16(gelu_t(y0[0] + d0[0] * __uint_as_float(uw.x << 16)), gelu_t(y0[1] + d0[1] * __uint_as_float(uw.x & 0xffff0000u)));
                    w.y = cvt_pk_bf16(gelu_t(y0[2] + d0[2] * __uint_as_float(uw.y << 16)), gelu_t(y0[3] + d0[3] * __uint_as_float(uw.y & 0xffff0000u)));
                    w.z = cvt_pk_bf16(gelu_t(y1[0] + d1[0] * __uint_as_float(uw.z << 16)), gelu_t(y1[1] + d1[1] * __uint_as_float(uw.z & 0xffff0000u)));
                    w.w = cvt_pk_bf16(gelu_t(y1[2] + d1[2] * __uint_as_float(uw.w << 16)), gelu_t(y1[3] + d1[3] * __uint_as_float(uw.w & 0xffff0000u)));
                    *(u32x4*)(Z + off) = w;
                }
            }
    }
};


__device__ __forceinline__ void xor32_pair(float x, float y, float& xs, float& ys) {
    const auto r1 = __builtin_amdgcn_permlane32_swap(__float_as_uint(x), __float_as_uint(y), false, false);
    const auto r2 = __builtin_amdgcn_permlane32_swap(r1[1], r1[0], false, false);
    xs = __uint_as_float(r2[0]); ys = __uint_as_float(r2[1]);
}
struct EpiQKRope {
    static constexpr bool PERM = true, AFTER_DRAIN = false;
    bf16_t* Q; size_t kstride; const PG8_LAS float* T;
    __device__ __forceinline__ void operator()(const f32x4 (&acc)[2][2][4][2], const Unit& u, int wr, int wc, int fr, int fq) const {
        const int row0 = u.pm * BM + wr * 64 + fr; int colt = u.pn * BM; bf16_t* base = Q;
        { const int t = colt / DD; base += (size_t)t * kstride; colt -= t * DD; }
        const int col0 = colt + wc * 32 + 8 * fq, half = wc & 1; const bool first = fq < 2;
        const int tb = (u.pm * BM) / PP;
        const float qs = u.pn * BM < DD ? 0.125f * 1.4426950408889634f : 1.0f;
#pragma unroll
        for (int ai = 0; ai < 2; ++ai)
#pragma unroll
            for (int m = 0; m < 4; ++m) { const int row = row0 + ai * HALF + m * 16, pos = row - tb * PP, tt = pos - 256; const bool lat = pos >= 256;
                const int p = lat ? (half ? (tt & 63) : (tt >> 6)) : 0;
                const PG8_LAS f32x4* cs = (const PG8_LAS f32x4*)(T + (p * 16 + 8 * (fq & 1)) * 2);
                const f32x4 t0 = cs[0], t1 = cs[1], t2 = cs[2], t3 = cs[3];
                bf16_t* rowp = base + (size_t)row * DD + col0;
#pragma unroll
                for (int bj = 0; bj < 2; ++bj) { f32x4 v0 = acc[ai][bj][m][0] * qs, v1 = acc[ai][bj][m][1] * qs;
                    f32x4 p0, p1;
#pragma unroll
                    for (int q = 0; q < 4; ++q) { float a_, b_; xor32_pair(v0[q], v1[q], a_, b_); p0[q] = a_; p1[q] = b_; }
                    if (lat) { const float sg = first ? -1.0f : 1.0f;
                        v0 = (f32x4){v0[0] * t0[0] + sg * p0[0] * t0[1], v0[1] * t0[2] + sg * p0[1] * t0[3], v0[2] * t1[0] + sg * p0[2] * t1[1], v0[3] * t1[2] + sg * p0[3] * t1[3]};
                        v1 = (f32x4){v1[0] * t2[0] + sg * p1[0] * t2[1], v1[1] * t2[2] + sg * p1[1] * t2[3], v1[2] * t3[0] + sg * p1[2] * t3[1], v1[3] * t3[2] + sg * p1[3] * t3[3]}; }
                    u32x4 w; w.x = cvt_pk_bf16(v0[0], v0[1]); w.y = cvt_pk_bf16(v0[2], v0[3]); w.z = cvt_pk_bf16(v1[0], v1[1]); w.w = cvt_pk_bf16(v1[2], v1[3]);
                    *(u32x4*)(rowp + bj * HALF) = w; } }
    }
};

template <class Epi, class Sched, bool ALIGN_EPI = false, bool SP2 = false, bool GATHER = false>
__device__ __forceinline__ void gemm_phase(PG8_LAS unsigned char* lds, const Gemm g, const Sched& S, const Epi& E, const int tid) {
    const int wid = __builtin_amdgcn_readfirstlane(tid >> 6), lane = tid & 63, wr = wid >> 2, wc = wid & 3, fr = lane & 15, fq = lane >> 4;
    const int K = g.K, nt = K / BK;
    unsigned voffA[2], voffB[2];
#pragma unroll
    for (int i = 0; i < 2; ++i) { int R, C; stage_rc(tid * 16 + i * 8192, R, C); const int Rb = Epi::PERM ? ((R & ~31) + perm32(R & 31)) : R;
        voffA[i] = (unsigned)(R * g.lda + C) * 2u; voffB[i] = (unsigned)(Rb * g.ldb + C) * 2u; }
    unsigned vA0[2] = {0u, 0u}, vA1[2] = {0u, 0u}, wA0[2] = {0u, 0u}, wA1[2] = {0u, 0u};
#define PG8_GOFF(u_, o0, o1) do { _Pragma("unroll") for (int i = 0; i < 2; ++i) { int R, C; stage_rc(tid * 16 + i * 8192, R, C); const int r0_ = (u_).pm * BM + R; \
        o0[i] = ((unsigned)g.rowidx[r0_] * (unsigned)g.lda + (unsigned)C) * 2u; o1[i] = ((unsigned)g.rowidx[r0_ + HALF] * (unsigned)g.lda + (unsigned)C) * 2u; } } while (0)
    const size_t kstep = (size_t)(BK * 2);
    const size_t hstepA = (size_t)HALF * g.lda * 2, hstepB = (size_t)HALF * g.ldb * 2;
    const size_t tstepA = 2 * hstepA, tstepB = 2 * hstepB;
    const unsigned ldsw = (unsigned)wid * 1024u;
    const int aoff = lds_byte(wr * 64 + fr, fq * 8), boff = lds_byte(wc * 32 + fr, fq * 8);
#define PG8_SA(b, h) (((b) * 2 + (h)) * HTB)
#define PG8_SB(b, h) ((4 + (b) * 2 + (h)) * HTB)
#define PG8_STAGE(bufoff, gbase, voff) do { _Pragma("unroll") for (int _i = 0; _i < 2; ++_i) \
        __builtin_amdgcn_global_load_lds((const unsigned*)((const char*)(gbase) + (voff)[_i]), (PG8_LAS unsigned*)(lds + (bufoff) + ldsw + _i * 8192), 16, 0, 0); } while (0)
#define PG8_STAGEA(bufoff, kptr, h, oc0, oc1) do { if constexpr (GATHER) { if (h) PG8_STAGE(bufoff, kptr, oc1); else PG8_STAGE(bufoff, kptr, oc0); } else { PG8_STAGE(bufoff, (kptr) + ((h) ? hstepA : 0), voffA); } } while (0)
#define PG8_LDA(dst, b, h) do { _Pragma("unroll") for (int m = 0; m < 4; ++m) _Pragma("unroll") for (int k = 0; k < 2; ++k) dst[m][k] = *(const PG8_LAS bf16x8*)(lds + PG8_SA(b, h) + aoff + m * 2048 + k * 1024); } while (0)
#define PG8_LDB(dst, b, h) do { _Pragma("unroll") for (int n = 0; n < 2; ++n) _Pragma("unroll") for (int k = 0; k < 2; ++k) dst[n][k] = *(const PG8_LAS bf16x8*)(lds + PG8_SB(b, h) + boff + n * 2048 + k * 1024); } while (0)
#define PG8_MMA(ai, bj, At, Bt) do { __builtin_amdgcn_s_setprio(1); _Pragma("unroll") for (int m = 0; m < 4; ++m) _Pragma("unroll") for (int n = 0; n < 2; ++n) _Pragma("unroll") for (int k = 0; k < 2; ++k) \
        acc[ai][bj][m][n] = __builtin_amdgcn_mfma_f32_16x16x32_bf16(Bt[n][k], At[m][k], acc[ai][bj][m][n], 0, 0, 0); __builtin_amdgcn_s_setprio(0); } while (0)
#define PG8_WAIT_V(n) asm volatile("s_waitcnt vmcnt(" #n ")" ::: "memory")
#define PG8_WAIT_L(n) asm volatile("s_waitcnt lgkmcnt(" #n ")" ::: "memory")
#define PG8_BAR __builtin_amdgcn_s_barrier()
#define PG8_SCHED __builtin_amdgcn_sched_barrier(0)
    Unit cur, nxt; int ui = 0;
    if (!S.next(0, cur)) return;
    f32x4 acc[2][2][4][2];
#pragma unroll
    for (int a = 0; a < 2; ++a)
#pragma unroll
        for (int b = 0; b < 2; ++b)
#pragma unroll
            for (int m = 0; m < 4; ++m)
#pragma unroll
                for (int n = 0; n < 2; ++n) acc[a][b][m][n] = (f32x4){0.f, 0.f, 0.f, 0.f};
    bf16x8 At[4][2], B0[2][2], B1[2][2];
    const char* cA = (const char*)g.A + (GATHER ? (size_t)0 : (size_t)cur.pm * tstepA); if constexpr (GATHER) PG8_GOFF(cur, vA0, vA1);
    const char* cB = (const char*)g.Bt + (size_t)cur.pn * tstepB;
    S.a_ready(cur);
    if constexpr (SP2) {
        PG8_STAGE(PG8_SB(0, 0), cB, voffB); PG8_STAGE(PG8_SB(0, 1), cB + hstepB, voffB); PG8_STAGEA(PG8_SA(0, 0), cA, 0, vA0, vA1); PG8_STAGEA(PG8_SA(0, 1), cA, 1, vA0, vA1);
        if (wr == 1) PG8_BAR;
        PG8_WAIT_V(2); PG8_BAR;
        PG8_STAGE(PG8_SB(1, 0), cB + kstep, voffB); PG8_STAGEA(PG8_SA(1, 0), cA + kstep, 0, vA0, vA1); PG8_STAGE(PG8_SB(1, 1), cB + hstepB + kstep, voffB);
        PG8_WAIT_V(6); PG8_BAR;
    } else {
        PG8_STAGE(PG8_SB(0, 0), cB, voffB); PG8_STAGE(PG8_SA(0, 0), cA, voffA); PG8_STAGE(PG8_SB(0, 1), cB + hstepB, voffB); PG8_STAGE(PG8_SA(0, 1), cA + hstepA, voffA);
        if (wr == 1) PG8_BAR;
        PG8_WAIT_V(4); PG8_BAR;
        PG8_STAGE(PG8_SB(1, 0), cB + kstep, voffB); PG8_STAGE(PG8_SA(1, 0), cA + kstep, voffA); PG8_STAGE(PG8_SB(1, 1), cB + hstepB + kstep, voffB);
        PG8_WAIT_V(6); PG8_BAR;
    }
    for (;;) {
        const bool has_next = S.next(ui + 1, nxt);
        const char* nA = (has_next && !GATHER) ? (const char*)g.A + (size_t)nxt.pm * tstepA : cA;
        if constexpr (GATHER) { if (has_next) { if (wid < 4) __builtin_amdgcn_global_load_lds((const unsigned*)(g.rowidx + (size_t)nxt.pm * BM + (tid & 255)), (PG8_LAS unsigned*)(lds + STAGE_BYTES + wid * 256), 4, 0, 0); }
                                else { wA0[0] = vA0[0]; wA0[1] = vA0[1]; wA1[0] = vA1[0]; wA1[1] = vA1[1]; } }
        const char* nB = has_next ? (const char*)g.Bt + (size_t)nxt.pn * tstepB : cB;
        for (int t = 0; t < nt; t += 2) {
            const bool last = (t == nt - 2);
            const char* a1 = cA + (size_t)(t + 1) * kstep;
            const char* a2 = last ? nA : cA + (size_t)(t + 2) * kstep; const char* b2 = last ? nB : cB + (size_t)(t + 2) * kstep;
            const char* a3 = a2 + kstep; const char* b3 = b2 + kstep;
            if (last && has_next) S.a_ready(nxt);
            if constexpr (GATHER) { if (last && has_next) {
#pragma unroll
                for (int i = 0; i < 2; ++i) { int R, C; stage_rc(tid * 16 + i * 8192, R, C);
                    const unsigned i0_ = *(const PG8_LAS unsigned*)(lds + STAGE_BYTES + R * 4), i1_ = *(const PG8_LAS unsigned*)(lds + STAGE_BYTES + (R + HALF) * 4);
                    wA0[i] = (i0_ * (unsigned)g.lda + (unsigned)C) * 2u; wA1[i] = (i1_ * (unsigned)g.lda + (unsigned)C) * 2u; } } }
            const unsigned sA0[2] = {last ? wA0[0] : vA0[0], last ? wA0[1] : vA0[1]}, sA1[2] = {last ? wA1[0] : vA1[0], last ? wA1[1] : vA1[1]};
            if constexpr (SP2) {
            PG8_LDB(B0, 0, 0); PG8_LDB(B1, 0, 1); PG8_SCHED; PG8_LDA(At, 0, 0); PG8_STAGEA(PG8_SA(1, 1), a1, 1, vA0, vA1);
            PG8_WAIT_V(8); PG8_WAIT_L(0); PG8_BAR; PG8_MMA(0, 0, At, B0); PG8_MMA(0, 1, At, B1); PG8_BAR; PG8_SCHED;
            PG8_LDA(At, 0, 1); PG8_STAGE(PG8_SB(0, 0), b2, voffB); PG8_STAGE(PG8_SB(0, 1), b2 + hstepB, voffB); PG8_STAGEA(PG8_SA(0, 0), a2, 0, sA0, sA1);
            PG8_WAIT_V(8); PG8_WAIT_L(0); PG8_BAR; PG8_MMA(1, 0, At, B0); PG8_MMA(1, 1, At, B1); PG8_BAR; PG8_SCHED;
            PG8_LDB(B0, 1, 0); PG8_LDB(B1, 1, 1); PG8_SCHED; PG8_LDA(At, 1, 0); PG8_STAGEA(PG8_SA(0, 1), a2, 1, sA0, sA1);
            PG8_WAIT_V(8); PG8_WAIT_L(0); PG8_BAR; PG8_MMA(0, 0, At, B0); PG8_MMA(0, 1, At, B1); PG8_BAR; PG8_SCHED;
            PG8_LDA(At, 1, 1); PG8_STAGE(PG8_SB(1, 0), b3, voffB); PG8_STAGE(PG8_SB(1, 1), b3 + hstepB, voffB); PG8_STAGEA(PG8_SA(1, 0), a3, 0, sA0, sA1);
            PG8_WAIT_V(8); PG8_WAIT_L(0); PG8_BAR; PG8_MMA(1, 0, At, B0); PG8_MMA(1, 1, At, B1); PG8_BAR; PG8_SCHED;
            } else {
            PG8_LDB(B0, 0, 0); PG8_SCHED; PG8_LDA(At, 0, 0); PG8_STAGE(PG8_SA(1, 1), a1 + hstepA, voffA);
            PG8_WAIT_L(8); PG8_BAR; PG8_WAIT_L(0); PG8_MMA(0, 0, At, B0); PG8_BAR; PG8_SCHED;
            PG8_LDB(B1, 0, 1); PG8_STAGE(PG8_SB(0, 0), b2, voffB);
            PG8_BAR; PG8_WAIT_L(0); PG8_MMA(0, 1, At, B1); PG8_BAR;
            PG8_LDA(At, 0, 1); PG8_STAGE(PG8_SA(0, 0), a2, voffA);
            PG8_BAR; PG8_WAIT_L(0); PG8_MMA(1, 0, At, B0); PG8_BAR; PG8_SCHED;
            PG8_STAGE(PG8_SB(0, 1), b2 + hstepB, voffB);
            PG8_WAIT_V(6); PG8_BAR; PG8_MMA(1, 1, At, B1); PG8_BAR;
            PG8_LDB(B0, 1, 0); PG8_SCHED; PG8_LDA(At, 1, 0); PG8_STAGE(PG8_SA(0, 1), a2 + hstepA, voffA);
            PG8_WAIT_L(8); PG8_BAR; PG8_WAIT_L(0); PG8_MMA(0, 0, At, B0); PG8_BAR; PG8_SCHED;
            PG8_LDB(B1, 1, 1); PG8_STAGE(PG8_SB(1, 0), b3, voffB);
            PG8_BAR; PG8_WAIT_L(0); PG8_MMA(0, 1, At, B1); PG8_BAR;
            PG8_LDA(At, 1, 1); PG8_STAGE(PG8_SA(1, 0), a3, voffA);
            PG8_BAR; PG8_WAIT_L(0); PG8_MMA(1, 0, At, B0); PG8_BAR; PG8_SCHED;
            PG8_STAGE(PG8_SB(1, 1), b3 + hstepB, voffB);
            PG8_WAIT_V(6); PG8_BAR; PG8_MMA(1, 1, At, B1); PG8_BAR;
            }
        }
        if constexpr (ALIGN_EPI) { if (wr == 0) PG8_BAR; }
        if constexpr (!Epi::AFTER_DRAIN) { E(acc, cur, wr, wc, fr, fq); S.done(cur); }
        if (!has_next) break;
#pragma unroll
        for (int a = 0; a < 2; ++a)
#pragma unroll
            for (int b = 0; b < 2; ++b)
#pragma unroll
                for (int m = 0; m < 4; ++m)
#pragma unroll
                    for (int n = 0; n < 2; ++n) { double z0_, z1_; asm volatile("v_mov_b64 %0, 0\n\tv_mov_b64 %1, 0" : "=v"(z0_), "=v"(z1_));
                        typedef double f64x2_ __attribute__((ext_vector_type(2))); acc[a][b][m][n] = __builtin_bit_cast(f32x4, (f64x2_){z0_, z1_}); }
        cur = nxt; cA = nA; cB = nB; ++ui; vA0[0] = wA0[0]; vA0[1] = wA0[1]; vA1[0] = wA1[0]; vA1[1] = wA1[1];
        if constexpr (ALIGN_EPI) { if (wr == 1) PG8_BAR; }
    }
    PG8_WAIT_V(0);
    if constexpr (!ALIGN_EPI) { if (wr == 0) PG8_BAR; }
    PG8_BAR;
    if constexpr (Epi::AFTER_DRAIN) { E.fused(acc, cur, wr, wc, fr, fq, lds, wid, lane); S.done(cur); }
#undef PG8_SA
#undef PG8_SB
#undef PG8_STAGE
#undef PG8_STAGEA
#undef PG8_GOFF
#undef PG8_LDA
#undef PG8_LDB
#undef PG8_MMA
#undef PG8_WAIT_V
#undef PG8_WAIT_L
#undef PG8_BAR
#undef PG8_SCHED
}
}
#define PG8_SP2 true
#define PG8_ALIGN true

struct Frame;
struct Args { const float* in[33]; float* out; unsigned char* ws; int ph_lo, ph_hi; };
struct Frame {
    unsigned char* lds;
    int tid, lane, wave, bid, nb;
    const float* const* in;
    float* out; unsigned char* ws;
    float* MOD; float* AFF; int* SEL; float* GATE; int* INV; bf16* X; bf16* H;
};
__device__ __forceinline__ void REFRESH_(Frame& F) { int l_; asm volatile("v_mbcnt_lo_u32_b32 %0, -1, 0\n\tv_mbcnt_hi_u32_b32 %0, -1, %0" : "=v"(l_)); F.lane = l_; F.tid = F.wave * 64 + l_; }
__device__ __forceinline__ int mod_row(int row) { const int b = row / P, pos = row - b * P; return pos < NCTX ? 32 : b; }

__device__ __forceinline__ void ph_s5_pre(const Frame& F) {
    const float *a_re = F.in[8], *a_im = F.in[9], *log_dt = F.in[10], *b_re = F.in[11], *b_im = F.in[12], *c_re = F.in[13], *c_im = F.in[14];
    f32x2* Bb = (f32x2*)F.lds;
    f32x2* Cc = Bb + 2048;
    f32x2* Ap = Cc + 2048;
    float* Kt = (float*)(Ap + 2 * 33 * 64);
    bf16* W1 = (bf16*)(F.ws + WS_S5W1); bf16* W2 = (bf16*)(F.ws + WS_S5W2); f32x2* A32 = (f32x2*)(F.ws + WS_S5A);
    const int tid = F.tid;
    for (int g = F.nb - 1 - F.bid; g < 64; g += F.nb) {
        __syncthreads();
        if (tid < 128) {
            const int dir = tid >> 6, p = tid & 63, dg = dir * 64 + g;
            const double are = (double)a_re[dg * 64 + p], aim = (double)a_im[dg * 64 + p], dt = exp((double)log_dt[dg]);
            const double lr = are * dt, li = aim * dt, cl = cos(li), sl = sin(li), mag = exp(lr);
            const double Abi = mag * sl, sh = sin(0.5 * li), nr = expm1(lr) * cl - 2.0 * sh * sh, den = are * are + aim * aim;
            const double fr = (nr * are + Abi * aim) / den, fi = (Abi * are - nr * aim) / den;
            for (int h = 0; h < 16; ++h) { const double br = (double)b_re[((size_t)dg * 64 + p) * 16 + h], bi = (double)b_im[((size_t)dg * 64 + p) * 16 + h];
                Bb[(dir * 64 + p) * 16 + h] = (f32x2){(float)(fr * br - fi * bi), (float)(fr * bi + fi * br)}; }
            const double Abr = mag * cl; double pr = 1.0, pi = 0.0;
            for (int e = 0; e <= 32; ++e) { const f32x2 v = {(float)pr, (float)pi};
                Ap[(dir * 33 + e) * 64 + p] = v; if (e == 32) A32[(g * 2 + dir) * 64 + p] = v;
                const double nr2 = pr * Abr - pi * Abi, ni2 = pr * Abi + pi * Abr; pr = nr2; pi = ni2; }
        }
        for (int i = tid; i < 2048; i += NTHREADS) { const int dir = i >> 10, k = (i >> 6) & 15, p = i & 63; const size_t o = ((size_t)(dir * 64 + g) * 16 + k) * 64 + p; Cc[i] = (f32x2){c_re[o], c_im[o]}; }
        __syncthreads();
        {
            const int dir = tid >> 8, k = (tid >> 4) & 15, h = tid & 15; float acc[32];
#pragma unroll
            for (int lag = 0; lag < 32; ++lag) acc[lag] = 0.f;
#pragma unroll 2
            for (int p = 0; p < 64; ++p) { const f32x2 c = Cc[(dir * 16 + k) * 64 + p], bb = Bb[(dir * 64 + p) * 16 + h], a1 = Ap[(dir * 33 + 1) * 64 + p];
                float zr = c.x * bb.x - c.y * bb.y, zi = c.x * bb.y + c.y * bb.x;
#pragma unroll
                for (int lag = 0; lag < 32; ++lag) { acc[lag] += zr; const float nz = zr * a1.x - zi * a1.y; zi = zr * a1.y + zi * a1.x; zr = nz; } }
#pragma unroll
            for (int lag = 0; lag < 32; ++lag) Kt[((dir * 32 + lag) * 16 + k) * 16 + h] = acc[lag];
        }
        for (int i = tid; i < 16384; i += NTHREADS) {
            const int n = i >> 6, sg = (i >> 1) & 31, h0 = (i & 1) * 8, dir = n >> 7, c = (n >> 6) & 1, p = n & 63, e = dir ? sg : 31 - sg;
            const f32x2 a = Ap[(dir * 33 + e) * 64 + p]; float v[8];
#pragma unroll
            for (int q = 0; q < 8; ++q) { const f32x2 bb = Bb[(dir * 64 + p) * 16 + h0 + q]; v[q] = c ? a.x * bb.y + a.y * bb.x : a.x * bb.x - a.y * bb.y; }
            u32x4 w; w.x = pk2(v[0], v[1]); w.y = pk2(v[2], v[3]); w.z = pk2(v[4], v[5]); w.w = pk2(v[6], v[7]);
            *(u32x4*)(W1 + ((size_t)g * 256 + n) * 512 + sg * 16 + h0) = w;
        }
        for (int i = tid; i < 16384; i += NTHREADS) {
            const int m = i >> 5, n0 = (i & 31) * 8, dir = n0 >> 7, c = (n0 >> 6) & 1, p0 = n0 & 63, tau = m >> 4, k = m & 15, e = dir ? 32 - tau : tau + 1; float v[8];
#pragma unroll
            for (int q = 0; q < 8; ++q) { const f32x2 cc = Cc[(dir * 16 + k) * 64 + p0 + q], a = Ap[(dir * 33 + e) * 64 + p0 + q]; v[q] = c ? -(cc.x * a.y + cc.y * a.x) : cc.x * a.x - cc.y * a.y; }
            u32x4 w; w.x = pk2(v[0], v[1]); w.y = pk2(v[2], v[3]); w.z = pk2(v[4], v[5]); w.w = pk2(v[6], v[7]);
            *(u32x4*)(W2 + ((size_t)g * 512 + m) * 768 + 512 + n0) = w;
        }
        __syncthreads();
        for (int i = tid; i < 32768; i += NTHREADS) {
            const int m = i >> 6, sg = (i >> 1) & 31, h0 = (i & 1) * 8, tau = m >> 4, k = m & 15; float v[8];
#pragma unroll
            for (int q = 0; q < 8; ++q) { float x = 0.f; if (sg <= tau) x += Kt[((tau - sg) * 16 + k) * 16 + h0 + q]; if (sg >= tau) x += Kt[((32 + sg - tau) * 16 + k) * 16 + h0 + q]; v[q] = x; }
            u32x4 w; w.x = pk2(v[0], v[1]); w.y = pk2(v[2], v[3]); w.z = pk2(v[4], v[5]); w.w = pk2(v[6], v[7]);
            *(u32x4*)(W2 + ((size_t)g * 512 + m) * 768 + sg * 16 + h0) = w;
        }
    }
    __syncthreads();
}
__device__ __forceinline__ void ph_s5_scan(const Frame& F) {
    const float* SS = (const float*)(F.ws + WS_SS); bf16* AG = (bf16*)(F.ws + WS_AG); const f32x2* A32 = (const f32x2*)(F.ws + WS_S5A);
    for (int gid = F.bid * NTHREADS + F.tid; gid < 64 * 32 * 128; gid += F.nb * NTHREADS) {
        const int p = gid & 63, dir = (gid >> 6) & 1, b = (gid >> 7) & 31, g = gid >> 12;
        const f32x2 a = A32[(g * 2 + dir) * 64 + p];
        float hr = 0.f, hi = 0.f;
        const size_t row0 = (size_t)g * 2304 + b * 72;
#pragma unroll 4
        for (int idx = 0; idx < 72; ++idx) {
            const int j = dir == 0 ? idx : (idx < 8 ? 7 - idx : 79 - idx);
            const size_t row = row0 + j;
            AG[row * 768 + 512 + dir * 128 + p] = (bf16)f2bf(hr); AG[row * 768 + 512 + dir * 128 + 64 + p] = (bf16)f2bf(hi);
            const float sr = SS[row * 256 + dir * 128 + p], si = SS[row * 256 + dir * 128 + 64 + p];
            const float nr = a.x * hr - a.y * hi + sr, ni = a.x * hi + a.y * hr + si; hr = nr; hi = ni;
        }
    }
}

template <int DUAL>
__device__ __forceinline__ void transpose_item(const float* W, int ldw, int K, int N, bf16* WT, int row_off, LAS float* scr, int item, int lane) {
    const int nblk = N / 64, kb = item / nblk, nb = item - kb * nblk, k0 = 64 * kb, n0 = 64 * nb;
    const int lr = lane >> 4, lc = (lane & 15) * 4;
    f32x4 v[16];
#pragma unroll
    for (int i = 0; i < 16; ++i) v[i] = *(const f32x4*)(W + (size_t)(k0 + lr + 4 * i) * ldw + n0 + lc);
#pragma unroll
    for (int i = 0; i < 16; ++i) { LAS float* d = scr + (lr + 4 * i) * 65 + lc; d[0] = v[i].x; d[1] = v[i].y; d[2] = v[i].z; d[3] = v[i].w; }
    asm volatile("s_waitcnt lgkmcnt(0)" ::: "memory");
    const int c = lane & 7;
#pragma unroll
    for (int j = 0; j < 8; ++j) { const int n = (lane >> 3) + 8 * j; const LAS float* sp = scr + (8 * c) * 65 + n;
        u32x4 o; o.x = pkbf(sp[0 * 65], sp[1 * 65]); o.y = pkbf(sp[2 * 65], sp[3 * 65]); o.z = pkbf(sp[4 * 65], sp[5 * 65]); o.w = pkbf(sp[6 * 65], sp[7 * 65]);
        const int nn = n0 + n, dest = DUAL == -2 ? (nn < 3072 ? nn : (nn < 4096 ? nn + 1024 : nn - 1024)) : (DUAL < 0 ? row_off + nn : row_off + (nn >> 7) * 256 + DUAL * 128 + (nn & 127));
        *(u32x4*)(WT + (size_t)dest * K + k0 + 8 * c) = o; }
    asm volatile("s_waitcnt lgkmcnt(0)" ::: "memory");
}
__device__ __forceinline__ void convert_moe(const Frame& F, int l, int cb = -1, int cnb = 0) {
    if (cb < 0) { cb = F.bid; cnb = F.nb; }
    if (cb >= cnb) return;
    LAS float* scr = (LAS float*)((LAS unsigned char*)F.lds) + F.wave * 4160;
    bf16* WGU = (bf16*)(F.ws + WO_GU); bf16* WDN = (bf16*)(F.ws + WO_DN);
    for (int it = cb * NWAVES + F.wave; it < 24576; it += cnb * NWAVES) {
        const int m = it >> 13, r = it & 8191, e = r >> 9, item = r & 511;
        if (m == 0) transpose_item<0>(F.in[29] + (size_t)(l * NE + e) * D * FF, FF, D, FF, WGU, e * 2 * FF, scr, item, F.lane);
        else if (m == 1) transpose_item<1>(F.in[30] + (size_t)(l * NE + e) * D * FF, FF, D, FF, WGU, e * 2 * FF, scr, item, F.lane);
        else transpose_item<-1>(F.in[31] + (size_t)(l * NE + e) * FF * D, D, FF, D, WDN, e * D, scr, item, F.lane);
    }
}
__device__ __forceinline__ void convert_mixers(const Frame& F, int cb, int cnb) {
    if (cb >= cnb) return;
    LAS float* scr = (LAS float*)((LAS unsigned char*)F.lds) + F.wave * 4160;
    for (int it = cb * NWAVES + F.wave; it < 4096; it += cnb * NWAVES) {
        int r = it;
        if (r < 256) { transpose_item<0>(F.in[16], 2 * D, D, D, (bf16*)(F.ws + WO_GLU), 0, scr, r, F.lane); continue; } r -= 256;
        if (r < 256) { transpose_item<1>(F.in[16] + D, 2 * D, D, D, (bf16*)(F.ws + WO_GLU), 0, scr, r, F.lane); continue; } r -= 256;
        if (r < 768) { transpose_item<-1>(F.in[17], 3 * D, D, 3 * D, (bf16*)(F.ws + WO_NAQKV), 0, scr, r, F.lane); continue; } r -= 768;
        if (r < 256) { transpose_item<-1>(F.in[18], D, D, D, (bf16*)(F.ws + WO_NAO), 0, scr, r, F.lane); continue; } r -= 256;
        if (r < 768) { transpose_item<-1>(F.in[20], 3 * D, D, 3 * D, (bf16*)(F.ws + WO_DAQKV), 0, scr, r, F.lane); continue; } r -= 768;
        if (r < 256) { transpose_item<-1>(F.in[21], D, D, D, (bf16*)(F.ws + WO_DAO), 0, scr, r, F.lane); continue; } r -= 256;
        if (r < 1280) { transpose_item<-2>(F.in[24], 5 * D, D, 5 * D, (bf16*)(F.ws + WO_HGIN), 0, scr, r, F.lane); continue; } r -= 1280;
        transpose_item<-1>(F.in[25], D, D, D, (bf16*)(F.ws + WO_HGO), 0, scr, r, F.lane);
    }
}

__device__ __forceinline__ void ph_prologue(const Frame& F) {
    {
        float* S = (float*)F.lds;
        for (int i = F.tid; i < 33 * 1024; i += NTHREADS) { const float v = i < 32 * 1024 ? F.in[1][i] : F.in[3][i - 32 * 1024]; S[i] = siluf_(v); }
        __syncthreads();
        float acc[2][33];
#pragma unroll
        for (int t = 0; t < 2; ++t)
#pragma unroll
            for (int r = 0; r < 33; ++r) acc[t][r] = 0.f;
#pragma unroll
        for (int t = 0; t < 2; ++t) {
            const int task = F.bid + t * F.nb;
            if (task < 384) {
                const int l = task / 96, col = (task % 96) * 64 + F.lane, kb = F.wave * 128;
                const float* W = F.in[4] + (size_t)l * 1024 * 6144 + col;
#pragma unroll 1
                for (int k = kb; k < kb + 128; k += 8) {
                    float w[8];
#pragma unroll
                    for (int q = 0; q < 8; ++q) w[q] = W[(size_t)(k + q) * 6144];
#pragma unroll
                    for (int r = 0; r < 33; ++r) { const f32x4 s0 = *(const f32x4*)&S[r * 1024 + k], s1 = *(const f32x4*)&S[r * 1024 + k + 4];
                        acc[t][r] += (s0.x * w[0] + s0.y * w[1]) + (s0.z * w[2] + s0.w * w[3]) + (s1.x * w[4] + s1.y * w[5]) + (s1.z * w[6] + s1.w * w[7]); }
                }
            }
        }
        __syncthreads();
#pragma unroll
        for (int t = 0; t < 2; ++t)
#pragma unroll
            for (int r = 0; r < 33; ++r) S[((t * 8 + F.wave) * 33 + r) * 64 + F.lane] = acc[t][r];
        __syncthreads();
        for (int i = F.tid; i < 2 * 33 * 64; i += NTHREADS) {
            const int t = i / (33 * 64), r = (i / 64) % 33, ln = i & 63, task = F.bid + t * F.nb;
            if (task < 384) { const int l = task / 96, col = (task % 96) * 64 + ln; float v = F.in[5][l * 6144 + col];
#pragma unroll
                for (int w = 0; w < 8; ++w) v += S[((t * 8 + w) * 33 + r) * 64 + ln];
                F.MOD[((size_t)l * 33 + r) * 6144 + col] = v; }
        }
        __syncthreads();
    }
    if (F.bid == 48) {
        const float* lbin = F.in[27];
        for (int c = F.tid; c < D; c += NTHREADS) { const float x0 = lbin[c], x1 = lbin[D + c], x2 = lbin[2 * D + c], x3 = lbin[3 * D + c], mx = fmaxf(fmaxf(x0, x1), fmaxf(x2, x3));
            const float e0 = expf(x0 - mx), e1 = expf(x1 - mx), e2 = expf(x2 - mx), e3 = expf(x3 - mx); ((float*)(F.ws + WS_LB))[c] = (e1 + e2 + e3) / (e0 + e1 + e2 + e3); }
    }
    if (F.bid == 49) {
        for (int i = F.tid; i < 64 * 16; i += NTHREADS) { const float inv = powf(10000.0f, -(float)(i & 15) * (1.0f / 16.0f)); float sn, cs; sincosf((float)(i >> 4) * inv, &sn, &cs);
            ((float*)(F.ws + WS_ROPE))[2 * i] = cs; ((float*)(F.ws + WS_ROPE))[2 * i + 1] = sn; }
    }
    { const int ncv = F.nb > 128 ? F.nb - 64 : F.nb;
      convert_mixers(F, F.bid, ncv); convert_moe(F, 0, F.bid, ncv); }
    __syncthreads();
    ph_s5_pre(F);
}

template <bool F32> struct XRawT { typedef f32x4 T; };
template <> struct XRawT<false> { typedef u32x2 T; };
__device__ __forceinline__ f32x4 xcvt(const f32x4& r) { return r; }
__device__ __forceinline__ f32x4 xcvt(const u32x2& r) { return (f32x4){bflo(r.x), bfhi(r.x), bflo(r.y), bfhi(r.y)}; }
template <int MODE, bool COMBINE, bool S5OUT = false, bool SKIPCTX = false, bool FROMIN = false>
__device__ __forceinline__ void ph_norm(const Frame& F, int layer, int prev_layer) {
    static_assert(MODE != 1, "norm2 + router is ph_norm2");
    const float* nw = MODE == 0 ? F.in[6] + layer * D : F.in[32];
    const bf16* Y = (const bf16*)(F.ws + WS_Y);
    constexpr int NI = SKIPCTX ? NB * SEQ : R;
    constexpr int NPF = 4;
    const int per = (NI + F.nb * NWAVES - 1) / (F.nb * NWAVES);
    int it = (F.bid * NWAVES + F.wave) * per; const int itend = min(NI, it + per);
    typedef typename XRawT<FROMIN>::T XR;
    const __amdgpu_buffer_rsrc_t yrs = __builtin_amdgcn_make_buffer_rsrc((void*)Y, 0, (int)((size_t)NE * SLOTS * D * 2), 0x00020000);
    const int l16 = F.lane & 15;
#define NORM_ROWOF(i_) (SKIPCTX ? ((i_) >> 11) * P + NCTX + ((i_) & (SEQ - 1)) : (i_))
#define NORM_XPTR(r_) ((FROMIN ? (const XR*)(((r_) % P) < NCTX ? F.in[2] + ((size_t)((r_) / P) * NCTX + ((r_) % P)) * D : F.in[0] + ((size_t)((r_) / P) * SEQ + ((r_) % P) - NCTX) * D) : (const XR*)(F.X + (size_t)(r_) * D)) + F.lane)
#define NORM_STAGE(i_, INVA_, V_, G_, Yq_, INVB_) do { \
        const int ic_ = min((i_), itend - 1), ic1_ = min((i_) + 1, itend - 1); const int rA_ = NORM_ROWOF(ic_); \
        if (COMBINE) INVB_ = F.INV[(size_t)NORM_ROWOF(ic1_) * NE + l16]; \
        if (COMBINE) G_ = F.GATE[l16 * SLOTS + max(INVA_, 0)]; \
        { const XR* xp_ = NORM_XPTR(rA_); _Pragma("unroll") for (int j = 0; j < 4; ++j) V_[j] = xp_[64 * j]; } \
        if (COMBINE) { unsigned m_ = ((i_) < itend) ? (unsigned)(__ballot(F.lane < NE && INVA_ >= 0) & 0xffffull) : 0u; \
            _Pragma("unroll") for (int q = 0; q < NPF; ++q) { const bool pr_ = m_ != 0u; const int e_ = pr_ ? __builtin_ctz(m_) : 0; m_ &= m_ - 1u; const int s_ = __builtin_amdgcn_readlane(INVA_, e_); \
                const unsigned vo_ = pr_ ? (unsigned)(e_ * SLOTS + s_) * (unsigned)(D * 2) + (unsigned)F.lane * 8u : 0xfffff000u; \
                _Pragma("unroll") for (int j = 0; j < 4; ++j) Yq_[q][j] = __builtin_amdgcn_raw_buffer_load_b64(yrs, vo_ + 512u * j, 0, 0); } } \
    } while (0)
    XR v[4]; u32x2 yc[NPF][4]; float gl = 0.f; int invl = -1, invn = -1;
    if (COMBINE) invl = F.INV[(size_t)NORM_ROWOF(min(it, NI - 1)) * NE + l16];
    NORM_STAGE(it, invl, v, gl, yc, invn);
    const f32x4* nw4 = (const f32x4*)nw + F.lane;
    f32x4 g5[4], nwv[4], shv[4], scv[4]; int mrc = -1;
#pragma unroll
    for (int j = 0; j < 4; ++j) { nwv[j] = nw4[64 * j]; g5[j] = shv[j] = scv[j] = (f32x4){0.f, 0.f, 0.f, 0.f}; }
    while (it < itend) {
        const int row = NORM_ROWOF(it), b = row / P, pos = row - b * P, mr = pos < NCTX ? 32 : b;
        if (mr != mrc) { mrc = mr;
            const float* mrow = F.MOD + ((size_t)layer * 33 + mr) * 6144;
#pragma unroll
            for (int j = 0; j < 4; ++j) {
                if (COMBINE) g5[j] = ((const f32x4*)(F.MOD + ((size_t)prev_layer * 33 + mr) * 6144 + 5 * D) + F.lane)[64 * j];
                if (MODE != 2) { shv[j] = ((const f32x4*)(mrow + (MODE == 0 ? 0 : 3) * D) + F.lane)[64 * j]; scv[j] = ((const f32x4*)(mrow + (MODE == 0 ? 1 : 4) * D) + F.lane)[64 * j]; }
            }
        }
        XR vn[4]; u32x2 yn[NPF][4]; float gln = 0.f; int invnn = -1;
        NORM_STAGE(it + 1, invn, vn, gln, yn, invnn);
        f32x4 a[4];
#pragma unroll
        for (int j = 0; j < 4; ++j) a[j] = (f32x4){0.f, 0.f, 0.f, 0.f};
        if (COMBINE) {
            unsigned m = (unsigned)(__ballot(F.lane < NE && invl >= 0) & 0xffffull);
#pragma unroll
            for (int q = 0; q < NPF; ++q) {
                const bool pr = m != 0u; const int e = pr ? __builtin_ctz(m) : 0; m &= m - 1u;
                const float g = pr ? __uint_as_float(__builtin_amdgcn_readlane(__float_as_uint(gl), e)) : 0.f;
#pragma unroll
                for (int j = 0; j < 4; ++j) { a[j].x += g * bflo(yc[q][j].x); a[j].y += g * bfhi(yc[q][j].x); a[j].z += g * bflo(yc[q][j].y); a[j].w += g * bfhi(yc[q][j].y); }
            }
            while (m) {
                const int e = __builtin_ctz(m); m &= m - 1u;
                const int sl = __builtin_amdgcn_readlane(invl, e); const float g = __uint_as_float(__builtin_amdgcn_readlane(__float_as_uint(gl), e));
                const u32x2* y0 = (const u32x2*)(Y + ((size_t)e * SLOTS + sl) * D) + F.lane;
                u32x2 w0[4];
#pragma unroll
                for (int j = 0; j < 4; ++j) w0[j] = y0[64 * j];
#pragma unroll
                for (int j = 0; j < 4; ++j) { a[j].x += g * bflo(w0[j].x); a[j].y += g * bfhi(w0[j].x); a[j].z += g * bflo(w0[j].y); a[j].w += g * bfhi(w0[j].y); }
            }
        }
        f32x4 vv[4];
#pragma unroll
        for (int j = 0; j < 4; ++j) vv[j] = xcvt(v[j]);
        if (COMBINE) {
#pragma unroll
            for (int j = 0; j < 4; ++j) vv[j] = vv[j] + g5[j] * a[j];
        }
        if ((FROMIN || COMBINE) && MODE != 2) { u32x2* xw = (u32x2*)(F.X + (size_t)row * D) + F.lane;
#pragma unroll
            for (int j = 0; j < 4; ++j) { u32x2 w; w.x = pkbf(vv[j].x, vv[j].y); w.y = pkbf(vv[j].z, vv[j].w); xw[64 * j] = w; } }
        float ss = 0.f;
#pragma unroll
        for (int j = 0; j < 4; ++j) ss += (vv[j].x * vv[j].x + vv[j].y * vv[j].y) + (vv[j].z * vv[j].z + vv[j].w * vv[j].w);
        const float rinv = rsqrtf(wave_sum(ss) * (1.0f / D) + EPS);
        if (MODE == 2) {
            if (pos >= NCTX) {
                f32x4* o = (f32x4*)(F.out + ((size_t)b * SEQ + pos - NCTX) * D) + F.lane;
#pragma unroll
                for (int j = 0; j < 4; ++j) o[64 * j] = vv[j] * rinv * nwv[j];
            }
        } else {
            u32x2* ho = (u32x2*)(F.H + (size_t)row * D) + F.lane;
            f32x4 h[4];
#pragma unroll
            for (int j = 0; j < 4; ++j) { h[j] = vv[j] * rinv * nwv[j] * (scv[j] + 1.0f) + shv[j]; u32x2 w; w.x = pkbf(h[j].x, h[j].y); w.y = pkbf(h[j].z, h[j].w); ho[64 * j] = w;
                if (S5OUT) { const int g = (F.lane >> 2) + 16 * j;
                    *(u32x2*)((bf16*)(F.ws + WS_AG) + ((size_t)g * 2304 + b * 72 + (pos >> 5)) * 768 + (pos & 31) * 16 + (F.lane & 3) * 4) = w; } }
        }
#pragma unroll
        for (int j = 0; j < 4; ++j) { v[j] = vn[j];
#pragma unroll
            for (int q = 0; q < NPF; ++q) yc[q][j] = yn[q][j]; }
        gl = gln; invl = invn; invn = invnn; ++it;
    }
#undef NORM_STAGE
#undef NORM_XPTR
#undef NORM_ROWOF
}

template <bool SKIPCTX>
__device__ __forceinline__ void ph_norm2(const Frame& F, int layer) {
    const float* nw = F.in[7] + layer * D;
    LAS float* wrt = (LAS float*)((LAS unsigned char*)F.lds);
    {
        const float* wr = F.in[28] + (size_t)layer * D * NE;
        for (int i = F.tid; i < D * NE; i += NTHREADS) wrt[(i & 15) * (D + 4) + (i >> 4)] = wr[i];
        __syncthreads();
    }
    const f32x4* nw4 = (const f32x4*)nw + F.lane;
    const int eid = ((F.lane & 1) << 3) | ((F.lane & 2) << 1) | ((F.lane & 4) >> 1) | ((F.lane & 8) >> 3);
    constexpr int NI = SKIPCTX ? NB * SEQ / 2 : R / 2;
    const int per = (NI + F.nb * NWAVES - 1) / (F.nb * NWAVES), it0 = (F.bid * NWAVES + F.wave) * per, it1 = min(NI, it0 + per);
    f32x4 gv[4], shv[4]; int mrc = -1;
#pragma unroll
    for (int j = 0; j < 4; ++j) gv[j] = shv[j] = (f32x4){0.f, 0.f, 0.f, 0.f};
#define N2_ROWOF(i_) (SKIPCTX ? ((i_) >> 10) * P + NCTX + 2 * ((i_) & (SEQ / 2 - 1)) : 2 * (i_))
    u32x2 w0[4], w1[4];
    { const u32x2* x0 = (const u32x2*)(F.X + (size_t)N2_ROWOF(min(it0, NI - 1)) * D) + F.lane;
#pragma unroll
      for (int j = 0; j < 4; ++j) { w0[j] = x0[64 * j]; w1[j] = x0[256 + 64 * j]; } }
    for (int it = it0; it < it1; ++it) {
        const int row = N2_ROWOF(it), b = row / P, pos = row - b * P, mr = pos < NCTX ? 32 : b;
        f32x4 v0[4], v1[4];
#pragma unroll
        for (int j = 0; j < 4; ++j) { v0[j] = xcvt(w0[j]); v1[j] = xcvt(w1[j]); }
        if (mr != mrc) { mrc = mr;
            const float* mrow = F.MOD + ((size_t)layer * 33 + mr) * 6144;
#pragma unroll
            for (int j = 0; j < 4; ++j) { shv[j] = ((const f32x4*)(mrow + 3 * D) + F.lane)[64 * j]; gv[j] = nw4[64 * j] * (((const f32x4*)(mrow + 4 * D) + F.lane)[64 * j] + 1.0f); }
        }
        u32x2 n0[4], n1[4];
        { const u32x2* xn = (const u32x2*)(F.X + (size_t)N2_ROWOF(min(it + 1, it1 - 1)) * D) + F.lane;
#pragma unroll
          for (int j = 0; j < 4; ++j) { n0[j] = xn[64 * j]; n1[j] = xn[256 + 64 * j]; } }
        float s0 = 0.f, s1 = 0.f;
#pragma unroll
        for (int j = 0; j < 4; ++j) { s0 += (v0[j].x * v0[j].x + v0[j].y * v0[j].y) + (v0[j].z * v0[j].z + v0[j].w * v0[j].w); s1 += (v1[j].x * v1[j].x + v1[j].y * v1[j].y) + (v1[j].z * v1[j].z + v1[j].w * v1[j].w); }
        const float r0 = rsqrtf(wave_sum(s0) * (1.0f / D) + EPS), r1 = rsqrtf(wave_sum(s1) * (1.0f / D) + EPS);
        u32x2* h0 = (u32x2*)(F.H + (size_t)row * D) + F.lane; u32x2* h1 = h0 + 256;
#pragma unroll
        for (int j = 0; j < 4; ++j) { const f32x4 g = gv[j];
            v0[j] = v0[j] * r0 * g + shv[j]; v1[j] = v1[j] * r1 * g + shv[j];
            u32x2 w; w.x = pkbf(v0[j].x, v0[j].y); w.y = pkbf(v0[j].z, v0[j].w); h0[64 * j] = w;
            w.x = pkbf(v1[j].x, v1[j].y); w.y = pkbf(v1[j].z, v1[j].w); h1[64 * j] = w; }
        f32x2 a0[NE], a1[NE];
#pragma unroll
        for (int e = 0; e < NE; ++e) { a0[e] = (f32x2){0.f, 0.f}; a1[e] = (f32x2){0.f, 0.f}; }
#pragma unroll
        for (int j = 0; j < 4; ++j) { asm volatile("" ::: "memory");
            const f32x2 p0 = {v0[j].x, v0[j].y}, q0 = {v0[j].z, v0[j].w}, p1 = {v1[j].x, v1[j].y}, q1 = {v1[j].z, v1[j].w};
#pragma unroll
            for (int e = 0; e < NE; ++e) { const f32x4 w = *(const LAS f32x4*)(wrt + e * (D + 4) + F.lane * 4 + 256 * j); const f32x2 wl = {w.x, w.y}, wh = {w.z, w.w};
                a0[e] += p0 * wl; a0[e] += q0 * wh; a1[e] += p1 * wl; a1[e] += q1 * wh; } }
        float lg0[NE], lg1[NE];
#pragma unroll
        for (int e = 0; e < NE; ++e) { lg0[e] = a0[e].x + a0[e].y; lg1[e] = a1[e].x + a1[e].y; }
        const float t0 = reduce16(lg0, F.lane), t1 = reduce16(lg1, F.lane);
        float m0 = fmaxf(t0, dpp_xor1(t0)), m1 = fmaxf(t1, dpp_xor1(t1));
        m0 = fmaxf(m0, dpp_xor2(m0)); m1 = fmaxf(m1, dpp_xor2(m1)); m0 = fmaxf(m0, __shfl_xor(m0, 4)); m1 = fmaxf(m1, __shfl_xor(m1, 4)); m0 = fmaxf(m0, __shfl_xor(m0, 8)); m1 = fmaxf(m1, __shfl_xor(m1, 8));
        const float e0 = __builtin_amdgcn_exp2f((t0 - m0) * LOG2E_), e1 = __builtin_amdgcn_exp2f((t1 - m1) * LOG2E_);
        float z0 = e0 + dpp_xor1(e0), z1 = e1 + dpp_xor1(e1);
        z0 += dpp_xor2(z0); z1 += dpp_xor2(z1); z0 += __shfl_xor(z0, 4); z1 += __shfl_xor(z1, 4); z0 += __shfl_xor(z0, 8); z1 += __shfl_xor(z1, 8);
        if (F.lane < NE) { float* ap = F.AFF + ((size_t)b * NE + eid) * P + pos; ap[0] = e0 / z0; ap[1] = e1 / z1; }
#pragma unroll
        for (int j = 0; j < 4; ++j) { w0[j] = n0[j]; w1[j] = n1[j]; }
    }
#undef N2_ROWOF
}

__device__ __forceinline__ void ph_topk(const Frame& F, int nitems) {
    const int tid = F.tid, lane = F.lane, half = F.wave >> 2, hw = F.wave & 3, ht = tid & 255;
    unsigned* hist = (unsigned*)F.lds + half * 288;
    unsigned* wtot = hist + 256;
    unsigned* bc = wtot + 8;
    for (int item0 = F.bid; item0 < nitems; item0 += 2 * F.nb) {
        const int item = item0 + half * F.nb; const bool valid = item < nitems;
        const int seg = item >> 9, b = (item >> 4) & 31, e = item & 15;
        const int n = seg ? NCTX : SEQ, pos0 = seg ? 0 : NCTX, cap = n / 8, slot0 = seg ? NB * 256 + b * 32 : b * 256;
        const int per = seg ? 1 : 8;
        const float* a = F.AFF + ((size_t)b * NE + e) * P + pos0;
        unsigned u[8];
#pragma unroll
        for (int q = 0; q < 8; ++q) u[q] = 0u;
        if (valid) {
            if (seg) u[0] = __float_as_uint(a[ht]);
            else { const f32x4 a0 = *(const f32x4*)(a + ht * 8), a1 = *(const f32x4*)(a + ht * 8 + 4);
                u[0] = __float_as_uint(a0.x); u[1] = __float_as_uint(a0.y); u[2] = __float_as_uint(a0.z); u[3] = __float_as_uint(a0.w);
                u[4] = __float_as_uint(a1.x); u[5] = __float_as_uint(a1.y); u[6] = __float_as_uint(a1.z); u[7] = __float_as_uint(a1.w); }
        }
        unsigned prefix = 0u, mask = 0u, kk = (unsigned)cap;
#pragma unroll 1
        for (int pass = 0; pass < 4; ++pass) {
            const int shift = 24 - 8 * pass;
            __syncthreads();
            hist[ht] = 0u;
            __syncthreads();
            if (valid) {
#pragma unroll
                for (int q = 0; q < 8; ++q) if (q < per && (u[q] & mask) == prefix) atomicAdd(&hist[(u[q] >> shift) & 255u], 1u);
            }
            __syncthreads();
            unsigned hv = hist[255 - ht], cum = hv;
#pragma unroll
            for (int o = 1; o < 64; o <<= 1) { const unsigned t = __shfl_up(cum, o); if (lane >= o) cum += t; }
            if (lane == 63) wtot[hw] = cum;
            __syncthreads();
            {
                unsigned off = 0u;
#pragma unroll
                for (int w = 0; w < 4; ++w) if (w < hw) off += wtot[w];
                cum += off;
                if (cum >= kk && cum - hv < kk) { bc[0] = 255u - (unsigned)ht; bc[1] = kk - (cum - hv); }
            }
            __syncthreads();
            prefix |= bc[0] << shift; mask |= 255u << shift; kk = bc[1];
        }
        unsigned cg = 0u, ce = 0u;
        if (valid) {
#pragma unroll
            for (int q = 0; q < 8; ++q) if (q < per) { cg += u[q] > prefix ? 1u : 0u; ce += u[q] == prefix ? 1u : 0u; }
        }
        unsigned pk = cg | (ce << 16), inc = pk;
#pragma unroll
        for (int o = 1; o < 64; o <<= 1) { const unsigned t = __shfl_up(inc, o); if (lane >= o) inc += t; }
        __syncthreads();
        if (lane == 63) wtot[hw] = inc;
        __syncthreads();
        unsigned off = 0u;
#pragma unroll
        for (int w = 0; w < 4; ++w) if (w < hw) off += wtot[w];
        unsigned excl = inc - pk + off, gb = excl & 0xffffu, eb = excl >> 16;
        if (valid) {
#pragma unroll
            for (int q = 0; q < 8; ++q) if (q < per) {
                const int i = ht * per + q, row = b * P + pos0 + i;
                const bool gt = u[q] > prefix, eq = u[q] == prefix, sel = gt || (eq && eb < kk);
                if (sel) { const int slot = slot0 + (int)(gb + (eb < kk ? eb : kk)); F.SEL[e * SLOTS + slot] = row; F.GATE[e * SLOTS + slot] = __uint_as_float(u[q]); F.INV[(size_t)row * NE + e] = slot; }
                else F.INV[(size_t)row * NE + e] = -1;
                gb += gt ? 1u : 0u; eb += eq ? 1u : 0u;
            }
        }
        __syncthreads();
    }
    __syncthreads();
}

typedef short bf16x8 __attribute__((ext_vector_type(8)));
typedef float f32x16 __attribute__((ext_vector_type(16)));
#define MFMA32(a, b, c) __builtin_amdgcn_mfma_f32_32x32x16_bf16((a), (b), (c), 0, 0, 0)
__device__ __forceinline__ int kperm(int m) { return (m & 0x13) | ((m & 8) >> 1) | ((m & 4) << 1); }
__device__ __forceinline__ bf16x8 pack8(const f32x16& x, int s8) {
    u32x4 p; p.x = pkbf(x[s8 + 0], x[s8 + 1]); p.y = pkbf(x[s8 + 2], x[s8 + 3]); p.z = pkbf(x[s8 + 4], x[s8 + 5]); p.w = pkbf(x[s8 + 6], x[s8 + 7]);
    return __builtin_bit_cast(bf16x8, p);
}
constexpr float LOG2E = 1.4426950408889634f;

__device__ __forceinline__ void ph_da_attn(const Frame& F) {
    const bf16* Q = (const bf16*)(F.ws + WS_Q); const bf16* K = (const bf16*)(F.ws + WS_K); const bf16* VT = (const bf16*)(F.ws + WS_VT); bf16* O = (bf16*)(F.ws + WS_O);
    const int tid = F.tid, lane = F.lane, l32 = lane & 31, hh = lane >> 5, map = F.wave & 1, qsub = F.wave >> 1;
    const float* lam = F.in[22];
    const float lam_full = expf(wave_sum(lam[lane] * lam[64 + lane])) - expf(wave_sum(lam[128 + lane] * lam[192 + lane])) + LAM_INIT;
    constexpr int KB = 64 * 144, VB = 128 * 144, BUF = 2 * KB + VB;
    unsigned char* sb = F.lds;
    float* xch = (float*)(F.lds + 2 * BUF) + qsub * 4096;
    const float c = 0.125f * LOG2E;
    const int kr = (tid >> 3) & 63, kc = tid & 7, vd = tid >> 3, vc = tid & 7;
    const int kdst = kr * 144 + kc * 16, vdst = 2 * KB + vd * 144 + vc * 16;
    const int kfrag = map * KB + kperm(l32) * 144 + hh * 16, vfrag = 2 * KB + l32 * 144 + hh * 16;
    const int vb = (F.nb & 7) == 0 ? (F.bid & 7) * (F.nb >> 3) + (F.bid >> 3) : F.bid;
    for (int it = vb; it < 4096 + 512; it += F.nb) {
        int b, h, pos0, nst;
        if (it < 4096) { b = it >> 7; h = (it >> 4) & 7; pos0 = NCTX + (it & 15) * 128 + qsub * 32; nst = P / 64; }
        else { const int j = it - 4096; b = j >> 4; h = (j >> 1) & 7; pos0 = (j & 1) * 128 + qsub * 32; nst = NCTX / 64; }
        const size_t qrow = (size_t)b * P + pos0 + l32;
        bf16x8 qf[4];
#pragma unroll
        for (int ks = 0; ks < 4; ++ks) qf[ks] = *(const bf16x8*)(Q + qrow * D + h * 128 + map * 64 + ks * 16 + hh * 8);
        f32x16 o[4];
#pragma unroll
        for (int dt = 0; dt < 4; ++dt)
#pragma unroll
            for (int j = 0; j < 16; ++j) o[dt][j] = 0.f;
        float m = 0.f, l = 0.f;
        const bf16* kg = K + ((size_t)b * P + kr) * D + h * 128 + kc * 8;
        const bf16* vg = VT + ((size_t)b * D + h * 128 + vd) * P + vc * 8;
        u32x4 ka0, ka1, va0, va1;
        { const u32x4 k0 = *(const u32x4*)kg, k1 = *(const u32x4*)(kg + 64), v0 = *(const u32x4*)vg, v1 = *(const u32x4*)(vg + (size_t)64 * P);
          const bf16* kq = kg + (size_t)64 * D; const bf16* vq = vg + 64;
          ka0 = *(const u32x4*)kq; ka1 = *(const u32x4*)(kq + 64); va0 = *(const u32x4*)vq; va1 = *(const u32x4*)(vq + (size_t)64 * P);
          *(u32x4*)(sb + kdst) = k0; *(u32x4*)(sb + KB + kdst) = k1; *(u32x4*)(sb + vdst) = v0; *(u32x4*)(sb + vdst + 64 * 144) = v1; }
        __syncthreads();
#pragma unroll 1
        for (int st = 0; st < nst; ++st) {
            const unsigned char* cb = sb + (st & 1) * BUF;
            u32x4 kn0 = (u32x4){0u, 0u, 0u, 0u}, kn1 = kn0, vn0 = kn0, vn1 = kn0;
            if (st + 2 < nst) { const bf16* kq = kg + (size_t)(st + 2) * 64 * D; const bf16* vq = vg + (st + 2) * 64;
                kn0 = *(const u32x4*)kq; kn1 = *(const u32x4*)(kq + 64); vn0 = *(const u32x4*)vq; vn1 = *(const u32x4*)(vq + (size_t)64 * P); }
#pragma unroll
            for (int sub = 0; sub < 2; ++sub) {
                f32x16 s;
#pragma unroll
                for (int j = 0; j < 16; ++j) s[j] = -m;
#pragma unroll
                for (int ks = 0; ks < 4; ++ks) s = MFMA32(*(const bf16x8*)(cb + kfrag + sub * 32 * 144 + ks * 32), qf[ks], s);
                float mx = s[0];
#pragma unroll
                for (int j = 1; j < 16; ++j) mx = fmaxf(mx, s[j]);
                mx = fmaxf(mx, __shfl_xor(mx, 32));
                const bool first = st == 0 && sub == 0;
                if (first || __any(mx > 8.0f)) {
                    const float d = first ? mx : fmaxf(mx, 0.f);
                    if (!first) { const float alpha = __builtin_amdgcn_exp2f(-d); l *= alpha;
#pragma unroll
                        for (int dt = 0; dt < 4; ++dt)
#pragma unroll
                            for (int j = 0; j < 16; ++j) o[dt][j] *= alpha; }
                    m += d;
#pragma unroll
                    for (int j = 0; j < 16; ++j) s[j] -= d;
                }
                float ps = 0.f;
#pragma unroll
                for (int j = 0; j < 16; ++j) { s[j] = __builtin_amdgcn_exp2f(s[j]); ps += s[j]; }
                l += ps;
                const bf16x8 p0 = pack8(s, 0), p1 = pack8(s, 8);
#pragma unroll
                for (int dt = 0; dt < 4; ++dt) { o[dt] = MFMA32(*(const bf16x8*)(cb + vfrag + dt * 32 * 144 + sub * 64), p0, o[dt]); o[dt] = MFMA32(*(const bf16x8*)(cb + vfrag + dt * 32 * 144 + sub * 64 + 32), p1, o[dt]); }
            }
            if (st + 1 < nst) { unsigned char* nb = sb + ((st + 1) & 1) * BUF; *(u32x4*)(nb + kdst) = ka0; *(u32x4*)(nb + KB + kdst) = ka1; *(u32x4*)(nb + vdst) = va0; *(u32x4*)(nb + vdst + 64 * 144) = va1; }
            ka0 = kn0; ka1 = kn1; va0 = vn0; va1 = vn1;
            __syncthreads();
        }
        l += __shfl_xor(l, 32);
        const float inv = 1.0f / l;
        if (map == 1) {
#pragma unroll
            for (int dt = 0; dt < 4; ++dt)
#pragma unroll
                for (int j = 0; j < 16; ++j) xch[(dt * 16 + j) * 64 + lane] = o[dt][j] * inv * lam_full;
        }
        __syncthreads();
        if (map == 0) {
            float ss = 0.f;
#pragma unroll
            for (int dt = 0; dt < 4; ++dt)
#pragma unroll
                for (int j = 0; j < 16; ++j) { const float v = o[dt][j] * inv - xch[(dt * 16 + j) * 64 + lane]; o[dt][j] = v; ss += v * v; }
            ss += __shfl_xor(ss, 32);
            const float rinv = rsqrtf(ss * (1.0f / 128.0f) + EPS) * (1.0f - LAM_INIT);
#pragma unroll
            for (int dt = 0; dt < 4; ++dt)
#pragma unroll
                for (int jq = 0; jq < 4; ++jq) {
                    const int d0 = dt * 32 + jq * 8 + hh * 4; const f32x4 sw = *(const f32x4*)(F.in[23] + d0);
                    u32x2 w; w.x = pkbf(o[dt][jq * 4 + 0] * rinv * sw.x, o[dt][jq * 4 + 1] * rinv * sw.y); w.y = pkbf(o[dt][jq * 4 + 2] * rinv * sw.z, o[dt][jq * 4 + 3] * rinv * sw.w);
                    *(u32x2*)(O + qrow * D + h * 128 + d0) = w;
                }
        }
        __syncthreads();
    }
}

__device__ __forceinline__ void ph_na_attn(const Frame& F) {
    const bf16* Q = (const bf16*)(F.ws + WS_Q); const bf16* K = (const bf16*)(F.ws + WS_K); const bf16* VT = (const bf16*)(F.ws + WS_VT); bf16* O = (bf16*)(F.ws + WS_O);
    const int tid = F.tid, lane = F.lane, l32 = lane & 31, hh = lane >> 5;
    constexpr int KB = 128 * 144, VP = 272, VB = 64 * VP, BUF = KB + VB;
    unsigned char* sb = F.lds;
    float* rp = (float*)(F.lds + 2 * BUF) + 64;
    for (int i = tid; i < 16 * 15 * 31 + 128; i += NTHREADS) { const int k = i - 64; rp[k] = (k >= 0 && k < 16 * 15 * 31) ? F.in[19][k] * LOG2E : 0.f; }
    __syncthreads();
    const float c = 0.125f * LOG2E;
    const int pr = tid >> 3, pc = tid & 7;
    const int kdst = pr * 144 + pc * 16, vdst = KB + pr * VP + pc * 16;
    const int kfrag = kperm(l32) * 144 + hh * 16, vfrag = KB + l32 * VP + hh * 16;
    const int vb = (F.nb & 7) == 0 ? (F.bid & 7) * (F.nb >> 3) + (F.bid >> 3) : F.bid;
    for (int it = vb; it < 4096 + 512; it += F.nb) {
        int b, h, r = 0, cq = 0, kc0 = 0, rlo = 0, rhi = 0, wr0 = 0, wr1 = 0, nt; bool lat; size_t qrow;
        if (it < 4096) { lat = true; b = it >> 7; h = (it >> 3) & 15; const int rg = ((it & 7) + (it >> 8)) & 7  ;
            const int rw = rg * 4 + (F.wave >> 2) * 2, cqt = F.wave & 3; r = rw + (l32 >> 4); cq = cqt * 16 + (l32 & 15); kc0 = min(max(cqt * 16 - 8, 0), 32);
            wr0 = min(max(rw - 4, 0), 24); wr1 = min(max(rw + 1 - 4, 0), 24) + 8;
            qrow = (size_t)b * P + NCTX + r * 64 + cq;
            rlo = min(max(rg * 4 - 4, 0), 24); rhi = min(max(rg * 4 + 3 - 4, 0), 24) + 7; nt = 2 + (rhi - rlo + 2) / 2; }
        else { lat = false; const int j = it - 4096; b = j >> 4; h = j & 15; qrow = (size_t)b * P + F.wave * 32 + l32; nt = 2; }
        const int r0 = min(max(r - 4, 0), 24), c0 = min(max(cq - 8, 0), 48);
        bf16x8 qf[4];
#pragma unroll
        for (int ks = 0; ks < 4; ++ks) qf[ks] = *(const bf16x8*)(Q + qrow * D + h * 64 + ks * 16 + hh * 8);
        float neg[16];
#pragma unroll
        for (int j = 0; j < 16; ++j) { const int kcol = kc0 + 16 * (j >> 3) + 8 * hh + 4 * ((j >> 2) & 1) + (j & 3); neg[j] = (kcol >= c0 && kcol < c0 + 16) ? 0.f : -1.0e30f; }
        f32x16 o[2];
#pragma unroll
        for (int dt = 0; dt < 2; ++dt)
#pragma unroll
            for (int j = 0; j < 16; ++j) o[dt][j] = 0.f;
        float m = -1.0e30f, l = 0.f;
        const bf16* kg = K + ((size_t)b * P + pr) * D + h * 64 + pc * 8;
        const bf16* vg = VT + ((size_t)b * D + h * 64 + pr) * P + pc * 8;
#define NA_KEYA(st) ((st) < 2 ? (st) * 128 : NCTX + (rlo + 2 * ((st) - 2)) * 64)
#define NA_KEYB(st) ((st) < 2 ? (st) * 128 + 64 : NCTX + min(rlo + 2 * ((st) - 2) + 1, 31) * 64)
#define NA_LOAD(dk0, dk1, dv0, dv1, st) do { const int ka_ = NA_KEYA(st), kb_ = NA_KEYB(st); dk0 = *(const u32x4*)(kg + (size_t)ka_ * D); dk1 = *(const u32x4*)(kg + (size_t)kb_ * D); \
        dv0 = *(const u32x4*)(vg + ka_); dv1 = *(const u32x4*)(vg + kb_); } while (0)
#define NA_STORE(buf, sk0, sk1, sv0, sv1) do { *(u32x4*)((buf) + kdst) = sk0; *(u32x4*)((buf) + kdst + 64 * 144) = sk1; *(u32x4*)((buf) + vdst) = sv0; *(u32x4*)((buf) + vdst + 128) = sv1; } while (0)
        u32x4 ka0, ka1, va0, va1;
        { u32x4 x0, x1, y0, y1; NA_LOAD(x0, x1, y0, y1, 0); NA_LOAD(ka0, ka1, va0, va1, 1); NA_STORE(sb, x0, x1, y0, y1); }
        __syncthreads();
#pragma unroll 1
        for (int st = 0; st < nt; ++st) {
            const unsigned char* cbuf = sb + (st & 1) * BUF;
            u32x4 kn0 = (u32x4){0u, 0u, 0u, 0u}, kn1 = kn0, vn0 = kn0, vn1 = kn0;
            if (st + 2 < nt) NA_LOAD(kn0, kn1, vn0, vn1, st + 2);
#define NA_TILE(KO_, WIN_, KROW_) do { const int ko = (KO_); \
                f32x16 s; \
                _Pragma("unroll") for (int j = 0; j < 16; ++j) s[j] = 0.f; \
                _Pragma("unroll") for (int ks = 0; ks < 4; ++ks) s = MFMA32(*(const bf16x8*)(cbuf + kfrag + ko * 144 + ks * 32), qf[ks], s); \
                if (WIN_) { const int krow = (KROW_); \
                    const float rmask = (krow >= r0 && krow < r0 + 8) ? 0.f : -1.0e30f;        \
                    const float* rph = rp + (h * 15 + (krow - r + 7)) * 31 - cq + 15 + 8 * hh + kc0;       \
                    _Pragma("unroll") for (int j = 0; j < 16; ++j) s[j] = (s[j] * c + rph[16 * (j >> 3) + 4 * ((j >> 2) & 1) + (j & 3)]) + (neg[j] + rmask); \
                } else { _Pragma("unroll") for (int j = 0; j < 16; ++j) s[j] *= c; } \
                float mx = s[0]; \
                _Pragma("unroll") for (int j = 1; j < 16; ++j) mx = fmaxf(mx, s[j]); \
                mx = fmaxf(mx, __shfl_xor(mx, 32)); \
                if (__any(mx > m + 8.0f)) { \
                    const float mn = fmaxf(m, mx), alpha = __builtin_amdgcn_exp2f(m - mn); m = mn; l *= alpha; \
                    _Pragma("unroll") for (int dt = 0; dt < 2; ++dt) _Pragma("unroll") for (int j = 0; j < 16; ++j) o[dt][j] *= alpha; \
                } \
                f32x2 ps2 = {0.f, 0.f}; \
                _Pragma("unroll") for (int j = 0; j < 16; j += 2) { f32x2 t = {s[j], s[j + 1]}; t = t - (f32x2){m, m}; t.x = __builtin_amdgcn_exp2f(t.x); t.y = __builtin_amdgcn_exp2f(t.y); s[j] = t.x; s[j + 1] = t.y; ps2 += t; } \
                l += ps2.x + ps2.y; \
                const bf16x8 p0 = pack8(s, 0), p1 = pack8(s, 8); \
                _Pragma("unroll") for (int dt = 0; dt < 2; ++dt) { o[dt] = MFMA32(*(const bf16x8*)(cbuf + vfrag + dt * 32 * VP + ko * 2), p0, o[dt]); o[dt] = MFMA32(*(const bf16x8*)(cbuf + vfrag + dt * 32 * VP + ko * 2 + 32), p1, o[dt]); } \
            } while (0)
            if (st < 2) {
#pragma unroll
                for (int sub = 0; sub < 4; ++sub) NA_TILE(sub * 32, false, 0);
            } else {
#pragma unroll
                for (int half = 0; half < 2; ++half) { const int krw = rlo + 2 * (st - 2) + half;
                    if (krw <= rhi && krw >= wr0 && krw < wr1) NA_TILE(half * 64 + kc0, true, krw); }
            }
#undef NA_TILE
            if (st + 1 < nt) { unsigned char* nb = sb + ((st + 1) & 1) * BUF; NA_STORE(nb, ka0, ka1, va0, va1); }
            ka0 = kn0; ka1 = kn1; va0 = vn0; va1 = vn1;
            __syncthreads();
        }
#undef NA_KEYA
#undef NA_KEYB
#undef NA_LOAD
#undef NA_STORE
        l += __shfl_xor(l, 32);
        const float inv = 1.0f / l;
#pragma unroll
        for (int dt = 0; dt < 2; ++dt)
#pragma unroll
            for (int jq = 0; jq < 4; ++jq) {
                const int d0 = dt * 32 + jq * 8 + hh * 4;
                u32x2 w; w.x = pkbf(o[dt][jq * 4 + 0] * inv, o[dt][jq * 4 + 1] * inv); w.y = pkbf(o[dt][jq * 4 + 2] * inv, o[dt][jq * 4 + 3] * inv);
                *(u32x2*)(O + qrow * D + h * 64 + d0) = w;
            }
    }
    __syncthreads();
}

__device__ __forceinline__ f32x4 unpk4(u32x2 w) { return (f32x4){bflo(w.x), bfhi(w.x), bflo(w.y), bfhi(w.y)}; }
__device__ __forceinline__ bf16 bf1(float x) { return (bf16)(pkbf(x, 0.f) & 0xffffu); }
__device__ __forceinline__ f32x4 shx32(f32x4 v) { return (f32x4){__shfl_xor(v.x, 32), __shfl_xor(v.y, 32), __shfl_xor(v.z, 32), __shfl_xor(v.w, 32)}; }
template <int DIR>
__device__ __forceinline__ void hgrn_seq(const Frame& F, int b, int h, int eb) {
    const bf16* ZIN = (const bf16*)(F.ws + WS_ZIN); const bf16* VTG = (const bf16*)(F.ws + WS_VTG); bf16* OUT = (bf16*)(F.ws + (DIR ? WS_OFB : WS_OFF));
    const int lane = F.lane, l32 = lane & 31, hh = lane >> 5, cperm = kperm(l32);
    constexpr int IMG = 32 * 136 * 2, KTB = 128 * 80, DBUF = 2 * IMG + KTB + 512;
    unsigned char* dbase = F.lds + DIR * 2 * DBUF;
    const int tg = lane & 7, prho = 8 * eb + (lane >> 3), pc = kperm(prho);
    f32x16 S[4];
#pragma unroll
    for (int d = 0; d < 4; ++d)
#pragma unroll
        for (int j = 0; j < 16; ++j) S[d][j] = 0.f;
    const bf16* vbase = VTG + ((size_t)b * D + h * 128 + eb * 32 + l32) * P + hh * 8;
    const bf16* zp = ZIN + ((size_t)b * P + 4 * tg) * 4096 + h * 128 + 4 * prho;
#define HG_CHUNK(i_) (DIR == 0 ? (i_) : ((i_) < 8 ? 7 - (i_) : 79 - (i_)))
#define HG_LOAD(i_) do { const int c_ = HG_CHUNK(i_); const bf16* z_ = zp + (size_t)c_ * 32 * 4096; \
        _Pragma("unroll") for (int i = 0; i < 4; ++i) { nlf[i] = *(const u32x2*)(z_ + (size_t)i * 4096 + (1 + DIR) * D); nq[i] = *(const u32x2*)(z_ + (size_t)i * 4096); } \
        nv0 = *(const bf16x8*)(vbase + c_ * 32); nv1 = *(const bf16x8*)(vbase + c_ * 32 + 16); } while (0)
    u32x2 nlf[4], nq[4]; bf16x8 nv0, nv1;
    HG_LOAD(0);
#pragma unroll 1
    for (int idx = 0; idx < 72; ++idx) {
        const int cc = HG_CHUNK(idx);
        const size_t row0 = (size_t)b * P + cc * 32;
        unsigned char* buf = dbase + (idx & 1) * DBUF;
        bf16* Qp = (bf16*)buf; bf16* Kp = (bf16*)(buf + IMG); bf16* KT = (bf16*)(buf + 2 * IMG); float* egl = (float*)(buf + 2 * IMG + KTB);
        u32x2 lfc[4], qc[4];
#pragma unroll
        for (int i = 0; i < 4; ++i) { lfc[i] = nlf[i]; qc[i] = nq[i]; }
        const bf16x8 vf0 = nv0, vf1 = nv1;
        HG_LOAD(min(idx + 1, 71));
        f32x4 l4[4], t = (f32x4){0.f, 0.f, 0.f, 0.f};
#pragma unroll
        for (int i = 0; i < 4; ++i) { l4[i] = unpk4(lfc[i]); t += l4[i]; }
        f32x4 x = t;
#pragma unroll
        for (int k = 1; k < 8; k <<= 1) { const f32x4 y = (f32x4){__shfl_up(x.x, k, 8), __shfl_up(x.y, k, 8), __shfl_up(x.z, k, 8), __shfl_up(x.w, k, 8)}; if (tg >= k) x += y; }
        const f32x4 tot = (f32x4){__shfl(x.x, 7, 8), __shfl(x.y, 7, 8), __shfl(x.z, 7, 8), __shfl(x.w, 7, 8)};
        const f32x4 off = DIR == 0 ? x - t : tot - x;
        f32x4 eg = (f32x4){__builtin_amdgcn_exp2f(off.x), __builtin_amdgcn_exp2f(off.y), __builtin_amdgcn_exp2f(off.z), __builtin_amdgcn_exp2f(off.w)}; float kv[4][4];
#pragma unroll
        for (int ii = 0; ii < 4; ++ii) {
            const int i = DIR ? 3 - ii : ii;
            const f32x4 lf = l4[i], q4 = unpk4(qc[i]);
            const int srow = (4 * tg + i) * 136 + pc;
#pragma unroll
            for (int d = 0; d < 4; ++d) { const float f = __builtin_amdgcn_exp2f(lf[d]); eg[d] *= f; const float kq = (1.0f - f) * __builtin_amdgcn_rcpf(eg[d]);
                Qp[srow + d * 32] = bf1(q4[d] * eg[d]); Kp[srow + d * 32] = bf1(kq); kv[d][i] = kq; }
        }
#pragma unroll
        for (int d = 0; d < 4; ++d) { u32x2 w; w.x = pkbf(kv[d][0], kv[d][1]); w.y = pkbf(kv[d][2], kv[d][3]); *(u32x2*)(KT + (d * 32 + prho) * 40 + 4 * tg) = w; }
        if (tg == 0) *(f32x4*)(egl + 4 * prho) = (f32x4){__builtin_amdgcn_exp2f(tot.x), __builtin_amdgcn_exp2f(tot.y), __builtin_amdgcn_exp2f(tot.z), __builtin_amdgcn_exp2f(tot.w)};
        __syncthreads();
        bf16x8 kf[4][2];
#pragma unroll
        for (int d = 0; d < 4; ++d)
#pragma unroll
            for (int sg = 0; sg < 2; ++sg) kf[d][sg] = *(const bf16x8*)(KT + (d * 32 + l32) * 40 + sg * 16 + 8 * hh);
        if (cc >= NCTX / 32) {
        f32x16 att, o;
#pragma unroll
        for (int j = 0; j < 16; ++j) { att[j] = 0.f; o[j] = 0.f; }
        const bf16* krow = Kp + cperm * 136 + hh * 8; const bf16* qrow = Qp + l32 * 136 + hh * 8;
#pragma unroll
        for (int ks = 0; ks < 8; ++ks) { att = MFMA32(*(const bf16x8*)(krow + ks * 16), *(const bf16x8*)(qrow + ks * 16), att);
            o = MFMA32(pack8(S[ks >> 1], (ks & 1) * 8), *(const bf16x8*)(qrow + (ks >> 1) * 32 + (ks & 1) * 16), o); }
#pragma unroll
        for (int j = 0; j < 16; ++j) { const int sa = 16 * (j >> 3) + 8 * hh + 4 * ((j >> 2) & 1) + (j & 3); const bool keep = DIR == 0 ? (sa <= l32) : (sa >= l32); att[j] = keep ? att[j] : 0.f; }
        const bf16x8 p0 = pack8(att, 0), p1 = pack8(att, 8);
        o = MFMA32(vf0, p0, o); o = MFMA32(vf1, p1, o);
        bf16* op = OUT + (row0 + l32) * D + h * 128 + eb * 32 + 4 * hh;
#pragma unroll
        for (int jq = 0; jq < 4; ++jq) { u32x2 w; w.x = pkbf(o[4 * jq], o[4 * jq + 1]); w.y = pkbf(o[4 * jq + 2], o[4 * jq + 3]); *(u32x2*)(op + 8 * jq) = w; }
        }
#pragma unroll
        for (int d = 0; d < 4; ++d) { S[d] = MFMA32(kf[d][0], vf0, S[d]); S[d] = MFMA32(kf[d][1], vf1, S[d]); }
#pragma unroll
        for (int j = 0; j < 16; ++j) { const int rho = (j & 3) + 8 * (j >> 2) + 4 * hh; const f32x4 e4 = *(const f32x4*)(egl + 4 * rho);
            S[0][j] *= e4.x; S[1][j] *= e4.y; S[2][j] *= e4.z; S[3][j] *= e4.w; }
    }
#undef HG_LOAD
#undef HG_CHUNK
}
__device__ __forceinline__ void ph_hgrn_scan(const Frame& F) {
    for (int id = F.bid * NWAVES + F.wave; id < NB * 8 * 8; id += F.nb * NWAVES) {
        const int eb = id & 3, dir = (id >> 2) & 1, h = (id >> 3) & 7, b = id >> 6;
        if (dir == 0) hgrn_seq<0>(F, b, h, eb); else hgrn_seq<1>(F, b, h, eb);
    }
}
__device__ __forceinline__ void ph_hgrn_post(const Frame& F) {
    const bf16* ZIN = (const bf16*)(F.ws + WS_ZIN); const bf16* OFF = (const bf16*)(F.ws + WS_OFF); const bf16* OFB = (const bf16*)(F.ws + WS_OFB); bf16* O2 = (bf16*)(F.ws + WS_O2);
    const int lane = F.lane, part = lane & 7;
    f32x4 gn[4];
#pragma unroll
    for (int q = 0; q < 4; ++q) gn[q] = *(const f32x4*)(F.in[26] + part * 16 + q * 4);
    for (int row = F.bid * NWAVES + F.wave; row < R; row += F.nb * NWAVES) {
        if (row % P < NCTX) continue;
        const size_t o = (size_t)row * D + lane * 16;
        const u32x4 a0 = *(const u32x4*)(OFF + o), a1 = *(const u32x4*)(OFF + o + 8), b0 = *(const u32x4*)(OFB + o), b1 = *(const u32x4*)(OFB + o + 8);
        const u32x4 g0 = *(const u32x4*)(ZIN + (size_t)row * 4096 + 3 * D + lane * 16), g1 = *(const u32x4*)(ZIN + (size_t)row * 4096 + 3 * D + lane * 16 + 8);
        float v[16];
        v[0] = bflo(a0.x) + bflo(b0.x); v[1] = bfhi(a0.x) + bfhi(b0.x); v[2] = bflo(a0.y) + bflo(b0.y); v[3] = bfhi(a0.y) + bfhi(b0.y);
        v[4] = bflo(a0.z) + bflo(b0.z); v[5] = bfhi(a0.z) + bfhi(b0.z); v[6] = bflo(a0.w) + bflo(b0.w); v[7] = bfhi(a0.w) + bfhi(b0.w);
        v[8] = bflo(a1.x) + bflo(b1.x); v[9] = bfhi(a1.x) + bfhi(b1.x); v[10] = bflo(a1.y) + bflo(b1.y); v[11] = bfhi(a1.y) + bfhi(b1.y);
        v[12] = bflo(a1.z) + bflo(b1.z); v[13] = bfhi(a1.z) + bfhi(b1.z); v[14] = bflo(a1.w) + bflo(b1.w); v[15] = bfhi(a1.w) + bfhi(b1.w);
        float ss = 0.f;
#pragma unroll
        for (int q = 0; q < 16; ++q) ss += v[q] * v[q];
        ss += dpp_xor1(ss); ss += dpp_xor2(ss); ss += __shfl_xor(ss, 4);
        const float rinv = rsqrtf(ss * (1.0f / 128.0f) + EPS);
        const unsigned gw[8] = {g0.x, g0.y, g0.z, g0.w, g1.x, g1.y, g1.z, g1.w};
        unsigned w[8];
#pragma unroll
        for (int q = 0; q < 8; ++q) w[q] = pkbf(v[2 * q] * rinv * gn[q >> 1][(2 * q) & 3] * bflo(gw[q]), v[2 * q + 1] * rinv * gn[q >> 1][(2 * q + 1) & 3] * bfhi(gw[q]));
        *(u32x4*)(O2 + o) = (u32x4){w[0], w[1], w[2], w[3]}; *(u32x4*)(O2 + o + 8) = (u32x4){w[4], w[5], w[6], w[7]};
    }
}

enum { PH_BASE = __COUNTER__ };
__global__ void __launch_bounds__(NTHREADS, 2) fwd(Args args) {
    extern __shared__ __attribute__((aligned(16))) unsigned char lds[];
    Frame F;
    F.lds = lds; F.wave = __builtin_amdgcn_readfirstlane((int)threadIdx.x >> 6); F.bid = blockIdx.x; F.nb = gridDim.x;
    REFRESH_(F);
    F.in = args.in; F.out = args.out; F.ws = args.ws;
    F.MOD = (float*)(args.ws + WS_MOD); F.AFF = (float*)(args.ws + WS_AFF); F.SEL = (int*)(args.ws + WS_SEL); F.GATE = (float*)(args.ws + WS_GATE); F.INV = (int*)(args.ws + WS_INV);
    F.X = (bf16*)(args.ws + WS_X); F.H = (bf16*)(args.ws + WS_H);
    const int lo = args.ph_lo, hi = args.ph_hi;
#if MK_SINGLE
    volatile LAS unsigned* misc = (volatile LAS unsigned*)((LAS unsigned char*)lds + LDS_MISC);
    if (F.tid < 64) misc[F.tid] = 0u;
    __syncthreads();
    XcdBarrier bar = xcd_barrier_post((unsigned*)(args.ws + WS_CTL) + CW_BAR, misc, F.tid);
#define SEAM(k) do { if ((k) + 1 < hi) xcd_barrier(bar, F.tid); } while (0)
#else
#define SEAM(k) do { } while (0)
#endif
#define PH(...) do { constexpr int k_ = __COUNTER__ - PH_BASE - 1; if (lo <= k_ && k_ < hi) { REFRESH_(F); __VA_ARGS__; SEAM(k_); } } while (0)
    bf16* HID = (bf16*)(F.ws + WS_HID); bf16* Y = (bf16*)(F.ws + WS_Y);
    PG8_LAS unsigned char* ring = (PG8_LAS unsigned char*)lds;
    bf16 *Qb = (bf16*)(F.ws + WS_Q), *VTb = (bf16*)(F.ws + WS_VT), *Ob = (bf16*)(F.ws + WS_O);

#define GEMM_PHASE(EPI, gA, lda_, gB, ldb_, gK, nM_, nN_, groups_, gsM_, ...) do { const pg8::Gemm g_{(const bf16*)(gA), (const bf16*)(gB), (lda_), (ldb_), (gK), nullptr}; pg8::GroupedOrder S_; S_.init((nM_), (nN_), (groups_), (gsM_), F.nb, F.bid); \
        const EPI E_{__VA_ARGS__}; pg8::gemm_phase<EPI, pg8::GroupedOrder, PG8_ALIGN, PG8_SP2>(ring, g_, S_, E_, F.tid); } while (0)
#define GEMM_PHASE_LAT(EPI, gA, lda_, gB, ldb_, gK, nN_, ...) do { const pg8::Gemm g_{(const bf16*)(gA), (const bf16*)(gB), (lda_), (ldb_), (gK), nullptr}; pg8::LatentOrder S_; S_.init((nN_), F.nb, F.bid); \
        const EPI E_{__VA_ARGS__}; pg8::gemm_phase<EPI, pg8::LatentOrder, false, PG8_SP2>(ring, g_, S_, E_, F.tid); } while (0)
#define GEMM_PHASE_NOALIGN(EPI, gA, lda_, gB, ldb_, gK, nM_, nN_, groups_, gsM_, ...) do { const pg8::Gemm g_{(const bf16*)(gA), (const bf16*)(gB), (lda_), (ldb_), (gK), nullptr}; pg8::GroupedOrder S_; S_.init((nM_), (nN_), (groups_), (gsM_), F.nb, F.bid); \
        const EPI E_{__VA_ARGS__}; pg8::gemm_phase<EPI, pg8::GroupedOrder, false, PG8_SP2>(ring, g_, S_, E_, F.tid); } while (0)
#define GEMM_PHASE_GATHER(EPI, gA, lda_, gIdx, gB, ldb_, gK, nM_, nN_, groups_, gsM_, ...) do { const pg8::Gemm g_{(const bf16*)(gA), (const bf16*)(gB), (lda_), (ldb_), (gK), (gIdx)}; pg8::GroupedOrder S_; S_.init((nM_), (nN_), (groups_), (gsM_), F.nb, F.bid); \
        const EPI E_{__VA_ARGS__}; pg8::gemm_phase<EPI, pg8::GroupedOrder, PG8_ALIGN, PG8_SP2, true>(ring, g_, S_, E_, F.tid); } while (0)
#define MODL(L) (F.MOD + (size_t)(L) * 33 * 6144)
#define MOE_PHASES(L, NMT, NITEMS, SKIPC) \
    PH(ph_norm2<SKIPC>(F, (L))); \
    PH(ph_topk(F, (NITEMS))); \
    PH(GEMM_PHASE_GATHER(pg8::EpiSwigluT, F.H, D, F.SEL, F.ws + WO_GU, D, D, (NMT), 2 * FF / 256, NE, SLOTS / 256, HID, 2 * FF / 256, FF)); \
    PH(GEMM_PHASE(pg8::EpiDownT, HID, FF, F.ws + WO_DN, FF, FF, (NMT), D / 256, NE, SLOTS / 256, Y, F.GATE, D / 256));
#define OUT_PROJ(Asrc, Wsrc, L) PH(GEMM_PHASE_NOALIGN(pg8::EpiResidT, (Asrc), D, (Wsrc), D, D, R / 256, D / 256, 1, R / 256, F.X, MODL(L)));

    PH(ph_prologue(F));
    PH(ph_norm<0, false, true, false, true>(F, 0, 0));
    PH(GEMM_PHASE(pg8::EpiF32G, F.ws + WS_AG, 768, F.ws + WS_S5W1, 512, 512, 2304 / 256, 1, 64, 2304 / 256, (float*)(F.ws + WS_SS), 256, 1));
    PH(ph_s5_scan(F));
    PH(GEMM_PHASE(pg8::EpiS5Out, F.ws + WS_AG, 768, F.ws + WS_S5W2, 768, 768, 2304 / 256, 2, 64, 2304 / 256, F.H, (bf16*)(F.ws + WS_Z), F.in[15]));
    PH(GEMM_PHASE(pg8::EpiGluT, F.ws + WS_Z, D, F.ws + WO_GLU, D, D, R / 256, 2 * D / 256, 1, R / 256, F.X, MODL(0)));
    MOE_PHASES(0, SLOTS / 256, NB * NE * 2, false)
    PH(ph_norm<0, true>(F, 1, 0); convert_moe(F, 1));
    PH(GEMM_PHASE(pg8::EpiBf16<0>, F.H, D, F.ws + WO_NAQKV, D, D, R / 256, 2 * D / 256, 1, R / 256, Qb, D, nullptr, D, (size_t)(WS_K - WS_Q) / 2, 1.0f);
       GEMM_PHASE(pg8::EpiVtT<false>, F.ws + WO_NAQKV + (size_t)2 * D * D * 2, D, F.H, D, D, D / 256, R / 256, 1, D / 256, VTb));
    PH(ph_na_attn(F));
    OUT_PROJ(Ob, F.ws + WO_NAO, 1)
    MOE_PHASES(1, SLOTS / 256, NB * NE * 2, false)
    PH(ph_norm<0, true>(F, 2, 1); convert_moe(F, 2));
    PH({ LAS float* rt = (LAS float*)((LAS unsigned char*)F.lds + pg8::STAGE_BYTES + 4096);
         for (int i = F.tid; i < 2048; i += NTHREADS) rt[i] = ((const float*)(F.ws + WS_ROPE))[i];
         __syncthreads(); }
       GEMM_PHASE(pg8::EpiQKRope, F.H, D, F.ws + WO_DAQKV, D, D, R / 256, 2 * D / 256, 1, R / 256, Qb, (size_t)(WS_K - WS_Q) / 2, (const PG8_LAS float*)((LAS unsigned char*)F.lds + pg8::STAGE_BYTES + 4096));
       GEMM_PHASE(pg8::EpiVtT<false>, F.ws + WO_DAQKV + (size_t)2 * D * D * 2, D, F.H, D, D, D / 256, R / 256, 1, D / 256, VTb));
    PH(ph_da_attn(F));
    OUT_PROJ(Ob, F.ws + WO_DAO, 2)
    MOE_PHASES(2, SLOTS / 256, NB * NE * 2, false)
    PH(ph_norm<0, true>(F, 3, 2); convert_moe(F, 3));
    PH({ const pg8::Gemm g_{(const bf16*)F.H, (const bf16*)(F.ws + WO_HGIN), D, D, D, nullptr}; pg8::HgInOrder S_; S_.init(F.nb, F.bid);
         const pg8::EpiHgIn E_{(bf16*)(F.ws + WS_ZIN), (const float*)(F.ws + WS_LB)}; pg8::gemm_phase<pg8::EpiHgIn, pg8::HgInOrder, PG8_ALIGN, PG8_SP2>(ring, g_, S_, E_, F.tid); }
       GEMM_PHASE(pg8::EpiVtT<true>, F.ws + WO_HGIN + (size_t)4 * D * D * 2, D, F.H, D, D, D / 256, R / 256, 1, D / 256, (bf16*)(F.ws + WS_VTG)));
    PH(ph_hgrn_scan(F));
    PH(ph_hgrn_post(F));
    PH(GEMM_PHASE_LAT(pg8::EpiResidT, F.ws + WS_O2, D, F.ws + WO_HGO, D, D, D / 256, F.X, MODL(3)));
    MOE_PHASES(3, NB, NB * NE, true)
    PH(ph_norm<2, true, false, true>(F, 0, 3));
}
constexpr int NPH = __COUNTER__ - PH_BASE - 1;

extern "C" void kernel_launch(void* const* d_in, const int* in_sizes, int n_in, void* d_out, int out_size, void* d_ws, size_t ws_size, hipStream_t stream) {
    static int grid = 0;
    if (grid == 0) {
        if (n_in != 33 || ws_size < WS_NEED) { fprintf(stderr, "kernel_launch: n_in %d ws %zu (need %zu)\n", n_in, ws_size, (size_t)WS_NEED); grid = -1; return; }
        int dev = 0, cus = 0;
        if (hipGetDevice(&dev) != hipSuccess || hipDeviceGetAttribute(&cus, hipDeviceAttributeMultiprocessorCount, dev) != hipSuccess) { grid = -1; return; }
        if (hipFuncSetAttribute((const void*)fwd, hipFuncAttributeMaxDynamicSharedMemorySize, LDS_BYTES) != hipSuccess) { fprintf(stderr, "kernel_launch: hipFuncSetAttribute failed\n"); grid = -1; return; }
        int per_cu = 0;
        if (hipOccupancyMaxActiveBlocksPerMultiprocessor(&per_cu, (const void*)fwd, NTHREADS, LDS_BYTES) != hipSuccess || per_cu < 1) fprintf(stderr, "kernel_launch: occupancy query says %d\n", per_cu);
        (void)hipGetLastError();
        grid = cus;
    }
    if (grid < 0) return;
    (void)hipMemsetAsync((char*)d_ws + WS_CTL + (size_t)CW_BAR * 4, 0, (size_t)XCD_BAR_WORDS * 4, stream);
    Args a{};
    for (int i = 0; i < 33; ++i) a.in[i] = (const float*)d_in[i];
    a.out = (float*)d_out; a.ws = (unsigned char*)d_ws;
#if MK_SINGLE
    a.ph_lo = 0; a.ph_hi = NPH;
    hipLaunchKernelGGL(fwd, dim3(grid), dim3(NTHREADS), LDS_BYTES, stream, a);
#else
    for (int k = 0; k < NPH; ++k) { a.ph_lo = k; a.ph_hi = k + 1; hipLaunchKernelGGL(fwd, dim3(grid), dim3(NTHREADS), LDS_BYTES, stream, a); }
#endif
}
```
